# Optimizing an MI355X kernel written in HIP

```python
import math
import jax, jax.numpy as jnp
from jax import lax
import numpy as np

D_MODEL = 2048
BATCH = 2
SEQ = 4096
DEPTH = 1

ATTN_HEADS = 8
ATTN_HEAD_DIM = 128
ATTN_WIDTH = ATTN_HEADS * ATTN_HEAD_DIM
MOBA_BLOCK = 256
MOBA_TOPK = 3
MOBA_Q_CHUNK = 32

RWKV_HEAD_DIM = 64
RWKV_WIDTH = D_MODEL - ATTN_WIDTH
RWKV_HEADS = RWKV_WIDTH // RWKV_HEAD_DIM
DECAY_LORA = 96
AAA_LORA = 96
GATE_LORA = 256
RWKV_GN_EPS = RWKV_HEAD_DIM * 1e-5

PEER_HEADS = 8
PEER_NKEYS = 128
PEER_EXPERTS = PEER_NKEYS * PEER_NKEYS
PEER_DKEY = 256
PEER_HALF = PEER_DKEY // 2
PEER_TOPK = 16
PEER_TOK_CHUNK = 128

RMS_EPS = 1e-6
NEG = -1e30

RWKV_COLS = 3 * RWKV_WIDTH + DECAY_LORA + AAA_LORA + GATE_LORA
IN_COLS = 3 * ATTN_WIDTH + RWKV_COLS

kernel_name = "hymba_moba_rwkv7_peer_block"


def rmsnorm(x, g):
    xf = x.astype(jnp.float32)
    y = xf * lax.rsqrt(jnp.mean(xf * xf, axis=-1, keepdims=True) + RMS_EPS)
    return (y * g.astype(jnp.float32)).astype(x.dtype)


def alibi_slopes(n):
    return 2.0 ** (-8.0 * (jnp.arange(n, dtype=jnp.float32) + 1.0) / n)


def moba_attention(q, k, v):
    B, S, _ = q.shape
    H, hd, L = ATTN_HEADS, ATTN_HEAD_DIM, MOBA_BLOCK
    nb = -(-S // L)
    s_pad = nb * L
    to_heads = lambda t: t.reshape(B, S, H, hd).transpose(0, 2, 1, 3)
    q, k, v = to_heads(q), to_heads(k), to_heads(v)
    pad = ((0, 0), (0, 0), (0, s_pad - S), (0, 0))
    k = jnp.pad(k, pad)
    v = jnp.pad(v, pad)
    kb = k.reshape(B, H, nb, L, hd)
    vb = v.reshape(B, H, nb, L, hd)
    kmean = jnp.mean(kb.astype(jnp.float32), axis=3)
    gate = jnp.einsum('bhsd,bhnd->bhsn', q.astype(jnp.float32), kmean)
    qblk = jnp.arange(S, dtype=jnp.int32) // L
    past = jnp.arange(nb, dtype=jnp.int32)[None, :] < qblk[:, None]
    gate = jnp.where(past[None, None], gate, NEG)
    n_sel = min(MOBA_TOPK, nb)
    _, sel = lax.top_k(gate, n_sel)
    sel = sel.astype(jnp.int32)
    sel_valid = sel < qblk[None, None, :, None]
    scale = hd ** -0.5
    slopes = alibi_slopes(H)
    offs = jnp.arange(L, dtype=jnp.int32)
    gather = jax.vmap(jax.vmap(lambda blocks, idx: blocks[idx]))
    Q = MOBA_Q_CHUNK

    def chunk(c0):
        qc = lax.dynamic_slice_in_dim(q, c0, Q, axis=2)
        ic = lax.dynamic_slice_in_dim(sel, c0, Q, axis=2)
        mc = lax.dynamic_slice_in_dim(sel_valid, c0, Q, axis=2)
        qpos = c0 + jnp.arange(Q, dtype=jnp.int32)
        ksel = gather(kb, ic)
        vsel = gather(vb, ic)
        s_sel = jnp.einsum('bhqd,bhqnld->bhqnl', qc, ksel).astype(jnp.float32) * scale
        kpos_sel = ic[..., None] * L + offs
        dist_sel = (qpos[None, None, :, None, None] - kpos_sel).astype(jnp.float32)
        s_sel = s_sel - slopes[None, :, None, None, None] * dist_sel
        s_sel = jnp.where(mc[..., None], s_sel, NEG).reshape(B, H, Q, n_sel * L)
        own0 = (c0 // L) * L
        kown = lax.dynamic_slice_in_dim(k, own0, L, axis=2)
        vown = lax.dynamic_slice_in_dim(v, own0, L, axis=2)
        s_own = jnp.einsum('bhqd,bhld->bhql', qc, kown).astype(jnp.float32) * scale
        dist_own = qpos[:, None] - (own0 + offs)[None, :]
        s_own = jnp.where(dist_own[None, None] >= 0,
                          s_own - slopes[None, :, None, None] * dist_own.astype(jnp.float32)[None, None],
                          NEG)
        p = jax.nn.softmax(jnp.concatenate([s_sel, s_own], axis=-1), axis=-1)
        p_sel = p[..., :n_sel * L].reshape(B, H, Q, n_sel, L).astype(v.dtype)
        p_own = p[..., n_sel * L:].astype(v.dtype)
        return (jnp.einsum('bhqnl,bhqnld->bhqd', p_sel, vsel)
                + jnp.einsum('bhql,bhld->bhqd', p_own, vown))

    starts = jnp.arange(0, S, Q, dtype=jnp.int32)
    out = lax.map(chunk, starts)
    return out.transpose(1, 0, 3, 2, 4).reshape(B, S, H * hd)


def token_shift_lerp(p, mu):
    prev = jnp.pad(p, ((0, 0), (1, 0), (0, 0)))[:, :-1]
    return p + (prev - p) * mu


def rwkv7_time_mix(p, w0, w2, a0, a2, g2, k_k, k_a, r_k, ln_g, ln_b):
    B, S, _ = p.shape
    H, N, W = RWKV_HEADS, RWKV_HEAD_DIM, RWKV_WIDTH
    f32 = jnp.float32
    r, k, v = p[..., :W], p[..., W:2 * W], p[..., 2 * W:3 * W]
    o = 3 * W
    xw = p[..., o:o + DECAY_LORA]
    o += DECAY_LORA
    xa = p[..., o:o + AAA_LORA]
    o += AAA_LORA
    xg = p[..., o:o + GATE_LORA]
    w_log = -jax.nn.softplus(-(w0 + jnp.tanh(xw) @ w2)) - 0.5
    decay = jnp.exp(-jnp.exp(w_log.astype(f32)))
    a = jax.nn.sigmoid(a0 + xa @ a2)
    g = jax.nn.sigmoid(xg) @ g2
    heads = lambda t: t.reshape(B, S, H, N)
    kk = heads(k * k_k).astype(f32)
    kk = kk / jnp.maximum(jnp.sqrt(jnp.sum(kk * kk, axis=-1, keepdims=True)), 1e-12)
    k = k * (1.0 + (a - 1.0) * k_a)
    r_h, k_h, v_h = heads(r), heads(k), heads(v)
    a_h = heads(a).astype(f32)
    b = kk * a_h
    xs = tuple(t.astype(f32).transpose(1, 0, 2, 3)
               for t in (r_h, heads(decay), k_h, v_h, -kk, b))

    def step(state, inp):
        rt, wt, kt, vt, at, bt = inp
        sa = jnp.einsum('bhij,bhj->bhi', state, at)
        state = (state * wt[:, :, None, :] + sa[..., None] * bt[:, :, None, :]
                 + vt[..., :, None] * kt[..., None, :])
        y = jnp.einsum('bhij,bhj->bhi', state, rt)
        return state, y

    s0 = jnp.zeros((B, H, N, N), f32)
    _, y = lax.scan(step, s0, xs)
    y = y.transpose(1, 0, 2, 3)
    mu = jnp.mean(y, axis=-1, keepdims=True)
    var = jnp.mean(jnp.square(y - mu), axis=-1, keepdims=True)
    y = ((y - mu) * lax.rsqrt(var + RWKV_GN_EPS)).reshape(B, S, W)
    y = y * ln_g.astype(f32) + ln_b.astype(f32)
    bonus = (jnp.sum(r_h * k_h * r_k, axis=-1, keepdims=True) * v_h).reshape(B, S, W)
    return ((y + bonus.astype(f32)) * g.astype(f32)).astype(p.dtype)


def peer_ffn(x, wq, sub_keys, u, v):
    B, S, D = x.shape
    T = B * S
    H, K, C = PEER_HEADS, PEER_TOPK, PEER_TOK_CHUNK
    xt = x.reshape(T, D)
    q = (xt @ wq).reshape(T, H, 2, PEER_HALF)
    s = jnp.einsum('thpc,hpnc->thpn', q, sub_keys).astype(jnp.float32)
    sv, si = lax.top_k(s, K)
    cand = (sv[:, :, 0, :, None] + sv[:, :, 1, None, :]).reshape(T, H, K * K)
    best, bi = lax.top_k(cand, K)
    i1 = jnp.take_along_axis(si[:, :, 0], bi // K, axis=-1)
    i2 = jnp.take_along_axis(si[:, :, 1], bi % K, axis=-1)
    expert = (i1 * PEER_NKEYS + i2).astype(jnp.int32)
    gates = jax.nn.softmax(best, axis=-1)
    nc = T // C

    def chunk(args):
        xc, ec, gc = args
        hpre = jnp.einsum('cd,chkd->chk', xc, u[ec]).astype(jnp.float32)
        act = (jax.nn.gelu(hpre, approximate=False) * gc).astype(x.dtype)
        return jnp.einsum('chk,chkd->cd', act, v[ec])

    y = lax.map(chunk, (xt.reshape(nc, C, D), expert.reshape(nc, C, H, K),
                        gates.reshape(nc, C, H, K)))
    return y.reshape(B, S, D)


def setup_inputs(seed: int = 0) -> dict:
    key = jax.random.key(seed)
    ks = jax.random.split(key, 22)
    f32 = jnp.float32
    nrm = lambda kk, shape, sc: jax.random.normal(kk, shape, f32) * sc
    L = DEPTH
    return {
        'x': nrm(ks[0], (BATCH, SEQ, D_MODEL), 1.0),
        'norm1_g': 1.0 + nrm(ks[1], (L, D_MODEL), 0.02),
        'w_in': nrm(ks[2], (L, D_MODEL, IN_COLS), D_MODEL ** -0.5),
        'rwkv_mu': jax.random.uniform(ks[3], (L, RWKV_COLS), f32),
        'rwkv_w0': jnp.tile(jnp.linspace(-6.0, -1.0, RWKV_HEAD_DIM, dtype=f32), RWKV_HEADS)[None]
                   + nrm(ks[4], (L, RWKV_WIDTH), 0.1),
        'rwkv_w2': nrm(ks[5], (L, DECAY_LORA, RWKV_WIDTH), 0.1 * DECAY_LORA ** -0.5),
        'rwkv_a0': nrm(ks[6], (L, RWKV_WIDTH), 0.5),
        'rwkv_a2': nrm(ks[7], (L, AAA_LORA, RWKV_WIDTH), AAA_LORA ** -0.5),
        'rwkv_g2': nrm(ks[8], (L, GATE_LORA, RWKV_WIDTH), GATE_LORA ** -0.5),
        'rwkv_k_k': 0.85 + nrm(ks[9], (L, RWKV_WIDTH), 0.02),
        'rwkv_k_a': 1.0 + nrm(ks[10], (L, RWKV_WIDTH), 0.02),
        'rwkv_r_k': nrm(ks[11], (L, RWKV_HEADS, RWKV_HEAD_DIM), 0.1),
        'rwkv_ln_g': 1.0 + nrm(ks[12], (L, RWKV_WIDTH), 0.02),
        'rwkv_ln_b': nrm(ks[13], (L, RWKV_WIDTH), 0.02),
        'w_out': nrm(ks[14], (L, ATTN_WIDTH + RWKV_WIDTH, D_MODEL), D_MODEL ** -0.5),
        'norm2_g': 1.0 + nrm(ks[15], (L, D_MODEL), 0.02),
        'peer_wq': nrm(ks[16], (L, D_MODEL, PEER_HEADS * PEER_DKEY), D_MODEL ** -0.5),
        'peer_sub_keys': nrm(ks[17], (L, PEER_HEADS, 2, PEER_NKEYS, PEER_HALF), PEER_HALF ** -0.5),
        'peer_u': nrm(ks[18], (L, PEER_EXPERTS, D_MODEL), D_MODEL ** -0.5),
        'peer_v': nrm(ks[19], (L, PEER_EXPERTS, D_MODEL), PEER_HEADS ** -0.5),
        'final_g': 1.0 + nrm(ks[20], (D_MODEL,), 0.02),
    }


def reference(x, norm1_g, w_in, rwkv_mu, rwkv_w0, rwkv_w2, rwkv_a0, rwkv_a2, rwkv_g2,
              rwkv_k_k, rwkv_k_a, rwkv_r_k, rwkv_ln_g, rwkv_ln_b, w_out, norm2_g,
              peer_wq, peer_sub_keys, peer_u, peer_v, final_g):
    A = ATTN_WIDTH
    h = x
    for l in range(DEPTH):
        xn = rmsnorm(h, norm1_g[l])
        proj = xn @ w_in[l]
        attn = moba_attention(proj[..., :A], proj[..., A:2 * A], proj[..., 2 * A:3 * A])
        rw_in = token_shift_lerp(proj[..., 3 * A:], rwkv_mu[l])
        rw = rwkv7_time_mix(rw_in, rwkv_w0[l], rwkv_w2[l], rwkv_a0[l], rwkv_a2[l], rwkv_g2[l],
                            rwkv_k_k[l], rwkv_k_a[l], rwkv_r_k[l], rwkv_ln_g[l], rwkv_ln_b[l])
        h = h + jnp.concatenate([attn, rw], axis=-1) @ w_out[l]
        h = h + peer_ffn(rmsnorm(h, norm2_g[l]), peer_wq[l], peer_sub_keys[l], peer_u[l], peer_v[l])
    return rmsnorm(h, final_g)
```

```cpp
#include <hip/hip_runtime.h>
#include <cstdio>
#include <cstdint>
__device__ __forceinline__ int ltid() { int t = threadIdx.x; asm volatile("" : "+v"(t)); return t; }
namespace pg8 {
#define PG8_LAS __attribute__((address_space(3)))
typedef unsigned short bf16_t;
typedef short bf16x8 __attribute__((ext_vector_type(8)));
typedef float f32x4 __attribute__((ext_vector_type(4)));
typedef unsigned u32x4 __attribute__((ext_vector_type(4)));
constexpr int BM = 256, BK = 64, HALF = 128, HTB = HALF * BK * 2  , STAGE_BYTES = 8 * HTB, NXCD = 8, WGM = 8;

__host__ __device__ __forceinline__ int lds_byte(int r, int c) { const int st = (r >> 4) * 2 + (c >> 5), rr = r & 15, cc = c & 31, ob = rr * 64 + cc * 2; return st * 1024 + (ob ^ (((ob >> 9) & 1) << 5)); }
__host__ __device__ __forceinline__ void stage_rc(int b, int& R, int& C) { const int st = b / 1024, sb = b % 1024, swz = sb ^ (((sb >> 9) & 1) << 5); R = (st >> 1) * 16 + swz / 64; C = (st & 1) * 32 + (swz % 64) / 2; }
__host__ __device__ __forceinline__ int perm32(int rho) { const int n = rho >> 4, i = rho & 15; return 8 * (i >> 2) + 4 * n + (i & 3); }

struct Unit { int pm, pn; };
struct Gemm { const bf16_t* A; const bf16_t* Bt; int M, N, K; };

struct StaticOrder {
    int nM, nN, nwg, G, c;
    __host__ __device__ void init(int M, int N, int G_, int c_) { nM = M / BM; nN = N / BM; nwg = nM * nN; G = G_; c = c_; }
    __host__ __device__ bool next(int i, Unit& u) const {
        const long L = (long)i * G + c; if (L >= nwg) return false;
        int wgid = (int)L; { const int q = nwg / NXCD, r = nwg % NXCD, xcd = wgid % NXCD, off = wgid / NXCD; wgid = (xcd < r ? xcd * (q + 1) : r * (q + 1) + (xcd - r) * q) + off; }
        const int nig = WGM * nN, gid = wgid / nig, fm = gid * WGM, gsz = (nM - fm) < WGM ? (nM - fm) : WGM;
        u.pm = fm + ((wgid % nig) % gsz); u.pn = (wgid % nig) / gsz; return true;
    }
    __device__ __forceinline__ void a_ready(const Unit&) const {}
    __device__ __forceinline__ void done(const Unit&) const {}
};

__device__ __forceinline__ unsigned cvt_pk_bf16(float lo, float hi) { unsigned r; asm volatile("v_cvt_pk_bf16_f32 %0, %1, %2" : "=v"(r) : "v"(lo), "v"(hi)); return r; }
typedef float f32x2 __attribute__((ext_vector_type(2)));
__device__ __forceinline__ f32x2 gelu_pk(f32x2 v) {
    const f32x2 av = __builtin_elementwise_abs(v), d = av * 0.2316418882f + 1.0f;
    f32x2 t; t.x = __builtin_amdgcn_rcpf(d.x); t.y = __builtin_amdgcn_rcpf(d.y);
    f32x2 q = t * 0.5307027145f + (-0.7265760135f); q = q * t + 0.7107068705f; q = q * t + (-0.142248368f); q = q * t + 0.127414796f; q = q * t;
    const f32x2 s = (v * v) * (-0.72134752044f);
    f32x2 e; e.x = __builtin_amdgcn_exp2f(s.x); e.y = __builtin_amdgcn_exp2f(s.y);
    const f32x2 m = v * (q * e), r = v - m;
    f32x2 o; o.x = v.x < 0.f ? m.x : r.x; o.y = v.y < 0.f ? m.y : r.y; return o;
}

template <int ACT  > struct EpiBf16 {
    static constexpr bool PERM = true, AFTER_DRAIN = false; static_assert(ACT == 0 || ACT == 1, "EpiBf16: ACT is 0 (none) or 1 (gelu_pk)");
    bf16_t* O; int ldc; const float* bias; int split_cols; size_t split_stride; float scale0;
    __device__ __forceinline__ void operator()(const f32x4 (&acc)[2][2][4][2], const Unit& u, int wr, int wc, int fr, int fq) const {
        const int row0 = u.pm * BM + wr * 64 + fr; int colt = u.pn * BM; bf16_t* base = O;
        float sc = 1.f; if (split_cols) { const int t = colt / split_cols; base += (size_t)t * split_stride; colt -= t * split_cols; if (t == 0) sc = scale0; }
        const int col0 = colt + wc * 32 + 8 * fq, bcol0 = u.pn * BM + wc * 32 + 8 * fq;
        f32x4 bv[2][2];
#pragma unroll
        for (int bj = 0; bj < 2; ++bj)
#pragma unroll
            for (int n = 0; n < 2; ++n) bv[bj][n] = bias ? *(const f32x4*)(bias + bcol0 + bj * HALF + 4 * n) : (f32x4){0.f, 0.f, 0.f, 0.f};
#pragma unroll
        for (int ai = 0; ai < 2; ++ai)
#pragma unroll
            for (int m = 0; m < 4; ++m) { bf16_t* rowp = base + (size_t)(row0 + ai * HALF + m * 16) * ldc + col0;
#pragma unroll
                for (int bj = 0; bj < 2; ++bj) { f32x4 v0 = acc[ai][bj][m][0] + bv[bj][0], v1 = acc[ai][bj][m][1] + bv[bj][1];
                    if (ACT == 1) { f32x2 a = gelu_pk((f32x2){v0[0], v0[1]}), b = gelu_pk((f32x2){v0[2], v0[3]}), c = gelu_pk((f32x2){v1[0], v1[1]}), d = gelu_pk((f32x2){v1[2], v1[3]});
                        v0 = (f32x4){a.x, a.y, b.x, b.y}; v1 = (f32x4){c.x, c.y, d.x, d.y}; }
                    v0 = v0 * sc; v1 = v1 * sc; u32x4 w; w.x = cvt_pk_bf16(v0[0], v0[1]); w.y = cvt_pk_bf16(v0[2], v0[3]); w.z = cvt_pk_bf16(v1[0], v1[1]); w.w = cvt_pk_bf16(v1[2], v1[3]);
                    *(u32x4*)(rowp + bj * HALF) = w; } }
    }
};
template <class Epi, class Sched, bool ALIGN_EPI = false, bool SP2 = false>
__device__ __forceinline__ void gemm_phase(PG8_LAS unsigned char* lds, const Gemm g, const Sched& S, const Epi& E) {
    const int tid = ltid(), wid = __builtin_amdgcn_readfirstlane(tid >> 6), lane = tid & 63, wr = wid >> 2, wc = wid & 3, fr = lane & 15, fq = lane >> 4;
    const int K = g.K, nt = K / BK;
    unsigned voffA[2], voffB[2];
#pragma unroll
    for (int i = 0; i < 2; ++i) { int R, C; stage_rc(tid * 16 + i * 8192, R, C); const int Rb = Epi::PERM ? ((R & ~31) + perm32(R & 31)) : R;
        voffA[i] = (unsigned)(R * K + C) * 2u; voffB[i] = (unsigned)(Rb * K + C) * 2u; }
    const size_t kstep = (size_t)(BK * 2);
    const size_t hstep = (size_t)HALF * K * 2;
    const size_t tstep = 2 * hstep;
    const unsigned ldsw = (unsigned)wid * 1024u;
    const int aoff = lds_byte(wr * 64 + fr, fq * 8), boff = lds_byte(wc * 32 + fr, fq * 8);
#define PG8_SA(b, h) (((b) * 2 + (h)) * HTB)
#define PG8_SB(b, h) ((4 + (b) * 2 + (h)) * HTB)
#define PG8_STAGE(bufoff, gbase, voff) do { _Pragma("unroll") for (int _i = 0; _i < 2; ++_i) \
        __builtin_amdgcn_global_load_lds((const unsigned*)((const char*)(gbase) + (voff)[_i]), (PG8_LAS unsigned*)(lds + (bufoff) + ldsw + _i * 8192), 16, 0, 0); } while (0)
#define PG8_LDA(dst, b, h) do { _Pragma("unroll") for (int m = 0; m < 4; ++m) _Pragma("unroll") for (int k = 0; k < 2; ++k) dst[m][k] = *(const PG8_LAS bf16x8*)(lds + PG8_SA(b, h) + aoff + m * 2048 + k * 1024); } while (0)
#define PG8_LDB(dst, b, h) do { _Pragma("unroll") for (int n = 0; n < 2; ++n) _Pragma("unroll") for (int k = 0; k < 2; ++k) dst[n][k] = *(const PG8_LAS bf16x8*)(lds + PG8_SB(b, h) + boff + n * 2048 + k * 1024); } while (0)
#define PG8_MMA(ai, bj, At, Bt) do { __builtin_amdgcn_s_setprio(1); _Pragma("unroll") for (int m = 0; m < 4; ++m) _Pragma("unroll") for (int n = 0; n < 2; ++n) _Pragma("unroll") for (int k = 0; k < 2; ++k) \
        acc[ai][bj][m][n] = __builtin_amdgcn_mfma_f32_16x16x32_bf16(Bt[n][k], At[m][k], acc[ai][bj][m][n], 0, 0, 0); __builtin_amdgcn_s_setprio(0); } while (0)
#define PG8_WAIT_V(n) asm volatile("s_waitcnt vmcnt(" #n ")" ::: "memory")
#define PG8_WAIT_L(n) asm volatile("s_waitcnt lgkmcnt(" #n ")" ::: "memory")
#define PG8_BAR __builtin_amdgcn_s_barrier()
#define PG8_SCHED __builtin_amdgcn_sched_barrier(0)
    Unit cur, nxt; int ui = 0;
    if (!S.next(0, cur)) return;
    f32x4 acc[2][2][4][2];
#pragma unroll
    for (int a = 0; a < 2; ++a)
#pragma unroll
        for (int b = 0; b < 2; ++b)
#pragma unroll
            for (int m = 0; m < 4; ++m)
#pragma unroll
                for (int n = 0; n < 2; ++n) acc[a][b][m][n] = (f32x4){0.f, 0.f, 0.f, 0.f};
    bf16x8 At[4][2], B0[2][2], B1[2][2];
    const char* cA = (const char*)g.A + (size_t)cur.pm * tstep; const char* cB = (const char*)g.Bt + (size_t)cur.pn * tstep;
    S.a_ready(cur);
    if constexpr (SP2) {
        PG8_STAGE(PG8_SB(0, 0), cB, voffB); PG8_STAGE(PG8_SB(0, 1), cB + hstep, voffB); PG8_STAGE(PG8_SA(0, 0), cA, voffA); PG8_STAGE(PG8_SA(0, 1), cA + hstep, voffA);
        if (wr == 1) PG8_BAR;
        PG8_WAIT_V(2); PG8_BAR;
        PG8_STAGE(PG8_SB(1, 0), cB + kstep, voffB); PG8_STAGE(PG8_SA(1, 0), cA + kstep, voffA); PG8_STAGE(PG8_SB(1, 1), cB + hstep + kstep, voffB);
        PG8_WAIT_V(6); PG8_BAR;
    } else {
        PG8_STAGE(PG8_SB(0, 0), cB, voffB); PG8_STAGE(PG8_SA(0, 0), cA, voffA); PG8_STAGE(PG8_SB(0, 1), cB + hstep, voffB); PG8_STAGE(PG8_SA(0, 1), cA + hstep, voffA);
        if (wr == 1) PG8_BAR;
        PG8_WAIT_V(4); PG8_BAR;
        PG8_STAGE(PG8_SB(1, 0), cB + kstep, voffB); PG8_STAGE(PG8_SA(1, 0), cA + kstep, voffA); PG8_STAGE(PG8_SB(1, 1), cB + hstep + kstep, voffB);
        PG8_WAIT_V(6); PG8_BAR;
    }
    for (;;) {
        const bool has_next = S.next(ui + 1, nxt);
        const char* nA = has_next ? (const char*)g.A + (size_t)nxt.pm * tstep : cA; const char* nB = has_next ? (const char*)g.Bt + (size_t)nxt.pn * tstep : cB;
        for (int t = 0; t < nt; t += 2) {
            const bool last = (t == nt - 2);
            const char* a1 = cA + (size_t)(t + 1) * kstep;
            const char* a2 = last ? nA : cA + (size_t)(t + 2) * kstep; const char* b2 = last ? nB : cB + (size_t)(t + 2) * kstep;
            const char* a3 = a2 + kstep; const char* b3 = b2 + kstep;
            if (last && has_next) S.a_ready(nxt);
            if constexpr (SP2) {
            PG8_LDB(B0, 0, 0); PG8_LDB(B1, 0, 1); PG8_SCHED; PG8_LDA(At, 0, 0); PG8_STAGE(PG8_SA(1, 1), a1 + hstep, voffA);
            PG8_WAIT_V(8); PG8_WAIT_L(0); PG8_BAR; PG8_MMA(0, 0, At, B0); PG8_MMA(0, 1, At, B1); PG8_BAR; PG8_SCHED;
            PG8_LDA(At, 0, 1); PG8_STAGE(PG8_SB(0, 0), b2, voffB); PG8_STAGE(PG8_SB(0, 1), b2 + hstep, voffB); PG8_STAGE(PG8_SA(0, 0), a2, voffA);
            PG8_WAIT_V(8); PG8_WAIT_L(0); PG8_BAR; PG8_MMA(1, 0, At, B0); PG8_MMA(1, 1, At, B1); PG8_BAR; PG8_SCHED;
            PG8_LDB(B0, 1, 0); PG8_LDB(B1, 1, 1); PG8_SCHED; PG8_LDA(At, 1, 0); PG8_STAGE(PG8_SA(0, 1), a2 + hstep, voffA);
            PG8_WAIT_V(8); PG8_WAIT_L(0); PG8_BAR; PG8_MMA(0, 0, At, B0); PG8_MMA(0, 1, At, B1); PG8_BAR; PG8_SCHED;
            PG8_LDA(At, 1, 1); PG8_STAGE(PG8_SB(1, 0), b3, voffB); PG8_STAGE(PG8_SB(1, 1), b3 + hstep, voffB); PG8_STAGE(PG8_SA(1, 0), a3, voffA);
            PG8_WAIT_V(8); PG8_WAIT_L(0); PG8_BAR; PG8_MMA(1, 0, At, B0); PG8_MMA(1, 1, At, B1); PG8_BAR; PG8_SCHED;
            } else {
            PG8_LDB(B0, 0, 0); PG8_SCHED; PG8_LDA(At, 0, 0); PG8_STAGE(PG8_SA(1, 1), a1 + hstep, voffA);
            PG8_WAIT_L(8); PG8_BAR; PG8_WAIT_L(0); PG8_MMA(0, 0, At, B0); PG8_BAR; PG8_SCHED;
            PG8_LDB(B1, 0, 1); PG8_STAGE(PG8_SB(0, 0), b2, voffB);
            PG8_BAR; PG8_WAIT_L(0); PG8_MMA(0, 1, At, B1); PG8_BAR;
            PG8_LDA(At, 0, 1); PG8_STAGE(PG8_SA(0, 0), a2, voffA);
            PG8_BAR; PG8_WAIT_L(0); PG8_MMA(1, 0, At, B0); PG8_BAR; PG8_SCHED;
            PG8_STAGE(PG8_SB(0, 1), b2 + hstep, voffB);
            PG8_WAIT_V(6); PG8_BAR; PG8_MMA(1, 1, At, B1); PG8_BAR;
            PG8_LDB(B0, 1, 0); PG8_SCHED; PG8_LDA(At, 1, 0); PG8_STAGE(PG8_SA(0, 1), a2 + hstep, voffA);
            PG8_WAIT_L(8); PG8_BAR; PG8_WAIT_L(0); PG8_MMA(0, 0, At, B0); PG8_BAR; PG8_SCHED;
            PG8_LDB(B1, 1, 1); PG8_STAGE(PG8_SB(1, 0), b3, voffB);
            PG8_BAR; PG8_WAIT_L(0); PG8_MMA(0, 1, At, B1); PG8_BAR;
            PG8_LDA(At, 1, 1); PG8_STAGE(PG8_SA(1, 0), a3, voffA);
            PG8_BAR; PG8_WAIT_L(0); PG8_MMA(1, 0, At, B0); PG8_BAR; PG8_SCHED;
            PG8_STAGE(PG8_SB(1, 1), b3 + hstep, voffB);
            PG8_WAIT_V(6); PG8_BAR; PG8_MMA(1, 1, At, B1); PG8_BAR;
            }
        }
        if constexpr (ALIGN_EPI) { if (wr == 0) PG8_BAR; }
        if constexpr (!Epi::AFTER_DRAIN) { E(acc, cur, wr, wc, fr, fq); S.done(cur); }
        if (!has_next) break;
#pragma unroll
        for (int a = 0; a < 2; ++a)
#pragma unroll
            for (int b = 0; b < 2; ++b)
#pragma unroll
                for (int m = 0; m < 4; ++m)
#pragma unroll
                    for (int n = 0; n < 2; ++n) acc[a][b][m][n] = (f32x4){0.f, 0.f, 0.f, 0.f};
        cur = nxt; cA = nA; cB = nB; ++ui;
        if constexpr (ALIGN_EPI) { if (wr == 1) PG8_BAR; }
    }
    PG8_WAIT_V(0);
    if constexpr (!ALIGN_EPI) { if (wr == 0) PG8_BAR; }
    PG8_BAR;
    if constexpr (Epi::AFTER_DRAIN) { E.fused(acc, cur, wr, wc, fr, fq, lds, wid, lane); S.done(cur); }
#undef PG8_SA
#undef PG8_SB
#undef PG8_STAGE
#undef PG8_LDA
#undef PG8_LDB
#undef PG8_MMA
#undef PG8_WAIT_V
#undef PG8_WAIT_L
#undef PG8_BAR
#undef PG8_SCHED
}
}
#define GAS __attribute__((address_space(1)))
#define LAS __attribute__((address_space(3)))
typedef unsigned short bf16;
typedef unsigned v4u __attribute__((ext_vector_type(4)));
typedef unsigned v2u __attribute__((ext_vector_type(2)));
typedef float f32x4 __attribute__((ext_vector_type(4)));
constexpr int NWAVES = 8, NTHR = 512;
constexpr int TT = 8192, DM = 2048, SEQ = 4096;
constexpr int INC = 6592, INCP = 6656;
constexpr int C_AK = 1024, C_AV = 2048, C_RW = 3072;
constexpr int RWC = 3520;
constexpr float RMS_EPS = 1e-6f;
constexpr size_t MiB = 1u << 20;
constexpr size_t WS_CTL = 0, CTL_ZERO_BYTES = 1 * MiB;
constexpr size_t WS_WIN = 1 * MiB;
constexpr size_t WS_WOUT = 27 * MiB;
constexpr size_t WS_WQ = 35 * MiB;
constexpr size_t WS_XN = 43 * MiB;
constexpr size_t WS_PROJ = 75 * MiB;
constexpr size_t WS_AR = 179 * MiB;
constexpr size_t WS_H = 211 * MiB;
constexpr size_t WS_RWA = 275 * MiB;
constexpr size_t WS_CHK = 339 * MiB;
constexpr size_t WS_KMEAN = 467 * MiB;
constexpr size_t WS_ACT = WS_H;
constexpr size_t WS_SSP = WS_WIN + 4 * MiB;
constexpr size_t WS_LORA = 468 * MiB;
constexpr size_t WS_END = 469 * MiB;
constexpr int CW_BAR = 4096, CW_MOBA_CTR = 16384, CW_SS = 32768;
constexpr int RING_BYTES = 147456, LDSCTL_OFF = RING_BYTES, MISC_OFF = LDSCTL_OFF + 320, LDS_BYTES = 163840;

struct Params {
    const float* x; const float* norm1_g; const float* w_in; const float* mu; const float* w0; const float* w2; const float* a0; const float* a2; const float* g2;
    const float* k_k; const float* k_a; const float* r_k; const float* ln_g; const float* ln_b; const float* w_out; const float* norm2_g; const float* wq;
    const float* sub_keys; const float* pu; const float* pv; const float* final_g;
    float* out; unsigned char* ws;
    int ph_lo, ph_hi, bar_li, pad;
};

typedef const __attribute__((address_space(4))) Params& KP;
__device__ __forceinline__ const __attribute__((address_space(4))) Params* params_ptr() {
    const __attribute__((address_space(4))) Params* ka = (const __attribute__((address_space(4))) Params*)__builtin_amdgcn_kernarg_segment_ptr(); asm volatile("" : "+s"(ka)); return ka; }
typedef float f32x2_t __attribute__((ext_vector_type(2))); typedef __bf16 bf16x2_t __attribute__((ext_vector_type(2)));
__device__ __forceinline__ unsigned pk2(float lo, float hi) { const f32x2_t v = {lo, hi}; const bf16x2_t b = __builtin_convertvector(v, bf16x2_t); return __builtin_bit_cast(unsigned, b); }
__device__ __forceinline__ unsigned f2bf(float f) { return pk2(f, 0.f) & 0xffffu; }
__device__ __forceinline__ float bf2f(bf16 v) { return __builtin_bit_cast(float, (unsigned)v << 16); }
__device__ __forceinline__ float bflo(unsigned u) { return __builtin_bit_cast(float, u << 16); }
__device__ __forceinline__ float bfhi(unsigned u) { return __builtin_bit_cast(float, u & 0xffff0000u); }
#define DPP_F(v, ctrl) __builtin_bit_cast(float, __builtin_amdgcn_update_dpp(0, __builtin_bit_cast(int, (v)), (ctrl), 0xf, 0xf, true))
__device__ __forceinline__ float wave_sum(float v) {
    v += DPP_F(v, 0xB1);
    v += DPP_F(v, 0x4E);
    v += DPP_F(v, 0x141);
    v += DPP_F(v, 0x140);
    const int b = __builtin_bit_cast(int, v);
    return (__builtin_bit_cast(float, __builtin_amdgcn_readlane(b, 0)) + __builtin_bit_cast(float, __builtin_amdgcn_readlane(b, 16))) +
           (__builtin_bit_cast(float, __builtin_amdgcn_readlane(b, 32)) + __builtin_bit_cast(float, __builtin_amdgcn_readlane(b, 48)));
}
__device__ __forceinline__ float wave_max(float v) {
#pragma unroll
    for (int o = 1; o < 64; o <<= 1) v = fmaxf(v, __shfl_xor(v, o));
    return v;
}
#define LDS_WAIT() asm volatile("s_waitcnt lgkmcnt(0)" ::: "memory")

__device__ __forceinline__ void p0_transpose_item(const float* W, int K, int N, bf16* WT, LAS float* scr, int item, int lane, const float* ksc = nullptr) {
    const int nblk = N / 32, kb = item / nblk, nb = item % nblk, k0 = 64 * kb, n0 = 32 * nb;
#pragma unroll 8
    for (int i = 0; i < 32; ++i) { const int kk = 2 * i + (lane >> 5); float wv = W[(size_t)(k0 + kk) * N + n0 + (lane & 31)]; if (ksc) wv *= ksc[k0 + kk]; scr[kk * 33 + (lane & 31)] = wv; }
    LDS_WAIT(); asm volatile("" ::: "memory");
    const int c = lane & 7;
#pragma unroll
    for (int j = 0; j < 4; ++j) { const int n = (lane >> 3) + 8 * j; const LAS float* s = scr + (8 * c) * 33 + n;
        v4u o; o.x = pk2(s[0 * 33], s[1 * 33]); o.y = pk2(s[2 * 33], s[3 * 33]); o.z = pk2(s[4 * 33], s[5 * 33]); o.w = pk2(s[6 * 33], s[7 * 33]);
        *(v4u*)(WT + (size_t)(n0 + n) * K + k0 + 8 * c) = o; }
    LDS_WAIT(); asm volatile("" ::: "memory");
}
__device__ __forceinline__ void rms_row_to_bf16(const float* xrow, const float* g, bf16* orow, int lane) {
    const f32x4* xr = (const f32x4*)xrow + lane;
    f32x4 v[8]; float s = 0.f;
#pragma unroll
    for (int j = 0; j < 8; ++j) { v[j] = xr[64 * j]; s += (v[j].x * v[j].x + v[j].y * v[j].y) + (v[j].z * v[j].z + v[j].w * v[j].w); }
    const float rs = 1.0f / sqrtf(wave_sum(s) * (1.f / DM) + RMS_EPS);
    v2u* o8 = (v2u*)orow + lane;
#pragma unroll
    for (int j = 0; j < 8; ++j) { const f32x4 gg = ((const f32x4*)g)[lane + 64 * j];
        v2u o; o.x = pk2(v[j].x * rs * gg.x, v[j].y * rs * gg.y); o.y = pk2(v[j].z * rs * gg.z, v[j].w * rs * gg.w); o8[64 * j] = o; }
}
__device__ __forceinline__ void phase_prologue(KP P, LAS unsigned char* lds, int vcu, int G) {
    const int tid = ltid(), lane = tid & 63, wave = tid >> 6;
    LAS float* scr = (LAS float*)(lds + wave * 16384);
    const int gw = vcu * NWAVES + wave, NGW = G * NWAVES;
    bf16* WIN = (bf16*)(P.ws + WS_WIN); bf16* WOUT = (bf16*)(P.ws + WS_WOUT); bf16* WQ = (bf16*)(P.ws + WS_WQ); bf16* XN = (bf16*)(P.ws + WS_XN);
    constexpr int I_IN = (DM / 64) * (INC / 32), I_SQ = (DM / 64) * (DM / 32);
    for (int it = gw; it < I_IN + 2 * I_SQ; it += NGW) {
        int r = it;
        if (r < I_IN) { p0_transpose_item(P.w_in, DM, INC, WIN, scr, r, lane); continue; } r -= I_IN;
        if (r < I_SQ) { p0_transpose_item(P.w_out, DM, DM, WOUT, scr, r, lane); continue; } r -= I_SQ;
        p0_transpose_item(P.wq, DM, DM, WQ, scr, r, lane, P.norm2_g);
    }
    for (int i = vcu * NTHR + tid; i < (INCP - INC) * DM / 8; i += G * NTHR) ((v4u*)(WIN + (size_t)INC * DM))[i] = (v4u){0u, 0u, 0u, 0u};
    for (int m = gw; m < TT; m += NGW) rms_row_to_bf16(P.x + (size_t)m * DM, P.norm1_g, XN + (size_t)m * DM, lane);
}

namespace pg8 {
struct EpiF32 {
    static constexpr bool PERM = false, AFTER_DRAIN = false;
    const float* base; float* out; int ldc;
    __device__ __forceinline__ void operator()(const f32x4 (&acc)[2][2][4][2], const Unit& u, int wr, int wc, int fr, int fq) const {
        const int col0 = u.pn * BM + wc * 32 + 4 * fq;
#pragma unroll
        for (int ai = 0; ai < 2; ++ai)
#pragma unroll
            for (int m = 0; m < 4; ++m) { const int r = ai * HALF + wr * 64 + m * 16 + fr; const size_t off = (size_t)(u.pm * BM + r) * ldc + col0;
#pragma unroll
                for (int bj = 0; bj < 2; ++bj)
#pragma unroll
                    for (int n = 0; n < 2; ++n) { f32x4 o = acc[ai][bj][m][n]; if (base) o = o + *(const f32x4*)(base + off + bj * HALF + n * 16);
                        *(f32x4*)(out + off + bj * HALF + n * 16) = o; } }
    }
};
struct EpiH {
    static constexpr bool PERM = false, AFTER_DRAIN = false;
    const float* base; bf16* outb; float* ss; int ldc;
    __device__ __forceinline__ void operator()(const f32x4 (&acc)[2][2][4][2], const Unit& u, int wr, int wc, int fr, int fq) const {
        const int col0 = u.pn * BM + wc * 32 + 4 * fq;
#pragma unroll
        for (int ai = 0; ai < 2; ++ai) {
            f32x4 xv[4][2][2];
#pragma unroll
            for (int m = 0; m < 4; ++m) { const size_t off = (size_t)(u.pm * BM + ai * HALF + wr * 64 + m * 16 + fr) * ldc + col0;
#pragma unroll
                for (int bj = 0; bj < 2; ++bj)
#pragma unroll
                    for (int n = 0; n < 2; ++n) xv[m][bj][n] = *(const f32x4*)(base + off + bj * HALF + n * 16); }
#pragma unroll
            for (int m = 0; m < 4; ++m) { const int r = ai * HALF + wr * 64 + m * 16 + fr; const size_t off = (size_t)(u.pm * BM + r) * ldc + col0; float sq = 0.f;
#pragma unroll
                for (int bj = 0; bj < 2; ++bj)
#pragma unroll
                    for (int n = 0; n < 2; ++n) { const f32x4 o = acc[ai][bj][m][n] + xv[m][bj][n];
                        *(v2u*)(outb + off + bj * HALF + n * 16) = (v2u){pk2(o.x, o.y), pk2(o.z, o.w)};
                        sq += (o.x * o.x + o.y * o.y) + (o.z * o.z + o.w * o.w); }
                sq += __shfl_xor(sq, 16); sq += __shfl_xor(sq, 32);
                if (fq == 0) ss[(size_t)(u.pm * BM + r) * 32 + u.pn * 4 + wc] = sq; }
        }
    }
};
struct EpiBf16Row {
    static constexpr bool PERM = true, AFTER_DRAIN = false;
    bf16_t* O; int ldc; const float* rs;
    __device__ __forceinline__ void operator()(const f32x4 (&acc)[2][2][4][2], const Unit& u, int wr, int wc, int fr, int fq) const {
        const int row0 = u.pm * BM + wr * 64 + fr, col0 = u.pn * BM + wc * 32 + 8 * fq;
        float scv[2][4];
#pragma unroll
        for (int ai = 0; ai < 2; ++ai)
#pragma unroll
            for (int m = 0; m < 4; ++m) scv[ai][m] = rs[row0 + ai * HALF + m * 16];
#pragma unroll
        for (int ai = 0; ai < 2; ++ai)
#pragma unroll
            for (int m = 0; m < 4; ++m) { const int row = row0 + ai * HALF + m * 16; const float sc = scv[ai][m]; bf16_t* rowp = O + (size_t)row * ldc + col0;
#pragma unroll
                for (int bj = 0; bj < 2; ++bj) { const f32x4 v0 = acc[ai][bj][m][0] * sc, v1 = acc[ai][bj][m][1] * sc;
                    u32x4 w; w.x = cvt_pk_bf16(v0[0], v0[1]); w.y = cvt_pk_bf16(v0[2], v0[3]); w.z = cvt_pk_bf16(v1[0], v1[1]); w.w = cvt_pk_bf16(v1[2], v1[3]);
                    *(u32x4*)(rowp + bj * HALF) = w; } }
    }
};
}

__device__ __forceinline__ void phase_rstd(KP P, int vcu, int G) {
    const float* ssp = (const float*)(P.ws + WS_SSP); float* rstd = (float*)(P.ws + WS_SSP + 2 * MiB);
    for (int row = vcu * NTHR + ltid(); row < TT; row += G * NTHR) { const f32x4* sp = (const f32x4*)(ssp + (size_t)row * 32); float a = 0.f;
#pragma unroll
        for (int j = 0; j < 8; ++j) { const f32x4 v = sp[j]; a += (v.x + v.y) + (v.z + v.w); }
        rstd[row] = 1.0f / sqrtf(a * (1.f / DM) + RMS_EPS); }
}
__device__ __forceinline__ void phase_kmean(KP P, LAS unsigned char* lds, int vcu, int G) {
    const int tid = ltid(); const bf16* proj = (const bf16*)(P.ws + WS_PROJ); float* kmean = (float*)(P.ws + WS_KMEAN);
    LAS float* red = (LAS float*)lds;
    for (int item = vcu; item < 32 * 8; item += G) {
        const int bb = item >> 3, cg = item & 7;
        const int c = tid & 127, rq = tid >> 7;
        const bf16* p = proj + (size_t)(bb * 256 + rq * 64) * INCP + C_AK + cg * 128 + c;
        float s = 0.f;
        for (int r = 0; r < 64; ++r) s += bf2f(p[(size_t)r * INCP]);
        red[rq * 128 + c] = s;
        __syncthreads();
        if (tid < 128) kmean[(size_t)bb * 1024 + cg * 128 + tid] = (red[tid] + red[128 + tid] + red[256 + tid] + red[384 + tid]) * (1.f / 256.f);
        __syncthreads();
    }
}

typedef short bf16x8 __attribute__((ext_vector_type(8)));
typedef float f32x16 __attribute__((ext_vector_type(16)));
constexpr int CP = 72;
constexpr int MATB = 64 * CP * 2;
enum { M_AT = 0, M_BT = 1, M_KT = 2, M_RT = 3, M_VT = 4, M_BBT = 5, M_KBT = 6, M_LAK = 7, M_MRB = 8, M_MRK = 9, M_LAB = 10, M_AHT = 0, M_U0T = 1 };
constexpr int L_RHS = 11 * MATB;
constexpr int L_MISC = L_RHS + 32768;
constexpr int L_TB = L_MISC + 9 * 64 * 4;
constexpr int L_A_END = L_TB + 2048;
static_assert(L_A_END <= RING_BYTES, "stage A LDS");
constexpr size_t CHK_ITEM = 6 * 8192;

__device__ __forceinline__ f32x16 mm_tile(const LAS unsigned char* A, int ra, const LAS unsigned char* B, int rb, f32x16 acc, int lane, int k0 = 0, int k1 = 4) {
    const int r = lane & 31, hi = lane >> 5;
    const LAS unsigned char* ap = A + ((ra * 32 + r) * CP + 8 * hi) * 2; const LAS unsigned char* bp = B + ((rb * 32 + r) * CP + 8 * hi) * 2;
#pragma unroll
    for (int kk = 0; kk < 4; ++kk) if (kk >= k0 && kk < k1) {
        const bf16x8 a = *(const LAS bf16x8*)(ap + kk * 32), b = *(const LAS bf16x8*)(bp + kk * 32);
        acc = __builtin_amdgcn_mfma_f32_32x32x16_bf16(a, b, acc, 0, 0, 0); }
    return acc;
}
__device__ __forceinline__ int crow32(int reg, int hi) { return (reg & 3) + 8 * (reg >> 2) + 4 * hi; }

__device__ __forceinline__ void prologue_lora(KP P, int vcu, int G) {
    bf16* w2T = (bf16*)(P.ws + WS_LORA); bf16* a2T = w2T + 1024 * 96; bf16* g2T = a2T + 1024 * 96;
    for (int e = vcu * NTHR + ltid(); e < 448 * 1024; e += G * NTHR) { const int i = e >> 10, n = e & 1023;
        if (i < 96) w2T[n * 96 + i] = (bf16)f2bf(P.w2[e]); else if (i < 192) a2T[n * 96 + (i - 96)] = (bf16)f2bf(P.a2[e - 96 * 1024]); else g2T[n * 256 + (i - 192)] = (bf16)f2bf(P.g2[e - 192 * 1024]); }
}
__device__ __forceinline__ void phase_act(KP P, int vcu, int G) {
    const bf16* proj = (const bf16*)(P.ws + WS_PROJ); unsigned* act = (unsigned*)(P.ws + WS_ACT);
    for (int e = vcu * NTHR + ltid(); e < TT * 224; e += G * NTHR) { const int t = e / 224, cp = e - t * 224, cc = 2 * cp;
        const bf16* pr = proj + (size_t)t * INCP + C_RW + 3072 + cc;
        const unsigned cu = *(const unsigned*)pr; const unsigned pu = (t & (SEQ - 1)) == 0 ? 0u : *(const unsigned*)(pr - INCP);
        const float m0 = P.mu[3072 + cc], m1 = P.mu[3072 + cc + 1];
        float v0 = bflo(cu) + (bflo(pu) - bflo(cu)) * m0, v1 = bfhi(cu) + (bfhi(pu) - bfhi(cu)) * m1;
        if (cc < 96) { v0 = tanhf(v0); v1 = tanhf(v1); } else if (cc >= 192) { v0 = 1.f / (1.f + __expf(-v0)); v1 = 1.f / (1.f + __expf(-v1)); }
        act[e] = pk2(v0, v1); }
}
constexpr int ACTP = 456;
constexpr int L_WAG = 58368;
static_assert(L_WAG + 3 * 16384 <= L_MISC, "lora scratch fits below misc");
struct LoraFrags { bf16x8 f[16]; f32x4 w0[4], a0[4]; float mu_r, mu_k, mu_v, kkc, kac, rkc, lng, lnb; };
__device__ __forceinline__ LoraFrags lora_frags_load(KP P, int h, int wave, int lane) {
    const int c32 = lane & 31, hi = lane >> 5, nb = (wave & 3) >> 1; const int nrow = h * 64 + nb * 32 + c32;
    const bf16* w2T = (const bf16*)(P.ws + WS_LORA); const bf16* a2T = w2T + 1024 * 96; const bf16* g2T = a2T + 1024 * 96;
    const bf16* wp = w2T + (size_t)nrow * 96 + 8 * hi; const bf16* ap = a2T + (size_t)nrow * 96 + 8 * hi; const bf16* gp = g2T + (size_t)nrow * 256 + 8 * hi;
    LoraFrags W;
#pragma unroll
    for (int kk = 0; kk < 16; ++kk) { const bf16* src = wave < 4 ? (kk < 6 ? wp + 16 * kk : ap + 16 * ((kk - 6) % 6)) : gp + 16 * kk; W.f[kk] = *(const bf16x8*)src; }
#pragma unroll
    for (int g = 0; g < 4; ++g) { const int n0 = h * 64 + nb * 32 + 8 * g + 4 * hi; W.w0[g] = *(const f32x4*)(P.w0 + n0); W.a0[g] = *(const f32x4*)(P.a0 + n0); }
    const int col = h * 64 + lane;
    W.mu_r = P.mu[col]; W.mu_k = P.mu[1024 + col]; W.mu_v = P.mu[2048 + col]; W.kkc = P.k_k[col]; W.kac = P.k_a[col]; W.rkc = P.r_k[col]; W.lng = P.ln_g[col]; W.lnb = P.ln_b[col];
    return W;
}
__device__ __forceinline__ void rwkv_stage_a(KP P, LAS unsigned char* lds, int item, const LoraFrags& W) {
    const int tid = ltid(), lane = tid & 63, wave = __builtin_amdgcn_readfirstlane(tid >> 6);
    const int b = item >> 10, h = (item >> 6) & 15, c = item & 63;
    const int tok0 = b * SEQ + c * 64;
    const bf16* proj = (const bf16*)(P.ws + WS_PROJ);
    unsigned char* chk = P.ws + WS_CHK + (size_t)((item & 63) * 32 + (item >> 6)) * CHK_ITEM;
    LAS float* misc = (LAS float*)(lds + L_MISC);
    { const bf16* actg = (const bf16*)(P.ws + WS_ACT) + (size_t)tok0 * 448;
#pragma unroll
      for (int e = tid; e < 64 * 56; e += NTHR) { const int row = e / 56, ch = e - row * 56; *(LAS v4u*)(lds + (row * ACTP + ch * 8) * 2) = *(const v4u*)(actg + (size_t)row * 448 + ch * 8); } }
    __syncthreads();
    {
        const int c32 = lane & 31, hi = lane >> 5, qd = wave & 3, nb = qd >> 1, tb = qd & 1;
        const LAS unsigned char* actp = lds + ((tb * 32 + c32) * ACTP + 8 * hi) * 2;
        LAS float* wag = (LAS float*)(lds + L_WAG) + (tb * 32 + c32) * 64 + nb * 32;
        if (wave < 4) {
            f32x16 aw = {}, aa = {};
#pragma unroll
            for (int kk = 0; kk < 6; ++kk) {
                aw = __builtin_amdgcn_mfma_f32_32x32x16_bf16(W.f[kk], *(const LAS bf16x8*)(actp + (16 * kk) * 2), aw, 0, 0, 0);
                aa = __builtin_amdgcn_mfma_f32_32x32x16_bf16(W.f[6 + kk], *(const LAS bf16x8*)(actp + (96 + 16 * kk) * 2), aa, 0, 0, 0); }
#pragma unroll
            for (int g = 0; g < 4; ++g) { const int n0 = h * 64 + nb * 32 + 8 * g + 4 * hi;
                const f32x4 w0 = W.w0[g], a0 = W.a0[g]; f32x4 ow, oa;
#pragma unroll
                for (int e = 0; e < 4; ++e) { const float xx = w0[e] + aw[4 * g + e];
                    ow[e] = __expf(-0.6065306597126334f * __builtin_amdgcn_rcpf(1.f + __expf(-xx))); oa[e] = __builtin_amdgcn_rcpf(1.f + __expf(-(a0[e] + aa[4 * g + e]))); }
                *(LAS f32x4*)(wag + 8 * g + 4 * hi) = ow; *(LAS f32x4*)(wag + 4096 + 8 * g + 4 * hi) = oa; }
        } else {
            f32x16 ag = {};
#pragma unroll
            for (int kk = 0; kk < 16; ++kk) ag = __builtin_amdgcn_mfma_f32_32x32x16_bf16(W.f[kk], *(const LAS bf16x8*)(actp + (192 + 16 * kk) * 2), ag, 0, 0, 0);
#pragma unroll
            for (int g = 0; g < 4; ++g) *(LAS f32x4*)(wag + 8192 + 8 * g + 4 * hi) = (f32x4){ag[4 * g], ag[4 * g + 1], ag[4 * g + 2], ag[4 * g + 3]};
        }
    }
    __syncthreads();
    {
        const int n = lane, tg = wave, col = h * 64 + n;
        const float mu_r = W.mu_r, mu_k = W.mu_k, mu_v = W.mu_v, kkc = W.kkc, kac = W.kac, rkc = W.rkc, lng = W.lng, lnb = W.lnb;
        float rr[8], kr[8], vv[8], ww[8], aa[8], gg[8], kk[8];
        const int tfirst = tok0 + 8 * tg;
        const bf16* pp = proj + (size_t)tfirst * INCP + C_RW + col;
        float pr, pk, pvv;
        if (c == 0 && tg == 0) { pr = 0.f; pk = 0.f; pvv = 0.f; } else { pr = bf2f(pp[-(long)INCP]); pk = bf2f(pp[-(long)INCP + 1024]); pvv = bf2f(pp[-(long)INCP + 2048]); }
        const LAS float* wagr = (const LAS float*)(lds + L_WAG) + (8 * tg) * 64 + n;
#pragma unroll
        for (int q = 0; q < 8; ++q) { const float cr = bf2f(pp[(size_t)q * INCP]), ck = bf2f(pp[(size_t)q * INCP + 1024]), cv = bf2f(pp[(size_t)q * INCP + 2048]);
            rr[q] = cr + (pr - cr) * mu_r; kr[q] = ck + (pk - ck) * mu_k; vv[q] = cv + (pvv - cv) * mu_v; pr = cr; pk = ck; pvv = cv;
            ww[q] = wagr[q * 64]; aa[q] = wagr[4096 + q * 64]; gg[q] = wagr[8192 + q * 64]; }
        float lam[8]; float run = 1.f;
#pragma unroll
        for (int q = 0; q < 8; ++q) { run *= ww[q]; lam[q] = run; }
        misc[tg * 64 + n] = run;
#pragma unroll
        for (int q = 0; q < 8; ++q) { const float kkv = kr[q] * kkc; const float ss = wave_sum(kkv * kkv); kk[q] = kkv * __builtin_amdgcn_rsqf(fmaxf(ss, 1e-24f));
            kr[q] = kr[q] * (1.f + (aa[q] - 1.f) * kac); }
        __syncthreads();
        float pre = 1.f, tot = 1.f;
#pragma unroll
        for (int g = 0; g < 8; ++g) { const float sgt = misc[g * 64 + n]; if (g < tg) pre *= sgt; tot *= sgt; }
        if (tg == 0) misc[512 + n] = tot;
        unsigned vt[4], bbt[4], kbt[4];
        LAS bf16* At = (LAS bf16*)(lds + M_AT * MATB); LAS bf16* Bt = (LAS bf16*)(lds + M_BT * MATB); LAS bf16* Kt = (LAS bf16*)(lds + M_KT * MATB); LAS bf16* Rt = (LAS bf16*)(lds + M_RT * MATB);
        float hbb = 0.f, hkb = 0.f, hv = 0.f;
#pragma unroll
        for (int q = 0; q < 8; ++q) { const int t = 8 * tg + q;
            const float L = pre * lam[q], Lp = q == 0 ? pre : pre * lam[q - 1], iL = __builtin_amdgcn_rcpf(L), rel = tot * iL;
            const float bq = kk[q] * aa[q];
            ((LAS float*)(lds + L_RHS))[t * 128 + 64 + n] = -kk[q] * Lp;
            At[t * CP + n] = (bf16)f2bf(-kk[q] * Lp); Bt[t * CP + n] = (bf16)f2bf(bq * iL); Kt[t * CP + n] = (bf16)f2bf(kr[q] * iL); Rt[t * CP + n] = (bf16)f2bf(rr[q] * L);
            const float bb = bq * rel, kb = kr[q] * rel;
            if (q & 1) { vt[q >> 1] = pk2(hv, vv[q]); bbt[q >> 1] = pk2(hbb, bb); kbt[q >> 1] = pk2(hkb, kb); } else { hv = vv[q]; hbb = bb; hkb = kb; }
            const float bs = wave_sum(rr[q] * kr[q] * rkc);
            const int pl = t * 64 + ((n >> 2) & 3) * 16 + (n >> 4) * 4 + (n & 3);
            ((bf16*)(chk + 4 * 8192))[pl] = (bf16)f2bf(lng * gg[q]);
            ((bf16*)(chk + 5 * 8192))[pl] = (bf16)f2bf((lnb + bs * vv[q]) * gg[q]); }
        *(LAS v4u*)(lds + M_VT * MATB + (n * CP + 8 * tg) * 2) = (v4u){vt[0], vt[1], vt[2], vt[3]};
        *(LAS v4u*)(lds + M_BBT * MATB + (n * CP + 8 * tg) * 2) = (v4u){bbt[0], bbt[1], bbt[2], bbt[3]};
        *(LAS v4u*)(lds + M_KBT * MATB + (n * CP + 8 * tg) * 2) = (v4u){kbt[0], kbt[1], kbt[2], kbt[3]};
    }
    __syncthreads();
    const int c32 = lane & 31, hi = lane >> 5;
    {
        const int prod = wave >> 1;
#pragma unroll
        for (int qi = 0; qi < 2; ++qi) {
            const int tb = (wave & 1) ? (qi == 0 ? 1 : 0) : qi, sb = (wave & 1) ? 1 : 0; const bool zero = (tb == 0 && sb == 1);
            f32x16 acc = {};
            const int xa = (prod == 0 || prod == 2) ? M_BT : M_KT, ya = prod < 2 ? M_AT : M_RT, dm = prod == 0 ? M_LAB : (prod == 1 ? M_LAK : (prod == 2 ? M_MRB : M_MRK));
            if (!zero) acc = mm_tile(lds + xa * MATB, sb, lds + ya * MATB, tb, acc, lane);
            const int t = tb * 32 + c32; LAS unsigned char* dst = lds + dm * MATB + (t * CP + sb * 32) * 2;
#pragma unroll
            for (int g = 0; g < 4; ++g) { float o[4];
#pragma unroll
                for (int e = 0; e < 4; ++e) { const int s = sb * 32 + 8 * g + 4 * hi + e; const bool keep = prod < 2 ? (s < t) : (s <= t); o[e] = keep ? acc[4 * g + e] : 0.f; }
                *(LAS v2u*)(dst + (8 * g + 4 * hi) * 2) = (v2u){pk2(o[0], o[1]), pk2(o[2], o[3])}; }
        }
    }
    __syncthreads();
    if (wave < 4) {
        const int ib = wave >> 1, tb = wave & 1; f32x16 acc = {};
        acc = mm_tile(lds + M_VT * MATB, ib, lds + M_LAK * MATB, tb, acc, lane, 0, tb == 0 ? 2 : 4);
        const int t = tb * 32 + c32; LAS float* dst = (LAS float*)(lds + L_RHS) + t * 128 + ib * 32;
#pragma unroll
        for (int g = 0; g < 4; ++g) *(LAS f32x4*)(dst + 8 * g + 4 * hi) = (f32x4){acc[4 * g], acc[4 * g + 1], acc[4 * g + 2], acc[4 * g + 3]};
    } else if (wave == 4) {
        const int bb = lane >> 4, col = lane & 15;
        float x[16];
#pragma unroll
        for (int t = 0; t < 16; ++t) x[t] = t == col ? 1.f : 0.f;
#pragma unroll
        for (int t = 1; t < 16; ++t) { const LAS unsigned char* rp = lds + M_LAB * MATB + ((16 * bb + t) * CP + 16 * bb) * 2; const v4u ra = *(const LAS v4u*)rp, rb = *(const LAS v4u*)(rp + 16);
            float lrow[16];
#pragma unroll
            for (int q = 0; q < 4; ++q) { lrow[2 * q] = bflo(ra[q]); lrow[2 * q + 1] = bfhi(ra[q]); lrow[8 + 2 * q] = bflo(rb[q]); lrow[8 + 2 * q + 1] = bfhi(rb[q]); }
#pragma unroll
            for (int s = 0; s < t; ++s) x[t] += lrow[s] * x[s]; }
        LAS bf16* T = (LAS bf16*)(lds + L_TB) + bb * 256 + col;
#pragma unroll
        for (int t = 0; t < 16; ++t) T[t * 16] = (bf16)f2bf(x[t]);
    }
    __syncthreads();
    {
        typedef short s16x4 __attribute__((ext_vector_type(4)));
        const int l15 = lane & 15, q4 = lane >> 4;
        LAS unsigned char* xt = lds + (wave < 4 ? M_U0T : M_AHT) * MATB + ((16 * (wave & 3) + l15) * CP) * 2;
        *(LAS v4u*)(xt + q4 * 32) = (v4u){0u, 0u, 0u, 0u}; *(LAS v4u*)(xt + q4 * 32 + 16) = (v4u){0u, 0u, 0u, 0u};
        const LAS float* Xf = (const LAS float*)(lds + L_RHS) + 16 * wave + l15;
#pragma unroll
        for (int bq = 0; bq < 4; ++bq) {
            f32x4 acc;
#pragma unroll
            for (int e = 0; e < 4; ++e) acc[e] = Xf[(16 * bq + 4 * q4 + e) * 128];
#pragma unroll
            for (int kk = 0; kk < (bq + 1) / 2; ++kk) {
                const bf16x8 a = *(const LAS bf16x8*)(lds + M_LAB * MATB + ((16 * bq + l15) * CP + 32 * kk + 8 * q4) * 2);
                const bf16x8 xb = *(const LAS bf16x8*)(xt + (32 * kk + 8 * q4) * 2);
                acc = __builtin_amdgcn_mfma_f32_16x16x32_bf16(a, xb, acc, 0, 0, 0); }
            const v2u tf = *(const LAS v2u*)(lds + L_TB + (bq * 256 + l15 * 16 + 4 * q4) * 2);
            const v2u ab = (v2u){pk2(acc[0], acc[1]), pk2(acc[2], acc[3])};
            const f32x4 z = {0.f, 0.f, 0.f, 0.f};
            const f32x4 xn = __builtin_amdgcn_mfma_f32_16x16x16bf16_1k(__builtin_bit_cast(s16x4, tf), __builtin_bit_cast(s16x4, ab), z, 0, 0, 0);
            *(LAS v2u*)(xt + (16 * bq + 4 * q4) * 2) = (v2u){pk2(xn[0], xn[1]), pk2(xn[2], xn[3])};
        }
    }
    __syncthreads();
    {
        const int qd = wave & 3, yb = qd >> 1, xb = qd & 1;
        f32x16 acc1 = {}, acc2 = {};
        if (wave < 4) {
            acc1 = mm_tile(lds + M_AHT * MATB, yb, lds + M_BBT * MATB, xb, acc1, lane);
            acc2 = mm_tile(lds + M_BBT * MATB, yb, lds + M_U0T * MATB, xb, acc2, lane);
            acc2 = mm_tile(lds + M_KBT * MATB, yb, lds + M_VT * MATB, xb, acc2, lane);
            const int x = xb * 32 + c32; const float lc = misc[512 + x];
            bf16* o1 = (bf16*)(chk + 0 * 8192) + x * 64 + yb * 32; bf16* o2 = (bf16*)(chk + 1 * 8192) + x * 64 + yb * 32;
#pragma unroll
            for (int g = 0; g < 4; ++g) { float p[4];
#pragma unroll
                for (int e = 0; e < 4; ++e) { const int y = yb * 32 + 8 * g + 4 * hi + e; p[e] = acc1[4 * g + e] + (y == x ? lc : 0.f); }
                *(v2u*)(o1 + 8 * g + 4 * hi) = (v2u){pk2(p[0], p[1]), pk2(p[2], p[3])};
                *(v2u*)(o2 + 8 * g + 4 * hi) = (v2u){pk2(acc2[4 * g], acc2[4 * g + 1]), pk2(acc2[4 * g + 2], acc2[4 * g + 3])}; }
        } else {
            acc1 = mm_tile(lds + M_AHT * MATB, yb, lds + M_MRB * MATB, xb, acc1, lane);
            acc2 = mm_tile(lds + M_U0T * MATB, yb, lds + M_MRB * MATB, xb, acc2, lane);
            acc2 = mm_tile(lds + M_VT * MATB, yb, lds + M_MRK * MATB, xb, acc2, lane);
            const int x = xb * 32 + c32;
            bf16* o1 = (bf16*)(chk + 2 * 8192) + x * 64 + yb * 32; bf16* o2 = (bf16*)(chk + 3 * 8192) + x * 64;
            const LAS bf16* Rt = (const LAS bf16*)(lds + M_RT * MATB) + x * CP + yb * 32;
#pragma unroll
            for (int g = 0; g < 4; ++g) { float p[4];
#pragma unroll
                for (int e = 0; e < 4; ++e) p[e] = acc1[4 * g + e] + bf2f(Rt[8 * g + 4 * hi + e]);
                *(v2u*)(o1 + 8 * g + 4 * hi) = (v2u){pk2(p[0], p[1]), pk2(p[2], p[3])};
                *(v2u*)(o2 + ((2 * g + hi) & 3) * 16 + (2 * yb + (g >> 1)) * 4) = (v2u){pk2(acc2[4 * g], acc2[4 * g + 1]), pk2(acc2[4 * g + 2], acc2[4 * g + 3])}; }
        }
    }
    __syncthreads();
}

__device__ __forceinline__ void phase_rwkv_stage_a(KP P, LAS unsigned char* lds, int vcu, int G) {
    const int tid = ltid(), lane = tid & 63, wave = __builtin_amdgcn_readfirstlane(tid >> 6);
    int cur_bh = (vcu & 255) >> 3; LoraFrags W = lora_frags_load(P, cur_bh & 15, wave, lane);
    for (int k = vcu; k < 2048; k += G) { const int bh = (k & 255) >> 3, c = (k & 7) + 8 * (k >> 8);
        if (bh != cur_bh) { W = lora_frags_load(P, bh & 15, wave, lane); cur_bh = bh; }
        rwkv_stage_a(P, lds, bh * 64 + c, W); }
}
typedef float f32x4v __attribute__((ext_vector_type(4)));
struct YSet { bf16x8 b0, b1; v4u y0[2], g1[2], g2[2]; };
struct SSet { bf16x8 p0[1], p1[1]; v2u q[4]; };
__device__ __forceinline__ void rwkv_stage_b(KP P, LAS unsigned char* lds, int bh) {
    const int tid = ltid(), lane = tid & 63, wave = __builtin_amdgcn_readfirstlane(tid >> 6);
    const int b = bh >> 4, h = bh & 15; const int l15 = lane & 15, q4 = lane >> 4;
    bf16* AR = (bf16*)(P.ws + WS_AR);
    for (int u = tid; u < 2 * MATB / 4; u += NTHR) ((LAS unsigned*)lds)[u] = 0u;
    __syncthreads();
    const int w4 = wave & 3;
    const unsigned char* chk0 = P.ws + WS_CHK + (size_t)bh * CHK_ITEM;
    if (wave < 4) {
        const int t = 16 * w4 + l15;
        YSet ys[4];
#define YLOAD(S_, c_) do { const unsigned char* chk = chk0 + (size_t)(c_) * (32 * CHK_ITEM); const bf16* rh = (const bf16*)(chk + 2 * 8192) + t * 64 + 8 * q4; S_.b0 = *(const bf16x8*)rh; S_.b1 = *(const bf16x8*)(rh + 32); \
        const bf16* y0 = (const bf16*)(chk + 3 * 8192) + t * 64 + 16 * q4; \
        S_.y0[0] = *(const v4u*)y0; S_.y0[1] = *(const v4u*)(y0 + 8); S_.g1[0] = *(const v4u*)(y0 + 4096); S_.g1[1] = *(const v4u*)(y0 + 4096 + 8); S_.g2[0] = *(const v4u*)(y0 + 8192); S_.g2[1] = *(const v4u*)(y0 + 8192 + 8); } while (0)
#define YV(A_, it_, w_) ((A_)[(it_) >> 1][2 * ((it_) & 1) + (w_)])
#pragma unroll
        for (int u = 0; u < 4; ++u) YLOAD(ys[u], u);
        for (int c0 = 0; c0 < 64; c0 += 4) {
#pragma unroll
            for (int u = 0; u < 4; ++u) { const int c = c0 + u;
                const LAS unsigned char* Scur = lds + (c & 1) * MATB;
                f32x4v acc[4];
#pragma unroll
                for (int it = 0; it < 4; ++it) { acc[it] = (f32x4v){bflo(YV(ys[u].y0, it, 0)), bfhi(YV(ys[u].y0, it, 0)), bflo(YV(ys[u].y0, it, 1)), bfhi(YV(ys[u].y0, it, 1))};
                    const LAS unsigned char* sp = Scur + ((16 * it + l15) * CP + 8 * q4) * 2;
                    acc[it] = __builtin_amdgcn_mfma_f32_16x16x32_bf16(*(const LAS bf16x8*)sp, ys[u].b0, acc[it], 0, 0, 0);
                    acc[it] = __builtin_amdgcn_mfma_f32_16x16x32_bf16(*(const LAS bf16x8*)(sp + 64), ys[u].b1, acc[it], 0, 0, 0); }
                float s = 0.f;
#pragma unroll
                for (int it = 0; it < 4; ++it) s += (acc[it].x + acc[it].y) + (acc[it].z + acc[it].w);
                s += __shfl_xor(s, 16); s += __shfl_xor(s, 32);
                const float mean = s * (1.f / 64.f); float v = 0.f;
#pragma unroll
                for (int it = 0; it < 4; ++it) { acc[it] = acc[it] - mean; v += (acc[it].x * acc[it].x + acc[it].y * acc[it].y) + (acc[it].z * acc[it].z + acc[it].w * acc[it].w); }
                v += __shfl_xor(v, 16); v += __shfl_xor(v, 32);
                const float rstd = 1.0f / sqrtf(v * (1.f / 64.f) + 64e-5f);
                bf16* orow = AR + (size_t)(b * SEQ + c * 64 + t) * DM + 1024 + h * 64 + 4 * q4;
#pragma unroll
                for (int it = 0; it < 4; ++it) {
                    const float o0 = acc[it].x * rstd * bflo(YV(ys[u].g1, it, 0)) + bflo(YV(ys[u].g2, it, 0)), o1 = acc[it].y * rstd * bfhi(YV(ys[u].g1, it, 0)) + bfhi(YV(ys[u].g2, it, 0));
                    const float o2 = acc[it].z * rstd * bflo(YV(ys[u].g1, it, 1)) + bflo(YV(ys[u].g2, it, 1)), o3 = acc[it].w * rstd * bfhi(YV(ys[u].g1, it, 1)) + bfhi(YV(ys[u].g2, it, 1));
                    *(v2u*)(orow + 16 * it) = (v2u){pk2(o0, o1), pk2(o2, o3)}; }
                if (c + 4 < 64) YLOAD(ys[u], c + 4);
                __syncthreads();
            }
        }
#undef YLOAD
#undef YV
    } else {
        const int nrow = 16 * w4 + l15;
        SSet ss[4];
#define SLOADX(S_, c_) do { const unsigned char* chk = chk0 + (size_t)(c_) * (32 * CHK_ITEM); const bf16* pt = (const bf16*)chk + nrow * 64 + 8 * q4; S_.p0[0] = *(const bf16x8*)pt; S_.p1[0] = *(const bf16x8*)(pt + 32); \
        const bf16* q = (const bf16*)(chk + 1 * 8192) + l15 * 64 + 16 * w4 + 4 * q4; \
        _Pragma("unroll") for (int it = 0; it < 4; ++it) S_.q[it] = *(const v2u*)(q + 16 * it * 64); } while (0)
#pragma unroll
        for (int u = 0; u < 4; ++u) SLOADX(ss[u], u);
        for (int c0 = 0; c0 < 64; c0 += 4) {
#pragma unroll
            for (int u = 0; u < 4; ++u) { const int c = c0 + u;
                const LAS unsigned char* Scur = lds + (c & 1) * MATB; LAS unsigned char* Snxt = lds + ((c & 1) ^ 1) * MATB;
#pragma unroll
                for (int it = 0; it < 4; ++it) { const int i = 16 * it + l15;
                    const LAS unsigned char* sp = Scur + (i * CP + 8 * q4) * 2; const bf16x8 s0 = *(const LAS bf16x8*)sp, s1 = *(const LAS bf16x8*)(sp + 64);
                    f32x4v acc = (f32x4v){bflo(ss[u].q[it].x), bfhi(ss[u].q[it].x), bflo(ss[u].q[it].y), bfhi(ss[u].q[it].y)};
                    acc = __builtin_amdgcn_mfma_f32_16x16x32_bf16(ss[u].p0[0], s0, acc, 0, 0, 0);
                    acc = __builtin_amdgcn_mfma_f32_16x16x32_bf16(ss[u].p1[0], s1, acc, 0, 0, 0);
                    *(LAS v2u*)(Snxt + (i * CP + 16 * w4 + 4 * q4) * 2) = (v2u){pk2(acc.x, acc.y), pk2(acc.z, acc.w)}; }
                if (c + 4 < 64) SLOADX(ss[u], c + 4);
                __syncthreads();
            }
        }
#undef SLOADX
    }
}

constexpr size_t WS_UB = WS_RWA;
constexpr size_t WS_VB = WS_RWA + 32 * MiB;
constexpr float U_SCALE = 512.f, V_SCALE = 32.f;
constexpr int SLICE_BYTES = 16384 * 128;
typedef float f32x2 __attribute__((ext_vector_type(2)));
__device__ __forceinline__ void convert_group(KP P, int i) {
    constexpr int N16 = 16384 * 2048 / 16;
    const bool isv = i >= N16; const int j = isv ? i - N16 : i; const int e = j >> 7, q = j & 127;
    const float* s = (isv ? P.pv : P.pu) + (size_t)j * 16; const float sc = isv ? V_SCALE : U_SCALE;
    v4u o;
#pragma unroll
    for (int k = 0; k < 4; ++k) { f32x4 a = *(const f32x4*)(s + 4 * k); if (!isv) a = a * *(const f32x4*)(P.norm2_g + 16 * q + 4 * k); int p = 0;
        p = __builtin_amdgcn_cvt_pk_fp8_f32(a.x * sc, a.y * sc, p, false); p = __builtin_amdgcn_cvt_pk_fp8_f32(a.z * sc, a.w * sc, p, true); o[k] = (unsigned)p; }
    *(v4u*)(P.ws + (isv ? WS_VB : WS_UB) + (size_t)(q >> 3) * SLICE_BYTES + (size_t)e * 128 + (q & 7) * 16) = o;
}
__device__ __forceinline__ void phase_convert_tables(KP P, LAS unsigned char* lds) {
    const int tid = ltid(); constexpr int N16 = 16384 * 2048 / 16, CH = 4 * NTHR, NCH = 2 * N16 / CH;
    unsigned* ctr = (unsigned*)(P.ws + WS_CTL) + CW_MOBA_CTR; LAS int* slot = (LAS int*)lds;
    for (;;) {
        __syncthreads();
        if (tid == 0) slot[0] = (int)__hip_atomic_fetch_add(ctr, 1u, __ATOMIC_RELAXED, __HIP_MEMORY_SCOPE_AGENT);
        __syncthreads();
        const int c = slot[0]; if (c >= NCH) break;
#pragma unroll
        for (int k = 0; k < 4; ++k) convert_group(P, c * CH + k * NTHR + tid);
    }
}
__device__ __forceinline__ f32x2 dot16p(const v4u u, const f32x2* x, f32x2 acc) {
#pragma unroll
    for (int q = 0; q < 4; ++q) { const f32x2 lo = __builtin_amdgcn_cvt_pk_f32_fp8((int)u[q], false), hi = __builtin_amdgcn_cvt_pk_f32_fp8((int)u[q], true);
        acc = __builtin_elementwise_fma(lo, x[2 * q], acc); acc = __builtin_elementwise_fma(hi, x[2 * q + 1], acc); }
    return acc;
}
__device__ __forceinline__ void axpy16p(const v4u v, f32x2 s, f32x2* y) {
#pragma unroll
    for (int q = 0; q < 4; ++q) { const f32x2 lo = __builtin_amdgcn_cvt_pk_f32_fp8((int)v[q], false), hi = __builtin_amdgcn_cvt_pk_f32_fp8((int)v[q], true);
        y[2 * q] = __builtin_elementwise_fma(s, lo, y[2 * q]); y[2 * q + 1] = __builtin_elementwise_fma(s, hi, y[2 * q + 1]); }
}
__device__ __forceinline__ float xsum_g8(float v) {
    v += DPP_F(v, 0x128);
    { auto r = __builtin_amdgcn_permlane16_swap(__float_as_uint(v), __float_as_uint(v), false, false); v = __uint_as_float(r[0]) + __uint_as_float(r[1]); }
    { auto r = __builtin_amdgcn_permlane32_swap(__float_as_uint(v), __float_as_uint(v), false, false); v = __uint_as_float(r[0]) + __uint_as_float(r[1]); }
    return v;
}
__device__ __forceinline__ void phase_peer_sliced(KP P, LAS unsigned char* lds, int bx, int G) {
    const int grp = bx & 7;
    const unsigned char* UB = P.ws + WS_UB; const unsigned char* VB = P.ws + WS_VB; const bf16* HB = (const bf16*)(P.ws + WS_XN);
    const int* ridx = (const int*)(P.ws + WS_PROJ + 64 * MiB); const float* rgate = (const float*)(P.ws + WS_PROJ + 68 * MiB); const float* RSTD = (const float*)(P.ws + WS_SSP + 2 * MiB);
    for (int bt = bx; bt < TT / 32; bt += G) {
        const int tid = ltid(), lane = tid & 63, wave = __builtin_amdgcn_readfirstlane(tid >> 6), g8 = lane >> 3, p = lane & 7;
        LAS int* idxT = (LAS int*)(lds + wave * 4096); LAS float* gT = (LAS float*)(lds + wave * 4096 + 2048);
        LAS bf16* h2T = (LAS bf16*)(lds + 32768 + wave * 16384);
        const int t0 = 32 * bt + 4 * wave;
#pragma unroll
        for (int i = 0; i < 4; ++i) { const size_t o = (size_t)(t0 + i) * 128; const int wofs = (i * 8 + (lane & 7)) * 16 + (lane >> 3);
            idxT[wofs] = ridx[o + lane]; idxT[wofs + 8] = ridx[o + 64 + lane]; gT[wofs] = rgate[o + lane]; gT[wofs + 8] = rgate[o + 64 + lane]; }
        float hacc[4][2];
#pragma unroll
        for (int i = 0; i < 4; ++i) { hacc[i][0] = 0.f; hacc[i][1] = 0.f; }
        {
            v4u rA[8], rB[8]; f32x2 xA[8], xB[8];
#define PS_SG(s_) (((s_) + 2 * grp) & 15)
#define PS_ISSUE(R, tabbase, s_, i_, hb_) do { const unsigned char* tb_ = (tabbase) + (size_t)PS_SG(s_) * SLICE_BYTES;        \
            const v4u ia_ = *(const LAS v4u*)(idxT + ((i_) * 8 + g8) * 16 + 8 * (hb_)), ib_ = *(const LAS v4u*)(idxT + ((i_) * 8 + g8) * 16 + 8 * (hb_) + 4); const unsigned po_ = 16u * (unsigned)p; \
            R[0] = *(const v4u*)(tb_ + (ia_[0] * 128u + po_)); R[1] = *(const v4u*)(tb_ + (ia_[1] * 128u + po_)); R[2] = *(const v4u*)(tb_ + (ia_[2] * 128u + po_)); R[3] = *(const v4u*)(tb_ + (ia_[3] * 128u + po_)); \
            R[4] = *(const v4u*)(tb_ + (ib_[0] * 128u + po_)); R[5] = *(const v4u*)(tb_ + (ib_[1] * 128u + po_)); R[6] = *(const v4u*)(tb_ + (ib_[2] * 128u + po_)); R[7] = *(const v4u*)(tb_ + (ib_[3] * 128u + po_)); } while (0)
#define PS_LOADX(X, s_, i_) do { const bf16* xp_ = HB + (size_t)(t0 + (i_)) * DM + 128 * PS_SG(s_) + 16 * p; const v4u xa_ = *(const v4u*)xp_, xb_ = *(const v4u*)(xp_ + 8); \
            _Pragma("unroll") for (int q = 0; q < 4; ++q) { X[q] = (f32x2){bflo(xa_[q]), bfhi(xa_[q])}; X[4 + q] = (f32x2){bflo(xb_[q]), bfhi(xb_[q])}; } } while (0)
#define PS_DOTS(R, X, i_, hb_) do { _Pragma("unroll") for (int m = 0; m < 8; ++m) { const f32x2 a2_ = dot16p(R[m], X, (f32x2){0.f, 0.f}); float sd_ = a2_.x + a2_.y; \
            sd_ += DPP_F(sd_, 0xB1); sd_ += DPP_F(sd_, 0x4E); sd_ += DPP_F(sd_, 0x141); if (p == m) hacc[i_][hb_] += sd_; } asm volatile("" ::: "memory"); } while (0)
            PS_LOADX(xA, 0, 0); PS_ISSUE(rA, UB, 0, 0, 0);
            for (int s = 0; s < 16; ++s) {
                PS_ISSUE(rB, UB, s, 0, 1); PS_LOADX(xB, s, 1);  PS_DOTS(rA, xA, 0, 0);
                PS_ISSUE(rA, UB, s, 1, 0);                       PS_DOTS(rB, xA, 0, 1);
                PS_ISSUE(rB, UB, s, 1, 1); PS_LOADX(xA, s, 2);  PS_DOTS(rA, xB, 1, 0);
                PS_ISSUE(rA, UB, s, 2, 0);                       PS_DOTS(rB, xB, 1, 1);
                PS_ISSUE(rB, UB, s, 2, 1); PS_LOADX(xB, s, 3);  PS_DOTS(rA, xA, 2, 0);
                PS_ISSUE(rA, UB, s, 3, 0);                       PS_DOTS(rB, xA, 2, 1);
                PS_ISSUE(rB, UB, s, 3, 1); if (s + 1 < 16) PS_LOADX(xA, s + 1, 0);  PS_DOTS(rA, xB, 3, 0);
                if (s + 1 < 16) PS_ISSUE(rA, UB, s + 1, 0, 0);  PS_DOTS(rB, xB, 3, 1);
            }
#undef PS_LOADX
#undef PS_DOTS
        }
#pragma unroll
        for (int i = 0; i < 4; ++i) { const float rsn = RSTD[t0 + i] * (1.f / U_SCALE);
#pragma unroll
            for (int hb = 0; hb < 2; ++hb) { const float hp = hacc[i][hb] * rsn; LAS float* gp = gT + (i * 8 + g8) * 16 + 8 * hb + p;
                *gp = 0.5f * hp * (1.f + erff(hp * 0.70710678118654752f)) * (1.f / V_SCALE) * *gp; } }
        float ssq[4] = {0.f, 0.f, 0.f, 0.f};
        {
            v4u rA[8], rB[8]; f32x2 y2[8];
#define PS_AXPY(R, i_, hb_) do { const f32x4 aa_ = *(const LAS f32x4*)(gT + ((i_) * 8 + g8) * 16 + 8 * (hb_)), ab_ = *(const LAS f32x4*)(gT + ((i_) * 8 + g8) * 16 + 8 * (hb_) + 4); \
            if ((hb_) == 0) { _Pragma("unroll") for (int q = 0; q < 8; ++q) y2[q] = (f32x2){0.f, 0.f}; } \
            _Pragma("unroll") for (int m = 0; m < 8; ++m) { const float av_ = m < 4 ? aa_[m & 3] : ab_[m & 3]; axpy16p(R[m], (f32x2){av_, av_}, y2); } asm volatile("" ::: "memory"); } while (0)
#define PS_FIN(s_, i_) do { f32x2 ysel_ = {0.f, 0.f}; _Pragma("unroll") for (int q = 0; q < 8; ++q) { const float a_ = xsum_g8(y2[q].x), b_ = xsum_g8(y2[q].y); if (g8 == q) ysel_ = (f32x2){a_, b_}; } \
            const int d_ = 128 * PS_SG(s_) + 16 * p + 2 * g8; const unsigned hb_ = *(const unsigned*)(HB + (size_t)(t0 + (i_)) * DM + d_); const f32x2 hv_ = (f32x2){bflo(hb_), bfhi(hb_)} + ysel_; \
            *(LAS unsigned*)(h2T + (i_) * DM + d_) = pk2(hv_.x, hv_.y); ssq[i_] += hv_.x * hv_.x + hv_.y * hv_.y; } while (0)
            PS_ISSUE(rA, VB, 0, 0, 0);
            for (int s = 0; s < 16; ++s) {
                PS_ISSUE(rB, VB, s, 0, 1); PS_AXPY(rA, 0, 0);
                PS_ISSUE(rA, VB, s, 1, 0); PS_AXPY(rB, 0, 1); PS_FIN(s, 0);
                PS_ISSUE(rB, VB, s, 1, 1); PS_AXPY(rA, 1, 0);
                PS_ISSUE(rA, VB, s, 2, 0); PS_AXPY(rB, 1, 1); PS_FIN(s, 1);
                PS_ISSUE(rB, VB, s, 2, 1); PS_AXPY(rA, 2, 0);
                PS_ISSUE(rA, VB, s, 3, 0); PS_AXPY(rB, 2, 1); PS_FIN(s, 2);
                PS_ISSUE(rB, VB, s, 3, 1); PS_AXPY(rA, 3, 0);
                if (s + 1 < 16) PS_ISSUE(rA, VB, s + 1, 0, 0); PS_AXPY(rB, 3, 1); PS_FIN(s, 3);
            }
#undef PS_AXPY
#undef PS_FIN
#undef PS_ISSUE
#undef PS_SG
        }
        { f32x4 fg[8];
#pragma unroll
          for (int j = 0; j < 8; ++j) fg[j] = *(const f32x4*)(P.final_g + 4 * lane + 256 * j);
#pragma unroll
          for (int i = 0; i < 4; ++i) { const float rs2 = 1.0f / sqrtf(wave_sum(ssq[i]) * (1.f / DM) + RMS_EPS);
#pragma unroll
            for (int j = 0; j < 8; ++j) { const v2u hv = *(const LAS v2u*)(h2T + i * DM + 4 * lane + 256 * j);
                *(f32x4*)(P.out + (size_t)(t0 + i) * DM + 4 * lane + 256 * j) = (f32x4){bflo(hv.x) * rs2 * fg[j].x, bfhi(hv.x) * rs2 * fg[j].y, bflo(hv.y) * rs2 * fg[j].z, bfhi(hv.y) * rs2 * fg[j].w}; } } }
        asm volatile("" ::: "memory");
    }
}
namespace moba {
constexpr float SCALE = 0.08838834764831845f;
constexpr float THR = 8.f;
constexpr bool WSKIP = false;
constexpr int D = 128, NW = 8, QBLK = 32, KVBLK = 64, QB = NW * QBLK;
constexpr int SHM_V = KVBLK * D * 2, SHM_K = KVBLK * D * 2;
constexpr int ATT_LDS_BYTES = 2 * SHM_V + 2 * SHM_K + NW * 64 * 4;
constexpr int KPITCH = INCP, QPITCH = INCP, OPITCH = DM;
typedef unsigned short bf16;
typedef short bf16x8 __attribute__((ext_vector_type(8)));
typedef short s16x4 __attribute__((ext_vector_type(4)));
typedef float f32x16 __attribute__((ext_vector_type(16)));
typedef float f32x4 __attribute__((ext_vector_type(4)));
typedef unsigned u32x4 __attribute__((ext_vector_type(4)));
template <class A, class Bt> struct same_t { static constexpr bool v = false; };
template <class A> struct same_t<A, A> { static constexpr bool v = true; };
#define KSWZ(row, colB) ((row) * 256 + ((colB) ^ (((row) & 7) << 4)))
#define SBAR() __builtin_amdgcn_sched_barrier(0)
__device__ __forceinline__ int v_st(int k, int c) { const int kk = (k & ~0xC) | ((k & 4) << 1) | ((k & 8) >> 1); return ((kk >> 3) * 4 + (c >> 5)) * 512 + ((kk & 7) * 32 + (c & 31)) * 2; }
__device__ __forceinline__ int v_rd_base(int lane) { return ((lane & 3) << 3) | (((lane >> 2) & 3) << 6) | (((lane >> 4) & 1) << 5) | (((lane >> 5) & 1) << 8); }
constexpr int v_rd_off(int d0, int ks, int half) { return d0 * 512 + ks * 4096 + half * 2048; }
__device__ __forceinline__ int crow(int r, int hi) { return (r & 3) + 8 * (r >> 2) + 4 * hi; }
__device__ __forceinline__ unsigned cvtpk(float lo, float hi) {
    unsigned r; asm volatile("v_cvt_pk_bf16_f32 %0, %1, %2" : "=v"(r) : "v"(lo), "v"(hi)); return r;
}
__device__ __forceinline__ bf16x8 pack8(f32x4 a, f32x4 b) {
    u32x4 w = {cvtpk(a[0], a[1]), cvtpk(a[2], a[3]), cvtpk(b[0], b[1]), cvtpk(b[2], b[3])};
    return *reinterpret_cast<bf16x8*>(&w);
}
template <class T> __device__ __forceinline__ bf16x8 load8(const T* p) {
    if constexpr (same_t<T, float>::v) { return pack8(*(const f32x4*)p, *(const f32x4*)(p + 4)); }
    else { return *reinterpret_cast<const bf16x8*>(p); }
}
__device__ __forceinline__ void mask_tile(f32x16& p0, f32x16& p1, int dq, unsigned W) {
    const float NEG = -__builtin_inff();
#pragma unroll
    for (int r = 0; r < 16; ++r) {
        const int c = (r & 3) + 8 * (r >> 2);
        if ((unsigned)(dq - c) >= W) p0[r] = NEG;
        if ((unsigned)(dq - c - 32) >= W) p1[r] = NEG;
    }
}
__device__ __forceinline__ void partialSM(f32x16& p0, f32x16& p1, float& m_reg, float& mn, float& alpha, float base0, float base1) {
    float pm0 = p0[0]; for (int r = 1; r < 16; ++r) pm0 = fmaxf(pm0, p0[r]); float pm1 = p1[0]; for (int r = 1; r < 16; ++r) pm1 = fmaxf(pm1, p1[r]);
    float pmax = fmaxf(pm0 + base0, pm1 + base1);
    { auto rr = __builtin_amdgcn_permlane32_swap(__float_as_uint(pmax), __float_as_uint(pmax), false, false);
      pmax = fmaxf(__uint_as_float(rr[0]), __uint_as_float(rr[1])); }
    constexpr float C2 = 1.4426950408889634f * SCALE;
    if (__builtin_expect(__all((pmax - m_reg) * SCALE <= THR), 1)) { mn = m_reg; alpha = 1.f; }
    else { mn = fmaxf(m_reg, pmax); alpha = __builtin_amdgcn_exp2f((m_reg - mn) * C2); m_reg = mn; }
    const float mnL0 = (base0 - mn) * C2, mnL1 = (base1 - mn) * C2;
    for (int r = 0; r < 16; ++r) p0[r] = fmaf(p0[r], C2, mnL0); for (int r = 0; r < 16; ++r) p1[r] = fmaf(p1[r], C2, mnL1);
    for (int r = 0; r < 16; ++r) p0[r] = __builtin_amdgcn_exp2f(p0[r]);
}
__device__ __forceinline__ void finishSM(f32x16& p0, f32x16& p1, float alpha, float& l_reg, bf16x8& pa0, bf16x8& pa1, bf16x8& pa2, bf16x8& pa3) {
    for (int r = 0; r < 16; ++r) p1[r] = __builtin_amdgcn_exp2f(p1[r]);
    float ps = 0; for (int r = 0; r < 16; ++r) ps += p0[r]; for (int r = 0; r < 16; ++r) ps += p1[r];
    { auto rr = __builtin_amdgcn_permlane32_swap(__float_as_uint(ps), __float_as_uint(ps), false, false);
      ps = __uint_as_float(rr[0]) + __uint_as_float(rr[1]); }
    l_reg = l_reg * alpha + ps;
#define PK4(P, B_, OUT) do { unsigned a0 = cvtpk(P[B_+0], P[B_+1]), a1 = cvtpk(P[B_+2], P[B_+3]);                          \
        unsigned b0 = cvtpk(P[B_+4], P[B_+5]), b1 = cvtpk(P[B_+6], P[B_+7]);                                             \
        auto r0 = __builtin_amdgcn_permlane32_swap(a0, b0, false, false); auto r1 = __builtin_amdgcn_permlane32_swap(a1, b1, false, false); \
        u32x4 w = {r0[0], r1[0], r0[1], r1[1]}; OUT = *reinterpret_cast<bf16x8*>(&w); } while (0)
    PK4(p0, 0, pa0); PK4(p0, 8, pa1); PK4(p1, 0, pa2); PK4(p1, 8, pa3);
#undef PK4
}
template <int KB, bool SK>
__device__ __forceinline__ void qkt(f32x16& p0, f32x16& p1, const char* K_lds, int r32, int hi, const bf16x8* qr, bool act) {
    if (SK && !act) { const float NEG = -__builtin_inff();
#pragma unroll
        for (int r = 0; r < 16; ++r) { p0[r] = NEG; p1[r] = NEG; } return; }
    p0 = f32x16{}; p1 = f32x16{};
    const char* kb[4];
#pragma unroll
    for (int dd = 0; dd < 4; ++dd) kb[dd] = K_lds + KB * SHM_K + KSWZ(r32, (dd * 16 + hi * 8) * 2);
#pragma unroll
    for (int d0 = 0; d0 < 8; ++d0) { const char* a = kb[d0 & 3] + (d0 >> 2) * 128;
        bf16x8 b0 = *reinterpret_cast<const bf16x8*>(a);
        bf16x8 b1 = *reinterpret_cast<const bf16x8*>(a + 32 * 256);
        p0 = __builtin_amdgcn_mfma_f32_32x32x16_bf16(b0, qr[d0], p0, 0, 0, 0);
        p1 = __builtin_amdgcn_mfma_f32_32x32x16_bf16(b1, qr[d0], p1, 0, 0, 0); }
}
template <int VB, bool SK>
__device__ __forceinline__ void pv_tile(f32x16* o, int vb0, bf16x8 pa0, bf16x8 pa1, bf16x8 pa2, bf16x8 pa3, bool act) {
    if (SK && !act) return;
#define TRRD(dst, off) asm volatile("ds_read_b64_tr_b16 %0, %1 offset:%2" : "=&v"(dst) : "v"(vb0), "i"(off) : "memory")
#define PV_D0(d0) do { s16x4 l0, l1, h0, h1; constexpr int b_ = VB * SHM_V + v_rd_off(d0, 0, 0);     \
        TRRD(l0, b_); TRRD(h0, b_ + 2048); TRRD(l1, b_ + 4096); TRRD(h1, b_ + 6144); \
        asm volatile("s_waitcnt lgkmcnt(0)" ::: "memory"); SBAR();                 \
        o[d0] = __builtin_amdgcn_mfma_f32_32x32x16_bf16(pa0, (bf16x8){l0[0], l0[1], l0[2], l0[3], h0[0], h0[1], h0[2], h0[3]}, o[d0], 0, 0, 0);   \
        o[d0] = __builtin_amdgcn_mfma_f32_32x32x16_bf16(pa1, (bf16x8){l1[0], l1[1], l1[2], l1[3], h1[0], h1[1], h1[2], h1[3]}, o[d0], 0, 0, 0);   \
        SBAR(); TRRD(l0, b_ + 8192); TRRD(h0, b_ + 10240); TRRD(l1, b_ + 12288); TRRD(h1, b_ + 14336); \
        asm volatile("s_waitcnt lgkmcnt(0)" ::: "memory"); SBAR();   \
        o[d0] = __builtin_amdgcn_mfma_f32_32x32x16_bf16(pa2, (bf16x8){l0[0], l0[1], l0[2], l0[3], h0[0], h0[1], h0[2], h0[3]}, o[d0], 0, 0, 0);   \
        o[d0] = __builtin_amdgcn_mfma_f32_32x32x16_bf16(pa3, (bf16x8){l1[0], l1[1], l1[2], l1[3], h1[0], h1[1], h1[2], h1[3]}, o[d0], 0, 0, 0); } while (0)
    PV_D0(0); PV_D0(1); PV_D0(2); PV_D0(3);
#undef PV_D0
#undef TRRD
}

template <class TIn, class TOut> struct BlockRef { const TIn* Q; const TIn* K; const TIn* V; TOut* O; int P0; const float* KM; float A; int jlo, jhi; float* ST; };
template <class TIn> struct Seam {
    bf16x8 qr[8];
    bf16x8 st_v0, st_v1, st_k0, st_k1; f32x4 sf0, sf1, sf2, sf3;
    f32x4 tq[16];
};
__device__ __forceinline__ int swa_jlo(int P0, int W) { const int lowk = P0 - W + 1; return lowk > 0 ? lowk / KVBLK : 0; }
#define ROW(p, k0, rr) ((p) + (size_t)((k0) + (rr)) * KPITCH + sc)
#define VMW() asm volatile("s_waitcnt vmcnt(0)" ::: "memory")
#define VMWN(n) asm volatile("s_waitcnt vmcnt(%0)" :: "i"(n) : "memory")
#define SLOAD_H(Kp, Vp, k0) do { S.st_v0 = load8<TIn>(ROW(Vp, k0, sr)); S.st_v1 = load8<TIn>(ROW(Vp, k0, 32 + sr));              \
                         S.st_k0 = load8<TIn>(ROW(Kp, k0, sr)); S.st_k1 = load8<TIn>(ROW(Kp, k0, 32 + sr)); } while (0)
#define SWRITE_HK(bf) do { *(bf16x8*)(K_lds + (bf) * SHM_K + kws) = S.st_k0; *(bf16x8*)(K_lds + (bf) * SHM_K + kws + 32 * 256) = S.st_k1; } while (0)
#define SWRITE_HV(bf) do { *(bf16x8*)(V_lds + (bf) * SHM_V + vst0) = S.st_v0; *(bf16x8*)(V_lds + (bf) * SHM_V + vst1) = S.st_v1; } while (0)
#define SWRITE_H(bf) do { SWRITE_HV(bf); SWRITE_HK(bf); } while (0)
#define SLOAD_F(p, k0) do { S.sf0 = *(const f32x4*)ROW(p, k0, sr); S.sf1 = *(const f32x4*)(ROW(p, k0, sr) + 4);                \
                            S.sf2 = *(const f32x4*)ROW(p, k0, 32 + sr); S.sf3 = *(const f32x4*)(ROW(p, k0, 32 + sr) + 4); } while (0)
#define SWRITE_KF(bf) do { *(bf16x8*)(K_lds + (bf) * SHM_K + kws) = pack8(S.sf0, S.sf1); *(bf16x8*)(K_lds + (bf) * SHM_K + kws + 32 * 256) = pack8(S.sf2, S.sf3); } while (0)
#define SWRITE_VF(bf) do { *(bf16x8*)(V_lds + (bf) * SHM_V + vst0) = pack8(S.sf0, S.sf1); *(bf16x8*)(V_lds + (bf) * SHM_V + vst1) = pack8(S.sf2, S.sf3); } while (0)
template <class TIn, class TOut>
__device__ __forceinline__ void causal_swa_prime(const BlockRef<TIn, TOut>& cur, int W, char* lds, Seam<TIn>& S) {
    constexpr bool F32 = same_t<TIn, float>::v;
    const int tid = ltid(), wid = __builtin_amdgcn_readfirstlane(tid >> 6), lane = tid & 63, r32 = lane & 31, hi = lane >> 5;
    const int sr = tid >> 4, sc = (tid & 15) * 8, kws = KSWZ(sr, sc * 2); char* K_lds = lds + 2 * SHM_V;
    const int kb0 = cur.jlo * KVBLK;
    for (int d0 = 0; d0 < 8; ++d0) S.qr[d0] = load8<TIn>(cur.Q + (size_t)(wid * QBLK + r32) * QPITCH + d0 * 16 + hi * 8);
    if constexpr (F32) { SLOAD_F((const float*)cur.K, kb0); VMW(); SWRITE_KF(0); SBAR(); SLOAD_F((const float*)cur.V, kb0); }
    else { SLOAD_H(cur.K, cur.V, kb0); VMW(); SWRITE_HK(0); }
    __syncthreads();
}
template <class TIn, class TOut>
__device__ __forceinline__ void causal_swa_block(const BlockRef<TIn, TOut>& cur, const BlockRef<TIn, TOut>& nxt, int skv, int W, char* lds, Seam<TIn>& S) {
    constexpr bool F32 = same_t<TIn, float>::v;
    const int tid = ltid(), wid = __builtin_amdgcn_readfirstlane(tid >> 6), lane = tid & 63, r32 = lane & 31, hi = lane >> 5;
    const int j_lo = cur.jlo, j_hi = cur.jhi;
    const int NT = j_hi - j_lo;
    const int kbn = nxt.jlo * KVBLK;
    const int qlo = cur.P0 + wid * QBLK, qm = qlo + r32 - 4 * hi;
    char* V_lds = lds; char* K_lds = lds + 2 * SHM_V;
    float* ws = (float*)(lds + 2 * SHM_V + 2 * SHM_K) + wid * 64; float* li_l = ws, * al_l = ws + 32;
    float m_reg = -1e30f, l_reg = 0; f32x16 o[4] = {};
    const int sr = tid >> 4, sc = (tid & 15) * 8, vst0 = v_st(sr, sc), vst1 = v_st(32 + sr, sc), kws = KSWZ(sr, sc * 2);
    const int vb0 = (int)(uintptr_t)V_lds + v_rd_base(lane);
    const TIn* Kh = cur.K; const TIn* Vh = cur.V;
    const float alA_ = cur.A;
    unsigned selm = 0u;
    { const int qb_ = cur.P0 >> 8;
      if (qb_ > 0) {
        float* kmL = (float*)(K_lds + SHM_K);
        *(f32x4*)(kmL + 4 * tid) = *(const f32x4*)(cur.KM + (size_t)(tid >> 5) * 1024 + 4 * (tid & 31));
        __syncthreads();
        float g[16];
#pragma unroll
        for (int n = 0; n < 16; ++n) g[n] = 0.f;
#pragma unroll
        for (int d0 = 0; d0 < 8; ++d0) { float qf[8];
#pragma unroll
            for (int j = 0; j < 8; ++j) qf[j] = __uint_as_float(((unsigned)(unsigned short)S.qr[d0][j]) << 16);
#pragma unroll
            for (int n = 0; n < 16; ++n) if (n < qb_) { const f32x4 k0 = *(const f32x4*)(kmL + n * 128 + d0 * 16 + hi * 8), k1 = *(const f32x4*)(kmL + n * 128 + d0 * 16 + hi * 8 + 4);
                g[n] += qf[0] * k0[0] + qf[1] * k0[1] + qf[2] * k0[2] + qf[3] * k0[3] + qf[4] * k1[0] + qf[5] * k1[1] + qf[6] * k1[2] + qf[7] * k1[3]; }
            asm volatile("" ::: "memory"); }
#pragma unroll
        for (int n = 0; n < 16; ++n) { const float a = g[n] + __shfl_xor(g[n], 32); g[n] = n < qb_ ? a : -1e30f; }
#pragma unroll
        for (int r = 0; r < 3; ++r) { float best = -3e38f; int bi = 0;
#pragma unroll
            for (int n = 0; n < 16; ++n) if (!((selm >> n) & 1u) && g[n] > best) { best = g[n]; bi = n; }
            selm |= 1u << bi; }
        selm &= (1u << qb_) - 1u;
        __syncthreads();
      }
      li_l[r32] = __uint_as_float(selm); }
#define RESC(a) do { if (__any((a) < 1.f)) { if (hi == 0) al_l[r32] = (a); asm volatile("s_waitcnt lgkmcnt(0)" ::: "memory");              \
                     for (int d_ = 0; d_ < 4; ++d_) for (int r = 0; r < 16; ++r) o[d_][r] *= al_l[crow(r, hi)]; } } while (0)
#define KBASE(t) ((j_lo + (t)) * KVBLK)
#define ACT(t) (KBASE(t) <= qlo + QBLK - 1 && KBASE(t) + KVBLK - 1 >= qlo - W + 1)
#define MASKT(P0_, P1_, t) do { const int kb_ = KBASE(t); if ((!SK || ACT(t)) && (kb_ + KVBLK - 1 > qlo || kb_ <= qlo + QBLK - 1 - W)) mask_tile(P0_, P1_, qm - kb_, (unsigned)W); \
        _Pragma("unroll") for (int r = 0; r < 16; ++r) { const float c_ = (float)((r & 3) + 8 * (r >> 2)); P0_[r] = fmaf(alA_, c_, P0_[r]); P1_[r] = fmaf(alA_, c_, P1_[r]); } } while (0)
#define BASE0(t) ((KBASE(t) < cur.P0 && !((__float_as_uint(li_l[r32]) >> (KBASE(t) >> 8)) & 1u)) ? -__builtin_inff() : alA_ * (float)(KBASE(t) - cur.P0 + 4 * hi))
#define BASE1(t) (BASE0(t) + 32.f * alA_)
    constexpr int NQL = F32 ? 16 : 8;
    constexpr bool SK = WSKIP && !F32;
#define SEAM_K0() do { VMWN(NQL); if constexpr (F32) { SWRITE_KF(0); SBAR(); SLOAD_F((const float*)nxt.V, kbn); } else { SWRITE_HK(0); } SBAR(); } while (0)
    f32x16 pA0, pA1, pB0, pB1; float mnA, mnB, alA, alB; bf16x8 pa0, pa1, pa2, pa3;
    if constexpr (F32) { VMW(); SWRITE_VF(0); SBAR(); } else { SWRITE_HV(0); SBAR(); }
    if (NT > 1) { if constexpr (F32) SLOAD_F((const float*)Kh, KBASE(1)); else SLOAD_H(Kh, Vh, KBASE(1)); }
    SBAR(); qkt<0, SK>(pA0, pA1, K_lds, r32, hi, S.qr, ACT(0));
    if constexpr (F32) { if (NT > 1) { VMW(); SWRITE_KF(1); SBAR(); SLOAD_F((const float*)Vh, KBASE(1)); } }
    MASKT(pA0, pA1, 0); partialSM(pA0, pA1, m_reg, mnA, alA, BASE0(0), BASE1(0));
    if (NT > 1) { VMW(); if constexpr (F32) { SWRITE_VF(1); SBAR(); if (NT > 2) SLOAD_F((const float*)Kh, KBASE(2)); } else SWRITE_H(1); }
    __syncthreads();
#define HALF_STEP(PX0, PX1, mnX, alX, PY0, PY1, alY, t, KB, VB, SB) do {                                                      \
        SBAR(); qkt<KB, SK>(PX0, PX1, K_lds, r32, hi, S.qr, ACT(t));                                             \
        finishSM(PY0, PY1, alY, l_reg, pa0, pa1, pa2, pa3); SBAR();                                                           \
        if ((t) + 1 < NT) { if constexpr (F32) { VMW(); SWRITE_KF(SB); SBAR(); SLOAD_F((const float*)Vh, KBASE((t) + 1)); }  \
                            else { SLOAD_H(Kh, Vh, KBASE((t) + 1)); } SBAR(); }                                               \
        pv_tile<VB, SK>(o, vb0, pa0, pa1, pa2, pa3, ACT((t) - 1)); MASKT(PX0, PX1, (t)); partialSM(PX0, PX1, m_reg, mnX, alX, BASE0(t), BASE1(t));                                        \
        __syncthreads();                                                                                                      \
        if ((t) + 1 < NT) { VMW(); if constexpr (F32) { SWRITE_VF(SB); SBAR(); if ((t) + 2 < NT) SLOAD_F((const float*)Kh, KBASE((t) + 2)); } \
                            else { SWRITE_H(SB); } }                                                                          \
        RESC(alX); __syncthreads(); } while (0)
    for (int t = 1; t + 1 < NT; t += 2) {
        HALF_STEP(pB0, pB1, mnB, alB, pA0, pA1, alA, t, 1, 0, 0);
        HALF_STEP(pA0, pA1, mnA, alA, pB0, pB1, alB, t + 1, 0, 1, 1);
    }
    const bool even = (NT & 1) == 0;
    if (even) { SBAR(); qkt<1, SK>(pB0, pB1, K_lds, r32, hi, S.qr, ACT(NT - 1)); SBAR(); }
#define QROW(e) (nxt.Q + (size_t)(wid * QBLK + r32) * QPITCH + ((e) >> 1) * 16 + hi * 8 + ((e) & 1) * 4)
    if constexpr (F32) { SLOAD_F((const float*)nxt.K, kbn); SBAR();
#pragma unroll
        for (int e = 0; e < 8; ++e) S.tq[e] = *(const f32x4*)QROW(e); }
    else { SLOAD_H(nxt.K, nxt.V, kbn); SBAR();
#pragma unroll
        for (int d0 = 0; d0 < 8; ++d0) S.qr[d0] = load8<TIn>(nxt.Q + (size_t)(wid * QBLK + r32) * QPITCH + d0 * 16 + hi * 8); }
    SBAR();
    finishSM(pA0, pA1, alA, l_reg, pa0, pa1, pa2, pa3); SBAR();
    if constexpr (F32) {
#pragma unroll
        for (int e = 8; e < 16; ++e) S.tq[e] = *(const f32x4*)QROW(e); SBAR(); }
#undef QROW
    pv_tile<0, SK>(o, vb0, pa0, pa1, pa2, pa3, ACT(even ? NT - 2 : NT - 1));
    if (even) { MASKT(pB0, pB1, NT - 1); partialSM(pB0, pB1, m_reg, mnB, alB, BASE0(NT - 1), BASE1(NT - 1)); __syncthreads(); RESC(alB);
        finishSM(pB0, pB1, alB, l_reg, pa0, pa1, pa2, pa3); SBAR(); pv_tile<1, SK>(o, vb0, pa0, pa1, pa2, pa3, ACT(NT - 1)); }
    SBAR(); SEAM_K0();
    if (hi == 0) { li_l[r32] = l_reg; if (cur.ST) { cur.ST[(wid * QBLK + r32) * 16] = m_reg; cur.ST[(wid * QBLK + r32) * 16 + 1] = l_reg; } }
    asm volatile("s_waitcnt lgkmcnt(0)" ::: "memory");
    float rli[16];
#pragma unroll
    for (int r = 0; r < 16; ++r) { const float l_ = li_l[crow(r, hi)]; rli[r] = l_ > 0.f ? __builtin_amdgcn_rcpf(l_) : 0.f; }
    TOut* Ow = cur.O + (size_t)(wid * QBLK) * OPITCH;
#pragma unroll
    for (int r = 0; r < 16; ++r) { const int orow = crow(r, hi);
#pragma unroll
        for (int d0 = 0; d0 < 4; ++d0) { const float v = o[d0][r] * rli[r];
            if constexpr (same_t<TOut, float>::v) { Ow[(size_t)orow * OPITCH + d0 * 32 + r32] = v; }
            else { const float vn = __shfl_xor(v, 1);
                   if ((r32 & 1) == 0) *(unsigned*)(Ow + (size_t)orow * OPITCH + d0 * 32 + r32) = cvtpk(v, vn); } } }
    if constexpr (F32) {
#pragma unroll
        for (int d0 = 0; d0 < 8; ++d0) S.qr[d0] = pack8(S.tq[2 * d0], S.tq[2 * d0 + 1]); }
    __syncthreads();
#undef RESC
#undef KBASE
#undef ACT
#undef MASKT
#undef SEAM_K0
#undef HALF_STEP
}
#undef ROW
#undef VMW
#undef VMWN
#undef SLOAD_H
#undef SWRITE_HK
#undef SWRITE_HV
#undef SWRITE_H
#undef SLOAD_F
#undef SWRITE_KF
#undef SWRITE_VF

#undef BASE0
#undef BASE1
}
constexpr size_t WS_OSL = WS_XN, WS_OSU = WS_H;
constexpr size_t WS_STL = WS_WIN, WS_STU = WS_WIN + 1 * MiB;
constexpr int MOBA_SPLIT_QB = 8;
__device__ __forceinline__ void phase_moba(KP P, char* lds, int vcu, int G) {
    typedef moba::BlockRef<moba::bf16, moba::bf16> BR;
    const moba::bf16* proj = (const moba::bf16*)(P.ws + WS_PROJ); moba::bf16* AR = (moba::bf16*)(P.ws + WS_AR); const float* kmean = (const float*)(P.ws + WS_KMEAN);
    constexpr int W = 1 << 30;
    auto mkref = [&](int bh, int qb, int part) -> BR { const int b = bh >> 3, h = bh & 7; BR r; const int nt = 4 * qb + 4;
        r.Q = proj + (size_t)(b * SEQ + qb * 256) * INCP + h * 128; r.K = proj + (size_t)(b * SEQ) * INCP + C_AK + h * 128; r.V = proj + (size_t)(b * SEQ) * INCP + C_AV + h * 128;
        moba::bf16* ob = part == 0 ? AR : (moba::bf16*)(P.ws + (part == 1 ? WS_OSL : WS_OSU));
        r.O = ob + (size_t)(b * SEQ + qb * 256) * DM + h * 128; r.P0 = qb * 256; r.KM = kmean + (size_t)(b * 16) * 1024 + h * 128; r.A = exp2f(-(float)(h + 1)) * (1.f / moba::SCALE);
        r.jlo = part == 2 ? nt / 2 : 0; r.jhi = part == 1 ? nt / 2 : nt;
        r.ST = part == 0 ? nullptr : (float*)(P.ws + (part == 1 ? WS_STL : WS_STU)) + ((size_t)(b * SEQ + qb * 256) * 8 + h) * 2;
        return r; };
    moba::Seam<moba::bf16> S;
    if (G == 256) {
        const int q_ = vcu & 15, bh = vcu >> 4;
        const int qbA[16] = {-1, -1, 15, 15,  7, 14, 14, 13, 13,  6, 12, 12, 11, 11,  5, 10};
        const int ptA[16] = { 0,  0,  2,  1,  0,  2,  1,  2,  1,  0,  2,  1,  2,  1,  0,  2};
        const int qbB[16] = {-1, -1, -1, -1, -1,  0, -1,  1,  2,  3,  8,  8,  4,  9,  9, 10};
        const int ptB[16] = { 0,  0,  0,  0,  0,  0,  0,  0,  0,  0,  2,  1,  0,  2,  1,  1};
        int qa = -1, pa = 0, qb2 = -1, pb = 0;
#pragma unroll
        for (int k = 0; k < 16; ++k) if (k == q_) { qa = qbA[k]; pa = ptA[k]; qb2 = qbB[k]; pb = ptB[k]; }
        for (int it = 0; it < 2; ++it) { const int qq = it == 0 ? qa : qb2, pp = it == 0 ? pa : pb; if (qq < 0) continue;
            const BR cur = mkref(bh, qq, pp);
            moba::causal_swa_prime<moba::bf16, moba::bf16>(cur, W, lds, S);
            moba::causal_swa_block<moba::bf16, moba::bf16>(cur, cur, SEQ, W, lds, S); }
    } else {
        for (int item = vcu; item < 256; item += G) {
            const BR cur = mkref(item >> 4, item & 15, 0);
            moba::causal_swa_prime<moba::bf16, moba::bf16>(cur, W, lds, S);
            moba::causal_swa_block<moba::bf16, moba::bf16>(cur, cur, SEQ, W, lds, S); }
    }
}
__device__ __forceinline__ void moba_combine(KP P, int vcu, int G) {
    if (G != 256) return;
    const int tid = ltid(); const bf16* OL = (const bf16*)(P.ws + WS_OSL); const bf16* OU = (const bf16*)(P.ws + WS_OSU); bf16* AR = (bf16*)(P.ws + WS_AR);
    const float* STL = (const float*)(P.ws + WS_STL); const float* STU = (const float*)(P.ws + WS_STU);
    constexpr int NSPL = 16 - MOBA_SPLIT_QB; constexpr float C2 = 1.4426950408889634f * moba::SCALE;
    for (int item = vcu; item < 16 * NSPL * 2; item += G) {
        const int half = item & 1, k = item >> 1, bh = k / NSPL, qb = MOBA_SPLIT_QB + k % NSPL, b = bh >> 3, h = bh & 7;
        const int row = b * SEQ + qb * 256 + half * 128 + (tid >> 2), c0 = (tid & 3) * 32;
        const size_t so = ((size_t)row * 8 + h) * 2; const float mL = STL[so], lL = STL[so + 1], mU = STU[so], lU = STU[so + 1];
        const float m = fmaxf(mL, mU); const float wL = lL * __builtin_amdgcn_exp2f((mL - m) * C2), wU = lU * __builtin_amdgcn_exp2f((mU - m) * C2); const float inv = __builtin_amdgcn_rcpf(wL + wU);
        const float aL = wL * inv, aU = wU * inv; const size_t o = (size_t)row * DM + h * 128 + c0;
#pragma unroll
        for (int j = 0; j < 4; ++j) { const v4u l4 = *(const v4u*)(OL + o + 8 * j), u4 = *(const v4u*)(OU + o + 8 * j); v4u r4;
#pragma unroll
            for (int e = 0; e < 4; ++e) r4[e] = pk2(aL * bflo(l4[e]) + aU * bflo(u4[e]), aL * bfhi(l4[e]) + aU * bfhi(u4[e]));
            *(v4u*)(AR + o + 8 * j) = r4; }
    }
}
constexpr size_t WS_SKB = WS_KMEAN + 256 * 1024;
__device__ __forceinline__ void prologue_subkeys(KP P, int vcu, int G) {
    unsigned* dst = (unsigned*)(P.ws + WS_SKB);
    for (int i = vcu * NTHR + ltid(); i < 8 * 2 * 128 * 128 / 2; i += G * NTHR) dst[i] = pk2(P.sub_keys[2 * i], P.sub_keys[2 * i + 1]);
}
__device__ __forceinline__ unsigned f2key(float v) { const unsigned u = __float_as_uint(v); return u ^ ((u >> 31) ? 0xFFFFFFFFu : 0x80000000u); }
__device__ __forceinline__ float key2f(unsigned k) { return __uint_as_float(k ^ ((k >> 31) ? 0x80000000u : 0xFFFFFFFFu)); }
__device__ __forceinline__ unsigned umax3(unsigned a, unsigned b, unsigned c) { return max(max(a, b), c); }
__device__ __forceinline__ void peer_route_tiles(KP P, LAS unsigned char* lds, int tt0, int nitems, int h) {
    const int tid = ltid(), lane = tid & 63, wave = __builtin_amdgcn_readfirstlane(tid >> 6), l15 = lane & 15, q4 = lane >> 4;
    const bf16* PQ = (const bf16*)(P.ws + WS_PROJ); const bf16* SKB = (const bf16*)(P.ws + WS_SKB);
    int* ridx = (int*)(P.ws + WS_PROJ + 64 * MiB); float* rgate = (float*)(P.ws + WS_PROJ + 68 * MiB);
    for (int it_ = 0; it_ < nitems; ++it_) {
        LAS float* sval = (LAS float*)(lds + it_ * 16384); LAS int* sidx = (LAS int*)(lds + it_ * 16384 + 8192);
        const int tt = tt0 + it_, p = wave & 1, sub = wave >> 1, tl = sub * 16 + l15;
        const bf16* qp = PQ + ((size_t)tt * 64 + tl) * DM + h * 256 + p * 128 + 8 * q4;
        bf16x8 qb[4];
#pragma unroll
        for (int kk = 0; kk < 4; ++kk) qb[kk] = *(const bf16x8*)(qp + 32 * kk);
        const bf16* sk = SKB + ((size_t)((h * 2 + p) * 128 + l15)) * 128 + 8 * q4;
        unsigned key[32];
#pragma unroll
        for (int nt = 0; nt < 8; ++nt) { f32x4v acc = {0.f, 0.f, 0.f, 0.f};
#pragma unroll
            for (int kk = 0; kk < 4; ++kk) acc = __builtin_amdgcn_mfma_f32_16x16x32_bf16(*(const bf16x8*)(sk + nt * 16 * 128 + 32 * kk), qb[kk], acc, 0, 0, 0);
#pragma unroll
            for (int e = 0; e < 4; ++e) key[4 * nt + e] = (f2key(acc[e]) & ~127u) | (unsigned)(127 - (16 * nt + 4 * q4 + e)); }
        unsigned lim = 0xFFFFFFFFu;
        for (int r = 0; r < 16; ++r) {
            unsigned c[32];
#pragma unroll
            for (int k = 0; k < 32; ++k) c[k] = key[k] < lim ? key[k] : 0u;
            unsigned m0 = umax3(c[0], c[1], c[2]), m1 = umax3(c[3], c[4], c[5]), m2 = umax3(c[6], c[7], c[8]), m3 = umax3(c[9], c[10], c[11]);
            m0 = umax3(m0, c[12], c[13]); m1 = umax3(m1, c[14], c[15]); m2 = umax3(m2, c[16], c[17]); m3 = umax3(m3, c[18], c[19]);
            m0 = umax3(m0, c[20], c[21]); m1 = umax3(m1, c[22], c[23]); m2 = umax3(m2, c[24], c[25]); m3 = umax3(m3, c[26], c[27]);
            m0 = umax3(m0, c[28], c[29]); m1 = umax3(m1, c[30], c[31]);
            unsigned best = max(max(m0, m1), max(m2, m3));
            { auto x16 = __builtin_amdgcn_permlane16_swap(best, best, false, false); best = max(x16[0], x16[1]);
              auto x32 = __builtin_amdgcn_permlane32_swap(best, best, false, false); best = max(x32[0], x32[1]); }
            lim = best;
            if (q4 == 0) { sval[(tl * 2 + p) * 16 + r] = key2f(best & ~127u); sidx[(tl * 2 + p) * 16 + r] = 127 - (int)(best & 127u); }
        }
    }
    __syncthreads();
    {
        const int it_ = wave; const int tt = tt0 + it_;
        LAS float* sval = (LAS float*)(lds + it_ * 16384); LAS int* sidx = (LAS int*)(lds + it_ * 16384 + 8192);
        if (wave < nitems) {
            const LAS float* av = sval + (lane * 2) * 16; const LAS float* bv = av + 16; const LAS int* ai = sidx + (lane * 2) * 16; const LAS int* bi = ai + 16;
            unsigned hk[16];
            const float b0 = bv[0];
#pragma unroll
            for (int i4 = 0; i4 < 4; ++i4) { const f32x4 t4 = *(const LAS f32x4*)(av + 4 * i4);
#pragma unroll
                for (int e = 0; e < 4; ++e) hk[4 * i4 + e] = (f2key(t4[e] + b0) & ~255u) | (unsigned)(255 - (4 * i4 + e) * 16); }
            float bestv[16]; int beste[16];
#pragma unroll
            for (int r = 0; r < 16; ++r) {
                unsigned m0 = umax3(hk[0], hk[1], hk[2]), m1 = umax3(hk[3], hk[4], hk[5]), m2 = umax3(hk[6], hk[7], hk[8]), m3 = umax3(hk[9], hk[10], hk[11]);
                m0 = umax3(m0, hk[12], hk[13]); m1 = umax3(m1, hk[14], hk[15]);
                const unsigned best = max(max(m0, m1), max(m2, m3));
                const int f = 255 - (int)(best & 255u), bi_ = f >> 4, bj = f & 15;
                const float a_i = av[bi_]; bestv[r] = a_i + bv[bj]; beste[r] = ai[bi_] * 128 + bi[bj];
                const int nj = bj + 1;
                const unsigned nk = nj < 16 ? ((f2key(a_i + bv[nj & 15]) & ~255u) | (unsigned)(255 - (bi_ * 16 + nj))) : 0u;
#pragma unroll
                for (int i = 0; i < 16; ++i) hk[i] = i == bi_ ? nk : hk[i];
            }
            float se = 0.f; const float mx = bestv[0];
#pragma unroll
            for (int r = 0; r < 16; ++r) { bestv[r] = __expf(bestv[r] - mx); se += bestv[r]; }
            const float ise = 1.f / se; const size_t o = ((size_t)tt * 64 + lane) * 128 + h * 16;
#pragma unroll
            for (int r4 = 0; r4 < 4; ++r4) { *(v4u*)(ridx + o + 4 * r4) = (v4u){(unsigned)beste[4 * r4], (unsigned)beste[4 * r4 + 1], (unsigned)beste[4 * r4 + 2], (unsigned)beste[4 * r4 + 3]};
                *(f32x4*)(rgate + o + 4 * r4) = (f32x4){bestv[4 * r4] * ise, bestv[4 * r4 + 1] * ise, bestv[4 * r4 + 2] * ise, bestv[4 * r4 + 3] * ise}; }
        }
        __syncthreads();
    }
}
#define XB_TMO      128
#define XB_XCNT(j)  (256  + 64 * (j))
#define XB_XSUB(j)  (1280 + 64 * (j))
#define XB_XGEN(j)  (2304 + 64 * (j))
#define XB_TOP      3328
#define XB_TOPGEN   3392
#define XCD_BAR_WORDS 3456
#define XB_SPIN_CAP (1u << 18)

__device__ __forceinline__ unsigned xb_ld(unsigned* p)              { return __hip_atomic_load(p, __ATOMIC_RELAXED, __HIP_MEMORY_SCOPE_AGENT); }
__device__ __forceinline__ unsigned xb_add(unsigned* p, unsigned v) { return __hip_atomic_fetch_add(p, v, __ATOMIC_RELAXED, __HIP_MEMORY_SCOPE_AGENT); }
__device__ __forceinline__ unsigned xb_xcc_id() { return (unsigned)__builtin_amdgcn_s_getreg((3 << 11) | 20) & 0xFu; }
#define XB_SPIN(cond, bar) do { unsigned _sp = 0; while (cond) { __builtin_amdgcn_s_sleep(1); \
    if ((++_sp & 255u) == 0u) { if (xb_ld(&(bar)[XB_TMO])) break; if (_sp > XB_SPIN_CAP) { atomicAdd(&(bar)[XB_TMO], 1u); break; } } } } while (0)

struct XcdBarrier {
    unsigned* bar; unsigned x;
    volatile LAS unsigned* st;
};

__device__ __forceinline__ XcdBarrier xcd_barrier_post(unsigned* bar, volatile LAS unsigned* st) {
    XcdBarrier b; b.bar = bar; b.x = xb_xcc_id(); b.st = st;
    if (threadIdx.x == 0) (void)xb_add(&bar[XB_XCNT(b.x)], 1u);
    return b;
}
__device__ __forceinline__ void xcd_barrier_complete(unsigned* bar, unsigned x, unsigned& nloc, unsigned& nx) {
    const unsigned G = gridDim.x * gridDim.y * gridDim.z;
    unsigned sum, cnt, mine, sp = 0u;
    for (;;) {
        sum = 0u; cnt = 0u; mine = 0u;
#pragma unroll
        for (unsigned j = 0; j < 16; ++j) { const unsigned c = xb_ld(&bar[XB_XCNT(j)]); sum += c; cnt += (c > 0u) ? 1u : 0u; mine = (j == x) ? c : mine; }
        if (sum == G) break;
        __builtin_amdgcn_s_sleep(1);
        if ((++sp & 255u) == 0u) { if (xb_ld(&bar[XB_TMO])) break; if (sp > XB_SPIN_CAP) { atomicAdd(&bar[XB_TMO], 1u); break; } }
    }
    nloc = mine > 0u ? mine : 1u; nx = cnt > 0u ? cnt : 1u;
}

__device__ __forceinline__ void xcd_barrier(const XcdBarrier& b) {
    asm volatile("s_waitcnt vmcnt(0)" ::: "memory");
    __syncthreads();
    if (threadIdx.x == 0) {
        unsigned* bar = b.bar;
        __builtin_amdgcn_s_waitcnt(0);
        unsigned nloc = b.st[0], nx = b.st[1];
        if (nloc == 0u) { xcd_barrier_complete(bar, b.x, nloc, nx); b.st[0] = nloc; b.st[1] = nx; }
        const unsigned old = xb_add(&bar[XB_XSUB(b.x)], 1u);
        const unsigned gen = old / nloc;
        if (old + 1u == (gen + 1u) * nloc) {
            __builtin_amdgcn_fence(__ATOMIC_RELEASE, "agent");
            asm volatile("s_waitcnt vmcnt(0)" ::: "memory");
            const unsigned og = xb_add(&bar[XB_TOP], 1u);
            const unsigned tg = og / nx;
            if (og + 1u == (tg + 1u) * nx) xb_add(&bar[XB_TOPGEN], 1u);
            else XB_SPIN(xb_ld(&bar[XB_TOPGEN]) == tg, bar);
            __builtin_amdgcn_fence(__ATOMIC_ACQUIRE, "agent");
            xb_add(&bar[XB_XGEN(b.x)], 1u);
            asm volatile("s_waitcnt vmcnt(0)" ::: "memory");
        } else {
            XB_SPIN(xb_ld(&bar[XB_XGEN(b.x)]) == gen, bar);
            __builtin_amdgcn_fence(__ATOMIC_ACQUIRE, "agent");
            asm volatile("s_waitcnt vmcnt(0)" ::: "memory");
        }
    }
    __syncthreads();
}
#ifndef MK_ONE_LAUNCH
#define MK_ONE_LAUNCH 1
#endif
constexpr int N_PHASES = 11;
__global__ void __launch_bounds__(NTHR, 2) mega(Params Pkernarg) {
    extern __shared__ __attribute__((aligned(16))) unsigned char lds_raw[];
    LAS unsigned char* lds = (LAS unsigned char*)lds_raw;
    const int tid = ltid();
    const int G = gridDim.x, bx = blockIdx.x; const int vcu = (G % 8 == 0) ? (bx % 8) * (G / 8) + bx / 8 : bx;
    for (int u = tid; u < (LDS_BYTES - LDSCTL_OFF) / 4; u += NTHR) ((LAS unsigned*)(lds + LDSCTL_OFF))[u] = 0u;
    __syncthreads();
#if MK_ONE_LAUNCH
    XcdBarrier bar = xcd_barrier_post((unsigned*)(params_ptr()->ws + WS_CTL) + CW_BAR + params_ptr()->bar_li * XCD_BAR_WORDS, (volatile LAS unsigned*)(lds + MISC_OFF) + 8);
#define GRID_BAR() xcd_barrier(bar)
#else
#define GRID_BAR() do {} while (0)
#endif
#ifndef PHOFF
#define PHOFF 0
#endif
#define IN(k) (!((PHOFF >> (k)) & 1))
#define BOTH(k) (IN(k) && IN((k) + 1))
    if (IN(0)) { KP P = *params_ptr(); phase_prologue(P, lds, vcu, G); prologue_subkeys(P, vcu, G); prologue_lora(P, vcu, G); if (BOTH(0)) GRID_BAR(); }
    if (IN(1)) { KP P = *params_ptr();
        pg8::Gemm g{(const bf16*)(P.ws + WS_XN), (const bf16*)(P.ws + WS_WIN), TT, INCP, DM}; pg8::StaticOrder S; S.init(TT, INCP, G, bx);
        pg8::EpiBf16<0> E{(bf16*)(P.ws + WS_PROJ), INCP, nullptr, 0, 0, 1.f};
        pg8::gemm_phase<pg8::EpiBf16<0>, pg8::StaticOrder, true, true>(lds, g, S, E);
        phase_convert_tables(P, lds);
        if (BOTH(1)) GRID_BAR();
    }
    if (IN(2)) { KP P = *params_ptr(); phase_act(P, vcu, G); phase_kmean(P, lds, vcu, G); if (BOTH(2)) GRID_BAR(); }
    if (IN(3)) { KP P = *params_ptr(); phase_rwkv_stage_a(P, lds, vcu, G); if (BOTH(3)) GRID_BAR(); }
    if (IN(4)) { KP P = *params_ptr(); if ((vcu & 15) < 2 && vcu < 256) rwkv_stage_b(P, lds, (vcu >> 4) * 2 + (vcu & 15)); phase_moba(P, (char*)lds_raw, vcu, G); }
    if (IN(5)) { GRID_BAR(); KP P = *params_ptr(); moba_combine(P, vcu, G); GRID_BAR(); }
    if (IN(6)) { KP P = *params_ptr();
        pg8::Gemm g{(const bf16*)(P.ws + WS_AR), (const bf16*)(P.ws + WS_WOUT), TT, DM, DM}; pg8::StaticOrder S; S.init(TT, DM, G, bx);
        pg8::EpiH E{P.x, (bf16*)(P.ws + WS_XN), (float*)(P.ws + WS_SSP), DM};
        pg8::gemm_phase<pg8::EpiH, pg8::StaticOrder, true, true>(lds, g, S, E);
        if (BOTH(6)) GRID_BAR();
    }
    if (IN(8)) { KP P = *params_ptr(); phase_rstd(P, vcu, G); GRID_BAR();
        pg8::Gemm g{(const bf16*)(P.ws + WS_XN), (const bf16*)(P.ws + WS_WQ), TT, DM, DM}; pg8::StaticOrder S; S.init(TT, DM, G, bx);
        pg8::EpiBf16Row E{(bf16*)(P.ws + WS_PROJ), DM, (const float*)(P.ws + WS_SSP + 2 * MiB)};
        pg8::gemm_phase<pg8::EpiBf16Row, pg8::StaticOrder, true, true>(lds, g, S, E);
        if (G == 256) { const int wg_ = (bx & 7) * 32 + (bx >> 3); pg8::Unit u; u.pm = (wg_ >> 6) * 8 + (wg_ & 7); u.pn = (wg_ & 63) >> 3;
            asm volatile("s_waitcnt vmcnt(0)" ::: "memory"); __syncthreads(); __builtin_amdgcn_fence(__ATOMIC_ACQUIRE, "agent"); asm volatile("s_waitcnt vmcnt(0)" ::: "memory");
            peer_route_tiles(P, lds, 4 * u.pm, 4, u.pn);
        } else if (G != 256) { GRID_BAR(); for (int item = vcu; item < 1024; item += G) peer_route_tiles(P, lds, item >> 3, 1, item & 7); }
        if (BOTH(8)) GRID_BAR();
    }
    if (IN(10)) { KP P = *params_ptr(); phase_peer_sliced(P, lds, bx, G); }
#undef IN
#undef BOTH
}

extern "C" void kernel_launch(void* const* d_in, const int* in_sizes, int n_in, void* d_out, int out_size, void* d_ws, size_t ws_size, hipStream_t stream) {
    static int grid = 0;
    if (grid == 0) {
        if (n_in != 21 || in_sizes[0] != TT * DM || out_size != TT * DM || ws_size < WS_END) {
            fprintf(stderr, "kernel_launch: unexpected shapes: n_in %d in0 %d out %d ws %zu\n", n_in, n_in > 0 ? in_sizes[0] : -1, out_size, ws_size); grid = -1; return; }
        int dev = 0, cus = 0;
        if (hipGetDevice(&dev) != hipSuccess || hipDeviceGetAttribute(&cus, hipDeviceAttributeMultiprocessorCount, dev) != hipSuccess) { grid = -1; return; }
        if (hipFuncSetAttribute((const void*)mega, hipFuncAttributeMaxDynamicSharedMemorySize, LDS_BYTES) != hipSuccess) { fprintf(stderr, "kernel_launch: hipFuncSetAttribute failed\n"); grid = -1; return; }
        int per_cu = 0;
        if (hipOccupancyMaxActiveBlocksPerMultiprocessor(&per_cu, (const void*)mega, NTHR, LDS_BYTES) != hipSuccess || per_cu < 1) fprintf(stderr, "kernel_launch: occupancy query says %d blocks per CU\n", per_cu);
        (void)hipGetLastError();
        grid = cus;
    }
    if (grid < 0) return;
    (void)hipMemsetAsync((char*)d_ws + WS_CTL, 0, CTL_ZERO_BYTES, stream);
    Params p{};
    p.x = (const float*)d_in[0]; p.norm1_g = (const float*)d_in[1]; p.w_in = (const float*)d_in[2]; p.mu = (const float*)d_in[3]; p.w0 = (const float*)d_in[4];
    p.w2 = (const float*)d_in[5]; p.a0 = (const float*)d_in[6]; p.a2 = (const float*)d_in[7]; p.g2 = (const float*)d_in[8]; p.k_k = (const float*)d_in[9];
    p.k_a = (const float*)d_in[10]; p.r_k = (const float*)d_in[11]; p.ln_g = (const float*)d_in[12]; p.ln_b = (const float*)d_in[13]; p.w_out = (const float*)d_in[14];
    p.norm2_g = (const float*)d_in[15]; p.wq = (const float*)d_in[16]; p.sub_keys = (const float*)d_in[17]; p.pu = (const float*)d_in[18]; p.pv = (const float*)d_in[19];
    p.final_g = (const float*)d_in[20]; p.out = (float*)d_out; p.ws = (unsigned char*)d_ws;
    p.ph_lo = 0; p.ph_hi = N_PHASES; p.bar_li = 0;
    hipLaunchKernelGGL(mega, dim3(grid), dim3(NTHR), LDS_BYTES, stream, p);
}
```

```cpp
#include <hip/hip_runtime.h>
#include <cstdio>
#include <cstdint>
__device__ __forceinline__ int ltid() { int t = threadIdx.x; asm volatile("" : "+v"(t)); return t; }
namespace pg8 {
#define PG8_LAS __attribute__((address_space(3)))
typedef unsigned short bf16_t;
typedef short bf16x8 __attribute__((ext_vector_type(8)));
typedef float f32x4 __attribute__((ext_vector_type(4)));
typedef unsigned u32x4 __attribute__((ext_vector_type(4)));
constexpr int BM = 256, BK = 64, HALF = 128, HTB = HALF * BK * 2  , STAGE_BYTES = 8 * HTB, NXCD = 8, WGM = 8;

__host__ __device__ __forceinline__ int lds_byte(int r, int c) { const int st = (r >> 4) * 2 + (c >> 5), rr = r & 15, cc = c & 31, ob = rr * 64 + cc * 2; return st * 1024 + (ob ^ (((ob >> 9) & 1) << 5)); }
__host__ __device__ __forceinline__ void stage_rc(int b, int& R, int& C) { const int st = b / 1024, sb = b % 1024, swz = sb ^ (((sb >> 9) & 1) << 5); R = (st >> 1) * 16 + swz / 64; C = (st & 1) * 32 + (swz % 64) / 2; }
__host__ __device__ __forceinline__ int perm32(int rho) { const int n = rho >> 4, i = rho & 15; return 8 * (i >> 2) + 4 * n + (i & 3); }

struct Unit { int pm, pn; };
struct Gemm { const bf16_t* A; const bf16_t* Bt; int M, N, K; };

struct StaticOrder {
    int nM, nN, nwg, G, c;
    __host__ __device__ void init(int M, int N, int G_, int c_) { nM = M / BM; nN = N / BM; nwg = nM * nN; G = G_; c = c_; }
    __host__ __device__ bool next(int i, Unit& u) const {
        const long L = (long)i * G + c; if (L >= nwg) return false;
        int wgid = (int)L; { const int q = nwg / NXCD, r = nwg % NXCD, xcd = wgid % NXCD, off = wgid / NXCD; wgid = (xcd < r ? xcd * (q + 1) : r * (q + 1) + (xcd - r) * q) + off; }
        const int nig = WGM * nN, gid = wgid / nig, fm = gid * WGM, gsz = (nM - fm) < WGM ? (nM - fm) : WGM;
        u.pm = fm + ((wgid % nig) % gsz); u.pn = (wgid % nig) / gsz; return true;
    }
    __device__ __forceinline__ void a_ready(const Unit&) const {}
    __device__ __forceinline__ void done(const Unit&) const {}
};

__device__ __forceinline__ unsigned cvt_pk_bf16(float lo, float hi) { unsigned r; asm volatile("v_cvt_pk_bf16_f32 %0, %1, %2" : "=v"(r) : "v"(lo), "v"(hi)); return r; }
typedef float f32x2 __attribute__((ext_vector_type(2)));
__device__ __forceinline__ f32x2 gelu_pk(f32x2 v) {
    const f32x2 av = __builtin_elementwise_abs(v), d = av * 0.2316418882f + 1.0f;
    f32x2 t; t.x = __builtin_amdgcn_rcpf(d.x); t.y = __builtin_amdgcn_rcpf(d.y);
    f32x2 q = t * 0.5307027145f + (-0.7265760135f); q = q * t + 0.7107068705f; q = q * t + (-0.142248368f); q = q * t + 0.127414796f; q = q * t;
    const f32x2 s = (v * v) * (-0.72134752044f);
    f32x2 e; e.x = __builtin_amdgcn_exp2f(s.x); e.y = __builtin_amdgcn_exp2f(s.y);
    const f32x2 m = v * (q * e), r = v - m;
    f32x2 o; o.x = v.x < 0.f ? m.x : r.x; o.y = v.y < 0.f ? m.y : r.y; return o;
}

template <int ACT  > struct EpiBf16 {
    static constexpr bool PERM = true, AFTER_DRAIN = false; static_assert(ACT == 0 || ACT == 1, "EpiBf16: ACT is 0 (none) or 1 (gelu_pk)");
    bf16_t* O; int ldc; const float* bias; int split_cols; size_t split_stride; float scale0;
    __device__ __forceinline__ void operator()(const f32x4 (&acc)[2][2][4][2], const Unit& u, int wr, int wc, int fr, int fq) const {
        const int row0 = u.pm * BM + wr * 64 + fr; int colt = u.pn * BM; bf16_t* base = O;
        float sc = 1.f; if (split_cols) { const int t = colt / split_cols; base += (size_t)t * split_stride; colt -= t * split_cols; if (t == 0) sc = scale0; }
        const int col0 = colt + wc * 32 + 8 * fq, bcol0 = u.pn * BM + wc * 32 + 8 * fq;
        f32x4 bv[2][2];
#pragma unroll
        for (int bj = 0; bj < 2; ++bj)
#pragma unroll
            for (int n = 0; n < 2; ++n) bv[bj][n] = bias ? *(const f32x4*)(bias + bcol0 + bj * HALF + 4 * n) : (f32x4){0.f, 0.f, 0.f, 0.f};
#pragma unroll
        for (int ai = 0; ai < 2; ++ai)
#pragma unroll
            for (int m = 0; m < 4; ++m) { bf16_t* rowp = base + (size_t)(row0 + ai * HALF + m * 16) * ldc + col0;
#pragma unroll
                for (int bj = 0; bj < 2; ++bj) { f32x4 v0 = acc[ai][bj][m][0] + bv[bj][0], v1 = acc[ai][bj][m][1] + bv[bj][1];
                    if (ACT == 1) { f32x2 a = gelu_pk((f32x2){v0[0], v0[1]}), b = gelu_pk((f32x2){v0[2], v0[3]}), c = gelu_pk((f32x2){v1[0], v1[1]}), d = gelu_pk((f32x2){v1[2], v1[3]});
                        v0 = (f32x4){a.x, a.y, b.x, b.y}; v1 = (f32x4){c.x, c.y, d.x, d.y}; }
                    v0 = v0 * sc; v1 = v1 * sc; u32x4 w; w.x = cvt_pk_bf16(v0[0], v0[1]); w.y = cvt_pk_bf16(v0[2], v0[3]); w.z = cvt_pk_bf16(v1[0], v1[1]); w.w = cvt_pk_bf16(v1[2], v1[3]);
                    *(u32x4*)(rowp + bj * HALF) = w; } }
    }
};
template <class Epi, class Sched, bool ALIGN_EPI = false, bool SP2 = false>
__device__ __forceinline__ void gemm_phase(PG8_LAS unsigned char* lds, const Gemm g, const Sched& S, const Epi& E) {
    const int tid = ltid(), wid = __builtin_amdgcn_readfirstlane(tid >> 6), lane = tid & 63, wr = wid >> 2, wc = wid & 3, fr = lane & 15, fq = lane >> 4;
    const int K = g.K, nt = K / BK;
    unsigned voffA[2], voffB[2];
#pragma unroll
    for (int i = 0; i < 2; ++i) { int R, C; stage_rc(tid * 16 + i * 8192, R, C); const int Rb = Epi::PERM ? ((R & ~31) + perm32(R & 31)) : R;
        voffA[i] = (unsigned)(R * K + C) * 2u; voffB[i] = (unsigned)(Rb * K + C) * 2u; }
    const size_t kstep = (size_t)(BK * 2);
    const size_t hstep = (size_t)HALF * K * 2;
    const size_t tstep = 2 * hstep;
    const unsigned ldsw = (unsigned)wid * 1024u;
    const int aoff = lds_byte(wr * 64 + fr, fq * 8), boff = lds_byte(wc * 32 + fr, fq * 8);
#define PG8_SA(b, h) (((b) * 2 + (h)) * HTB)
#define PG8_SB(b, h) ((4 + (b) * 2 + (h)) * HTB)
#define PG8_STAGE(bufoff, gbase, voff) do { _Pragma("unroll") for (int _i = 0; _i < 2; ++_i) \
        __builtin_amdgcn_global_load_lds((const unsigned*)((const char*)(gbase) + (voff)[_i]), (PG8_LAS unsigned*)(lds + (bufoff) + ldsw + _i * 8192), 16, 0, 0); } while (0)
#define PG8_LDA(dst, b, h) do { _Pragma("unroll") for (int m = 0; m < 4; ++m) _Pragma("unroll") for (int k = 0; k < 2; ++k) dst[m][k] = *(const PG8_LAS bf16x8*)(lds + PG8_SA(b, h) + aoff + m * 2048 + k * 1024); } while (0)
#define PG8_LDB(dst, b, h) do { _Pragma("unroll") for (int n = 0; n < 2; ++n) _Pragma("unroll") for (int k = 0; k < 2; ++k) dst[n][k] = *(const PG8_LAS bf16x8*)(lds + PG8_SB(b, h) + boff + n * 2048 + k * 1024); } while (0)
#define PG8_MMA(ai, bj, At, Bt) do { __builtin_amdgcn_s_setprio(1); _Pragma("unroll") for (int m = 0; m < 4; ++m) _Pragma("unroll") for (int n = 0; n < 2; ++n) _Pragma("unroll") for (int k = 0; k < 2; ++k) \
        acc[ai][bj][m][n] = __builtin_amdgcn_mfma_f32_16x16x32_bf16(Bt[n][k], At[m][k], acc[ai][bj][m][n], 0, 0, 0); __builtin_amdgcn_s_setprio(0); } while (0)
#define PG8_WAIT_V(n) asm volatile("s_waitcnt vmcnt(" #n ")" ::: "memory")
#define PG8_WAIT_L(n) asm volatile("s_waitcnt lgkmcnt(" #n ")" ::: "memory")
#define PG8_BAR __builtin_amdgcn_s_barrier()
#define PG8_SCHED __builtin_amdgcn_sched_barrier(0)
    Unit cur, nxt; int ui = 0;
    if (!S.next(0, cur)) return;
    f32x4 acc[2][2][4][2];
#pragma unroll
    for (int a = 0; a < 2; ++a)
#pragma unroll
        for (int b = 0; b < 2; ++b)
#pragma unroll
            for (int m = 0; m < 4; ++m)
#pragma unroll
                for (int n = 0; n < 2; ++n) acc[a][b][m][n] = (f32x4){0.f, 0.f, 0.f, 0.f};
    bf16x8 At[4][2], B0[2][2], B1[2][2];
    const char* cA = (const char*)g.A + (size_t)cur.pm * tstep; const char* cB = (const char*)g.Bt + (size_t)cur.pn * tstep;
    S.a_ready(cur);
    if constexpr (SP2) {
        PG8_STAGE(PG8_SB(0, 0), cB, voffB); PG8_STAGE(PG8_SB(0, 1), cB + hstep, voffB); PG8_STAGE(PG8_SA(0, 0), cA, voffA); PG8_STAGE(PG8_SA(0, 1), cA + hstep, voffA);
        if (wr == 1) PG8_BAR;
        PG8_WAIT_V(2); PG8_BAR;
        PG8_STAGE(PG8_SB(1, 0), cB + kstep, voffB); PG8_STAGE(PG8_SA(1, 0), cA + kstep, voffA); PG8_STAGE(PG8_SB(1, 1), cB + hstep + kstep, voffB);
        PG8_WAIT_V(6); PG8_BAR;
    } else {
        PG8_STAGE(PG8_SB(0, 0), cB, voffB); PG8_STAGE(PG8_SA(0, 0), cA, voffA); PG8_STAGE(PG8_SB(0, 1), cB + hstep, voffB); PG8_STAGE(PG8_SA(0, 1), cA + hstep, voffA);
        if (wr == 1) PG8_BAR;
        PG8_WAIT_V(4); PG8_BAR;
        PG8_STAGE(PG8_SB(1, 0), cB + kstep, voffB); PG8_STAGE(PG8_SA(1, 0), cA + kstep, voffA); PG8_STAGE(PG8_SB(1, 1), cB + hstep + kstep, voffB);
        PG8_WAIT_V(6); PG8_BAR;
    }
    for (;;) {
        const bool has_next = S.next(ui + 1, nxt);
        const char* nA = has_next ? (const char*)g.A + (size_t)nxt.pm * tstep : cA; const char* nB = has_next ? (const char*)g.Bt + (size_t)nxt.pn * tstep : cB;
        for (int t = 0; t < nt; t += 2) {
            const bool last = (t == nt - 2);
            const char* a1 = cA + (size_t)(t + 1) * kstep;
            const char* a2 = last ? nA : cA + (size_t)(t + 2) * kstep; const char* b2 = last ? nB : cB + (size_t)(t + 2) * kstep;
            const char* a3 = a2 + kstep; const char* b3 = b2 + kstep;
            if (last && has_next) S.a_ready(nxt);
            if constexpr (SP2) {
            PG8_LDB(B0, 0, 0); PG8_LDB(B1, 0, 1); PG8_SCHED; PG8_LDA(At, 0, 0); PG8_STAGE(PG8_SA(1, 1), a1 + hstep, voffA);
            PG8_WAIT_V(8); PG8_WAIT_L(0); PG8_BAR; PG8_MMA(0, 0, At, B0); PG8_MMA(0, 1, At, B1); PG8_BAR; PG8_SCHED;
            PG8_LDA(At, 0, 1); PG8_STAGE(PG8_SB(0, 0), b2, voffB); PG8_STAGE(PG8_SB(0, 1), b2 + hstep, voffB); PG8_STAGE(PG8_SA(0, 0), a2, voffA);
            PG8_WAIT_V(8); PG8_WAIT_L(0); PG8_BAR; PG8_MMA(1, 0, At, B0); PG8_MMA(1, 1, At, B1); PG8_BAR; PG8_SCHED;
            PG8_LDB(B0, 1, 0); PG8_LDB(B1, 1, 1); PG8_SCHED; PG8_LDA(At, 1, 0); PG8_STAGE(PG8_SA(0, 1), a2 + hstep, voffA);
            PG8_WAIT_V(8); PG8_WAIT_L(0); PG8_BAR; PG8_MMA(0, 0, At, B0); PG8_MMA(0, 1, At, B1); PG8_BAR; PG8_SCHED;
            PG8_LDA(At, 1, 1); PG8_STAGE(PG8_SB(1, 0), b3, voffB); PG8_STAGE(PG8_SB(1, 1), b3 + hstep, voffB); PG8_STAGE(PG8_SA(1, 0), a3, voffA);
            PG8_WAIT_V(8); PG8_WAIT_L(0); PG8_BAR; PG8_MMA(1, 0, At, B0); PG8_MMA(1, 1, At, B1); PG8_BAR; PG8_SCHED;
            } else {
            PG8_LDB(B0, 0, 0); PG8_SCHED; PG8_LDA(At, 0, 0); PG8_STAGE(PG8_SA(1, 1), a1 + hstep, voffA);
            PG8_WAIT_L(8); PG8_BAR; PG8_WAIT_L(0); PG8_MMA(0, 0, At, B0); PG8_BAR; PG8_SCHED;
            PG8_LDB(B1, 0, 1); PG8_STAGE(PG8_SB(0, 0), b2, voffB);
            PG8_BAR; PG8_WAIT_L(0); PG8_MMA(0, 1, At, B1); PG8_BAR;
            PG8_LDA(At, 0, 1); PG8_STAGE(PG8_SA(0, 0), a2, voffA);
            PG8_BAR; PG8_WAIT_L(0); PG8_MMA(1, 0, At, B0); PG8_BAR; PG8_SCHED;
            PG8_STAGE(PG8_SB(0, 1), b2 + hstep, voffB);
            PG8_WAIT_V(6); PG8_BAR; PG8_MMA(1, 1, At, B1); PG8_BAR;
            PG8_LDB(B0, 1, 0); PG8_SCHED; PG8_LDA(At, 1, 0); PG8_STAGE(PG8_SA(0, 1), a2 + hstep, voffA);
            PG8_WAIT_L(8); PG8_BAR; PG8_WAIT_L(0); PG8_MMA(0, 0, At, B0); PG8_BAR; PG8_SCHED;
            PG8_LDB(B1, 1, 1); PG8_STAGE(PG8_SB(1, 0), b3, voffB);
            PG8_BAR; PG8_WAIT_L(0); PG8_MMA(0, 1, At, B1); PG8_BAR;
            PG8_LDA(At, 1, 1); PG8_STAGE(PG8_SA(1, 0), a3, voffA);
            PG8_BAR; PG8_WAIT_L(0); PG8_MMA(1, 0, At, B0); PG8_BAR; PG8_SCHED;
            PG8_STAGE(PG8_SB(1, 1), b3 + hstep, voffB);
            PG8_WAIT_V(6); PG8_BAR; PG8_MMA(1, 1, At, B1); PG8_BAR;
            }
        }
        if constexpr (ALIGN_EPI) { if (wr == 0) PG8_BAR; }
        if constexpr (!Epi::AFTER_DRAIN) { E(acc, cur, wr, wc, fr, fq); S.done(cur); }
        if (!has_next) break;
#pragma unroll
        for (int a = 0; a < 2; ++a)
#pragma unroll
            for (int b = 0; b < 2; ++b)
#pragma unroll
                for (int m = 0; m < 4; ++m)
#pragma unroll
                    for (int n = 0; n < 2; ++n) acc[a][b][m][n] = (f32x4){0.f, 0.f, 0.f, 0.f};
        cur = nxt; cA = nA; cB = nB; ++ui;
        if constexpr (ALIGN_EPI) { if (wr == 1) PG8_BAR; }
    }
    PG8_WAIT_V(0);
    if constexpr (!ALIGN_EPI) { if (wr == 0) PG8_BAR; }
    PG8_BAR;
    if constexpr (Epi::AFTER_DRAIN) { E.fused(acc, cur, wr, wc, fr, fq, lds, wid, lane); S.done(cur); }
#undef PG8_SA
#undef PG8_SB
#undef PG8_STAGE
#undef PG8_LDA
#undef PG8_LDB
#undef PG8_MMA
#undef PG8_WAIT_V
#undef PG8_WAIT_L
#undef PG8_BAR
#undef PG8_SCHED
}
}
#define GAS __attribute__((address_space(1)))
#define LAS __attribute__((address_space(3)))
typedef unsigned short bf16;
typedef unsigned v4u __attribute__((ext_vector_type(4)));
typedef unsigned v2u __attribute__((ext_vector_type(2)));
typedef float f32x4 __attribute__((ext_vector_type(4)));
constexpr int NWAVES = 8, NTHR = 512;
constexpr int TT = 8192, DM = 2048, SEQ = 4096;
constexpr int INC = 6592, INCP = 6656;
constexpr int C_AK = 1024, C_AV = 2048, C_RW = 3072;
constexpr int RWC = 3520;
constexpr float RMS_EPS = 1e-6f;
constexpr size_t MiB = 1u << 20;
constexpr size_t WS_CTL = 0, CTL_ZERO_BYTES = 1 * MiB;
constexpr size_t WS_WIN = 1 * MiB;
constexpr size_t WS_WOUT = 27 * MiB;
constexpr size_t WS_WQ = 35 * MiB;
constexpr size_t WS_XN = 43 * MiB;
constexpr size_t WS_PROJ = 75 * MiB;
constexpr size_t WS_AR = 179 * MiB;
constexpr size_t WS_H = 211 * MiB;
constexpr size_t WS_RWA = 275 * MiB;
constexpr size_t WS_CHK = 339 * MiB;
constexpr size_t WS_KMEAN = 467 * MiB;
constexpr size_t WS_ACT = WS_H;
constexpr size_t WS_SSP = WS_WIN + 4 * MiB;
constexpr size_t WS_LORA = 468 * MiB;
constexpr size_t WS_END = 469 * MiB;
constexpr int CW_BAR = 4096, CW_MOBA_CTR = 16384, CW_SS = 32768;
constexpr int RING_BYTES = 147456, LDSCTL_OFF = RING_BYTES, MISC_OFF = LDSCTL_OFF + 320, LDS_BYTES = 163840;

struct Params {
    const float* x; const float* norm1_g; const float* w_in; const float* mu; const float* w0; const float* w2; const float* a0; const float* a2; const float* g2;
    const float* k_k; const float* k_a; const float* r_k; const float* ln_g; const float* ln_b; const float* w_out; const float* norm2_g; const float* wq;
    const float* sub_keys; const float* pu; const float* pv; const float* final_g;
    float* out; unsigned char* ws;
    int ph_lo, ph_hi, bar_li, pad;
};

typedef const __attribute__((address_space(4))) Params& KP;
__device__ __forceinline__ const __attribute__((address_space(4))) Params* params_ptr() {
    const __attribute__((address_space(4))) Params* ka = (const __attribute__((address_space(4))) Params*)__builtin_amdgcn_kernarg_segment_ptr(); asm volatile("" : "+s"(ka)); return ka; }
typedef float f32x2_t __attribute__((ext_vector_type(2))); typedef __bf16 bf16x2_t __attribute__((ext_vector_type(2)));
__device__ __forceinline__ unsigned pk2(float lo, float hi) { const f32x2_t v = {lo, hi}; const bf16x2_t b = __builtin_convertvector(v, bf16x2_t); return __builtin_bit_cast(unsigned, b); }
__device__ __forceinline__ unsigned f2bf(float f) { return pk2(f, 0.f) & 0xffffu; }
__device__ __forceinline__ float bf2f(bf16 v) { return __builtin_bit_cast(float, (unsigned)v << 16); }
__device__ __forceinline__ float bflo(unsigned u) { return __builtin_bit_cast(float, u << 16); }
__device__ __forceinline__ float bfhi(unsigned u) { return __builtin_bit_cast(float, u & 0xffff0000u); }
#define DPP_F(v, ctrl) __builtin_bit_cast(float, __builtin_amdgcn_update_dpp(0, __builtin_bit_cast(int, (v)), (ctrl), 0xf, 0xf, true))
__device__ __forceinline__ float wave_sum(float v) {
    v += DPP_F(v, 0xB1);
    v += DPP_F(v, 0x4E);
    v += DPP_F(v, 0x141);
    v += DPP_F(v, 0x140);
    const int b = __builtin_bit_cast(int, v);
    return (__builtin_bit_cast(float, __builtin_amdgcn_readlane(b, 0)) + __builtin_bit_cast(float, __builtin_amdgcn_readlane(b, 16))) +
           (__builtin_bit_cast(float, __builtin_amdgcn_readlane(b, 32)) + __builtin_bit_cast(float, __builtin_amdgcn_readlane(b, 48)));
}
__device__ __forceinline__ float wave_max(float v) {
#pragma unroll
    for (int o = 1; o < 64; o <<= 1) v = fmaxf(v, __shfl_xor(v, o));
    return v;
}
#define LDS_WAIT() asm volatile("s_waitcnt lgkmcnt(0)" ::: "memory")

__device__ __forceinline__ void p0_transpose_item(const float* W, int K, int N, bf16* WT, LAS float* scr, int item, int lane, const float* ksc = nullptr) {
    const int nblk = N / 32, kb = item / nblk, nb = item % nblk, k0 = 64 * kb, n0 = 32 * nb;
#pragma unroll 8
    for (int i = 0; i < 32; ++i) { const int kk = 2 * i + (lane >> 5); float wv = W[(size_t)(k0 + kk) * N + n0 + (lane & 31)]; if (ksc) wv *= ksc[k0 + kk]; scr[kk * 33 + (lane & 31)] = wv; }
    LDS_WAIT(); asm volatile("" ::: "memory");
    const int c = lane & 7;
#pragma unroll
    for (int j = 0; j < 4; ++j) { const int n = (lane >> 3) + 8 * j; const LAS float* s = scr + (8 * c) * 33 + n;
        v4u o; o.x = pk2(s[0 * 33], s[1 * 33]); o.y = pk2(s[2 * 33], s[3 * 33]); o.z = pk2(s[4 * 33], s[5 * 33]); o.w = pk2(s[6 * 33], s[7 * 33]);
        *(v4u*)(WT + (size_t)(n0 + n) * K + k0 + 8 * c) = o; }
    LDS_WAIT(); asm volatile("" ::: "memory");
}
__device__ __forceinline__ void rms_row_to_bf16(const float* xrow, const float* g, bf16* orow, int lane) {
    const f32x4* xr = (const f32x4*)xrow + lane;
    f32x4 v[8]; float s = 0.f;
#pragma unroll
    for (int j = 0; j < 8; ++j) { v[j] = xr[64 * j]; s += (v[j].x * v[j].x + v[j].y * v[j].y) + (v[j].z * v[j].z + v[j].w * v[j].w); }
    const float rs = 1.0f / sqrtf(wave_sum(s) * (1.f / DM) + RMS_EPS);
    v2u* o8 = (v2u*)orow + lane;
#pragma unroll
    for (int j = 0; j < 8; ++j) { const f32x4 gg = ((const f32x4*)g)[lane + 64 * j];
        v2u o; o.x = pk2(v[j].x * rs * gg.x, v[j].y * rs * gg.y); o.y = pk2(v[j].z * rs * gg.z, v[j].w * rs * gg.w); o8[64 * j] = o; }
}
__device__ __forceinline__ void phase_prologue(KP P, LAS unsigned char* lds, int vcu, int G) {
    const int tid = ltid(), lane = tid & 63, wave = tid >> 6;
    LAS float* scr = (LAS float*)(lds + wave * 16384);
    const int gw = vcu * NWAVES + wave, NGW = G * NWAVES;
    bf16* WIN = (bf16*)(P.ws + WS_WIN); bf16* WOUT = (bf16*)(P.ws + WS_WOUT); bf16* WQ = (bf16*)(P.ws + WS_WQ); bf16* XN = (bf16*)(P.ws + WS_XN);
    constexpr int I_IN = (DM / 64) * (INC / 32), I_SQ = (DM / 64) * (DM / 32);
    for (int it = gw; it < I_IN + 2 * I_SQ; it += NGW) {
        int r = it;
        if (r < I_IN) { p0_transpose_item(P.w_in, DM, INC, WIN, scr, r, lane); continue; } r -= I_IN;
        if (r < I_SQ) { p0_transpose_item(P.w_out, DM, DM, WOUT, scr, r, lane); continue; } r -= I_SQ;
        p0_transpose_item(P.wq, DM, DM, WQ, scr, r, lane, P.norm2_g);
    }
    for (int i = vcu * NTHR + tid; i < (INCP - INC) * DM / 8; i += G * NTHR) ((v4u*)(WIN + (size_t)INC * DM))[i] = (v4u){0u, 0u, 0u, 0u};
    for (int m = gw; m < TT; m += NGW) rms_row_to_bf16(P.x + (size_t)m * DM, P.norm1_g, XN + (size_t)m * DM, lane);
}

namespace pg8 {
struct EpiF32 {
    static constexpr bool PERM = false, AFTER_DRAIN = false;
    const float* base; float* out; int ldc;
    __device__ __forceinline__ void operator()(const f32x4 (&acc)[2][2][4][2], const Unit& u, int wr, int wc, int fr, int fq) const {
        const int col0 = u.pn * BM + wc * 32 + 4 * fq;
#pragma unroll
        for (int ai = 0; ai < 2; ++ai)
#pragma unroll
            for (int m = 0; m < 4; ++m) { const int r = ai * HALF + wr * 64 + m * 16 + fr; const size_t off = (size_t)(u.pm * BM + r) * ldc + col0;
#pragma unroll
                for (int bj = 0; bj < 2; ++bj)
#pragma unroll
                    for (int n = 0; n < 2; ++n) { f32x4 o = acc[ai][bj][m][n]; if (base) o = o + *(const f32x4*)(base + off + bj * HALF + n * 16);
                        *(f32x4*)(out + off + bj * HALF + n * 16) = o; } }
    }
};
struct EpiH {
    static constexpr bool PERM = false, AFTER_DRAIN = false;
    const float* base; bf16* outb; float* ss; int ldc;
    __device__ __forceinline__ void operator()(const f32x4 (&acc)[2][2][4][2], const Unit& u, int wr, int wc, int fr, int fq) const {
        const int col0 = u.pn * BM + wc * 32 + 4 * fq;
#pragma unroll
        for (int ai = 0; ai < 2; ++ai) {
            f32x4 xv[4][2][2];
#pragma unroll
            for (int m = 0; m < 4; ++m) { const size_t off = (size_t)(u.pm * BM + ai * HALF + wr * 64 + m * 16 + fr) * ldc + col0;
#pragma unroll
                for (int bj = 0; bj < 2; ++bj)
#pragma unroll
                    for (int n = 0; n < 2; ++n) xv[m][bj][n] = *(const f32x4*)(base + off + bj * HALF + n * 16); }
#pragma unroll
            for (int m = 0; m < 4; ++m) { const int r = ai * HALF + wr * 64 + m * 16 + fr; const size_t off = (size_t)(u.pm * BM + r) * ldc + col0; float sq = 0.f;
#pragma unroll
                for (int bj = 0; bj < 2; ++bj)
#pragma unroll
                    for (int n = 0; n < 2; ++n) { const f32x4 o = acc[ai][bj][m][n] + xv[m][bj][n];
                        *(v2u*)(outb + off + bj * HALF + n * 16) = (v2u){pk2(o.x, o.y), pk2(o.z, o.w)};
                        sq += (o.x * o.x + o.y * o.y) + (o.z * o.z + o.w * o.w); }
                sq += __shfl_xor(sq, 16); sq += __shfl_xor(sq, 32);
                if (fq == 0) ss[(size_t)(u.pm * BM + r) * 32 + u.pn * 4 + wc] = sq; }
        }
    }
};
struct EpiBf16Row {
    static constexpr bool PERM = true, AFTER_DRAIN = false;
    bf16_t* O; int ldc; const float* rs;
    __device__ __forceinline__ void operator()(const f32x4 (&acc)[2][2][4][2], const Unit& u, int wr, int wc, int fr, int fq) const {
        const int row0 = u.pm * BM + wr * 64 + fr, col0 = u.pn * BM + wc * 32 + 8 * fq;
        float scv[2][4];
#pragma unroll
        for (int ai = 0; ai < 2; ++ai)
#pragma unroll
            for (int m = 0; m < 4; ++m) scv[ai][m] = rs[row0 + ai * HALF + m * 16];
#pragma unroll
        for (int ai = 0; ai < 2; ++ai)
#pragma unroll
            for (int m = 0; m < 4; ++m) { const int row = row0 + ai * HALF + m * 16; const float sc = scv[ai][m]; bf16_t* rowp = O + (size_t)row * ldc + col0;
#pragma unroll
                for (int bj = 0; bj < 2; ++bj) { const f32x4 v0 = acc[ai][bj][m][0] * sc, v1 = acc[ai][bj][m][1] * sc;
                    u32x4 w; w.x = cvt_pk_bf16(v0[0], v0[1]); w.y = cvt_pk_bf16(v0[2], v0[3]); w.z = cvt_pk_bf16(v1[0], v1[1]); w.w = cvt_pk_bf16(v1[2], v1[3]);
                    *(u32x4*)(rowp + bj * HALF) = w; } }
    }
};
}

__device__ __forceinline__ void phase_rstd(KP P, int vcu, int G) {
    const float* ssp = (const float*)(P.ws + WS_SSP); float* rstd = (float*)(P.ws + WS_SSP + 2 * MiB);
    for (int row = vcu * NTHR + ltid(); row < TT; row += G * NTHR) { const f32x4* sp = (const f32x4*)(ssp + (size_t)row * 32); float a = 0.f;
#pragma unroll
        for (int j = 0; j < 8; ++j) { const f32x4 v = sp[j]; a += (v.x + v.y) + (v.z + v.w); }
        rstd[row] = 1.0f / sqrtf(a * (1.f / DM) + RMS_EPS); }
}
__device__ __forceinline__ void phase_kmean(KP P, LAS unsigned char* lds, int vcu, int G) {
    const int tid = ltid(); const bf16* proj = (const bf16*)(P.ws + WS_PROJ); float* kmean = (float*)(P.ws + WS_KMEAN);
    LAS float* red = (LAS float*)lds;
    for (int item = vcu; item < 32 * 8; item += G) {
        const int bb = item >> 3, cg = item & 7;
        const int c = tid & 127, rq = tid >> 7;
        const bf16* p = proj + (size_t)(bb * 256 + rq * 64) * INCP + C_AK + cg * 128 + c;
        float s = 0.f;
        for (int r = 0; r < 64; ++r) s += bf2f(p[(size_t)r * INCP]);
        red[rq * 128 + c] = s;
        __syncthreads();
        if (tid < 128) kmean[(size_t)bb * 1024 + cg * 128 + tid] = (red[tid] + red[128 + tid] + red[256 + tid] + red[384 + tid]) * (1.f / 256.f);
        __syncthreads();
    }
}

typedef short bf16x8 __attribute__((ext_vector_type(8)));
typedef float f32x16 __attribute__((ext_vector_type(16)));
constexpr int CP = 72;
constexpr int MATB = 64 * CP * 2;
enum { M_AT = 0, M_BT = 1, M_KT = 2, M_RT = 3, M_VT = 4, M_BBT = 5, M_KBT = 6, M_LAK = 7, M_MRB = 8, M_MRK = 9, M_LAB = 10, M_AHT = 0, M_U0T = 1 };
constexpr int L_RHS = 11 * MATB;
constexpr int L_MISC = L_RHS + 32768;
constexpr int L_TB = L_MISC + 9 * 64 * 4;
constexpr int L_A_END = L_TB + 2048;
static_assert(L_A_END <= RING_BYTES, "stage A LDS");
constexpr size_t CHK_ITEM = 6 * 8192;

__device__ __forceinline__ f32x16 mm_tile(const LAS unsigned char* A, int ra, const LAS unsigned char* B, int rb, f32x16 acc, int lane, int k0 = 0, int k1 = 4) {
    const int r = lane & 31, hi = lane >> 5;
    const LAS unsigned char* ap = A + ((ra * 32 + r) * CP + 8 * hi) * 2; const LAS unsigned char* bp = B + ((rb * 32 + r) * CP + 8 * hi) * 2;
#pragma unroll
    for (int kk = 0; kk < 4; ++kk) if (kk >= k0 && kk < k1) {
        const bf16x8 a = *(const LAS bf16x8*)(ap + kk * 32), b = *(const LAS bf16x8*)(bp + kk * 32);
        acc = __builtin_amdgcn_mfma_f32_32x32x16_bf16(a, b, acc, 0, 0, 0); }
    return acc;
}
__device__ __forceinline__ int crow32(int reg, int hi) { return (reg & 3) + 8 * (reg >> 2) + 4 * hi; }

__device__ __forceinline__ void prologue_lora(KP P, int vcu, int G) {
    bf16* w2T = (bf16*)(P.ws + WS_LORA); bf16* a2T = w2T + 1024 * 96; bf16* g2T = a2T + 1024 * 96;
    for (int e = vcu * NTHR + ltid(); e < 448 * 1024; e += G * NTHR) { const int i = e >> 10, n = e & 1023;
        if (i < 96) w2T[n * 96 + i] = (bf16)f2bf(P.w2[e]); else if (i < 192) a2T[n * 96 + (i - 96)] = (bf16)f2bf(P.a2[e - 96 * 1024]); else g2T[n * 256 + (i - 192)] = (bf16)f2bf(P.g2[e - 192 * 1024]); }
}
__device__ __forceinline__ void phase_act(KP P, int vcu, int G) {
    const bf16* proj = (const bf16*)(P.ws + WS_PROJ); unsigned* act = (unsigned*)(P.ws + WS_ACT);
    for (int e = vcu * NTHR + ltid(); e < TT * 224; e += G * NTHR) { const int t = e / 224, cp = e - t * 224, cc = 2 * cp;
        const bf16* pr = proj + (size_t)t * INCP + C_RW + 3072 + cc;
        const unsigned cu = *(const unsigned*)pr; const unsigned pu = (t & (SEQ - 1)) == 0 ? 0u : *(const unsigned*)(pr - INCP);
        const float m0 = P.mu[3072 + cc], m1 = P.mu[3072 + cc + 1];
        float v0 = bflo(cu) + (bflo(pu) - bflo(cu)) * m0, v1 = bfhi(cu) + (bfhi(pu) - bfhi(cu)) * m1;
        if (cc < 96) { v0 = tanhf(v0); v1 = tanhf(v1); } else if (cc >= 192) { v0 = 1.f / (1.f + __expf(-v0)); v1 = 1.f / (1.f + __expf(-v1)); }
        act[e] = pk2(v0, v1); }
}
constexpr int ACTP = 456;
constexpr int L_WAG = 58368;
static_assert(L_WAG + 3 * 16384 <= L_MISC, "lora scratch fits below misc");
struct LoraFrags { bf16x8 f[16]; f32x4 w0[4], a0[4]; float mu_r, mu_k, mu_v, kkc, kac, rkc, lng, lnb; };
__device__ __forceinline__ LoraFrags lora_frags_load(KP P, int h, int wave, int lane) {
    const int c32 = lane & 31, hi = lane >> 5, nb = (wave & 3) >> 1; const int nrow = h * 64 + nb * 32 + c32;
    const bf16* w2T = (const bf16*)(P.ws + WS_LORA); const bf16* a2T = w2T + 1024 * 96; const bf16* g2T = a2T + 1024 * 96;
    const bf16* wp = w2T + (size_t)nrow * 96 + 8 * hi; const bf16* ap = a2T + (size_t)nrow * 96 + 8 * hi; const bf16* gp = g2T + (size_t)nrow * 256 + 8 * hi;
    LoraFrags W;
#pragma unroll
    for (int kk = 0; kk < 16; ++kk) { const bf16* src = wave < 4 ? (kk < 6 ? wp + 16 * kk : ap + 16 * ((kk - 6) % 6)) : gp + 16 * kk; W.f[kk] = *(const bf16x8*)src; }
#pragma unroll
    for (int g = 0; g < 4; ++g) { const int n0 = h * 64 + nb * 32 + 8 * g + 4 * hi; W.w0[g] = *(const f32x4*)(P.w0 + n0); W.a0[g] = *(const f32x4*)(P.a0 + n0); }
    const int col = h * 64 + lane;
    W.mu_r = P.mu[col]; W.mu_k = P.mu[1024 + col]; W.mu_v = P.mu[2048 + col]; W.kkc = P.k_k[col]; W.kac = P.k_a[col]; W.rkc = P.r_k[col]; W.lng = P.ln_g[col]; W.lnb = P.ln_b[col];
    return W;
}
__device__ __forceinline__ void rwkv_stage_a(KP P, LAS unsigned char* lds, int item, const LoraFrags& W) {
    const int tid = ltid(), lane = tid & 63, wave = __builtin_amdgcn_readfirstlane(tid >> 6);
    const int b = item >> 10, h = (item >> 6) & 15, c = item & 63;
    const int tok0 = b * SEQ + c * 64;
    const bf16* proj = (const bf16*)(P.ws + WS_PROJ);
    unsigned char* chk = P.ws + WS_CHK + (size_t)((item & 63) * 32 + (item >> 6)) * CHK_ITEM;
    LAS float* misc = (LAS float*)(lds + L_MISC);
    { const bf16* actg = (const bf16*)(P.ws + WS_ACT) + (size_t)tok0 * 448;
#pragma unroll
      for (int e = tid; e < 64 * 56; e += NTHR) { const int row = e / 56, ch = e - row * 56; *(LAS v4u*)(lds + (row * ACTP + ch * 8) * 2) = *(const v4u*)(actg + (size_t)row * 448 + ch * 8); } }
    __syncthreads();
    {
        const int c32 = lane & 31, hi = lane >> 5, qd = wave & 3, nb = qd >> 1, tb = qd & 1;
        const LAS unsigned char* actp = lds + ((tb * 32 + c32) * ACTP + 8 * hi) * 2;
        LAS float* wag = (LAS float*)(lds + L_WAG) + (tb * 32 + c32) * 64 + nb * 32;
        if (wave < 4) {
            f32x16 aw = {}, aa = {};
#pragma unroll
            for (int kk = 0; kk < 6; ++kk) {
                aw = __builtin_amdgcn_mfma_f32_32x32x16_bf16(W.f[kk], *(const LAS bf16x8*)(actp + (16 * kk) * 2), aw, 0, 0, 0);
                aa = __builtin_amdgcn_mfma_f32_32x32x16_bf16(W.f[6 + kk], *(const LAS bf16x8*)(actp + (96 + 16 * kk) * 2), aa, 0, 0, 0); }
#pragma unroll
            for (int g = 0; g < 4; ++g) { const int n0 = h * 64 + nb * 32 + 8 * g + 4 * hi;
                const f32x4 w0 = W.w0[g], a0 = W.a0[g]; f32x4 ow, oa;
#pragma unroll
                for (int e = 0; e < 4; ++e) { const float xx = w0[e] + aw[4 * g + e];
                    ow[e] = __expf(-0.6065306597126334f * __builtin_amdgcn_rcpf(1.f + __expf(-xx))); oa[e] = __builtin_amdgcn_rcpf(1.f + __expf(-(a0[e] + aa[4 * g + e]))); }
                *(LAS f32x4*)(wag + 8 * g + 4 * hi) = ow; *(LAS f32x4*)(wag + 4096 + 8 * g + 4 * hi) = oa; }
        } else {
            f32x16 ag = {};
#pragma unroll
            for (int kk = 0; kk < 16; ++kk) ag = __builtin_amdgcn_mfma_f32_32x32x16_bf16(W.f[kk], *(const LAS bf16x8*)(actp + (192 + 16 * kk) * 2), ag, 0, 0, 0);
#pragma unroll
            for (int g = 0; g < 4; ++g) *(LAS f32x4*)(wag + 8192 + 8 * g + 4 * hi) = (f32x4){ag[4 * g], ag[4 * g + 1], ag[4 * g + 2], ag[4 * g + 3]};
        }
    }
    __syncthreads();
    {
        const int n = lane, tg = wave, col = h * 64 + n;
        const float mu_r = W.mu_r, mu_k = W.mu_k, mu_v = W.mu_v, kkc = W.kkc, kac = W.kac, rkc = W.rkc, lng = W.lng, lnb = W.lnb;
        float rr[8], kr[8], vv[8], ww[8], aa[8], gg[8], kk[8];
        const int tfirst = tok0 + 8 * tg;
        const bf16* pp = proj + (size_t)tfirst * INCP + C_RW + col;
        float pr, pk, pvv;
        if (c == 0 && tg == 0) { pr = 0.f; pk = 0.f; pvv = 0.f; } else { pr = bf2f(pp[-(long)INCP]); pk = bf2f(pp[-(long)INCP + 1024]); pvv = bf2f(pp[-(long)INCP + 2048]); }
        const LAS float* wagr = (const LAS float*)(lds + L_WAG) + (8 * tg) * 64 + n;
#pragma unroll
        for (int q = 0; q < 8; ++q) { const float cr = bf2f(pp[(size_t)q * INCP]), ck = bf2f(pp[(size_t)q * INCP + 1024]), cv = bf2f(pp[(size_t)q * INCP + 2048]);
            rr[q] = cr + (pr - cr) * mu_r; kr[q] = ck + (pk - ck) * mu_k; vv[q] = cv + (pvv - cv) * mu_v; pr = cr; pk = ck; pvv = cv;
            ww[q] = wagr[q * 64]; aa[q] = wagr[4096 + q * 64]; gg[q] = wagr[8192 + q * 64]; }
        float lam[8]; float run = 1.f;
#pragma unroll
        for (int q = 0; q < 8; ++q) { run *= ww[q]; lam[q] = run; }
        misc[tg * 64 + n] = run;
#pragma unroll
        for (int q = 0; q < 8; ++q) { const float kkv = kr[q] * kkc; const float ss = wave_sum(kkv * kkv); kk[q] = kkv * __builtin_amdgcn_rsqf(fmaxf(ss, 1e-24f));
            kr[q] = kr[q] * (1.f + (aa[q] - 1.f) * kac); }
        __syncthreads();
        float pre = 1.f, tot = 1.f;
#pragma unroll
        for (int g = 0; g < 8; ++g) { const float sgt = misc[g * 64 + n]; if (g < tg) pre *= sgt; tot *= sgt; }
        if (tg == 0) misc[512 + n] = tot;
        unsigned vt[4], bbt[4], kbt[4];
        LAS bf16* At = (LAS bf16*)(lds + M_AT * MATB); LAS bf16* Bt = (LAS bf16*)(lds + M_BT * MATB); LAS bf16* Kt = (LAS bf16*)(lds + M_KT * MATB); LAS bf16* Rt = (LAS bf16*)(lds + M_RT * MATB);
        float hbb = 0.f, hkb = 0.f, hv = 0.f;
#pragma unroll
        for (int q = 0; q < 8; ++q) { const int t = 8 * tg + q;
            const float L = pre * lam[q], Lp = q == 0 ? pre : pre * lam[q - 1], iL = __builtin_amdgcn_rcpf(L), rel = tot * iL;
            const float bq = kk[q] * aa[q];
            ((LAS float*)(lds + L_RHS))[t * 128 + 64 + n] = -kk[q] * Lp;
            At[t * CP + n] = (bf16)f2bf(-kk[q] * Lp); Bt[t * CP + n] = (bf16)f2bf(bq * iL); Kt[t * CP + n] = (bf16)f2bf(kr[q] * iL); Rt[t * CP + n] = (bf16)f2bf(rr[q] * L);
            const float bb = bq * rel, kb = kr[q] * rel;
            if (q & 1) { vt[q >> 1] = pk2(hv, vv[q]); bbt[q >> 1] = pk2(hbb, bb); kbt[q >> 1] = pk2(hkb, kb); } else { hv = vv[q]; hbb = bb; hkb = kb; }
            const float bs = wave_sum(rr[q] * kr[q] * rkc);
            const int pl = t * 64 + ((n >> 2) & 3) * 16 + (n >> 4) * 4 + (n & 3);
            ((bf16*)(chk + 4 * 8192))[pl] = (bf16)f2bf(lng * gg[q]);
            ((bf16*)(chk + 5 * 8192))[pl] = (bf16)f2bf((lnb + bs * vv[q]) * gg[q]); }
        *(LAS v4u*)(lds + M_VT * MATB + (n * CP + 8 * tg) * 2) = (v4u){vt[0], vt[1], vt[2], vt[3]};
        *(LAS v4u*)(lds + M_BBT * MATB + (n * CP + 8 * tg) * 2) = (v4u){bbt[0], bbt[1], bbt[2], bbt[3]};
        *(LAS v4u*)(lds + M_KBT * MATB + (n * CP + 8 * tg) * 2) = (v4u){kbt[0], kbt[1], kbt[2], kbt[3]};
    }
    __syncthreads();
    const int c32 = lane & 31, hi = lane >> 5;
    {
        const int prod = wave >> 1;
#pragma unroll
        for (int qi = 0; qi < 2; ++qi) {
            const int tb = (wave & 1) ? (qi == 0 ? 1 : 0) : qi, sb = (wave & 1) ? 1 : 0; const bool zero = (tb == 0 && sb == 1);
            f32x16 acc = {};
            const int xa = (prod == 0 || prod == 2) ? M_BT : M_KT, ya = prod < 2 ? M_AT : M_RT, dm = prod == 0 ? M_LAB : (prod == 1 ? M_LAK : (prod == 2 ? M_MRB : M_MRK));
            if (!zero) acc = mm_tile(lds + xa * MATB, sb, lds + ya * MATB, tb, acc, lane);
            const int t = tb * 32 + c32; LAS unsigned char* dst = lds + dm * MATB + (t * CP + sb * 32) * 2;
#pragma unroll
            for (int g = 0; g < 4; ++g) { float o[4];
#pragma unroll
                for (int e = 0; e < 4; ++e) { const int s = sb * 32 + 8 * g + 4 * hi + e; const bool keep = prod < 2 ? (s < t) : (s <= t); o[e] = keep ? acc[4 * g + e] : 0.f; }
                *(LAS v2u*)(dst + (8 * g + 4 * hi) * 2) = (v2u){pk2(o[0], o[1]), pk2(o[2], o[3])}; }
        }
    }
    __syncthreads();
    if (wave < 4) {
        const int ib = wave >> 1, tb = wave & 1; f32x16 acc = {};
        acc = mm_tile(lds + M_VT * MATB, ib, lds + M_LAK * MATB, tb, acc, lane, 0, tb == 0 ? 2 : 4);
        const int t = tb * 32 + c32; LAS float* dst = (LAS float*)(lds + L_RHS) + t * 128 + ib * 32;
#pragma unroll
        for (int g = 0; g < 4; ++g) *(LAS f32x4*)(dst + 8 * g + 4 * hi) = (f32x4){acc[4 * g], acc[4 * g + 1], acc[4 * g + 2], acc[4 * g + 3]};
    } else if (wave == 4) {
        const int bb = lane >> 4, col = lane & 15;
        float x[16];
#pragma unroll
        for (int t = 0; t < 16; ++t) x[t] = t == col ? 1.f : 0.f;
#pragma unroll
        for (int t = 1; t < 16; ++t) { const LAS unsigned char* rp = lds + M_LAB * MATB + ((16 * bb + t) * CP + 16 * bb) * 2; const v4u ra = *(const LAS v4u*)rp, rb = *(const LAS v4u*)(rp + 16);
            float lrow[16];
#pragma unroll
            for (int q = 0; q < 4; ++q) { lrow[2 * q] = bflo(ra[q]); lrow[2 * q + 1] = bfhi(ra[q]); lrow[8 + 2 * q] = bflo(rb[q]); lrow[8 + 2 * q + 1] = bfhi(rb[q]); }
#pragma unroll
            for (int s = 0; s < t; ++s) x[t] += lrow[s] * x[s]; }
        LAS bf16* T = (LAS bf16*)(lds + L_TB) + bb * 256 + col;
#pragma unroll
        for (int t = 0; t < 16; ++t) T[t * 16] = (bf16)f2bf(x[t]);
    }
    __syncthreads();
    {
        typedef short s16x4 __attribute__((ext_vector_type(4)));
        const int l15 = lane & 15, q4 = lane >> 4;
        LAS unsigned char* xt = lds + (wave < 4 ? M_U0T : M_AHT) * MATB + ((16 * (wave & 3) + l15) * CP) * 2;
        *(LAS v4u*)(xt + q4 * 32) = (v4u){0u, 0u, 0u, 0u}; *(LAS v4u*)(xt + q4 * 32 + 16) = (v4u){0u, 0u, 0u, 0u};
        const LAS float* Xf = (const LAS float*)(lds + L_RHS) + 16 * wave + l15;
#pragma unroll
        for (int bq = 0; bq < 4; ++bq) {
            f32x4 acc;
#pragma unroll
            for (int e = 0; e < 4; ++e) acc[e] = Xf[(16 * bq + 4 * q4 + e) * 128];
#pragma unroll
            for (int kk = 0; kk < (bq + 1) / 2; ++kk) {
                const bf16x8 a = *(const LAS bf16x8*)(lds + M_LAB * MATB + ((16 * bq + l15) * CP + 32 * kk + 8 * q4) * 2);
                const bf16x8 xb = *(const LAS bf16x8*)(xt + (32 * kk + 8 * q4) * 2);
                acc = __builtin_amdgcn_mfma_f32_16x16x32_bf16(a, xb, acc, 0, 0, 0); }
            const v2u tf = *(const LAS v2u*)(lds + L_TB + (bq * 256 + l15 * 16 + 4 * q4) * 2);
            const v2u ab = (v2u){pk2(acc[0], acc[1]), pk2(acc[2], acc[3])};
            const f32x4 z = {0.f, 0.f, 0.f, 0.f};
            const f32x4 xn = __builtin_amdgcn_mfma_f32_16x16x16bf16_1k(__builtin_bit_cast(s16x4, tf), __builtin_bit_cast(s16x4, ab), z, 0, 0, 0);
            *(LAS v2u*)(xt + (16 * bq + 4 * q4) * 2) = (v2u){pk2(xn[0], xn[1]), pk2(xn[2], xn[3])};
        }
    }
    __syncthreads();
    {
        const int qd = wave & 3, yb = qd >> 1, xb = qd & 1;
        f32x16 acc1 = {}, acc2 = {};
        if (wave < 4) {
            acc1 = mm_tile(lds + M_AHT * MATB, yb, lds + M_BBT * MATB, xb, acc1, lane);
            acc2 = mm_tile(lds + M_BBT * MATB, yb, lds + M_U0T * MATB, xb, acc2, lane);
            acc2 = mm_tile(lds + M_KBT * MATB, yb, lds + M_VT * MATB, xb, acc2, lane);
            const int x = xb * 32 + c32; const float lc = misc[512 + x];
            bf16* o1 = (bf16*)(chk + 0 * 8192) + x * 64 + yb * 32; bf16* o2 = (bf16*)(chk + 1 * 8192) + x * 64 + yb * 32;
#pragma unroll
            for (int g = 0; g < 4; ++g) { float p[4];
#pragma unroll
                for (int e = 0; e < 4; ++e) { const int y = yb * 32 + 8 * g + 4 * hi + e; p[e] = acc1[4 * g + e] + (y == x ? lc : 0.f); }
                *(v2u*)(o1 + 8 * g + 4 * hi) = (v2u){pk2(p[0], p[1]), pk2(p[2], p[3])};
                *(v2u*)(o2 + 8 * g + 4 * hi) = (v2u){pk2(acc2[4 * g], acc2[4 * g + 1]), pk2(acc2[4 * g + 2], acc2[4 * g + 3])}; }
        } else {
            acc1 = mm_tile(lds + M_AHT * MATB, yb, lds + M_MRB * MATB, xb, acc1, lane);
            acc2 = mm_tile(lds + M_U0T * MATB, yb, lds + M_MRB * MATB, xb, acc2, lane);
            acc2 = mm_tile(lds + M_VT * MATB, yb, lds + M_MRK * MATB, xb, acc2, lane);
            const int x = xb * 32 + c32;
            bf16* o1 = (bf16*)(chk + 2 * 8192) + x * 64 + yb * 32; bf16* o2 = (bf16*)(chk + 3 * 8192) + x * 64;
            const LAS bf16* Rt = (const LAS bf16*)(lds + M_RT * MATB) + x * CP + yb * 32;
#pragma unroll
            for (int g = 0; g < 4; ++g) { float p[4];
#pragma unroll
                for (int e = 0; e < 4; ++e) p[e] = acc1[4 * g + e] + bf2f(Rt[8 * g + 4 * hi + e]);
                *(v2u*)(o1 + 8 * g + 4 * hi) = (v2u){pk2(p[0], p[1]), pk2(p[2], p[3])};
                *(v2u*)(o2 + ((2 * g + hi) & 3) * 16 + (2 * yb + (g >> 1)) * 4) = (v2u){pk2(acc2[4 * g], acc2[4 * g + 1]), pk2(acc2[4 * g + 2], acc2[4 * g + 3])}; }
        }
    }
    __syncthreads();
}

__device__ __forceinline__ void phase_rwkv_stage_a(KP P, LAS unsigned char* lds, int vcu, int G) {
    const int tid = ltid(), lane = tid & 63, wave = __builtin_amdgcn_readfirstlane(tid >> 6);
    int cur_bh = (vcu & 255) >> 3; LoraFrags W = lora_frags_load(P, cur_bh & 15, wave, lane);
    for (int k = vcu; k < 2048; k += G) { const int bh = (k & 255) >> 3, c = (k & 7) + 8 * (k >> 8);
        if (bh != cur_bh) { W = lora_frags_load(P, bh & 15, wave, lane); cur_bh = bh; }
        rwkv_stage_a(P, lds, bh * 64 + c, W); }
}
typedef float f32x4v __attribute__((ext_vector_type(4)));
struct YSet { bf16x8 b0, b1; v4u y0[2], g1[2], g2[2]; };
struct SSet { bf16x8 p0[1], p1[1]; v2u q[4]; };
__device__ __forceinline__ void rwkv_stage_b(KP P, LAS unsigned char* lds, int bh) {
    const int tid = ltid(), lane = tid & 63, wave = __builtin_amdgcn_readfirstlane(tid >> 6);
    const int b = bh >> 4, h = bh & 15; const int l15 = lane & 15, q4 = lane >> 4;
    bf16* AR = (bf16*)(P.ws + WS_AR);
    for (int u = tid; u < 2 * MATB / 4; u += NTHR) ((LAS unsigned*)lds)[u] = 0u;
    __syncthreads();
    const int w4 = wave & 3;
    const unsigned char* chk0 = P.ws + WS_CHK + (size_t)bh * CHK_ITEM;
    if (wave < 4) {
        const int t = 16 * w4 + l15;
        YSet ys[4];
#define YLOAD(S_, c_) do { const unsigned char* chk = chk0 + (size_t)(c_) * (32 * CHK_ITEM); const bf16* rh = (const bf16*)(chk + 2 * 8192) + t * 64 + 8 * q4; S_.b0 = *(const bf16x8*)rh; S_.b1 = *(const bf16x8*)(rh + 32); \
        const bf16* y0 = (const bf16*)(chk + 3 * 8192) + t * 64 + 16 * q4; \
        S_.y0[0] = *(const v4u*)y0; S_.y0[1] = *(const v4u*)(y0 + 8); S_.g1[0] = *(const v4u*)(y0 + 4096); S_.g1[1] = *(const v4u*)(y0 + 4096 + 8); S_.g2[0] = *(const v4u*)(y0 + 8192); S_.g2[1] = *(const v4u*)(y0 + 8192 + 8); } while (0)
#define YV(A_, it_, w_) ((A_)[(it_) >> 1][2 * ((it_) & 1) + (w_)])
#pragma unroll
        for (int u = 0; u < 4; ++u) YLOAD(ys[u], u);
        for (int c0 = 0; c0 < 64; c0 += 4) {
#pragma unroll
            for (int u = 0; u < 4; ++u) { const int c = c0 + u;
                const LAS unsigned char* Scur = lds + (c & 1) * MATB;
                f32x4v acc[4];
#pragma unroll
                for (int it = 0; it < 4; ++it) { acc[it] = (f32x4v){bflo(YV(ys[u].y0, it, 0)), bfhi(YV(ys[u].y0, it, 0)), bflo(YV(ys[u].y0, it, 1)), bfhi(YV(ys[u].y0, it, 1))};
                    const LAS unsigned char* sp = Scur + ((16 * it + l15) * CP + 8 * q4) * 2;
                    acc[it] = __builtin_amdgcn_mfma_f32_16x16x32_bf16(*(const LAS bf16x8*)sp, ys[u].b0, acc[it], 0, 0, 0);
                    acc[it] = __builtin_amdgcn_mfma_f32_16x16x32_bf16(*(const LAS bf16x8*)(sp + 64), ys[u].b1, acc[it], 0, 0, 0); }
                float s = 0.f;
#pragma unroll
                for (int it = 0; it < 4; ++it) s += (acc[it].x + acc[it].y) + (acc[it].z + acc[it].w);
                s += __shfl_xor(s, 16); s += __shfl_xor(s, 32);
                const float mean = s * (1.f / 64.f); float v = 0.f;
#pragma unroll
                for (int it = 0; it < 4; ++it) { acc[it] = acc[it] - mean; v += (acc[it].x * acc[it].x + acc[it].y * acc[it].y) + (acc[it].z * acc[it].z + acc[it].w * acc[it].w); }
                v += __shfl_xor(v, 16); v += __shfl_xor(v, 32);
                const float rstd = 1.0f / sqrtf(v * (1.f / 64.f) + 64e-5f);
                bf16* orow = AR + (size_t)(b * SEQ + c * 64 + t) * DM + 1024 + h * 64 + 4 * q4;
#pragma unroll
                for (int it = 0; it < 4; ++it) {
                    const float o0 = acc[it].x * rstd * bflo(YV(ys[u].g1, it, 0)) + bflo(YV(ys[u].g2, it, 0)), o1 = acc[it].y * rstd * bfhi(YV(ys[u].g1, it, 0)) + bfhi(YV(ys[u].g2, it, 0));
                    const float o2 = acc[it].z * rstd * bflo(YV(ys[u].g1, it, 1)) + bflo(YV(ys[u].g2, it, 1)), o3 = acc[it].w * rstd * bfhi(YV(ys[u].g1, it, 1)) + bfhi(YV(ys[u].g2, it, 1));
                    *(v2u*)(orow + 16 * it) = (v2u){pk2(o0, o1), pk2(o2, o3)}; }
                if (c + 4 < 64) YLOAD(ys[u], c + 4);
                __syncthreads();
            }
        }
#undef YLOAD
#undef YV
    } else {
        const int nrow = 16 * w4 + l15;
        SSet ss[4];
#define SLOADX(S_, c_) do { const unsigned char* chk = chk0 + (size_t)(c_) * (32 * CHK_ITEM); const bf16* pt = (const bf16*)chk + nrow * 64 + 8 * q4; S_.p0[0] = *(const bf16x8*)pt; S_.p1[0] = *(const bf16x8*)(pt + 32); \
        const bf16* q = (const bf16*)(chk + 1 * 8192) + l15 * 64 + 16 * w4 + 4 * q4; \
        _Pragma("unroll") for (int it = 0; it < 4; ++it) S_.q[it] = *(const v2u*)(q + 16 * it * 64); } while (0)
#pragma unroll
        for (int u = 0; u < 4; ++u) SLOADX(ss[u], u);
        for (int c0 = 0; c0 < 64; c0 += 4) {
#pragma unroll
            for (int u = 0; u < 4; ++u) { const int c = c0 + u;
                const LAS unsigned char* Scur = lds + (c & 1) * MATB; LAS unsigned char* Snxt = lds + ((c & 1) ^ 1) * MATB;
#pragma unroll
                for (int it = 0; it < 4; ++it) { const int i = 16 * it + l15;
                    const LAS unsigned char* sp = Scur + (i * CP + 8 * q4) * 2; const bf16x8 s0 = *(const LAS bf16x8*)sp, s1 = *(const LAS bf16x8*)(sp + 64);
                    f32x4v acc = (f32x4v){bflo(ss[u].q[it].x), bfhi(ss[u].q[it].x), bflo(ss[u].q[it].y), bfhi(ss[u].q[it].y)};
                    acc = __builtin_amdgcn_mfma_f32_16x16x32_bf16(ss[u].p0[0], s0, acc, 0, 0, 0);
                    acc = __builtin_amdgcn_mfma_f32_16x16x32_bf16(ss[u].p1[0], s1, acc, 0, 0, 0);
                    *(LAS v2u*)(Snxt + (i * CP + 16 * w4 + 4 * q4) * 2) = (v2u){pk2(acc.x, acc.y), pk2(acc.z, acc.w)}; }
                if (c + 4 < 64) SLOADX(ss[u], c + 4);
                __syncthreads();
            }
        }
#undef SLOADX
    }
}

constexpr size_t WS_UB = WS_RWA;
constexpr size_t WS_VB = WS_RWA + 32 * MiB;
constexpr float U_SCALE = 512.f, V_SCALE = 32.f;
constexpr int SLICE_BYTES = 16384 * 128;
typedef float f32x2 __attribute__((ext_vector_type(2)));
__device__ __forceinline__ void convert_group(KP P, int i) {
    constexpr int N16 = 16384 * 2048 / 16;
    const bool isv = i >= N16; const int j = isv ? i - N16 : i; const int e = j >> 7, q = j & 127;
    const float* s = (isv ? P.pv : P.pu) + (size_t)j * 16; const float sc = isv ? V_SCALE : U_SCALE;
    v4u o;
#pragma unroll
    for (int k = 0; k < 4; ++k) { f32x4 a = *(const f32x4*)(s + 4 * k); if (!isv) a = a * *(const f32x4*)(P.norm2_g + 16 * q + 4 * k); int p = 0;
        p = __builtin_amdgcn_cvt_pk_fp8_f32(a.x * sc, a.y * sc, p, false); p = __builtin_amdgcn_cvt_pk_fp8_f32(a.z * sc, a.w * sc, p, true); o[k] = (unsigned)p; }
    *(v4u*)(P.ws + (isv ? WS_VB : WS_UB) + (size_t)(q >> 3) * SLICE_BYTES + (size_t)e * 128 + (q & 7) * 16) = o;
}
__device__ __forceinline__ void phase_convert_tables(KP P, LAS unsigned char* lds) {
    const int tid = ltid(); constexpr int N16 = 16384 * 2048 / 16, CH = 4 * NTHR, NCH = 2 * N16 / CH;
    unsigned* ctr = (unsigned*)(P.ws + WS_CTL) + CW_MOBA_CTR; LAS int* slot = (LAS int*)lds;
    for (;;) {
        __syncthreads();
        if (tid == 0) slot[0] = (int)__hip_atomic_fetch_add(ctr, 1u, __ATOMIC_RELAXED, __HIP_MEMORY_SCOPE_AGENT);
        __syncthreads();
        const int c = slot[0]; if (c >= NCH) break;
#pragma unroll
        for (int k = 0; k < 4; ++k) convert_group(P, c * CH + k * NTHR + tid);
    }
}
__device__ __forceinline__ f32x2 dot16p(const v4u u, const f32x2* x, f32x2 acc) {
#pragma unroll
    for (int q = 0; q < 4; ++q) { const f32x2 lo = __builtin_amdgcn_cvt_pk_f32_fp8((int)u[q], false), hi = __builtin_amdgcn_cvt_pk_f32_fp8((int)u[q], true);
        acc = __builtin_elementwise_fma(lo, x[2 * q], acc); acc = __builtin_elementwise_fma(hi, x[2 * q + 1], acc); }
    return acc;
}
__device__ __forceinline__ void axpy16p(const v4u v, f32x2 s, f32x2* y) {
#pragma unroll
    for (int q = 0; q < 4; ++q) { const f32x2 lo = __builtin_amdgcn_cvt_pk_f32_fp8((int)v[q], false), hi = __builtin_amdgcn_cvt_pk_f32_fp8((int)v[q], true);
        y[2 * q] = __builtin_elementwise_fma(s, lo, y[2 * q]); y[2 * q + 1] = __builtin_elementwise_fma(s, hi, y[2 * q + 1]); }
}
__device__ __forceinline__ float xsum_g8(float v) {
    v += DPP_F(v, 0x128);
    { auto r = __builtin_amdgcn_permlane16_swap(__float_as_uint(v), __float_as_uint(v), false, false); v = __uint_as_float(r[0]) + __uint_as_float(r[1]); }
    { auto r = __builtin_amdgcn_permlane32_swap(__float_as_uint(v), __float_as_uint(v), false, false); v = __uint_as_float(r[0]) + __uint_as_float(r[1]); }
    return v;
}
__device__ __forceinline__ void phase_peer_sliced(KP P, LAS unsigned char* lds, int bx, int G) {
    const int grp = bx & 7;
    const unsigned char* UB = P.ws + WS_UB; const unsigned char* VB = P.ws + WS_VB; const bf16* HB = (const bf16*)(P.ws + WS_XN);
    const int* ridx = (const int*)(P.ws + WS_PROJ + 64 * MiB); const float* rgate = (const float*)(P.ws + WS_PROJ + 68 * MiB); const float* RSTD = (const float*)(P.ws + WS_SSP + 2 * MiB);
    for (int bt = bx; bt < TT / 32; bt += G) {
        const int tid = ltid(), lane = tid & 63, wave = __builtin_amdgcn_readfirstlane(tid >> 6), g8 = lane >> 3, p = lane & 7;
        LAS int* idxT = (LAS int*)(lds + wave * 4096); LAS float* gT = (LAS float*)(lds + wave * 4096 + 2048);
        LAS bf16* h2T = (LAS bf16*)(lds + 32768 + wave * 16384);
        const int t0 = 32 * bt + 4 * wave;
#pragma unroll
        for (int i = 0; i < 4; ++i) { const size_t o = (size_t)(t0 + i) * 128; const int wofs = (i * 8 + (lane & 7)) * 16 + (lane >> 3);
            idxT[wofs] = ridx[o + lane]; idxT[wofs + 8] = ridx[o + 64 + lane]; gT[wofs] = rgate[o + lane]; gT[wofs + 8] = rgate[o + 64 + lane]; }
        float hacc[4][2];
#pragma unroll
        for (int i = 0; i < 4; ++i) { hacc[i][0] = 0.f; hacc[i][1] = 0.f; }
        {
            v4u rA[8], rB[8]; f32x2 xA[8], xB[8];
#define PS_SG(s_) (((s_) + 2 * grp) & 15)
#define PS_ISSUE(R, tabbase, s_, i_, hb_) do { const unsigned char* tb_ = (tabbase) + (size_t)PS_SG(s_) * SLICE_BYTES;        \
            const v4u ia_ = *(const LAS v4u*)(idxT + ((i_) * 8 + g8) * 16 + 8 * (hb_)), ib_ = *(const LAS v4u*)(idxT + ((i_) * 8 + g8) * 16 + 8 * (hb_) + 4); const unsigned po_ = 16u * (unsigned)p; \
            R[0] = *(const v4u*)(tb_ + (ia_[0] * 128u + po_)); R[1] = *(const v4u*)(tb_ + (ia_[1] * 128u + po_)); R[2] = *(const v4u*)(tb_ + (ia_[2] * 128u + po_)); R[3] = *(const v4u*)(tb_ + (ia_[3] * 128u + po_)); \
            R[4] = *(const v4u*)(tb_ + (ib_[0] * 128u + po_)); R[5] = *(const v4u*)(tb_ + (ib_[1] * 128u + po_)); R[6] = *(const v4u*)(tb_ + (ib_[2] * 128u + po_)); R[7] = *(const v4u*)(tb_ + (ib_[3] * 128u + po_)); } while (0)
#define PS_LOADX(X, s_, i_) do { const bf16* xp_ = HB + (size_t)(t0 + (i_)) * DM + 128 * PS_SG(s_) + 16 * p; const v4u xa_ = *(const v4u*)xp_, xb_ = *(const v4u*)(xp_ + 8); \
            _Pragma("unroll") for (int q = 0; q < 4; ++q) { X[q] = (f32x2){bflo(xa_[q]), bfhi(xa_[q])}; X[4 + q] = (f32x2){bflo(xb_[q]), bfhi(xb_[q])}; } } while (0)
#define PS_DOTS(R, X, i_, hb_) do { _Pragma("unroll") for (int m = 0; m < 8; ++m) { const f32x2 a2_ = dot16p(R[m], X, (f32x2){0.f, 0.f}); float sd_ = a2_.x + a2_.y; \
            sd_ += DPP_F(sd_, 0xB1); sd_ += DPP_F(sd_, 0x4E); sd_ += DPP_F(sd_, 0x141); if (p == m) hacc[i_][hb_] += sd_; } asm volatile("" ::: "memory"); } while (0)
            PS_LOADX(xA, 0, 0); PS_ISSUE(rA, UB, 0, 0, 0);
            for (int s = 0; s < 16; ++s) {
                PS_ISSUE(rB, UB, s, 0, 1); PS_LOADX(xB, s, 1);  PS_DOTS(rA, xA, 0, 0);
                PS_ISSUE(rA, UB, s, 1, 0);                       PS_DOTS(rB, xA, 0, 1);
                PS_ISSUE(rB, UB, s, 1, 1); PS_LOADX(xA, s, 2);  PS_DOTS(rA, xB, 1, 0);
                PS_ISSUE(rA, UB, s, 2, 0);                       PS_DOTS(rB, xB, 1, 1);
                PS_ISSUE(rB, UB, s, 2, 1); PS_LOADX(xB, s, 3);  PS_DOTS(rA, xA, 2, 0);
                PS_ISSUE(rA, UB, s, 3, 0);                       PS_DOTS(rB, xA, 2, 1);
                PS_ISSUE(rB, UB, s, 3, 1); if (s + 1 < 16) PS_LOADX(xA, s + 1, 0);  PS_DOTS(rA, xB, 3, 0);
                if (s + 1 < 16) PS_ISSUE(rA, UB, s + 1, 0, 0);  PS_DOTS(rB, xB, 3, 1);
            }
#undef PS_LOADX
#undef PS_DOTS
        }
#pragma unroll
        for (int i = 0; i < 4; ++i) { const float rsn = RSTD[t0 + i] * (1.f / U_SCALE);
#pragma unroll
            for (int hb = 0; hb < 2; ++hb) { const float hp = hacc[i][hb] * rsn; LAS float* gp = gT + (i * 8 + g8) * 16 + 8 * hb + p;
                *gp = 0.5f * hp * (1.f + erff(hp * 0.70710678118654752f)) * (1.f / V_SCALE) * *gp; } }
        float ssq[4] = {0.f, 0.f, 0.f, 0.f};
        {
            v4u rA[8], rB[8]; f32x2 y2[8];
#define PS_AXPY(R, i_, hb_) do { const f32x4 aa_ = *(const LAS f32x4*)(gT + ((i_) * 8 + g8) * 16 + 8 * (hb_)), ab_ = *(const LAS f32x4*)(gT + ((i_) * 8 + g8) * 16 + 8 * (hb_) + 4); \
            if ((hb_) == 0) { _Pragma("unroll") for (int q = 0; q < 8; ++q) y2[q] = (f32x2){0.f, 0.f}; } \
            _Pragma("unroll") for (int m = 0; m < 8; ++m) { const float av_ = m < 4 ? aa_[m & 3] : ab_[m & 3]; axpy16p(R[m], (f32x2){av_, av_}, y2); } asm volatile("" ::: "memory"); } while (0)
#define PS_FIN(s_, i_) do { f32x2 ysel_ = {0.f, 0.f}; _Pragma("unroll") for (int q = 0; q < 8; ++q) { const float a_ = xsum_g8(y2[q].x), b_ = xsum_g8(y2[q].y); if (g8 == q) ysel_ = (f32x2){a_, b_}; } \
            const int d_ = 128 * PS_SG(s_) + 16 * p + 2 * g8; const unsigned hb_ = *(const unsigned*)(HB + (size_t)(t0 + (i_)) * DM + d_); const f32x2 hv_ = (f32x2){bflo(hb_), bfhi(hb_)} + ysel_; \
            *(LAS unsigned*)(h2T + (i_) * DM + d_) = pk2(hv_.x, hv_.y); ssq[i_] += hv_.x * hv_.x + hv_.y * hv_.y; } while (0)
            PS_ISSUE(rA, VB, 0, 0, 0);
            for (int s = 0; s < 16; ++s) {
                PS_ISSUE(rB, VB, s, 0, 1); PS_AXPY(rA, 0, 0);
                PS_ISSUE(rA, VB, s, 1, 0); PS_AXPY(rB, 0, 1); PS_FIN(s, 0);
                PS_ISSUE(rB, VB, s, 1, 1); PS_AXPY(rA, 1, 0);
                PS_ISSUE(rA, VB, s, 2, 0); PS_AXPY(rB, 1, 1); PS_FIN(s, 1);
                PS_ISSUE(rB, VB, s, 2, 1); PS_AXPY(rA, 2, 0);
                PS_ISSUE(rA, VB, s, 3, 0); PS_AXPY(rB, 2, 1); PS_FIN(s, 2);
                PS_ISSUE(rB, VB, s, 3, 1); PS_AXPY(rA, 3, 0);
                if (s + 1 < 16) PS_ISSUE(rA, VB, s + 1, 0, 0); PS_AXPY(rB, 3, 1); PS_FIN(s, 3);
            }
#undef PS_AXPY
#undef PS_FIN
#undef PS_ISSUE
#undef PS_SG
        }
        { f32x4 fg[8];
#pragma unroll
          for (int j = 0; j < 8; ++j) fg[j] = *(const f32x4*)(P.final_g + 4 * lane + 256 * j);
#pragma unroll
          for (int i = 0; i < 4; ++i) { const float rs2 = 1.0f / sqrtf(wave_sum(ssq[i]) * (1.f / DM) + RMS_EPS);
#pragma unroll
            for (int j = 0; j < 8; ++j) { const v2u hv = *(const LAS v2u*)(h2T + i * DM + 4 * lane + 256 * j);
                *(f32x4*)(P.out + (size_t)(t0 + i) * DM + 4 * lane + 256 * j) = (f32x4){bflo(hv.x) * rs2 * fg[j].x, bfhi(hv.x) * rs2 * fg[j].y, bflo(hv.y) * rs2 * fg[j].z, bfhi(hv.y) * rs2 * fg[j].w}; } } }
        asm volatile("" ::: "memory");
    }
}
namespace moba {
constexpr float SCALE = 0.08838834764831845f;
constexpr float THR = 8.f;
constexpr bool WSKIP = false;
constexpr int D = 128, NW = 8, QBLK = 32, KVBLK = 64, QB = NW * QBLK;
constexpr int SHM_V = KVBLK * D * 2, SHM_K = KVBLK * D * 2;
constexpr int ATT_LDS_BYTES = 2 * SHM_V + 2 * SHM_K + NW * 64 * 4;
constexpr int KPITCH = INCP, QPITCH = INCP, OPITCH = DM;
typedef unsigned short bf16;
typedef short bf16x8 __attribute__((ext_vector_type(8)));
typedef short s16x4 __attribute__((ext_vector_type(4)));
typedef float f32x16 __attribute__((ext_vector_type(16)));
typedef float f32x4 __attribute__((ext_vector_type(4)));
typedef unsigned u32x4 __attribute__((ext_vector_type(4)));
template <class A, class Bt> struct same_t { static constexpr bool v = false; };
template <class A> struct same_t<A, A> { static constexpr bool v = true; };
#define KSWZ(row, colB) ((row) * 256 + ((colB) ^ (((row) & 7) << 4)))
#define SBAR() __builtin_amdgcn_sched_barrier(0)
__device__ __forceinline__ int v_st(int k, int c) { const int kk = (k & ~0xC) | ((k & 4) << 1) | ((k & 8) >> 1); return ((kk >> 3) * 4 + (c >> 5)) * 512 + ((kk & 7) * 32 + (c & 31)) * 2; }
__device__ __forceinline__ int v_rd_base(int lane) { return ((lane & 3) << 3) | (((lane >> 2) & 3) << 6) | (((lane >> 4) & 1) << 5) | (((lane >> 5) & 1) << 8); }
constexpr int v_rd_off(int d0, int ks, int half) { return d0 * 512 + ks * 4096 + half * 2048; }
__device__ __forceinline__ int crow(int r, int hi) { return (r & 3) + 8 * (r >> 2) + 4 * hi; }
__device__ __forceinline__ unsigned cvtpk(float lo, float hi) {
    unsigned r; asm volatile("v_cvt_pk_bf16_f32 %0, %1, %2" : "=v"(r) : "v"(lo), "v"(hi)); return r;
}
__device__ __forceinline__ bf16x8 pack8(f32x4 a, f32x4 b) {
    u32x4 w = {cvtpk(a[0], a[1]), cvtpk(a[2], a[3]), cvtpk(b[0], b[1]), cvtpk(b[2], b[3])};
    return *reinterpret_cast<bf16x8*>(&w);
}
template <class T> __device__ __forceinline__ bf16x8 load8(const T* p) {
    if constexpr (same_t<T, float>::v) { return pack8(*(const f32x4*)p, *(const f32x4*)(p + 4)); }
    else { return *reinterpret_cast<const bf16x8*>(p); }
}
__device__ __forceinline__ void mask_tile(f32x16& p0, f32x16& p1, int dq, unsigned W) {
    const float NEG = -__builtin_inff();
#pragma unroll
    for (int r = 0; r < 16; ++r) {
        const int c = (r & 3) + 8 * (r >> 2);
        if ((unsigned)(dq - c) >= W) p0[r] = NEG;
        if ((unsigned)(dq - c - 32) >= W) p1[r] = NEG;
    }
}
__device__ __forceinline__ void partialSM(f32x16& p0, f32x16& p1, float& m_reg, float& mn, float& alpha, float base0, float base1) {
    float pm0 = p0[0]; for (int r = 1; r < 16; ++r) pm0 = fmaxf(pm0, p0[r]); float pm1 = p1[0]; for (int r = 1; r < 16; ++r) pm1 = fmaxf(pm1, p1[r]);
    float pmax = fmaxf(pm0 + base0, pm1 + base1);
    { auto rr = __builtin_amdgcn_permlane32_swap(__float_as_uint(pmax), __float_as_uint(pmax), false, false);
      pmax = fmaxf(__uint_as_float(rr[0]), __uint_as_float(rr[1])); }
    constexpr float C2 = 1.4426950408889634f * SCALE;
    if (__builtin_expect(__all((pmax - m_reg) * SCALE <= THR), 1)) { mn = m_reg; alpha = 1.f; }
    else { mn = fmaxf(m_reg, pmax); alpha = __builtin_amdgcn_exp2f((m_reg - mn) * C2); m_reg = mn; }
    const float mnL0 = (base0 - mn) * C2, mnL1 = (base1 - mn) * C2;
    for (int r = 0; r < 16; ++r) p0[r] = fmaf(p0[r], C2, mnL0); for (int r = 0; r < 16; ++r) p1[r] = fmaf(p1[r], C2, mnL1);
    for (int r = 0; r < 16; ++r) p0[r] = __builtin_amdgcn_exp2f(p0[r]);
}
__device__ __forceinline__ void finishSM(f32x16& p0, f32x16& p1, float alpha, float& l_reg, bf16x8& pa0, bf16x8& pa1, bf16x8& pa2, bf16x8& pa3) {
    for (int r = 0; r < 16; ++r) p1[r] = __builtin_amdgcn_exp2f(p1[r]);
    float ps = 0; for (int r = 0; r < 16; ++r) ps += p0[r]; for (int r = 0; r < 16; ++r) ps += p1[r];
    { auto rr = __builtin_amdgcn_permlane32_swap(__float_as_uint(ps), __float_as_uint(ps), false, false);
      ps = __uint_as_float(rr[0]) + __uint_as_float(rr[1]); }
    l_reg = l_reg * alpha + ps;
#define PK4(P, B_, OUT) do { unsigned a0 = cvtpk(P[B_+0], P[B_+1]), a1 = cvtpk(P[B_+2], P[B_+3]);                          \
        unsigned b0 = cvtpk(P[B_+4], P[B_+5]), b1 = cvtpk(P[B_+6], P[B_+7]);                                             \
        auto r0 = __builtin_amdgcn_permlane32_swap(a0, b0, false, false); auto r1 = __builtin_amdgcn_permlane32_swap(a1, b1, false, false); \
        u32x4 w = {r0[0], r1[0], r0[1], r1[1]}; OUT = *reinterpret_cast<bf16x8*>(&w); } while (0)
    PK4(p0, 0, pa0); PK4(p0, 8, pa1); PK4(p1, 0, pa2); PK4(p1, 8, pa3);
#undef PK4
}
template <int KB, bool SK>
__device__ __forceinline__ void qkt(f32x16& p0, f32x16& p1, const char* K_lds, int r32, int hi, const bf16x8* qr, bool act) {
    if (SK && !act) { const float NEG = -__builtin_inff();
#pragma unroll
        for (int r = 0; r < 16; ++r) { p0[r] = NEG; p1[r] = NEG; } return; }
    p0 = f32x16{}; p1 = f32x16{};
    const char* kb[4];
#pragma unroll
    for (int dd = 0; dd < 4; ++dd) kb[dd] = K_lds + KB * SHM_K + KSWZ(r32, (dd * 16 + hi * 8) * 2);
#pragma unroll
    for (int d0 = 0; d0 < 8; ++d0) { const char* a = kb[d0 & 3] + (d0 >> 2) * 128;
        bf16x8 b0 = *reinterpret_cast<const bf16x8*>(a);
        bf16x8 b1 = *reinterpret_cast<const bf16x8*>(a + 32 * 256);
        p0 = __builtin_amdgcn_mfma_f32_32x32x16_bf16(b0, qr[d0], p0, 0, 0, 0);
        p1 = __builtin_amdgcn_mfma_f32_32x32x16_bf16(b1, qr[d0], p1, 0, 0, 0); }
}
template <int VB, bool SK>
__device__ __forceinline__ void pv_tile(f32x16* o, int vb0, bf16x8 pa0, bf16x8 pa1, bf16x8 pa2, bf16x8 pa3, bool act) {
    if (SK && !act) return;
#define TRRD(dst, off) asm volatile("ds_read_b64_tr_b16 %0, %1 offset:%2" : "=&v"(dst) : "v"(vb0), "i"(off) : "memory")
#define PV_D0(d0) do { s16x4 l0, l1, h0, h1; constexpr int b_ = VB * SHM_V + v_rd_off(d0, 0, 0);     \
        TRRD(l0, b_); TRRD(h0, b_ + 2048); TRRD(l1, b_ + 4096); TRRD(h1, b_ + 6144); \
        asm volatile("s_waitcnt lgkmcnt(0)" ::: "memory"); SBAR();                 \
        o[d0] = __builtin_amdgcn_mfma_f32_32x32x16_bf16(pa0, (bf16x8){l0[0], l0[1], l0[2], l0[3], h0[0], h0[1], h0[2], h0[3]}, o[d0], 0, 0, 0);   \
        o[d0] = __builtin_amdgcn_mfma_f32_32x32x16_bf16(pa1, (bf16x8){l1[0], l1[1], l1[2], l1[3], h1[0], h1[1], h1[2], h1[3]}, o[d0], 0, 0, 0);   \
        SBAR(); TRRD(l0, b_ + 8192); TRRD(h0, b_ + 10240); TRRD(l1, b_ + 12288); TRRD(h1, b_ + 14336); \
        asm volatile("s_waitcnt lgkmcnt(0)" ::: "memory"); SBAR();   \
        o[d0] = __builtin_amdgcn_mfma_f32_32x32x16_bf16(pa2, (bf16x8){l0[0], l0[1], l0[2], l0[3], h0[0], h0[1], h0[2], h0[3]}, o[d0], 0, 0, 0);   \
        o[d0] = __builtin_amdgcn_mfma_f32_32x32x16_bf16(pa3, (bf16x8){l1[0], l1[1], l1[2], l1[3], h1[0], h1[1], h1[2], h1[3]}, o[d0], 0, 0, 0); } while (0)
    PV_D0(0); PV_D0(1); PV_D0(2); PV_D0(3);
#undef PV_D0
#undef TRRD
}

template <class TIn, class TOut> struct BlockRef { const TIn* Q; const TIn* K; const TIn* V; TOut* O; int P0; const float* KM; float A; int jlo, jhi; float* ST; };
template <class TIn> struct Seam {
    bf16x8 qr[8];
    bf16x8 st_v0, st_v1, st_k0, st_k1; f32x4 sf0, sf1, sf2, sf3;
    f32x4 tq[16];
};
__device__ __forceinline__ int swa_jlo(int P0, int W) { const int lowk = P0 - W + 1; return lowk > 0 ? lowk / KVBLK : 0; }
#define ROW(p, k0, rr) ((p) + (size_t)((k0) + (rr)) * KPITCH + sc)
#define VMW() asm volatile("s_waitcnt vmcnt(0)" ::: "memory")
#define VMWN(n) asm volatile("s_waitcnt vmcnt(%0)" :: "i"(n) : "memory")
#define SLOAD_H(Kp, Vp, k0) do { S.st_v0 = load8<TIn>(ROW(Vp, k0, sr)); S.st_v1 = load8<TIn>(ROW(Vp, k0, 32 + sr));              \
                         S.st_k0 = load8<TIn>(ROW(Kp, k0, sr)); S.st_k1 = load8<TIn>(ROW(Kp, k0, 32 + sr)); } while (0)
#define SWRITE_HK(bf) do { *(bf16x8*)(K_lds + (bf) * SHM_K + kws) = S.st_k0; *(bf16x8*)(K_lds + (bf) * SHM_K + kws + 32 * 256) = S.st_k1; } while (0)
#define SWRITE_HV(bf) do { *(bf16x8*)(V_lds + (bf) * SHM_V + vst0) = S.st_v0; *(bf16x8*)(V_lds + (bf) * SHM_V + vst1) = S.st_v1; } while (0)
#define SWRITE_H(bf) do { SWRITE_HV(bf); SWRITE_HK(bf); } while (0)
#define SLOAD_F(p, k0) do { S.sf0 = *(const f32x4*)ROW(p, k0, sr); S.sf1 = *(const f32x4*)(ROW(p, k0, sr) + 4);                \
                            S.sf2 = *(const f32x4*)ROW(p, k0, 32 + sr); S.sf3 = *(const f32x4*)(ROW(p, k0, 32 + sr) + 4); } while (0)
#define SWRITE_KF(bf) do { *(bf16x8*)(K_lds + (bf) * SHM_K + kws) = pack8(S.sf0, S.sf1); *(bf16x8*)(K_lds + (bf) * SHM_K + kws + 32 * 256) = pack8(S.sf2, S.sf3); } while (0)
#define SWRITE_VF(bf) do { *(bf16x8*)(V_lds + (bf) * SHM_V + vst0) = pack8(S.sf0, S.sf1); *(bf16x8*)(V_lds + (bf) * SHM_V + vst1) = pack8(S.sf2, S.sf3); } while (0)
template <class TIn, class TOut>
__device__ __forceinline__ void causal_swa_prime(const BlockRef<TIn, TOut>& cur, int W, char* lds, Seam<TIn>& S) {
    constexpr bool F32 = same_t<TIn, float>::v;
    const int tid = ltid(), wid = __builtin_amdgcn_readfirstlane(tid >> 6), lane = tid & 63, r32 = lane & 31, hi = lane >> 5;
    const int sr = tid >> 4, sc = (tid & 15) * 8, kws = KSWZ(sr, sc * 2); char* K_lds = lds + 2 * SHM_V;
    const int kb0 = cur.jlo * KVBLK;
    for (int d0 = 0; d0 < 8; ++d0) S.qr[d0] = load8<TIn>(cur.Q + (size_t)(wid * QBLK + r32) * QPITCH + d0 * 16 + hi * 8);
    if constexpr (F32) { SLOAD_F((const float*)cur.K, kb0); VMW(); SWRITE_KF(0); SBAR(); SLOAD_F((const float*)cur.V, kb0); }
    else { SLOAD_H(cur.K, cur.V, kb0); VMW(); SWRITE_HK(0); }
    __syncthreads();
}
template <class TIn, class TOut>
__device__ __forceinline__ void causal_swa_block(const BlockRef<TIn, TOut>& cur, const BlockRef<TIn, TOut>& nxt, int skv, int W, char* lds, Seam<TIn>& S) {
    constexpr bool F32 = same_t<TIn, float>::v;
    const int tid = ltid(), wid = __builtin_amdgcn_readfirstlane(tid >> 6), lane = tid & 63, r32 = lane & 31, hi = lane >> 5;
    const int j_lo = cur.jlo, j_hi = cur.jhi;
    const int NT = j_hi - j_lo;
    const int kbn = nxt.jlo * KVBLK;
    const int qlo = cur.P0 + wid * QBLK, qm = qlo + r32 - 4 * hi;
    char* V_lds = lds; char* K_lds = lds + 2 * SHM_V;
    float* ws = (float*)(lds + 2 * SHM_V + 2 * SHM_K) + wid * 64; float* li_l = ws, * al_l = ws + 32;
    float m_reg = -1e30f, l_reg = 0; f32x16 o[4] = {};
    const int sr = tid >> 4, sc = (tid & 15) * 8, vst0 = v_st(sr, sc), vst1 = v_st(32 + sr, sc), kws = KSWZ(sr, sc * 2);
    const int vb0 = (int)(uintptr_t)V_lds + v_rd_base(lane);
    const TIn* Kh = cur.K; const TIn* Vh = cur.V;
    const float alA_ = cur.A;
    unsigned selm = 0u;
    { const int qb_ = cur.P0 >> 8;
      if (qb_ > 0) {
        float* kmL = (float*)(K_lds + SHM_K);
        *(f32x4*)(kmL + 4 * tid) = *(const f32x4*)(cur.KM + (size_t)(tid >> 5) * 1024 + 4 * (tid & 31));
        __syncthreads();
        float g[16];
#pragma unroll
        for (int n = 0; n < 16; ++n) g[n] = 0.f;
#pragma unroll
        for (int d0 = 0; d0 < 8; ++d0) { float qf[8];
#pragma unroll
            for (int j = 0; j < 8; ++j) qf[j] = __uint_as_float(((unsigned)(unsigned short)S.qr[d0][j]) << 16);
#pragma unroll
            for (int n = 0; n < 16; ++n) if (n < qb_) { const f32x4 k0 = *(const f32x4*)(kmL + n * 128 + d0 * 16 + hi * 8), k1 = *(const f32x4*)(kmL + n * 128 + d0 * 16 + hi * 8 + 4);
                g[n] += qf[0] * k0[0] + qf[1] * k0[1] + qf[2] * k0[2] + qf[3] * k0[3] + qf[4] * k1[0] + qf[5] * k1[1] + qf[6] * k1[2] + qf[7] * k1[3]; }
            asm volatile("" ::: "memory"); }
#pragma unroll
        for (int n = 0; n < 16; ++n) { const float a = g[n] + __shfl_xor(g[n], 32); g[n] = n < qb_ ? a : -1e30f; }
#pragma unroll
        for (int r = 0; r < 3; ++r) { float best = -3e38f; int bi = 0;
#pragma unroll
            for (int n = 0; n < 16; ++n) if (!((selm >> n) & 1u) && g[n] > best) { best = g[n]; bi = n; }
            selm |= 1u << bi; }
        selm &= (1u << qb_) - 1u;
        __syncthreads();
      }
      li_l[r32] = __uint_as_float(selm); }
#define RESC(a) do { if (__any((a) < 1.f)) { if (hi == 0) al_l[r32] = (a); asm volatile("s_waitcnt lgkmcnt(0)" ::: "memory");              \
                     for (int d_ = 0; d_ < 4; ++d_) for (int r = 0; r < 16; ++r) o[d_][r] *= al_l[crow(r, hi)]; } } while (0)
#define KBASE(t) ((j_lo + (t)) * KVBLK)
#define ACT(t) (KBASE(t) <= qlo + QBLK - 1 && KBASE(t) + KVBLK - 1 >= qlo - W + 1)
#define MASKT(P0_, P1_, t) do { const int kb_ = KBASE(t); if ((!SK || ACT(t)) && (kb_ + KVBLK - 1 > qlo || kb_ <= qlo + QBLK - 1 - W)) mask_tile(P0_, P1_, qm - kb_, (unsigned)W); \
        _Pragma("unroll") for (int r = 0; r < 16; ++r) { const float c_ = (float)((r & 3) + 8 * (r >> 2)); P0_[r] = fmaf(alA_, c_, P0_[r]); P1_[r] = fmaf(alA_, c_, P1_[r]); } } while (0)
#define BASE0(t) ((KBASE(t) < cur.P0 && !((__float_as_uint(li_l[r32]) >> (KBASE(t) >> 8)) & 1u)) ? -__builtin_inff() : alA_ * (float)(KBASE(t) - cur.P0 + 4 * hi))
#define BASE1(t) (BASE0(t) + 32.f * alA_)
    constexpr int NQL = F32 ? 16 : 8;
    constexpr bool SK = WSKIP && !F32;
#define SEAM_K0() do { VMWN(NQL); if constexpr (F32) { SWRITE_KF(0); SBAR(); SLOAD_F((const float*)nxt.V, kbn); } else { SWRITE_HK(0); } SBAR(); } while (0)
    f32x16 pA0, pA1, pB0, pB1; float mnA, mnB, alA, alB; bf16x8 pa0, pa1, pa2, pa3;
    if constexpr (F32) { VMW(); SWRITE_VF(0); SBAR(); } else { SWRITE_HV(0); SBAR(); }
    if (NT > 1) { if constexpr (F32) SLOAD_F((const float*)Kh, KBASE(1)); else SLOAD_H(Kh, Vh, KBASE(1)); }
    SBAR(); qkt<0, SK>(pA0, pA1, K_lds, r32, hi, S.qr, ACT(0));
    if constexpr (F32) { if (NT > 1) { VMW(); SWRITE_KF(1); SBAR(); SLOAD_F((const float*)Vh, KBASE(1)); } }
    MASKT(pA0, pA1, 0); partialSM(pA0, pA1, m_reg, mnA, alA, BASE0(0), BASE1(0));
    if (NT > 1) { VMW(); if constexpr (F32) { SWRITE_VF(1); SBAR(); if (NT > 2) SLOAD_F((const float*)Kh, KBASE(2)); } else SWRITE_H(1); }
    __syncthreads();
#define HALF_STEP(PX0, PX1, mnX, alX, PY0, PY1, alY, t, KB, VB, SB) do {                                                      \
        SBAR(); qkt<KB, SK>(PX0, PX1, K_lds, r32, hi, S.qr, ACT(t));                                             \
        finishSM(PY0, PY1, alY, l_reg, pa0, pa1, pa2, pa3); SBAR();                                                           \
        if ((t) + 1 < NT) { if constexpr (F32) { VMW(); SWRITE_KF(SB); SBAR(); SLOAD_F((const float*)Vh, KBASE((t) + 1)); }  \
                            else { SLOAD_H(Kh, Vh, KBASE((t) + 1)); } SBAR(); }                                               \
        pv_tile<VB, SK>(o, vb0, pa0, pa1, pa2, pa3, ACT((t) - 1)); MASKT(PX0, PX1, (t)); partialSM(PX0, PX1, m_reg, mnX, alX, BASE0(t), BASE1(t));                                        \
        __syncthreads();                                                                                                      \
        if ((t) + 1 < NT) { VMW(); if constexpr (F32) { SWRITE_VF(SB); SBAR(); if ((t) + 2 < NT) SLOAD_F((const float*)Kh, KBASE((t) + 2)); } \
                            else { SWRITE_H(SB); } }                                                                          \
        RESC(alX); __syncthreads(); } while (0)
    for (int t = 1; t + 1 < NT; t += 2) {
        HALF_STEP(pB0, pB1, mnB, alB, pA0, pA1, alA, t, 1, 0, 0);
        HALF_STEP(pA0, pA1, mnA, alA, pB0, pB1, alB, t + 1, 0, 1, 1);
    }
    const bool even = (NT & 1) == 0;
    if (even) { SBAR(); qkt<1, SK>(pB0, pB1, K_lds, r32, hi, S.qr, ACT(NT - 1)); SBAR(); }
#define QROW(e) (nxt.Q + (size_t)(wid * QBLK + r32) * QPITCH + ((e) >> 1) * 16 + hi * 8 + ((e) & 1) * 4)
    if constexpr (F32) { SLOAD_F((const float*)nxt.K, kbn); SBAR();
#pragma unroll
        for (int e = 0; e < 8; ++e) S.tq[e] = *(const f32x4*)QROW(e); }
    else { SLOAD_H(nxt.K, nxt.V, kbn); SBAR();
#pragma unroll
        for (int d0 = 0; d0 < 8; ++d0) S.qr[d0] = load8<TIn>(nxt.Q + (size_t)(wid * QBLK + r32) * QPITCH + d0 * 16 + hi * 8); }
    SBAR();
    finishSM(pA0, pA1, alA, l_reg, pa0, pa1, pa2, pa3); SBAR();
    if constexpr (F32) {
#pragma unroll
        for (int e = 8; e < 16; ++e) S.tq[e] = *(const f32x4*)QROW(e); SBAR(); }
#undef QROW
    pv_tile<0, SK>(o, vb0, pa0, pa1, pa2, pa3, ACT(even ? NT - 2 : NT - 1));
    if (even) { MASKT(pB0, pB1, NT - 1); partialSM(pB0, pB1, m_reg, mnB, alB, BASE0(NT - 1), BASE1(NT - 1)); __syncthreads(); RESC(alB);
        finishSM(pB0, pB1, alB, l_reg, pa0, pa1, pa2, pa3); SBAR(); pv_tile<1, SK>(o, vb0, pa0, pa1, pa2, pa3, ACT(NT - 1)); }
    SBAR(); SEAM_K0();
    if (hi == 0) { li_l[r32] = l_reg; if (cur.ST) { cur.ST[(wid * QBLK + r32) * 16] = m_reg; cur.ST[(wid * QBLK + r32) * 16 + 1] = l_reg; } }
    asm volatile("s_waitcnt lgkmcnt(0)" ::: "memory");
    float rli[16];
#pragma unroll
    for (int r = 0; r < 16; ++r) { const float l_ = li_l[crow(r, hi)]; rli[r] = l_ > 0.f ? __builtin_amdgcn_rcpf(l_) : 0.f; }
    TOut* Ow = cur.O + (size_t)(wid * QBLK) * OPITCH;
#pragma unroll
    for (int r = 0; r < 16; ++r) { const int orow = crow(r, hi);
#pragma unroll
        for (int d0 = 0; d0 < 4; ++d0) { const float v = o[d0][r] * rli[r];
            if constexpr (same_t<TOut, float>::v) { Ow[(size_t)orow * OPITCH + d0 * 32 + r32] = v; }
            else { const float vn = __shfl_xor(v, 1);
                   if ((r32 & 1) == 0) *(unsigned*)(Ow + (size_t)orow * OPITCH + d0 * 32 + r32) = cvtpk(v, vn); } } }
    if constexpr (F32) {
#pragma unroll
        for (int d0 = 0; d0 < 8; ++d0) S.qr[d0] = pack8(S.tq[2 * d0], S.tq[2 * d0 + 1]); }
    __syncthreads();
#undef RESC
#undef KBASE
#undef ACT
#undef MASKT
#undef SEAM_K0
#undef HALF_STEP
}
#undef ROW
#undef VMW
#undef VMWN
#undef SLOAD_H
#undef SWRITE_HK
#undef SWRITE_HV
#undef SWRITE_H
#undef SLOAD_F
#undef SWRITE_KF
#undef SWRITE_VF

#undef BASE0
#undef BASE1
}
constexpr size_t WS_OSL = WS_XN, WS_OSU = WS_H;
constexpr size_t WS_STL = WS_WIN, WS_STU = WS_WIN + 1 * MiB;
constexpr int MOBA_SPLIT_QB = 8;
__device__ __forceinline__ void phase_moba(KP P, char* lds, int vcu, int G) {
    typedef moba::BlockRef<moba::bf16, moba::bf16> BR;
    const moba::bf16* proj = (const moba::bf16*)(P.ws + WS_PROJ); moba::bf16* AR = (moba::bf16*)(P.ws + WS_AR); const float* kmean = (const float*)(P.ws + WS_KMEAN);
    constexpr int W = 1 << 30;
    auto mkref = [&](int bh, int qb, int part) -> BR { const int b = bh >> 3, h = bh & 7; BR r; const int nt = 4 * qb + 4;
        r.Q = proj + (size_t)(b * SEQ + qb * 256) * INCP + h * 128; r.K = proj + (size_t)(b * SEQ) * INCP + C_AK + h * 128; r.V = proj + (size_t)(b * SEQ) * INCP + C_AV + h * 128;
        moba::bf16* ob = part == 0 ? AR : (moba::bf16*)(P.ws + (part == 1 ? WS_OSL : WS_OSU));
        r.O = ob + (size_t)(b * SEQ + qb * 256) * DM + h * 128; r.P0 = qb * 256; r.KM = kmean + (size_t)(b * 16) * 1024 + h * 128; r.A = exp2f(-(float)(h + 1)) * (1.f / moba::SCALE);
        r.jlo = part == 2 ? nt / 2 : 0; r.jhi = part == 1 ? nt / 2 : nt;
        r.ST = part == 0 ? nullptr : (float*)(P.ws + (part == 1 ? WS_STL : WS_STU)) + ((size_t)(b * SEQ + qb * 256) * 8 + h) * 2;
        return r; };
    moba::Seam<moba::bf16> S;
    if (G == 256) {
        const int q_ = vcu & 15, bh = vcu >> 4;
        const int qbA[16] = {-1, -1, 15, 15,  7, 14, 14, 13, 13,  6, 12, 12, 11, 11,  5, 10};
        const int ptA[16] = { 0,  0,  2,  1,  0,  2,  1,  2,  1,  0,  2,  1,  2,  1,  0,  2};
        const int qbB[16] = {-1, -1, -1, -1, -1,  0, -1,  1,  2,  3,  8,  8,  4,  9,  9, 10};
        const int ptB[16] = { 0,  0,  0,  0,  0,  0,  0,  0,  0,  0,  2,  1,  0,  2,  1,  1};
        int qa = -1, pa = 0, qb2 = -1, pb = 0;
#pragma unroll
        for (int k = 0; k < 16; ++k) if (k == q_) { qa = qbA[k]; pa = ptA[k]; qb2 = qbB[k]; pb = ptB[k]; }
        for (int it = 0; it < 2; ++it) { const int qq = it == 0 ? qa : qb2, pp = it == 0 ? pa : pb; if (qq < 0) continue;
            const BR cur = mkref(bh, qq, pp);
            moba::causal_swa_prime<moba::bf16, moba::bf16>(cur, W, lds, S);
            moba::causal_swa_block<moba::bf16, moba::bf16>(cur, cur, SEQ, W, lds, S); }
    } else {
        for (int item = vcu; item < 256; item += G) {
            const BR cur = mkref(item >> 4, item & 15, 0);
            moba::causal_swa_prime<moba::bf16, moba::bf16>(cur, W, lds, S);
            moba::causal_swa_block<moba::bf16, moba::bf16>(cur, cur, SEQ, W, lds, S); }
    }
}
__device__ __forceinline__ void moba_combine(KP P, int vcu, int G) {
    if (G != 256) return;
    const int tid = ltid(); const bf16* OL = (const bf16*)(P.ws + WS_OSL); const bf16* OU = (const bf16*)(P.ws + WS_OSU); bf16* AR = (bf16*)(P.ws + WS_AR);
    const float* STL = (const float*)(P.ws + WS_STL); const float* STU = (const float*)(P.ws + WS_STU);
    constexpr int NSPL = 16 - MOBA_SPLIT_QB; constexpr float C2 = 1.4426950408889634f * moba::SCALE;
    for (int item = vcu; item < 16 * NSPL * 2; item += G) {
        const int half = item & 1, k = item >> 1, bh = k / NSPL, qb = MOBA_SPLIT_QB + k % NSPL, b = bh >> 3, h = bh & 7;
        const int row = b * SEQ + qb * 256 + half * 128 + (tid >> 2), c0 = (tid & 3) * 32;
        const size_t so = ((size_t)row * 8 + h) * 2; const float mL = STL[so], lL = STL[so + 1], mU = STU[so], lU = STU[so + 1];
        const float m = fmaxf(mL, mU); const float wL = lL * __builtin_amdgcn_exp2f((mL - m) * C2), wU = lU * __builtin_amdgcn_exp2f((mU - m) * C2); const float inv = __builtin_amdgcn_rcpf(wL + wU);
        const float aL = wL * inv, aU = wU * inv; const size_t o = (size_t)row * DM + h * 128 + c0;
#pragma unroll
        for (int j = 0; j < 4; ++j) { const v4u l4 = *(const v4u*)(OL + o + 8 * j), u4 = *(const v4u*)(OU + o + 8 * j); v4u r4;
#pragma unroll
            for (int e = 0; e < 4; ++e) r4[e] = pk2(aL * bflo(l4[e]) + aU * bflo(u4[e]), aL * bfhi(l4[e]) + aU * bfhi(u4[e]));
            *(v4u*)(AR + o + 8 * j) = r4; }
    }
}
constexpr size_t WS_SKB = WS_KMEAN + 256 * 1024;
__device__ __forceinline__ void prologue_subkeys(KP P, int vcu, int G) {
    unsigned* dst = (unsigned*)(P.ws + WS_SKB);
    for (int i = vcu * NTHR + ltid(); i < 8 * 2 * 128 * 128 / 2; i += G * NTHR) dst[i] = pk2(P.sub_keys[2 * i], P.sub_keys[2 * i + 1]);
}
__device__ __forceinline__ unsigned f2key(float v) { const unsigned u = __float_as_uint(v); return u ^ ((u >> 31) ? 0xFFFFFFFFu : 0x80000000u); }
__device__ __forceinline__ float key2f(unsigned k) { return __uint_as_float(k ^ ((k >> 31) ? 0x80000000u : 0xFFFFFFFFu)); }
__device__ __forceinline__ unsigned umax3(unsigned a, unsigned b, unsigned c) { return max(max(a, b), c); }
__device__ __forceinline__ void peer_route_tiles(KP P, LAS unsigned char* lds, int tt0, int nitems, int h) {
    const int tid = ltid(), lane = tid & 63, wave = __builtin_amdgcn_readfirstlane(tid >> 6), l15 = lane & 15, q4 = lane >> 4;
    const bf16* PQ = (const bf16*)(P.ws + WS_PROJ); const bf16* SKB = (const bf16*)(P.ws + WS_SKB);
    int* ridx = (int*)(P.ws + WS_PROJ + 64 * MiB); float* rgate = (float*)(P.ws + WS_PROJ + 68 * MiB);
    for (int it_ = 0; it_ < nitems; ++it_) {
        LAS float* sval = (LAS float*)(lds + it_ * 16384); LAS int* sidx = (LAS int*)(lds + it_ * 16384 + 8192);
        const int tt = tt0 + it_, p = wave & 1, sub = wave >> 1, tl = sub * 16 + l15;
        const bf16* qp = PQ + ((size_t)tt * 64 + tl) * DM + h * 256 + p * 128 + 8 * q4;
        bf16x8 qb[4];
#pragma unroll
        for (int kk = 0; kk < 4; ++kk) qb[kk] = *(const bf16x8*)(qp + 32 * kk);
        const bf16* sk = SKB + ((size_t)((h * 2 + p) * 128 + l15)) * 128 + 8 * q4;
        unsigned key[32];
#pragma unroll
        for (int nt = 0; nt < 8; ++nt) { f32x4v acc = {0.f, 0.f, 0.f, 0.f};
#pragma unroll
            for (int kk = 0; kk < 4; ++kk) acc = __builtin_amdgcn_mfma_f32_16x16x32_bf16(*(const bf16x8*)(sk + nt * 16 * 128 + 32 * kk), qb[kk], acc, 0, 0, 0);
#pragma unroll
            for (int e = 0; e < 4; ++e) key[4 * nt + e] = (f2key(acc[e]) & ~127u) | (unsigned)(127 - (16 * nt + 4 * q4 + e)); }
#define CE(a_, b_) { const unsigned hi_ = max(KA[a_], KA[b_]), lo_ = min(KA[a_], KA[b_]); KA[a_] = hi_; KA[b_] = lo_; }
#define SORT16_NET CE(0,1) CE(2,3) CE(0,2) CE(1,3) CE(1,2) CE(4,5) CE(6,7) CE(4,6) CE(5,7) CE(5,6) CE(0,4) CE(2,6) CE(2,4) CE(1,5) CE(3,7) CE(3,5) CE(1,2) CE(3,4) CE(5,6) CE(8,9) CE(10,11) CE(8,10) CE(9,11) CE(9,10) CE(12,13) CE(14,15) CE(12,14) CE(13,15) CE(13,14) CE(8,12) CE(10,14) CE(10,12) CE(9,13) CE(11,15) CE(11,13) CE(9,10) CE(11,12) CE(13,14) CE(0,8) CE(4,12) CE(4,8) CE(2,10) CE(6,14) CE(6,10) CE(2,4) CE(6,8) CE(10,12) CE(1,9) CE(5,13) CE(5,9) CE(3,11) CE(7,15) CE(7,11) CE(3,5) CE(7,9) CE(11,13) CE(1,2) CE(3,4) CE(5,6) CE(7,8) CE(9,10) CE(11,12) CE(13,14)
#define BMERGE16(T_) _Pragma("unroll") for (int d_ = 8; d_ >= 1; d_ >>= 1) { _Pragma("unroll") for (int i_ = 0; i_ < 16; ++i_) if ((i_ & d_) == 0) { const unsigned hi_ = max(T_[i_], T_[i_ + d_]), lo_ = min(T_[i_], T_[i_ + d_]); T_[i_] = hi_; T_[i_ + d_] = lo_; } }
#define KA key
        SORT16_NET
#undef KA
#define KA (key + 16)
        SORT16_NET
#undef KA
        unsigned t16[16];
#pragma unroll
        for (int i = 0; i < 16; ++i) t16[i] = max(key[i], key[31 - i]);
        BMERGE16(t16)
        { const bool odd = (lane & 16) != 0; unsigned L[16];
#pragma unroll
          for (int i = 0; i < 16; ++i) L[i] = odd ? t16[15 - i] : t16[i];
#pragma unroll
          for (int i = 0; i < 16; ++i) { auto x = __builtin_amdgcn_permlane16_swap(L[i], L[i], false, false); t16[i] = max(x[0], x[1]); }
          BMERGE16(t16) }
        { const bool odd = (lane & 32) != 0; unsigned L[16];
#pragma unroll
          for (int i = 0; i < 16; ++i) L[i] = odd ? t16[15 - i] : t16[i];
#pragma unroll
          for (int i = 0; i < 16; ++i) { auto x = __builtin_amdgcn_permlane32_swap(L[i], L[i], false, false); t16[i] = max(x[0], x[1]); }
          BMERGE16(t16) }
#undef CE
#undef SORT16_NET
#undef BMERGE16
        if (q4 == 0) {
#pragma unroll
            for (int r4 = 0; r4 < 4; ++r4) {
                *(LAS f32x4*)(sval + (tl * 2 + p) * 16 + 4 * r4) = (f32x4){key2f(t16[4 * r4] & ~127u), key2f(t16[4 * r4 + 1] & ~127u), key2f(t16[4 * r4 + 2] & ~127u), key2f(t16[4 * r4 + 3] & ~127u)};
                *(LAS v4u*)(sidx + (tl * 2 + p) * 16 + 4 * r4) = (v4u){127u - (t16[4 * r4] & 127u), 127u - (t16[4 * r4 + 1] & 127u), 127u - (t16[4 * r4 + 2] & 127u), 127u - (t16[4 * r4 + 3] & 127u)}; }
        }
    }
    __syncthreads();
    {
        const int it_ = wave; const int tt = tt0 + it_;
        LAS float* sval = (LAS float*)(lds + it_ * 16384); LAS int* sidx = (LAS int*)(lds + it_ * 16384 + 8192);
        if (wave < nitems) {
            const LAS float* av = sval + (lane * 2) * 16; const LAS float* bv = av + 16; const LAS int* ai = sidx + (lane * 2) * 16; const LAS int* bi = ai + 16;
            unsigned hk[16];
            const float b0 = bv[0];
#pragma unroll
            for (int i4 = 0; i4 < 4; ++i4) { const f32x4 t4 = *(const LAS f32x4*)(av + 4 * i4);
#pragma unroll
                for (int e = 0; e < 4; ++e) hk[4 * i4 + e] = (f2key(t4[e] + b0) & ~255u) | (unsigned)(255 - (4 * i4 + e) * 16); }
            float bestv[16]; int beste[16];
#pragma unroll
            for (int r = 0; r < 16; ++r) {
                unsigned m0 = umax3(hk[0], hk[1], hk[2]), m1 = umax3(hk[3], hk[4], hk[5]), m2 = umax3(hk[6], hk[7], hk[8]), m3 = umax3(hk[9], hk[10], hk[11]);
                m0 = umax3(m0, hk[12], hk[13]); m1 = umax3(m1, hk[14], hk[15]);
                const unsigned best = max(max(m0, m1), max(m2, m3));
                const int f = 255 - (int)(best & 255u), bi_ = f >> 4, bj = f & 15;
                const float a_i = av[bi_]; bestv[r] = a_i + bv[bj]; beste[r] = ai[bi_] * 128 + bi[bj];
                const int nj = bj + 1;
                const unsigned nk = nj < 16 ? ((f2key(a_i + bv[nj & 15]) & ~255u) | (unsigned)(255 - (bi_ * 16 + nj))) : 0u;
#pragma unroll
                for (int i = 0; i < 16; ++i) hk[i] = i == bi_ ? nk : hk[i];
            }
            float se = 0.f; const float mx = bestv[0];
#pragma unroll
            for (int r = 0; r < 16; ++r) { bestv[r] = __expf(bestv[r] - mx); se += bestv[r]; }
            const float ise = 1.f / se; const size_t o = ((size_t)tt * 64 + lane) * 128 + h * 16;
#pragma unroll
            for (int r4 = 0; r4 < 4; ++r4) { *(v4u*)(ridx + o + 4 * r4) = (v4u){(unsigned)beste[4 * r4], (unsigned)beste[4 * r4 + 1], (unsigned)beste[4 * r4 + 2], (unsigned)beste[4 * r4 + 3]};
                *(f32x4*)(rgate + o + 4 * r4) = (f32x4){bestv[4 * r4] * ise, bestv[4 * r4 + 1] * ise, bestv[4 * r4 + 2] * ise, bestv[4 * r4 + 3] * ise}; }
        }
        __syncthreads();
    }
}
#define XB_TMO      128
#define XB_XCNT(j)  (256  + 64 * (j))
#define XB_XSUB(j)  (1280 + 64 * (j))
#define XB_XGEN(j)  (2304 + 64 * (j))
#define XB_TOP      3328
#define XB_TOPGEN   3392
#define XCD_BAR_WORDS 3456
#define XB_SPIN_CAP (1u << 18)

__device__ __forceinline__ unsigned xb_ld(unsigned* p)              { return __hip_atomic_load(p, __ATOMIC_RELAXED, __HIP_MEMORY_SCOPE_AGENT); }
__device__ __forceinline__ unsigned xb_add(unsigned* p, unsigned v) { return __hip_atomic_fetch_add(p, v, __ATOMIC_RELAXED, __HIP_MEMORY_SCOPE_AGENT); }
__device__ __forceinline__ unsigned xb_xcc_id() { return (unsigned)__builtin_amdgcn_s_getreg((3 << 11) | 20) & 0xFu; }
#define XB_SPIN(cond, bar) do { unsigned _sp = 0; while (cond) { __builtin_amdgcn_s_sleep(1); \
    if ((++_sp & 255u) == 0u) { if (xb_ld(&(bar)[XB_TMO])) break; if (_sp > XB_SPIN_CAP) { atomicAdd(&(bar)[XB_TMO], 1u); break; } } } } while (0)

struct XcdBarrier {
    unsigned* bar; unsigned x;
    volatile LAS unsigned* st;
};

__device__ __forceinline__ XcdBarrier xcd_barrier_post(unsigned* bar, volatile LAS unsigned* st) {
    XcdBarrier b; b.bar = bar; b.x = xb_xcc_id(); b.st = st;
    if (threadIdx.x == 0) (void)xb_add(&bar[XB_XCNT(b.x)], 1u);
    return b;
}
__device__ __forceinline__ void xcd_barrier_complete(unsigned* bar, unsigned x, unsigned& nloc, unsigned& nx) {
    const unsigned G = gridDim.x * gridDim.y * gridDim.z;
    unsigned sum, cnt, mine, sp = 0u;
    for (;;) {
        sum = 0u; cnt = 0u; mine = 0u;
#pragma unroll
        for (unsigned j = 0; j < 16; ++j) { const unsigned c = xb_ld(&bar[XB_XCNT(j)]); sum += c; cnt += (c > 0u) ? 1u : 0u; mine = (j == x) ? c : mine; }
        if (sum == G) break;
        __builtin_amdgcn_s_sleep(1);
        if ((++sp & 255u) == 0u) { if (xb_ld(&bar[XB_TMO])) break; if (sp > XB_SPIN_CAP) { atomicAdd(&bar[XB_TMO], 1u); break; } }
    }
    nloc = mine > 0u ? mine : 1u; nx = cnt > 0u ? cnt : 1u;
}

__device__ __forceinline__ void xcd_barrier(const XcdBarrier& b) {
    asm volatile("s_waitcnt vmcnt(0)" ::: "memory");
    __syncthreads();
    if (threadIdx.x == 0) {
        unsigned* bar = b.bar;
        __builtin_amdgcn_s_waitcnt(0);
        unsigned nloc = b.st[0], nx = b.st[1];
        if (nloc == 0u) { xcd_barrier_complete(bar, b.x, nloc, nx); b.st[0] = nloc; b.st[1] = nx; }
        const unsigned old = xb_add(&bar[XB_XSUB(b.x)], 1u);
        const unsigned gen = old / nloc;
        if (old + 1u == (gen + 1u) * nloc) {
            __builtin_amdgcn_fence(__ATOMIC_RELEASE, "agent");
            asm volatile("s_waitcnt vmcnt(0)" ::: "memory");
            const unsigned og = xb_add(&bar[XB_TOP], 1u);
            const unsigned tg = og / nx;
            if (og + 1u == (tg + 1u) * nx) xb_add(&bar[XB_TOPGEN], 1u);
            else XB_SPIN(xb_ld(&bar[XB_TOPGEN]) == tg, bar);
            __builtin_amdgcn_fence(__ATOMIC_ACQUIRE, "agent");
            xb_add(&bar[XB_XGEN(b.x)], 1u);
            asm volatile("s_waitcnt vmcnt(0)" ::: "memory");
        } else {
            XB_SPIN(xb_ld(&bar[XB_XGEN(b.x)]) == gen, bar);
            __builtin_amdgcn_fence(__ATOMIC_ACQUIRE, "agent");
            asm volatile("s_waitcnt vmcnt(0)" ::: "memory");
        }
    }
    __syncthreads();
}
#ifndef MK_ONE_LAUNCH
#define MK_ONE_LAUNCH 1
#endif
constexpr int N_PHASES = 11;
__global__ void __launch_bounds__(NTHR, 2) mega(Params Pkernarg) {
    extern __shared__ __attribute__((aligned(16))) unsigned char lds_raw[];
    LAS unsigned char* lds = (LAS unsigned char*)lds_raw;
    const int tid = ltid();
    const int G = gridDim.x, bx = blockIdx.x; const int vcu = (G % 8 == 0) ? (bx % 8) * (G / 8) + bx / 8 : bx;
    for (int u = tid; u < (LDS_BYTES - LDSCTL_OFF) / 4; u += NTHR) ((LAS unsigned*)(lds + LDSCTL_OFF))[u] = 0u;
    __syncthreads();
#if MK_ONE_LAUNCH
    XcdBarrier bar = xcd_barrier_post((unsigned*)(params_ptr()->ws + WS_CTL) + CW_BAR + params_ptr()->bar_li * XCD_BAR_WORDS, (volatile LAS unsigned*)(lds + MISC_OFF) + 8);
#define GRID_BAR() xcd_barrier(bar)
#else
#define GRID_BAR() do {} while (0)
#endif
#ifndef PHOFF
#define PHOFF 0
#endif
#define IN(k) (!((PHOFF >> (k)) & 1))
#define BOTH(k) (IN(k) && IN((k) + 1))
    if (IN(0)) { KP P = *params_ptr(); phase_prologue(P, lds, vcu, G); prologue_subkeys(P, vcu, G); prologue_lora(P, vcu, G); if (BOTH(0)) GRID_BAR(); }
    if (IN(1)) { KP P = *params_ptr();
        pg8::Gemm g{(const bf16*)(P.ws + WS_XN), (const bf16*)(P.ws + WS_WIN), TT, INCP, DM}; pg8::StaticOrder S; S.init(TT, INCP, G, bx);
        pg8::EpiBf16<0> E{(bf16*)(P.ws + WS_PROJ), INCP, nullptr, 0, 0, 1.f};
        pg8::gemm_phase<pg8::EpiBf16<0>, pg8::StaticOrder, true, true>(lds, g, S, E);
        phase_convert_tables(P, lds);
        if (BOTH(1)) GRID_BAR();
    }
    if (IN(2)) { KP P = *params_ptr(); phase_act(P, vcu, G); phase_kmean(P, lds, vcu, G); if (BOTH(2)) GRID_BAR(); }
    if (IN(3)) { KP P = *params_ptr(); phase_rwkv_stage_a(P, lds, vcu, G); if (BOTH(3)) GRID_BAR(); }
    if (IN(4)) { KP P = *params_ptr(); if ((vcu & 15) < 2 && vcu < 256) rwkv_stage_b(P, lds, (vcu >> 4) * 2 + (vcu & 15)); phase_moba(P, (char*)lds_raw, vcu, G); }
    if (IN(5)) { GRID_BAR(); KP P = *params_ptr(); moba_combine(P, vcu, G); GRID_BAR(); }
    if (IN(6)) { KP P = *params_ptr();
        pg8::Gemm g{(const bf16*)(P.ws + WS_AR), (const bf16*)(P.ws + WS_WOUT), TT, DM, DM}; pg8::StaticOrder S; S.init(TT, DM, G, bx);
        pg8::EpiH E{P.x, (bf16*)(P.ws + WS_XN), (float*)(P.ws + WS_SSP), DM};
        pg8::gemm_phase<pg8::EpiH, pg8::StaticOrder, true, true>(lds, g, S, E);
        if (BOTH(6)) GRID_BAR();
    }
    if (IN(8)) { KP P = *params_ptr(); phase_rstd(P, vcu, G); GRID_BAR();
        pg8::Gemm g{(const bf16*)(P.ws + WS_XN), (const bf16*)(P.ws + WS_WQ), TT, DM, DM}; pg8::StaticOrder S; S.init(TT, DM, G, bx);
        pg8::EpiBf16Row E{(bf16*)(P.ws + WS_PROJ), DM, (const float*)(P.ws + WS_SSP + 2 * MiB)};
        pg8::gemm_phase<pg8::EpiBf16Row, pg8::StaticOrder, true, true>(lds, g, S, E);
        if (G == 256) { const int wg_ = (bx & 7) * 32 + (bx >> 3); pg8::Unit u; u.pm = (wg_ >> 6) * 8 + (wg_ & 7); u.pn = (wg_ & 63) >> 3;
            asm volatile("s_waitcnt vmcnt(0)" ::: "memory"); __syncthreads(); __builtin_amdgcn_fence(__ATOMIC_ACQUIRE, "agent"); asm volatile("s_waitcnt vmcnt(0)" ::: "memory");
            peer_route_tiles(P, lds, 4 * u.pm, 4, u.pn);
        } else if (G != 256) { GRID_BAR(); for (int item = vcu; item < 1024; item += G) peer_route_tiles(P, lds, item >> 3, 1, item & 7); }
        if (BOTH(8)) GRID_BAR();
    }
    if (IN(10)) { KP P = *params_ptr(); phase_peer_sliced(P, lds, bx, G); }
#undef IN
#undef BOTH
}

extern "C" void kernel_launch(void* const* d_in, const int* in_sizes, int n_in, void* d_out, int out_size, void* d_ws, size_t ws_size, hipStream_t stream) {
    static int grid = 0;
    if (grid == 0) {
        if (n_in != 21 || in_sizes[0] != TT * DM || out_size != TT * DM || ws_size < WS_END) {
            fprintf(stderr, "kernel_launch: unexpected shapes: n_in %d in0 %d out %d ws %zu\n", n_in, n_in > 0 ? in_sizes[0] : -1, out_size, ws_size); grid = -1; return; }
        int dev = 0, cus = 0;
        if (hipGetDevice(&dev) != hipSuccess || hipDeviceGetAttribute(&cus, hipDeviceAttributeMultiprocessorCount, dev) != hipSuccess) { grid = -1; return; }
        if (hipFuncSetAttribute((const void*)mega, hipFuncAttributeMaxDynamicSharedMemorySize, LDS_BYTES) != hipSuccess) { fprintf(stderr, "kernel_launch: hipFuncSetAttribute failed\n"); grid = -1; return; }
        int per_cu = 0;
        if (hipOccupancyMaxActiveBlocksPerMultiprocessor(&per_cu, (const void*)mega, NTHR, LDS_BYTES) != hipSuccess || per_cu < 1) fprintf(stderr, "kernel_launch: occupancy query says %d blocks per CU\n", per_cu);
        (void)hipGetLastError();
        grid = cus;
    }
    if (grid < 0) return;
    (void)hipMemsetAsync((char*)d_ws + WS_CTL, 0, CTL_ZERO_BYTES, stream);
    Params p{};
    p.x = (const float*)d_in[0]; p.norm1_g = (const float*)d_in[1]; p.w_in = (const float*)d_in[2]; p.mu = (const float*)d_in[3]; p.w0 = (const float*)d_in[4];
    p.w2 = (const float*)d_in[5]; p.a0 = (const float*)d_in[6]; p.a2 = (const float*)d_in[7]; p.g2 = (const float*)d_in[8]; p.k_k = (const float*)d_in[9];
    p.k_a = (const float*)d_in[10]; p.r_k = (const float*)d_in[11]; p.ln_g = (const float*)d_in[12]; p.ln_b = (const float*)d_in[13]; p.w_out = (const float*)d_in[14];
    p.norm2_g = (const float*)d_in[15]; p.wq = (const float*)d_in[16]; p.sub_keys = (const float*)d_in[17]; p.pu = (const float*)d_in[18]; p.pv = (const float*)d_in[19];
    p.final_g = (const float*)d_in[20]; p.out = (float*)d_out; p.ws = (unsigned char*)d_ws;
    p.ph_lo = 0; p.ph_hi = N_PHASES; p.bar_li = 0;
    hipLaunchKernelGGL(mega, dim3(grid), dim3(NTHR), LDS_BYTES, stream, p);
}
```

```cpp
#include <hip/hip_runtime.h>
#include <cstdio>
#include <cstdint>
__device__ __forceinline__ int ltid() { int t = threadIdx.x; asm volatile("" : "+v"(t)); return t; }
namespace pg8 {
#define PG8_LAS __attribute__((address_space(3)))
typedef unsigned short bf16_t;
typedef short bf16x8 __attribute__((ext_vector_type(8)));
typedef float f32x4 __attribute__((ext_vector_type(4)));
typedef unsigned u32x4 __attribute__((ext_vector_type(4)));
constexpr int BM = 256, BK = 64, HALF = 128, HTB = HALF * BK * 2  , STAGE_BYTES = 8 * HTB, NXCD = 8, WGM = 8;

__host__ __device__ __forceinline__ int lds_byte(int r, int c) { const int st = (r >> 4) * 2 + (c >> 5), rr = r & 15, cc = c & 31, ob = rr * 64 + cc * 2; return st * 1024 + (ob ^ (((ob >> 9) & 1) << 5)); }
__host__ __device__ __forceinline__ void stage_rc(int b, int& R, int& C) { const int st = b / 1024, sb = b % 1024, swz = sb ^ (((sb >> 9) & 1) << 5); R = (st >> 1) * 16 + swz / 64; C = (st & 1) * 32 + (swz % 64) / 2; }
__host__ __device__ __forceinline__ int perm32(int rho) { const int n = rho >> 4, i = rho & 15; return 8 * (i >> 2) + 4 * n + (i & 3); }

struct Unit { int pm, pn; };
struct Gemm { const bf16_t* A; const bf16_t* Bt; int M, N, K; };

struct StaticOrder {
    int nM, nN, nwg, G, c;
    __host__ __device__ void init(int M, int N, int G_, int c_) { nM = M / BM; nN = N / BM; nwg = nM * nN; G = G_; c = c_; }
    __host__ __device__ bool next(int i, Unit& u) const {
        const long L = (long)i * G + c; if (L >= nwg) return false;
        int wgid = (int)L; { const int q = nwg / NXCD, r = nwg % NXCD, xcd = wgid % NXCD, off = wgid / NXCD; wgid = (xcd < r ? xcd * (q + 1) : r * (q + 1) + (xcd - r) * q) + off; }
        const int nig = WGM * nN, gid = wgid / nig, fm = gid * WGM, gsz = (nM - fm) < WGM ? (nM - fm) : WGM;
        u.pm = fm + ((wgid % nig) % gsz); u.pn = (wgid % nig) / gsz; return true;
    }
    __device__ __forceinline__ void a_ready(const Unit&) const {}
    __device__ __forceinline__ void done(const Unit&) const {}
};

__device__ __forceinline__ unsigned cvt_pk_bf16(float lo, float hi) { unsigned r; asm volatile("v_cvt_pk_bf16_f32 %0, %1, %2" : "=v"(r) : "v"(lo), "v"(hi)); return r; }
typedef float f32x2 __attribute__((ext_vector_type(2)));
__device__ __forceinline__ f32x2 gelu_pk(f32x2 v) {
    const f32x2 av = __builtin_elementwise_abs(v), d = av * 0.2316418882f + 1.0f;
    f32x2 t; t.x = __builtin_amdgcn_rcpf(d.x); t.y = __builtin_amdgcn_rcpf(d.y);
    f32x2 q = t * 0.5307027145f + (-0.7265760135f); q = q * t + 0.7107068705f; q = q * t + (-0.142248368f); q = q * t + 0.127414796f; q = q * t;
    const f32x2 s = (v * v) * (-0.72134752044f);
    f32x2 e; e.x = __builtin_amdgcn_exp2f(s.x); e.y = __builtin_amdgcn_exp2f(s.y);
    const f32x2 m = v * (q * e), r = v - m;
    f32x2 o; o.x = v.x < 0.f ? m.x : r.x; o.y = v.y < 0.f ? m.y : r.y; return o;
}

template <int ACT  > struct EpiBf16 {
    static constexpr bool PERM = true, AFTER_DRAIN = false; static_assert(ACT == 0 || ACT == 1, "EpiBf16: ACT is 0 (none) or 1 (gelu_pk)");
    bf16_t* O; int ldc; const float* bias; int split_cols; size_t split_stride; float scale0;
    __device__ __forceinline__ void operator()(const f32x4 (&acc)[2][2][4][2], const Unit& u, int wr, int wc, int fr, int fq) const {
        const int row0 = u.pm * BM + wr * 64 + fr; int colt = u.pn * BM; bf16_t* base = O;
        float sc = 1.f; if (split_cols) { const int t = colt / split_cols; base += (size_t)t * split_stride; colt -= t * split_cols; if (t == 0) sc = scale0; }
        const int col0 = colt + wc * 32 + 8 * fq, bcol0 = u.pn * BM + wc * 32 + 8 * fq;
        f32x4 bv[2][2];
#pragma unroll
        for (int bj = 0; bj < 2; ++bj)
#pragma unroll
            for (int n = 0; n < 2; ++n) bv[bj][n] = bias ? *(const f32x4*)(bias + bcol0 + bj * HALF + 4 * n) : (f32x4){0.f, 0.f, 0.f, 0.f};
#pragma unroll
        for (int ai = 0; ai < 2; ++ai)
#pragma unroll
            for (int m = 0; m < 4; ++m) { bf16_t* rowp = base + (size_t)(row0 + ai * HALF + m * 16) * ldc + col0;
#pragma unroll
                for (int bj = 0; bj < 2; ++bj) { f32x4 v0 = acc[ai][bj][m][0] + bv[bj][0], v1 = acc[ai][bj][m][1] + bv[bj][1];
                    if (ACT == 1) { f32x2 a = gelu_pk((f32x2){v0[0], v0[1]}), b = gelu_pk((f32x2){v0[2], v0[3]}), c = gelu_pk((f32x2){v1[0], v1[1]}), d = gelu_pk((f32x2){v1[2], v1[3]});
                        v0 = (f32x4){a.x, a.y, b.x, b.y}; v1 = (f32x4){c.x, c.y, d.x, d.y}; }
                    v0 = v0 * sc; v1 = v1 * sc; u32x4 w; w.x = cvt_pk_bf16(v0[0], v0[1]); w.y = cvt_pk_bf16(v0[2], v0[3]); w.z = cvt_pk_bf16(v1[0], v1[1]); w.w = cvt_pk_bf16(v1[2], v1[3]);
                    *(u32x4*)(rowp + bj * HALF) = w; } }
    }
};
template <class Epi, class Sched, bool ALIGN_EPI = false, bool SP2 = false>
__device__ __forceinline__ void gemm_phase(PG8_LAS unsigned char* lds, const Gemm g, const Sched& S, const Epi& E) {
    const int tid = ltid(), wid = __builtin_amdgcn_readfirstlane(tid >> 6), lane = tid & 63, wr = wid >> 2, wc = wid & 3, fr = lane & 15, fq = lane >> 4;
    const int K = g.K, nt = K / BK;
    unsigned voffA[2], voffB[2];
#pragma unroll
    for (int i = 0; i < 2; ++i) { int R, C; stage_rc(tid * 16 + i * 8192, R, C); const int Rb = Epi::PERM ? ((R & ~31) + perm32(R & 31)) : R;
        voffA[i] = (unsigned)(R * K + C) * 2u; voffB[i] = (unsigned)(Rb * K + C) * 2u; }
    const size_t kstep = (size_t)(BK * 2);
    const size_t hstep = (size_t)HALF * K * 2;
    const size_t tstep = 2 * hstep;
    const unsigned ldsw = (unsigned)wid * 1024u;
    const int aoff = lds_byte(wr * 64 + fr, fq * 8), boff = lds_byte(wc * 32 + fr, fq * 8);
#define PG8_SA(b, h) (((b) * 2 + (h)) * HTB)
#define PG8_SB(b, h) ((4 + (b) * 2 + (h)) * HTB)
#define PG8_STAGE(bufoff, gbase, voff) do { _Pragma("unroll") for (int _i = 0; _i < 2; ++_i) \
        __builtin_amdgcn_global_load_lds((const unsigned*)((const char*)(gbase) + (voff)[_i]), (PG8_LAS unsigned*)(lds + (bufoff) + ldsw + _i * 8192), 16, 0, 0); } while (0)
#define PG8_LDA(dst, b, h) do { _Pragma("unroll") for (int m = 0; m < 4; ++m) _Pragma("unroll") for (int k = 0; k < 2; ++k) dst[m][k] = *(const PG8_LAS bf16x8*)(lds + PG8_SA(b, h) + aoff + m * 2048 + k * 1024); } while (0)
#define PG8_LDB(dst, b, h) do { _Pragma("unroll") for (int n = 0; n < 2; ++n) _Pragma("unroll") for (int k = 0; k < 2; ++k) dst[n][k] = *(const PG8_LAS bf16x8*)(lds + PG8_SB(b, h) + boff + n * 2048 + k * 1024); } while (0)
#define PG8_MMA(ai, bj, At, Bt) do { __builtin_amdgcn_s_setprio(1); _Pragma("unroll") for (int m = 0; m < 4; ++m) _Pragma("unroll") for (int n = 0; n < 2; ++n) _Pragma("unroll") for (int k = 0; k < 2; ++k) \
        acc[ai][bj][m][n] = __builtin_amdgcn_mfma_f32_16x16x32_bf16(Bt[n][k], At[m][k], acc[ai][bj][m][n], 0, 0, 0); __builtin_amdgcn_s_setprio(0); } while (0)
#define PG8_WAIT_V(n) asm volatile("s_waitcnt vmcnt(" #n ")" ::: "memory")
#define PG8_WAIT_L(n) asm volatile("s_waitcnt lgkmcnt(" #n ")" ::: "memory")
#define PG8_BAR __builtin_amdgcn_s_barrier()
#define PG8_SCHED __builtin_amdgcn_sched_barrier(0)
    Unit cur, nxt; int ui = 0;
    if (!S.next(0, cur)) return;
    f32x4 acc[2][2][4][2];
#pragma unroll
    for (int a = 0; a < 2; ++a)
#pragma unroll
        for (int b = 0; b < 2; ++b)
#pragma unroll
            for (int m = 0; m < 4; ++m)
#pragma unroll
                for (int n = 0; n < 2; ++n) acc[a][b][m][n] = (f32x4){0.f, 0.f, 0.f, 0.f};
    bf16x8 At[4][2], B0[2][2], B1[2][2];
    const char* cA = (const char*)g.A + (size_t)cur.pm * tstep; const char* cB = (const char*)g.Bt + (size_t)cur.pn * tstep;
    S.a_ready(cur);
    if constexpr (SP2) {
        PG8_STAGE(PG8_SB(0, 0), cB, voffB); PG8_STAGE(PG8_SB(0, 1), cB + hstep, voffB); PG8_STAGE(PG8_SA(0, 0), cA, voffA); PG8_STAGE(PG8_SA(0, 1), cA + hstep, voffA);
        if (wr == 1) PG8_BAR;
        PG8_WAIT_V(2); PG8_BAR;
        PG8_STAGE(PG8_SB(1, 0), cB + kstep, voffB); PG8_STAGE(PG8_SA(1, 0), cA + kstep, voffA); PG8_STAGE(PG8_SB(1, 1), cB + hstep + kstep, voffB);
        PG8_WAIT_V(6); PG8_BAR;
    } else {
        PG8_STAGE(PG8_SB(0, 0), cB, voffB); PG8_STAGE(PG8_SA(0, 0), cA, voffA); PG8_STAGE(PG8_SB(0, 1), cB + hstep, voffB); PG8_STAGE(PG8_SA(0, 1), cA + hstep, voffA);
        if (wr == 1) PG8_BAR;
        PG8_WAIT_V(4); PG8_BAR;
        PG8_STAGE(PG8_SB(1, 0), cB + kstep, voffB); PG8_STAGE(PG8_SA(1, 0), cA + kstep, voffA); PG8_STAGE(PG8_SB(1, 1), cB + hstep + kstep, voffB);
        PG8_WAIT_V(6); PG8_BAR;
    }
    for (;;) {
        const bool has_next = S.next(ui + 1, nxt);
        const char* nA = has_next ? (const char*)g.A + (size_t)nxt.pm * tstep : cA; const char* nB = has_next ? (const char*)g.Bt + (size_t)nxt.pn * tstep : cB;
        for (int t = 0; t < nt; t += 2) {
            const bool last = (t == nt - 2);
            const char* a1 = cA + (size_t)(t + 1) * kstep;
            const char* a2 = last ? nA : cA + (size_t)(t + 2) * kstep; const char* b2 = last ? nB : cB + (size_t)(t + 2) * kstep;
            const char* a3 = a2 + kstep; const char* b3 = b2 + kstep;
            if (last && has_next) S.a_ready(nxt);
            if constexpr (SP2) {
            PG8_LDB(B0, 0, 0); PG8_LDB(B1, 0, 1); PG8_SCHED; PG8_LDA(At, 0, 0); PG8_STAGE(PG8_SA(1, 1), a1 + hstep, voffA);
            PG8_WAIT_V(8); PG8_WAIT_L(0); PG8_BAR; PG8_MMA(0, 0, At, B0); PG8_MMA(0, 1, At, B1); PG8_BAR; PG8_SCHED;
            PG8_LDA(At, 0, 1); PG8_STAGE(PG8_SB(0, 0), b2, voffB); PG8_STAGE(PG8_SB(0, 1), b2 + hstep, voffB); PG8_STAGE(PG8_SA(0, 0), a2, voffA);
            PG8_WAIT_V(8); PG8_WAIT_L(0); PG8_BAR; PG8_MMA(1, 0, At, B0); PG8_MMA(1, 1, At, B1); PG8_BAR; PG8_SCHED;
            PG8_LDB(B0, 1, 0); PG8_LDB(B1, 1, 1); PG8_SCHED; PG8_LDA(At, 1, 0); PG8_STAGE(PG8_SA(0, 1), a2 + hstep, voffA);
            PG8_WAIT_V(8); PG8_WAIT_L(0); PG8_BAR; PG8_MMA(0, 0, At, B0); PG8_MMA(0, 1, At, B1); PG8_BAR; PG8_SCHED;
            PG8_LDA(At, 1, 1); PG8_STAGE(PG8_SB(1, 0), b3, voffB); PG8_STAGE(PG8_SB(1, 1), b3 + hstep, voffB); PG8_STAGE(PG8_SA(1, 0), a3, voffA);
            PG8_WAIT_V(8); PG8_WAIT_L(0); PG8_BAR; PG8_MMA(1, 0, At, B0); PG8_MMA(1, 1, At, B1); PG8_BAR; PG8_SCHED;
            } else {
            PG8_LDB(B0, 0, 0); PG8_SCHED; PG8_LDA(At, 0, 0); PG8_STAGE(PG8_SA(1, 1), a1 + hstep, voffA);
            PG8_WAIT_L(8); PG8_BAR; PG8_WAIT_L(0); PG8_MMA(0, 0, At, B0); PG8_BAR; PG8_SCHED;
            PG8_LDB(B1, 0, 1); PG8_STAGE(PG8_SB(0, 0), b2, voffB);
            PG8_BAR; PG8_WAIT_L(0); PG8_MMA(0, 1, At, B1); PG8_BAR;
            PG8_LDA(At, 0, 1); PG8_STAGE(PG8_SA(0, 0), a2, voffA);
            PG8_BAR; PG8_WAIT_L(0); PG8_MMA(1, 0, At, B0); PG8_BAR; PG8_SCHED;
            PG8_STAGE(PG8_SB(0, 1), b2 + hstep, voffB);
            PG8_WAIT_V(6); PG8_BAR; PG8_MMA(1, 1, At, B1); PG8_BAR;
            PG8_LDB(B0, 1, 0); PG8_SCHED; PG8_LDA(At, 1, 0); PG8_STAGE(PG8_SA(0, 1), a2 + hstep, voffA);
            PG8_WAIT_L(8); PG8_BAR; PG8_WAIT_L(0); PG8_MMA(0, 0, At, B0); PG8_BAR; PG8_SCHED;
            PG8_LDB(B1, 1, 1); PG8_STAGE(PG8_SB(1, 0), b3, voffB);
            PG8_BAR; PG8_WAIT_L(0); PG8_MMA(0, 1, At, B1); PG8_BAR;
            PG8_LDA(At, 1, 1); PG8_STAGE(PG8_SA(1, 0), a3, voffA);
            PG8_BAR; PG8_WAIT_L(0); PG8_MMA(1, 0, At, B0); PG8_BAR; PG8_SCHED;
            PG8_STAGE(PG8_SB(1, 1), b3 + hstep, voffB);
            PG8_WAIT_V(6); PG8_BAR; PG8_MMA(1, 1, At, B1); PG8_BAR;
            }
        }
        if constexpr (ALIGN_EPI) { if (wr == 0) PG8_BAR; }
        if constexpr (!Epi::AFTER_DRAIN) { E(acc, cur, wr, wc, fr, fq); S.done(cur); }
        if (!has_next) break;
#pragma unroll
        for (int a = 0; a < 2; ++a)
#pragma unroll
            for (int b = 0; b < 2; ++b)
#pragma unroll
                for (int m = 0; m < 4; ++m)
#pragma unroll
                    for (int n = 0; n < 2; ++n) acc[a][b][m][n] = (f32x4){0.f, 0.f, 0.f, 0.f};
        cur = nxt; cA = nA; cB = nB; ++ui;
        if constexpr (ALIGN_EPI) { if (wr == 1) PG8_BAR; }
    }
    PG8_WAIT_V(0);
    if constexpr (!ALIGN_EPI) { if (wr == 0) PG8_BAR; }
    PG8_BAR;
    if constexpr (Epi::AFTER_DRAIN) { E.fused(acc, cur, wr, wc, fr, fq, lds, wid, lane); S.done(cur); }
#undef PG8_SA
#undef PG8_SB
#undef PG8_STAGE
#undef PG8_LDA
#undef PG8_LDB
#undef PG8_MMA
#undef PG8_WAIT_V
#undef PG8_WAIT_L
#undef PG8_BAR
#undef PG8_SCHED
}
}
#define GAS __attribute__((address_space(1)))
#define LAS __attribute__((address_space(3)))
typedef unsigned short bf16;
typedef unsigned v4u __attribute__((ext_vector_type(4)));
typedef unsigned v2u __attribute__((ext_vector_type(2)));
typedef float f32x4 __attribute__((ext_vector_type(4)));
constexpr int NWAVES = 8, NTHR = 512;
constexpr int TT = 8192, DM = 2048, SEQ = 4096;
constexpr int INC = 6592, INCP = 6656;
constexpr int C_AK = 1024, C_AV = 2048, C_RW = 3072;
constexpr int RWC = 3520;
constexpr float RMS_EPS = 1e-6f;
constexpr size_t MiB = 1u << 20;
constexpr size_t WS_CTL = 0, CTL_ZERO_BYTES = 1 * MiB;
constexpr size_t WS_WIN = 1 * MiB;
constexpr size_t WS_WOUT = 27 * MiB;
constexpr size_t WS_WQ = 35 * MiB;
constexpr size_t WS_XN = 43 * MiB;
constexpr size_t WS_PROJ = 75 * MiB;
constexpr size_t WS_AR = 179 * MiB;
constexpr size_t WS_H = 211 * MiB;
constexpr size_t WS_RWA = 275 * MiB;
constexpr size_t WS_CHK = 339 * MiB;
constexpr size_t WS_KMEAN = 467 * MiB;
constexpr size_t WS_ACT = WS_H;
constexpr size_t WS_SSP = WS_WIN + 4 * MiB;
constexpr size_t WS_LORA = 468 * MiB;
constexpr size_t WS_END = 469 * MiB;
constexpr int CW_BAR = 4096, CW_MOBA_CTR = 16384, CW_SS = 32768;
constexpr int RING_BYTES = 147456, LDSCTL_OFF = RING_BYTES, MISC_OFF = LDSCTL_OFF + 320, LDS_BYTES = 163840;

struct Params {
    const float* x; const float* norm1_g; const float* w_in; const float* mu; const float* w0; const float* w2; const float* a0; const float* a2; const float* g2;
    const float* k_k; const float* k_a; const float* r_k; const float* ln_g; const float* ln_b; const float* w_out; const float* norm2_g; const float* wq;
    const float* sub_keys; const float* pu; const float* pv; const float* final_g;
    float* out; unsigned char* ws;
    int ph_lo, ph_hi, bar_li, pad;
};

typedef const __attribute__((address_space(4))) Params& KP;
__device__ __forceinline__ const __attribute__((address_space(4))) Params* params_ptr() {
    const __attribute__((address_space(4))) Params* ka = (const __attribute__((address_space(4))) Params*)__builtin_amdgcn_kernarg_segment_ptr(); asm volatile("" : "+s"(ka)); return ka; }
typedef float f32x2_t __attribute__((ext_vector_type(2))); typedef __bf16 bf16x2_t __attribute__((ext_vector_type(2)));
__device__ __forceinline__ unsigned pk2(float lo, float hi) { const f32x2_t v = {lo, hi}; const bf16x2_t b = __builtin_convertvector(v, bf16x2_t); return __builtin_bit_cast(unsigned, b); }
__device__ __forceinline__ unsigned f2bf(float f) { return pk2(f, 0.f) & 0xffffu; }
__device__ __forceinline__ float bf2f(bf16 v) { return __builtin_bit_cast(float, (unsigned)v << 16); }
__device__ __forceinline__ float bflo(unsigned u) { return __builtin_bit_cast(float, u << 16); }
__device__ __forceinline__ float bfhi(unsigned u) { return __builtin_bit_cast(float, u & 0xffff0000u); }
#define DPP_F(v, ctrl) __builtin_bit_cast(float, __builtin_amdgcn_update_dpp(0, __builtin_bit_cast(int, (v)), (ctrl), 0xf, 0xf, true))
__device__ __forceinline__ float wave_sum(float v) {
    v += DPP_F(v, 0xB1);
    v += DPP_F(v, 0x4E);
    v += DPP_F(v, 0x141);
    v += DPP_F(v, 0x140);
    const int b = __builtin_bit_cast(int, v);
    return (__builtin_bit_cast(float, __builtin_amdgcn_readlane(b, 0)) + __builtin_bit_cast(float, __builtin_amdgcn_readlane(b, 16))) +
           (__builtin_bit_cast(float, __builtin_amdgcn_readlane(b, 32)) + __builtin_bit_cast(float, __builtin_amdgcn_readlane(b, 48)));
}
__device__ __forceinline__ float wave_max(float v) {
#pragma unroll
    for (int o = 1; o < 64; o <<= 1) v = fmaxf(v, __shfl_xor(v, o));
    return v;
}
#define LDS_WAIT() asm volatile("s_waitcnt lgkmcnt(0)" ::: "memory")

__device__ __forceinline__ void p0_transpose_item(const float* W, int K, int N, bf16* WT, LAS float* scr, int item, int lane, const float* ksc = nullptr) {
    const int nblk = N / 32, kb = item / nblk, nb = item % nblk, k0 = 64 * kb, n0 = 32 * nb;
#pragma unroll 8
    for (int i = 0; i < 32; ++i) { const int kk = 2 * i + (lane >> 5); float wv = W[(size_t)(k0 + kk) * N + n0 + (lane & 31)]; if (ksc) wv *= ksc[k0 + kk]; scr[kk * 33 + (lane & 31)] = wv; }
    LDS_WAIT(); asm volatile("" ::: "memory");
    const int c = lane & 7;
#pragma unroll
    for (int j = 0; j < 4; ++j) { const int n = (lane >> 3) + 8 * j; const LAS float* s = scr + (8 * c) * 33 + n;
        v4u o; o.x = pk2(s[0 * 33], s[1 * 33]); o.y = pk2(s[2 * 33], s[3 * 33]); o.z = pk2(s[4 * 33], s[5 * 33]); o.w = pk2(s[6 * 33], s[7 * 33]);
        *(v4u*)(WT + (size_t)(n0 + n) * K + k0 + 8 * c) = o; }
    LDS_WAIT(); asm volatile("" ::: "memory");
}
__device__ __forceinline__ void rms_row_to_bf16(const float* xrow, const float* g, bf16* orow, int lane) {
    const f32x4* xr = (const f32x4*)xrow + lane;
    f32x4 v[8]; float s = 0.f;
#pragma unroll
    for (int j = 0; j < 8; ++j) { v[j] = xr[64 * j]; s += (v[j].x * v[j].x + v[j].y * v[j].y) + (v[j].z * v[j].z + v[j].w * v[j].w); }
    const float rs = 1.0f / sqrtf(wave_sum(s) * (1.f / DM) + RMS_EPS);
    v2u* o8 = (v2u*)orow + lane;
#pragma unroll
    for (int j = 0; j < 8; ++j) { const f32x4 gg = ((const f32x4*)g)[lane + 64 * j];
        v2u o; o.x = pk2(v[j].x * rs * gg.x, v[j].y * rs * gg.y); o.y = pk2(v[j].z * rs * gg.z, v[j].w * rs * gg.w); o8[64 * j] = o; }
}
__device__ __forceinline__ void phase_prologue(KP P, LAS unsigned char* lds, int vcu, int G) {
    const int tid = ltid(), lane = tid & 63, wave = tid >> 6;
    LAS float* scr = (LAS float*)(lds + wave * 16384);
    const int gw = vcu * NWAVES + wave, NGW = G * NWAVES;
    bf16* WIN = (bf16*)(P.ws + WS_WIN); bf16* WOUT = (bf16*)(P.ws + WS_WOUT); bf16* WQ = (bf16*)(P.ws + WS_WQ); bf16* XN = (bf16*)(P.ws + WS_XN);
    constexpr int I_IN = (DM / 64) * (INC / 32), I_SQ = (DM / 64) * (DM / 32);
    for (int it = gw; it < I_IN + 2 * I_SQ; it += NGW) {
        int r = it;
        if (r < I_IN) { p0_transpose_item(P.w_in, DM, INC, WIN, scr, r, lane); continue; } r -= I_IN;
        if (r < I_SQ) { p0_transpose_item(P.w_out, DM, DM, WOUT, scr, r, lane); continue; } r -= I_SQ;
        p0_transpose_item(P.wq, DM, DM, WQ, scr, r, lane, P.norm2_g);
    }
    for (int i = vcu * NTHR + tid; i < (INCP - INC) * DM / 8; i += G * NTHR) ((v4u*)(WIN + (size_t)INC * DM))[i] = (v4u){0u, 0u, 0u, 0u};
    for (int m = gw; m < TT; m += NGW) rms_row_to_bf16(P.x + (size_t)m * DM, P.norm1_g, XN + (size_t)m * DM, lane);
}

namespace pg8 {
struct EpiF32 {
    static constexpr bool PERM = false, AFTER_DRAIN = false;
    const float* base; float* out; int ldc;
    __device__ __forceinline__ void operator()(const f32x4 (&acc)[2][2][4][2], const Unit& u, int wr, int wc, int fr, int fq) const {
        const int col0 = u.pn * BM + wc * 32 + 4 * fq;
#pragma unroll
        for (int ai = 0; ai < 2; ++ai)
#pragma unroll
            for (int m = 0; m < 4; ++m) { const int r = ai * HALF + wr * 64 + m * 16 + fr; const size_t off = (size_t)(u.pm * BM + r) * ldc + col0;
#pragma unroll
                for (int bj = 0; bj < 2; ++bj)
#pragma unroll
                    for (int n = 0; n < 2; ++n) { f32x4 o = acc[ai][bj][m][n]; if (base) o = o + *(const f32x4*)(base + off + bj * HALF + n * 16);
                        *(f32x4*)(out + off + bj * HALF + n * 16) = o; } }
    }
};
struct EpiH {
    static constexpr bool PERM = false, AFTER_DRAIN = false;
    const float* base; bf16* outb; float* ss; int ldc;
    __device__ __forceinline__ void operator()(const f32x4 (&acc)[2][2][4][2], const Unit& u, int wr, int wc, int fr, int fq) const {
        const int col0 = u.pn * BM + wc * 32 + 4 * fq;
#pragma unroll
        for (int ai = 0; ai < 2; ++ai) {
            f32x4 xv[4][2][2];
#pragma unroll
            for (int m = 0; m < 4; ++m) { const size_t off = (size_t)(u.pm * BM + ai * HALF + wr * 64 + m * 16 + fr) * ldc + col0;
#pragma unroll
                for (int bj = 0; bj < 2; ++bj)
#pragma unroll
                    for (int n = 0; n < 2; ++n) xv[m][bj][n] = *(const f32x4*)(base + off + bj * HALF + n * 16); }
#pragma unroll
            for (int m = 0; m < 4; ++m) { const int r = ai * HALF + wr * 64 + m * 16 + fr; const size_t off = (size_t)(u.pm * BM + r) * ldc + col0; float sq = 0.f;
#pragma unroll
                for (int bj = 0; bj < 2; ++bj)
#pragma unroll
                    for (int n = 0; n < 2; ++n) { const f32x4 o = acc[ai][bj][m][n] + xv[m][bj][n];
                        *(v2u*)(outb + off + bj * HALF + n * 16) = (v2u){pk2(o.x, o.y), pk2(o.z, o.w)};
                        sq += (o.x * o.x + o.y * o.y) + (o.z * o.z + o.w * o.w); }
                sq += __shfl_xor(sq, 16); sq += __shfl_xor(sq, 32);
                if (fq == 0) ss[(size_t)(u.pm * BM + r) * 32 + u.pn * 4 + wc] = sq; }
        }
    }
};
struct EpiBf16Row {
    static constexpr bool PERM = true, AFTER_DRAIN = false;
    bf16_t* O; int ldc; const float* rs;
    __device__ __forceinline__ void operator()(const f32x4 (&acc)[2][2][4][2], const Unit& u, int wr, int wc, int fr, int fq) const {
        const int row0 = u.pm * BM + wr * 64 + fr, col0 = u.pn * BM + wc * 32 + 8 * fq;
        float scv[2][4];
#pragma unroll
        for (int ai = 0; ai < 2; ++ai)
#pragma unroll
            for (int m = 0; m < 4; ++m) scv[ai][m] = rs[row0 + ai * HALF + m * 16];
#pragma unroll
        for (int ai = 0; ai < 2; ++ai)
#pragma unroll
            for (int m = 0; m < 4; ++m) { const int row = row0 + ai * HALF + m * 16; const float sc = scv[ai][m]; bf16_t* rowp = O + (size_t)row * ldc + col0;
#pragma unroll
                for (int bj = 0; bj < 2; ++bj) { const f32x4 v0 = acc[ai][bj][m][0] * sc, v1 = acc[ai][bj][m][1] * sc;
                    u32x4 w; w.x = cvt_pk_bf16(v0[0], v0[1]); w.y = cvt_pk_bf16(v0[2], v0[3]); w.z = cvt_pk_bf16(v1[0], v1[1]); w.w = cvt_pk_bf16(v1[2], v1[3]);
                    *(u32x4*)(rowp + bj * HALF) = w; } }
    }
};
struct Order1 {
    StaticOrder s; bool split; int c;
    __device__ void init(int M, int N, int G_, int c_) { s.init(M, N, G_, c_); split = (G_ == 256 && M == 8192 && N == 6656); c = c_; }
    __device__ bool next(int i, Unit& u) const {
        if (!split) return s.next(i, u);
        if (c >= 208 || i >= 4) return false;
        const int x = c & 7, j = c >> 3; u.pm = 4 * x + 2 * (i >> 1) + (j & 1); u.pn = 13 * (i & 1) + (j >> 1); return true; }
    __device__ __forceinline__ void a_ready(const Unit&) const {}
    __device__ __forceinline__ void done(const Unit&) const {}
};
}

__device__ __forceinline__ void phase_rstd(KP P, int vcu, int G) {
    const float* ssp = (const float*)(P.ws + WS_SSP); float* rstd = (float*)(P.ws + WS_SSP + 2 * MiB);
    for (int row = vcu * NTHR + ltid(); row < TT; row += G * NTHR) { const f32x4* sp = (const f32x4*)(ssp + (size_t)row * 32); float a = 0.f;
#pragma unroll
        for (int j = 0; j < 8; ++j) { const f32x4 v = sp[j]; a += (v.x + v.y) + (v.z + v.w); }
        rstd[row] = 1.0f / sqrtf(a * (1.f / DM) + RMS_EPS); }
}
__device__ __forceinline__ void phase_kmean(KP P, LAS unsigned char* lds, int vcu, int G) {
    const int tid = ltid(); const bf16* proj = (const bf16*)(P.ws + WS_PROJ); float* kmean = (float*)(P.ws + WS_KMEAN);
    LAS float* red = (LAS float*)lds;
    for (int item = vcu; item < 32 * 8; item += G) {
        const int bb = item >> 3, cg = item & 7;
        const int c = tid & 127, rq = tid >> 7;
        const bf16* p = proj + (size_t)(bb * 256 + rq * 64) * INCP + C_AK + cg * 128 + c;
        float s = 0.f;
        for (int r = 0; r < 64; ++r) s += bf2f(p[(size_t)r * INCP]);
        red[rq * 128 + c] = s;
        __syncthreads();
        if (tid < 128) kmean[(size_t)bb * 1024 + cg * 128 + tid] = (red[tid] + red[128 + tid] + red[256 + tid] + red[384 + tid]) * (1.f / 256.f);
        __syncthreads();
    }
}

typedef short bf16x8 __attribute__((ext_vector_type(8)));
typedef float f32x16 __attribute__((ext_vector_type(16)));
constexpr int CP = 72;
constexpr int MATB = 64 * CP * 2;
enum { M_AT = 0, M_BT = 1, M_KT = 2, M_RT = 3, M_VT = 4, M_BBT = 5, M_KBT = 6, M_LAK = 7, M_MRB = 8, M_MRK = 9, M_LAB = 10, M_AHT = 0, M_U0T = 1 };
constexpr int L_RHS = 11 * MATB;
constexpr int L_MISC = L_RHS + 32768;
constexpr int L_TB = L_MISC + 9 * 64 * 4;
constexpr int L_A_END = L_TB + 2048;
static_assert(L_A_END <= RING_BYTES, "stage A LDS");
constexpr size_t CHK_ITEM = 6 * 8192;

__device__ __forceinline__ f32x16 mm_tile(const LAS unsigned char* A, int ra, const LAS unsigned char* B, int rb, f32x16 acc, int lane, int k0 = 0, int k1 = 4) {
    const int r = lane & 31, hi = lane >> 5;
    const LAS unsigned char* ap = A + ((ra * 32 + r) * CP + 8 * hi) * 2; const LAS unsigned char* bp = B + ((rb * 32 + r) * CP + 8 * hi) * 2;
#pragma unroll
    for (int kk = 0; kk < 4; ++kk) if (kk >= k0 && kk < k1) {
        const bf16x8 a = *(const LAS bf16x8*)(ap + kk * 32), b = *(const LAS bf16x8*)(bp + kk * 32);
        acc = __builtin_amdgcn_mfma_f32_32x32x16_bf16(a, b, acc, 0, 0, 0); }
    return acc;
}
__device__ __forceinline__ int crow32(int reg, int hi) { return (reg & 3) + 8 * (reg >> 2) + 4 * hi; }

__device__ __forceinline__ void prologue_lora(KP P, int vcu, int G) {
    bf16* w2T = (bf16*)(P.ws + WS_LORA); bf16* a2T = w2T + 1024 * 96; bf16* g2T = a2T + 1024 * 96;
    for (int e = vcu * NTHR + ltid(); e < 448 * 1024; e += G * NTHR) { const int i = e >> 10, n = e & 1023;
        if (i < 96) w2T[n * 96 + i] = (bf16)f2bf(P.w2[e]); else if (i < 192) a2T[n * 96 + (i - 96)] = (bf16)f2bf(P.a2[e - 96 * 1024]); else g2T[n * 256 + (i - 192)] = (bf16)f2bf(P.g2[e - 192 * 1024]); }
}
__device__ __forceinline__ void phase_act(KP P, int vcu, int G) {
    const bf16* proj = (const bf16*)(P.ws + WS_PROJ); unsigned* act = (unsigned*)(P.ws + WS_ACT);
    for (int e = vcu * NTHR + ltid(); e < TT * 224; e += G * NTHR) { const int t = e / 224, cp = e - t * 224, cc = 2 * cp;
        const bf16* pr = proj + (size_t)t * INCP + C_RW + 3072 + cc;
        const unsigned cu = *(const unsigned*)pr; const unsigned pu = (t & (SEQ - 1)) == 0 ? 0u : *(const unsigned*)(pr - INCP);
        const float m0 = P.mu[3072 + cc], m1 = P.mu[3072 + cc + 1];
        float v0 = bflo(cu) + (bflo(pu) - bflo(cu)) * m0, v1 = bfhi(cu) + (bfhi(pu) - bfhi(cu)) * m1;
        if (cc < 96) { v0 = tanhf(v0); v1 = tanhf(v1); } else if (cc >= 192) { v0 = 1.f / (1.f + __expf(-v0)); v1 = 1.f / (1.f + __expf(-v1)); }
        act[e] = pk2(v0, v1); }
}
constexpr int ACTP = 456;
constexpr int L_WAG = 58368;
static_assert(L_WAG + 3 * 16384 <= L_MISC, "lora scratch fits below misc");
struct LoraFrags { bf16x8 f[16]; f32x4 w0[4], a0[4]; float mu_r, mu_k, mu_v, kkc, kac, rkc, lng, lnb; };
__device__ __forceinline__ LoraFrags lora_frags_load(KP P, int h, int wave, int lane) {
    const int c32 = lane & 31, hi = lane >> 5, nb = (wave & 3) >> 1; const int nrow = h * 64 + nb * 32 + c32;
    const bf16* w2T = (const bf16*)(P.ws + WS_LORA); const bf16* a2T = w2T + 1024 * 96; const bf16* g2T = a2T + 1024 * 96;
    const bf16* wp = w2T + (size_t)nrow * 96 + 8 * hi; const bf16* ap = a2T + (size_t)nrow * 96 + 8 * hi; const bf16* gp = g2T + (size_t)nrow * 256 + 8 * hi;
    LoraFrags W;
#pragma unroll
    for (int kk = 0; kk < 16; ++kk) { const bf16* src = wave < 4 ? (kk < 6 ? wp + 16 * kk : ap + 16 * ((kk - 6) % 6)) : gp + 16 * kk; W.f[kk] = *(const bf16x8*)src; }
#pragma unroll
    for (int g = 0; g < 4; ++g) { const int n0 = h * 64 + nb * 32 + 8 * g + 4 * hi; W.w0[g] = *(const f32x4*)(P.w0 + n0); W.a0[g] = *(const f32x4*)(P.a0 + n0); }
    const int col = h * 64 + lane;
    W.mu_r = P.mu[col]; W.mu_k = P.mu[1024 + col]; W.mu_v = P.mu[2048 + col]; W.kkc = P.k_k[col]; W.kac = P.k_a[col]; W.rkc = P.r_k[col]; W.lng = P.ln_g[col]; W.lnb = P.ln_b[col];
    return W;
}
__device__ __forceinline__ void rwkv_stage_a(KP P, LAS unsigned char* lds, int item, const LoraFrags& W) {
    const int tid = ltid(), lane = tid & 63, wave = __builtin_amdgcn_readfirstlane(tid >> 6);
    const int b = item >> 10, h = (item >> 6) & 15, c = item & 63;
    const int tok0 = b * SEQ + c * 64;
    const bf16* proj = (const bf16*)(P.ws + WS_PROJ);
    unsigned char* chk = P.ws + WS_CHK + (size_t)((item & 63) * 32 + (item >> 6)) * CHK_ITEM;
    LAS float* misc = (LAS float*)(lds + L_MISC);
    { const bf16* actg = (const bf16*)(P.ws + WS_ACT) + (size_t)tok0 * 448;
#pragma unroll
      for (int e = tid; e < 64 * 56; e += NTHR) { const int row = e / 56, ch = e - row * 56; *(LAS v4u*)(lds + (row * ACTP + ch * 8) * 2) = *(const v4u*)(actg + (size_t)row * 448 + ch * 8); } }
    __syncthreads();
    {
        const int c32 = lane & 31, hi = lane >> 5, qd = wave & 3, nb = qd >> 1, tb = qd & 1;
        const LAS unsigned char* actp = lds + ((tb * 32 + c32) * ACTP + 8 * hi) * 2;
        LAS float* wag = (LAS float*)(lds + L_WAG) + (tb * 32 + c32) * 64 + nb * 32;
        if (wave < 4) {
            f32x16 aw = {}, aa = {};
#pragma unroll
            for (int kk = 0; kk < 6; ++kk) {
                aw = __builtin_amdgcn_mfma_f32_32x32x16_bf16(W.f[kk], *(const LAS bf16x8*)(actp + (16 * kk) * 2), aw, 0, 0, 0);
                aa = __builtin_amdgcn_mfma_f32_32x32x16_bf16(W.f[6 + kk], *(const LAS bf16x8*)(actp + (96 + 16 * kk) * 2), aa, 0, 0, 0); }
#pragma unroll
            for (int g = 0; g < 4; ++g) { const int n0 = h * 64 + nb * 32 + 8 * g + 4 * hi;
                const f32x4 w0 = W.w0[g], a0 = W.a0[g]; f32x4 ow, oa;
#pragma unroll
                for (int e = 0; e < 4; ++e) { const float xx = w0[e] + aw[4 * g + e];
                    ow[e] = __expf(-0.6065306597126334f * __builtin_amdgcn_rcpf(1.f + __expf(-xx))); oa[e] = __builtin_amdgcn_rcpf(1.f + __expf(-(a0[e] + aa[4 * g + e]))); }
                *(LAS f32x4*)(wag + 8 * g + 4 * hi) = ow; *(LAS f32x4*)(wag + 4096 + 8 * g + 4 * hi) = oa; }
        } else {
            f32x16 ag = {};
#pragma unroll
            for (int kk = 0; kk < 16; ++kk) ag = __builtin_amdgcn_mfma_f32_32x32x16_bf16(W.f[kk], *(const LAS bf16x8*)(actp + (192 + 16 * kk) * 2), ag, 0, 0, 0);
#pragma unroll
            for (int g = 0; g < 4; ++g) *(LAS f32x4*)(wag + 8192 + 8 * g + 4 * hi) = (f32x4){ag[4 * g], ag[4 * g + 1], ag[4 * g + 2], ag[4 * g + 3]};
        }
    }
    __syncthreads();
    {
        const int n = lane, tg = wave, col = h * 64 + n;
        const float mu_r = W.mu_r, mu_k = W.mu_k, mu_v = W.mu_v, kkc = W.kkc, kac = W.kac, rkc = W.rkc, lng = W.lng, lnb = W.lnb;
        float rr[8], kr[8], vv[8], ww[8], aa[8], gg[8], kk[8];
        const int tfirst = tok0 + 8 * tg;
        const bf16* pp = proj + (size_t)tfirst * INCP + C_RW + col;
        float pr, pk, pvv;
        if (c == 0 && tg == 0) { pr = 0.f; pk = 0.f; pvv = 0.f; } else { pr = bf2f(pp[-(long)INCP]); pk = bf2f(pp[-(long)INCP + 1024]); pvv = bf2f(pp[-(long)INCP + 2048]); }
        const LAS float* wagr = (const LAS float*)(lds + L_WAG) + (8 * tg) * 64 + n;
#pragma unroll
        for (int q = 0; q < 8; ++q) { const float cr = bf2f(pp[(size_t)q * INCP]), ck = bf2f(pp[(size_t)q * INCP + 1024]), cv = bf2f(pp[(size_t)q * INCP + 2048]);
            rr[q] = cr + (pr - cr) * mu_r; kr[q] = ck + (pk - ck) * mu_k; vv[q] = cv + (pvv - cv) * mu_v; pr = cr; pk = ck; pvv = cv;
            ww[q] = wagr[q * 64]; aa[q] = wagr[4096 + q * 64]; gg[q] = wagr[8192 + q * 64]; }
        float lam[8]; float run = 1.f;
#pragma unroll
        for (int q = 0; q < 8; ++q) { run *= ww[q]; lam[q] = run; }
        misc[tg * 64 + n] = run;
#pragma unroll
        for (int q = 0; q < 8; ++q) { const float kkv = kr[q] * kkc; const float ss = wave_sum(kkv * kkv); kk[q] = kkv * __builtin_amdgcn_rsqf(fmaxf(ss, 1e-24f));
            kr[q] = kr[q] * (1.f + (aa[q] - 1.f) * kac); }
        __syncthreads();
        float pre = 1.f, tot = 1.f;
#pragma unroll
        for (int g = 0; g < 8; ++g) { const float sgt = misc[g * 64 + n]; if (g < tg) pre *= sgt; tot *= sgt; }
        if (tg == 0) misc[512 + n] = tot;
        unsigned vt[4], bbt[4], kbt[4];
        LAS bf16* At = (LAS bf16*)(lds + M_AT * MATB); LAS bf16* Bt = (LAS bf16*)(lds + M_BT * MATB); LAS bf16* Kt = (LAS bf16*)(lds + M_KT * MATB); LAS bf16* Rt = (LAS bf16*)(lds + M_RT * MATB);
        float hbb = 0.f, hkb = 0.f, hv = 0.f;
#pragma unroll
        for (int q = 0; q < 8; ++q) { const int t = 8 * tg + q;
            const float L = pre * lam[q], Lp = q == 0 ? pre : pre * lam[q - 1], iL = __builtin_amdgcn_rcpf(L), rel = tot * iL;
            const float bq = kk[q] * aa[q];
            ((LAS float*)(lds + L_RHS))[t * 128 + 64 + n] = -kk[q] * Lp;
            At[t * CP + n] = (bf16)f2bf(-kk[q] * Lp); Bt[t * CP + n] = (bf16)f2bf(bq * iL); Kt[t * CP + n] = (bf16)f2bf(kr[q] * iL); Rt[t * CP + n] = (bf16)f2bf(rr[q] * L);
            const float bb = bq * rel, kb = kr[q] * rel;
            if (q & 1) { vt[q >> 1] = pk2(hv, vv[q]); bbt[q >> 1] = pk2(hbb, bb); kbt[q >> 1] = pk2(hkb, kb); } else { hv = vv[q]; hbb = bb; hkb = kb; }
            const float bs = wave_sum(rr[q] * kr[q] * rkc);
            const int pl = t * 64 + ((n >> 2) & 3) * 16 + (n >> 4) * 4 + (n & 3);
            ((bf16*)(chk + 4 * 8192))[pl] = (bf16)f2bf(lng * gg[q]);
            ((bf16*)(chk + 5 * 8192))[pl] = (bf16)f2bf((lnb + bs * vv[q]) * gg[q]); }
        *(LAS v4u*)(lds + M_VT * MATB + (n * CP + 8 * tg) * 2) = (v4u){vt[0], vt[1], vt[2], vt[3]};
        *(LAS v4u*)(lds + M_BBT * MATB + (n * CP + 8 * tg) * 2) = (v4u){bbt[0], bbt[1], bbt[2], bbt[3]};
        *(LAS v4u*)(lds + M_KBT * MATB + (n * CP + 8 * tg) * 2) = (v4u){kbt[0], kbt[1], kbt[2], kbt[3]};
    }
    __syncthreads();
    const int c32 = lane & 31, hi = lane >> 5;
    {
        const int prod = wave >> 1;
#pragma unroll
        for (int qi = 0; qi < 2; ++qi) {
            const int tb = (wave & 1) ? (qi == 0 ? 1 : 0) : qi, sb = (wave & 1) ? 1 : 0; const bool zero = (tb == 0 && sb == 1);
            f32x16 acc = {};
            const int xa = (prod == 0 || prod == 2) ? M_BT : M_KT, ya = prod < 2 ? M_AT : M_RT, dm = prod == 0 ? M_LAB : (prod == 1 ? M_LAK : (prod == 2 ? M_MRB : M_MRK));
            if (!zero) acc = mm_tile(lds + xa * MATB, sb, lds + ya * MATB, tb, acc, lane);
            const int t = tb * 32 + c32; LAS unsigned char* dst = lds + dm * MATB + (t * CP + sb * 32) * 2;
#pragma unroll
            for (int g = 0; g < 4; ++g) { float o[4];
#pragma unroll
                for (int e = 0; e < 4; ++e) { const int s = sb * 32 + 8 * g + 4 * hi + e; const bool keep = prod < 2 ? (s < t) : (s <= t); o[e] = keep ? acc[4 * g + e] : 0.f; }
                *(LAS v2u*)(dst + (8 * g + 4 * hi) * 2) = (v2u){pk2(o[0], o[1]), pk2(o[2], o[3])}; }
        }
    }
    __syncthreads();
    if (wave < 4) {
        const int ib = wave >> 1, tb = wave & 1; f32x16 acc = {};
        acc = mm_tile(lds + M_VT * MATB, ib, lds + M_LAK * MATB, tb, acc, lane, 0, tb == 0 ? 2 : 4);
        const int t = tb * 32 + c32; LAS float* dst = (LAS float*)(lds + L_RHS) + t * 128 + ib * 32;
#pragma unroll
        for (int g = 0; g < 4; ++g) *(LAS f32x4*)(dst + 8 * g + 4 * hi) = (f32x4){acc[4 * g], acc[4 * g + 1], acc[4 * g + 2], acc[4 * g + 3]};
    } else if (wave == 4) {
        const int bb = lane >> 4, col = lane & 15;
        float x[16];
#pragma unroll
        for (int t = 0; t < 16; ++t) x[t] = t == col ? 1.f : 0.f;
#pragma unroll
        for (int t = 1; t < 16; ++t) { const LAS unsigned char* rp = lds + M_LAB * MATB + ((16 * bb + t) * CP + 16 * bb) * 2; const v4u ra = *(const LAS v4u*)rp, rb = *(const LAS v4u*)(rp + 16);
            float lrow[16];
#pragma unroll
            for (int q = 0; q < 4; ++q) { lrow[2 * q] = bflo(ra[q]); lrow[2 * q + 1] = bfhi(ra[q]); lrow[8 + 2 * q] = bflo(rb[q]); lrow[8 + 2 * q + 1] = bfhi(rb[q]); }
#pragma unroll
            for (int s = 0; s < t; ++s) x[t] += lrow[s] * x[s]; }
        LAS bf16* T = (LAS bf16*)(lds + L_TB) + bb * 256 + col;
#pragma unroll
        for (int t = 0; t < 16; ++t) T[t * 16] = (bf16)f2bf(x[t]);
    }
    __syncthreads();
    {
        typedef short s16x4 __attribute__((ext_vector_type(4)));
        const int l15 = lane & 15, q4 = lane >> 4;
        LAS unsigned char* xt = lds + (wave < 4 ? M_U0T : M_AHT) * MATB + ((16 * (wave & 3) + l15) * CP) * 2;
        *(LAS v4u*)(xt + q4 * 32) = (v4u){0u, 0u, 0u, 0u}; *(LAS v4u*)(xt + q4 * 32 + 16) = (v4u){0u, 0u, 0u, 0u};
        const LAS float* Xf = (const LAS float*)(lds + L_RHS) + 16 * wave + l15;
#pragma unroll
        for (int bq = 0; bq < 4; ++bq) {
            f32x4 acc;
#pragma unroll
            for (int e = 0; e < 4; ++e) acc[e] = Xf[(16 * bq + 4 * q4 + e) * 128];
#pragma unroll
            for (int kk = 0; kk < (bq + 1) / 2; ++kk) {
                const bf16x8 a = *(const LAS bf16x8*)(lds + M_LAB * MATB + ((16 * bq + l15) * CP + 32 * kk + 8 * q4) * 2);
                const bf16x8 xb = *(const LAS bf16x8*)(xt + (32 * kk + 8 * q4) * 2);
                acc = __builtin_amdgcn_mfma_f32_16x16x32_bf16(a, xb, acc, 0, 0, 0); }
            const v2u tf = *(const LAS v2u*)(lds + L_TB + (bq * 256 + l15 * 16 + 4 * q4) * 2);
            const v2u ab = (v2u){pk2(acc[0], acc[1]), pk2(acc[2], acc[3])};
            const f32x4 z = {0.f, 0.f, 0.f, 0.f};
            const f32x4 xn = __builtin_amdgcn_mfma_f32_16x16x16bf16_1k(__builtin_bit_cast(s16x4, tf), __builtin_bit_cast(s16x4, ab), z, 0, 0, 0);
            *(LAS v2u*)(xt + (16 * bq + 4 * q4) * 2) = (v2u){pk2(xn[0], xn[1]), pk2(xn[2], xn[3])};
        }
    }
    __syncthreads();
    {
        const int qd = wave & 3, yb = qd >> 1, xb = qd & 1;
        f32x16 acc1 = {}, acc2 = {};
        if (wave < 4) {
            acc1 = mm_tile(lds + M_AHT * MATB, yb, lds + M_BBT * MATB, xb, acc1, lane);
            acc2 = mm_tile(lds + M_BBT * MATB, yb, lds + M_U0T * MATB, xb, acc2, lane);
            acc2 = mm_tile(lds + M_KBT * MATB, yb, lds + M_VT * MATB, xb, acc2, lane);
            const int x = xb * 32 + c32; const float lc = misc[512 + x];
            bf16* o1 = (bf16*)(chk + 0 * 8192) + x * 64 + yb * 32; bf16* o2 = (bf16*)(chk + 1 * 8192) + x * 64 + yb * 32;
#pragma unroll
            for (int g = 0; g < 4; ++g) { float p[4];
#pragma unroll
                for (int e = 0; e < 4; ++e) { const int y = yb * 32 + 8 * g + 4 * hi + e; p[e] = acc1[4 * g + e] + (y == x ? lc : 0.f); }
                *(v2u*)(o1 + 8 * g + 4 * hi) = (v2u){pk2(p[0], p[1]), pk2(p[2], p[3])};
                *(v2u*)(o2 + 8 * g + 4 * hi) = (v2u){pk2(acc2[4 * g], acc2[4 * g + 1]), pk2(acc2[4 * g + 2], acc2[4 * g + 3])}; }
        } else {
            acc1 = mm_tile(lds + M_AHT * MATB, yb, lds + M_MRB * MATB, xb, acc1, lane);
            acc2 = mm_tile(lds + M_U0T * MATB, yb, lds + M_MRB * MATB, xb, acc2, lane);
            acc2 = mm_tile(lds + M_VT * MATB, yb, lds + M_MRK * MATB, xb, acc2, lane);
            const int x = xb * 32 + c32;
            bf16* o1 = (bf16*)(chk + 2 * 8192) + x * 64 + yb * 32; bf16* o2 = (bf16*)(chk + 3 * 8192) + x * 64;
            const LAS bf16* Rt = (const LAS bf16*)(lds + M_RT * MATB) + x * CP + yb * 32;
#pragma unroll
            for (int g = 0; g < 4; ++g) { float p[4];
#pragma unroll
                for (int e = 0; e < 4; ++e) p[e] = acc1[4 * g + e] + bf2f(Rt[8 * g + 4 * hi + e]);
                *(v2u*)(o1 + 8 * g + 4 * hi) = (v2u){pk2(p[0], p[1]), pk2(p[2], p[3])};
                *(v2u*)(o2 + ((2 * g + hi) & 3) * 16 + (2 * yb + (g >> 1)) * 4) = (v2u){pk2(acc2[4 * g], acc2[4 * g + 1]), pk2(acc2[4 * g + 2], acc2[4 * g + 3])}; }
        }
    }
    __syncthreads();
}

__device__ __forceinline__ void phase_rwkv_stage_a(KP P, LAS unsigned char* lds, int vcu, int G) {
    const int tid = ltid(), lane = tid & 63, wave = __builtin_amdgcn_readfirstlane(tid >> 6);
    int cur_bh = (vcu & 255) >> 3; LoraFrags W = lora_frags_load(P, cur_bh & 15, wave, lane);
    for (int k = vcu; k < 2048; k += G) { const int bh = (k & 255) >> 3, c = (k & 7) + 8 * (k >> 8);
        if (bh != cur_bh) { W = lora_frags_load(P, bh & 15, wave, lane); cur_bh = bh; }
        rwkv_stage_a(P, lds, bh * 64 + c, W); }
}
typedef float f32x4v __attribute__((ext_vector_type(4)));
struct YSet { bf16x8 b0, b1; v4u y0[2], g1[2], g2[2]; };
struct SSet { bf16x8 p0[1], p1[1]; v2u q[4]; };
__device__ __forceinline__ void rwkv_stage_b(KP P, LAS unsigned char* lds, int bh) {
    const int tid = ltid(), lane = tid & 63, wave = __builtin_amdgcn_readfirstlane(tid >> 6);
    const int b = bh >> 4, h = bh & 15; const int l15 = lane & 15, q4 = lane >> 4;
    bf16* AR = (bf16*)(P.ws + WS_AR);
    for (int u = tid; u < 2 * MATB / 4; u += NTHR) ((LAS unsigned*)lds)[u] = 0u;
    __syncthreads();
    const int w4 = wave & 3;
    const unsigned char* chk0 = P.ws + WS_CHK + (size_t)bh * CHK_ITEM;
    if (wave < 4) {
        const int t = 16 * w4 + l15;
        YSet ys[4];
#define YLOAD(S_, c_) do { const unsigned char* chk = chk0 + (size_t)(c_) * (32 * CHK_ITEM); const bf16* rh = (const bf16*)(chk + 2 * 8192) + t * 64 + 8 * q4; S_.b0 = *(const bf16x8*)rh; S_.b1 = *(const bf16x8*)(rh + 32); \
        const bf16* y0 = (const bf16*)(chk + 3 * 8192) + t * 64 + 16 * q4; \
        S_.y0[0] = *(const v4u*)y0; S_.y0[1] = *(const v4u*)(y0 + 8); S_.g1[0] = *(const v4u*)(y0 + 4096); S_.g1[1] = *(const v4u*)(y0 + 4096 + 8); S_.g2[0] = *(const v4u*)(y0 + 8192); S_.g2[1] = *(const v4u*)(y0 + 8192 + 8); } while (0)
#define YV(A_, it_, w_) ((A_)[(it_) >> 1][2 * ((it_) & 1) + (w_)])
#pragma unroll
        for (int u = 0; u < 4; ++u) YLOAD(ys[u], u);
        for (int c0 = 0; c0 < 64; c0 += 4) {
#pragma unroll
            for (int u = 0; u < 4; ++u) { const int c = c0 + u;
                const LAS unsigned char* Scur = lds + (c & 1) * MATB;
                f32x4v acc[4];
#pragma unroll
                for (int it = 0; it < 4; ++it) { acc[it] = (f32x4v){bflo(YV(ys[u].y0, it, 0)), bfhi(YV(ys[u].y0, it, 0)), bflo(YV(ys[u].y0, it, 1)), bfhi(YV(ys[u].y0, it, 1))};
                    const LAS unsigned char* sp = Scur + ((16 * it + l15) * CP + 8 * q4) * 2;
                    acc[it] = __builtin_amdgcn_mfma_f32_16x16x32_bf16(*(const LAS bf16x8*)sp, ys[u].b0, acc[it], 0, 0, 0);
                    acc[it] = __builtin_amdgcn_mfma_f32_16x16x32_bf16(*(const LAS bf16x8*)(sp + 64), ys[u].b1, acc[it], 0, 0, 0); }
                float s = 0.f;
#pragma unroll
                for (int it = 0; it < 4; ++it) s += (acc[it].x + acc[it].y) + (acc[it].z + acc[it].w);
                s += __shfl_xor(s, 16); s += __shfl_xor(s, 32);
                const float mean = s * (1.f / 64.f); float v = 0.f;
#pragma unroll
                for (int it = 0; it < 4; ++it) { acc[it] = acc[it] - mean; v += (acc[it].x * acc[it].x + acc[it].y * acc[it].y) + (acc[it].z * acc[it].z + acc[it].w * acc[it].w); }
                v += __shfl_xor(v, 16); v += __shfl_xor(v, 32);
                const float rstd = 1.0f / sqrtf(v * (1.f / 64.f) + 64e-5f);
                bf16* orow = AR + (size_t)(b * SEQ + c * 64 + t) * DM + 1024 + h * 64 + 4 * q4;
#pragma unroll
                for (int it = 0; it < 4; ++it) {
                    const float o0 = acc[it].x * rstd * bflo(YV(ys[u].g1, it, 0)) + bflo(YV(ys[u].g2, it, 0)), o1 = acc[it].y * rstd * bfhi(YV(ys[u].g1, it, 0)) + bfhi(YV(ys[u].g2, it, 0));
                    const float o2 = acc[it].z * rstd * bflo(YV(ys[u].g1, it, 1)) + bflo(YV(ys[u].g2, it, 1)), o3 = acc[it].w * rstd * bfhi(YV(ys[u].g1, it, 1)) + bfhi(YV(ys[u].g2, it, 1));
                    *(v2u*)(orow + 16 * it) = (v2u){pk2(o0, o1), pk2(o2, o3)}; }
                if (c + 4 < 64) YLOAD(ys[u], c + 4);
                __syncthreads();
            }
        }
#undef YLOAD
#undef YV
    } else {
        const int nrow = 16 * w4 + l15;
        SSet ss[4];
#define SLOADX(S_, c_) do { const unsigned char* chk = chk0 + (size_t)(c_) * (32 * CHK_ITEM); const bf16* pt = (const bf16*)chk + nrow * 64 + 8 * q4; S_.p0[0] = *(const bf16x8*)pt; S_.p1[0] = *(const bf16x8*)(pt + 32); \
        const bf16* q = (const bf16*)(chk + 1 * 8192) + l15 * 64 + 16 * w4 + 4 * q4; \
        _Pragma("unroll") for (int it = 0; it < 4; ++it) S_.q[it] = *(const v2u*)(q + 16 * it * 64); } while (0)
#pragma unroll
        for (int u = 0; u < 4; ++u) SLOADX(ss[u], u);
        for (int c0 = 0; c0 < 64; c0 += 4) {
#pragma unroll
            for (int u = 0; u < 4; ++u) { const int c = c0 + u;
                const LAS unsigned char* Scur = lds + (c & 1) * MATB; LAS unsigned char* Snxt = lds + ((c & 1) ^ 1) * MATB;
#pragma unroll
                for (int it = 0; it < 4; ++it) { const int i = 16 * it + l15;
                    const LAS unsigned char* sp = Scur + (i * CP + 8 * q4) * 2; const bf16x8 s0 = *(const LAS bf16x8*)sp, s1 = *(const LAS bf16x8*)(sp + 64);
                    f32x4v acc = (f32x4v){bflo(ss[u].q[it].x), bfhi(ss[u].q[it].x), bflo(ss[u].q[it].y), bfhi(ss[u].q[it].y)};
                    acc = __builtin_amdgcn_mfma_f32_16x16x32_bf16(ss[u].p0[0], s0, acc, 0, 0, 0);
                    acc = __builtin_amdgcn_mfma_f32_16x16x32_bf16(ss[u].p1[0], s1, acc, 0, 0, 0);
                    *(LAS v2u*)(Snxt + (i * CP + 16 * w4 + 4 * q4) * 2) = (v2u){pk2(acc.x, acc.y), pk2(acc.z, acc.w)}; }
                if (c + 4 < 64) SLOADX(ss[u], c + 4);
                __syncthreads();
            }
        }
#undef SLOADX
    }
}

constexpr size_t WS_UB = WS_RWA;
constexpr size_t WS_VB = WS_RWA + 32 * MiB;
constexpr float U_SCALE = 512.f, V_SCALE = 32.f;
constexpr int SLICE_BYTES = 16384 * 128;
typedef float f32x2 __attribute__((ext_vector_type(2)));
__device__ __forceinline__ void convert_group(KP P, int i) {
    constexpr int N16 = 16384 * 2048 / 16;
    const bool isv = i >= N16; const int j = isv ? i - N16 : i; const int e = j >> 7, q = j & 127;
    const float* s = (isv ? P.pv : P.pu) + (size_t)j * 16; const float sc = isv ? V_SCALE : U_SCALE;
    v4u o;
#pragma unroll
    for (int k = 0; k < 4; ++k) { f32x4 a = *(const f32x4*)(s + 4 * k); if (!isv) a = a * *(const f32x4*)(P.norm2_g + 16 * q + 4 * k); int p = 0;
        p = __builtin_amdgcn_cvt_pk_fp8_f32(a.x * sc, a.y * sc, p, false); p = __builtin_amdgcn_cvt_pk_fp8_f32(a.z * sc, a.w * sc, p, true); o[k] = (unsigned)p; }
    *(v4u*)(P.ws + (isv ? WS_VB : WS_UB) + (size_t)(q >> 3) * SLICE_BYTES + (size_t)e * 128 + (q & 7) * 16) = o;
}
__device__ __forceinline__ void phase_convert_tables(KP P, LAS unsigned char* lds) {
    const int tid = ltid(); constexpr int N16 = 16384 * 2048 / 16, CH = 4 * NTHR, NCH = 2 * N16 / CH;
    unsigned* ctr = (unsigned*)(P.ws + WS_CTL) + CW_MOBA_CTR; LAS int* slot = (LAS int*)lds;
    for (;;) {
        __syncthreads();
        if (tid == 0) slot[0] = (int)__hip_atomic_fetch_add(ctr, 1u, __ATOMIC_RELAXED, __HIP_MEMORY_SCOPE_AGENT);
        __syncthreads();
        const int c = slot[0]; if (c >= NCH) break;
#pragma unroll
        for (int k = 0; k < 4; ++k) convert_group(P, c * CH + k * NTHR + tid);
    }
}
__device__ __forceinline__ f32x2 dot16p(const v4u u, const f32x2* x, f32x2 acc) {
#pragma unroll
    for (int q = 0; q < 4; ++q) { const f32x2 lo = __builtin_amdgcn_cvt_pk_f32_fp8((int)u[q], false), hi = __builtin_amdgcn_cvt_pk_f32_fp8((int)u[q], true);
        acc = __builtin_elementwise_fma(lo, x[2 * q], acc); acc = __builtin_elementwise_fma(hi, x[2 * q + 1], acc); }
    return acc;
}
__device__ __forceinline__ void axpy16p(const v4u v, f32x2 s, f32x2* y) {
#pragma unroll
    for (int q = 0; q < 4; ++q) { const f32x2 lo = __builtin_amdgcn_cvt_pk_f32_fp8((int)v[q], false), hi = __builtin_amdgcn_cvt_pk_f32_fp8((int)v[q], true);
        y[2 * q] = __builtin_elementwise_fma(s, lo, y[2 * q]); y[2 * q + 1] = __builtin_elementwise_fma(s, hi, y[2 * q + 1]); }
}
__device__ __forceinline__ float xsum_g8(float v) {
    v += DPP_F(v, 0x128);
    { auto r = __builtin_amdgcn_permlane16_swap(__float_as_uint(v), __float_as_uint(v), false, false); v = __uint_as_float(r[0]) + __uint_as_float(r[1]); }
    { auto r = __builtin_amdgcn_permlane32_swap(__float_as_uint(v), __float_as_uint(v), false, false); v = __uint_as_float(r[0]) + __uint_as_float(r[1]); }
    return v;
}
__device__ __forceinline__ void phase_peer_sliced(KP P, LAS unsigned char* lds, int bx, int G) {
    const int grp = bx & 7;
    const unsigned char* UB = P.ws + WS_UB; const unsigned char* VB = P.ws + WS_VB; const bf16* HB = (const bf16*)(P.ws + WS_XN);
    const int* ridx = (const int*)(P.ws + WS_PROJ + 64 * MiB); const float* rgate = (const float*)(P.ws + WS_PROJ + 68 * MiB); const float* RSTD = (const float*)(P.ws + WS_SSP + 2 * MiB);
    for (int bt = bx; bt < TT / 32; bt += G) {
        const int tid = ltid(), lane = tid & 63, wave = __builtin_amdgcn_readfirstlane(tid >> 6), g8 = lane >> 3, p = lane & 7;
        LAS int* idxT = (LAS int*)(lds + wave * 4096); LAS float* gT = (LAS float*)(lds + wave * 4096 + 2048);
        LAS bf16* h2T = (LAS bf16*)(lds + 32768 + wave * 16384);
        const int t0 = 32 * bt + 4 * wave;
#pragma unroll
        for (int i = 0; i < 4; ++i) { const size_t o = (size_t)(t0 + i) * 128; const int wofs = (i * 8 + (lane & 7)) * 16 + (lane >> 3);
            idxT[wofs] = ridx[o + lane]; idxT[wofs + 8] = ridx[o + 64 + lane]; gT[wofs] = rgate[o + lane]; gT[wofs + 8] = rgate[o + 64 + lane]; }
        float hacc[4][2];
#pragma unroll
        for (int i = 0; i < 4; ++i) { hacc[i][0] = 0.f; hacc[i][1] = 0.f; }
        {
            v4u rA[8], rB[8]; f32x2 xA[8], xB[8];
#define PS_SG(s_) (((s_) + 2 * grp) & 15)
#define PS_ISSUE(R, tabbase, s_, i_, hb_) do { const unsigned char* tb_ = (tabbase) + (size_t)PS_SG(s_) * SLICE_BYTES;        \
            const v4u ia_ = *(const LAS v4u*)(idxT + ((i_) * 8 + g8) * 16 + 8 * (hb_)), ib_ = *(const LAS v4u*)(idxT + ((i_) * 8 + g8) * 16 + 8 * (hb_) + 4); const unsigned po_ = 16u * (unsigned)p; \
            R[0] = *(const v4u*)(tb_ + (ia_[0] * 128u + po_)); R[1] = *(const v4u*)(tb_ + (ia_[1] * 128u + po_)); R[2] = *(const v4u*)(tb_ + (ia_[2] * 128u + po_)); R[3] = *(const v4u*)(tb_ + (ia_[3] * 128u + po_)); \
            R[4] = *(const v4u*)(tb_ + (ib_[0] * 128u + po_)); R[5] = *(const v4u*)(tb_ + (ib_[1] * 128u + po_)); R[6] = *(const v4u*)(tb_ + (ib_[2] * 128u + po_)); R[7] = *(const v4u*)(tb_ + (ib_[3] * 128u + po_)); } while (0)
#define PS_LOADX(X, s_, i_) do { const bf16* xp_ = HB + (size_t)(t0 + (i_)) * DM + 128 * PS_SG(s_) + 16 * p; const v4u xa_ = *(const v4u*)xp_, xb_ = *(const v4u*)(xp_ + 8); \
            _Pragma("unroll") for (int q = 0; q < 4; ++q) { X[q] = (f32x2){bflo(xa_[q]), bfhi(xa_[q])}; X[4 + q] = (f32x2){bflo(xb_[q]), bfhi(xb_[q])}; } } while (0)
#define PS_DOTS(R, X, i_, hb_) do { _Pragma("unroll") for (int m = 0; m < 8; ++m) { const f32x2 a2_ = dot16p(R[m], X, (f32x2){0.f, 0.f}); float sd_ = a2_.x + a2_.y; \
            sd_ += DPP_F(sd_, 0xB1); sd_ += DPP_F(sd_, 0x4E); sd_ += DPP_F(sd_, 0x141); if (p == m) hacc[i_][hb_] += sd_; } asm volatile("" ::: "memory"); } while (0)
            PS_LOADX(xA, 0, 0); PS_ISSUE(rA, UB, 0, 0, 0);
            for (int s = 0; s < 16; ++s) {
                PS_ISSUE(rB, UB, s, 0, 1); PS_LOADX(xB, s, 1);  PS_DOTS(rA, xA, 0, 0);
                PS_ISSUE(rA, UB, s, 1, 0);                       PS_DOTS(rB, xA, 0, 1);
                PS_ISSUE(rB, UB, s, 1, 1); PS_LOADX(xA, s, 2);  PS_DOTS(rA, xB, 1, 0);
                PS_ISSUE(rA, UB, s, 2, 0);                       PS_DOTS(rB, xB, 1, 1);
                PS_ISSUE(rB, UB, s, 2, 1); PS_LOADX(xB, s, 3);  PS_DOTS(rA, xA, 2, 0);
                PS_ISSUE(rA, UB, s, 3, 0);                       PS_DOTS(rB, xA, 2, 1);
                PS_ISSUE(rB, UB, s, 3, 1); if (s + 1 < 16) PS_LOADX(xA, s + 1, 0);  PS_DOTS(rA, xB, 3, 0);
                if (s + 1 < 16) PS_ISSUE(rA, UB, s + 1, 0, 0);  PS_DOTS(rB, xB, 3, 1);
            }
#undef PS_LOADX
#undef PS_DOTS
        }
#pragma unroll
        for (int i = 0; i < 4; ++i) { const float rsn = RSTD[t0 + i] * (1.f / U_SCALE);
#pragma unroll
            for (int hb = 0; hb < 2; ++hb) { const float hp = hacc[i][hb] * rsn; LAS float* gp = gT + (i * 8 + g8) * 16 + 8 * hb + p;
                *gp = 0.5f * hp * (1.f + erff(hp * 0.70710678118654752f)) * (1.f / V_SCALE) * *gp; } }
        float ssq[4] = {0.f, 0.f, 0.f, 0.f};
        {
            v4u rA[8], rB[8]; f32x2 y2[8];
#define PS_AXPY(R, i_, hb_) do { const f32x4 aa_ = *(const LAS f32x4*)(gT + ((i_) * 8 + g8) * 16 + 8 * (hb_)), ab_ = *(const LAS f32x4*)(gT + ((i_) * 8 + g8) * 16 + 8 * (hb_) + 4); \
            if ((hb_) == 0) { _Pragma("unroll") for (int q = 0; q < 8; ++q) y2[q] = (f32x2){0.f, 0.f}; } \
            _Pragma("unroll") for (int m = 0; m < 8; ++m) { const float av_ = m < 4 ? aa_[m & 3] : ab_[m & 3]; axpy16p(R[m], (f32x2){av_, av_}, y2); } asm volatile("" ::: "memory"); } while (0)
#define PS_FIN(s_, i_) do { f32x2 ysel_ = {0.f, 0.f}; _Pragma("unroll") for (int q = 0; q < 8; ++q) { const float a_ = xsum_g8(y2[q].x), b_ = xsum_g8(y2[q].y); if (g8 == q) ysel_ = (f32x2){a_, b_}; } \
            const int d_ = 128 * PS_SG(s_) + 16 * p + 2 * g8; const unsigned hb_ = *(const unsigned*)(HB + (size_t)(t0 + (i_)) * DM + d_); const f32x2 hv_ = (f32x2){bflo(hb_), bfhi(hb_)} + ysel_; \
            *(LAS unsigned*)(h2T + (i_) * DM + d_) = pk2(hv_.x, hv_.y); ssq[i_] += hv_.x * hv_.x + hv_.y * hv_.y; } while (0)
            PS_ISSUE(rA, VB, 0, 0, 0);
            for (int s = 0; s < 16; ++s) {
                PS_ISSUE(rB, VB, s, 0, 1); PS_AXPY(rA, 0, 0);
                PS_ISSUE(rA, VB, s, 1, 0); PS_AXPY(rB, 0, 1); PS_FIN(s, 0);
                PS_ISSUE(rB, VB, s, 1, 1); PS_AXPY(rA, 1, 0);
                PS_ISSUE(rA, VB, s, 2, 0); PS_AXPY(rB, 1, 1); PS_FIN(s, 1);
                PS_ISSUE(rB, VB, s, 2, 1); PS_AXPY(rA, 2, 0);
                PS_ISSUE(rA, VB, s, 3, 0); PS_AXPY(rB, 2, 1); PS_FIN(s, 2);
                PS_ISSUE(rB, VB, s, 3, 1); PS_AXPY(rA, 3, 0);
                if (s + 1 < 16) PS_ISSUE(rA, VB, s + 1, 0, 0); PS_AXPY(rB, 3, 1); PS_FIN(s, 3);
            }
#undef PS_AXPY
#undef PS_FIN
#undef PS_ISSUE
#undef PS_SG
        }
        { f32x4 fg[8];
#pragma unroll
          for (int j = 0; j < 8; ++j) fg[j] = *(const f32x4*)(P.final_g + 4 * lane + 256 * j);
#pragma unroll
          for (int i = 0; i < 4; ++i) { const float rs2 = 1.0f / sqrtf(wave_sum(ssq[i]) * (1.f / DM) + RMS_EPS);
#pragma unroll
            for (int j = 0; j < 8; ++j) { const v2u hv = *(const LAS v2u*)(h2T + i * DM + 4 * lane + 256 * j);
                *(f32x4*)(P.out + (size_t)(t0 + i) * DM + 4 * lane + 256 * j) = (f32x4){bflo(hv.x) * rs2 * fg[j].x, bfhi(hv.x) * rs2 * fg[j].y, bflo(hv.y) * rs2 * fg[j].z, bfhi(hv.y) * rs2 * fg[j].w}; } } }
        asm volatile("" ::: "memory");
    }
}
namespace moba {
constexpr float SCALE = 0.08838834764831845f;
constexpr float THR = 8.f;
constexpr bool WSKIP = false;
constexpr int D = 128, NW = 8, QBLK = 32, KVBLK = 64, QB = NW * QBLK;
constexpr int SHM_V = KVBLK * D * 2, SHM_K = KVBLK * D * 2;
constexpr int ATT_LDS_BYTES = 2 * SHM_V + 2 * SHM_K + NW * 64 * 4;
constexpr int KPITCH = INCP, QPITCH = INCP, OPITCH = DM;
typedef unsigned short bf16;
typedef short bf16x8 __attribute__((ext_vector_type(8)));
typedef short s16x4 __attribute__((ext_vector_type(4)));
typedef float f32x16 __attribute__((ext_vector_type(16)));
typedef float f32x4 __attribute__((ext_vector_type(4)));
typedef unsigned u32x4 __attribute__((ext_vector_type(4)));
template <class A, class Bt> struct same_t { static constexpr bool v = false; };
template <class A> struct same_t<A, A> { static constexpr bool v = true; };
#define KSWZ(row, colB) ((row) * 256 + ((colB) ^ (((row) & 7) << 4)))
#define SBAR() __builtin_amdgcn_sched_barrier(0)
__device__ __forceinline__ int v_st(int k, int c) { const int kk = (k & ~0xC) | ((k & 4) << 1) | ((k & 8) >> 1); return ((kk >> 3) * 4 + (c >> 5)) * 512 + ((kk & 7) * 32 + (c & 31)) * 2; }
__device__ __forceinline__ int v_rd_base(int lane) { return ((lane & 3) << 3) | (((lane >> 2) & 3) << 6) | (((lane >> 4) & 1) << 5) | (((lane >> 5) & 1) << 8); }
constexpr int v_rd_off(int d0, int ks, int half) { return d0 * 512 + ks * 4096 + half * 2048; }
__device__ __forceinline__ int crow(int r, int hi) { return (r & 3) + 8 * (r >> 2) + 4 * hi; }
__device__ __forceinline__ unsigned cvtpk(float lo, float hi) {
    unsigned r; asm volatile("v_cvt_pk_bf16_f32 %0, %1, %2" : "=v"(r) : "v"(lo), "v"(hi)); return r;
}
__device__ __forceinline__ bf16x8 pack8(f32x4 a, f32x4 b) {
    u32x4 w = {cvtpk(a[0], a[1]), cvtpk(a[2], a[3]), cvtpk(b[0], b[1]), cvtpk(b[2], b[3])};
    return *reinterpret_cast<bf16x8*>(&w);
}
template <class T> __device__ __forceinline__ bf16x8 load8(const T* p) {
    if constexpr (same_t<T, float>::v) { return pack8(*(const f32x4*)p, *(const f32x4*)(p + 4)); }
    else { return *reinterpret_cast<const bf16x8*>(p); }
}
__device__ __forceinline__ void mask_tile(f32x16& p0, f32x16& p1, int dq, unsigned W) {
    const float NEG = -__builtin_inff();
#pragma unroll
    for (int r = 0; r < 16; ++r) {
        const int c = (r & 3) + 8 * (r >> 2);
        if ((unsigned)(dq - c) >= W) p0[r] = NEG;
        if ((unsigned)(dq - c - 32) >= W) p1[r] = NEG;
    }
}
__device__ __forceinline__ void partialSM(f32x16& p0, f32x16& p1, float& m_reg, float& mn, float& alpha, float base0, float base1) {
    float pm0 = p0[0]; for (int r = 1; r < 16; ++r) pm0 = fmaxf(pm0, p0[r]); float pm1 = p1[0]; for (int r = 1; r < 16; ++r) pm1 = fmaxf(pm1, p1[r]);
    float pmax = fmaxf(pm0 + base0, pm1 + base1);
    { auto rr = __builtin_amdgcn_permlane32_swap(__float_as_uint(pmax), __float_as_uint(pmax), false, false);
      pmax = fmaxf(__uint_as_float(rr[0]), __uint_as_float(rr[1])); }
    constexpr float C2 = 1.4426950408889634f * SCALE;
    if (__builtin_expect(__all((pmax - m_reg) * SCALE <= THR), 1)) { mn = m_reg; alpha = 1.f; }
    else { mn = fmaxf(m_reg, pmax); alpha = __builtin_amdgcn_exp2f((m_reg - mn) * C2); m_reg = mn; }
    const float mnL0 = (base0 - mn) * C2, mnL1 = (base1 - mn) * C2;
    for (int r = 0; r < 16; ++r) p0[r] = fmaf(p0[r], C2, mnL0); for (int r = 0; r < 16; ++r) p1[r] = fmaf(p1[r], C2, mnL1);
    for (int r = 0; r < 16; ++r) p0[r] = __builtin_amdgcn_exp2f(p0[r]);
}
__device__ __forceinline__ void finishSM(f32x16& p0, f32x16& p1, float alpha, float& l_reg, bf16x8& pa0, bf16x8& pa1, bf16x8& pa2, bf16x8& pa3) {
    for (int r = 0; r < 16; ++r) p1[r] = __builtin_amdgcn_exp2f(p1[r]);
    float ps = 0; for (int r = 0; r < 16; ++r) ps += p0[r]; for (int r = 0; r < 16; ++r) ps += p1[r];
    { auto rr = __builtin_amdgcn_permlane32_swap(__float_as_uint(ps), __float_as_uint(ps), false, false);
      ps = __uint_as_float(rr[0]) + __uint_as_float(rr[1]); }
    l_reg = l_reg * alpha + ps;
#define PK4(P, B_, OUT) do { unsigned a0 = cvtpk(P[B_+0], P[B_+1]), a1 = cvtpk(P[B_+2], P[B_+3]);                          \
        unsigned b0 = cvtpk(P[B_+4], P[B_+5]), b1 = cvtpk(P[B_+6], P[B_+7]);                                             \
        auto r0 = __builtin_amdgcn_permlane32_swap(a0, b0, false, false); auto r1 = __builtin_amdgcn_permlane32_swap(a1, b1, false, false); \
        u32x4 w = {r0[0], r1[0], r0[1], r1[1]}; OUT = *reinterpret_cast<bf16x8*>(&w); } while (0)
    PK4(p0, 0, pa0); PK4(p0, 8, pa1); PK4(p1, 0, pa2); PK4(p1, 8, pa3);
#undef PK4
}
template <int KB, bool SK>
__device__ __forceinline__ void qkt(f32x16& p0, f32x16& p1, const char* K_lds, int r32, int hi, const bf16x8* qr, bool act) {
    if (SK && !act) { const float NEG = -__builtin_inff();
#pragma unroll
        for (int r = 0; r < 16; ++r) { p0[r] = NEG; p1[r] = NEG; } return; }
    p0 = f32x16{}; p1 = f32x16{};
    const char* kb[4];
#pragma unroll
    for (int dd = 0; dd < 4; ++dd) kb[dd] = K_lds + KB * SHM_K + KSWZ(r32, (dd * 16 + hi * 8) * 2);
#pragma unroll
    for (int d0 = 0; d0 < 8; ++d0) { const char* a = kb[d0 & 3] + (d0 >> 2) * 128;
        bf16x8 b0 = *reinterpret_cast<const bf16x8*>(a);
        bf16x8 b1 = *reinterpret_cast<const bf16x8*>(a + 32 * 256);
        p0 = __builtin_amdgcn_mfma_f32_32x32x16_bf16(b0, qr[d0], p0, 0, 0, 0);
        p1 = __builtin_amdgcn_mfma_f32_32x32x16_bf16(b1, qr[d0], p1, 0, 0, 0); }
}
template <int VB, bool SK>
__device__ __forceinline__ void pv_tile(f32x16* o, int vb0, bf16x8 pa0, bf16x8 pa1, bf16x8 pa2, bf16x8 pa3, bool act) {
    if (SK && !act) return;
#define TRRD(dst, off) asm volatile("ds_read_b64_tr_b16 %0, %1 offset:%2" : "=&v"(dst) : "v"(vb0), "i"(off) : "memory")
#define PV_D0(d0) do { s16x4 l0, l1, h0, h1; constexpr int b_ = VB * SHM_V + v_rd_off(d0, 0, 0);     \
        TRRD(l0, b_); TRRD(h0, b_ + 2048); TRRD(l1, b_ + 4096); TRRD(h1, b_ + 6144); \
        asm volatile("s_waitcnt lgkmcnt(0)" ::: "memory"); SBAR();                 \
        o[d0] = __builtin_amdgcn_mfma_f32_32x32x16_bf16(pa0, (bf16x8){l0[0], l0[1], l0[2], l0[3], h0[0], h0[1], h0[2], h0[3]}, o[d0], 0, 0, 0);   \
        o[d0] = __builtin_amdgcn_mfma_f32_32x32x16_bf16(pa1, (bf16x8){l1[0], l1[1], l1[2], l1[3], h1[0], h1[1], h1[2], h1[3]}, o[d0], 0, 0, 0);   \
        SBAR(); TRRD(l0, b_ + 8192); TRRD(h0, b_ + 10240); TRRD(l1, b_ + 12288); TRRD(h1, b_ + 14336); \
        asm volatile("s_waitcnt lgkmcnt(0)" ::: "memory"); SBAR();   \
        o[d0] = __builtin_amdgcn_mfma_f32_32x32x16_bf16(pa2, (bf16x8){l0[0], l0[1], l0[2], l0[3], h0[0], h0[1], h0[2], h0[3]}, o[d0], 0, 0, 0);   \
        o[d0] = __builtin_amdgcn_mfma_f32_32x32x16_bf16(pa3, (bf16x8){l1[0], l1[1], l1[2], l1[3], h1[0], h1[1], h1[2], h1[3]}, o[d0], 0, 0, 0); } while (0)
    PV_D0(0); PV_D0(1); PV_D0(2); PV_D0(3);
#undef PV_D0
#undef TRRD
}

template <class TIn, class TOut> struct BlockRef { const TIn* Q; const TIn* K; const TIn* V; TOut* O; int P0; const float* KM; float A; int jlo, jhi; float* ST; };
template <class TIn> struct Seam {
    bf16x8 qr[8];
    bf16x8 st_v0, st_v1, st_k0, st_k1; f32x4 sf0, sf1, sf2, sf3;
    f32x4 tq[16];
};
__device__ __forceinline__ int swa_jlo(int P0, int W) { const int lowk = P0 - W + 1; return lowk > 0 ? lowk / KVBLK : 0; }
#define ROW(p, k0, rr) ((p) + (size_t)((k0) + (rr)) * KPITCH + sc)
#define VMW() asm volatile("s_waitcnt vmcnt(0)" ::: "memory")
#define VMWN(n) asm volatile("s_waitcnt vmcnt(%0)" :: "i"(n) : "memory")
#define SLOAD_H(Kp, Vp, k0) do { S.st_v0 = load8<TIn>(ROW(Vp, k0, sr)); S.st_v1 = load8<TIn>(ROW(Vp, k0, 32 + sr));              \
                         S.st_k0 = load8<TIn>(ROW(Kp, k0, sr)); S.st_k1 = load8<TIn>(ROW(Kp, k0, 32 + sr)); } while (0)
#define SWRITE_HK(bf) do { *(bf16x8*)(K_lds + (bf) * SHM_K + kws) = S.st_k0; *(bf16x8*)(K_lds + (bf) * SHM_K + kws + 32 * 256) = S.st_k1; } while (0)
#define SWRITE_HV(bf) do { *(bf16x8*)(V_lds + (bf) * SHM_V + vst0) = S.st_v0; *(bf16x8*)(V_lds + (bf) * SHM_V + vst1) = S.st_v1; } while (0)
#define SWRITE_H(bf) do { SWRITE_HV(bf); SWRITE_HK(bf); } while (0)
#define SLOAD_F(p, k0) do { S.sf0 = *(const f32x4*)ROW(p, k0, sr); S.sf1 = *(const f32x4*)(ROW(p, k0, sr) + 4);                \
                            S.sf2 = *(const f32x4*)ROW(p, k0, 32 + sr); S.sf3 = *(const f32x4*)(ROW(p, k0, 32 + sr) + 4); } while (0)
#define SWRITE_KF(bf) do { *(bf16x8*)(K_lds + (bf) * SHM_K + kws) = pack8(S.sf0, S.sf1); *(bf16x8*)(K_lds + (bf) * SHM_K + kws + 32 * 256) = pack8(S.sf2, S.sf3); } while (0)
#define SWRITE_VF(bf) do { *(bf16x8*)(V_lds + (bf) * SHM_V + vst0) = pack8(S.sf0, S.sf1); *(bf16x8*)(V_lds + (bf) * SHM_V + vst1) = pack8(S.sf2, S.sf3); } while (0)
template <class TIn, class TOut>
__device__ __forceinline__ void causal_swa_prime(const BlockRef<TIn, TOut>& cur, int W, char* lds, Seam<TIn>& S) {
    constexpr bool F32 = same_t<TIn, float>::v;
    const int tid = ltid(), wid = __builtin_amdgcn_readfirstlane(tid >> 6), lane = tid & 63, r32 = lane & 31, hi = lane >> 5;
    const int sr = tid >> 4, sc = (tid & 15) * 8, kws = KSWZ(sr, sc * 2); char* K_lds = lds + 2 * SHM_V;
    const int kb0 = cur.jlo * KVBLK;
    for (int d0 = 0; d0 < 8; ++d0) S.qr[d0] = load8<TIn>(cur.Q + (size_t)(wid * QBLK + r32) * QPITCH + d0 * 16 + hi * 8);
    if constexpr (F32) { SLOAD_F((const float*)cur.K, kb0); VMW(); SWRITE_KF(0); SBAR(); SLOAD_F((const float*)cur.V, kb0); }
    else { SLOAD_H(cur.K, cur.V, kb0); VMW(); SWRITE_HK(0); }
    __syncthreads();
}
template <class TIn, class TOut>
__device__ __forceinline__ void causal_swa_block(const BlockRef<TIn, TOut>& cur, const BlockRef<TIn, TOut>& nxt, int skv, int W, char* lds, Seam<TIn>& S) {
    constexpr bool F32 = same_t<TIn, float>::v;
    const int tid = ltid(), wid = __builtin_amdgcn_readfirstlane(tid >> 6), lane = tid & 63, r32 = lane & 31, hi = lane >> 5;
    const int j_lo = cur.jlo, j_hi = cur.jhi;
    const int NT = j_hi - j_lo;
    const int kbn = nxt.jlo * KVBLK;
    const int qlo = cur.P0 + wid * QBLK, qm = qlo + r32 - 4 * hi;
    char* V_lds = lds; char* K_lds = lds + 2 * SHM_V;
    float* ws = (float*)(lds + 2 * SHM_V + 2 * SHM_K) + wid * 64; float* li_l = ws, * al_l = ws + 32;
    float m_reg = -1e30f, l_reg = 0; f32x16 o[4] = {};
    const int sr = tid >> 4, sc = (tid & 15) * 8, vst0 = v_st(sr, sc), vst1 = v_st(32 + sr, sc), kws = KSWZ(sr, sc * 2);
    const int vb0 = (int)(uintptr_t)V_lds + v_rd_base(lane);
    const TIn* Kh = cur.K; const TIn* Vh = cur.V;
    const float alA_ = cur.A;
    unsigned selm = 0u;
    { const int qb_ = cur.P0 >> 8;
      if (qb_ > 0) {
        float* kmL = (float*)(K_lds + SHM_K);
        *(f32x4*)(kmL + 4 * tid) = *(const f32x4*)(cur.KM + (size_t)(tid >> 5) * 1024 + 4 * (tid & 31));
        __syncthreads();
        float g[16];
#pragma unroll
        for (int n = 0; n < 16; ++n) g[n] = 0.f;
#pragma unroll
        for (int d0 = 0; d0 < 8; ++d0) { float qf[8];
#pragma unroll
            for (int j = 0; j < 8; ++j) qf[j] = __uint_as_float(((unsigned)(unsigned short)S.qr[d0][j]) << 16);
#pragma unroll
            for (int n = 0; n < 16; ++n) if (n < qb_) { const f32x4 k0 = *(const f32x4*)(kmL + n * 128 + d0 * 16 + hi * 8), k1 = *(const f32x4*)(kmL + n * 128 + d0 * 16 + hi * 8 + 4);
                g[n] += qf[0] * k0[0] + qf[1] * k0[1] + qf[2] * k0[2] + qf[3] * k0[3] + qf[4] * k1[0] + qf[5] * k1[1] + qf[6] * k1[2] + qf[7] * k1[3]; }
            asm volatile("" ::: "memory"); }
#pragma unroll
        for (int n = 0; n < 16; ++n) { const float a = g[n] + __shfl_xor(g[n], 32); g[n] = n < qb_ ? a : -1e30f; }
#pragma unroll
        for (int r = 0; r < 3; ++r) { float best = -3e38f; int bi = 0;
#pragma unroll
            for (int n = 0; n < 16; ++n) if (!((selm >> n) & 1u) && g[n] > best) { best = g[n]; bi = n; }
            selm |= 1u << bi; }
        selm &= (1u << qb_) - 1u;
        __syncthreads();
      }
      li_l[r32] = __uint_as_float(selm); }
#define RESC(a) do { if (__any((a) < 1.f)) { if (hi == 0) al_l[r32] = (a); asm volatile("s_waitcnt lgkmcnt(0)" ::: "memory");              \
                     for (int d_ = 0; d_ < 4; ++d_) for (int r = 0; r < 16; ++r) o[d_][r] *= al_l[crow(r, hi)]; } } while (0)
#define KBASE(t) ((j_lo + (t)) * KVBLK)
#define ACT(t) (KBASE(t) <= qlo + QBLK - 1 && KBASE(t) + KVBLK - 1 >= qlo - W + 1)
#define MASKT(P0_, P1_, t) do { const int kb_ = KBASE(t); if ((!SK || ACT(t)) && (kb_ + KVBLK - 1 > qlo || kb_ <= qlo + QBLK - 1 - W)) mask_tile(P0_, P1_, qm - kb_, (unsigned)W); \
        _Pragma("unroll") for (int r = 0; r < 16; ++r) { const float c_ = (float)((r & 3) + 8 * (r >> 2)); P0_[r] = fmaf(alA_, c_, P0_[r]); P1_[r] = fmaf(alA_, c_, P1_[r]); } } while (0)
#define BASE0(t) ((KBASE(t) < cur.P0 && !((__float_as_uint(li_l[r32]) >> (KBASE(t) >> 8)) & 1u)) ? -__builtin_inff() : alA_ * (float)(KBASE(t) - cur.P0 + 4 * hi))
#define BASE1(t) (BASE0(t) + 32.f * alA_)
    constexpr int NQL = F32 ? 16 : 8;
    constexpr bool SK = WSKIP && !F32;
#define SEAM_K0() do { VMWN(NQL); if constexpr (F32) { SWRITE_KF(0); SBAR(); SLOAD_F((const float*)nxt.V, kbn); } else { SWRITE_HK(0); } SBAR(); } while (0)
    f32x16 pA0, pA1, pB0, pB1; float mnA, mnB, alA, alB; bf16x8 pa0, pa1, pa2, pa3;
    if constexpr (F32) { VMW(); SWRITE_VF(0); SBAR(); } else { SWRITE_HV(0); SBAR(); }
    if (NT > 1) { if constexpr (F32) SLOAD_F((const float*)Kh, KBASE(1)); else SLOAD_H(Kh, Vh, KBASE(1)); }
    SBAR(); qkt<0, SK>(pA0, pA1, K_lds, r32, hi, S.qr, ACT(0));
    if constexpr (F32) { if (NT > 1) { VMW(); SWRITE_KF(1); SBAR(); SLOAD_F((const float*)Vh, KBASE(1)); } }
    MASKT(pA0, pA1, 0); partialSM(pA0, pA1, m_reg, mnA, alA, BASE0(0), BASE1(0));
    if (NT > 1) { VMW(); if constexpr (F32) { SWRITE_VF(1); SBAR(); if (NT > 2) SLOAD_F((const float*)Kh, KBASE(2)); } else SWRITE_H(1); }
    __syncthreads();
#define HALF_STEP(PX0, PX1, mnX, alX, PY0, PY1, alY, t, KB, VB, SB) do {                                                      \
        SBAR(); qkt<KB, SK>(PX0, PX1, K_lds, r32, hi, S.qr, ACT(t));                                             \
        finishSM(PY0, PY1, alY, l_reg, pa0, pa1, pa2, pa3); SBAR();                                                           \
        if ((t) + 1 < NT) { if constexpr (F32) { VMW(); SWRITE_KF(SB); SBAR(); SLOAD_F((const float*)Vh, KBASE((t) + 1)); }  \
                            else { SLOAD_H(Kh, Vh, KBASE((t) + 1)); } SBAR(); }                                               \
        pv_tile<VB, SK>(o, vb0, pa0, pa1, pa2, pa3, ACT((t) - 1)); MASKT(PX0, PX1, (t)); partialSM(PX0, PX1, m_reg, mnX, alX, BASE0(t), BASE1(t));                                        \
        __syncthreads();                                                                                                      \
        if ((t) + 1 < NT) { VMW(); if constexpr (F32) { SWRITE_VF(SB); SBAR(); if ((t) + 2 < NT) SLOAD_F((const float*)Kh, KBASE((t) + 2)); } \
                            else { SWRITE_H(SB); } }                                                                          \
        RESC(alX); __syncthreads(); } while (0)
    for (int t = 1; t + 1 < NT; t += 2) {
        HALF_STEP(pB0, pB1, mnB, alB, pA0, pA1, alA, t, 1, 0, 0);
        HALF_STEP(pA0, pA1, mnA, alA, pB0, pB1, alB, t + 1, 0, 1, 1);
    }
    const bool even = (NT & 1) == 0;
    if (even) { SBAR(); qkt<1, SK>(pB0, pB1, K_lds, r32, hi, S.qr, ACT(NT - 1)); SBAR(); }
#define QROW(e) (nxt.Q + (size_t)(wid * QBLK + r32) * QPITCH + ((e) >> 1) * 16 + hi * 8 + ((e) & 1) * 4)
    if constexpr (F32) { SLOAD_F((const float*)nxt.K, kbn); SBAR();
#pragma unroll
        for (int e = 0; e < 8; ++e) S.tq[e] = *(const f32x4*)QROW(e); }
    else { SLOAD_H(nxt.K, nxt.V, kbn); SBAR();
#pragma unroll
        for (int d0 = 0; d0 < 8; ++d0) S.qr[d0] = load8<TIn>(nxt.Q + (size_t)(wid * QBLK + r32) * QPITCH + d0 * 16 + hi * 8); }
    SBAR();
    finishSM(pA0, pA1, alA, l_reg, pa0, pa1, pa2, pa3); SBAR();
    if constexpr (F32) {
#pragma unroll
        for (int e = 8; e < 16; ++e) S.tq[e] = *(const f32x4*)QROW(e); SBAR(); }
#undef QROW
    pv_tile<0, SK>(o, vb0, pa0, pa1, pa2, pa3, ACT(even ? NT - 2 : NT - 1));
    if (even) { MASKT(pB0, pB1, NT - 1); partialSM(pB0, pB1, m_reg, mnB, alB, BASE0(NT - 1), BASE1(NT - 1)); __syncthreads(); RESC(alB);
        finishSM(pB0, pB1, alB, l_reg, pa0, pa1, pa2, pa3); SBAR(); pv_tile<1, SK>(o, vb0, pa0, pa1, pa2, pa3, ACT(NT - 1)); }
    SBAR(); SEAM_K0();
    if (hi == 0) { li_l[r32] = l_reg; if (cur.ST) { cur.ST[(wid * QBLK + r32) * 16] = m_reg; cur.ST[(wid * QBLK + r32) * 16 + 1] = l_reg; } }
    asm volatile("s_waitcnt lgkmcnt(0)" ::: "memory");
    float rli[16];
#pragma unroll
    for (int r = 0; r < 16; ++r) { const float l_ = li_l[crow(r, hi)]; rli[r] = l_ > 0.f ? __builtin_amdgcn_rcpf(l_) : 0.f; }
    TOut* Ow = cur.O + (size_t)(wid * QBLK) * OPITCH;
#pragma unroll
    for (int r = 0; r < 16; ++r) { const int orow = crow(r, hi);
#pragma unroll
        for (int d0 = 0; d0 < 4; ++d0) { const float v = o[d0][r] * rli[r];
            if constexpr (same_t<TOut, float>::v) { Ow[(size_t)orow * OPITCH + d0 * 32 + r32] = v; }
            else { const float vn = __shfl_xor(v, 1);
                   if ((r32 & 1) == 0) *(unsigned*)(Ow + (size_t)orow * OPITCH + d0 * 32 + r32) = cvtpk(v, vn); } } }
    if constexpr (F32) {
#pragma unroll
        for (int d0 = 0; d0 < 8; ++d0) S.qr[d0] = pack8(S.tq[2 * d0], S.tq[2 * d0 + 1]); }
    __syncthreads();
#undef RESC
#undef KBASE
#undef ACT
#undef MASKT
#undef SEAM_K0
#undef HALF_STEP
}
#undef ROW
#undef VMW
#undef VMWN
#undef SLOAD_H
#undef SWRITE_HK
#undef SWRITE_HV
#undef SWRITE_H
#undef SLOAD_F
#undef SWRITE_KF
#undef SWRITE_VF

#undef BASE0
#undef BASE1
}
constexpr size_t WS_OSL = WS_XN, WS_OSU = WS_H;
constexpr size_t WS_STL = WS_WIN, WS_STU = WS_WIN + 1 * MiB;
constexpr int MOBA_SPLIT_QB = 8;
__device__ __forceinline__ void phase_moba(KP P, char* lds, int vcu, int G) {
    typedef moba::BlockRef<moba::bf16, moba::bf16> BR;
    const moba::bf16* proj = (const moba::bf16*)(P.ws + WS_PROJ); moba::bf16* AR = (moba::bf16*)(P.ws + WS_AR); const float* kmean = (const float*)(P.ws + WS_KMEAN);
    constexpr int W = 1 << 30;
    auto mkref = [&](int bh, int qb, int part) -> BR { const int b = bh >> 3, h = bh & 7; BR r; const int nt = 4 * qb + 4;
        r.Q = proj + (size_t)(b * SEQ + qb * 256) * INCP + h * 128; r.K = proj + (size_t)(b * SEQ) * INCP + C_AK + h * 128; r.V = proj + (size_t)(b * SEQ) * INCP + C_AV + h * 128;
        moba::bf16* ob = part == 0 ? AR : (moba::bf16*)(P.ws + (part == 1 ? WS_OSL : WS_OSU));
        r.O = ob + (size_t)(b * SEQ + qb * 256) * DM + h * 128; r.P0 = qb * 256; r.KM = kmean + (size_t)(b * 16) * 1024 + h * 128; r.A = exp2f(-(float)(h + 1)) * (1.f / moba::SCALE);
        r.jlo = part == 2 ? nt / 2 : 0; r.jhi = part == 1 ? nt / 2 : nt;
        r.ST = part == 0 ? nullptr : (float*)(P.ws + (part == 1 ? WS_STL : WS_STU)) + ((size_t)(b * SEQ + qb * 256) * 8 + h) * 2;
        return r; };
    moba::Seam<moba::bf16> S;
    if (G == 256) {
        const int q_ = vcu & 15, bh = vcu >> 4;
        const int qbA[16] = {-1, -1, 15, 15,  7, 14, 14, 13, 13,  6, 12, 12, 11, 11,  5, 10};
        const int ptA[16] = { 0,  0,  2,  1,  0,  2,  1,  2,  1,  0,  2,  1,  2,  1,  0,  2};
        const int qbB[16] = {-1, -1, -1, -1, -1,  0, -1,  1,  2,  3,  8,  8,  4,  9,  9, 10};
        const int ptB[16] = { 0,  0,  0,  0,  0,  0,  0,  0,  0,  0,  2,  1,  0,  2,  1,  1};
        int qa = -1, pa = 0, qb2 = -1, pb = 0;
#pragma unroll
        for (int k = 0; k < 16; ++k) if (k == q_) { qa = qbA[k]; pa = ptA[k]; qb2 = qbB[k]; pb = ptB[k]; }
        for (int it = 0; it < 2; ++it) { const int qq = it == 0 ? qa : qb2, pp = it == 0 ? pa : pb; if (qq < 0) continue;
            const BR cur = mkref(bh, qq, pp);
            moba::causal_swa_prime<moba::bf16, moba::bf16>(cur, W, lds, S);
            moba::causal_swa_block<moba::bf16, moba::bf16>(cur, cur, SEQ, W, lds, S); }
    } else {
        for (int item = vcu; item < 256; item += G) {
            const BR cur = mkref(item >> 4, item & 15, 0);
            moba::causal_swa_prime<moba::bf16, moba::bf16>(cur, W, lds, S);
            moba::causal_swa_block<moba::bf16, moba::bf16>(cur, cur, SEQ, W, lds, S); }
    }
}
__device__ __forceinline__ void moba_combine(KP P, int vcu, int G) {
    if (G != 256) return;
    const int tid = ltid(); const bf16* OL = (const bf16*)(P.ws + WS_OSL); const bf16* OU = (const bf16*)(P.ws + WS_OSU); bf16* AR = (bf16*)(P.ws + WS_AR);
    const float* STL = (const float*)(P.ws + WS_STL); const float* STU = (const float*)(P.ws + WS_STU);
    constexpr int NSPL = 16 - MOBA_SPLIT_QB; constexpr float C2 = 1.4426950408889634f * moba::SCALE;
    for (int item = vcu; item < 16 * NSPL * 2; item += G) {
        const int half = item & 1, k = item >> 1, bh = k / NSPL, qb = MOBA_SPLIT_QB + k % NSPL, b = bh >> 3, h = bh & 7;
        const int row = b * SEQ + qb * 256 + half * 128 + (tid >> 2), c0 = (tid & 3) * 32;
        const size_t so = ((size_t)row * 8 + h) * 2; const float mL = STL[so], lL = STL[so + 1], mU = STU[so], lU = STU[so + 1];
        const float m = fmaxf(mL, mU); const float wL = lL * __builtin_amdgcn_exp2f((mL - m) * C2), wU = lU * __builtin_amdgcn_exp2f((mU - m) * C2); const float inv = __builtin_amdgcn_rcpf(wL + wU);
        const float aL = wL * inv, aU = wU * inv; const size_t o = (size_t)row * DM + h * 128 + c0;
#pragma unroll
        for (int j = 0; j < 4; ++j) { const v4u l4 = *(const v4u*)(OL + o + 8 * j), u4 = *(const v4u*)(OU + o + 8 * j); v4u r4;
#pragma unroll
            for (int e = 0; e < 4; ++e) r4[e] = pk2(aL * bflo(l4[e]) + aU * bflo(u4[e]), aL * bfhi(l4[e]) + aU * bfhi(u4[e]));
            *(v4u*)(AR + o + 8 * j) = r4; }
    }
}
constexpr size_t WS_SKB = WS_KMEAN + 256 * 1024;
__device__ __forceinline__ void prologue_subkeys(KP P, int vcu, int G) {
    unsigned* dst = (unsigned*)(P.ws + WS_SKB);
    for (int i = vcu * NTHR + ltid(); i < 8 * 2 * 128 * 128 / 2; i += G * NTHR) dst[i] = pk2(P.sub_keys[2 * i], P.sub_keys[2 * i + 1]);
}
__device__ __forceinline__ unsigned f2key(float v) { const unsigned u = __float_as_uint(v); return u ^ ((u >> 31) ? 0xFFFFFFFFu : 0x80000000u); }
__device__ __forceinline__ float key2f(unsigned k) { return __uint_as_float(k ^ ((k >> 31) ? 0x80000000u : 0xFFFFFFFFu)); }
__device__ __forceinline__ unsigned umax3(unsigned a, unsigned b, unsigned c) { return max(max(a, b), c); }
__device__ __forceinline__ void peer_route_tiles(KP P, LAS unsigned char* lds, int tt0, int nitems, int h) {
    const int tid = ltid(), lane = tid & 63, wave = __builtin_amdgcn_readfirstlane(tid >> 6), l15 = lane & 15, q4 = lane >> 4;
    const bf16* PQ = (const bf16*)(P.ws + WS_PROJ); const bf16* SKB = (const bf16*)(P.ws + WS_SKB);
    int* ridx = (int*)(P.ws + WS_PROJ + 64 * MiB); float* rgate = (float*)(P.ws + WS_PROJ + 68 * MiB);
    for (int it_ = 0; it_ < nitems; ++it_) {
        LAS float* sval = (LAS float*)(lds + it_ * 16384); LAS int* sidx = (LAS int*)(lds + it_ * 16384 + 8192);
        const int tt = tt0 + it_, p = wave & 1, sub = wave >> 1, tl = sub * 16 + l15;
        const bf16* qp = PQ + ((size_t)tt * 64 + tl) * DM + h * 256 + p * 128 + 8 * q4;
        bf16x8 qb[4];
#pragma unroll
        for (int kk = 0; kk < 4; ++kk) qb[kk] = *(const bf16x8*)(qp + 32 * kk);
        const bf16* sk = SKB + ((size_t)((h * 2 + p) * 128 + l15)) * 128 + 8 * q4;
        unsigned key[32];
#pragma unroll
        for (int nt = 0; nt < 8; ++nt) { f32x4v acc = {0.f, 0.f, 0.f, 0.f};
#pragma unroll
            for (int kk = 0; kk < 4; ++kk) acc = __builtin_amdgcn_mfma_f32_16x16x32_bf16(*(const bf16x8*)(sk + nt * 16 * 128 + 32 * kk), qb[kk], acc, 0, 0, 0);
#pragma unroll
            for (int e = 0; e < 4; ++e) key[4 * nt + e] = (f2key(acc[e]) & ~127u) | (unsigned)(127 - (16 * nt + 4 * q4 + e)); }
#define CE(a_, b_) { const unsigned hi_ = max(KA[a_], KA[b_]), lo_ = min(KA[a_], KA[b_]); KA[a_] = hi_; KA[b_] = lo_; }
#define SORT16_NET CE(0,1) CE(2,3) CE(0,2) CE(1,3) CE(1,2) CE(4,5) CE(6,7) CE(4,6) CE(5,7) CE(5,6) CE(0,4) CE(2,6) CE(2,4) CE(1,5) CE(3,7) CE(3,5) CE(1,2) CE(3,4) CE(5,6) CE(8,9) CE(10,11) CE(8,10) CE(9,11) CE(9,10) CE(12,13) CE(14,15) CE(12,14) CE(13,15) CE(13,14) CE(8,12) CE(10,14) CE(10,12) CE(9,13) CE(11,15) CE(11,13) CE(9,10) CE(11,12) CE(13,14) CE(0,8) CE(4,12) CE(4,8) CE(2,10) CE(6,14) CE(6,10) CE(2,4) CE(6,8) CE(10,12) CE(1,9) CE(5,13) CE(5,9) CE(3,11) CE(7,15) CE(7,11) CE(3,5) CE(7,9) CE(11,13) CE(1,2) CE(3,4) CE(5,6) CE(7,8) CE(9,10) CE(11,12) CE(13,14)
#define BMERGE16(T_) _Pragma("unroll") for (int d_ = 8; d_ >= 1; d_ >>= 1) { _Pragma("unroll") for (int i_ = 0; i_ < 16; ++i_) if ((i_ & d_) == 0) { const unsigned hi_ = max(T_[i_], T_[i_ + d_]), lo_ = min(T_[i_], T_[i_ + d_]); T_[i_] = hi_; T_[i_ + d_] = lo_; } }
#define KA key
        SORT16_NET
#undef KA
#define KA (key + 16)
        SORT16_NET
#undef KA
        unsigned t16[16];
#pragma unroll
        for (int i = 0; i < 16; ++i) t16[i] = max(key[i], key[31 - i]);
        BMERGE16(t16)
        { const bool odd = (lane & 16) != 0; unsigned L[16];
#pragma unroll
          for (int i = 0; i < 16; ++i) L[i] = odd ? t16[15 - i] : t16[i];
#pragma unroll
          for (int i = 0; i < 16; ++i) { auto x = __builtin_amdgcn_permlane16_swap(L[i], L[i], false, false); t16[i] = max(x[0], x[1]); }
          BMERGE16(t16) }
        { const bool odd = (lane & 32) != 0; unsigned L[16];
#pragma unroll
          for (int i = 0; i < 16; ++i) L[i] = odd ? t16[15 - i] : t16[i];
#pragma unroll
          for (int i = 0; i < 16; ++i) { auto x = __builtin_amdgcn_permlane32_swap(L[i], L[i], false, false); t16[i] = max(x[0], x[1]); }
          BMERGE16(t16) }
#undef CE
#undef SORT16_NET
#undef BMERGE16
        if (q4 == 0) {
#pragma unroll
            for (int r4 = 0; r4 < 4; ++r4) {
                *(LAS f32x4*)(sval + (tl * 2 + p) * 16 + 4 * r4) = (f32x4){key2f(t16[4 * r4] & ~127u), key2f(t16[4 * r4 + 1] & ~127u), key2f(t16[4 * r4 + 2] & ~127u), key2f(t16[4 * r4 + 3] & ~127u)};
                *(LAS v4u*)(sidx + (tl * 2 + p) * 16 + 4 * r4) = (v4u){127u - (t16[4 * r4] & 127u), 127u - (t16[4 * r4 + 1] & 127u), 127u - (t16[4 * r4 + 2] & 127u), 127u - (t16[4 * r4 + 3] & 127u)}; }
        }
    }
    __syncthreads();
    {
        const int it_ = wave; const int tt = tt0 + it_;
        LAS float* sval = (LAS float*)(lds + it_ * 16384); LAS int* sidx = (LAS int*)(lds + it_ * 16384 + 8192);
        if (wave < nitems) {
            const LAS float* av = sval + (lane * 2) * 16; const LAS float* bv = av + 16; const LAS int* ai = sidx + (lane * 2) * 16; const LAS int* bi = ai + 16;
            unsigned hk[16];
            const float b0 = bv[0];
#pragma unroll
            for (int i4 = 0; i4 < 4; ++i4) { const f32x4 t4 = *(const LAS f32x4*)(av + 4 * i4);
#pragma unroll
                for (int e = 0; e < 4; ++e) hk[4 * i4 + e] = (f2key(t4[e] + b0) & ~255u) | (unsigned)(255 - (4 * i4 + e) * 16); }
            float bestv[16]; int beste[16];
#pragma unroll
            for (int r = 0; r < 16; ++r) {
                unsigned m0 = umax3(hk[0], hk[1], hk[2]), m1 = umax3(hk[3], hk[4], hk[5]), m2 = umax3(hk[6], hk[7], hk[8]), m3 = umax3(hk[9], hk[10], hk[11]);
                m0 = umax3(m0, hk[12], hk[13]); m1 = umax3(m1, hk[14], hk[15]);
                const unsigned best = max(max(m0, m1), max(m2, m3));
                const int f = 255 - (int)(best & 255u), bi_ = f >> 4, bj = f & 15;
                const float a_i = av[bi_]; bestv[r] = a_i + bv[bj]; beste[r] = ai[bi_] * 128 + bi[bj];
                const int nj = bj + 1;
                const unsigned nk = nj < 16 ? ((f2key(a_i + bv[nj & 15]) & ~255u) | (unsigned)(255 - (bi_ * 16 + nj))) : 0u;
#pragma unroll
                for (int i = 0; i < 16; ++i) hk[i] = i == bi_ ? nk : hk[i];
            }
            float se = 0.f; const float mx = bestv[0];
#pragma unroll
            for (int r = 0; r < 16; ++r) { bestv[r] = __expf(bestv[r] - mx); se += bestv[r]; }
            const float ise = 1.f / se; const size_t o = ((size_t)tt * 64 + lane) * 128 + h * 16;
#pragma unroll
            for (int r4 = 0; r4 < 4; ++r4) { *(v4u*)(ridx + o + 4 * r4) = (v4u){(unsigned)beste[4 * r4], (unsigned)beste[4 * r4 + 1], (unsigned)beste[4 * r4 + 2], (unsigned)beste[4 * r4 + 3]};
                *(f32x4*)(rgate + o + 4 * r4) = (f32x4){bestv[4 * r4] * ise, bestv[4 * r4 + 1] * ise, bestv[4 * r4 + 2] * ise, bestv[4 * r4 + 3] * ise}; }
        }
        __syncthreads();
    }
}
#define XB_TMO      128
#define XB_XCNT(j)  (256  + 64 * (j))
#define XB_XSUB(j)  (1280 + 64 * (j))
#define XB_XGEN(j)  (2304 + 64 * (j))
#define XB_TOP      3328
#define XB_TOPGEN   3392
#define XCD_BAR_WORDS 3456
#define XB_SPIN_CAP (1u << 18)

__device__ __forceinline__ unsigned xb_ld(unsigned* p)              { return __hip_atomic_load(p, __ATOMIC_RELAXED, __HIP_MEMORY_SCOPE_AGENT); }
__device__ __forceinline__ unsigned xb_add(unsigned* p, unsigned v) { return __hip_atomic_fetch_add(p, v, __ATOMIC_RELAXED, __HIP_MEMORY_SCOPE_AGENT); }
__device__ __forceinline__ unsigned xb_xcc_id() { return (unsigned)__builtin_amdgcn_s_getreg((3 << 11) | 20) & 0xFu; }
#define XB_SPIN(cond, bar) do { unsigned _sp = 0; while (cond) { __builtin_amdgcn_s_sleep(1); \
    if ((++_sp & 255u) == 0u) { if (xb_ld(&(bar)[XB_TMO])) break; if (_sp > XB_SPIN_CAP) { atomicAdd(&(bar)[XB_TMO], 1u); break; } } } } while (0)

struct XcdBarrier {
    unsigned* bar; unsigned x;
    volatile LAS unsigned* st;
};

__device__ __forceinline__ XcdBarrier xcd_barrier_post(unsigned* bar, volatile LAS unsigned* st) {
    XcdBarrier b; b.bar = bar; b.x = xb_xcc_id(); b.st = st;
    if (threadIdx.x == 0) (void)xb_add(&bar[XB_XCNT(b.x)], 1u);
    return b;
}
__device__ __forceinline__ void xcd_barrier_complete(unsigned* bar, unsigned x, unsigned& nloc, unsigned& nx) {
    const unsigned G = gridDim.x * gridDim.y * gridDim.z;
    unsigned sum, cnt, mine, sp = 0u;
    for (;;) {
        sum = 0u; cnt = 0u; mine = 0u;
#pragma unroll
        for (unsigned j = 0; j < 16; ++j) { const unsigned c = xb_ld(&bar[XB_XCNT(j)]); sum += c; cnt += (c > 0u) ? 1u : 0u; mine = (j == x) ? c : mine; }
        if (sum == G) break;
        __builtin_amdgcn_s_sleep(1);
        if ((++sp & 255u) == 0u) { if (xb_ld(&bar[XB_TMO])) break; if (sp > XB_SPIN_CAP) { atomicAdd(&bar[XB_TMO], 1u); break; } }
    }
    nloc = mine > 0u ? mine : 1u; nx = cnt > 0u ? cnt : 1u;
}

__device__ __forceinline__ void xcd_barrier(const XcdBarrier& b) {
    asm volatile("s_waitcnt vmcnt(0)" ::: "memory");
    __syncthreads();
    if (threadIdx.x == 0) {
        unsigned* bar = b.bar;
        __builtin_amdgcn_s_waitcnt(0);
        unsigned nloc = b.st[0], nx = b.st[1];
        if (nloc == 0u) { xcd_barrier_complete(bar, b.x, nloc, nx); b.st[0] = nloc; b.st[1] = nx; }
        const unsigned old = xb_add(&bar[XB_XSUB(b.x)], 1u);
        const unsigned gen = old / nloc;
        if (old + 1u == (gen + 1u) * nloc) {
            __builtin_amdgcn_fence(__ATOMIC_RELEASE, "agent");
            asm volatile("s_waitcnt vmcnt(0)" ::: "memory");
            const unsigned og = xb_add(&bar[XB_TOP], 1u);
            const unsigned tg = og / nx;
            if (og + 1u == (tg + 1u) * nx) xb_add(&bar[XB_TOPGEN], 1u);
            else XB_SPIN(xb_ld(&bar[XB_TOPGEN]) == tg, bar);
            __builtin_amdgcn_fence(__ATOMIC_ACQUIRE, "agent");
            xb_add(&bar[XB_XGEN(b.x)], 1u);
            asm volatile("s_waitcnt vmcnt(0)" ::: "memory");
        } else {
            XB_SPIN(xb_ld(&bar[XB_XGEN(b.x)]) == gen, bar);
            __builtin_amdgcn_fence(__ATOMIC_ACQUIRE, "agent");
            asm volatile("s_waitcnt vmcnt(0)" ::: "memory");
        }
    }
    __syncthreads();
}
#ifndef MK_ONE_LAUNCH
#define MK_ONE_LAUNCH 1
#endif
constexpr int N_PHASES = 11;
__global__ void __launch_bounds__(NTHR, 2) mega(Params Pkernarg) {
    extern __shared__ __attribute__((aligned(16))) unsigned char lds_raw[];
    LAS unsigned char* lds = (LAS unsigned char*)lds_raw;
    const int tid = ltid();
    const int G = gridDim.x, bx = blockIdx.x; const int vcu = (G % 8 == 0) ? (bx % 8) * (G / 8) + bx / 8 : bx;
    for (int u = tid; u < (LDS_BYTES - LDSCTL_OFF) / 4; u += NTHR) ((LAS unsigned*)(lds + LDSCTL_OFF))[u] = 0u;
    __syncthreads();
#if MK_ONE_LAUNCH
    XcdBarrier bar = xcd_barrier_post((unsigned*)(params_ptr()->ws + WS_CTL) + CW_BAR + params_ptr()->bar_li * XCD_BAR_WORDS, (volatile LAS unsigned*)(lds + MISC_OFF) + 8);
#define GRID_BAR() xcd_barrier(bar)
#else
#define GRID_BAR() do {} while (0)
#endif
#ifndef PHOFF
#define PHOFF 0
#endif
#define IN(k) (!((PHOFF >> (k)) & 1))
#define BOTH(k) (IN(k) && IN((k) + 1))
    if (IN(0)) { KP P = *params_ptr(); phase_prologue(P, lds, vcu, G); prologue_subkeys(P, vcu, G); prologue_lora(P, vcu, G); if (BOTH(0)) GRID_BAR(); }
    if (IN(1)) { KP P = *params_ptr();
        pg8::Gemm g{(const bf16*)(P.ws + WS_XN), (const bf16*)(P.ws + WS_WIN), TT, INCP, DM}; pg8::Order1 S; S.init(TT, INCP, G, bx);
        pg8::EpiBf16<0> E{(bf16*)(P.ws + WS_PROJ), INCP, nullptr, 0, 0, 1.f};
        pg8::gemm_phase<pg8::EpiBf16<0>, pg8::Order1, true, true>(lds, g, S, E);
        phase_convert_tables(P, lds);
        if (BOTH(1)) GRID_BAR();
    }
    if (IN(2)) { KP P = *params_ptr(); phase_act(P, vcu, G); phase_kmean(P, lds, vcu, G); if (BOTH(2)) GRID_BAR(); }
    if (IN(3)) { KP P = *params_ptr(); phase_rwkv_stage_a(P, lds, vcu, G); if (BOTH(3)) GRID_BAR(); }
    if (IN(4)) { KP P = *params_ptr(); if ((vcu & 15) < 2 && vcu < 256) rwkv_stage_b(P, lds, (vcu >> 4) * 2 + (vcu & 15)); phase_moba(P, (char*)lds_raw, vcu, G); }
    if (IN(5)) { GRID_BAR(); KP P = *params_ptr(); moba_combine(P, vcu, G); GRID_BAR(); }
    if (IN(6)) { KP P = *params_ptr();
        pg8::Gemm g{(const bf16*)(P.ws + WS_AR), (const bf16*)(P.ws + WS_WOUT), TT, DM, DM}; pg8::StaticOrder S; S.init(TT, DM, G, bx);
        pg8::EpiH E{P.x, (bf16*)(P.ws + WS_XN), (float*)(P.ws + WS_SSP), DM};
        pg8::gemm_phase<pg8::EpiH, pg8::StaticOrder, true, true>(lds, g, S, E);
        if (BOTH(6)) GRID_BAR();
    }
    if (IN(8)) { KP P = *params_ptr(); phase_rstd(P, vcu, G); GRID_BAR();
        pg8::Gemm g{(const bf16*)(P.ws + WS_XN), (const bf16*)(P.ws + WS_WQ), TT, DM, DM}; pg8::StaticOrder S; S.init(TT, DM, G, bx);
        pg8::EpiBf16Row E{(bf16*)(P.ws + WS_PROJ), DM, (const float*)(P.ws + WS_SSP + 2 * MiB)};
        pg8::gemm_phase<pg8::EpiBf16Row, pg8::StaticOrder, true, true>(lds, g, S, E);
        if (G == 256) { const int wg_ = (bx & 7) * 32 + (bx >> 3); pg8::Unit u; u.pm = (wg_ >> 6) * 8 + (wg_ & 7); u.pn = (wg_ & 63) >> 3;
            asm volatile("s_waitcnt vmcnt(0)" ::: "memory"); __syncthreads(); __builtin_amdgcn_fence(__ATOMIC_ACQUIRE, "agent"); asm volatile("s_waitcnt vmcnt(0)" ::: "memory");
            peer_route_tiles(P, lds, 4 * u.pm, 4, u.pn);
        } else if (G != 256) { GRID_BAR(); for (int item = vcu; item < 1024; item += G) peer_route_tiles(P, lds, item >> 3, 1, item & 7); }
        if (BOTH(8)) GRID_BAR();
    }
    if (IN(10)) { KP P = *params_ptr(); phase_peer_sliced(P, lds, bx, G); }
#undef IN
#undef BOTH
}

extern "C" void kernel_launch(void* const* d_in, const int* in_sizes, int n_in, void* d_out, int out_size, void* d_ws, size_t ws_size, hipStream_t stream) {
    static int grid = 0;
    if (grid == 0) {
        if (n_in != 21 || in_sizes[0] != TT * DM || out_size != TT * DM || ws_size < WS_END) {
            fprintf(stderr, "kernel_launch: unexpected shapes: n_in %d in0 %d out %d ws %zu\n", n_in, n_in > 0 ? in_sizes[0] : -1, out_size, ws_size); grid = -1; return; }
        int dev = 0, cus = 0;
        if (hipGetDevice(&dev) != hipSuccess || hipDeviceGetAttribute(&cus, hipDeviceAttributeMultiprocessorCount, dev) != hipSuccess) { grid = -1; return; }
        if (hipFuncSetAttribute((const void*)mega, hipFuncAttributeMaxDynamicSharedMemorySize, LDS_BYTES) != hipSuccess) { fprintf(stderr, "kernel_launch: hipFuncSetAttribute failed\n"); grid = -1; return; }
        int per_cu = 0;
        if (hipOccupancyMaxActiveBlocksPerMultiprocessor(&per_cu, (const void*)mega, NTHR, LDS_BYTES) != hipSuccess || per_cu < 1) fprintf(stderr, "kernel_launch: occupancy query says %d blocks per CU\n", per_cu);
        (void)hipGetLastError();
        grid = cus;
    }
    if (grid < 0) return;
    (void)hipMemsetAsync((char*)d_ws + WS_CTL, 0, CTL_ZERO_BYTES, stream);
    Params p{};
    p.x = (const float*)d_in[0]; p.norm1_g = (const float*)d_in[1]; p.w_in = (const float*)d_in[2]; p.mu = (const float*)d_in[3]; p.w0 = (const float*)d_in[4];
    p.w2 = (const float*)d_in[5]; p.a0 = (const float*)d_in[6]; p.a2 = (const float*)d_in[7]; p.g2 = (const float*)d_in[8]; p.k_k = (const float*)d_in[9];
    p.k_a = (const float*)d_in[10]; p.r_k = (const float*)d_in[11]; p.ln_g = (const float*)d_in[12]; p.ln_b = (const float*)d_in[13]; p.w_out = (const float*)d_in[14];
    p.norm2_g = (const float*)d_in[15]; p.wq = (const float*)d_in[16]; p.sub_keys = (const float*)d_in[17]; p.pu = (const float*)d_in[18]; p.pv = (const float*)d_in[19];
    p.final_g = (const float*)d_in[20]; p.out = (float*)d_out; p.ws = (unsigned char*)d_ws;
    p.ph_lo = 0; p.ph_hi = N_PHASES; p.bar_li = 0;
    hipLaunchKernelGGL(mega, dim3(grid), dim3(NTHR), LDS_BYTES, stream, p);
}
```

```cpp
#include <hip/hip_runtime.h>
#include <cstdio>
#include <cstdint>
__device__ __forceinline__ int ltid() { int t = threadIdx.x; asm volatile("" : "+v"(t)); return t; }
namespace pg8 {
#define PG8_LAS __attribute__((address_space(3)))
typedef unsigned short bf16_t;
typedef short bf16x8 __attribute__((ext_vector_type(8)));
typedef float f32x4 __attribute__((ext_vector_type(4)));
typedef unsigned u32x4 __attribute__((ext_vector_type(4)));
constexpr int BM = 256, BK = 64, HALF = 128, HTB = HALF * BK * 2  , STAGE_BYTES = 8 * HTB, NXCD = 8, WGM = 8;

__host__ __device__ __forceinline__ int lds_byte(int r, int c) { const int st = (r >> 4) * 2 + (c >> 5), rr = r & 15, cc = c & 31, ob = rr * 64 + cc * 2; return st * 1024 + (ob ^ (((ob >> 9) & 1) << 5)); }
__host__ __device__ __forceinline__ void stage_rc(int b, int& R, int& C) { const int st = b / 1024, sb = b % 1024, swz = sb ^ (((sb >> 9) & 1) << 5); R = (st >> 1) * 16 + swz / 64; C = (st & 1) * 32 + (swz % 64) / 2; }
__host__ __device__ __forceinline__ int perm32(int rho) { const int n = rho >> 4, i = rho & 15; return 8 * (i >> 2) + 4 * n + (i & 3); }

struct Unit { int pm, pn; };
struct Gemm { const bf16_t* A; const bf16_t* Bt; int M, N, K; };

struct StaticOrder {
    int nM, nN, nwg, G, c;
    __host__ __device__ void init(int M, int N, int G_, int c_) { nM = M / BM; nN = N / BM; nwg = nM * nN; G = G_; c = c_; }
    __host__ __device__ bool next(int i, Unit& u) const {
        const long L = (long)i * G + c; if (L >= nwg) return false;
        int wgid = (int)L; { const int q = nwg / NXCD, r = nwg % NXCD, xcd = wgid % NXCD, off = wgid / NXCD; wgid = (xcd < r ? xcd * (q + 1) : r * (q + 1) + (xcd - r) * q) + off; }
        const int nig = WGM * nN, gid = wgid / nig, fm = gid * WGM, gsz = (nM - fm) < WGM ? (nM - fm) : WGM;
        u.pm = fm + ((wgid % nig) % gsz); u.pn = (wgid % nig) / gsz; return true;
    }
    __device__ __forceinline__ void a_ready(const Unit&) const {}
    __device__ __forceinline__ void done(const Unit&) const {}
};

__device__ __forceinline__ unsigned cvt_pk_bf16(float lo, float hi) { unsigned r; asm volatile("v_cvt_pk_bf16_f32 %0, %1, %2" : "=v"(r) : "v"(lo), "v"(hi)); return r; }
typedef float f32x2 __attribute__((ext_vector_type(2)));
__device__ __forceinline__ f32x2 gelu_pk(f32x2 v) {
    const f32x2 av = __builtin_elementwise_abs(v), d = av * 0.2316418882f + 1.0f;
    f32x2 t; t.x = __builtin_amdgcn_rcpf(d.x); t.y = __builtin_amdgcn_rcpf(d.y);
    f32x2 q = t * 0.5307027145f + (-0.7265760135f); q = q * t + 0.7107068705f; q = q * t + (-0.142248368f); q = q * t + 0.127414796f; q = q * t;
    const f32x2 s = (v * v) * (-0.72134752044f);
    f32x2 e; e.x = __builtin_amdgcn_exp2f(s.x); e.y = __builtin_amdgcn_exp2f(s.y);
    const f32x2 m = v * (q * e), r = v - m;
    f32x2 o; o.x = v.x < 0.f ? m.x : r.x; o.y = v.y < 0.f ? m.y : r.y; return o;
}

template <int ACT  > struct EpiBf16 {
    static constexpr bool PERM = true, AFTER_DRAIN = false; static_assert(ACT == 0 || ACT == 1, "EpiBf16: ACT is 0 (none) or 1 (gelu_pk)");
    bf16_t* O; int ldc; const float* bias; int split_cols; size_t split_stride; float scale0;
    __device__ __forceinline__ void operator()(const f32x4 (&acc)[2][2][4][2], const Unit& u, int wr, int wc, int fr, int fq) const {
        const int row0 = u.pm * BM + wr * 64 + fr; int colt = u.pn * BM; bf16_t* base = O;
        float sc = 1.f; if (split_cols) { const int t = colt / split_cols; base += (size_t)t * split_stride; colt -= t * split_cols; if (t == 0) sc = scale0; }
        const int col0 = colt + wc * 32 + 8 * fq, bcol0 = u.pn * BM + wc * 32 + 8 * fq;
        f32x4 bv[2][2];
#pragma unroll
        for (int bj = 0; bj < 2; ++bj)
#pragma unroll
            for (int n = 0; n < 2; ++n) bv[bj][n] = bias ? *(const f32x4*)(bias + bcol0 + bj * HALF + 4 * n) : (f32x4){0.f, 0.f, 0.f, 0.f};
#pragma unroll
        for (int ai = 0; ai < 2; ++ai)
#pragma unroll
            for (int m = 0; m < 4; ++m) { bf16_t* rowp = base + (size_t)(row0 + ai * HALF + m * 16) * ldc + col0;
#pragma unroll
                for (int bj = 0; bj < 2; ++bj) { f32x4 v0 = acc[ai][bj][m][0] + bv[bj][0], v1 = acc[ai][bj][m][1] + bv[bj][1];
                    if (ACT == 1) { f32x2 a = gelu_pk((f32x2){v0[0], v0[1]}), b = gelu_pk((f32x2){v0[2], v0[3]}), c = gelu_pk((f32x2){v1[0], v1[1]}), d = gelu_pk((f32x2){v1[2], v1[3]});
                        v0 = (f32x4){a.x, a.y, b.x, b.y}; v1 = (f32x4){c.x, c.y, d.x, d.y}; }
                    v0 = v0 * sc; v1 = v1 * sc; u32x4 w; w.x = cvt_pk_bf16(v0[0], v0[1]); w.y = cvt_pk_bf16(v0[2], v0[3]); w.z = cvt_pk_bf16(v1[0], v1[1]); w.w = cvt_pk_bf16(v1[2], v1[3]);
                    *(u32x4*)(rowp + bj * HALF) = w; } }
    }
};
template <class Epi, class Sched, bool ALIGN_EPI = false, bool SP2 = false>
__device__ __forceinline__ void gemm_phase(PG8_LAS unsigned char* lds, const Gemm g, const Sched& S, const Epi& E) {
    const int tid = ltid(), wid = __builtin_amdgcn_readfirstlane(tid >> 6), lane = tid & 63, wr = wid >> 2, wc = wid & 3, fr = lane & 15, fq = lane >> 4;
    const int K = g.K, nt = K / BK;
    unsigned voffA[2], voffB[2];
#pragma unroll
    for (int i = 0; i < 2; ++i) { int R, C; stage_rc(tid * 16 + i * 8192, R, C); const int Rb = Epi::PERM ? ((R & ~31) + perm32(R & 31)) : R;
        voffA[i] = (unsigned)(R * K + C) * 2u; voffB[i] = (unsigned)(Rb * K + C) * 2u; }
    const size_t kstep = (size_t)(BK * 2);
    const size_t hstep = (size_t)HALF * K * 2;
    const size_t tstep = 2 * hstep;
    const unsigned ldsw = (unsigned)wid * 1024u;
    const int aoff = lds_byte(wr * 64 + fr, fq * 8), boff = lds_byte(wc * 32 + fr, fq * 8);
#define PG8_SA(b, h) (((b) * 2 + (h)) * HTB)
#define PG8_SB(b, h) ((4 + (b) * 2 + (h)) * HTB)
#define PG8_STAGE(bufoff, gbase, voff) do { _Pragma("unroll") for (int _i = 0; _i < 2; ++_i) \
        __builtin_amdgcn_global_load_lds((const unsigned*)((const char*)(gbase) + (voff)[_i]), (PG8_LAS unsigned*)(lds + (bufoff) + ldsw + _i * 8192), 16, 0, 0); } while (0)
#define PG8_LDA(dst, b, h) do { _Pragma("unroll") for (int m = 0; m < 4; ++m) _Pragma("unroll") for (int k = 0; k < 2; ++k) dst[m][k] = *(const PG8_LAS bf16x8*)(lds + PG8_SA(b, h) + aoff + m * 2048 + k * 1024); } while (0)
#define PG8_LDB(dst, b, h) do { _Pragma("unroll") for (int n = 0; n < 2; ++n) _Pragma("unroll") for (int k = 0; k < 2; ++k) dst[n][k] = *(const PG8_LAS bf16x8*)(lds + PG8_SB(b, h) + boff + n * 2048 + k * 1024); } while (0)
#define PG8_MMA(ai, bj, At, Bt) do { __builtin_amdgcn_s_setprio(1); _Pragma("unroll") for (int m = 0; m < 4; ++m) _Pragma("unroll") for (int n = 0; n < 2; ++n) _Pragma("unroll") for (int k = 0; k < 2; ++k) \
        acc[ai][bj][m][n] = __builtin_amdgcn_mfma_f32_16x16x32_bf16(Bt[n][k], At[m][k], acc[ai][bj][m][n], 0, 0, 0); __builtin_amdgcn_s_setprio(0); } while (0)
#define PG8_WAIT_V(n) asm volatile("s_waitcnt vmcnt(" #n ")" ::: "memory")
#define PG8_WAIT_L(n) asm volatile("s_waitcnt lgkmcnt(" #n ")" ::: "memory")
#define PG8_BAR __builtin_amdgcn_s_barrier()
#define PG8_SCHED __builtin_amdgcn_sched_barrier(0)
    Unit cur, nxt; int ui = 0;
    if (!S.next(0, cur)) return;
    f32x4 acc[2][2][4][2];
#pragma unroll
    for (int a = 0; a < 2; ++a)
#pragma unroll
        for (int b = 0; b < 2; ++b)
#pragma unroll
            for (int m = 0; m < 4; ++m)
#pragma unroll
                for (int n = 0; n < 2; ++n) acc[a][b][m][n] = (f32x4){0.f, 0.f, 0.f, 0.f};
    bf16x8 At[4][2], B0[2][2], B1[2][2];
    const char* cA = (const char*)g.A + (size_t)cur.pm * tstep; const char* cB = (const char*)g.Bt + (size_t)cur.pn * tstep;
    S.a_ready(cur);
    if constexpr (SP2) {
        PG8_STAGE(PG8_SB(0, 0), cB, voffB); PG8_STAGE(PG8_SB(0, 1), cB + hstep, voffB); PG8_STAGE(PG8_SA(0, 0), cA, voffA); PG8_STAGE(PG8_SA(0, 1), cA + hstep, voffA);
        if (wr == 1) PG8_BAR;
        PG8_WAIT_V(2); PG8_BAR;
        PG8_STAGE(PG8_SB(1, 0), cB + kstep, voffB); PG8_STAGE(PG8_SA(1, 0), cA + kstep, voffA); PG8_STAGE(PG8_SB(1, 1), cB + hstep + kstep, voffB);
        PG8_WAIT_V(6); PG8_BAR;
    } else {
        PG8_STAGE(PG8_SB(0, 0), cB, voffB); PG8_STAGE(PG8_SA(0, 0), cA, voffA); PG8_STAGE(PG8_SB(0, 1), cB + hstep, voffB); PG8_STAGE(PG8_SA(0, 1), cA + hstep, voffA);
        if (wr == 1) PG8_BAR;
        PG8_WAIT_V(4); PG8_BAR;
        PG8_STAGE(PG8_SB(1, 0), cB + kstep, voffB); PG8_STAGE(PG8_SA(1, 0), cA + kstep, voffA); PG8_STAGE(PG8_SB(1, 1), cB + hstep + kstep, voffB);
        PG8_WAIT_V(6); PG8_BAR;
    }
    for (;;) {
        const bool has_next = S.next(ui + 1, nxt);
        const char* nA = has_next ? (const char*)g.A + (size_t)nxt.pm * tstep : cA; const char* nB = has_next ? (const char*)g.Bt + (size_t)nxt.pn * tstep : cB;
        for (int t = 0; t < nt; t += 2) {
            const bool last = (t == nt - 2);
            const char* a1 = cA + (size_t)(t + 1) * kstep;
            const char* a2 = last ? nA : cA + (size_t)(t + 2) * kstep; const char* b2 = last ? nB : cB + (size_t)(t + 2) * kstep;
            const char* a3 = a2 + kstep; const char* b3 = b2 + kstep;
            if (last && has_next) S.a_ready(nxt);
            if constexpr (SP2) {
            PG8_LDB(B0, 0, 0); PG8_LDB(B1, 0, 1); PG8_SCHED; PG8_LDA(At, 0, 0); PG8_STAGE(PG8_SA(1, 1), a1 + hstep, voffA);
            PG8_WAIT_V(8); PG8_WAIT_L(0); PG8_BAR; PG8_MMA(0, 0, At, B0); PG8_MMA(0, 1, At, B1); PG8_BAR; PG8_SCHED;
            PG8_LDA(At, 0, 1); PG8_STAGE(PG8_SB(0, 0), b2, voffB); PG8_STAGE(PG8_SB(0, 1), b2 + hstep, voffB); PG8_STAGE(PG8_SA(0, 0), a2, voffA);
            PG8_WAIT_V(8); PG8_WAIT_L(0); PG8_BAR; PG8_MMA(1, 0, At, B0); PG8_MMA(1, 1, At, B1); PG8_BAR; PG8_SCHED;
            PG8_LDB(B0, 1, 0); PG8_LDB(B1, 1, 1); PG8_SCHED; PG8_LDA(At, 1, 0); PG8_STAGE(PG8_SA(0, 1), a2 + hstep, voffA);
            PG8_WAIT_V(8); PG8_WAIT_L(0); PG8_BAR; PG8_MMA(0, 0, At, B0); PG8_MMA(0, 1, At, B1); PG8_BAR; PG8_SCHED;
            PG8_LDA(At, 1, 1); PG8_STAGE(PG8_SB(1, 0), b3, voffB); PG8_STAGE(PG8_SB(1, 1), b3 + hstep, voffB); PG8_STAGE(PG8_SA(1, 0), a3, voffA);
            PG8_WAIT_V(8); PG8_WAIT_L(0); PG8_BAR; PG8_MMA(1, 0, At, B0); PG8_MMA(1, 1, At, B1); PG8_BAR; PG8_SCHED;
            } else {
            PG8_LDB(B0, 0, 0); PG8_SCHED; PG8_LDA(At, 0, 0); PG8_STAGE(PG8_SA(1, 1), a1 + hstep, voffA);
            PG8_WAIT_L(8); PG8_BAR; PG8_WAIT_L(0); PG8_MMA(0, 0, At, B0); PG8_BAR; PG8_SCHED;
            PG8_LDB(B1, 0, 1); PG8_STAGE(PG8_SB(0, 0), b2, voffB);
            PG8_BAR; PG8_WAIT_L(0); PG8_MMA(0, 1, At, B1); PG8_BAR;
            PG8_LDA(At, 0, 1); PG8_STAGE(PG8_SA(0, 0), a2, voffA);
            PG8_BAR; PG8_WAIT_L(0); PG8_MMA(1, 0, At, B0); PG8_BAR; PG8_SCHED;
            PG8_STAGE(PG8_SB(0, 1), b2 + hstep, voffB);
            PG8_WAIT_V(6); PG8_BAR; PG8_MMA(1, 1, At, B1); PG8_BAR;
            PG8_LDB(B0, 1, 0); PG8_SCHED; PG8_LDA(At, 1, 0); PG8_STAGE(PG8_SA(0, 1), a2 + hstep, voffA);
            PG8_WAIT_L(8); PG8_BAR; PG8_WAIT_L(0); PG8_MMA(0, 0, At, B0); PG8_BAR; PG8_SCHED;
            PG8_LDB(B1, 1, 1); PG8_STAGE(PG8_SB(1, 0), b3, voffB);
            PG8_BAR; PG8_WAIT_L(0); PG8_MMA(0, 1, At, B1); PG8_BAR;
            PG8_LDA(At, 1, 1); PG8_STAGE(PG8_SA(1, 0), a3, voffA);
            PG8_BAR; PG8_WAIT_L(0); PG8_MMA(1, 0, At, B0); PG8_BAR; PG8_SCHED;
            PG8_STAGE(PG8_SB(1, 1), b3 + hstep, voffB);
            PG8_WAIT_V(6); PG8_BAR; PG8_MMA(1, 1, At, B1); PG8_BAR;
            }
        }
        if constexpr (ALIGN_EPI) { if (wr == 0) PG8_BAR; }
        if constexpr (!Epi::AFTER_DRAIN) { E(acc, cur, wr, wc, fr, fq); S.done(cur); }
        if (!has_next) break;
#pragma unroll
        for (int a = 0; a < 2; ++a)
#pragma unroll
            for (int b = 0; b < 2; ++b)
#pragma unroll
                for (int m = 0; m < 4; ++m)
#pragma unroll
                    for (int n = 0; n < 2; ++n) acc[a][b][m][n] = (f32x4){0.f, 0.f, 0.f, 0.f};
        cur = nxt; cA = nA; cB = nB; ++ui;
        if constexpr (ALIGN_EPI) { if (wr == 1) PG8_BAR; }
    }
    PG8_WAIT_V(0);
    if constexpr (!ALIGN_EPI) { if (wr == 0) PG8_BAR; }
    PG8_BAR;
    if constexpr (Epi::AFTER_DRAIN) { E.fused(acc, cur, wr, wc, fr, fq, lds, wid, lane); S.done(cur); }
#undef PG8_SA
#undef PG8_SB
#undef PG8_STAGE
#undef PG8_LDA
#undef PG8_LDB
#undef PG8_MMA
#undef PG8_WAIT_V
#undef PG8_WAIT_L
#undef PG8_BAR
#undef PG8_SCHED
}
}
#define GAS __attribute__((address_space(1)))
#define LAS __attribute__((address_space(3)))
typedef unsigned short bf16;
typedef unsigned v4u __attribute__((ext_vector_type(4)));
typedef unsigned v2u __attribute__((ext_vector_type(2)));
typedef float f32x4 __attribute__((ext_vector_type(4)));
constexpr int NWAVES = 8, NTHR = 512;
constexpr int TT = 8192, DM = 2048, SEQ = 4096;
constexpr int INC = 6592, INCP = 6656;
constexpr int C_AK = 1024, C_AV = 2048, C_RW = 3072;
constexpr int RWC = 3520;
constexpr float RMS_EPS = 1e-6f;
constexpr size_t MiB = 1u << 20;
constexpr size_t WS_CTL = 0, CTL_ZERO_BYTES = 1 * MiB;
constexpr size_t WS_WIN = 1 * MiB;
constexpr size_t WS_WOUT = 27 * MiB;
constexpr size_t WS_WQ = 35 * MiB;
constexpr size_t WS_XN = 43 * MiB;
constexpr size_t WS_PROJ = 75 * MiB;
constexpr size_t WS_AR = 179 * MiB;
constexpr size_t WS_H = 211 * MiB;
constexpr size_t WS_RWA = 275 * MiB;
constexpr size_t WS_CHK = 339 * MiB;
constexpr size_t WS_KMEAN = 467 * MiB;
constexpr size_t WS_ACT = WS_H;
constexpr size_t WS_SSP = WS_WIN + 4 * MiB;
constexpr size_t WS_LORA = 468 * MiB;
constexpr size_t WS_END = 469 * MiB;
constexpr int CW_BAR = 4096, CW_MOBA_CTR = 16384, CW_SS = 32768;
constexpr int RING_BYTES = 147456, LDSCTL_OFF = RING_BYTES, MISC_OFF = LDSCTL_OFF + 320, LDS_BYTES = 163840;

struct Params {
    const float* x; const float* norm1_g; const float* w_in; const float* mu; const float* w0; const float* w2; const float* a0; const float* a2; const float* g2;
    const float* k_k; const float* k_a; const float* r_k; const float* ln_g; const float* ln_b; const float* w_out; const float* norm2_g; const float* wq;
    const float* sub_keys; const float* pu; const float* pv; const float* final_g;
    float* out; unsigned char* ws;
    int ph_lo, ph_hi, bar_li, pad;
};

typedef const __attribute__((address_space(4))) Params& KP;
__device__ __forceinline__ const __attribute__((address_space(4))) Params* params_ptr() {
    const __attribute__((address_space(4))) Params* ka = (const __attribute__((address_space(4))) Params*)__builtin_amdgcn_kernarg_segment_ptr(); asm volatile("" : "+s"(ka)); return ka; }
typedef float f32x2_t __attribute__((ext_vector_type(2))); typedef __bf16 bf16x2_t __attribute__((ext_vector_type(2)));
__device__ __forceinline__ unsigned pk2(float lo, float hi) { const f32x2_t v = {lo, hi}; const bf16x2_t b = __builtin_convertvector(v, bf16x2_t); return __builtin_bit_cast(unsigned, b); }
__device__ __forceinline__ unsigned f2bf(float f) { return pk2(f, 0.f) & 0xffffu; }
__device__ __forceinline__ float bf2f(bf16 v) { return __builtin_bit_cast(float, (unsigned)v << 16); }
__device__ __forceinline__ float bflo(unsigned u) { return __builtin_bit_cast(float, u << 16); }
__device__ __forceinline__ float bfhi(unsigned u) { return __builtin_bit_cast(float, u & 0xffff0000u); }
#define DPP_F(v, ctrl) __builtin_bit_cast(float, __builtin_amdgcn_update_dpp(0, __builtin_bit_cast(int, (v)), (ctrl), 0xf, 0xf, true))
__device__ __forceinline__ float wave_sum(float v) {
    v += DPP_F(v, 0xB1);
    v += DPP_F(v, 0x4E);
    v += DPP_F(v, 0x141);
    v += DPP_F(v, 0x140);
    const int b = __builtin_bit_cast(int, v);
    return (__builtin_bit_cast(float, __builtin_amdgcn_readlane(b, 0)) + __builtin_bit_cast(float, __builtin_amdgcn_readlane(b, 16))) +
           (__builtin_bit_cast(float, __builtin_amdgcn_readlane(b, 32)) + __builtin_bit_cast(float, __builtin_amdgcn_readlane(b, 48)));
}
__device__ __forceinline__ float wave_max(float v) {
#pragma unroll
    for (int o = 1; o < 64; o <<= 1) v = fmaxf(v, __shfl_xor(v, o));
    return v;
}
#define LDS_WAIT() asm volatile("s_waitcnt lgkmcnt(0)" ::: "memory")

__device__ __forceinline__ void p0_transpose_item(const float* W, int K, int N, bf16* WT, LAS float* scr, int item, int lane, const float* ksc = nullptr) {
    const int nblk = N / 32, kb = item / nblk, nb = item % nblk, k0 = 64 * kb, n0 = 32 * nb;
#pragma unroll 8
    for (int i = 0; i < 32; ++i) { const int kk = 2 * i + (lane >> 5); float wv = W[(size_t)(k0 + kk) * N + n0 + (lane & 31)]; if (ksc) wv *= ksc[k0 + kk]; scr[kk * 33 + (lane & 31)] = wv; }
    LDS_WAIT(); asm volatile("" ::: "memory");
    const int c = lane & 7;
#pragma unroll
    for (int j = 0; j < 4; ++j) { const int n = (lane >> 3) + 8 * j; const LAS float* s = scr + (8 * c) * 33 + n;
        v4u o; o.x = pk2(s[0 * 33], s[1 * 33]); o.y = pk2(s[2 * 33], s[3 * 33]); o.z = pk2(s[4 * 33], s[5 * 33]); o.w = pk2(s[6 * 33], s[7 * 33]);
        *(v4u*)(WT + (size_t)(n0 + n) * K + k0 + 8 * c) = o; }
    LDS_WAIT(); asm volatile("" ::: "memory");
}
__device__ __forceinline__ void rms_row_to_bf16(const float* xrow, const float* g, bf16* orow, int lane) {
    const f32x4* xr = (const f32x4*)xrow + lane;
    f32x4 v[8]; float s = 0.f;
#pragma unroll
    for (int j = 0; j < 8; ++j) { v[j] = xr[64 * j]; s += (v[j].x * v[j].x + v[j].y * v[j].y) + (v[j].z * v[j].z + v[j].w * v[j].w); }
    const float rs = 1.0f / sqrtf(wave_sum(s) * (1.f / DM) + RMS_EPS);
    v2u* o8 = (v2u*)orow + lane;
#pragma unroll
    for (int j = 0; j < 8; ++j) { const f32x4 gg = ((const f32x4*)g)[lane + 64 * j];
        v2u o; o.x = pk2(v[j].x * rs * gg.x, v[j].y * rs * gg.y); o.y = pk2(v[j].z * rs * gg.z, v[j].w * rs * gg.w); o8[64 * j] = o; }
}
__device__ __forceinline__ void phase_prologue(KP P, LAS unsigned char* lds, int vcu, int G) {
    const int tid = ltid(), lane = tid & 63, wave = tid >> 6;
    LAS float* scr = (LAS float*)(lds + wave * 16384);
    const int gw = vcu * NWAVES + wave, NGW = G * NWAVES;
    bf16* WIN = (bf16*)(P.ws + WS_WIN); bf16* WOUT = (bf16*)(P.ws + WS_WOUT); bf16* WQ = (bf16*)(P.ws + WS_WQ); bf16* XN = (bf16*)(P.ws + WS_XN);
    constexpr int I_IN = (DM / 64) * (INC / 32), I_SQ = (DM / 64) * (DM / 32);
    for (int it = gw; it < I_IN + 2 * I_SQ; it += NGW) {
        int r = it;
        if (r < I_IN) { p0_transpose_item(P.w_in, DM, INC, WIN, scr, r, lane); continue; } r -= I_IN;
        if (r < I_SQ) { p0_transpose_item(P.w_out, DM, DM, WOUT, scr, r, lane); continue; } r -= I_SQ;
        p0_transpose_item(P.wq, DM, DM, WQ, scr, r, lane, P.norm2_g);
    }
    for (int i = vcu * NTHR + tid; i < (INCP - INC) * DM / 8; i += G * NTHR) ((v4u*)(WIN + (size_t)INC * DM))[i] = (v4u){0u, 0u, 0u, 0u};
    for (int m = gw; m < TT; m += NGW) rms_row_to_bf16(P.x + (size_t)m * DM, P.norm1_g, XN + (size_t)m * DM, lane);
}

namespace pg8 {
struct EpiF32 {
    static constexpr bool PERM = false, AFTER_DRAIN = false;
    const float* base; float* out; int ldc;
    __device__ __forceinline__ void operator()(const f32x4 (&acc)[2][2][4][2], const Unit& u, int wr, int wc, int fr, int fq) const {
        const int col0 = u.pn * BM + wc * 32 + 4 * fq;
#pragma unroll
        for (int ai = 0; ai < 2; ++ai)
#pragma unroll
            for (int m = 0; m < 4; ++m) { const int r = ai * HALF + wr * 64 + m * 16 + fr; const size_t off = (size_t)(u.pm * BM + r) * ldc + col0;
#pragma unroll
                for (int bj = 0; bj < 2; ++bj)
#pragma unroll
                    for (int n = 0; n < 2; ++n) { f32x4 o = acc[ai][bj][m][n]; if (base) o = o + *(const f32x4*)(base + off + bj * HALF + n * 16);
                        *(f32x4*)(out + off + bj * HALF + n * 16) = o; } }
    }
};
struct EpiH {
    static constexpr bool PERM = false, AFTER_DRAIN = false;
    const float* base; bf16* outb; float* ss; int ldc;
    __device__ __forceinline__ void operator()(const f32x4 (&acc)[2][2][4][2], const Unit& u, int wr, int wc, int fr, int fq) const {
        const int col0 = u.pn * BM + wc * 32 + 4 * fq;
#pragma unroll
        for (int ai = 0; ai < 2; ++ai) {
            f32x4 xv[4][2][2];
#pragma unroll
            for (int m = 0; m < 4; ++m) { const size_t off = (size_t)(u.pm * BM + ai * HALF + wr * 64 + m * 16 + fr) * ldc + col0;
#pragma unroll
                for (int bj = 0; bj < 2; ++bj)
#pragma unroll
                    for (int n = 0; n < 2; ++n) xv[m][bj][n] = *(const f32x4*)(base + off + bj * HALF + n * 16); }
#pragma unroll
            for (int m = 0; m < 4; ++m) { const int r = ai * HALF + wr * 64 + m * 16 + fr; const size_t off = (size_t)(u.pm * BM + r) * ldc + col0; float sq = 0.f;
#pragma unroll
                for (int bj = 0; bj < 2; ++bj)
#pragma unroll
                    for (int n = 0; n < 2; ++n) { const f32x4 o = acc[ai][bj][m][n] + xv[m][bj][n];
                        *(v2u*)(outb + off + bj * HALF + n * 16) = (v2u){pk2(o.x, o.y), pk2(o.z, o.w)};
                        sq += (o.x * o.x + o.y * o.y) + (o.z * o.z + o.w * o.w); }
                sq += __shfl_xor(sq, 16); sq += __shfl_xor(sq, 32);
                if (fq == 0) ss[(size_t)(u.pm * BM + r) * 32 + u.pn * 4 + wc] = sq; }
        }
    }
};
struct EpiBf16Row {
    static constexpr bool PERM = true, AFTER_DRAIN = false;
    bf16_t* O; int ldc; const float* rs;
    __device__ __forceinline__ void operator()(const f32x4 (&acc)[2][2][4][2], const Unit& u, int wr, int wc, int fr, int fq) const {
        const int row0 = u.pm * BM + wr * 64 + fr, col0 = u.pn * BM + wc * 32 + 8 * fq;
        float scv[2][4];
#pragma unroll
        for (int ai = 0; ai < 2; ++ai)
#pragma unroll
            for (int m = 0; m < 4; ++m) scv[ai][m] = rs[row0 + ai * HALF + m * 16];
#pragma unroll
        for (int ai = 0; ai < 2; ++ai)
#pragma unroll
            for (int m = 0; m < 4; ++m) { const int row = row0 + ai * HALF + m * 16; const float sc = scv[ai][m]; bf16_t* rowp = O + (size_t)row * ldc + col0;
#pragma unroll
                for (int bj = 0; bj < 2; ++bj) { const f32x4 v0 = acc[ai][bj][m][0] * sc, v1 = acc[ai][bj][m][1] * sc;
                    u32x4 w; w.x = cvt_pk_bf16(v0[0], v0[1]); w.y = cvt_pk_bf16(v0[2], v0[3]); w.z = cvt_pk_bf16(v1[0], v1[1]); w.w = cvt_pk_bf16(v1[2], v1[3]);
                    *(u32x4*)(rowp + bj * HALF) = w; } }
    }
};
struct Order1 {
    StaticOrder s; bool split; int c;
    __device__ void init(int M, int N, int G_, int c_) { s.init(M, N, G_, c_); split = (G_ == 256 && M == 8192 && N == 6656); c = c_; }
    __device__ bool next(int i, Unit& u) const {
        if (!split) return s.next(i, u);
        if (c >= 208 || i >= 4) return false;
        const int x = c & 7, j = c >> 3; u.pm = 4 * x + 2 * (i >> 1) + (j & 1); u.pn = 13 * (i & 1) + (j >> 1); return true; }
    __device__ __forceinline__ void a_ready(const Unit&) const {}
    __device__ __forceinline__ void done(const Unit&) const {}
};
}

__device__ __forceinline__ void phase_rstd(KP P, int vcu, int G) {
    const float* ssp = (const float*)(P.ws + WS_SSP); float* rstd = (float*)(P.ws + WS_SSP + 2 * MiB);
    for (int row = vcu * NTHR + ltid(); row < TT; row += G * NTHR) { const f32x4* sp = (const f32x4*)(ssp + (size_t)row * 32); float a = 0.f;
#pragma unroll
        for (int j = 0; j < 8; ++j) { const f32x4 v = sp[j]; a += (v.x + v.y) + (v.z + v.w); }
        rstd[row] = 1.0f / sqrtf(a * (1.f / DM) + RMS_EPS); }
}
__device__ __forceinline__ void phase_kmean(KP P, LAS unsigned char* lds, int vcu, int G) {
    const int tid = ltid(); const bf16* proj = (const bf16*)(P.ws + WS_PROJ); float* kmean = (float*)(P.ws + WS_KMEAN);
    LAS float* red = (LAS float*)lds;
    for (int item = vcu; item < 32 * 8; item += G) {
        const int bb = item >> 3, cg = item & 7;
        const int c = tid & 127, rq = tid >> 7;
        const bf16* p = proj + (size_t)(bb * 256 + rq * 64) * INCP + C_AK + cg * 128 + c;
        float s = 0.f;
        for (int r = 0; r < 64; ++r) s += bf2f(p[(size_t)r * INCP]);
        red[rq * 128 + c] = s;
        __syncthreads();
        if (tid < 128) kmean[(size_t)bb * 1024 + cg * 128 + tid] = (red[tid] + red[128 + tid] + red[256 + tid] + red[384 + tid]) * (1.f / 256.f);
        __syncthreads();
    }
}

typedef short bf16x8 __attribute__((ext_vector_type(8)));
typedef float f32x16 __attribute__((ext_vector_type(16)));
constexpr int CP = 72;
constexpr int MATB = 64 * CP * 2;
enum { M_AT = 0, M_BT = 1, M_KT = 2, M_RT = 3, M_VT = 4, M_BBT = 5, M_KBT = 6, M_LAK = 7, M_MRB = 8, M_MRK = 9, M_LAB = 10, M_AHT = 0, M_U0T = 1 };
constexpr int L_RHS = 11 * MATB;
constexpr int L_MISC = L_RHS + 32768;
constexpr int L_TB = L_MISC + 9 * 64 * 4;
constexpr int L_A_END = L_TB + 2048;
static_assert(L_A_END <= RING_BYTES, "stage A LDS");
constexpr size_t CHK_ITEM = 6 * 8192;

__device__ __forceinline__ f32x16 mm_tile(const LAS unsigned char* A, int ra, const LAS unsigned char* B, int rb, f32x16 acc, int lane, int k0 = 0, int k1 = 4) {
    const int r = lane & 31, hi = lane >> 5;
    const LAS unsigned char* ap = A + ((ra * 32 + r) * CP + 8 * hi) * 2; const LAS unsigned char* bp = B + ((rb * 32 + r) * CP + 8 * hi) * 2;
#pragma unroll
    for (int kk = 0; kk < 4; ++kk) if (kk >= k0 && kk < k1) {
        const bf16x8 a = *(const LAS bf16x8*)(ap + kk * 32), b = *(const LAS bf16x8*)(bp + kk * 32);
        acc = __builtin_amdgcn_mfma_f32_32x32x16_bf16(a, b, acc, 0, 0, 0); }
    return acc;
}
__device__ __forceinline__ int crow32(int reg, int hi) { return (reg & 3) + 8 * (reg >> 2) + 4 * hi; }

__device__ __forceinline__ void prologue_lora(KP P, int vcu, int G) {
    bf16* w2T = (bf16*)(P.ws + WS_LORA); bf16* a2T = w2T + 1024 * 96; bf16* g2T = a2T + 1024 * 96;
    for (int e = vcu * NTHR + ltid(); e < 448 * 1024; e += G * NTHR) { const int i = e >> 10, n = e & 1023;
        if (i < 96) w2T[n * 96 + i] = (bf16)f2bf(P.w2[e]); else if (i < 192) a2T[n * 96 + (i - 96)] = (bf16)f2bf(P.a2[e - 96 * 1024]); else g2T[n * 256 + (i - 192)] = (bf16)f2bf(P.g2[e - 192 * 1024]); }
}
__device__ __forceinline__ void phase_act(KP P, int vcu, int G) {
    const bf16* proj = (const bf16*)(P.ws + WS_PROJ); unsigned* act = (unsigned*)(P.ws + WS_ACT);
    for (int e = vcu * NTHR + ltid(); e < TT * 224; e += G * NTHR) { const int t = e / 224, cp = e - t * 224, cc = 2 * cp;
        const bf16* pr = proj + (size_t)t * INCP + C_RW + 3072 + cc;
        const unsigned cu = *(const unsigned*)pr; const unsigned pu = (t & (SEQ - 1)) == 0 ? 0u : *(const unsigned*)(pr - INCP);
        const float m0 = P.mu[3072 + cc], m1 = P.mu[3072 + cc + 1];
        float v0 = bflo(cu) + (bflo(pu) - bflo(cu)) * m0, v1 = bfhi(cu) + (bfhi(pu) - bfhi(cu)) * m1;
        if (cc < 96) { v0 = tanhf(v0); v1 = tanhf(v1); } else if (cc >= 192) { v0 = 1.f / (1.f + __expf(-v0)); v1 = 1.f / (1.f + __expf(-v1)); }
        act[e] = pk2(v0, v1); }
}
constexpr int ACTP = 456;
constexpr int L_WAG = 58368;
static_assert(L_WAG + 3 * 16384 <= L_MISC, "lora scratch fits below misc");
struct LoraFrags { bf16x8 f[16]; f32x4 w0[4], a0[4]; float mu_r, mu_k, mu_v, kkc, kac, rkc, lng, lnb; };
__device__ __forceinline__ LoraFrags lora_frags_load(KP P, int h, int wave, int lane) {
    const int c32 = lane & 31, hi = lane >> 5, nb = (wave & 3) >> 1; const int nrow = h * 64 + nb * 32 + c32;
    const bf16* w2T = (const bf16*)(P.ws + WS_LORA); const bf16* a2T = w2T + 1024 * 96; const bf16* g2T = a2T + 1024 * 96;
    const bf16* wp = w2T + (size_t)nrow * 96 + 8 * hi; const bf16* ap = a2T + (size_t)nrow * 96 + 8 * hi; const bf16* gp = g2T + (size_t)nrow * 256 + 8 * hi;
    LoraFrags W;
#pragma unroll
    for (int kk = 0; kk < 16; ++kk) { const bf16* src = wave < 4 ? (kk < 6 ? wp + 16 * kk : ap + 16 * ((kk - 6) % 6)) : gp + 16 * kk; W.f[kk] = *(const bf16x8*)src; }
#pragma unroll
    for (int g = 0; g < 4; ++g) { const int n0 = h * 64 + nb * 32 + 8 * g + 4 * hi; W.w0[g] = *(const f32x4*)(P.w0 + n0); W.a0[g] = *(const f32x4*)(P.a0 + n0); }
    const int col = h * 64 + lane;
    W.mu_r = P.mu[col]; W.mu_k = P.mu[1024 + col]; W.mu_v = P.mu[2048 + col]; W.kkc = P.k_k[col]; W.kac = P.k_a[col]; W.rkc = P.r_k[col]; W.lng = P.ln_g[col]; W.lnb = P.ln_b[col];
    return W;
}
__device__ __forceinline__ void rwkv_stage_a(KP P, LAS unsigned char* lds, int item, const LoraFrags& W) {
    const int tid = ltid(), lane = tid & 63, wave = __builtin_amdgcn_readfirstlane(tid >> 6);
    const int b = item >> 10, h = (item >> 6) & 15, c = item & 63;
    const int tok0 = b * SEQ + c * 64;
    const bf16* proj = (const bf16*)(P.ws + WS_PROJ);
    unsigned char* chk = P.ws + WS_CHK + (size_t)((item & 63) * 32 + (item >> 6)) * CHK_ITEM;
    LAS float* misc = (LAS float*)(lds + L_MISC);
    { const bf16* actg = (const bf16*)(P.ws + WS_ACT) + (size_t)tok0 * 448;
#pragma unroll
      for (int e = tid; e < 64 * 56; e += NTHR) { const int row = e / 56, ch = e - row * 56; *(LAS v4u*)(lds + (row * ACTP + ch * 8) * 2) = *(const v4u*)(actg + (size_t)row * 448 + ch * 8); } }
    __syncthreads();
    {
        const int c32 = lane & 31, hi = lane >> 5, qd = wave & 3, nb = qd >> 1, tb = qd & 1;
        const LAS unsigned char* actp = lds + ((tb * 32 + c32) * ACTP + 8 * hi) * 2;
        LAS float* wag = (LAS float*)(lds + L_WAG) + (tb * 32 + c32) * 64 + nb * 32;
        if (wave < 4) {
            f32x16 aw = {}, aa = {};
#pragma unroll
            for (int kk = 0; kk < 6; ++kk) {
                aw = __builtin_amdgcn_mfma_f32_32x32x16_bf16(W.f[kk], *(const LAS bf16x8*)(actp + (16 * kk) * 2), aw, 0, 0, 0);
                aa = __builtin_amdgcn_mfma_f32_32x32x16_bf16(W.f[6 + kk], *(const LAS bf16x8*)(actp + (96 + 16 * kk) * 2), aa, 0, 0, 0); }
#pragma unroll
            for (int g = 0; g < 4; ++g) { const int n0 = h * 64 + nb * 32 + 8 * g + 4 * hi;
                const f32x4 w0 = W.w0[g], a0 = W.a0[g]; f32x4 ow, oa;
#pragma unroll
                for (int e = 0; e < 4; ++e) { const float xx = w0[e] + aw[4 * g + e];
                    ow[e] = __expf(-0.6065306597126334f * __builtin_amdgcn_rcpf(1.f + __expf(-xx))); oa[e] = __builtin_amdgcn_rcpf(1.f + __expf(-(a0[e] + aa[4 * g + e]))); }
                *(LAS f32x4*)(wag + 8 * g + 4 * hi) = ow; *(LAS f32x4*)(wag + 4096 + 8 * g + 4 * hi) = oa; }
        } else {
            f32x16 ag = {};
#pragma unroll
            for (int kk = 0; kk < 16; ++kk) ag = __builtin_amdgcn_mfma_f32_32x32x16_bf16(W.f[kk], *(const LAS bf16x8*)(actp + (192 + 16 * kk) * 2), ag, 0, 0, 0);
#pragma unroll
            for (int g = 0; g < 4; ++g) *(LAS f32x4*)(wag + 8192 + 8 * g + 4 * hi) = (f32x4){ag[4 * g], ag[4 * g + 1], ag[4 * g + 2], ag[4 * g + 3]};
        }
    }
    __syncthreads();
    {
        const int n = lane, tg = wave, col = h * 64 + n;
        const float mu_r = W.mu_r, mu_k = W.mu_k, mu_v = W.mu_v, kkc = W.kkc, kac = W.kac, rkc = W.rkc, lng = W.lng, lnb = W.lnb;
        float rr[8], kr[8], vv[8], ww[8], aa[8], gg[8], kk[8];
        const int tfirst = tok0 + 8 * tg;
        const bf16* pp = proj + (size_t)tfirst * INCP + C_RW + col;
        float pr, pk, pvv;
        if (c == 0 && tg == 0) { pr = 0.f; pk = 0.f; pvv = 0.f; } else { pr = bf2f(pp[-(long)INCP]); pk = bf2f(pp[-(long)INCP + 1024]); pvv = bf2f(pp[-(long)INCP + 2048]); }
        const LAS float* wagr = (const LAS float*)(lds + L_WAG) + (8 * tg) * 64 + n;
#pragma unroll
        for (int q = 0; q < 8; ++q) { const float cr = bf2f(pp[(size_t)q * INCP]), ck = bf2f(pp[(size_t)q * INCP + 1024]), cv = bf2f(pp[(size_t)q * INCP + 2048]);
            rr[q] = cr + (pr - cr) * mu_r; kr[q] = ck + (pk - ck) * mu_k; vv[q] = cv + (pvv - cv) * mu_v; pr = cr; pk = ck; pvv = cv;
            ww[q] = wagr[q * 64]; aa[q] = wagr[4096 + q * 64]; gg[q] = wagr[8192 + q * 64]; }
        float lam[8]; float run = 1.f;
#pragma unroll
        for (int q = 0; q < 8; ++q) { run *= ww[q]; lam[q] = run; }
        misc[tg * 64 + n] = run;
#pragma unroll
        for (int q = 0; q < 8; ++q) { const float kkv = kr[q] * kkc; const float ss = wave_sum(kkv * kkv); kk[q] = kkv * __builtin_amdgcn_rsqf(fmaxf(ss, 1e-24f));
            kr[q] = kr[q] * (1.f + (aa[q] - 1.f) * kac); }
        __syncthreads();
        float pre = 1.f, tot = 1.f;
#pragma unroll
        for (int g = 0; g < 8; ++g) { const float sgt = misc[g * 64 + n]; if (g < tg) pre *= sgt; tot *= sgt; }
        if (tg == 0) misc[512 + n] = tot;
        unsigned vt[4], bbt[4], kbt[4];
        LAS bf16* At = (LAS bf16*)(lds + M_AT * MATB); LAS bf16* Bt = (LAS bf16*)(lds + M_BT * MATB); LAS bf16* Kt = (LAS bf16*)(lds + M_KT * MATB); LAS bf16* Rt = (LAS bf16*)(lds + M_RT * MATB);
        float hbb = 0.f, hkb = 0.f, hv = 0.f;
#pragma unroll
        for (int q = 0; q < 8; ++q) { const int t = 8 * tg + q;
            const float L = pre * lam[q], Lp = q == 0 ? pre : pre * lam[q - 1], iL = __builtin_amdgcn_rcpf(L), rel = tot * iL;
            const float bq = kk[q] * aa[q];
            ((LAS float*)(lds + L_RHS))[t * 128 + 64 + n] = -kk[q] * Lp;
            At[t * CP + n] = (bf16)f2bf(-kk[q] * Lp); Bt[t * CP + n] = (bf16)f2bf(bq * iL); Kt[t * CP + n] = (bf16)f2bf(kr[q] * iL); Rt[t * CP + n] = (bf16)f2bf(rr[q] * L);
            const float bb = bq * rel, kb = kr[q] * rel;
            if (q & 1) { vt[q >> 1] = pk2(hv, vv[q]); bbt[q >> 1] = pk2(hbb, bb); kbt[q >> 1] = pk2(hkb, kb); } else { hv = vv[q]; hbb = bb; hkb = kb; }
            const float bs = wave_sum(rr[q] * kr[q] * rkc);
            const int pl = t * 64 + ((n >> 2) & 3) * 16 + (n >> 4) * 4 + (n & 3);
            ((bf16*)(chk + 4 * 8192))[pl] = (bf16)f2bf(lng * gg[q]);
            ((bf16*)(chk + 5 * 8192))[pl] = (bf16)f2bf((lnb + bs * vv[q]) * gg[q]); }
        *(LAS v4u*)(lds + M_VT * MATB + (n * CP + 8 * tg) * 2) = (v4u){vt[0], vt[1], vt[2], vt[3]};
        *(LAS v4u*)(lds + M_BBT * MATB + (n * CP + 8 * tg) * 2) = (v4u){bbt[0], bbt[1], bbt[2], bbt[3]};
        *(LAS v4u*)(lds + M_KBT * MATB + (n * CP + 8 * tg) * 2) = (v4u){kbt[0], kbt[1], kbt[2], kbt[3]};
    }
    __syncthreads();
    const int c32 = lane & 31, hi = lane >> 5;
    {
        const int prod = wave >> 1;
#pragma unroll
        for (int qi = 0; qi < 2; ++qi) {
            const int tb = (wave & 1) ? (qi == 0 ? 1 : 0) : qi, sb = (wave & 1) ? 1 : 0; const bool zero = (tb == 0 && sb == 1);
            f32x16 acc = {};
            const int xa = (prod == 0 || prod == 2) ? M_BT : M_KT, ya = prod < 2 ? M_AT : M_RT, dm = prod == 0 ? M_LAB : (prod == 1 ? M_LAK : (prod == 2 ? M_MRB : M_MRK));
            if (!zero) acc = mm_tile(lds + xa * MATB, sb, lds + ya * MATB, tb, acc, lane);
            const int t = tb * 32 + c32; LAS unsigned char* dst = lds + dm * MATB + (t * CP + sb * 32) * 2;
#pragma unroll
            for (int g = 0; g < 4; ++g) { float o[4];
#pragma unroll
                for (int e = 0; e < 4; ++e) { const int s = sb * 32 + 8 * g + 4 * hi + e; const bool keep = prod < 2 ? (s < t) : (s <= t); o[e] = keep ? acc[4 * g + e] : 0.f; }
                *(LAS v2u*)(dst + (8 * g + 4 * hi) * 2) = (v2u){pk2(o[0], o[1]), pk2(o[2], o[3])}; }
        }
    }
    __syncthreads();
    if (wave < 4) {
        const int ib = wave >> 1, tb = wave & 1; f32x16 acc = {};
        acc = mm_tile(lds + M_VT * MATB, ib, lds + M_LAK * MATB, tb, acc, lane, 0, tb == 0 ? 2 : 4);
        const int t = tb * 32 + c32; LAS float* dst = (LAS float*)(lds + L_RHS) + t * 128 + ib * 32;
#pragma unroll
        for (int g = 0; g < 4; ++g) *(LAS f32x4*)(dst + 8 * g + 4 * hi) = (f32x4){acc[4 * g], acc[4 * g + 1], acc[4 * g + 2], acc[4 * g + 3]};
    } else if (wave == 4) {
        const int bb = lane >> 4, col = lane & 15;
        float x[16];
#pragma unroll
        for (int t = 0; t < 16; ++t) x[t] = t == col ? 1.f : 0.f;
#pragma unroll
        for (int t = 1; t < 16; ++t) { const LAS unsigned char* rp = lds + M_LAB * MATB + ((16 * bb + t) * CP + 16 * bb) * 2; const v4u ra = *(const LAS v4u*)rp, rb = *(const LAS v4u*)(rp + 16);
            float lrow[16];
#pragma unroll
            for (int q = 0; q < 4; ++q) { lrow[2 * q] = bflo(ra[q]); lrow[2 * q + 1] = bfhi(ra[q]); lrow[8 + 2 * q] = bflo(rb[q]); lrow[8 + 2 * q + 1] = bfhi(rb[q]); }
#pragma unroll
            for (int s = 0; s < t; ++s) x[t] += lrow[s] * x[s]; }
        LAS bf16* T = (LAS bf16*)(lds + L_TB) + bb * 256 + col;
#pragma unroll
        for (int t = 0; t < 16; ++t) T[t * 16] = (bf16)f2bf(x[t]);
    }
    __syncthreads();
    {
        typedef short s16x4 __attribute__((ext_vector_type(4)));
        const int l15 = lane & 15, q4 = lane >> 4;
        LAS unsigned char* xt = lds + (wave < 4 ? M_U0T : M_AHT) * MATB + ((16 * (wave & 3) + l15) * CP) * 2;
        *(LAS v4u*)(xt + q4 * 32) = (v4u){0u, 0u, 0u, 0u}; *(LAS v4u*)(xt + q4 * 32 + 16) = (v4u){0u, 0u, 0u, 0u};
        const LAS float* Xf = (const LAS float*)(lds + L_RHS) + 16 * wave + l15;
#pragma unroll
        for (int bq = 0; bq < 4; ++bq) {
            f32x4 acc;
#pragma unroll
            for (int e = 0; e < 4; ++e) acc[e] = Xf[(16 * bq + 4 * q4 + e) * 128];
#pragma unroll
            for (int kk = 0; kk < (bq + 1) / 2; ++kk) {
                const bf16x8 a = *(const LAS bf16x8*)(lds + M_LAB * MATB + ((16 * bq + l15) * CP + 32 * kk + 8 * q4) * 2);
                const bf16x8 xb = *(const LAS bf16x8*)(xt + (32 * kk + 8 * q4) * 2);
                acc = __builtin_amdgcn_mfma_f32_16x16x32_bf16(a, xb, acc, 0, 0, 0); }
            const v2u tf = *(const LAS v2u*)(lds + L_TB + (bq * 256 + l15 * 16 + 4 * q4) * 2);
            const v2u ab = (v2u){pk2(acc[0], acc[1]), pk2(acc[2], acc[3])};
            const f32x4 z = {0.f, 0.f, 0.f, 0.f};
            const f32x4 xn = __builtin_amdgcn_mfma_f32_16x16x16bf16_1k(__builtin_bit_cast(s16x4, tf), __builtin_bit_cast(s16x4, ab), z, 0, 0, 0);
            *(LAS v2u*)(xt + (16 * bq + 4 * q4) * 2) = (v2u){pk2(xn[0], xn[1]), pk2(xn[2], xn[3])};
        }
    }
    __syncthreads();
    {
        const int qd = wave & 3, yb = qd >> 1, xb = qd & 1;
        f32x16 acc1 = {}, acc2 = {};
        if (wave < 4) {
            acc1 = mm_tile(lds + M_AHT * MATB, yb, lds + M_BBT * MATB, xb, acc1, lane);
            acc2 = mm_tile(lds + M_BBT * MATB, yb, lds + M_U0T * MATB, xb, acc2, lane);
            acc2 = mm_tile(lds + M_KBT * MATB, yb, lds + M_VT * MATB, xb, acc2, lane);
            const int x = xb * 32 + c32; const float lc = misc[512 + x];
            bf16* o1 = (bf16*)(chk + 0 * 8192) + x * 64 + yb * 32; bf16* o2 = (bf16*)(chk + 1 * 8192) + x * 64 + yb * 32;
#pragma unroll
            for (int g = 0; g < 4; ++g) { float p[4];
#pragma unroll
                for (int e = 0; e < 4; ++e) { const int y = yb * 32 + 8 * g + 4 * hi + e; p[e] = acc1[4 * g + e] + (y == x ? lc : 0.f); }
                *(v2u*)(o1 + 8 * g + 4 * hi) = (v2u){pk2(p[0], p[1]), pk2(p[2], p[3])};
                *(v2u*)(o2 + 8 * g + 4 * hi) = (v2u){pk2(acc2[4 * g], acc2[4 * g + 1]), pk2(acc2[4 * g + 2], acc2[4 * g + 3])}; }
        } else {
            acc1 = mm_tile(lds + M_AHT * MATB, yb, lds + M_MRB * MATB, xb, acc1, lane);
            acc2 = mm_tile(lds + M_U0T * MATB, yb, lds + M_MRB * MATB, xb, acc2, lane);
            acc2 = mm_tile(lds + M_VT * MATB, yb, lds + M_MRK * MATB, xb, acc2, lane);
            const int x = xb * 32 + c32;
            bf16* o1 = (bf16*)(chk + 2 * 8192) + x * 64 + yb * 32; bf16* o2 = (bf16*)(chk + 3 * 8192) + x * 64;
            const LAS bf16* Rt = (const LAS bf16*)(lds + M_RT * MATB) + x * CP + yb * 32;
#pragma unroll
            for (int g = 0; g < 4; ++g) { float p[4];
#pragma unroll
                for (int e = 0; e < 4; ++e) p[e] = acc1[4 * g + e] + bf2f(Rt[8 * g + 4 * hi + e]);
                *(v2u*)(o1 + 8 * g + 4 * hi) = (v2u){pk2(p[0], p[1]), pk2(p[2], p[3])};
                *(v2u*)(o2 + ((2 * g + hi) & 3) * 16 + (2 * yb + (g >> 1)) * 4) = (v2u){pk2(acc2[4 * g], acc2[4 * g + 1]), pk2(acc2[4 * g + 2], acc2[4 * g + 3])}; }
        }
    }
    __syncthreads();
}

__device__ __forceinline__ void phase_rwkv_stage_a(KP P, LAS unsigned char* lds, int vcu, int G) {
    const int tid = ltid(), lane = tid & 63, wave = __builtin_amdgcn_readfirstlane(tid >> 6);
    int cur_bh = (vcu & 255) >> 3; LoraFrags W = lora_frags_load(P, cur_bh & 15, wave, lane);
    for (int k = vcu; k < 2048; k += G) { const int bh = (k & 255) >> 3, c = (k & 7) + 8 * (k >> 8);
        if (bh != cur_bh) { W = lora_frags_load(P, bh & 15, wave, lane); cur_bh = bh; }
        rwkv_stage_a(P, lds, bh * 64 + c, W); }
}
typedef float f32x4v __attribute__((ext_vector_type(4)));
struct YSet { bf16x8 b0, b1; v4u y0[2], g1[2], g2[2]; };
struct SSet { bf16x8 p0[1], p1[1]; v2u q[4]; };
__device__ __forceinline__ void rwkv_stage_b(KP P, LAS unsigned char* lds, int bh) {
    const int tid = ltid(), lane = tid & 63, wave = __builtin_amdgcn_readfirstlane(tid >> 6);
    const int b = bh >> 4, h = bh & 15; const int l15 = lane & 15, q4 = lane >> 4;
    bf16* AR = (bf16*)(P.ws + WS_AR);
    for (int u = tid; u < 2 * MATB / 4; u += NTHR) ((LAS unsigned*)lds)[u] = 0u;
    __syncthreads();
    const int w4 = wave & 3;
    const unsigned char* chk0 = P.ws + WS_CHK + (size_t)bh * CHK_ITEM;
    if (wave < 4) {
        const int t = 16 * w4 + l15;
        YSet ys[4];
#define YLOAD(S_, c_) do { const unsigned char* chk = chk0 + (size_t)(c_) * (32 * CHK_ITEM); const bf16* rh = (const bf16*)(chk + 2 * 8192) + t * 64 + 8 * q4; S_.b0 = *(const bf16x8*)rh; S_.b1 = *(const bf16x8*)(rh + 32); \
        const bf16* y0 = (const bf16*)(chk + 3 * 8192) + t * 64 + 16 * q4; \
        S_.y0[0] = *(const v4u*)y0; S_.y0[1] = *(const v4u*)(y0 + 8); S_.g1[0] = *(const v4u*)(y0 + 4096); S_.g1[1] = *(const v4u*)(y0 + 4096 + 8); S_.g2[0] = *(const v4u*)(y0 + 8192); S_.g2[1] = *(const v4u*)(y0 + 8192 + 8); } while (0)
#define YV(A_, it_, w_) ((A_)[(it_) >> 1][2 * ((it_) & 1) + (w_)])
#pragma unroll
        for (int u = 0; u < 4; ++u) YLOAD(ys[u], u);
        for (int c0 = 0; c0 < 64; c0 += 4) {
#pragma unroll
            for (int u = 0; u < 4; ++u) { const int c = c0 + u;
                const LAS unsigned char* Scur = lds + (c & 1) * MATB;
                f32x4v acc[4];
#pragma unroll
                for (int it = 0; it < 4; ++it) { acc[it] = (f32x4v){bflo(YV(ys[u].y0, it, 0)), bfhi(YV(ys[u].y0, it, 0)), bflo(YV(ys[u].y0, it, 1)), bfhi(YV(ys[u].y0, it, 1))};
                    const LAS unsigned char* sp = Scur + ((16 * it + l15) * CP + 8 * q4) * 2;
                    acc[it] = __builtin_amdgcn_mfma_f32_16x16x32_bf16(*(const LAS bf16x8*)sp, ys[u].b0, acc[it], 0, 0, 0);
                    acc[it] = __builtin_amdgcn_mfma_f32_16x16x32_bf16(*(const LAS bf16x8*)(sp + 64), ys[u].b1, acc[it], 0, 0, 0); }
                float s = 0.f;
#pragma unroll
                for (int it = 0; it < 4; ++it) s += (acc[it].x + acc[it].y) + (acc[it].z + acc[it].w);
                s += __shfl_xor(s, 16); s += __shfl_xor(s, 32);
                const float mean = s * (1.f / 64.f); float v = 0.f;
#pragma unroll
                for (int it = 0; it < 4; ++it) { acc[it] = acc[it] - mean; v += (acc[it].x * acc[it].x + acc[it].y * acc[it].y) + (acc[it].z * acc[it].z + acc[it].w * acc[it].w); }
                v += __shfl_xor(v, 16); v += __shfl_xor(v, 32);
                const float rstd = 1.0f / sqrtf(v * (1.f / 64.f) + 64e-5f);
                bf16* orow = AR + (size_t)(b * SEQ + c * 64 + t) * DM + 1024 + h * 64 + 4 * q4;
#pragma unroll
                for (int it = 0; it < 4; ++it) {
                    const float o0 = acc[it].x * rstd * bflo(YV(ys[u].g1, it, 0)) + bflo(YV(ys[u].g2, it, 0)), o1 = acc[it].y * rstd * bfhi(YV(ys[u].g1, it, 0)) + bfhi(YV(ys[u].g2, it, 0));
                    const float o2 = acc[it].z * rstd * bflo(YV(ys[u].g1, it, 1)) + bflo(YV(ys[u].g2, it, 1)), o3 = acc[it].w * rstd * bfhi(YV(ys[u].g1, it, 1)) + bfhi(YV(ys[u].g2, it, 1));
                    *(v2u*)(orow + 16 * it) = (v2u){pk2(o0, o1), pk2(o2, o3)}; }
                if (c + 4 < 64) YLOAD(ys[u], c + 4);
                __syncthreads();
            }
        }
#undef YLOAD
#undef YV
    } else {
        const int nrow = 16 * w4 + l15;
        SSet ss[4];
#define SLOADX(S_, c_) do { const unsigned char* chk = chk0 + (size_t)(c_) * (32 * CHK_ITEM); const bf16* pt = (const bf16*)chk + nrow * 64 + 8 * q4; S_.p0[0] = *(const bf16x8*)pt; S_.p1[0] = *(const bf16x8*)(pt + 32); \
        const bf16* q = (const bf16*)(chk + 1 * 8192) + l15 * 64 + 16 * w4 + 4 * q4; \
        _Pragma("unroll") for (int it = 0; it < 4; ++it) S_.q[it] = *(const v2u*)(q + 16 * it * 64); } while (0)
#pragma unroll
        for (int u = 0; u < 4; ++u) SLOADX(ss[u], u);
        for (int c0 = 0; c0 < 64; c0 += 4) {
#pragma unroll
            for (int u = 0; u < 4; ++u) { const int c = c0 + u;
                const LAS unsigned char* Scur = lds + (c & 1) * MATB; LAS unsigned char* Snxt = lds + ((c & 1) ^ 1) * MATB;
#pragma unroll
                for (int it = 0; it < 4; ++it) { const int i = 16 * it + l15;
                    const LAS unsigned char* sp = Scur + (i * CP + 8 * q4) * 2; const bf16x8 s0 = *(const LAS bf16x8*)sp, s1 = *(const LAS bf16x8*)(sp + 64);
                    f32x4v acc = (f32x4v){bflo(ss[u].q[it].x), bfhi(ss[u].q[it].x), bflo(ss[u].q[it].y), bfhi(ss[u].q[it].y)};
                    acc = __builtin_amdgcn_mfma_f32_16x16x32_bf16(ss[u].p0[0], s0, acc, 0, 0, 0);
                    acc = __builtin_amdgcn_mfma_f32_16x16x32_bf16(ss[u].p1[0], s1, acc, 0, 0, 0);
                    *(LAS v2u*)(Snxt + (i * CP + 16 * w4 + 4 * q4) * 2) = (v2u){pk2(acc.x, acc.y), pk2(acc.z, acc.w)}; }
                if (c + 4 < 64) SLOADX(ss[u], c + 4);
                __syncthreads();
            }
        }
#undef SLOADX
    }
}

constexpr size_t WS_UB = WS_RWA;
constexpr size_t WS_VB = WS_RWA + 32 * MiB;
constexpr float U_SCALE = 512.f, V_SCALE = 32.f;
constexpr int SLICE_BYTES = 16384 * 128;
typedef float f32x2 __attribute__((ext_vector_type(2)));
__device__ __forceinline__ void phase_convert_tables(KP P, LAS unsigned char* lds) {
    const int tid = ltid(); constexpr int N16 = 16384 * 2048 / 16, GPT = 4, CH = GPT * NTHR, NCH = 2 * N16 / CH;
    unsigned* ctr = (unsigned*)(P.ws + WS_CTL) + CW_MOBA_CTR; LAS int* slot = (LAS int*)lds;
    const int q = tid & 127;
    f32x4 gu[4];
#pragma unroll
    for (int m = 0; m < 4; ++m) gu[m] = *(const f32x4*)(P.norm2_g + 16 * q + 4 * m) * U_SCALE;
    __syncthreads();
    if (tid == 0) slot[0] = (int)__hip_atomic_fetch_add(ctr, 1u, __ATOMIC_RELAXED, __HIP_MEMORY_SCOPE_AGENT);
    __syncthreads();
    for (int it = 0;; ++it) {
        const int c = slot[it & 1]; if (c >= NCH) break;
        if (tid == 0) slot[(it & 1) ^ 1] = (int)__hip_atomic_fetch_add(ctr, 1u, __ATOMIC_RELAXED, __HIP_MEMORY_SCOPE_AGENT);
        const bool isv = c >= NCH / 2;
        const int j0 = (isv ? c - NCH / 2 : c) * CH + tid;
        const float* src = (isv ? P.pv : P.pu) + (size_t)j0 * 16;
        unsigned char* dst = P.ws + (isv ? WS_VB : WS_UB) + (size_t)(q >> 3) * SLICE_BYTES + (size_t)(j0 >> 7) * 128 + (q & 7) * 16;
        f32x4 sc[4];
#pragma unroll
        for (int m = 0; m < 4; ++m) sc[m] = isv ? (f32x4){V_SCALE, V_SCALE, V_SCALE, V_SCALE} : gu[m];
#pragma unroll
        for (int hb = 0; hb < 1; ++hb) {
            f32x4 a[4][4];
#pragma unroll
            for (int k = 0; k < 4; ++k)
#pragma unroll
                for (int m = 0; m < 4; ++m) a[k][m] = *(const f32x4*)(src + (size_t)(4 * hb + k) * (NTHR * 16) + 4 * m);
#pragma unroll
            for (int k = 0; k < 4; ++k) { v4u o;
#pragma unroll
                for (int m = 0; m < 4; ++m) { const f32x4 v = a[k][m] * sc[m]; int p = 0;
                    p = __builtin_amdgcn_cvt_pk_fp8_f32(v.x, v.y, p, false); p = __builtin_amdgcn_cvt_pk_fp8_f32(v.z, v.w, p, true); o[m] = (unsigned)p; }
                *(v4u*)(dst + (size_t)(4 * hb + k) * 512) = o; }
        }
        __syncthreads();
    }
}
__device__ __forceinline__ f32x2 dot16p(const v4u u, const f32x2* x, f32x2 acc) {
#pragma unroll
    for (int q = 0; q < 4; ++q) { const f32x2 lo = __builtin_amdgcn_cvt_pk_f32_fp8((int)u[q], false), hi = __builtin_amdgcn_cvt_pk_f32_fp8((int)u[q], true);
        acc = __builtin_elementwise_fma(lo, x[2 * q], acc); acc = __builtin_elementwise_fma(hi, x[2 * q + 1], acc); }
    return acc;
}
__device__ __forceinline__ void axpy16p(const v4u v, f32x2 s, f32x2* y) {
#pragma unroll
    for (int q = 0; q < 4; ++q) { const f32x2 lo = __builtin_amdgcn_cvt_pk_f32_fp8((int)v[q], false), hi = __builtin_amdgcn_cvt_pk_f32_fp8((int)v[q], true);
        y[2 * q] = __builtin_elementwise_fma(s, lo, y[2 * q]); y[2 * q + 1] = __builtin_elementwise_fma(s, hi, y[2 * q + 1]); }
}
__device__ __forceinline__ float xsum_g8(float v) {
    v += DPP_F(v, 0x128);
    { auto r = __builtin_amdgcn_permlane16_swap(__float_as_uint(v), __float_as_uint(v), false, false); v = __uint_as_float(r[0]) + __uint_as_float(r[1]); }
    { auto r = __builtin_amdgcn_permlane32_swap(__float_as_uint(v), __float_as_uint(v), false, false); v = __uint_as_float(r[0]) + __uint_as_float(r[1]); }
    return v;
}
__device__ __forceinline__ void phase_peer_sliced(KP P, LAS unsigned char* lds, int bx, int G) {
    const int grp = bx & 7;
    const unsigned char* UB = P.ws + WS_UB; const unsigned char* VB = P.ws + WS_VB; const bf16* HB = (const bf16*)(P.ws + WS_XN);
    const int* ridx = (const int*)(P.ws + WS_PROJ + 64 * MiB); const float* rgate = (const float*)(P.ws + WS_PROJ + 68 * MiB); const float* RSTD = (const float*)(P.ws + WS_SSP + 2 * MiB);
    for (int bt = bx; bt < TT / 32; bt += G) {
        const int tid = ltid(), lane = tid & 63, wave = __builtin_amdgcn_readfirstlane(tid >> 6), g8 = lane >> 3, p = lane & 7;
        LAS int* idxT = (LAS int*)(lds + wave * 4096); LAS float* gT = (LAS float*)(lds + wave * 4096 + 2048);
        LAS bf16* h2T = (LAS bf16*)(lds + 32768 + wave * 16384);
        const int t0 = 32 * bt + 4 * wave;
#pragma unroll
        for (int i = 0; i < 4; ++i) { const size_t o = (size_t)(t0 + i) * 128; const int wofs = (i * 8 + (lane & 7)) * 16 + (lane >> 3);
            idxT[wofs] = ridx[o + lane]; idxT[wofs + 8] = ridx[o + 64 + lane]; gT[wofs] = rgate[o + lane]; gT[wofs + 8] = rgate[o + 64 + lane]; }
        float hacc[4][2];
#pragma unroll
        for (int i = 0; i < 4; ++i) { hacc[i][0] = 0.f; hacc[i][1] = 0.f; }
        {
            v4u rA[8], rB[8]; f32x2 xA[8], xB[8];
#define PS_SG(s_) (((s_) + 2 * grp) & 15)
#define PS_ISSUE(R, tabbase, s_, i_, hb_) do { const unsigned char* tb_ = (tabbase) + (size_t)PS_SG(s_) * SLICE_BYTES;        \
            const v4u ia_ = *(const LAS v4u*)(idxT + ((i_) * 8 + g8) * 16 + 8 * (hb_)), ib_ = *(const LAS v4u*)(idxT + ((i_) * 8 + g8) * 16 + 8 * (hb_) + 4); const unsigned po_ = 16u * (unsigned)p; \
            R[0] = *(const v4u*)(tb_ + (ia_[0] * 128u + po_)); R[1] = *(const v4u*)(tb_ + (ia_[1] * 128u + po_)); R[2] = *(const v4u*)(tb_ + (ia_[2] * 128u + po_)); R[3] = *(const v4u*)(tb_ + (ia_[3] * 128u + po_)); \
            R[4] = *(const v4u*)(tb_ + (ib_[0] * 128u + po_)); R[5] = *(const v4u*)(tb_ + (ib_[1] * 128u + po_)); R[6] = *(const v4u*)(tb_ + (ib_[2] * 128u + po_)); R[7] = *(const v4u*)(tb_ + (ib_[3] * 128u + po_)); } while (0)
#define PS_LOADX(X, s_, i_) do { const bf16* xp_ = HB + (size_t)(t0 + (i_)) * DM + 128 * PS_SG(s_) + 16 * p; const v4u xa_ = *(const v4u*)xp_, xb_ = *(const v4u*)(xp_ + 8); \
            _Pragma("unroll") for (int q = 0; q < 4; ++q) { X[q] = (f32x2){bflo(xa_[q]), bfhi(xa_[q])}; X[4 + q] = (f32x2){bflo(xb_[q]), bfhi(xb_[q])}; } } while (0)
#define PS_DOTS(R, X, i_, hb_) do { _Pragma("unroll") for (int m = 0; m < 8; ++m) { const f32x2 a2_ = dot16p(R[m], X, (f32x2){0.f, 0.f}); float sd_ = a2_.x + a2_.y; \
            sd_ += DPP_F(sd_, 0xB1); sd_ += DPP_F(sd_, 0x4E); sd_ += DPP_F(sd_, 0x141); if (p == m) hacc[i_][hb_] += sd_; } asm volatile("" ::: "memory"); } while (0)
            PS_LOADX(xA, 0, 0); PS_ISSUE(rA, UB, 0, 0, 0);
            for (int s = 0; s < 16; ++s) {
                PS_ISSUE(rB, UB, s, 0, 1); PS_LOADX(xB, s, 1);  PS_DOTS(rA, xA, 0, 0);
                PS_ISSUE(rA, UB, s, 1, 0);                       PS_DOTS(rB, xA, 0, 1);
                PS_ISSUE(rB, UB, s, 1, 1); PS_LOADX(xA, s, 2);  PS_DOTS(rA, xB, 1, 0);
                PS_ISSUE(rA, UB, s, 2, 0);                       PS_DOTS(rB, xB, 1, 1);
                PS_ISSUE(rB, UB, s, 2, 1); PS_LOADX(xB, s, 3);  PS_DOTS(rA, xA, 2, 0);
                PS_ISSUE(rA, UB, s, 3, 0);                       PS_DOTS(rB, xA, 2, 1);
                PS_ISSUE(rB, UB, s, 3, 1); if (s + 1 < 16) PS_LOADX(xA, s + 1, 0);  PS_DOTS(rA, xB, 3, 0);
                if (s + 1 < 16) PS_ISSUE(rA, UB, s + 1, 0, 0);  PS_DOTS(rB, xB, 3, 1);
            }
#undef PS_LOADX
#undef PS_DOTS
        }
#pragma unroll
        for (int i = 0; i < 4; ++i) { const float rsn = RSTD[t0 + i] * (1.f / U_SCALE);
#pragma unroll
            for (int hb = 0; hb < 2; ++hb) { const float hp = hacc[i][hb] * rsn; LAS float* gp = gT + (i * 8 + g8) * 16 + 8 * hb + p;
                *gp = 0.5f * hp * (1.f + erff(hp * 0.70710678118654752f)) * (1.f / V_SCALE) * *gp; } }
        float ssq[4] = {0.f, 0.f, 0.f, 0.f};
        {
            v4u rA[8], rB[8]; f32x2 y2[8];
#define PS_AXPY(R, i_, hb_) do { const f32x4 aa_ = *(const LAS f32x4*)(gT + ((i_) * 8 + g8) * 16 + 8 * (hb_)), ab_ = *(const LAS f32x4*)(gT + ((i_) * 8 + g8) * 16 + 8 * (hb_) + 4); \
            if ((hb_) == 0) { _Pragma("unroll") for (int q = 0; q < 8; ++q) y2[q] = (f32x2){0.f, 0.f}; } \
            _Pragma("unroll") for (int m = 0; m < 8; ++m) { const float av_ = m < 4 ? aa_[m & 3] : ab_[m & 3]; axpy16p(R[m], (f32x2){av_, av_}, y2); } asm volatile("" ::: "memory"); } while (0)
#define PS_FIN(s_, i_) do { f32x2 ysel_ = {0.f, 0.f}; _Pragma("unroll") for (int q = 0; q < 8; ++q) { const float a_ = xsum_g8(y2[q].x), b_ = xsum_g8(y2[q].y); if (g8 == q) ysel_ = (f32x2){a_, b_}; } \
            const int d_ = 128 * PS_SG(s_) + 16 * p + 2 * g8; const unsigned hb_ = *(const unsigned*)(HB + (size_t)(t0 + (i_)) * DM + d_); const f32x2 hv_ = (f32x2){bflo(hb_), bfhi(hb_)} + ysel_; \
            *(LAS unsigned*)(h2T + (i_) * DM + d_) = pk2(hv_.x, hv_.y); ssq[i_] += hv_.x * hv_.x + hv_.y * hv_.y; } while (0)
            PS_ISSUE(rA, VB, 0, 0, 0);
            for (int s = 0; s < 16; ++s) {
                PS_ISSUE(rB, VB, s, 0, 1); PS_AXPY(rA, 0, 0);
                PS_ISSUE(rA, VB, s, 1, 0); PS_AXPY(rB, 0, 1); PS_FIN(s, 0);
                PS_ISSUE(rB, VB, s, 1, 1); PS_AXPY(rA, 1, 0);
                PS_ISSUE(rA, VB, s, 2, 0); PS_AXPY(rB, 1, 1); PS_FIN(s, 1);
                PS_ISSUE(rB, VB, s, 2, 1); PS_AXPY(rA, 2, 0);
                PS_ISSUE(rA, VB, s, 3, 0); PS_AXPY(rB, 2, 1); PS_FIN(s, 2);
                PS_ISSUE(rB, VB, s, 3, 1); PS_AXPY(rA, 3, 0);
                if (s + 1 < 16) PS_ISSUE(rA, VB, s + 1, 0, 0); PS_AXPY(rB, 3, 1); PS_FIN(s, 3);
            }
#undef PS_AXPY
#undef PS_FIN
#undef PS_ISSUE
#undef PS_SG
        }
        { f32x4 fg[8];
#pragma unroll
          for (int j = 0; j < 8; ++j) fg[j] = *(const f32x4*)(P.final_g + 4 * lane + 256 * j);
#pragma unroll
          for (int i = 0; i < 4; ++i) { const float rs2 = 1.0f / sqrtf(wave_sum(ssq[i]) * (1.f / DM) + RMS_EPS);
#pragma unroll
            for (int j = 0; j < 8; ++j) { const v2u hv = *(const LAS v2u*)(h2T + i * DM + 4 * lane + 256 * j);
                *(f32x4*)(P.out + (size_t)(t0 + i) * DM + 4 * lane + 256 * j) = (f32x4){bflo(hv.x) * rs2 * fg[j].x, bfhi(hv.x) * rs2 * fg[j].y, bflo(hv.y) * rs2 * fg[j].z, bfhi(hv.y) * rs2 * fg[j].w}; } } }
        asm volatile("" ::: "memory");
    }
}
namespace moba {
constexpr float SCALE = 0.08838834764831845f;
constexpr float THR = 8.f;
constexpr bool WSKIP = false;
constexpr int D = 128, NW = 8, QBLK = 32, KVBLK = 64, QB = NW * QBLK;
constexpr int SHM_V = KVBLK * D * 2, SHM_K = KVBLK * D * 2;
constexpr int ATT_LDS_BYTES = 2 * SHM_V + 2 * SHM_K + NW * 64 * 4;
constexpr int KPITCH = INCP, QPITCH = INCP, OPITCH = DM;
typedef unsigned short bf16;
typedef short bf16x8 __attribute__((ext_vector_type(8)));
typedef short s16x4 __attribute__((ext_vector_type(4)));
typedef float f32x16 __attribute__((ext_vector_type(16)));
typedef float f32x4 __attribute__((ext_vector_type(4)));
typedef unsigned u32x4 __attribute__((ext_vector_type(4)));
template <class A, class Bt> struct same_t { static constexpr bool v = false; };
template <class A> struct same_t<A, A> { static constexpr bool v = true; };
#define KSWZ(row, colB) ((row) * 256 + ((colB) ^ (((row) & 7) << 4)))
#define SBAR() __builtin_amdgcn_sched_barrier(0)
__device__ __forceinline__ int v_st(int k, int c) { const int kk = (k & ~0xC) | ((k & 4) << 1) | ((k & 8) >> 1); return ((kk >> 3) * 4 + (c >> 5)) * 512 + ((kk & 7) * 32 + (c & 31)) * 2; }
__device__ __forceinline__ int v_rd_base(int lane) { return ((lane & 3) << 3) | (((lane >> 2) & 3) << 6) | (((lane >> 4) & 1) << 5) | (((lane >> 5) & 1) << 8); }
constexpr int v_rd_off(int d0, int ks, int half) { return d0 * 512 + ks * 4096 + half * 2048; }
__device__ __forceinline__ int crow(int r, int hi) { return (r & 3) + 8 * (r >> 2) + 4 * hi; }
__device__ __forceinline__ unsigned cvtpk(float lo, float hi) {
    unsigned r; asm volatile("v_cvt_pk_bf16_f32 %0, %1, %2" : "=v"(r) : "v"(lo), "v"(hi)); return r;
}
__device__ __forceinline__ bf16x8 pack8(f32x4 a, f32x4 b) {
    u32x4 w = {cvtpk(a[0], a[1]), cvtpk(a[2], a[3]), cvtpk(b[0], b[1]), cvtpk(b[2], b[3])};
    return *reinterpret_cast<bf16x8*>(&w);
}
template <class T> __device__ __forceinline__ bf16x8 load8(const T* p) {
    if constexpr (same_t<T, float>::v) { return pack8(*(const f32x4*)p, *(const f32x4*)(p + 4)); }
    else { return *reinterpret_cast<const bf16x8*>(p); }
}
__device__ __forceinline__ void mask_tile(f32x16& p0, f32x16& p1, int dq, unsigned W) {
    const float NEG = -__builtin_inff();
#pragma unroll
    for (int r = 0; r < 16; ++r) {
        const int c = (r & 3) + 8 * (r >> 2);
        if ((unsigned)(dq - c) >= W) p0[r] = NEG;
        if ((unsigned)(dq - c - 32) >= W) p1[r] = NEG;
    }
}
__device__ __forceinline__ void partialSM(f32x16& p0, f32x16& p1, float& m_reg, float& mn, float& alpha, float base0, float base1) {
    float pm0 = p0[0]; for (int r = 1; r < 16; ++r) pm0 = fmaxf(pm0, p0[r]); float pm1 = p1[0]; for (int r = 1; r < 16; ++r) pm1 = fmaxf(pm1, p1[r]);
    float pmax = fmaxf(pm0 + base0, pm1 + base1);
    { auto rr = __builtin_amdgcn_permlane32_swap(__float_as_uint(pmax), __float_as_uint(pmax), false, false);
      pmax = fmaxf(__uint_as_float(rr[0]), __uint_as_float(rr[1])); }
    constexpr float C2 = 1.4426950408889634f * SCALE;
    if (__builtin_expect(__all((pmax - m_reg) * SCALE <= THR), 1)) { mn = m_reg; alpha = 1.f; }
    else { mn = fmaxf(m_reg, pmax); alpha = __builtin_amdgcn_exp2f((m_reg - mn) * C2); m_reg = mn; }
    const float mnL0 = (base0 - mn) * C2, mnL1 = (base1 - mn) * C2;
    for (int r = 0; r < 16; ++r) p0[r] = fmaf(p0[r], C2, mnL0); for (int r = 0; r < 16; ++r) p1[r] = fmaf(p1[r], C2, mnL1);
    for (int r = 0; r < 16; ++r) p0[r] = __builtin_amdgcn_exp2f(p0[r]);
}
__device__ __forceinline__ void finishSM(f32x16& p0, f32x16& p1, float alpha, float& l_reg, bf16x8& pa0, bf16x8& pa1, bf16x8& pa2, bf16x8& pa3) {
    for (int r = 0; r < 16; ++r) p1[r] = __builtin_amdgcn_exp2f(p1[r]);
    float ps = 0; for (int r = 0; r < 16; ++r) ps += p0[r]; for (int r = 0; r < 16; ++r) ps += p1[r];
    { auto rr = __builtin_amdgcn_permlane32_swap(__float_as_uint(ps), __float_as_uint(ps), false, false);
      ps = __uint_as_float(rr[0]) + __uint_as_float(rr[1]); }
    l_reg = l_reg * alpha + ps;
#define PK4(P, B_, OUT) do { unsigned a0 = cvtpk(P[B_+0], P[B_+1]), a1 = cvtpk(P[B_+2], P[B_+3]);                          \
        unsigned b0 = cvtpk(P[B_+4], P[B_+5]), b1 = cvtpk(P[B_+6], P[B_+7]);                                             \
        auto r0 = __builtin_amdgcn_permlane32_swap(a0, b0, false, false); auto r1 = __builtin_amdgcn_permlane32_swap(a1, b1, false, false); \
        u32x4 w = {r0[0], r1[0], r0[1], r1[1]}; OUT = *reinterpret_cast<bf16x8*>(&w); } while (0)
    PK4(p0, 0, pa0); PK4(p0, 8, pa1); PK4(p1, 0, pa2); PK4(p1, 8, pa3);
#undef PK4
}
template <int KB, bool SK>
__device__ __forceinline__ void qkt(f32x16& p0, f32x16& p1, const char* K_lds, int r32, int hi, const bf16x8* qr, bool act) {
    if (SK && !act) { const float NEG = -__builtin_inff();
#pragma unroll
        for (int r = 0; r < 16; ++r) { p0[r] = NEG; p1[r] = NEG; } return; }
    p0 = f32x16{}; p1 = f32x16{};
    const char* kb[4];
#pragma unroll
    for (int dd = 0; dd < 4; ++dd) kb[dd] = K_lds + KB * SHM_K + KSWZ(r32, (dd * 16 + hi * 8) * 2);
#pragma unroll
    for (int d0 = 0; d0 < 8; ++d0) { const char* a = kb[d0 & 3] + (d0 >> 2) * 128;
        bf16x8 b0 = *reinterpret_cast<const bf16x8*>(a);
        bf16x8 b1 = *reinterpret_cast<const bf16x8*>(a + 32 * 256);
        p0 = __builtin_amdgcn_mfma_f32_32x32x16_bf16(b0, qr[d0], p0, 0, 0, 0);
        p1 = __builtin_amdgcn_mfma_f32_32x32x16_bf16(b1, qr[d0], p1, 0, 0, 0); }
}
template <int VB, bool SK>
__device__ __forceinline__ void pv_tile(f32x16* o, int vb0, bf16x8 pa0, bf16x8 pa1, bf16x8 pa2, bf16x8 pa3, bool act) {
    if (SK && !act) return;
#define TRRD(dst, off) asm volatile("ds_read_b64_tr_b16 %0, %1 offset:%2" : "=&v"(dst) : "v"(vb0), "i"(off) : "memory")
#define PV_D0(d0) do { s16x4 l0, l1, h0, h1; constexpr int b_ = VB * SHM_V + v_rd_off(d0, 0, 0);     \
        TRRD(l0, b_); TRRD(h0, b_ + 2048); TRRD(l1, b_ + 4096); TRRD(h1, b_ + 6144); \
        asm volatile("s_waitcnt lgkmcnt(0)" ::: "memory"); SBAR();                 \
        o[d0] = __builtin_amdgcn_mfma_f32_32x32x16_bf16(pa0, (bf16x8){l0[0], l0[1], l0[2], l0[3], h0[0], h0[1], h0[2], h0[3]}, o[d0], 0, 0, 0);   \
        o[d0] = __builtin_amdgcn_mfma_f32_32x32x16_bf16(pa1, (bf16x8){l1[0], l1[1], l1[2], l1[3], h1[0], h1[1], h1[2], h1[3]}, o[d0], 0, 0, 0);   \
        SBAR(); TRRD(l0, b_ + 8192); TRRD(h0, b_ + 10240); TRRD(l1, b_ + 12288); TRRD(h1, b_ + 14336); \
        asm volatile("s_waitcnt lgkmcnt(0)" ::: "memory"); SBAR();   \
        o[d0] = __builtin_amdgcn_mfma_f32_32x32x16_bf16(pa2, (bf16x8){l0[0], l0[1], l0[2], l0[3], h0[0], h0[1], h0[2], h0[3]}, o[d0], 0, 0, 0);   \
        o[d0] = __builtin_amdgcn_mfma_f32_32x32x16_bf16(pa3, (bf16x8){l1[0], l1[1], l1[2], l1[3], h1[0], h1[1], h1[2], h1[3]}, o[d0], 0, 0, 0); } while (0)
    PV_D0(0); PV_D0(1); PV_D0(2); PV_D0(3);
#undef PV_D0
#undef TRRD
}

template <class TIn, class TOut> struct BlockRef { const TIn* Q; const TIn* K; const TIn* V; TOut* O; int P0; const float* KM; float A; int jlo, jhi; float* ST; };
template <class TIn> struct Seam {
    bf16x8 qr[8];
    bf16x8 st_v0, st_v1, st_k0, st_k1; f32x4 sf0, sf1, sf2, sf3;
    f32x4 tq[16];
};
__device__ __forceinline__ int swa_jlo(int P0, int W) { const int lowk = P0 - W + 1; return lowk > 0 ? lowk / KVBLK : 0; }
#define ROW(p, k0, rr) ((p) + (size_t)((k0) + (rr)) * KPITCH + sc)
#define VMW() asm volatile("s_waitcnt vmcnt(0)" ::: "memory")
#define VMWN(n) asm volatile("s_waitcnt vmcnt(%0)" :: "i"(n) : "memory")
#define SLOAD_H(Kp, Vp, k0) do { S.st_v0 = load8<TIn>(ROW(Vp, k0, sr)); S.st_v1 = load8<TIn>(ROW(Vp, k0, 32 + sr));              \
                         S.st_k0 = load8<TIn>(ROW(Kp, k0, sr)); S.st_k1 = load8<TIn>(ROW(Kp, k0, 32 + sr)); } while (0)
#define SWRITE_HK(bf) do { *(bf16x8*)(K_lds + (bf) * SHM_K + kws) = S.st_k0; *(bf16x8*)(K_lds + (bf) * SHM_K + kws + 32 * 256) = S.st_k1; } while (0)
#define SWRITE_HV(bf) do { *(bf16x8*)(V_lds + (bf) * SHM_V + vst0) = S.st_v0; *(bf16x8*)(V_lds + (bf) * SHM_V + vst1) = S.st_v1; } while (0)
#define SWRITE_H(bf) do { SWRITE_HV(bf); SWRITE_HK(bf); } while (0)
#define SLOAD_F(p, k0) do { S.sf0 = *(const f32x4*)ROW(p, k0, sr); S.sf1 = *(const f32x4*)(ROW(p, k0, sr) + 4);                \
                            S.sf2 = *(const f32x4*)ROW(p, k0, 32 + sr); S.sf3 = *(const f32x4*)(ROW(p, k0, 32 + sr) + 4); } while (0)
#define SWRITE_KF(bf) do { *(bf16x8*)(K_lds + (bf) * SHM_K + kws) = pack8(S.sf0, S.sf1); *(bf16x8*)(K_lds + (bf) * SHM_K + kws + 32 * 256) = pack8(S.sf2, S.sf3); } while (0)
#define SWRITE_VF(bf) do { *(bf16x8*)(V_lds + (bf) * SHM_V + vst0) = pack8(S.sf0, S.sf1); *(bf16x8*)(V_lds + (bf) * SHM_V + vst1) = pack8(S.sf2, S.sf3); } while (0)
template <class TIn, class TOut>
__device__ __forceinline__ void causal_swa_prime(const BlockRef<TIn, TOut>& cur, int W, char* lds, Seam<TIn>& S) {
    constexpr bool F32 = same_t<TIn, float>::v;
    const int tid = ltid(), wid = __builtin_amdgcn_readfirstlane(tid >> 6), lane = tid & 63, r32 = lane & 31, hi = lane >> 5;
    const int sr = tid >> 4, sc = (tid & 15) * 8, kws = KSWZ(sr, sc * 2); char* K_lds = lds + 2 * SHM_V;
    const int kb0 = cur.jlo * KVBLK;
    for (int d0 = 0; d0 < 8; ++d0) S.qr[d0] = load8<TIn>(cur.Q + (size_t)(wid * QBLK + r32) * QPITCH + d0 * 16 + hi * 8);
    if constexpr (F32) { SLOAD_F((const float*)cur.K, kb0); VMW(); SWRITE_KF(0); SBAR(); SLOAD_F((const float*)cur.V, kb0); }
    else { SLOAD_H(cur.K, cur.V, kb0); VMW(); SWRITE_HK(0); }
    __syncthreads();
}
template <class TIn, class TOut>
__device__ __forceinline__ void causal_swa_block(const BlockRef<TIn, TOut>& cur, const BlockRef<TIn, TOut>& nxt, int skv, int W, char* lds, Seam<TIn>& S) {
    constexpr bool F32 = same_t<TIn, float>::v;
    const int tid = ltid(), wid = __builtin_amdgcn_readfirstlane(tid >> 6), lane = tid & 63, r32 = lane & 31, hi = lane >> 5;
    const int j_lo = cur.jlo, j_hi = cur.jhi;
    const int NT = j_hi - j_lo;
    const int kbn = nxt.jlo * KVBLK;
    const int qlo = cur.P0 + wid * QBLK, qm = qlo + r32 - 4 * hi;
    char* V_lds = lds; char* K_lds = lds + 2 * SHM_V;
    float* ws = (float*)(lds + 2 * SHM_V + 2 * SHM_K) + wid * 64; float* li_l = ws, * al_l = ws + 32;
    float m_reg = -1e30f, l_reg = 0; f32x16 o[4] = {};
    const int sr = tid >> 4, sc = (tid & 15) * 8, vst0 = v_st(sr, sc), vst1 = v_st(32 + sr, sc), kws = KSWZ(sr, sc * 2);
    const int vb0 = (int)(uintptr_t)V_lds + v_rd_base(lane);
    const TIn* Kh = cur.K; const TIn* Vh = cur.V;
    const float alA_ = cur.A;
    unsigned selm = 0u;
    { const int qb_ = cur.P0 >> 8;
      if (qb_ > 0) {
        float* kmL = (float*)(K_lds + SHM_K);
        *(f32x4*)(kmL + 4 * tid) = *(const f32x4*)(cur.KM + (size_t)(tid >> 5) * 1024 + 4 * (tid & 31));
        __syncthreads();
        float g[16];
#pragma unroll
        for (int n = 0; n < 16; ++n) g[n] = 0.f;
#pragma unroll
        for (int d0 = 0; d0 < 8; ++d0) { float qf[8];
#pragma unroll
            for (int j = 0; j < 8; ++j) qf[j] = __uint_as_float(((unsigned)(unsigned short)S.qr[d0][j]) << 16);
#pragma unroll
            for (int n = 0; n < 16; ++n) if (n < qb_) { const f32x4 k0 = *(const f32x4*)(kmL + n * 128 + d0 * 16 + hi * 8), k1 = *(const f32x4*)(kmL + n * 128 + d0 * 16 + hi * 8 + 4);
                g[n] += qf[0] * k0[0] + qf[1] * k0[1] + qf[2] * k0[2] + qf[3] * k0[3] + qf[4] * k1[0] + qf[5] * k1[1] + qf[6] * k1[2] + qf[7] * k1[3]; }
            asm volatile("" ::: "memory"); }
#pragma unroll
        for (int n = 0; n < 16; ++n) { const float a = g[n] + __shfl_xor(g[n], 32); g[n] = n < qb_ ? a : -1e30f; }
#pragma unroll
        for (int r = 0; r < 3; ++r) { float best = -3e38f; int bi = 0;
#pragma unroll
            for (int n = 0; n < 16; ++n) if (!((selm >> n) & 1u) && g[n] > best) { best = g[n]; bi = n; }
            selm |= 1u << bi; }
        selm &= (1u << qb_) - 1u;
        __syncthreads();
      }
      li_l[r32] = __uint_as_float(selm); }
#define RESC(a) do { if (__any((a) < 1.f)) { if (hi == 0) al_l[r32] = (a); asm volatile("s_waitcnt lgkmcnt(0)" ::: "memory");              \
                     for (int d_ = 0; d_ < 4; ++d_) for (int r = 0; r < 16; ++r) o[d_][r] *= al_l[crow(r, hi)]; } } while (0)
#define KBASE(t) ((j_lo + (t)) * KVBLK)
#define ACT(t) (KBASE(t) <= qlo + QBLK - 1 && KBASE(t) + KVBLK - 1 >= qlo - W + 1)
#define MASKT(P0_, P1_, t) do { const int kb_ = KBASE(t); if ((!SK || ACT(t)) && (kb_ + KVBLK - 1 > qlo || kb_ <= qlo + QBLK - 1 - W)) mask_tile(P0_, P1_, qm - kb_, (unsigned)W); \
        _Pragma("unroll") for (int r = 0; r < 16; ++r) { const float c_ = (float)((r & 3) + 8 * (r >> 2)); P0_[r] = fmaf(alA_, c_, P0_[r]); P1_[r] = fmaf(alA_, c_, P1_[r]); } } while (0)
#define BASE0(t) ((KBASE(t) < cur.P0 && !((__float_as_uint(li_l[r32]) >> (KBASE(t) >> 8)) & 1u)) ? -__builtin_inff() : alA_ * (float)(KBASE(t) - cur.P0 + 4 * hi))
#define BASE1(t) (BASE0(t) + 32.f * alA_)
    constexpr int NQL = F32 ? 16 : 8;
    constexpr bool SK = WSKIP && !F32;
#define SEAM_K0() do { VMWN(NQL); if constexpr (F32) { SWRITE_KF(0); SBAR(); SLOAD_F((const float*)nxt.V, kbn); } else { SWRITE_HK(0); } SBAR(); } while (0)
    f32x16 pA0, pA1, pB0, pB1; float mnA, mnB, alA, alB; bf16x8 pa0, pa1, pa2, pa3;
    if constexpr (F32) { VMW(); SWRITE_VF(0); SBAR(); } else { SWRITE_HV(0); SBAR(); }
    if (NT > 1) { if constexpr (F32) SLOAD_F((const float*)Kh, KBASE(1)); else SLOAD_H(Kh, Vh, KBASE(1)); }
    SBAR(); qkt<0, SK>(pA0, pA1, K_lds, r32, hi, S.qr, ACT(0));
    if constexpr (F32) { if (NT > 1) { VMW(); SWRITE_KF(1); SBAR(); SLOAD_F((const float*)Vh, KBASE(1)); } }
    MASKT(pA0, pA1, 0); partialSM(pA0, pA1, m_reg, mnA, alA, BASE0(0), BASE1(0));
    if (NT > 1) { VMW(); if constexpr (F32) { SWRITE_VF(1); SBAR(); if (NT > 2) SLOAD_F((const float*)Kh, KBASE(2)); } else SWRITE_H(1); }
    __syncthreads();
#define HALF_STEP(PX0, PX1, mnX, alX, PY0, PY1, alY, t, KB, VB, SB) do {                                                      \
        SBAR(); qkt<KB, SK>(PX0, PX1, K_lds, r32, hi, S.qr, ACT(t));                                             \
        finishSM(PY0, PY1, alY, l_reg, pa0, pa1, pa2, pa3); SBAR();                                                           \
        if ((t) + 1 < NT) { if constexpr (F32) { VMW(); SWRITE_KF(SB); SBAR(); SLOAD_F((const float*)Vh, KBASE((t) + 1)); }  \
                            else { SLOAD_H(Kh, Vh, KBASE((t) + 1)); } SBAR(); }                                               \
        pv_tile<VB, SK>(o, vb0, pa0, pa1, pa2, pa3, ACT((t) - 1)); MASKT(PX0, PX1, (t)); partialSM(PX0, PX1, m_reg, mnX, alX, BASE0(t), BASE1(t));                                        \
        __syncthreads();                                                                                                      \
        if ((t) + 1 < NT) { VMW(); if constexpr (F32) { SWRITE_VF(SB); SBAR(); if ((t) + 2 < NT) SLOAD_F((const float*)Kh, KBASE((t) + 2)); } \
                            else { SWRITE_H(SB); } }                                                                          \
        RESC(alX); __syncthreads(); } while (0)
    for (int t = 1; t + 1 < NT; t += 2) {
        HALF_STEP(pB0, pB1, mnB, alB, pA0, pA1, alA, t, 1, 0, 0);
        HALF_STEP(pA0, pA1, mnA, alA, pB0, pB1, alB, t + 1, 0, 1, 1);
    }
    const bool even = (NT & 1) == 0;
    if (even) { SBAR(); qkt<1, SK>(pB0, pB1, K_lds, r32, hi, S.qr, ACT(NT - 1)); SBAR(); }
#define QROW(e) (nxt.Q + (size_t)(wid * QBLK + r32) * QPITCH + ((e) >> 1) * 16 + hi * 8 + ((e) & 1) * 4)
    if constexpr (F32) { SLOAD_F((const float*)nxt.K, kbn); SBAR();
#pragma unroll
        for (int e = 0; e < 8; ++e) S.tq[e] = *(const f32x4*)QROW(e); }
    else { SLOAD_H(nxt.K, nxt.V, kbn); SBAR();
#pragma unroll
        for (int d0 = 0; d0 < 8; ++d0) S.qr[d0] = load8<TIn>(nxt.Q + (size_t)(wid * QBLK + r32) * QPITCH + d0 * 16 + hi * 8); }
    SBAR();
    finishSM(pA0, pA1, alA, l_reg, pa0, pa1, pa2, pa3); SBAR();
    if constexpr (F32) {
#pragma unroll
        for (int e = 8; e < 16; ++e) S.tq[e] = *(const f32x4*)QROW(e); SBAR(); }
#undef QROW
    pv_tile<0, SK>(o, vb0, pa0, pa1, pa2, pa3, ACT(even ? NT - 2 : NT - 1));
    if (even) { MASKT(pB0, pB1, NT - 1); partialSM(pB0, pB1, m_reg, mnB, alB, BASE0(NT - 1), BASE1(NT - 1)); __syncthreads(); RESC(alB);
        finishSM(pB0, pB1, alB, l_reg, pa0, pa1, pa2, pa3); SBAR(); pv_tile<1, SK>(o, vb0, pa0, pa1, pa2, pa3, ACT(NT - 1)); }
    SBAR(); SEAM_K0();
    if (hi == 0) { li_l[r32] = l_reg; if (cur.ST) { cur.ST[(wid * QBLK + r32) * 16] = m_reg; cur.ST[(wid * QBLK + r32) * 16 + 1] = l_reg; } }
    asm volatile("s_waitcnt lgkmcnt(0)" ::: "memory");
    float rli[16];
#pragma unroll
    for (int r = 0; r < 16; ++r) { const float l_ = li_l[crow(r, hi)]; rli[r] = l_ > 0.f ? __builtin_amdgcn_rcpf(l_) : 0.f; }
    TOut* Ow = cur.O + (size_t)(wid * QBLK) * OPITCH;
#pragma unroll
    for (int r = 0; r < 16; ++r) { const int orow = crow(r, hi);
#pragma unroll
        for (int d0 = 0; d0 < 4; ++d0) { const float v = o[d0][r] * rli[r];
            if constexpr (same_t<TOut, float>::v) { Ow[(size_t)orow * OPITCH + d0 * 32 + r32] = v; }
            else { const float vn = __shfl_xor(v, 1);
                   if ((r32 & 1) == 0) *(unsigned*)(Ow + (size_t)orow * OPITCH + d0 * 32 + r32) = cvtpk(v, vn); } } }
    if constexpr (F32) {
#pragma unroll
        for (int d0 = 0; d0 < 8; ++d0) S.qr[d0] = pack8(S.tq[2 * d0], S.tq[2 * d0 + 1]); }
    __syncthreads();
#undef RESC
#undef KBASE
#undef ACT
#undef MASKT
#undef SEAM_K0
#undef HALF_STEP
}
#undef ROW
#undef VMW
#undef VMWN
#undef SLOAD_H
#undef SWRITE_HK
#undef SWRITE_HV
#undef SWRITE_H
#undef SLOAD_F
#undef SWRITE_KF
#undef SWRITE_VF

#undef BASE0
#undef BASE1
}
constexpr size_t WS_OSL = WS_XN, WS_OSU = WS_H;
constexpr size_t WS_STL = WS_WIN, WS_STU = WS_WIN + 1 * MiB;
constexpr int MOBA_SPLIT_QB = 8;
__device__ __forceinline__ void phase_moba(KP P, char* lds, int vcu, int G) {
    typedef moba::BlockRef<moba::bf16, moba::bf16> BR;
    const moba::bf16* proj = (const moba::bf16*)(P.ws + WS_PROJ); moba::bf16* AR = (moba::bf16*)(P.ws + WS_AR); const float* kmean = (const float*)(P.ws + WS_KMEAN);
    constexpr int W = 1 << 30;
    auto mkref = [&](int bh, int qb, int part) -> BR { const int b = bh >> 3, h = bh & 7; BR r; const int nt = 4 * qb + 4;
        r.Q = proj + (size_t)(b * SEQ + qb * 256) * INCP + h * 128; r.K = proj + (size_t)(b * SEQ) * INCP + C_AK + h * 128; r.V = proj + (size_t)(b * SEQ) * INCP + C_AV + h * 128;
        moba::bf16* ob = part == 0 ? AR : (moba::bf16*)(P.ws + (part == 1 ? WS_OSL : WS_OSU));
        r.O = ob + (size_t)(b * SEQ + qb * 256) * DM + h * 128; r.P0 = qb * 256; r.KM = kmean + (size_t)(b * 16) * 1024 + h * 128; r.A = exp2f(-(float)(h + 1)) * (1.f / moba::SCALE);
        r.jlo = part == 2 ? nt / 2 : 0; r.jhi = part == 1 ? nt / 2 : nt;
        r.ST = part == 0 ? nullptr : (float*)(P.ws + (part == 1 ? WS_STL : WS_STU)) + ((size_t)(b * SEQ + qb * 256) * 8 + h) * 2;
        return r; };
    moba::Seam<moba::bf16> S;
    if (G == 256) {
        const int q_ = vcu & 15, bh = vcu >> 4;
        const int qbA[16] = {-1, -1, 15, 15,  7, 14, 14, 13, 13,  6, 12, 12, 11, 11,  5, 10};
        const int ptA[16] = { 0,  0,  2,  1,  0,  2,  1,  2,  1,  0,  2,  1,  2,  1,  0,  2};
        const int qbB[16] = {-1, -1, -1, -1, -1,  0, -1,  1,  2,  3,  8,  8,  4,  9,  9, 10};
        const int ptB[16] = { 0,  0,  0,  0,  0,  0,  0,  0,  0,  0,  2,  1,  0,  2,  1,  1};
        int qa = -1, pa = 0, qb2 = -1, pb = 0;
#pragma unroll
        for (int k = 0; k < 16; ++k) if (k == q_) { qa = qbA[k]; pa = ptA[k]; qb2 = qbB[k]; pb = ptB[k]; }
        for (int it = 0; it < 2; ++it) { const int qq = it == 0 ? qa : qb2, pp = it == 0 ? pa : pb; if (qq < 0) continue;
            const BR cur = mkref(bh, qq, pp);
            moba::causal_swa_prime<moba::bf16, moba::bf16>(cur, W, lds, S);
            moba::causal_swa_block<moba::bf16, moba::bf16>(cur, cur, SEQ, W, lds, S); }
    } else {
        for (int item = vcu; item < 256; item += G) {
            const BR cur = mkref(item >> 4, item & 15, 0);
            moba::causal_swa_prime<moba::bf16, moba::bf16>(cur, W, lds, S);
            moba::causal_swa_block<moba::bf16, moba::bf16>(cur, cur, SEQ, W, lds, S); }
    }
}
__device__ __forceinline__ void moba_combine(KP P, int vcu, int G) {
    if (G != 256) return;
    const int tid = ltid(); const bf16* OL = (const bf16*)(P.ws + WS_OSL); const bf16* OU = (const bf16*)(P.ws + WS_OSU); bf16* AR = (bf16*)(P.ws + WS_AR);
    const float* STL = (const float*)(P.ws + WS_STL); const float* STU = (const float*)(P.ws + WS_STU);
    constexpr int NSPL = 16 - MOBA_SPLIT_QB; constexpr float C2 = 1.4426950408889634f * moba::SCALE;
    for (int item = vcu; item < 16 * NSPL * 2; item += G) {
        const int half = item & 1, k = item >> 1, bh = k / NSPL, qb = MOBA_SPLIT_QB + k % NSPL, b = bh >> 3, h = bh & 7;
        const int row = b * SEQ + qb * 256 + half * 128 + (tid >> 2), c0 = (tid & 3) * 32;
        const size_t so = ((size_t)row * 8 + h) * 2; const float mL = STL[so], lL = STL[so + 1], mU = STU[so], lU = STU[so + 1];
        const float m = fmaxf(mL, mU); const float wL = lL * __builtin_amdgcn_exp2f((mL - m) * C2), wU = lU * __builtin_amdgcn_exp2f((mU - m) * C2); const float inv = __builtin_amdgcn_rcpf(wL + wU);
        const float aL = wL * inv, aU = wU * inv; const size_t o = (size_t)row * DM + h * 128 + c0;
#pragma unroll
        for (int j = 0; j < 4; ++j) { const v4u l4 = *(const v4u*)(OL + o + 8 * j), u4 = *(const v4u*)(OU + o + 8 * j); v4u r4;
#pragma unroll
            for (int e = 0; e < 4; ++e) r4[e] = pk2(aL * bflo(l4[e]) + aU * bflo(u4[e]), aL * bfhi(l4[e]) + aU * bfhi(u4[e]));
            *(v4u*)(AR + o + 8 * j) = r4; }
    }
}
constexpr size_t WS_SKB = WS_KMEAN + 256 * 1024;
__device__ __forceinline__ void prologue_subkeys(KP P, int vcu, int G) {
    unsigned* dst = (unsigned*)(P.ws + WS_SKB);
    for (int i = vcu * NTHR + ltid(); i < 8 * 2 * 128 * 128 / 2; i += G * NTHR) dst[i] = pk2(P.sub_keys[2 * i], P.sub_keys[2 * i + 1]);
}
__device__ __forceinline__ unsigned f2key(float v) { const unsigned u = __float_as_uint(v); return u ^ ((u >> 31) ? 0xFFFFFFFFu : 0x80000000u); }
__device__ __forceinline__ float key2f(unsigned k) { return __uint_as_float(k ^ ((k >> 31) ? 0x80000000u : 0xFFFFFFFFu)); }
__device__ __forceinline__ unsigned umax3(unsigned a, unsigned b, unsigned c) { return max(max(a, b), c); }
__device__ __forceinline__ void peer_route_tiles(KP P, LAS unsigned char* lds, int tt0, int nitems, int h) {
    const int tid = ltid(), lane = tid & 63, wave = __builtin_amdgcn_readfirstlane(tid >> 6), l15 = lane & 15, q4 = lane >> 4;
    const bf16* PQ = (const bf16*)(P.ws + WS_PROJ); const bf16* SKB = (const bf16*)(P.ws + WS_SKB);
    int* ridx = (int*)(P.ws + WS_PROJ + 64 * MiB); float* rgate = (float*)(P.ws + WS_PROJ + 68 * MiB);
    for (int it_ = 0; it_ < nitems; ++it_) {
        LAS float* sval = (LAS float*)(lds + it_ * 16384); LAS int* sidx = (LAS int*)(lds + it_ * 16384 + 8192);
        const int tt = tt0 + it_, p = wave & 1, sub = wave >> 1, tl = sub * 16 + l15;
        const bf16* qp = PQ + ((size_t)tt * 64 + tl) * DM + h * 256 + p * 128 + 8 * q4;
        bf16x8 qb[4];
#pragma unroll
        for (int kk = 0; kk < 4; ++kk) qb[kk] = *(const bf16x8*)(qp + 32 * kk);
        const bf16* sk = SKB + ((size_t)((h * 2 + p) * 128 + l15)) * 128 + 8 * q4;
        unsigned key[32];
#pragma unroll
        for (int nt = 0; nt < 8; ++nt) { f32x4v acc = {0.f, 0.f, 0.f, 0.f};
#pragma unroll
            for (int kk = 0; kk < 4; ++kk) acc = __builtin_amdgcn_mfma_f32_16x16x32_bf16(*(const bf16x8*)(sk + nt * 16 * 128 + 32 * kk), qb[kk], acc, 0, 0, 0);
#pragma unroll
            for (int e = 0; e < 4; ++e) key[4 * nt + e] = (f2key(acc[e]) & ~127u) | (unsigned)(127 - (16 * nt + 4 * q4 + e)); }
#define CE(a_, b_) { const unsigned hi_ = max(KA[a_], KA[b_]), lo_ = min(KA[a_], KA[b_]); KA[a_] = hi_; KA[b_] = lo_; }
#define SORT16_NET CE(0,1) CE(2,3) CE(0,2) CE(1,3) CE(1,2) CE(4,5) CE(6,7) CE(4,6) CE(5,7) CE(5,6) CE(0,4) CE(2,6) CE(2,4) CE(1,5) CE(3,7) CE(3,5) CE(1,2) CE(3,4) CE(5,6) CE(8,9) CE(10,11) CE(8,10) CE(9,11) CE(9,10) CE(12,13) CE(14,15) CE(12,14) CE(13,15) CE(13,14) CE(8,12) CE(10,14) CE(10,12) CE(9,13) CE(11,15) CE(11,13) CE(9,10) CE(11,12) CE(13,14) CE(0,8) CE(4,12) CE(4,8) CE(2,10) CE(6,14) CE(6,10) CE(2,4) CE(6,8) CE(10,12) CE(1,9) CE(5,13) CE(5,9) CE(3,11) CE(7,15) CE(7,11) CE(3,5) CE(7,9) CE(11,13) CE(1,2) CE(3,4) CE(5,6) CE(7,8) CE(9,10) CE(11,12) CE(13,14)
#define BMERGE16(T_) _Pragma("unroll") for (int d_ = 8; d_ >= 1; d_ >>= 1) { _Pragma("unroll") for (int i_ = 0; i_ < 16; ++i_) if ((i_ & d_) == 0) { const unsigned hi_ = max(T_[i_], T_[i_ + d_]), lo_ = min(T_[i_], T_[i_ + d_]); T_[i_] = hi_; T_[i_ + d_] = lo_; } }
#define KA key
        SORT16_NET
#undef KA
#define KA (key + 16)
        SORT16_NET
#undef KA
        unsigned t16[16];
#pragma unroll
        for (int i = 0; i < 16; ++i) t16[i] = max(key[i], key[31 - i]);
        BMERGE16(t16)
        { const bool odd = (lane & 16) != 0; unsigned L[16];
#pragma unroll
          for (int i = 0; i < 16; ++i) L[i] = odd ? t16[15 - i] : t16[i];
#pragma unroll
          for (int i = 0; i < 16; ++i) { auto x = __builtin_amdgcn_permlane16_swap(L[i], L[i], false, false); t16[i] = max(x[0], x[1]); }
          BMERGE16(t16) }
        { const bool odd = (lane & 32) != 0; unsigned L[16];
#pragma unroll
          for (int i = 0; i < 16; ++i) L[i] = odd ? t16[15 - i] : t16[i];
#pragma unroll
          for (int i = 0; i < 16; ++i) { auto x = __builtin_amdgcn_permlane32_swap(L[i], L[i], false, false); t16[i] = max(x[0], x[1]); }
          BMERGE16(t16) }
#undef CE
#undef SORT16_NET
#undef BMERGE16
        if (q4 == 0) {
#pragma unroll
            for (int r4 = 0; r4 < 4; ++r4) {
                *(LAS f32x4*)(sval + (tl * 2 + p) * 16 + 4 * r4) = (f32x4){key2f(t16[4 * r4] & ~127u), key2f(t16[4 * r4 + 1] & ~127u), key2f(t16[4 * r4 + 2] & ~127u), key2f(t16[4 * r4 + 3] & ~127u)};
                *(LAS v4u*)(sidx + (tl * 2 + p) * 16 + 4 * r4) = (v4u){127u - (t16[4 * r4] & 127u), 127u - (t16[4 * r4 + 1] & 127u), 127u - (t16[4 * r4 + 2] & 127u), 127u - (t16[4 * r4 + 3] & 127u)}; }
        }
    }
    __syncthreads();
    {
        const int it_ = wave; const int tt = tt0 + it_;
        LAS float* sval = (LAS float*)(lds + it_ * 16384); LAS int* sidx = (LAS int*)(lds + it_ * 16384 + 8192);
        if (wave < nitems) {
            const LAS float* av = sval + (lane * 2) * 16; const LAS float* bv = av + 16; const LAS int* ai = sidx + (lane * 2) * 16; const LAS int* bi = ai + 16;
            unsigned hk[16];
            const float b0 = bv[0];
#pragma unroll
            for (int i4 = 0; i4 < 4; ++i4) { const f32x4 t4 = *(const LAS f32x4*)(av + 4 * i4);
#pragma unroll
                for (int e = 0; e < 4; ++e) hk[4 * i4 + e] = (f2key(t4[e] + b0) & ~255u) | (unsigned)(255 - (4 * i4 + e) * 16); }
            float bestv[16]; int beste[16];
#pragma unroll
            for (int r = 0; r < 16; ++r) {
                unsigned m0 = umax3(hk[0], hk[1], hk[2]), m1 = umax3(hk[3], hk[4], hk[5]), m2 = umax3(hk[6], hk[7], hk[8]), m3 = umax3(hk[9], hk[10], hk[11]);
                m0 = umax3(m0, hk[12], hk[13]); m1 = umax3(m1, hk[14], hk[15]);
                const unsigned best = max(max(m0, m1), max(m2, m3));
                const int f = 255 - (int)(best & 255u), bi_ = f >> 4, bj = f & 15;
                const float a_i = av[bi_]; bestv[r] = a_i + bv[bj]; beste[r] = ai[bi_] * 128 + bi[bj];
                const int nj = bj + 1;
                const unsigned nk = nj < 16 ? ((f2key(a_i + bv[nj & 15]) & ~255u) | (unsigned)(255 - (bi_ * 16 + nj))) : 0u;
#pragma unroll
                for (int i = 0; i < 16; ++i) hk[i] = i == bi_ ? nk : hk[i];
            }
            float se = 0.f; const float mx = bestv[0];
#pragma unroll
            for (int r = 0; r < 16; ++r) { bestv[r] = __expf(bestv[r] - mx); se += bestv[r]; }
            const float ise = 1.f / se; const size_t o = ((size_t)tt * 64 + lane) * 128 + h * 16;
#pragma unroll
            for (int r4 = 0; r4 < 4; ++r4) { *(v4u*)(ridx + o + 4 * r4) = (v4u){(unsigned)beste[4 * r4], (unsigned)beste[4 * r4 + 1], (unsigned)beste[4 * r4 + 2], (unsigned)beste[4 * r4 + 3]};
                *(f32x4*)(rgate + o + 4 * r4) = (f32x4){bestv[4 * r4] * ise, bestv[4 * r4 + 1] * ise, bestv[4 * r4 + 2] * ise, bestv[4 * r4 + 3] * ise}; }
        }
        __syncthreads();
    }
}
#define XB_TMO      128
#define XB_XCNT(j)  (256  + 64 * (j))
#define XB_XSUB(j)  (1280 + 64 * (j))
#define XB_XGEN(j)  (2304 + 64 * (j))
#define XB_TOP      3328
#define XB_TOPGEN   3392
#define XCD_BAR_WORDS 3456
#define XB_SPIN_CAP (1u << 18)

__device__ __forceinline__ unsigned xb_ld(unsigned* p)              { return __hip_atomic_load(p, __ATOMIC_RELAXED, __HIP_MEMORY_SCOPE_AGENT); }
__device__ __forceinline__ unsigned xb_add(unsigned* p, unsigned v) { return __hip_atomic_fetch_add(p, v, __ATOMIC_RELAXED, __HIP_MEMORY_SCOPE_AGENT); }
__device__ __forceinline__ unsigned xb_xcc_id() { return (unsigned)__builtin_amdgcn_s_getreg((3 << 11) | 20) & 0xFu; }
#define XB_SPIN(cond, bar) do { unsigned _sp = 0; while (cond) { __builtin_amdgcn_s_sleep(1); \
    if ((++_sp & 255u) == 0u) { if (xb_ld(&(bar)[XB_TMO])) break; if (_sp > XB_SPIN_CAP) { atomicAdd(&(bar)[XB_TMO], 1u); break; } } } } while (0)

struct XcdBarrier {
    unsigned* bar; unsigned x;
    volatile LAS unsigned* st;
};

__device__ __forceinline__ XcdBarrier xcd_barrier_post(unsigned* bar, volatile LAS unsigned* st) {
    XcdBarrier b; b.bar = bar; b.x = xb_xcc_id(); b.st = st;
    if (threadIdx.x == 0) (void)xb_add(&bar[XB_XCNT(b.x)], 1u);
    return b;
}
__device__ __forceinline__ void xcd_barrier_complete(unsigned* bar, unsigned x, unsigned& nloc, unsigned& nx) {
    const unsigned G = gridDim.x * gridDim.y * gridDim.z;
    unsigned sum, cnt, mine, sp = 0u;
    for (;;) {
        sum = 0u; cnt = 0u; mine = 0u;
#pragma unroll
        for (unsigned j = 0; j < 16; ++j) { const unsigned c = xb_ld(&bar[XB_XCNT(j)]); sum += c; cnt += (c > 0u) ? 1u : 0u; mine = (j == x) ? c : mine; }
        if (sum == G) break;
        __builtin_amdgcn_s_sleep(1);
        if ((++sp & 255u) == 0u) { if (xb_ld(&bar[XB_TMO])) break; if (sp > XB_SPIN_CAP) { atomicAdd(&bar[XB_TMO], 1u); break; } }
    }
    nloc = mine > 0u ? mine : 1u; nx = cnt > 0u ? cnt : 1u;
}

__device__ __forceinline__ void xcd_barrier(const XcdBarrier& b) {
    asm volatile("s_waitcnt vmcnt(0)" ::: "memory");
    __syncthreads();
    if (threadIdx.x == 0) {
        unsigned* bar = b.bar;
        __builtin_amdgcn_s_waitcnt(0);
        unsigned nloc = b.st[0], nx = b.st[1];
        if (nloc == 0u) { xcd_barrier_complete(bar, b.x, nloc, nx); b.st[0] = nloc; b.st[1] = nx; }
        const unsigned old = xb_add(&bar[XB_XSUB(b.x)], 1u);
        const unsigned gen = old / nloc;
        if (old + 1u == (gen + 1u) * nloc) {
            __builtin_amdgcn_fence(__ATOMIC_RELEASE, "agent");
            asm volatile("s_waitcnt vmcnt(0)" ::: "memory");
            const unsigned og = xb_add(&bar[XB_TOP], 1u);
            const unsigned tg = og / nx;
            if (og + 1u == (tg + 1u) * nx) xb_add(&bar[XB_TOPGEN], 1u);
            else XB_SPIN(xb_ld(&bar[XB_TOPGEN]) == tg, bar);
            __builtin_amdgcn_fence(__ATOMIC_ACQUIRE, "agent");
            xb_add(&bar[XB_XGEN(b.x)], 1u);
            asm volatile("s_waitcnt vmcnt(0)" ::: "memory");
        } else {
            XB_SPIN(xb_ld(&bar[XB_XGEN(b.x)]) == gen, bar);
            __builtin_amdgcn_fence(__ATOMIC_ACQUIRE, "agent");
            asm volatile("s_waitcnt vmcnt(0)" ::: "memory");
        }
    }
    __syncthreads();
}
#ifndef MK_ONE_LAUNCH
#define MK_ONE_LAUNCH 1
#endif
constexpr int N_PHASES = 11;
__global__ void __launch_bounds__(NTHR, 2) mega(Params Pkernarg) {
    extern __shared__ __attribute__((aligned(16))) unsigned char lds_raw[];
    LAS unsigned char* lds = (LAS unsigned char*)lds_raw;
    const int tid = ltid();
    const int G = gridDim.x, bx = blockIdx.x; const int vcu = (G % 8 == 0) ? (bx % 8) * (G / 8) + bx / 8 : bx;
    for (int u = tid; u < (LDS_BYTES - LDSCTL_OFF) / 4; u += NTHR) ((LAS unsigned*)(lds + LDSCTL_OFF))[u] = 0u;
    __syncthreads();
#if MK_ONE_LAUNCH
    XcdBarrier bar = xcd_barrier_post((unsigned*)(params_ptr()->ws + WS_CTL) + CW_BAR + params_ptr()->bar_li * XCD_BAR_WORDS, (volatile LAS unsigned*)(lds + MISC_OFF) + 8);
#define GRID_BAR() xcd_barrier(bar)
#else
#define GRID_BAR() do {} while (0)
#endif
#ifndef PHOFF
#define PHOFF 0
#endif
#define IN(k) (!((PHOFF >> (k)) & 1))
#define BOTH(k) (IN(k) && IN((k) + 1))
    if (IN(0)) { KP P = *params_ptr(); phase_prologue(P, lds, vcu, G); prologue_subkeys(P, vcu, G); prologue_lora(P, vcu, G); if (BOTH(0)) GRID_BAR(); }
    if (IN(1)) { KP P = *params_ptr();
        pg8::Gemm g{(const bf16*)(P.ws + WS_XN), (const bf16*)(P.ws + WS_WIN), TT, INCP, DM}; pg8::Order1 S; S.init(TT, INCP, G, bx);
        pg8::EpiBf16<0> E{(bf16*)(P.ws + WS_PROJ), INCP, nullptr, 0, 0, 1.f};
        pg8::gemm_phase<pg8::EpiBf16<0>, pg8::Order1, true, true>(lds, g, S, E);
        phase_convert_tables(P, lds);
        if (BOTH(1)) GRID_BAR();
    }
    if (IN(2)) { KP P = *params_ptr(); phase_act(P, vcu, G); phase_kmean(P, lds, vcu, G); if (BOTH(2)) GRID_BAR(); }
    if (IN(3)) { KP P = *params_ptr(); phase_rwkv_stage_a(P, lds, vcu, G); if (BOTH(3)) GRID_BAR(); }
    if (IN(4)) { KP P = *params_ptr(); if ((vcu & 15) < 2 && vcu < 256) rwkv_stage_b(P, lds, (vcu >> 4) * 2 + (vcu & 15)); phase_moba(P, (char*)lds_raw, vcu, G); }
    if (IN(5)) { GRID_BAR(); KP P = *params_ptr(); moba_combine(P, vcu, G); GRID_BAR(); }
    if (IN(6)) { KP P = *params_ptr();
        pg8::Gemm g{(const bf16*)(P.ws + WS_AR), (const bf16*)(P.ws + WS_WOUT), TT, DM, DM}; pg8::StaticOrder S; S.init(TT, DM, G, bx);
        pg8::EpiH E{P.x, (bf16*)(P.ws + WS_XN), (float*)(P.ws + WS_SSP), DM};
        pg8::gemm_phase<pg8::EpiH, pg8::StaticOrder, true, true>(lds, g, S, E);
        if (BOTH(6)) GRID_BAR();
    }
    if (IN(8)) { KP P = *params_ptr(); phase_rstd(P, vcu, G); GRID_BAR();
        pg8::Gemm g{(const bf16*)(P.ws + WS_XN), (const bf16*)(P.ws + WS_WQ), TT, DM, DM}; pg8::StaticOrder S; S.init(TT, DM, G, bx);
        pg8::EpiBf16Row E{(bf16*)(P.ws + WS_PROJ), DM, (const float*)(P.ws + WS_SSP + 2 * MiB)};
        pg8::gemm_phase<pg8::EpiBf16Row, pg8::StaticOrder, true, true>(lds, g, S, E);
        if (G == 256) { const int wg_ = (bx & 7) * 32 + (bx >> 3); pg8::Unit u; u.pm = (wg_ >> 6) * 8 + (wg_ & 7); u.pn = (wg_ & 63) >> 3;
            asm volatile("s_waitcnt vmcnt(0)" ::: "memory"); __syncthreads(); __builtin_amdgcn_fence(__ATOMIC_ACQUIRE, "agent"); asm volatile("s_waitcnt vmcnt(0)" ::: "memory");
            peer_route_tiles(P, lds, 4 * u.pm, 4, u.pn);
        } else if (G != 256) { GRID_BAR(); for (int item = vcu; item < 1024; item += G) peer_route_tiles(P, lds, item >> 3, 1, item & 7); }
        if (BOTH(8)) GRID_BAR();
    }
    if (IN(10)) { KP P = *params_ptr(); phase_peer_sliced(P, lds, bx, G); }
#undef IN
#undef BOTH
}

extern "C" void kernel_launch(void* const* d_in, const int* in_sizes, int n_in, void* d_out, int out_size, void* d_ws, size_t ws_size, hipStream_t stream) {
    static int grid = 0;
    if (grid == 0) {
        if (n_in != 21 || in_sizes[0] != TT * DM || out_size != TT * DM || ws_size < WS_END) {
            fprintf(stderr, "kernel_launch: unexpected shapes: n_in %d in0 %d out %d ws %zu\n", n_in, n_in > 0 ? in_sizes[0] : -1, out_size, ws_size); grid = -1; return; }
        int dev = 0, cus = 0;
        if (hipGetDevice(&dev) != hipSuccess || hipDeviceGetAttribute(&cus, hipDeviceAttributeMultiprocessorCount, dev) != hipSuccess) { grid = -1; return; }
        if (hipFuncSetAttribute((const void*)mega, hipFuncAttributeMaxDynamicSharedMemorySize, LDS_BYTES) != hipSuccess) { fprintf(stderr, "kernel_launch: hipFuncSetAttribute failed\n"); grid = -1; return; }
        int per_cu = 0;
        if (hipOccupancyMaxActiveBlocksPerMultiprocessor(&per_cu, (const void*)mega, NTHR, LDS_BYTES) != hipSuccess || per_cu < 1) fprintf(stderr, "kernel_launch: occupancy query says %d blocks per CU\n", per_cu);
        (void)hipGetLastError();
        grid = cus;
    }
    if (grid < 0) return;
    (void)hipMemsetAsync((char*)d_ws + WS_CTL, 0, CTL_ZERO_BYTES, stream);
    Params p{};
    p.x = (const float*)d_in[0]; p.norm1_g = (const float*)d_in[1]; p.w_in = (const float*)d_in[2]; p.mu = (const float*)d_in[3]; p.w0 = (const float*)d_in[4];
    p.w2 = (const float*)d_in[5]; p.a0 = (const float*)d_in[6]; p.a2 = (const float*)d_in[7]; p.g2 = (const float*)d_in[8]; p.k_k = (const float*)d_in[9];
    p.k_a = (const float*)d_in[10]; p.r_k = (const float*)d_in[11]; p.ln_g = (const float*)d_in[12]; p.ln_b = (const float*)d_in[13]; p.w_out = (const float*)d_in[14];
    p.norm2_g = (const float*)d_in[15]; p.wq = (const float*)d_in[16]; p.sub_keys = (const float*)d_in[17]; p.pu = (const float*)d_in[18]; p.pv = (const float*)d_in[19];
    p.final_g = (const float*)d_in[20]; p.out = (float*)d_out; p.ws = (unsigned char*)d_ws;
    p.ph_lo = 0; p.ph_hi = N_PHASES; p.bar_li = 0;
    hipLaunchKernelGGL(mega, dim3(grid), dim3(NTHR), LDS_BYTES, stream, p);
}
```

```cpp
#include <hip/hip_runtime.h>
#include <cstdio>
#include <cstdint>
__device__ __forceinline__ int ltid() { int t = threadIdx.x; asm volatile("" : "+v"(t)); return t; }
namespace pg8 {
#define PG8_LAS __attribute__((address_space(3)))
typedef unsigned short bf16_t;
typedef short bf16x8 __attribute__((ext_vector_type(8)));
typedef float f32x4 __attribute__((ext_vector_type(4)));
typedef unsigned u32x4 __attribute__((ext_vector_type(4)));
constexpr int BM = 256, BK = 64, HALF = 128, HTB = HALF * BK * 2  , STAGE_BYTES = 8 * HTB, NXCD = 8, WGM = 8;

__host__ __device__ __forceinline__ int lds_byte(int r, int c) { const int st = (r >> 4) * 2 + (c >> 5), rr = r & 15, cc = c & 31, ob = rr * 64 + cc * 2; return st * 1024 + (ob ^ (((ob >> 9) & 1) << 5)); }
__host__ __device__ __forceinline__ void stage_rc(int b, int& R, int& C) { const int st = b / 1024, sb = b % 1024, swz = sb ^ (((sb >> 9) & 1) << 5); R = (st >> 1) * 16 + swz / 64; C = (st & 1) * 32 + (swz % 64) / 2; }
__host__ __device__ __forceinline__ int perm32(int rho) { const int n = rho >> 4, i = rho & 15; return 8 * (i >> 2) + 4 * n + (i & 3); }

struct Unit { int pm, pn; };
struct Gemm { const bf16_t* A; const bf16_t* Bt; int M, N, K; };

struct StaticOrder {
    int nM, nN, nwg, G, c;
    __host__ __device__ void init(int M, int N, int G_, int c_) { nM = M / BM; nN = N / BM; nwg = nM * nN; G = G_; c = c_; }
    __host__ __device__ bool next(int i, Unit& u) const {
        const long L = (long)i * G + c; if (L >= nwg) return false;
        int wgid = (int)L; { const int q = nwg / NXCD, r = nwg % NXCD, xcd = wgid % NXCD, off = wgid / NXCD; wgid = (xcd < r ? xcd * (q + 1) : r * (q + 1) + (xcd - r) * q) + off; }
        const int nig = WGM * nN, gid = wgid / nig, fm = gid * WGM, gsz = (nM - fm) < WGM ? (nM - fm) : WGM;
        u.pm = fm + ((wgid % nig) % gsz); u.pn = (wgid % nig) / gsz; return true;
    }
    __device__ __forceinline__ void a_ready(const Unit&) const {}
    __device__ __forceinline__ void done(const Unit&) const {}
};

__device__ __forceinline__ unsigned cvt_pk_bf16(float lo, float hi) { unsigned r; asm volatile("v_cvt_pk_bf16_f32 %0, %1, %2" : "=v"(r) : "v"(lo), "v"(hi)); return r; }
typedef float f32x2 __attribute__((ext_vector_type(2)));
__device__ __forceinline__ f32x2 gelu_pk(f32x2 v) {
    const f32x2 av = __builtin_elementwise_abs(v), d = av * 0.2316418882f + 1.0f;
    f32x2 t; t.x = __builtin_amdgcn_rcpf(d.x); t.y = __builtin_amdgcn_rcpf(d.y);
    f32x2 q = t * 0.5307027145f + (-0.7265760135f); q = q * t + 0.7107068705f; q = q * t + (-0.142248368f); q = q * t + 0.127414796f; q = q * t;
    const f32x2 s = (v * v) * (-0.72134752044f);
    f32x2 e; e.x = __builtin_amdgcn_exp2f(s.x); e.y = __builtin_amdgcn_exp2f(s.y);
    const f32x2 m = v * (q * e), r = v - m;
    f32x2 o; o.x = v.x < 0.f ? m.x : r.x; o.y = v.y < 0.f ? m.y : r.y; return o;
}

template <int ACT  > struct EpiBf16 {
    static constexpr bool PERM = true, AFTER_DRAIN = false; static_assert(ACT == 0 || ACT == 1, "EpiBf16: ACT is 0 (none) or 1 (gelu_pk)");
    bf16_t* O; int ldc; const float* bias; int split_cols; size_t split_stride; float scale0;
    __device__ __forceinline__ void operator()(const f32x4 (&acc)[2][2][4][2], const Unit& u, int wr, int wc, int fr, int fq) const {
        const int row0 = u.pm * BM + wr * 64 + fr; int colt = u.pn * BM; bf16_t* base = O;
        float sc = 1.f; if (split_cols) { const int t = colt / split_cols; base += (size_t)t * split_stride; colt -= t * split_cols; if (t == 0) sc = scale0; }
        const int col0 = colt + wc * 32 + 8 * fq, bcol0 = u.pn * BM + wc * 32 + 8 * fq;
        f32x4 bv[2][2];
#pragma unroll
        for (int bj = 0; bj < 2; ++bj)
#pragma unroll
            for (int n = 0; n < 2; ++n) bv[bj][n] = bias ? *(const f32x4*)(bias + bcol0 + bj * HALF + 4 * n) : (f32x4){0.f, 0.f, 0.f, 0.f};
#pragma unroll
        for (int ai = 0; ai < 2; ++ai)
#pragma unroll
            for (int m = 0; m < 4; ++m) { bf16_t* rowp = base + (size_t)(row0 + ai * HALF + m * 16) * ldc + col0;
#pragma unroll
                for (int bj = 0; bj < 2; ++bj) { f32x4 v0 = acc[ai][bj][m][0] + bv[bj][0], v1 = acc[ai][bj][m][1] + bv[bj][1];
                    if (ACT == 1) { f32x2 a = gelu_pk((f32x2){v0[0], v0[1]}), b = gelu_pk((f32x2){v0[2], v0[3]}), c = gelu_pk((f32x2){v1[0], v1[1]}), d = gelu_pk((f32x2){v1[2], v1[3]});
                        v0 = (f32x4){a.x, a.y, b.x, b.y}; v1 = (f32x4){c.x, c.y, d.x, d.y}; }
                    v0 = v0 * sc; v1 = v1 * sc; u32x4 w; w.x = cvt_pk_bf16(v0[0], v0[1]); w.y = cvt_pk_bf16(v0[2], v0[3]); w.z = cvt_pk_bf16(v1[0], v1[1]); w.w = cvt_pk_bf16(v1[2], v1[3]);
                    *(u32x4*)(rowp + bj * HALF) = w; } }
    }
};
template <class Epi, class Sched, bool ALIGN_EPI = false, bool SP2 = false>
__device__ __forceinline__ void gemm_phase(PG8_LAS unsigned char* lds, const Gemm g, const Sched& S, const Epi& E) {
    const int tid = ltid(), wid = __builtin_amdgcn_readfirstlane(tid >> 6), lane = tid & 63, wr = wid >> 2, wc = wid & 3, fr = lane & 15, fq = lane >> 4;
    const int K = g.K, nt = K / BK;
    unsigned voffA[2], voffB[2];
#pragma unroll
    for (int i = 0; i < 2; ++i) { int R, C; stage_rc(tid * 16 + i * 8192, R, C); const int Rb = Epi::PERM ? ((R & ~31) + perm32(R & 31)) : R;
        voffA[i] = (unsigned)(R * K + C) * 2u; voffB[i] = (unsigned)(Rb * K + C) * 2u; }
    const size_t kstep = (size_t)(BK * 2);
    const size_t hstep = (size_t)HALF * K * 2;
    const size_t tstep = 2 * hstep;
    const unsigned ldsw = (unsigned)wid * 1024u;
    const int aoff = lds_byte(wr * 64 + fr, fq * 8), boff = lds_byte(wc * 32 + fr, fq * 8);
#define PG8_SA(b, h) (((b) * 2 + (h)) * HTB)
#define PG8_SB(b, h) ((4 + (b) * 2 + (h)) * HTB)
#define PG8_STAGE(bufoff, gbase, voff) do { _Pragma("unroll") for (int _i = 0; _i < 2; ++_i) \
        __builtin_amdgcn_global_load_lds((const unsigned*)((const char*)(gbase) + (voff)[_i]), (PG8_LAS unsigned*)(lds + (bufoff) + ldsw + _i * 8192), 16, 0, 0); } while (0)
#define PG8_LDA(dst, b, h) do { _Pragma("unroll") for (int m = 0; m < 4; ++m) _Pragma("unroll") for (int k = 0; k < 2; ++k) dst[m][k] = *(const PG8_LAS bf16x8*)(lds + PG8_SA(b, h) + aoff + m * 2048 + k * 1024); } while (0)
#define PG8_LDB(dst, b, h) do { _Pragma("unroll") for (int n = 0; n < 2; ++n) _Pragma("unroll") for (int k = 0; k < 2; ++k) dst[n][k] = *(const PG8_LAS bf16x8*)(lds + PG8_SB(b, h) + boff + n * 2048 + k * 1024); } while (0)
#define PG8_MMA(ai, bj, At, Bt) do { __builtin_amdgcn_s_setprio(1); _Pragma("unroll") for (int m = 0; m < 4; ++m) _Pragma("unroll") for (int n = 0; n < 2; ++n) _Pragma("unroll") for (int k = 0; k < 2; ++k) \
        acc[ai][bj][m][n] = __builtin_amdgcn_mfma_f32_16x16x32_bf16(Bt[n][k], At[m][k], acc[ai][bj][m][n], 0, 0, 0); __builtin_amdgcn_s_setprio(0); } while (0)
#define PG8_WAIT_V(n) asm volatile("s_waitcnt vmcnt(" #n ")" ::: "memory")
#define PG8_WAIT_L(n) asm volatile("s_waitcnt lgkmcnt(" #n ")" ::: "memory")
#define PG8_BAR __builtin_amdgcn_s_barrier()
#define PG8_SCHED __builtin_amdgcn_sched_barrier(0)
    Unit cur, nxt; int ui = 0;
    if (!S.next(0, cur)) return;
    f32x4 acc[2][2][4][2];
#pragma unroll
    for (int a = 0; a < 2; ++a)
#pragma unroll
        for (int b = 0; b < 2; ++b)
#pragma unroll
            for (int m = 0; m < 4; ++m)
#pragma unroll
                for (int n = 0; n < 2; ++n) acc[a][b][m][n] = (f32x4){0.f, 0.f, 0.f, 0.f};
    bf16x8 At[4][2], B0[2][2], B1[2][2];
    const char* cA = (const char*)g.A + (size_t)cur.pm * tstep; const char* cB = (const char*)g.Bt + (size_t)cur.pn * tstep;
    S.a_ready(cur);
    if constexpr (SP2) {
        PG8_STAGE(PG8_SB(0, 0), cB, voffB); PG8_STAGE(PG8_SB(0, 1), cB + hstep, voffB); PG8_STAGE(PG8_SA(0, 0), cA, voffA); PG8_STAGE(PG8_SA(0, 1), cA + hstep, voffA);
        if (wr == 1) PG8_BAR;
        PG8_WAIT_V(2); PG8_BAR;
        PG8_STAGE(PG8_SB(1, 0), cB + kstep, voffB); PG8_STAGE(PG8_SA(1, 0), cA + kstep, voffA); PG8_STAGE(PG8_SB(1, 1), cB + hstep + kstep, voffB);
        PG8_WAIT_V(6); PG8_BAR;
    } else {
        PG8_STAGE(PG8_SB(0, 0), cB, voffB); PG8_STAGE(PG8_SA(0, 0), cA, voffA); PG8_STAGE(PG8_SB(0, 1), cB + hstep, voffB); PG8_STAGE(PG8_SA(0, 1), cA + hstep, voffA);
        if (wr == 1) PG8_BAR;
        PG8_WAIT_V(4); PG8_BAR;
        PG8_STAGE(PG8_SB(1, 0), cB + kstep, voffB); PG8_STAGE(PG8_SA(1, 0), cA + kstep, voffA); PG8_STAGE(PG8_SB(1, 1), cB + hstep + kstep, voffB);
        PG8_WAIT_V(6); PG8_BAR;
    }
    for (;;) {
        const bool has_next = S.next(ui + 1, nxt);
        const char* nA = has_next ? (const char*)g.A + (size_t)nxt.pm * tstep : cA; const char* nB = has_next ? (const char*)g.Bt + (size_t)nxt.pn * tstep : cB;
        for (int t = 0; t < nt; t += 2) {
            const bool last = (t == nt - 2);
            const char* a1 = cA + (size_t)(t + 1) * kstep;
            const char* a2 = last ? nA : cA + (size_t)(t + 2) * kstep; const char* b2 = last ? nB : cB + (size_t)(t + 2) * kstep;
            const char* a3 = a2 + kstep; const char* b3 = b2 + kstep;
            if (last && has_next) S.a_ready(nxt);
            if constexpr (SP2) {
            PG8_LDB(B0, 0, 0); PG8_LDB(B1, 0, 1); PG8_SCHED; PG8_LDA(At, 0, 0); PG8_STAGE(PG8_SA(1, 1), a1 + hstep, voffA);
            PG8_WAIT_V(8); PG8_WAIT_L(0); PG8_BAR; PG8_MMA(0, 0, At, B0); PG8_MMA(0, 1, At, B1); PG8_BAR; PG8_SCHED;
            PG8_LDA(At, 0, 1); PG8_STAGE(PG8_SB(0, 0), b2, voffB); PG8_STAGE(PG8_SB(0, 1), b2 + hstep, voffB); PG8_STAGE(PG8_SA(0, 0), a2, voffA);
            PG8_WAIT_V(8); PG8_WAIT_L(0); PG8_BAR; PG8_MMA(1, 0, At, B0); PG8_MMA(1, 1, At, B1); PG8_BAR; PG8_SCHED;
            PG8_LDB(B0, 1, 0); PG8_LDB(B1, 1, 1); PG8_SCHED; PG8_LDA(At, 1, 0); PG8_STAGE(PG8_SA(0, 1), a2 + hstep, voffA);
            PG8_WAIT_V(8); PG8_WAIT_L(0); PG8_BAR; PG8_MMA(0, 0, At, B0); PG8_MMA(0, 1, At, B1); PG8_BAR; PG8_SCHED;
            PG8_LDA(At, 1, 1); PG8_STAGE(PG8_SB(1, 0), b3, voffB); PG8_STAGE(PG8_SB(1, 1), b3 + hstep, voffB); PG8_STAGE(PG8_SA(1, 0), a3, voffA);
            PG8_WAIT_V(8); PG8_WAIT_L(0); PG8_BAR; PG8_MMA(1, 0, At, B0); PG8_MMA(1, 1, At, B1); PG8_BAR; PG8_SCHED;
            } else {
            PG8_LDB(B0, 0, 0); PG8_SCHED; PG8_LDA(At, 0, 0); PG8_STAGE(PG8_SA(1, 1), a1 + hstep, voffA);
            PG8_WAIT_L(8); PG8_BAR; PG8_WAIT_L(0); PG8_MMA(0, 0, At, B0); PG8_BAR; PG8_SCHED;
            PG8_LDB(B1, 0, 1); PG8_STAGE(PG8_SB(0, 0), b2, voffB);
            PG8_BAR; PG8_WAIT_L(0); PG8_MMA(0, 1, At, B1); PG8_BAR;
            PG8_LDA(At, 0, 1); PG8_STAGE(PG8_SA(0, 0), a2, voffA);
            PG8_BAR; PG8_WAIT_L(0); PG8_MMA(1, 0, At, B0); PG8_BAR; PG8_SCHED;
            PG8_STAGE(PG8_SB(0, 1), b2 + hstep, voffB);
            PG8_WAIT_V(6); PG8_BAR; PG8_MMA(1, 1, At, B1); PG8_BAR;
            PG8_LDB(B0, 1, 0); PG8_SCHED; PG8_LDA(At, 1, 0); PG8_STAGE(PG8_SA(0, 1), a2 + hstep, voffA);
            PG8_WAIT_L(8); PG8_BAR; PG8_WAIT_L(0); PG8_MMA(0, 0, At, B0); PG8_BAR; PG8_SCHED;
            PG8_LDB(B1, 1, 1); PG8_STAGE(PG8_SB(1, 0), b3, voffB);
            PG8_BAR; PG8_WAIT_L(0); PG8_MMA(0, 1, At, B1); PG8_BAR;
            PG8_LDA(At, 1, 1); PG8_STAGE(PG8_SA(1, 0), a3, voffA);
            PG8_BAR; PG8_WAIT_L(0); PG8_MMA(1, 0, At, B0); PG8_BAR; PG8_SCHED;
            PG8_STAGE(PG8_SB(1, 1), b3 + hstep, voffB);
            PG8_WAIT_V(6); PG8_BAR; PG8_MMA(1, 1, At, B1); PG8_BAR;
            }
        }
        if constexpr (ALIGN_EPI) { if (wr == 0) PG8_BAR; }
        if constexpr (!Epi::AFTER_DRAIN) { E(acc, cur, wr, wc, fr, fq); S.done(cur); }
        if (!has_next) break;
#pragma unroll
        for (int a = 0; a < 2; ++a)
#pragma unroll
            for (int b = 0; b < 2; ++b)
#pragma unroll
                for (int m = 0; m < 4; ++m)
#pragma unroll
                    for (int n = 0; n < 2; ++n) acc[a][b][m][n] = (f32x4){0.f, 0.f, 0.f, 0.f};
        cur = nxt; cA = nA; cB = nB; ++ui;
        if constexpr (ALIGN_EPI) { if (wr == 1) PG8_BAR; }
    }
    PG8_WAIT_V(0);
    if constexpr (!ALIGN_EPI) { if (wr == 0) PG8_BAR; }
    PG8_BAR;
    if constexpr (Epi::AFTER_DRAIN) { E.fused(acc, cur, wr, wc, fr, fq, lds, wid, lane); S.done(cur); }
#undef PG8_SA
#undef PG8_SB
#undef PG8_STAGE
#undef PG8_LDA
#undef PG8_LDB
#undef PG8_MMA
#undef PG8_WAIT_V
#undef PG8_WAIT_L
#undef PG8_BAR
#undef PG8_SCHED
}
}
#define GAS __attribute__((address_space(1)))
#define LAS __attribute__((address_space(3)))
typedef unsigned short bf16;
typedef unsigned v4u __attribute__((ext_vector_type(4)));
typedef unsigned v2u __attribute__((ext_vector_type(2)));
typedef float f32x4 __attribute__((ext_vector_type(4)));
constexpr int NWAVES = 8, NTHR = 512;
constexpr int TT = 8192, DM = 2048, SEQ = 4096;
constexpr int INC = 6592, INCP = 6656;
constexpr int C_AK = 1024, C_AV = 2048, C_RW = 3072;
constexpr int RWC = 3520;
constexpr float RMS_EPS = 1e-6f;
constexpr size_t MiB = 1u << 20;
constexpr size_t WS_CTL = 0, CTL_ZERO_BYTES = 1 * MiB;
constexpr size_t WS_WIN = 1 * MiB;
constexpr size_t WS_WOUT = 27 * MiB;
constexpr size_t WS_WQ = 35 * MiB;
constexpr size_t WS_XN = 43 * MiB;
constexpr size_t WS_PROJ = 75 * MiB;
constexpr size_t WS_AR = 179 * MiB;
constexpr size_t WS_H = 211 * MiB;
constexpr size_t WS_RWA = 275 * MiB;
constexpr size_t WS_CHK = 339 * MiB;
constexpr size_t WS_KMEAN = 467 * MiB;
constexpr size_t WS_ACT = WS_H;
constexpr size_t WS_SSP = WS_WIN + 4 * MiB;
constexpr size_t WS_LORA = 468 * MiB;
constexpr size_t WS_END = 469 * MiB;
constexpr int CW_BAR = 4096, CW_MOBA_CTR = 16384, CW_SS = 32768;
constexpr int RING_BYTES = 147456, LDSCTL_OFF = RING_BYTES, MISC_OFF = LDSCTL_OFF + 320, LDS_BYTES = 163840;

struct Params {
    const float* x; const float* norm1_g; const float* w_in; const float* mu; const float* w0; const float* w2; const float* a0; const float* a2; const float* g2;
    const float* k_k; const float* k_a; const float* r_k; const float* ln_g; const float* ln_b; const float* w_out; const float* norm2_g; const float* wq;
    const float* sub_keys; const float* pu; const float* pv; const float* final_g;
    float* out; unsigned char* ws;
    int ph_lo, ph_hi, bar_li, pad;
};

typedef const __attribute__((address_space(4))) Params& KP;
__device__ __forceinline__ const __attribute__((address_space(4))) Params* params_ptr() {
    const __attribute__((address_space(4))) Params* ka = (const __attribute__((address_space(4))) Params*)__builtin_amdgcn_kernarg_segment_ptr(); asm volatile("" : "+s"(ka)); return ka; }
typedef float f32x2_t __attribute__((ext_vector_type(2))); typedef __bf16 bf16x2_t __attribute__((ext_vector_type(2)));
__device__ __forceinline__ unsigned pk2(float lo, float hi) { const f32x2_t v = {lo, hi}; const bf16x2_t b = __builtin_convertvector(v, bf16x2_t); return __builtin_bit_cast(unsigned, b); }
__device__ __forceinline__ unsigned f2bf(float f) { return pk2(f, 0.f) & 0xffffu; }
__device__ __forceinline__ float bf2f(bf16 v) { return __builtin_bit_cast(float, (unsigned)v << 16); }
__device__ __forceinline__ float bflo(unsigned u) { return __builtin_bit_cast(float, u << 16); }
__device__ __forceinline__ float bfhi(unsigned u) { return __builtin_bit_cast(float, u & 0xffff0000u); }
#define DPP_F(v, ctrl) __builtin_bit_cast(float, __builtin_amdgcn_update_dpp(0, __builtin_bit_cast(int, (v)), (ctrl), 0xf, 0xf, true))
__device__ __forceinline__ float wave_sum(float v) {
    v += DPP_F(v, 0xB1);
    v += DPP_F(v, 0x4E);
    v += DPP_F(v, 0x141);
    v += DPP_F(v, 0x140);
    const int b = __builtin_bit_cast(int, v);
    return (__builtin_bit_cast(float, __builtin_amdgcn_readlane(b, 0)) + __builtin_bit_cast(float, __builtin_amdgcn_readlane(b, 16))) +
           (__builtin_bit_cast(float, __builtin_amdgcn_readlane(b, 32)) + __builtin_bit_cast(float, __builtin_amdgcn_readlane(b, 48)));
}
__device__ __forceinline__ float wave_max(float v) {
#pragma unroll
    for (int o = 1; o < 64; o <<= 1) v = fmaxf(v, __shfl_xor(v, o));
    return v;
}
#define LDS_WAIT() asm volatile("s_waitcnt lgkmcnt(0)" ::: "memory")

__device__ __forceinline__ void p0_transpose_item(const float* W, int K, int N, bf16* WT, LAS float* scr, int item, int lane, const float* ksc = nullptr) {
    const int nblk = N / 32, kb = item / nblk, nb = item % nblk, k0 = 64 * kb, n0 = 32 * nb;
    float wv[32];
#pragma unroll
    for (int i = 0; i < 32; ++i) wv[i] = W[(size_t)(k0 + 2 * i + (lane >> 5)) * N + n0 + (lane & 31)];
#pragma unroll
    for (int i = 0; i < 32; ++i) { const int kk = 2 * i + (lane >> 5); scr[kk * 33 + (lane & 31)] = ksc ? wv[i] * ksc[k0 + kk] : wv[i]; }
    LDS_WAIT(); asm volatile("" ::: "memory");
    const int c = lane & 7;
#pragma unroll
    for (int j = 0; j < 4; ++j) { const int n = (lane >> 3) + 8 * j; const LAS float* s = scr + (8 * c) * 33 + n;
        v4u o; o.x = pk2(s[0 * 33], s[1 * 33]); o.y = pk2(s[2 * 33], s[3 * 33]); o.z = pk2(s[4 * 33], s[5 * 33]); o.w = pk2(s[6 * 33], s[7 * 33]);
        *(v4u*)(WT + (size_t)(n0 + n) * K + k0 + 8 * c) = o; }
    LDS_WAIT(); asm volatile("" ::: "memory");
}
__device__ __forceinline__ void rms_row_to_bf16(const float* xrow, const float* g, bf16* orow, int lane) {
    const f32x4* xr = (const f32x4*)xrow + lane;
    f32x4 v[8]; float s = 0.f;
#pragma unroll
    for (int j = 0; j < 8; ++j) { v[j] = xr[64 * j]; s += (v[j].x * v[j].x + v[j].y * v[j].y) + (v[j].z * v[j].z + v[j].w * v[j].w); }
    const float rs = 1.0f / sqrtf(wave_sum(s) * (1.f / DM) + RMS_EPS);
    v2u* o8 = (v2u*)orow + lane;
#pragma unroll
    for (int j = 0; j < 8; ++j) { const f32x4 gg = ((const f32x4*)g)[lane + 64 * j];
        v2u o; o.x = pk2(v[j].x * rs * gg.x, v[j].y * rs * gg.y); o.y = pk2(v[j].z * rs * gg.z, v[j].w * rs * gg.w); o8[64 * j] = o; }
}
__device__ __forceinline__ void phase_prologue(KP P, LAS unsigned char* lds, int vcu, int G) {
    const int tid = ltid(), lane = tid & 63, wave = tid >> 6;
    LAS float* scr = (LAS float*)(lds + wave * 16384);
    const int gw = vcu * NWAVES + wave, NGW = G * NWAVES;
    bf16* WIN = (bf16*)(P.ws + WS_WIN); bf16* WOUT = (bf16*)(P.ws + WS_WOUT); bf16* WQ = (bf16*)(P.ws + WS_WQ); bf16* XN = (bf16*)(P.ws + WS_XN);
    constexpr int I_IN = (DM / 64) * (INC / 32), I_SQ = (DM / 64) * (DM / 32);
    for (int it = gw; it < I_IN + 2 * I_SQ; it += NGW) {
        int r = it;
        if (r < I_IN) { p0_transpose_item(P.w_in, DM, INC, WIN, scr, r, lane); continue; } r -= I_IN;
        if (r < I_SQ) { p0_transpose_item(P.w_out, DM, DM, WOUT, scr, r, lane); continue; } r -= I_SQ;
        p0_transpose_item(P.wq, DM, DM, WQ, scr, r, lane, P.norm2_g);
    }
    for (int i = vcu * NTHR + tid; i < (INCP - INC) * DM / 8; i += G * NTHR) ((v4u*)(WIN + (size_t)INC * DM))[i] = (v4u){0u, 0u, 0u, 0u};
    for (int m = gw; m < TT; m += NGW) rms_row_to_bf16(P.x + (size_t)m * DM, P.norm1_g, XN + (size_t)m * DM, lane);
}

namespace pg8 {
struct EpiF32 {
    static constexpr bool PERM = false, AFTER_DRAIN = false;
    const float* base; float* out; int ldc;
    __device__ __forceinline__ void operator()(const f32x4 (&acc)[2][2][4][2], const Unit& u, int wr, int wc, int fr, int fq) const {
        const int col0 = u.pn * BM + wc * 32 + 4 * fq;
#pragma unroll
        for (int ai = 0; ai < 2; ++ai)
#pragma unroll
            for (int m = 0; m < 4; ++m) { const int r = ai * HALF + wr * 64 + m * 16 + fr; const size_t off = (size_t)(u.pm * BM + r) * ldc + col0;
#pragma unroll
                for (int bj = 0; bj < 2; ++bj)
#pragma unroll
                    for (int n = 0; n < 2; ++n) { f32x4 o = acc[ai][bj][m][n]; if (base) o = o + *(const f32x4*)(base + off + bj * HALF + n * 16);
                        *(f32x4*)(out + off + bj * HALF + n * 16) = o; } }
    }
};
struct EpiH {
    static constexpr bool PERM = false, AFTER_DRAIN = false;
    const float* base; bf16* outb; float* ss; int ldc;
    __device__ __forceinline__ void operator()(const f32x4 (&acc)[2][2][4][2], const Unit& u, int wr, int wc, int fr, int fq) const {
        const int col0 = u.pn * BM + wc * 32 + 4 * fq;
#pragma unroll
        for (int ai = 0; ai < 2; ++ai) {
            f32x4 xv[4][2][2];
#pragma unroll
            for (int m = 0; m < 4; ++m) { const size_t off = (size_t)(u.pm * BM + ai * HALF + wr * 64 + m * 16 + fr) * ldc + col0;
#pragma unroll
                for (int bj = 0; bj < 2; ++bj)
#pragma unroll
                    for (int n = 0; n < 2; ++n) xv[m][bj][n] = *(const f32x4*)(base + off + bj * HALF + n * 16); }
#pragma unroll
            for (int m = 0; m < 4; ++m) { const int r = ai * HALF + wr * 64 + m * 16 + fr; const size_t off = (size_t)(u.pm * BM + r) * ldc + col0; float sq = 0.f;
#pragma unroll
                for (int bj = 0; bj < 2; ++bj)
#pragma unroll
                    for (int n = 0; n < 2; ++n) { const f32x4 o = acc[ai][bj][m][n] + xv[m][bj][n];
                        *(v2u*)(outb + off + bj * HALF + n * 16) = (v2u){pk2(o.x, o.y), pk2(o.z, o.w)};
                        sq += (o.x * o.x + o.y * o.y) + (o.z * o.z + o.w * o.w); }
                sq += __shfl_xor(sq, 16); sq += __shfl_xor(sq, 32);
                if (fq == 0) ss[(size_t)(u.pm * BM + r) * 32 + u.pn * 4 + wc] = sq; }
        }
    }
};
struct EpiBf16Row {
    static constexpr bool PERM = true, AFTER_DRAIN = false;
    bf16_t* O; int ldc; const float* rs;
    __device__ __forceinline__ void operator()(const f32x4 (&acc)[2][2][4][2], const Unit& u, int wr, int wc, int fr, int fq) const {
        const int row0 = u.pm * BM + wr * 64 + fr, col0 = u.pn * BM + wc * 32 + 8 * fq;
        float scv[2][4];
#pragma unroll
        for (int ai = 0; ai < 2; ++ai)
#pragma unroll
            for (int m = 0; m < 4; ++m) scv[ai][m] = rs[row0 + ai * HALF + m * 16];
#pragma unroll
        for (int ai = 0; ai < 2; ++ai)
#pragma unroll
            for (int m = 0; m < 4; ++m) { const int row = row0 + ai * HALF + m * 16; const float sc = scv[ai][m]; bf16_t* rowp = O + (size_t)row * ldc + col0;
#pragma unroll
                for (int bj = 0; bj < 2; ++bj) { const f32x4 v0 = acc[ai][bj][m][0] * sc, v1 = acc[ai][bj][m][1] * sc;
                    u32x4 w; w.x = cvt_pk_bf16(v0[0], v0[1]); w.y = cvt_pk_bf16(v0[2], v0[3]); w.z = cvt_pk_bf16(v1[0], v1[1]); w.w = cvt_pk_bf16(v1[2], v1[3]);
                    *(u32x4*)(rowp + bj * HALF) = w; } }
    }
};
struct Order1 {
    StaticOrder s; bool split; int c;
    __device__ void init(int M, int N, int G_, int c_) { s.init(M, N, G_, c_); split = (G_ == 256 && M == 8192 && N == 6656); c = c_; }
    __device__ bool next(int i, Unit& u) const {
        if (!split) return s.next(i, u);
        if (c >= 208 || i >= 4) return false;
        const int x = c & 7, j = c >> 3; u.pm = 4 * x + 2 * (i >> 1) + (j & 1); u.pn = 13 * (i & 1) + (j >> 1); return true; }
    __device__ __forceinline__ void a_ready(const Unit&) const {}
    __device__ __forceinline__ void done(const Unit&) const {}
};
}

__device__ __forceinline__ void phase_rstd(KP P, int vcu, int G) {
    const float* ssp = (const float*)(P.ws + WS_SSP); float* rstd = (float*)(P.ws + WS_SSP + 2 * MiB);
    for (int row = vcu * NTHR + ltid(); row < TT; row += G * NTHR) { const f32x4* sp = (const f32x4*)(ssp + (size_t)row * 32); float a = 0.f;
#pragma unroll
        for (int j = 0; j < 8; ++j) { const f32x4 v = sp[j]; a += (v.x + v.y) + (v.z + v.w); }
        rstd[row] = 1.0f / sqrtf(a * (1.f / DM) + RMS_EPS); }
}
__device__ __forceinline__ void phase_kmean(KP P, LAS unsigned char* lds, int vcu, int G) {
    const int tid = ltid(); const bf16* proj = (const bf16*)(P.ws + WS_PROJ); float* kmean = (float*)(P.ws + WS_KMEAN);
    LAS float* red = (LAS float*)lds;
    for (int item = vcu; item < 32 * 8; item += G) {
        const int bb = item >> 3, cg = item & 7;
        const int c = tid & 127, rq = tid >> 7;
        const bf16* p = proj + (size_t)(bb * 256 + rq * 64) * INCP + C_AK + cg * 128 + c;
        float s = 0.f;
        for (int r = 0; r < 64; ++r) s += bf2f(p[(size_t)r * INCP]);
        red[rq * 128 + c] = s;
        __syncthreads();
        if (tid < 128) kmean[(size_t)bb * 1024 + cg * 128 + tid] = (red[tid] + red[128 + tid] + red[256 + tid] + red[384 + tid]) * (1.f / 256.f);
        __syncthreads();
    }
}

typedef short bf16x8 __attribute__((ext_vector_type(8)));
typedef float f32x16 __attribute__((ext_vector_type(16)));
constexpr int CP = 72;
constexpr int MATB = 64 * CP * 2;
enum { M_AT = 0, M_BT = 1, M_KT = 2, M_RT = 3, M_VT = 4, M_BBT = 5, M_KBT = 6, M_LAK = 7, M_MRB = 8, M_MRK = 9, M_LAB = 10, M_AHT = 0, M_U0T = 1 };
constexpr int L_RHS = 11 * MATB;
constexpr int L_MISC = L_RHS + 32768;
constexpr int L_TB = L_MISC + 9 * 64 * 4;
constexpr int L_A_END = L_TB + 2048;
static_assert(L_A_END <= RING_BYTES, "stage A LDS");
constexpr size_t CHK_ITEM = 6 * 8192;

__device__ __forceinline__ f32x16 mm_tile(const LAS unsigned char* A, int ra, const LAS unsigned char* B, int rb, f32x16 acc, int lane, int k0 = 0, int k1 = 4) {
    const int r = lane & 31, hi = lane >> 5;
    const LAS unsigned char* ap = A + ((ra * 32 + r) * CP + 8 * hi) * 2; const LAS unsigned char* bp = B + ((rb * 32 + r) * CP + 8 * hi) * 2;
#pragma unroll
    for (int kk = 0; kk < 4; ++kk) if (kk >= k0 && kk < k1) {
        const bf16x8 a = *(const LAS bf16x8*)(ap + kk * 32), b = *(const LAS bf16x8*)(bp + kk * 32);
        acc = __builtin_amdgcn_mfma_f32_32x32x16_bf16(a, b, acc, 0, 0, 0); }
    return acc;
}
__device__ __forceinline__ int crow32(int reg, int hi) { return (reg & 3) + 8 * (reg >> 2) + 4 * hi; }

__device__ __forceinline__ void prologue_lora(KP P, int vcu, int G) {
    bf16* w2T = (bf16*)(P.ws + WS_LORA); bf16* a2T = w2T + 1024 * 96; bf16* g2T = a2T + 1024 * 96;
    for (int e = vcu * NTHR + ltid(); e < 448 * 1024; e += G * NTHR) { const int i = e >> 10, n = e & 1023;
        if (i < 96) w2T[n * 96 + i] = (bf16)f2bf(P.w2[e]); else if (i < 192) a2T[n * 96 + (i - 96)] = (bf16)f2bf(P.a2[e - 96 * 1024]); else g2T[n * 256 + (i - 192)] = (bf16)f2bf(P.g2[e - 192 * 1024]); }
}
__device__ __forceinline__ void phase_act(KP P, int vcu, int G) {
    const bf16* proj = (const bf16*)(P.ws + WS_PROJ); unsigned* act = (unsigned*)(P.ws + WS_ACT);
    for (int e = vcu * NTHR + ltid(); e < TT * 224; e += G * NTHR) { const int t = e / 224, cp = e - t * 224, cc = 2 * cp;
        const bf16* pr = proj + (size_t)t * INCP + C_RW + 3072 + cc;
        const unsigned cu = *(const unsigned*)pr; const unsigned pu = (t & (SEQ - 1)) == 0 ? 0u : *(const unsigned*)(pr - INCP);
        const float m0 = P.mu[3072 + cc], m1 = P.mu[3072 + cc + 1];
        float v0 = bflo(cu) + (bflo(pu) - bflo(cu)) * m0, v1 = bfhi(cu) + (bfhi(pu) - bfhi(cu)) * m1;
        if (cc < 96) { v0 = tanhf(v0); v1 = tanhf(v1); } else if (cc >= 192) { v0 = 1.f / (1.f + __expf(-v0)); v1 = 1.f / (1.f + __expf(-v1)); }
        act[e] = pk2(v0, v1); }
}
constexpr int ACTP = 456;
constexpr int L_WAG = 58368;
static_assert(L_WAG + 3 * 16384 <= L_MISC, "lora scratch fits below misc");
struct LoraFrags { bf16x8 f[16]; f32x4 w0[4], a0[4]; float mu_r, mu_k, mu_v, kkc, kac, rkc, lng, lnb; };
__device__ __forceinline__ LoraFrags lora_frags_load(KP P, int h, int wave, int lane) {
    const int c32 = lane & 31, hi = lane >> 5, nb = (wave & 3) >> 1; const int nrow = h * 64 + nb * 32 + c32;
    const bf16* w2T = (const bf16*)(P.ws + WS_LORA); const bf16* a2T = w2T + 1024 * 96; const bf16* g2T = a2T + 1024 * 96;
    const bf16* wp = w2T + (size_t)nrow * 96 + 8 * hi; const bf16* ap = a2T + (size_t)nrow * 96 + 8 * hi; const bf16* gp = g2T + (size_t)nrow * 256 + 8 * hi;
    LoraFrags W;
#pragma unroll
    for (int kk = 0; kk < 16; ++kk) { const bf16* src = wave < 4 ? (kk < 6 ? wp + 16 * kk : ap + 16 * ((kk - 6) % 6)) : gp + 16 * kk; W.f[kk] = *(const bf16x8*)src; }
#pragma unroll
    for (int g = 0; g < 4; ++g) { const int n0 = h * 64 + nb * 32 + 8 * g + 4 * hi; W.w0[g] = *(const f32x4*)(P.w0 + n0); W.a0[g] = *(const f32x4*)(P.a0 + n0); }
    const int col = h * 64 + lane;
    W.mu_r = P.mu[col]; W.mu_k = P.mu[1024 + col]; W.mu_v = P.mu[2048 + col]; W.kkc = P.k_k[col]; W.kac = P.k_a[col]; W.rkc = P.r_k[col]; W.lng = P.ln_g[col]; W.lnb = P.ln_b[col];
    return W;
}
__device__ __forceinline__ void rwkv_stage_a(KP P, LAS unsigned char* lds, int item, const LoraFrags& W) {
    const int tid = ltid(), lane = tid & 63, wave = __builtin_amdgcn_readfirstlane(tid >> 6);
    const int b = item >> 10, h = (item >> 6) & 15, c = item & 63;
    const int tok0 = b * SEQ + c * 64;
    const bf16* proj = (const bf16*)(P.ws + WS_PROJ);
    unsigned char* chk = P.ws + WS_CHK + (size_t)((item & 63) * 32 + (item >> 6)) * CHK_ITEM;
    LAS float* misc = (LAS float*)(lds + L_MISC);
    { const bf16* actg = (const bf16*)(P.ws + WS_ACT) + (size_t)tok0 * 448;
#pragma unroll
      for (int e = tid; e < 64 * 56; e += NTHR) { const int row = e / 56, ch = e - row * 56; *(LAS v4u*)(lds + (row * ACTP + ch * 8) * 2) = *(const v4u*)(actg + (size_t)row * 448 + ch * 8); } }
    __syncthreads();
    {
        const int c32 = lane & 31, hi = lane >> 5, qd = wave & 3, nb = qd >> 1, tb = qd & 1;
        const LAS unsigned char* actp = lds + ((tb * 32 + c32) * ACTP + 8 * hi) * 2;
        LAS float* wag = (LAS float*)(lds + L_WAG) + (tb * 32 + c32) * 64 + nb * 32;
        if (wave < 4) {
            f32x16 aw = {}, aa = {};
#pragma unroll
            for (int kk = 0; kk < 6; ++kk) {
                aw = __builtin_amdgcn_mfma_f32_32x32x16_bf16(W.f[kk], *(const LAS bf16x8*)(actp + (16 * kk) * 2), aw, 0, 0, 0);
                aa = __builtin_amdgcn_mfma_f32_32x32x16_bf16(W.f[6 + kk], *(const LAS bf16x8*)(actp + (96 + 16 * kk) * 2), aa, 0, 0, 0); }
#pragma unroll
            for (int g = 0; g < 4; ++g) { const int n0 = h * 64 + nb * 32 + 8 * g + 4 * hi;
                const f32x4 w0 = W.w0[g], a0 = W.a0[g]; f32x4 ow, oa;
#pragma unroll
                for (int e = 0; e < 4; ++e) { const float xx = w0[e] + aw[4 * g + e];
                    ow[e] = __expf(-0.6065306597126334f * __builtin_amdgcn_rcpf(1.f + __expf(-xx))); oa[e] = __builtin_amdgcn_rcpf(1.f + __expf(-(a0[e] + aa[4 * g + e]))); }
                *(LAS f32x4*)(wag + 8 * g + 4 * hi) = ow; *(LAS f32x4*)(wag + 4096 + 8 * g + 4 * hi) = oa; }
        } else {
            f32x16 ag = {};
#pragma unroll
            for (int kk = 0; kk < 16; ++kk) ag = __builtin_amdgcn_mfma_f32_32x32x16_bf16(W.f[kk], *(const LAS bf16x8*)(actp + (192 + 16 * kk) * 2), ag, 0, 0, 0);
#pragma unroll
            for (int g = 0; g < 4; ++g) *(LAS f32x4*)(wag + 8192 + 8 * g + 4 * hi) = (f32x4){ag[4 * g], ag[4 * g + 1], ag[4 * g + 2], ag[4 * g + 3]};
        }
    }
    __syncthreads();
    {
        const int n = lane, tg = wave, col = h * 64 + n;
        const float mu_r = W.mu_r, mu_k = W.mu_k, mu_v = W.mu_v, kkc = W.kkc, kac = W.kac, rkc = W.rkc, lng = W.lng, lnb = W.lnb;
        float rr[8], kr[8], vv[8], ww[8], aa[8], gg[8], kk[8];
        const int tfirst = tok0 + 8 * tg;
        const bf16* pp = proj + (size_t)tfirst * INCP + C_RW + col;
        float pr, pk, pvv;
        if (c == 0 && tg == 0) { pr = 0.f; pk = 0.f; pvv = 0.f; } else { pr = bf2f(pp[-(long)INCP]); pk = bf2f(pp[-(long)INCP + 1024]); pvv = bf2f(pp[-(long)INCP + 2048]); }
        const LAS float* wagr = (const LAS float*)(lds + L_WAG) + (8 * tg) * 64 + n;
#pragma unroll
        for (int q = 0; q < 8; ++q) { const float cr = bf2f(pp[(size_t)q * INCP]), ck = bf2f(pp[(size_t)q * INCP + 1024]), cv = bf2f(pp[(size_t)q * INCP + 2048]);
            rr[q] = cr + (pr - cr) * mu_r; kr[q] = ck + (pk - ck) * mu_k; vv[q] = cv + (pvv - cv) * mu_v; pr = cr; pk = ck; pvv = cv;
            ww[q] = wagr[q * 64]; aa[q] = wagr[4096 + q * 64]; gg[q] = wagr[8192 + q * 64]; }
        float lam[8]; float run = 1.f;
#pragma unroll
        for (int q = 0; q < 8; ++q) { run *= ww[q]; lam[q] = run; }
        misc[tg * 64 + n] = run;
#pragma unroll
        for (int q = 0; q < 8; ++q) { const float kkv = kr[q] * kkc; const float ss = wave_sum(kkv * kkv); kk[q] = kkv * __builtin_amdgcn_rsqf(fmaxf(ss, 1e-24f));
            kr[q] = kr[q] * (1.f + (aa[q] - 1.f) * kac); }
        __syncthreads();
        float pre = 1.f, tot = 1.f;
#pragma unroll
        for (int g = 0; g < 8; ++g) { const float sgt = misc[g * 64 + n]; if (g < tg) pre *= sgt; tot *= sgt; }
        if (tg == 0) misc[512 + n] = tot;
        unsigned vt[4], bbt[4], kbt[4];
        LAS bf16* At = (LAS bf16*)(lds + M_AT * MATB); LAS bf16* Bt = (LAS bf16*)(lds + M_BT * MATB); LAS bf16* Kt = (LAS bf16*)(lds + M_KT * MATB); LAS bf16* Rt = (LAS bf16*)(lds + M_RT * MATB);
        float hbb = 0.f, hkb = 0.f, hv = 0.f;
#pragma unroll
        for (int q = 0; q < 8; ++q) { const int t = 8 * tg + q;
            const float L = pre * lam[q], Lp = q == 0 ? pre : pre * lam[q - 1], iL = __builtin_amdgcn_rcpf(L), rel = tot * iL;
            const float bq = kk[q] * aa[q];
            ((LAS float*)(lds + L_RHS))[t * 128 + 64 + n] = -kk[q] * Lp;
            At[t * CP + n] = (bf16)f2bf(-kk[q] * Lp); Bt[t * CP + n] = (bf16)f2bf(bq * iL); Kt[t * CP + n] = (bf16)f2bf(kr[q] * iL); Rt[t * CP + n] = (bf16)f2bf(rr[q] * L);
            const float bb = bq * rel, kb = kr[q] * rel;
            if (q & 1) { vt[q >> 1] = pk2(hv, vv[q]); bbt[q >> 1] = pk2(hbb, bb); kbt[q >> 1] = pk2(hkb, kb); } else { hv = vv[q]; hbb = bb; hkb = kb; }
            const float bs = wave_sum(rr[q] * kr[q] * rkc);
            const int pl = t * 64 + ((n >> 2) & 3) * 16 + (n >> 4) * 4 + (n & 3);
            ((bf16*)(chk + 4 * 8192))[pl] = (bf16)f2bf(lng * gg[q]);
            ((bf16*)(chk + 5 * 8192))[pl] = (bf16)f2bf((lnb + bs * vv[q]) * gg[q]); }
        *(LAS v4u*)(lds + M_VT * MATB + (n * CP + 8 * tg) * 2) = (v4u){vt[0], vt[1], vt[2], vt[3]};
        *(LAS v4u*)(lds + M_BBT * MATB + (n * CP + 8 * tg) * 2) = (v4u){bbt[0], bbt[1], bbt[2], bbt[3]};
        *(LAS v4u*)(lds + M_KBT * MATB + (n * CP + 8 * tg) * 2) = (v4u){kbt[0], kbt[1], kbt[2], kbt[3]};
    }
    __syncthreads();
    const int c32 = lane & 31, hi = lane >> 5;
    {
        const int prod = wave >> 1;
#pragma unroll
        for (int qi = 0; qi < 2; ++qi) {
            const int tb = (wave & 1) ? (qi == 0 ? 1 : 0) : qi, sb = (wave & 1) ? 1 : 0; const bool zero = (tb == 0 && sb == 1);
            f32x16 acc = {};
            const int xa = (prod == 0 || prod == 2) ? M_BT : M_KT, ya = prod < 2 ? M_AT : M_RT, dm = prod == 0 ? M_LAB : (prod == 1 ? M_LAK : (prod == 2 ? M_MRB : M_MRK));
            if (!zero) acc = mm_tile(lds + xa * MATB, sb, lds + ya * MATB, tb, acc, lane);
            const int t = tb * 32 + c32; LAS unsigned char* dst = lds + dm * MATB + (t * CP + sb * 32) * 2;
#pragma unroll
            for (int g = 0; g < 4; ++g) { float o[4];
#pragma unroll
                for (int e = 0; e < 4; ++e) { const int s = sb * 32 + 8 * g + 4 * hi + e; const bool keep = prod < 2 ? (s < t) : (s <= t); o[e] = keep ? acc[4 * g + e] : 0.f; }
                *(LAS v2u*)(dst + (8 * g + 4 * hi) * 2) = (v2u){pk2(o[0], o[1]), pk2(o[2], o[3])}; }
        }
    }
    __syncthreads();
    if (wave < 4) {
        const int ib = wave >> 1, tb = wave & 1; f32x16 acc = {};
        acc = mm_tile(lds + M_VT * MATB, ib, lds + M_LAK * MATB, tb, acc, lane, 0, tb == 0 ? 2 : 4);
        const int t = tb * 32 + c32; LAS float* dst = (LAS float*)(lds + L_RHS) + t * 128 + ib * 32;
#pragma unroll
        for (int g = 0; g < 4; ++g) *(LAS f32x4*)(dst + 8 * g + 4 * hi) = (f32x4){acc[4 * g], acc[4 * g + 1], acc[4 * g + 2], acc[4 * g + 3]};
    } else if (wave == 4) {
        const int bb = lane >> 4, col = lane & 15;
        float x[16];
#pragma unroll
        for (int t = 0; t < 16; ++t) x[t] = t == col ? 1.f : 0.f;
#pragma unroll
        for (int t = 1; t < 16; ++t) { const LAS unsigned char* rp = lds + M_LAB * MATB + ((16 * bb + t) * CP + 16 * bb) * 2; const v4u ra = *(const LAS v4u*)rp, rb = *(const LAS v4u*)(rp + 16);
            float lrow[16];
#pragma unroll
            for (int q = 0; q < 4; ++q) { lrow[2 * q] = bflo(ra[q]); lrow[2 * q + 1] = bfhi(ra[q]); lrow[8 + 2 * q] = bflo(rb[q]); lrow[8 + 2 * q + 1] = bfhi(rb[q]); }
#pragma unroll
            for (int s = 0; s < t; ++s) x[t] += lrow[s] * x[s]; }
        LAS bf16* T = (LAS bf16*)(lds + L_TB) + bb * 256 + col;
#pragma unroll
        for (int t = 0; t < 16; ++t) T[t * 16] = (bf16)f2bf(x[t]);
    }
    __syncthreads();
    {
        typedef short s16x4 __attribute__((ext_vector_type(4)));
        const int l15 = lane & 15, q4 = lane >> 4;
        LAS unsigned char* xt = lds + (wave < 4 ? M_U0T : M_AHT) * MATB + ((16 * (wave & 3) + l15) * CP) * 2;
        *(LAS v4u*)(xt + q4 * 32) = (v4u){0u, 0u, 0u, 0u}; *(LAS v4u*)(xt + q4 * 32 + 16) = (v4u){0u, 0u, 0u, 0u};
        const LAS float* Xf = (const LAS float*)(lds + L_RHS) + 16 * wave + l15;
#pragma unroll
        for (int bq = 0; bq < 4; ++bq) {
            f32x4 acc;
#pragma unroll
            for (int e = 0; e < 4; ++e) acc[e] = Xf[(16 * bq + 4 * q4 + e) * 128];
#pragma unroll
            for (int kk = 0; kk < (bq + 1) / 2; ++kk) {
                const bf16x8 a = *(const LAS bf16x8*)(lds + M_LAB * MATB + ((16 * bq + l15) * CP + 32 * kk + 8 * q4) * 2);
                const bf16x8 xb = *(const LAS bf16x8*)(xt + (32 * kk + 8 * q4) * 2);
                acc = __builtin_amdgcn_mfma_f32_16x16x32_bf16(a, xb, acc, 0, 0, 0); }
            const v2u tf = *(const LAS v2u*)(lds + L_TB + (bq * 256 + l15 * 16 + 4 * q4) * 2);
            const v2u ab = (v2u){pk2(acc[0], acc[1]), pk2(acc[2], acc[3])};
            const f32x4 z = {0.f, 0.f, 0.f, 0.f};
            const f32x4 xn = __builtin_amdgcn_mfma_f32_16x16x16bf16_1k(__builtin_bit_cast(s16x4, tf), __builtin_bit_cast(s16x4, ab), z, 0, 0, 0);
            *(LAS v2u*)(xt + (16 * bq + 4 * q4) * 2) = (v2u){pk2(xn[0], xn[1]), pk2(xn[2], xn[3])};
        }
    }
    __syncthreads();
    {
        const int qd = wave & 3, yb = qd >> 1, xb = qd & 1;
        f32x16 acc1 = {}, acc2 = {};
        if (wave < 4) {
            acc1 = mm_tile(lds + M_AHT * MATB, yb, lds + M_BBT * MATB, xb, acc1, lane);
            acc2 = mm_tile(lds + M_BBT * MATB, yb, lds + M_U0T * MATB, xb, acc2, lane);
            acc2 = mm_tile(lds + M_KBT * MATB, yb, lds + M_VT * MATB, xb, acc2, lane);
            const int x = xb * 32 + c32; const float lc = misc[512 + x];
            bf16* o1 = (bf16*)(chk + 0 * 8192) + x * 64 + yb * 32; bf16* o2 = (bf16*)(chk + 1 * 8192) + x * 64 + yb * 32;
#pragma unroll
            for (int g = 0; g < 4; ++g) { float p[4];
#pragma unroll
                for (int e = 0; e < 4; ++e) { const int y = yb * 32 + 8 * g + 4 * hi + e; p[e] = acc1[4 * g + e] + (y == x ? lc : 0.f); }
                *(v2u*)(o1 + 8 * g + 4 * hi) = (v2u){pk2(p[0], p[1]), pk2(p[2], p[3])};
                *(v2u*)(o2 + 8 * g + 4 * hi) = (v2u){pk2(acc2[4 * g], acc2[4 * g + 1]), pk2(acc2[4 * g + 2], acc2[4 * g + 3])}; }
        } else {
            acc1 = mm_tile(lds + M_AHT * MATB, yb, lds + M_MRB * MATB, xb, acc1, lane);
            acc2 = mm_tile(lds + M_U0T * MATB, yb, lds + M_MRB * MATB, xb, acc2, lane);
            acc2 = mm_tile(lds + M_VT * MATB, yb, lds + M_MRK * MATB, xb, acc2, lane);
            const int x = xb * 32 + c32;
            bf16* o1 = (bf16*)(chk + 2 * 8192) + x * 64 + yb * 32; bf16* o2 = (bf16*)(chk + 3 * 8192) + x * 64;
            const LAS bf16* Rt = (const LAS bf16*)(lds + M_RT * MATB) + x * CP + yb * 32;
#pragma unroll
            for (int g = 0; g < 4; ++g) { float p[4];
#pragma unroll
                for (int e = 0; e < 4; ++e) p[e] = acc1[4 * g + e] + bf2f(Rt[8 * g + 4 * hi + e]);
                *(v2u*)(o1 + 8 * g + 4 * hi) = (v2u){pk2(p[0], p[1]), pk2(p[2], p[3])};
                *(v2u*)(o2 + ((2 * g + hi) & 3) * 16 + (2 * yb + (g >> 1)) * 4) = (v2u){pk2(acc2[4 * g], acc2[4 * g + 1]), pk2(acc2[4 * g + 2], acc2[4 * g + 3])}; }
        }
    }
    __syncthreads();
}

__device__ __forceinline__ void phase_rwkv_stage_a(KP P, LAS unsigned char* lds, int vcu, int G) {
    const int tid = ltid(), lane = tid & 63, wave = __builtin_amdgcn_readfirstlane(tid >> 6);
    int cur_bh = (vcu & 255) >> 3; LoraFrags W = lora_frags_load(P, cur_bh & 15, wave, lane);
    for (int k = vcu; k < 2048; k += G) { const int bh = (k & 255) >> 3, c = (k & 7) + 8 * (k >> 8);
        if (bh != cur_bh) { W = lora_frags_load(P, bh & 15, wave, lane); cur_bh = bh; }
        rwkv_stage_a(P, lds, bh * 64 + c, W); }
}
typedef float f32x4v __attribute__((ext_vector_type(4)));
struct YSet { bf16x8 b0, b1; v4u y0[2], g1[2], g2[2]; };
struct SSet { bf16x8 p0[1], p1[1]; v2u q[4]; };
__device__ __forceinline__ void rwkv_stage_b(KP P, LAS unsigned char* lds, int bh) {
    const int tid = ltid(), lane = tid & 63, wave = __builtin_amdgcn_readfirstlane(tid >> 6);
    const int b = bh >> 4, h = bh & 15; const int l15 = lane & 15, q4 = lane >> 4;
    bf16* AR = (bf16*)(P.ws + WS_AR);
    for (int u = tid; u < 2 * MATB / 4; u += NTHR) ((LAS unsigned*)lds)[u] = 0u;
    __syncthreads();
    const int w4 = wave & 3;
    const unsigned char* chk0 = P.ws + WS_CHK + (size_t)bh * CHK_ITEM;
    if (wave < 4) {
        const int t = 16 * w4 + l15;
        YSet ys[4];
#define YLOAD(S_, c_) do { const unsigned char* chk = chk0 + (size_t)(c_) * (32 * CHK_ITEM); const bf16* rh = (const bf16*)(chk + 2 * 8192) + t * 64 + 8 * q4; S_.b0 = *(const bf16x8*)rh; S_.b1 = *(const bf16x8*)(rh + 32); \
        const bf16* y0 = (const bf16*)(chk + 3 * 8192) + t * 64 + 16 * q4; \
        S_.y0[0] = *(const v4u*)y0; S_.y0[1] = *(const v4u*)(y0 + 8); S_.g1[0] = *(const v4u*)(y0 + 4096); S_.g1[1] = *(const v4u*)(y0 + 4096 + 8); S_.g2[0] = *(const v4u*)(y0 + 8192); S_.g2[1] = *(const v4u*)(y0 + 8192 + 8); } while (0)
#define YV(A_, it_, w_) ((A_)[(it_) >> 1][2 * ((it_) & 1) + (w_)])
#pragma unroll
        for (int u = 0; u < 4; ++u) YLOAD(ys[u], u);
        for (int c0 = 0; c0 < 64; c0 += 4) {
#pragma unroll
            for (int u = 0; u < 4; ++u) { const int c = c0 + u;
                const LAS unsigned char* Scur = lds + (c & 1) * MATB;
                f32x4v acc[4];
#pragma unroll
                for (int it = 0; it < 4; ++it) { acc[it] = (f32x4v){bflo(YV(ys[u].y0, it, 0)), bfhi(YV(ys[u].y0, it, 0)), bflo(YV(ys[u].y0, it, 1)), bfhi(YV(ys[u].y0, it, 1))};
                    const LAS unsigned char* sp = Scur + ((16 * it + l15) * CP + 8 * q4) * 2;
                    acc[it] = __builtin_amdgcn_mfma_f32_16x16x32_bf16(*(const LAS bf16x8*)sp, ys[u].b0, acc[it], 0, 0, 0);
                    acc[it] = __builtin_amdgcn_mfma_f32_16x16x32_bf16(*(const LAS bf16x8*)(sp + 64), ys[u].b1, acc[it], 0, 0, 0); }
                float s = 0.f;
#pragma unroll
                for (int it = 0; it < 4; ++it) s += (acc[it].x + acc[it].y) + (acc[it].z + acc[it].w);
                s += __shfl_xor(s, 16); s += __shfl_xor(s, 32);
                const float mean = s * (1.f / 64.f); float v = 0.f;
#pragma unroll
                for (int it = 0; it < 4; ++it) { acc[it] = acc[it] - mean; v += (acc[it].x * acc[it].x + acc[it].y * acc[it].y) + (acc[it].z * acc[it].z + acc[it].w * acc[it].w); }
                v += __shfl_xor(v, 16); v += __shfl_xor(v, 32);
                const float rstd = 1.0f / sqrtf(v * (1.f / 64.f) + 64e-5f);
                bf16* orow = AR + (size_t)(b * SEQ + c * 64 + t) * DM + 1024 + h * 64 + 4 * q4;
#pragma unroll
                for (int it = 0; it < 4; ++it) {
                    const float o0 = acc[it].x * rstd * bflo(YV(ys[u].g1, it, 0)) + bflo(YV(ys[u].g2, it, 0)), o1 = acc[it].y * rstd * bfhi(YV(ys[u].g1, it, 0)) + bfhi(YV(ys[u].g2, it, 0));
                    const float o2 = acc[it].z * rstd * bflo(YV(ys[u].g1, it, 1)) + bflo(YV(ys[u].g2, it, 1)), o3 = acc[it].w * rstd * bfhi(YV(ys[u].g1, it, 1)) + bfhi(YV(ys[u].g2, it, 1));
                    *(v2u*)(orow + 16 * it) = (v2u){pk2(o0, o1), pk2(o2, o3)}; }
                if (c + 4 < 64) YLOAD(ys[u], c + 4);
                __syncthreads();
            }
        }
#undef YLOAD
#undef YV
    } else {
        const int nrow = 16 * w4 + l15;
        SSet ss[4];
#define SLOADX(S_, c_) do { const unsigned char* chk = chk0 + (size_t)(c_) * (32 * CHK_ITEM); const bf16* pt = (const bf16*)chk + nrow * 64 + 8 * q4; S_.p0[0] = *(const bf16x8*)pt; S_.p1[0] = *(const bf16x8*)(pt + 32); \
        const bf16* q = (const bf16*)(chk + 1 * 8192) + l15 * 64 + 16 * w4 + 4 * q4; \
        _Pragma("unroll") for (int it = 0; it < 4; ++it) S_.q[it] = *(const v2u*)(q + 16 * it * 64); } while (0)
#pragma unroll
        for (int u = 0; u < 4; ++u) SLOADX(ss[u], u);
        for (int c0 = 0; c0 < 64; c0 += 4) {
#pragma unroll
            for (int u = 0; u < 4; ++u) { const int c = c0 + u;
                const LAS unsigned char* Scur = lds + (c & 1) * MATB; LAS unsigned char* Snxt = lds + ((c & 1) ^ 1) * MATB;
#pragma unroll
                for (int it = 0; it < 4; ++it) { const int i = 16 * it + l15;
                    const LAS unsigned char* sp = Scur + (i * CP + 8 * q4) * 2; const bf16x8 s0 = *(const LAS bf16x8*)sp, s1 = *(const LAS bf16x8*)(sp + 64);
                    f32x4v acc = (f32x4v){bflo(ss[u].q[it].x), bfhi(ss[u].q[it].x), bflo(ss[u].q[it].y), bfhi(ss[u].q[it].y)};
                    acc = __builtin_amdgcn_mfma_f32_16x16x32_bf16(ss[u].p0[0], s0, acc, 0, 0, 0);
                    acc = __builtin_amdgcn_mfma_f32_16x16x32_bf16(ss[u].p1[0], s1, acc, 0, 0, 0);
                    *(LAS v2u*)(Snxt + (i * CP + 16 * w4 + 4 * q4) * 2) = (v2u){pk2(acc.x, acc.y), pk2(acc.z, acc.w)}; }
                if (c + 4 < 64) SLOADX(ss[u], c + 4);
                __syncthreads();
            }
        }
#undef SLOADX
    }
}

constexpr size_t WS_UB = WS_RWA;
constexpr size_t WS_VB = WS_RWA + 32 * MiB;
constexpr float U_SCALE = 512.f, V_SCALE = 32.f;
constexpr int SLICE_BYTES = 16384 * 128;
typedef float f32x2 __attribute__((ext_vector_type(2)));
__device__ __forceinline__ void phase_convert_tables(KP P, LAS unsigned char* lds) {
    const int tid = ltid(); constexpr int N16 = 16384 * 2048 / 16, GPT = 4, CH = GPT * NTHR, NCH = 2 * N16 / CH;
    unsigned* ctr = (unsigned*)(P.ws + WS_CTL) + CW_MOBA_CTR; LAS int* slot = (LAS int*)lds;
    const int q = tid & 127;
    f32x4 gu[4];
#pragma unroll
    for (int m = 0; m < 4; ++m) gu[m] = *(const f32x4*)(P.norm2_g + 16 * q + 4 * m) * U_SCALE;
    __syncthreads();
    if (tid == 0) slot[0] = (int)__hip_atomic_fetch_add(ctr, 1u, __ATOMIC_RELAXED, __HIP_MEMORY_SCOPE_AGENT);
    __syncthreads();
    for (int it = 0;; ++it) {
        const int c = slot[it & 1]; if (c >= NCH) break;
        if (tid == 0) slot[(it & 1) ^ 1] = (int)__hip_atomic_fetch_add(ctr, 1u, __ATOMIC_RELAXED, __HIP_MEMORY_SCOPE_AGENT);
        const bool isv = c >= NCH / 2;
        const int j0 = (isv ? c - NCH / 2 : c) * CH + tid;
        const float* src = (isv ? P.pv : P.pu) + (size_t)j0 * 16;
        unsigned char* dst = P.ws + (isv ? WS_VB : WS_UB) + (size_t)(q >> 3) * SLICE_BYTES + (size_t)(j0 >> 7) * 128 + (q & 7) * 16;
        f32x4 sc[4];
#pragma unroll
        for (int m = 0; m < 4; ++m) sc[m] = isv ? (f32x4){V_SCALE, V_SCALE, V_SCALE, V_SCALE} : gu[m];
#pragma unroll
        for (int hb = 0; hb < 1; ++hb) {
            f32x4 a[4][4];
#pragma unroll
            for (int k = 0; k < 4; ++k)
#pragma unroll
                for (int m = 0; m < 4; ++m) a[k][m] = *(const f32x4*)(src + (size_t)(4 * hb + k) * (NTHR * 16) + 4 * m);
#pragma unroll
            for (int k = 0; k < 4; ++k) { v4u o;
#pragma unroll
                for (int m = 0; m < 4; ++m) { const f32x4 v = a[k][m] * sc[m]; int p = 0;
                    p = __builtin_amdgcn_cvt_pk_fp8_f32(v.x, v.y, p, false); p = __builtin_amdgcn_cvt_pk_fp8_f32(v.z, v.w, p, true); o[m] = (unsigned)p; }
                *(v4u*)(dst + (size_t)(4 * hb + k) * 512) = o; }
        }
        __syncthreads();
    }
}
__device__ __forceinline__ f32x2 dot16p(const v4u u, const f32x2* x, f32x2 acc) {
#pragma unroll
    for (int q = 0; q < 4; ++q) { const f32x2 lo = __builtin_amdgcn_cvt_pk_f32_fp8((int)u[q], false), hi = __builtin_amdgcn_cvt_pk_f32_fp8((int)u[q], true);
        acc = __builtin_elementwise_fma(lo, x[2 * q], acc); acc = __builtin_elementwise_fma(hi, x[2 * q + 1], acc); }
    return acc;
}
__device__ __forceinline__ void axpy16p(const v4u v, f32x2 s, f32x2* y) {
#pragma unroll
    for (int q = 0; q < 4; ++q) { const f32x2 lo = __builtin_amdgcn_cvt_pk_f32_fp8((int)v[q], false), hi = __builtin_amdgcn_cvt_pk_f32_fp8((int)v[q], true);
        y[2 * q] = __builtin_elementwise_fma(s, lo, y[2 * q]); y[2 * q + 1] = __builtin_elementwise_fma(s, hi, y[2 * q + 1]); }
}
__device__ __forceinline__ float xsum_g8(float v) {
    v += DPP_F(v, 0x128);
    { auto r = __builtin_amdgcn_permlane16_swap(__float_as_uint(v), __float_as_uint(v), false, false); v = __uint_as_float(r[0]) + __uint_as_float(r[1]); }
    { auto r = __builtin_amdgcn_permlane32_swap(__float_as_uint(v), __float_as_uint(v), false, false); v = __uint_as_float(r[0]) + __uint_as_float(r[1]); }
    return v;
}
__device__ __forceinline__ void phase_peer_sliced(KP P, LAS unsigned char* lds, int bx, int G) {
    const int grp = bx & 7;
    const unsigned char* UB = P.ws + WS_UB; const unsigned char* VB = P.ws + WS_VB; const bf16* HB = (const bf16*)(P.ws + WS_XN);
    const int* ridx = (const int*)(P.ws + WS_PROJ + 64 * MiB); const float* rgate = (const float*)(P.ws + WS_PROJ + 68 * MiB); const float* RSTD = (const float*)(P.ws + WS_SSP + 2 * MiB);
    for (int bt = bx; bt < TT / 32; bt += G) {
        const int tid = ltid(), lane = tid & 63, wave = __builtin_amdgcn_readfirstlane(tid >> 6), g8 = lane >> 3, p = lane & 7;
        LAS int* idxT = (LAS int*)(lds + wave * 4096); LAS float* gT = (LAS float*)(lds + wave * 4096 + 2048);
        LAS bf16* h2T = (LAS bf16*)(lds + 32768 + wave * 16384);
        const int t0 = 32 * bt + 4 * wave;
#pragma unroll
        for (int i = 0; i < 4; ++i) { const size_t o = (size_t)(t0 + i) * 128; const int wofs = (i * 8 + (lane & 7)) * 16 + (lane >> 3);
            idxT[wofs] = ridx[o + lane]; idxT[wofs + 8] = ridx[o + 64 + lane]; gT[wofs] = rgate[o + lane]; gT[wofs + 8] = rgate[o + 64 + lane]; }
        float hacc[4][2];
#pragma unroll
        for (int i = 0; i < 4; ++i) { hacc[i][0] = 0.f; hacc[i][1] = 0.f; }
        {
            v4u rA[8], rB[8]; f32x2 xA[8], xB[8];
#define PS_SG(s_) (((s_) + 2 * grp) & 15)
#define PS_ISSUE(R, tabbase, s_, i_, hb_) do { const unsigned char* tb_ = (tabbase) + (size_t)PS_SG(s_) * SLICE_BYTES;        \
            const v4u ia_ = *(const LAS v4u*)(idxT + ((i_) * 8 + g8) * 16 + 8 * (hb_)), ib_ = *(const LAS v4u*)(idxT + ((i_) * 8 + g8) * 16 + 8 * (hb_) + 4); const unsigned po_ = 16u * (unsigned)p; \
            R[0] = *(const v4u*)(tb_ + (ia_[0] * 128u + po_)); R[1] = *(const v4u*)(tb_ + (ia_[1] * 128u + po_)); R[2] = *(const v4u*)(tb_ + (ia_[2] * 128u + po_)); R[3] = *(const v4u*)(tb_ + (ia_[3] * 128u + po_)); \
            R[4] = *(const v4u*)(tb_ + (ib_[0] * 128u + po_)); R[5] = *(const v4u*)(tb_ + (ib_[1] * 128u + po_)); R[6] = *(const v4u*)(tb_ + (ib_[2] * 128u + po_)); R[7] = *(const v4u*)(tb_ + (ib_[3] * 128u + po_)); } while (0)
#define PS_LOADX(X, s_, i_) do { const bf16* xp_ = HB + (size_t)(t0 + (i_)) * DM + 128 * PS_SG(s_) + 16 * p; const v4u xa_ = *(const v4u*)xp_, xb_ = *(const v4u*)(xp_ + 8); \
            _Pragma("unroll") for (int q = 0; q < 4; ++q) { X[q] = (f32x2){bflo(xa_[q]), bfhi(xa_[q])}; X[4 + q] = (f32x2){bflo(xb_[q]), bfhi(xb_[q])}; } } while (0)
#define PS_DOTS(R, X, i_, hb_) do { _Pragma("unroll") for (int m = 0; m < 8; ++m) { const f32x2 a2_ = dot16p(R[m], X, (f32x2){0.f, 0.f}); float sd_ = a2_.x + a2_.y; \
            sd_ += DPP_F(sd_, 0xB1); sd_ += DPP_F(sd_, 0x4E); sd_ += DPP_F(sd_, 0x141); if (p == m) hacc[i_][hb_] += sd_; } asm volatile("" ::: "memory"); } while (0)
            PS_LOADX(xA, 0, 0); PS_ISSUE(rA, UB, 0, 0, 0);
            for (int s = 0; s < 16; ++s) {
                PS_ISSUE(rB, UB, s, 0, 1); PS_LOADX(xB, s, 1);  PS_DOTS(rA, xA, 0, 0);
                PS_ISSUE(rA, UB, s, 1, 0);                       PS_DOTS(rB, xA, 0, 1);
                PS_ISSUE(rB, UB, s, 1, 1); PS_LOADX(xA, s, 2);  PS_DOTS(rA, xB, 1, 0);
                PS_ISSUE(rA, UB, s, 2, 0);                       PS_DOTS(rB, xB, 1, 1);
                PS_ISSUE(rB, UB, s, 2, 1); PS_LOADX(xB, s, 3);  PS_DOTS(rA, xA, 2, 0);
                PS_ISSUE(rA, UB, s, 3, 0);                       PS_DOTS(rB, xA, 2, 1);
                PS_ISSUE(rB, UB, s, 3, 1); if (s + 1 < 16) PS_LOADX(xA, s + 1, 0);  PS_DOTS(rA, xB, 3, 0);
                if (s + 1 < 16) PS_ISSUE(rA, UB, s + 1, 0, 0);  PS_DOTS(rB, xB, 3, 1);
            }
#undef PS_LOADX
#undef PS_DOTS
        }
#pragma unroll
        for (int i = 0; i < 4; ++i) { const float rsn = RSTD[t0 + i] * (1.f / U_SCALE);
#pragma unroll
            for (int hb = 0; hb < 2; ++hb) { const float hp = hacc[i][hb] * rsn; LAS float* gp = gT + (i * 8 + g8) * 16 + 8 * hb + p;
                *gp = 0.5f * hp * (1.f + erff(hp * 0.70710678118654752f)) * (1.f / V_SCALE) * *gp; } }
        float ssq[4] = {0.f, 0.f, 0.f, 0.f};
        {
            v4u rA[8], rB[8]; f32x2 y2[8];
#define PS_AXPY(R, i_, hb_) do { const f32x4 aa_ = *(const LAS f32x4*)(gT + ((i_) * 8 + g8) * 16 + 8 * (hb_)), ab_ = *(const LAS f32x4*)(gT + ((i_) * 8 + g8) * 16 + 8 * (hb_) + 4); \
            if ((hb_) == 0) { _Pragma("unroll") for (int q = 0; q < 8; ++q) y2[q] = (f32x2){0.f, 0.f}; } \
            _Pragma("unroll") for (int m = 0; m < 8; ++m) { const float av_ = m < 4 ? aa_[m & 3] : ab_[m & 3]; axpy16p(R[m], (f32x2){av_, av_}, y2); } asm volatile("" ::: "memory"); } while (0)
#define PS_FIN(s_, i_) do { f32x2 ysel_ = {0.f, 0.f}; _Pragma("unroll") for (int q = 0; q < 8; ++q) { const float a_ = xsum_g8(y2[q].x), b_ = xsum_g8(y2[q].y); if (g8 == q) ysel_ = (f32x2){a_, b_}; } \
            const int d_ = 128 * PS_SG(s_) + 16 * p + 2 * g8; const unsigned hb_ = *(const unsigned*)(HB + (size_t)(t0 + (i_)) * DM + d_); const f32x2 hv_ = (f32x2){bflo(hb_), bfhi(hb_)} + ysel_; \
            *(LAS unsigned*)(h2T + (i_) * DM + d_) = pk2(hv_.x, hv_.y); ssq[i_] += hv_.x * hv_.x + hv_.y * hv_.y; } while (0)
            PS_ISSUE(rA, VB, 0, 0, 0);
            for (int s = 0; s < 16; ++s) {
                PS_ISSUE(rB, VB, s, 0, 1); PS_AXPY(rA, 0, 0);
                PS_ISSUE(rA, VB, s, 1, 0); PS_AXPY(rB, 0, 1); PS_FIN(s, 0);
                PS_ISSUE(rB, VB, s, 1, 1); PS_AXPY(rA, 1, 0);
                PS_ISSUE(rA, VB, s, 2, 0); PS_AXPY(rB, 1, 1); PS_FIN(s, 1);
                PS_ISSUE(rB, VB, s, 2, 1); PS_AXPY(rA, 2, 0);
                PS_ISSUE(rA, VB, s, 3, 0); PS_AXPY(rB, 2, 1); PS_FIN(s, 2);
                PS_ISSUE(rB, VB, s, 3, 1); PS_AXPY(rA, 3, 0);
                if (s + 1 < 16) PS_ISSUE(rA, VB, s + 1, 0, 0); PS_AXPY(rB, 3, 1); PS_FIN(s, 3);
            }
#undef PS_AXPY
#undef PS_FIN
#undef PS_ISSUE
#undef PS_SG
        }
        { f32x4 fg[8];
#pragma unroll
          for (int j = 0; j < 8; ++j) fg[j] = *(const f32x4*)(P.final_g + 4 * lane + 256 * j);
#pragma unroll
          for (int i = 0; i < 4; ++i) { const float rs2 = 1.0f / sqrtf(wave_sum(ssq[i]) * (1.f / DM) + RMS_EPS);
#pragma unroll
            for (int j = 0; j < 8; ++j) { const v2u hv = *(const LAS v2u*)(h2T + i * DM + 4 * lane + 256 * j);
                *(f32x4*)(P.out + (size_t)(t0 + i) * DM + 4 * lane + 256 * j) = (f32x4){bflo(hv.x) * rs2 * fg[j].x, bfhi(hv.x) * rs2 * fg[j].y, bflo(hv.y) * rs2 * fg[j].z, bfhi(hv.y) * rs2 * fg[j].w}; } } }
        asm volatile("" ::: "memory");
    }
}
namespace moba {
constexpr float SCALE = 0.08838834764831845f;
constexpr float THR = 8.f;
constexpr bool WSKIP = false;
constexpr int D = 128, NW = 8, QBLK = 32, KVBLK = 64, QB = NW * QBLK;
constexpr int SHM_V = KVBLK * D * 2, SHM_K = KVBLK * D * 2;
constexpr int ATT_LDS_BYTES = 2 * SHM_V + 2 * SHM_K + NW * 64 * 4;
constexpr int KPITCH = INCP, QPITCH = INCP, OPITCH = DM;
typedef unsigned short bf16;
typedef short bf16x8 __attribute__((ext_vector_type(8)));
typedef short s16x4 __attribute__((ext_vector_type(4)));
typedef float f32x16 __attribute__((ext_vector_type(16)));
typedef float f32x4 __attribute__((ext_vector_type(4)));
typedef unsigned u32x4 __attribute__((ext_vector_type(4)));
template <class A, class Bt> struct same_t { static constexpr bool v = false; };
template <class A> struct same_t<A, A> { static constexpr bool v = true; };
#define KSWZ(row, colB) ((row) * 256 + ((colB) ^ (((row) & 7) << 4)))
#define SBAR() __builtin_amdgcn_sched_barrier(0)
__device__ __forceinline__ int v_st(int k, int c) { const int kk = (k & ~0xC) | ((k & 4) << 1) | ((k & 8) >> 1); return ((kk >> 3) * 4 + (c >> 5)) * 512 + ((kk & 7) * 32 + (c & 31)) * 2; }
__device__ __forceinline__ int v_rd_base(int lane) { return ((lane & 3) << 3) | (((lane >> 2) & 3) << 6) | (((lane >> 4) & 1) << 5) | (((lane >> 5) & 1) << 8); }
constexpr int v_rd_off(int d0, int ks, int half) { return d0 * 512 + ks * 4096 + half * 2048; }
__device__ __forceinline__ int crow(int r, int hi) { return (r & 3) + 8 * (r >> 2) + 4 * hi; }
__device__ __forceinline__ unsigned cvtpk(float lo, float hi) {
    unsigned r; asm volatile("v_cvt_pk_bf16_f32 %0, %1, %2" : "=v"(r) : "v"(lo), "v"(hi)); return r;
}
__device__ __forceinline__ bf16x8 pack8(f32x4 a, f32x4 b) {
    u32x4 w = {cvtpk(a[0], a[1]), cvtpk(a[2], a[3]), cvtpk(b[0], b[1]), cvtpk(b[2], b[3])};
    return *reinterpret_cast<bf16x8*>(&w);
}
template <class T> __device__ __forceinline__ bf16x8 load8(const T* p) {
    if constexpr (same_t<T, float>::v) { return pack8(*(const f32x4*)p, *(const f32x4*)(p + 4)); }
    else { return *reinterpret_cast<const bf16x8*>(p); }
}
__device__ __forceinline__ void mask_tile(f32x16& p0, f32x16& p1, int dq, unsigned W) {
    const float NEG = -__builtin_inff();
#pragma unroll
    for (int r = 0; r < 16; ++r) {
        const int c = (r & 3) + 8 * (r >> 2);
        if ((unsigned)(dq - c) >= W) p0[r] = NEG;
        if ((unsigned)(dq - c - 32) >= W) p1[r] = NEG;
    }
}
__device__ __forceinline__ void partialSM(f32x16& p0, f32x16& p1, float& m_reg, float& mn, float& alpha, float base0, float base1) {
    float pm0 = p0[0]; for (int r = 1; r < 16; ++r) pm0 = fmaxf(pm0, p0[r]); float pm1 = p1[0]; for (int r = 1; r < 16; ++r) pm1 = fmaxf(pm1, p1[r]);
    float pmax = fmaxf(pm0 + base0, pm1 + base1);
    { auto rr = __builtin_amdgcn_permlane32_swap(__float_as_uint(pmax), __float_as_uint(pmax), false, false);
      pmax = fmaxf(__uint_as_float(rr[0]), __uint_as_float(rr[1])); }
    constexpr float C2 = 1.4426950408889634f * SCALE;
    if (__builtin_expect(__all((pmax - m_reg) * SCALE <= THR), 1)) { mn = m_reg; alpha = 1.f; }
    else { mn = fmaxf(m_reg, pmax); alpha = __builtin_amdgcn_exp2f((m_reg - mn) * C2); m_reg = mn; }
    const float mnL0 = (base0 - mn) * C2, mnL1 = (base1 - mn) * C2;
    for (int r = 0; r < 16; ++r) p0[r] = fmaf(p0[r], C2, mnL0); for (int r = 0; r < 16; ++r) p1[r] = fmaf(p1[r], C2, mnL1);
    for (int r = 0; r < 16; ++r) p0[r] = __builtin_amdgcn_exp2f(p0[r]);
}
__device__ __forceinline__ void finishSM(f32x16& p0, f32x16& p1, float alpha, float& l_reg, bf16x8& pa0, bf16x8& pa1, bf16x8& pa2, bf16x8& pa3) {
    for (int r = 0; r < 16; ++r) p1[r] = __builtin_amdgcn_exp2f(p1[r]);
    float ps = 0; for (int r = 0; r < 16; ++r) ps += p0[r]; for (int r = 0; r < 16; ++r) ps += p1[r];
    { auto rr = __builtin_amdgcn_permlane32_swap(__float_as_uint(ps), __float_as_uint(ps), false, false);
      ps = __uint_as_float(rr[0]) + __uint_as_float(rr[1]); }
    l_reg = l_reg * alpha + ps;
#define PK4(P, B_, OUT) do { unsigned a0 = cvtpk(P[B_+0], P[B_+1]), a1 = cvtpk(P[B_+2], P[B_+3]);                          \
        unsigned b0 = cvtpk(P[B_+4], P[B_+5]), b1 = cvtpk(P[B_+6], P[B_+7]);                                             \
        auto r0 = __builtin_amdgcn_permlane32_swap(a0, b0, false, false); auto r1 = __builtin_amdgcn_permlane32_swap(a1, b1, false, false); \
        u32x4 w = {r0[0], r1[0], r0[1], r1[1]}; OUT = *reinterpret_cast<bf16x8*>(&w); } while (0)
    PK4(p0, 0, pa0); PK4(p0, 8, pa1); PK4(p1, 0, pa2); PK4(p1, 8, pa3);
#undef PK4
}
template <int KB, bool SK>
__device__ __forceinline__ void qkt(f32x16& p0, f32x16& p1, const char* K_lds, int r32, int hi, const bf16x8* qr, bool act) {
    if (SK && !act) { const float NEG = -__builtin_inff();
#pragma unroll
        for (int r = 0; r < 16; ++r) { p0[r] = NEG; p1[r] = NEG; } return; }
    p0 = f32x16{}; p1 = f32x16{};
    const char* kb[4];
#pragma unroll
    for (int dd = 0; dd < 4; ++dd) kb[dd] = K_lds + KB * SHM_K + KSWZ(r32, (dd * 16 + hi * 8) * 2);
#pragma unroll
    for (int d0 = 0; d0 < 8; ++d0) { const char* a = kb[d0 & 3] + (d0 >> 2) * 128;
        bf16x8 b0 = *reinterpret_cast<const bf16x8*>(a);
        bf16x8 b1 = *reinterpret_cast<const bf16x8*>(a + 32 * 256);
        p0 = __builtin_amdgcn_mfma_f32_32x32x16_bf16(b0, qr[d0], p0, 0, 0, 0);
        p1 = __builtin_amdgcn_mfma_f32_32x32x16_bf16(b1, qr[d0], p1, 0, 0, 0); }
}
template <int VB, bool SK>
__device__ __forceinline__ void pv_tile(f32x16* o, int vb0, bf16x8 pa0, bf16x8 pa1, bf16x8 pa2, bf16x8 pa3, bool act) {
    if (SK && !act) return;
#define TRRD(dst, off) asm volatile("ds_read_b64_tr_b16 %0, %1 offset:%2" : "=&v"(dst) : "v"(vb0), "i"(off) : "memory")
#define PV_D0(d0) do { s16x4 l0, l1, h0, h1; constexpr int b_ = VB * SHM_V + v_rd_off(d0, 0, 0);     \
        TRRD(l0, b_); TRRD(h0, b_ + 2048); TRRD(l1, b_ + 4096); TRRD(h1, b_ + 6144); \
        asm volatile("s_waitcnt lgkmcnt(0)" ::: "memory"); SBAR();                 \
        o[d0] = __builtin_amdgcn_mfma_f32_32x32x16_bf16(pa0, (bf16x8){l0[0], l0[1], l0[2], l0[3], h0[0], h0[1], h0[2], h0[3]}, o[d0], 0, 0, 0);   \
        o[d0] = __builtin_amdgcn_mfma_f32_32x32x16_bf16(pa1, (bf16x8){l1[0], l1[1], l1[2], l1[3], h1[0], h1[1], h1[2], h1[3]}, o[d0], 0, 0, 0);   \
        SBAR(); TRRD(l0, b_ + 8192); TRRD(h0, b_ + 10240); TRRD(l1, b_ + 12288); TRRD(h1, b_ + 14336); \
        asm volatile("s_waitcnt lgkmcnt(0)" ::: "memory"); SBAR();   \
        o[d0] = __builtin_amdgcn_mfma_f32_32x32x16_bf16(pa2, (bf16x8){l0[0], l0[1], l0[2], l0[3], h0[0], h0[1], h0[2], h0[3]}, o[d0], 0, 0, 0);   \
        o[d0] = __builtin_amdgcn_mfma_f32_32x32x16_bf16(pa3, (bf16x8){l1[0], l1[1], l1[2], l1[3], h1[0], h1[1], h1[2], h1[3]}, o[d0], 0, 0, 0); } while (0)
    PV_D0(0); PV_D0(1); PV_D0(2); PV_D0(3);
#undef PV_D0
#undef TRRD
}

template <class TIn, class TOut> struct BlockRef { const TIn* Q; const TIn* K; const TIn* V; TOut* O; int P0; const float* KM; float A; int jlo, jhi; float* ST; };
template <class TIn> struct Seam {
    bf16x8 qr[8];
    bf16x8 st_v0, st_v1, st_k0, st_k1; f32x4 sf0, sf1, sf2, sf3;
    f32x4 tq[16];
};
__device__ __forceinline__ int swa_jlo(int P0, int W) { const int lowk = P0 - W + 1; return lowk > 0 ? lowk / KVBLK : 0; }
#define ROW(p, k0, rr) ((p) + (size_t)((k0) + (rr)) * KPITCH + sc)
#define VMW() asm volatile("s_waitcnt vmcnt(0)" ::: "memory")
#define VMWN(n) asm volatile("s_waitcnt vmcnt(%0)" :: "i"(n) : "memory")
#define SLOAD_H(Kp, Vp, k0) do { S.st_v0 = load8<TIn>(ROW(Vp, k0, sr)); S.st_v1 = load8<TIn>(ROW(Vp, k0, 32 + sr));              \
                         S.st_k0 = load8<TIn>(ROW(Kp, k0, sr)); S.st_k1 = load8<TIn>(ROW(Kp, k0, 32 + sr)); } while (0)
#define SWRITE_HK(bf) do { *(bf16x8*)(K_lds + (bf) * SHM_K + kws) = S.st_k0; *(bf16x8*)(K_lds + (bf) * SHM_K + kws + 32 * 256) = S.st_k1; } while (0)
#define SWRITE_HV(bf) do { *(bf16x8*)(V_lds + (bf) * SHM_V + vst0) = S.st_v0; *(bf16x8*)(V_lds + (bf) * SHM_V + vst1) = S.st_v1; } while (0)
#define SWRITE_H(bf) do { SWRITE_HV(bf); SWRITE_HK(bf); } while (0)
#define SLOAD_F(p, k0) do { S.sf0 = *(const f32x4*)ROW(p, k0, sr); S.sf1 = *(const f32x4*)(ROW(p, k0, sr) + 4);                \
                            S.sf2 = *(const f32x4*)ROW(p, k0, 32 + sr); S.sf3 = *(const f32x4*)(ROW(p, k0, 32 + sr) + 4); } while (0)
#define SWRITE_KF(bf) do { *(bf16x8*)(K_lds + (bf) * SHM_K + kws) = pack8(S.sf0, S.sf1); *(bf16x8*)(K_lds + (bf) * SHM_K + kws + 32 * 256) = pack8(S.sf2, S.sf3); } while (0)
#define SWRITE_VF(bf) do { *(bf16x8*)(V_lds + (bf) * SHM_V + vst0) = pack8(S.sf0, S.sf1); *(bf16x8*)(V_lds + (bf) * SHM_V + vst1) = pack8(S.sf2, S.sf3); } while (0)
template <class TIn, class TOut>
__device__ __forceinline__ void causal_swa_prime(const BlockRef<TIn, TOut>& cur, int W, char* lds, Seam<TIn>& S) {
    constexpr bool F32 = same_t<TIn, float>::v;
    const int tid = ltid(), wid = __builtin_amdgcn_readfirstlane(tid >> 6), lane = tid & 63, r32 = lane & 31, hi = lane >> 5;
    const int sr = tid >> 4, sc = (tid & 15) * 8, kws = KSWZ(sr, sc * 2); char* K_lds = lds + 2 * SHM_V;
    const int kb0 = cur.jlo * KVBLK;
    for (int d0 = 0; d0 < 8; ++d0) S.qr[d0] = load8<TIn>(cur.Q + (size_t)(wid * QBLK + r32) * QPITCH + d0 * 16 + hi * 8);
    if constexpr (F32) { SLOAD_F((const float*)cur.K, kb0); VMW(); SWRITE_KF(0); SBAR(); SLOAD_F((const float*)cur.V, kb0); }
    else { SLOAD_H(cur.K, cur.V, kb0); VMW(); SWRITE_HK(0); }
    __syncthreads();
}
template <class TIn, class TOut>
__device__ __forceinline__ void causal_swa_block(const BlockRef<TIn, TOut>& cur, const BlockRef<TIn, TOut>& nxt, int skv, int W, char* lds, Seam<TIn>& S) {
    constexpr bool F32 = same_t<TIn, float>::v;
    const int tid = ltid(), wid = __builtin_amdgcn_readfirstlane(tid >> 6), lane = tid & 63, r32 = lane & 31, hi = lane >> 5;
    const int j_lo = cur.jlo, j_hi = cur.jhi;
    const int NT = j_hi - j_lo;
    const int kbn = nxt.jlo * KVBLK;
    const int qlo = cur.P0 + wid * QBLK, qm = qlo + r32 - 4 * hi;
    char* V_lds = lds; char* K_lds = lds + 2 * SHM_V;
    float* ws = (float*)(lds + 2 * SHM_V + 2 * SHM_K) + wid * 64; float* li_l = ws, * al_l = ws + 32;
    float m_reg = -1e30f, l_reg = 0; f32x16 o[4] = {};
    const int sr = tid >> 4, sc = (tid & 15) * 8, vst0 = v_st(sr, sc), vst1 = v_st(32 + sr, sc), kws = KSWZ(sr, sc * 2);
    const int vb0 = (int)(uintptr_t)V_lds + v_rd_base(lane);
    const TIn* Kh = cur.K; const TIn* Vh = cur.V;
    const float alA_ = cur.A;
    unsigned selm = 0u;
    { const int qb_ = cur.P0 >> 8;
      if (qb_ > 0) {
        float* kmL = (float*)(K_lds + SHM_K);
        *(f32x4*)(kmL + 4 * tid) = *(const f32x4*)(cur.KM + (size_t)(tid >> 5) * 1024 + 4 * (tid & 31));
        __syncthreads();
        float g[16];
#pragma unroll
        for (int n = 0; n < 16; ++n) g[n] = 0.f;
#pragma unroll
        for (int d0 = 0; d0 < 8; ++d0) { float qf[8];
#pragma unroll
            for (int j = 0; j < 8; ++j) qf[j] = __uint_as_float(((unsigned)(unsigned short)S.qr[d0][j]) << 16);
#pragma unroll
            for (int n = 0; n < 16; ++n) if (n < qb_) { const f32x4 k0 = *(const f32x4*)(kmL + n * 128 + d0 * 16 + hi * 8), k1 = *(const f32x4*)(kmL + n * 128 + d0 * 16 + hi * 8 + 4);
                g[n] += qf[0] * k0[0] + qf[1] * k0[1] + qf[2] * k0[2] + qf[3] * k0[3] + qf[4] * k1[0] + qf[5] * k1[1] + qf[6] * k1[2] + qf[7] * k1[3]; }
            asm volatile("" ::: "memory"); }
#pragma unroll
        for (int n = 0; n < 16; ++n) { const float a = g[n] + __shfl_xor(g[n], 32); g[n] = n < qb_ ? a : -1e30f; }
#pragma unroll
        for (int r = 0; r < 3; ++r) { float best = -3e38f; int bi = 0;
#pragma unroll
            for (int n = 0; n < 16; ++n) if (!((selm >> n) & 1u) && g[n] > best) { best = g[n]; bi = n; }
            selm |= 1u << bi; }
        selm &= (1u << qb_) - 1u;
        __syncthreads();
      }
      li_l[r32] = __uint_as_float(selm); }
#define RESC(a) do { if (__any((a) < 1.f)) { if (hi == 0) al_l[r32] = (a); asm volatile("s_waitcnt lgkmcnt(0)" ::: "memory");              \
                     for (int d_ = 0; d_ < 4; ++d_) for (int r = 0; r < 16; ++r) o[d_][r] *= al_l[crow(r, hi)]; } } while (0)
#define KBASE(t) ((j_lo + (t)) * KVBLK)
#define ACT(t) (KBASE(t) <= qlo + QBLK - 1 && KBASE(t) + KVBLK - 1 >= qlo - W + 1)
#define MASKT(P0_, P1_, t) do { const int kb_ = KBASE(t); if ((!SK || ACT(t)) && (kb_ + KVBLK - 1 > qlo || kb_ <= qlo + QBLK - 1 - W)) mask_tile(P0_, P1_, qm - kb_, (unsigned)W); \
        _Pragma("unroll") for (int r = 0; r < 16; ++r) { const float c_ = (float)((r & 3) + 8 * (r >> 2)); P0_[r] = fmaf(alA_, c_, P0_[r]); P1_[r] = fmaf(alA_, c_, P1_[r]); } } while (0)
#define BASE0(t) ((KBASE(t) < cur.P0 && !((__float_as_uint(li_l[r32]) >> (KBASE(t) >> 8)) & 1u)) ? -__builtin_inff() : alA_ * (float)(KBASE(t) - cur.P0 + 4 * hi))
#define BASE1(t) (BASE0(t) + 32.f * alA_)
    constexpr int NQL = F32 ? 16 : 8;
    constexpr bool SK = WSKIP && !F32;
#define SEAM_K0() do { VMWN(NQL); if constexpr (F32) { SWRITE_KF(0); SBAR(); SLOAD_F((const float*)nxt.V, kbn); } else { SWRITE_HK(0); } SBAR(); } while (0)
    f32x16 pA0, pA1, pB0, pB1; float mnA, mnB, alA, alB; bf16x8 pa0, pa1, pa2, pa3;
    if constexpr (F32) { VMW(); SWRITE_VF(0); SBAR(); } else { SWRITE_HV(0); SBAR(); }
    if (NT > 1) { if constexpr (F32) SLOAD_F((const float*)Kh, KBASE(1)); else SLOAD_H(Kh, Vh, KBASE(1)); }
    SBAR(); qkt<0, SK>(pA0, pA1, K_lds, r32, hi, S.qr, ACT(0));
    if constexpr (F32) { if (NT > 1) { VMW(); SWRITE_KF(1); SBAR(); SLOAD_F((const float*)Vh, KBASE(1)); } }
    MASKT(pA0, pA1, 0); partialSM(pA0, pA1, m_reg, mnA, alA, BASE0(0), BASE1(0));
    if (NT > 1) { VMW(); if constexpr (F32) { SWRITE_VF(1); SBAR(); if (NT > 2) SLOAD_F((const float*)Kh, KBASE(2)); } else SWRITE_H(1); }
    __syncthreads();
#define HALF_STEP(PX0, PX1, mnX, alX, PY0, PY1, alY, t, KB, VB, SB) do {                                                      \
        SBAR(); qkt<KB, SK>(PX0, PX1, K_lds, r32, hi, S.qr, ACT(t));                                             \
        finishSM(PY0, PY1, alY, l_reg, pa0, pa1, pa2, pa3); SBAR();                                                           \
        if ((t) + 1 < NT) { if constexpr (F32) { VMW(); SWRITE_KF(SB); SBAR(); SLOAD_F((const float*)Vh, KBASE((t) + 1)); }  \
                            else { SLOAD_H(Kh, Vh, KBASE((t) + 1)); } SBAR(); }                                               \
        pv_tile<VB, SK>(o, vb0, pa0, pa1, pa2, pa3, ACT((t) - 1)); MASKT(PX0, PX1, (t)); partialSM(PX0, PX1, m_reg, mnX, alX, BASE0(t), BASE1(t));                                        \
        __syncthreads();                                                                                                      \
        if ((t) + 1 < NT) { VMW(); if constexpr (F32) { SWRITE_VF(SB); SBAR(); if ((t) + 2 < NT) SLOAD_F((const float*)Kh, KBASE((t) + 2)); } \
                            else { SWRITE_H(SB); } }                                                                          \
        RESC(alX); __syncthreads(); } while (0)
    for (int t = 1; t + 1 < NT; t += 2) {
        HALF_STEP(pB0, pB1, mnB, alB, pA0, pA1, alA, t, 1, 0, 0);
        HALF_STEP(pA0, pA1, mnA, alA, pB0, pB1, alB, t + 1, 0, 1, 1);
    }
    const bool even = (NT & 1) == 0;
    if (even) { SBAR(); qkt<1, SK>(pB0, pB1, K_lds, r32, hi, S.qr, ACT(NT - 1)); SBAR(); }
#define QROW(e) (nxt.Q + (size_t)(wid * QBLK + r32) * QPITCH + ((e) >> 1) * 16 + hi * 8 + ((e) & 1) * 4)
    if constexpr (F32) { SLOAD_F((const float*)nxt.K, kbn); SBAR();
#pragma unroll
        for (int e = 0; e < 8; ++e) S.tq[e] = *(const f32x4*)QROW(e); }
    else { SLOAD_H(nxt.K, nxt.V, kbn); SBAR();
#pragma unroll
        for (int d0 = 0; d0 < 8; ++d0) S.qr[d0] = load8<TIn>(nxt.Q + (size_t)(wid * QBLK + r32) * QPITCH + d0 * 16 + hi * 8); }
    SBAR();
    finishSM(pA0, pA1, alA, l_reg, pa0, pa1, pa2, pa3); SBAR();
    if constexpr (F32) {
#pragma unroll
        for (int e = 8; e < 16; ++e) S.tq[e] = *(const f32x4*)QROW(e); SBAR(); }
#undef QROW
    pv_tile<0, SK>(o, vb0, pa0, pa1, pa2, pa3, ACT(even ? NT - 2 : NT - 1));
    if (even) { MASKT(pB0, pB1, NT - 1); partialSM(pB0, pB1, m_reg, mnB, alB, BASE0(NT - 1), BASE1(NT - 1)); __syncthreads(); RESC(alB);
        finishSM(pB0, pB1, alB, l_reg, pa0, pa1, pa2, pa3); SBAR(); pv_tile<1, SK>(o, vb0, pa0, pa1, pa2, pa3, ACT(NT - 1)); }
    SBAR(); SEAM_K0();
    if (hi == 0) { li_l[r32] = l_reg; if (cur.ST) { cur.ST[(wid * QBLK + r32) * 16] = m_reg; cur.ST[(wid * QBLK + r32) * 16 + 1] = l_reg; } }
    asm volatile("s_waitcnt lgkmcnt(0)" ::: "memory");
    float rli[16];
#pragma unroll
    for (int r = 0; r < 16; ++r) { const float l_ = li_l[crow(r, hi)]; rli[r] = l_ > 0.f ? __builtin_amdgcn_rcpf(l_) : 0.f; }
    TOut* Ow = cur.O + (size_t)(wid * QBLK) * OPITCH;
#pragma unroll
    for (int r = 0; r < 16; ++r) { const int orow = crow(r, hi);
#pragma unroll
        for (int d0 = 0; d0 < 4; ++d0) { const float v = o[d0][r] * rli[r];
            if constexpr (same_t<TOut, float>::v) { Ow[(size_t)orow * OPITCH + d0 * 32 + r32] = v; }
            else { const float vn = __shfl_xor(v, 1);
                   if ((r32 & 1) == 0) *(unsigned*)(Ow + (size_t)orow * OPITCH + d0 * 32 + r32) = cvtpk(v, vn); } } }
    if constexpr (F32) {
#pragma unroll
        for (int d0 = 0; d0 < 8; ++d0) S.qr[d0] = pack8(S.tq[2 * d0], S.tq[2 * d0 + 1]); }
    __syncthreads();
#undef RESC
#undef KBASE
#undef ACT
#undef MASKT
#undef SEAM_K0
#undef HALF_STEP
}
#undef ROW
#undef VMW
#undef VMWN
#undef SLOAD_H
#undef SWRITE_HK
#undef SWRITE_HV
#undef SWRITE_H
#undef SLOAD_F
#undef SWRITE_KF
#undef SWRITE_VF

#undef BASE0
#undef BASE1
}
constexpr size_t WS_OSL = WS_XN, WS_OSU = WS_H;
constexpr size_t WS_STL = WS_WIN, WS_STU = WS_WIN + 1 * MiB;
constexpr int MOBA_SPLIT_QB = 8;
__device__ __forceinline__ void phase_moba(KP P, char* lds, int vcu, int G) {
    typedef moba::BlockRef<moba::bf16, moba::bf16> BR;
    const moba::bf16* proj = (const moba::bf16*)(P.ws + WS_PROJ); moba::bf16* AR = (moba::bf16*)(P.ws + WS_AR); const float* kmean = (const float*)(P.ws + WS_KMEAN);
    constexpr int W = 1 << 30;
    auto mkref = [&](int bh, int qb, int part) -> BR { const int b = bh >> 3, h = bh & 7; BR r; const int nt = 4 * qb + 4;
        r.Q = proj + (size_t)(b * SEQ + qb * 256) * INCP + h * 128; r.K = proj + (size_t)(b * SEQ) * INCP + C_AK + h * 128; r.V = proj + (size_t)(b * SEQ) * INCP + C_AV + h * 128;
        moba::bf16* ob = part == 0 ? AR : (moba::bf16*)(P.ws + (part == 1 ? WS_OSL : WS_OSU));
        r.O = ob + (size_t)(b * SEQ + qb * 256) * DM + h * 128; r.P0 = qb * 256; r.KM = kmean + (size_t)(b * 16) * 1024 + h * 128; r.A = exp2f(-(float)(h + 1)) * (1.f / moba::SCALE);
        r.jlo = part == 2 ? nt / 2 : 0; r.jhi = part == 1 ? nt / 2 : nt;
        r.ST = part == 0 ? nullptr : (float*)(P.ws + (part == 1 ? WS_STL : WS_STU)) + ((size_t)(b * SEQ + qb * 256) * 8 + h) * 2;
        return r; };
    moba::Seam<moba::bf16> S;
    if (G == 256) {
        const int q_ = vcu & 15, bh = vcu >> 4;
        const int qbA[16] = {-1, -1, 15, 15,  7, 14, 14, 13, 13,  6, 12, 12, 11, 11,  5, 10};
        const int ptA[16] = { 0,  0,  2,  1,  0,  2,  1,  2,  1,  0,  2,  1,  2,  1,  0,  2};
        const int qbB[16] = {-1, -1, -1, -1, -1,  0, -1,  1,  2,  3,  8,  8,  4,  9,  9, 10};
        const int ptB[16] = { 0,  0,  0,  0,  0,  0,  0,  0,  0,  0,  2,  1,  0,  2,  1,  1};
        int qa = -1, pa = 0, qb2 = -1, pb = 0;
#pragma unroll
        for (int k = 0; k < 16; ++k) if (k == q_) { qa = qbA[k]; pa = ptA[k]; qb2 = qbB[k]; pb = ptB[k]; }
        for (int it = 0; it < 2; ++it) { const int qq = it == 0 ? qa : qb2, pp = it == 0 ? pa : pb; if (qq < 0) continue;
            const BR cur = mkref(bh, qq, pp);
            moba::causal_swa_prime<moba::bf16, moba::bf16>(cur, W, lds, S);
            moba::causal_swa_block<moba::bf16, moba::bf16>(cur, cur, SEQ, W, lds, S); }
    } else {
        for (int item = vcu; item < 256; item += G) {
            const BR cur = mkref(item >> 4, item & 15, 0);
            moba::causal_swa_prime<moba::bf16, moba::bf16>(cur, W, lds, S);
            moba::causal_swa_block<moba::bf16, moba::bf16>(cur, cur, SEQ, W, lds, S); }
    }
}
__device__ __forceinline__ void moba_combine(KP P, int vcu, int G) {
    if (G != 256) return;
    const int tid = ltid(); const bf16* OL = (const bf16*)(P.ws + WS_OSL); const bf16* OU = (const bf16*)(P.ws + WS_OSU); bf16* AR = (bf16*)(P.ws + WS_AR);
    const float* STL = (const float*)(P.ws + WS_STL); const float* STU = (const float*)(P.ws + WS_STU);
    constexpr int NSPL = 16 - MOBA_SPLIT_QB; constexpr float C2 = 1.4426950408889634f * moba::SCALE;
    for (int item = vcu; item < 16 * NSPL * 2; item += G) {
        const int half = item & 1, k = item >> 1, bh = k / NSPL, qb = MOBA_SPLIT_QB + k % NSPL, b = bh >> 3, h = bh & 7;
        const int row = b * SEQ + qb * 256 + half * 128 + (tid >> 2), c0 = (tid & 3) * 32;
        const size_t so = ((size_t)row * 8 + h) * 2; const float mL = STL[so], lL = STL[so + 1], mU = STU[so], lU = STU[so + 1];
        const float m = fmaxf(mL, mU); const float wL = lL * __builtin_amdgcn_exp2f((mL - m) * C2), wU = lU * __builtin_amdgcn_exp2f((mU - m) * C2); const float inv = __builtin_amdgcn_rcpf(wL + wU);
        const float aL = wL * inv, aU = wU * inv; const size_t o = (size_t)row * DM + h * 128 + c0;
#pragma unroll
        for (int j = 0; j < 4; ++j) { const v4u l4 = *(const v4u*)(OL + o + 8 * j), u4 = *(const v4u*)(OU + o + 8 * j); v4u r4;
#pragma unroll
            for (int e = 0; e < 4; ++e) r4[e] = pk2(aL * bflo(l4[e]) + aU * bflo(u4[e]), aL * bfhi(l4[e]) + aU * bfhi(u4[e]));
            *(v4u*)(AR + o + 8 * j) = r4; }
    }
}
constexpr size_t WS_SKB = WS_KMEAN + 256 * 1024;
__device__ __forceinline__ void prologue_subkeys(KP P, int vcu, int G) {
    unsigned* dst = (unsigned*)(P.ws + WS_SKB);
    for (int i = vcu * NTHR + ltid(); i < 8 * 2 * 128 * 128 / 2; i += G * NTHR) dst[i] = pk2(P.sub_keys[2 * i], P.sub_keys[2 * i + 1]);
}
__device__ __forceinline__ unsigned f2key(float v) { const unsigned u = __float_as_uint(v); return u ^ ((u >> 31) ? 0xFFFFFFFFu : 0x80000000u); }
__device__ __forceinline__ float key2f(unsigned k) { return __uint_as_float(k ^ ((k >> 31) ? 0x80000000u : 0xFFFFFFFFu)); }
__device__ __forceinline__ unsigned umax3(unsigned a, unsigned b, unsigned c) { return max(max(a, b), c); }
__device__ __forceinline__ void peer_route_tiles(KP P, LAS unsigned char* lds, int tt0, int nitems, int h) {
    const int tid = ltid(), lane = tid & 63, wave = __builtin_amdgcn_readfirstlane(tid >> 6), l15 = lane & 15, q4 = lane >> 4;
    const bf16* PQ = (const bf16*)(P.ws + WS_PROJ); const bf16* SKB = (const bf16*)(P.ws + WS_SKB);
    int* ridx = (int*)(P.ws + WS_PROJ + 64 * MiB); float* rgate = (float*)(P.ws + WS_PROJ + 68 * MiB);
    for (int it_ = 0; it_ < nitems; ++it_) {
        LAS float* sval = (LAS float*)(lds + it_ * 16384); LAS int* sidx = (LAS int*)(lds + it_ * 16384 + 8192);
        const int tt = tt0 + it_, p = wave & 1, sub = wave >> 1, tl = sub * 16 + l15;
        const bf16* qp = PQ + ((size_t)tt * 64 + tl) * DM + h * 256 + p * 128 + 8 * q4;
        bf16x8 qb[4];
#pragma unroll
        for (int kk = 0; kk < 4; ++kk) qb[kk] = *(const bf16x8*)(qp + 32 * kk);
        const bf16* sk = SKB + ((size_t)((h * 2 + p) * 128 + l15)) * 128 + 8 * q4;
        unsigned key[32];
#pragma unroll
        for (int nt = 0; nt < 8; ++nt) { f32x4v acc = {0.f, 0.f, 0.f, 0.f};
#pragma unroll
            for (int kk = 0; kk < 4; ++kk) acc = __builtin_amdgcn_mfma_f32_16x16x32_bf16(*(const bf16x8*)(sk + nt * 16 * 128 + 32 * kk), qb[kk], acc, 0, 0, 0);
#pragma unroll
            for (int e = 0; e < 4; ++e) key[4 * nt + e] = (f2key(acc[e]) & ~127u) | (unsigned)(127 - (16 * nt + 4 * q4 + e)); }
#define CE(a_, b_) { const unsigned hi_ = max(KA[a_], KA[b_]), lo_ = min(KA[a_], KA[b_]); KA[a_] = hi_; KA[b_] = lo_; }
#define SORT16_NET CE(0,1) CE(2,3) CE(0,2) CE(1,3) CE(1,2) CE(4,5) CE(6,7) CE(4,6) CE(5,7) CE(5,6) CE(0,4) CE(2,6) CE(2,4) CE(1,5) CE(3,7) CE(3,5) CE(1,2) CE(3,4) CE(5,6) CE(8,9) CE(10,11) CE(8,10) CE(9,11) CE(9,10) CE(12,13) CE(14,15) CE(12,14) CE(13,15) CE(13,14) CE(8,12) CE(10,14) CE(10,12) CE(9,13) CE(11,15) CE(11,13) CE(9,10) CE(11,12) CE(13,14) CE(0,8) CE(4,12) CE(4,8) CE(2,10) CE(6,14) CE(6,10) CE(2,4) CE(6,8) CE(10,12) CE(1,9) CE(5,13) CE(5,9) CE(3,11) CE(7,15) CE(7,11) CE(3,5) CE(7,9) CE(11,13) CE(1,2) CE(3,4) CE(5,6) CE(7,8) CE(9,10) CE(11,12) CE(13,14)
#define BMERGE16(T_) _Pragma("unroll") for (int d_ = 8; d_ >= 1; d_ >>= 1) { _Pragma("unroll") for (int i_ = 0; i_ < 16; ++i_) if ((i_ & d_) == 0) { const unsigned hi_ = max(T_[i_], T_[i_ + d_]), lo_ = min(T_[i_], T_[i_ + d_]); T_[i_] = hi_; T_[i_ + d_] = lo_; } }
#define KA key
        SORT16_NET
#undef KA
#define KA (key + 16)
        SORT16_NET
#undef KA
        unsigned t16[16];
#pragma unroll
        for (int i = 0; i < 16; ++i) t16[i] = max(key[i], key[31 - i]);
        BMERGE16(t16)
        { const bool odd = (lane & 16) != 0; unsigned L[16];
#pragma unroll
          for (int i = 0; i < 16; ++i) L[i] = odd ? t16[15 - i] : t16[i];
#pragma unroll
          for (int i = 0; i < 16; ++i) { auto x = __builtin_amdgcn_permlane16_swap(L[i], L[i], false, false); t16[i] = max(x[0], x[1]); }
          BMERGE16(t16) }
        { const bool odd = (lane & 32) != 0; unsigned L[16];
#pragma unroll
          for (int i = 0; i < 16; ++i) L[i] = odd ? t16[15 - i] : t16[i];
#pragma unroll
          for (int i = 0; i < 16; ++i) { auto x = __builtin_amdgcn_permlane32_swap(L[i], L[i], false, false); t16[i] = max(x[0], x[1]); }
          BMERGE16(t16) }
#undef CE
#undef SORT16_NET
#undef BMERGE16
        if (q4 == 0) {
#pragma unroll
            for (int r4 = 0; r4 < 4; ++r4) {
                *(LAS f32x4*)(sval + (tl * 2 + p) * 16 + 4 * r4) = (f32x4){key2f(t16[4 * r4] & ~127u), key2f(t16[4 * r4 + 1] & ~127u), key2f(t16[4 * r4 + 2] & ~127u), key2f(t16[4 * r4 + 3] & ~127u)};
                *(LAS v4u*)(sidx + (tl * 2 + p) * 16 + 4 * r4) = (v4u){127u - (t16[4 * r4] & 127u), 127u - (t16[4 * r4 + 1] & 127u), 127u - (t16[4 * r4 + 2] & 127u), 127u - (t16[4 * r4 + 3] & 127u)}; }
        }
    }
    __syncthreads();
    {
        const int it_ = wave; const int tt = tt0 + it_;
        LAS float* sval = (LAS float*)(lds + it_ * 16384); LAS int* sidx = (LAS int*)(lds + it_ * 16384 + 8192);
        if (wave < nitems) {
            const LAS float* av = sval + (lane * 2) * 16; const LAS float* bv = av + 16; const LAS int* ai = sidx + (lane * 2) * 16; const LAS int* bi = ai + 16;
            unsigned hk[16];
            const float b0 = bv[0];
#pragma unroll
            for (int i4 = 0; i4 < 4; ++i4) { const f32x4 t4 = *(const LAS f32x4*)(av + 4 * i4);
#pragma unroll
                for (int e = 0; e < 4; ++e) hk[4 * i4 + e] = (f2key(t4[e] + b0) & ~255u) | (unsigned)(255 - (4 * i4 + e) * 16); }
            float bestv[16]; int beste[16];
#pragma unroll
            for (int r = 0; r < 16; ++r) {
                unsigned m0 = umax3(hk[0], hk[1], hk[2]), m1 = umax3(hk[3], hk[4], hk[5]), m2 = umax3(hk[6], hk[7], hk[8]), m3 = umax3(hk[9], hk[10], hk[11]);
                m0 = umax3(m0, hk[12], hk[13]); m1 = umax3(m1, hk[14], hk[15]);
                const unsigned best = max(max(m0, m1), max(m2, m3));
                const int f = 255 - (int)(best & 255u), bi_ = f >> 4, bj = f & 15;
                const float a_i = av[bi_]; bestv[r] = a_i + bv[bj]; beste[r] = ai[bi_] * 128 + bi[bj];
                const int nj = bj + 1;
                const unsigned nk = nj < 16 ? ((f2key(a_i + bv[nj & 15]) & ~255u) | (unsigned)(255 - (bi_ * 16 + nj))) : 0u;
#pragma unroll
                for (int i = 0; i < 16; ++i) hk[i] = i == bi_ ? nk : hk[i];
            }
            float se = 0.f; const float mx = bestv[0];
#pragma unroll
            for (int r = 0; r < 16; ++r) { bestv[r] = __expf(bestv[r] - mx); se += bestv[r]; }
            const float ise = 1.f / se; const size_t o = ((size_t)tt * 64 + lane) * 128 + h * 16;
#pragma unroll
            for (int r4 = 0; r4 < 4; ++r4) { *(v4u*)(ridx + o + 4 * r4) = (v4u){(unsigned)beste[4 * r4], (unsigned)beste[4 * r4 + 1], (unsigned)beste[4 * r4 + 2], (unsigned)beste[4 * r4 + 3]};
                *(f32x4*)(rgate + o + 4 * r4) = (f32x4){bestv[4 * r4] * ise, bestv[4 * r4 + 1] * ise, bestv[4 * r4 + 2] * ise, bestv[4 * r4 + 3] * ise}; }
        }
        __syncthreads();
    }
}
#define XB_TMO      128
#define XB_XCNT(j)  (256  + 64 * (j))
#define XB_XSUB(j)  (1280 + 64 * (j))
#define XB_XGEN(j)  (2304 + 64 * (j))
#define XB_TOP      3328
#define XB_TOPGEN   3392
#define XCD_BAR_WORDS 3456
#define XB_SPIN_CAP (1u << 18)

__device__ __forceinline__ unsigned xb_ld(unsigned* p)              { return __hip_atomic_load(p, __ATOMIC_RELAXED, __HIP_MEMORY_SCOPE_AGENT); }
__device__ __forceinline__ unsigned xb_add(unsigned* p, unsigned v) { return __hip_atomic_fetch_add(p, v, __ATOMIC_RELAXED, __HIP_MEMORY_SCOPE_AGENT); }
__device__ __forceinline__ unsigned xb_xcc_id() { return (unsigned)__builtin_amdgcn_s_getreg((3 << 11) | 20) & 0xFu; }
#define XB_SPIN(cond, bar) do { unsigned _sp = 0; while (cond) { __builtin_amdgcn_s_sleep(1); \
    if ((++_sp & 255u) == 0u) { if (xb_ld(&(bar)[XB_TMO])) break; if (_sp > XB_SPIN_CAP) { atomicAdd(&(bar)[XB_TMO], 1u); break; } } } } while (0)

struct XcdBarrier {
    unsigned* bar; unsigned x;
    volatile LAS unsigned* st;
};

__device__ __forceinline__ XcdBarrier xcd_barrier_post(unsigned* bar, volatile LAS unsigned* st) {
    XcdBarrier b; b.bar = bar; b.x = xb_xcc_id(); b.st = st;
    if (threadIdx.x == 0) (void)xb_add(&bar[XB_XCNT(b.x)], 1u);
    return b;
}
__device__ __forceinline__ void xcd_barrier_complete(unsigned* bar, unsigned x, unsigned& nloc, unsigned& nx) {
    const unsigned G = gridDim.x * gridDim.y * gridDim.z;
    unsigned sum, cnt, mine, sp = 0u;
    for (;;) {
        sum = 0u; cnt = 0u; mine = 0u;
#pragma unroll
        for (unsigned j = 0; j < 16; ++j) { const unsigned c = xb_ld(&bar[XB_XCNT(j)]); sum += c; cnt += (c > 0u) ? 1u : 0u; mine = (j == x) ? c : mine; }
        if (sum == G) break;
        __builtin_amdgcn_s_sleep(1);
        if ((++sp & 255u) == 0u) { if (xb_ld(&bar[XB_TMO])) break; if (sp > XB_SPIN_CAP) { atomicAdd(&bar[XB_TMO], 1u); break; } }
    }
    nloc = mine > 0u ? mine : 1u; nx = cnt > 0u ? cnt : 1u;
}

__device__ __forceinline__ void xcd_barrier(const XcdBarrier& b) {
    asm volatile("s_waitcnt vmcnt(0)" ::: "memory");
    __syncthreads();
    if (threadIdx.x == 0) {
        unsigned* bar = b.bar;
        __builtin_amdgcn_s_waitcnt(0);
        unsigned nloc = b.st[0], nx = b.st[1];
        if (nloc == 0u) { xcd_barrier_complete(bar, b.x, nloc, nx); b.st[0] = nloc; b.st[1] = nx; }
        const unsigned old = xb_add(&bar[XB_XSUB(b.x)], 1u);
        const unsigned gen = old / nloc;
        if (old + 1u == (gen + 1u) * nloc) {
            __builtin_amdgcn_fence(__ATOMIC_RELEASE, "agent");
            asm volatile("s_waitcnt vmcnt(0)" ::: "memory");
            const unsigned og = xb_add(&bar[XB_TOP], 1u);
            const unsigned tg = og / nx;
            if (og + 1u == (tg + 1u) * nx) xb_add(&bar[XB_TOPGEN], 1u);
            else XB_SPIN(xb_ld(&bar[XB_TOPGEN]) == tg, bar);
            __builtin_amdgcn_fence(__ATOMIC_ACQUIRE, "agent");
            xb_add(&bar[XB_XGEN(b.x)], 1u);
            asm volatile("s_waitcnt vmcnt(0)" ::: "memory");
        } else {
            XB_SPIN(xb_ld(&bar[XB_XGEN(b.x)]) == gen, bar);
            __builtin_amdgcn_fence(__ATOMIC_ACQUIRE, "agent");
            asm volatile("s_waitcnt vmcnt(0)" ::: "memory");
        }
    }
    __syncthreads();
}
#ifndef MK_ONE_LAUNCH
#define MK_ONE_LAUNCH 1
#endif
constexpr int N_PHASES = 11;
__global__ void __launch_bounds__(NTHR, 2) mega(Params Pkernarg) {
    extern __shared__ __attribute__((aligned(16))) unsigned char lds_raw[];
    LAS unsigned char* lds = (LAS unsigned char*)lds_raw;
    const int tid = ltid();
    const int G = gridDim.x, bx = blockIdx.x; const int vcu = (G % 8 == 0) ? (bx % 8) * (G / 8) + bx / 8 : bx;
    for (int u = tid; u < (LDS_BYTES - LDSCTL_OFF) / 4; u += NTHR) ((LAS unsigned*)(lds + LDSCTL_OFF))[u] = 0u;
    __syncthreads();
#if MK_ONE_LAUNCH
    XcdBarrier bar = xcd_barrier_post((unsigned*)(params_ptr()->ws + WS_CTL) + CW_BAR + params_ptr()->bar_li * XCD_BAR_WORDS, (volatile LAS unsigned*)(lds + MISC_OFF) + 8);
#define GRID_BAR() xcd_barrier(bar)
#else
#define GRID_BAR() do {} while (0)
#endif
#ifndef PHOFF
#define PHOFF 0
#endif
#define IN(k) (!((PHOFF >> (k)) & 1))
#define BOTH(k) (IN(k) && IN((k) + 1))
    if (IN(0)) { KP P = *params_ptr(); phase_prologue(P, lds, vcu, G); prologue_subkeys(P, vcu, G); prologue_lora(P, vcu, G); if (BOTH(0)) GRID_BAR(); }
    if (IN(1)) { KP P = *params_ptr();
        pg8::Gemm g{(const bf16*)(P.ws + WS_XN), (const bf16*)(P.ws + WS_WIN), TT, INCP, DM}; pg8::Order1 S; S.init(TT, INCP, G, bx);
        pg8::EpiBf16<0> E{(bf16*)(P.ws + WS_PROJ), INCP, nullptr, 0, 0, 1.f};
        pg8::gemm_phase<pg8::EpiBf16<0>, pg8::Order1, true, true>(lds, g, S, E);
        phase_convert_tables(P, lds);
        if (BOTH(1)) GRID_BAR();
    }
    if (IN(2)) { KP P = *params_ptr(); phase_act(P, vcu, G); phase_kmean(P, lds, vcu, G); if (BOTH(2)) GRID_BAR(); }
    if (IN(3)) { KP P = *params_ptr(); phase_rwkv_stage_a(P, lds, vcu, G); if (BOTH(3)) GRID_BAR(); }
    if (IN(4)) { KP P = *params_ptr(); if ((vcu & 15) < 2 && vcu < 256) rwkv_stage_b(P, lds, (vcu >> 4) * 2 + (vcu & 15)); phase_moba(P, (char*)lds_raw, vcu, G); }
    if (IN(5)) { GRID_BAR(); KP P = *params_ptr(); moba_combine(P, vcu, G); GRID_BAR(); }
    if (IN(6)) { KP P = *params_ptr();
        pg8::Gemm g{(const bf16*)(P.ws + WS_AR), (const bf16*)(P.ws + WS_WOUT), TT, DM, DM}; pg8::StaticOrder S; S.init(TT, DM, G, bx);
        pg8::EpiH E{P.x, (bf16*)(P.ws + WS_XN), (float*)(P.ws + WS_SSP), DM};
        pg8::gemm_phase<pg8::EpiH, pg8::StaticOrder, true, true>(lds, g, S, E);
        if (BOTH(6)) GRID_BAR();
    }
    if (IN(8)) { KP P = *params_ptr(); phase_rstd(P, vcu, G); GRID_BAR();
        pg8::Gemm g{(const bf16*)(P.ws + WS_XN), (const bf16*)(P.ws + WS_WQ), TT, DM, DM}; pg8::StaticOrder S; S.init(TT, DM, G, bx);
        pg8::EpiBf16Row E{(bf16*)(P.ws + WS_PROJ), DM, (const float*)(P.ws + WS_SSP + 2 * MiB)};
        pg8::gemm_phase<pg8::EpiBf16Row, pg8::StaticOrder, true, true>(lds, g, S, E);
        if (G == 256) { const int wg_ = (bx & 7) * 32 + (bx >> 3); pg8::Unit u; u.pm = (wg_ >> 6) * 8 + (wg_ & 7); u.pn = (wg_ & 63) >> 3;
            asm volatile("s_waitcnt vmcnt(0)" ::: "memory"); __syncthreads(); __builtin_amdgcn_fence(__ATOMIC_ACQUIRE, "agent"); asm volatile("s_waitcnt vmcnt(0)" ::: "memory");
            peer_route_tiles(P, lds, 4 * u.pm, 4, u.pn);
        } else if (G != 256) { GRID_BAR(); for (int item = vcu; item < 1024; item += G) peer_route_tiles(P, lds, item >> 3, 1, item & 7); }
        if (BOTH(8)) GRID_BAR();
    }
    if (IN(10)) { KP P = *params_ptr(); phase_peer_sliced(P, lds, bx, G); }
#undef IN
#undef BOTH
}

extern "C" void kernel_launch(void* const* d_in, const int* in_sizes, int n_in, void* d_out, int out_size, void* d_ws, size_t ws_size, hipStream_t stream) {
    static int grid = 0;
    if (grid == 0) {
        if (n_in != 21 || in_sizes[0] != TT * DM || out_size != TT * DM || ws_size < WS_END) {
            fprintf(stderr, "kernel_launch: unexpected shapes: n_in %d in0 %d out %d ws %zu\n", n_in, n_in > 0 ? in_sizes[0] : -1, out_size, ws_size); grid = -1; return; }
        int dev = 0, cus = 0;
        if (hipGetDevice(&dev) != hipSuccess || hipDeviceGetAttribute(&cus, hipDeviceAttributeMultiprocessorCount, dev) != hipSuccess) { grid = -1; return; }
        if (hipFuncSetAttribute((const void*)mega, hipFuncAttributeMaxDynamicSharedMemorySize, LDS_BYTES) != hipSuccess) { fprintf(stderr, "kernel_launch: hipFuncSetAttribute failed\n"); grid = -1; return; }
        int per_cu = 0;
        if (hipOccupancyMaxActiveBlocksPerMultiprocessor(&per_cu, (const void*)mega, NTHR, LDS_BYTES) != hipSuccess || per_cu < 1) fprintf(stderr, "kernel_launch: occupancy query says %d blocks per CU\n", per_cu);
        (void)hipGetLastError();
        grid = cus;
    }
    if (grid < 0) return;
    (void)hipMemsetAsync((char*)d_ws + WS_CTL, 0, CTL_ZERO_BYTES, stream);
    Params p{};
    p.x = (const float*)d_in[0]; p.norm1_g = (const float*)d_in[1]; p.w_in = (const float*)d_in[2]; p.mu = (const float*)d_in[3]; p.w0 = (const float*)d_in[4];
    p.w2 = (const float*)d_in[5]; p.a0 = (const float*)d_in[6]; p.a2 = (const float*)d_in[7]; p.g2 = (const float*)d_in[8]; p.k_k = (const float*)d_in[9];
    p.k_a = (const float*)d_in[10]; p.r_k = (const float*)d_in[11]; p.ln_g = (const float*)d_in[12]; p.ln_b = (const float*)d_in[13]; p.w_out = (const float*)d_in[14];
    p.norm2_g = (const float*)d_in[15]; p.wq = (const float*)d_in[16]; p.sub_keys = (const float*)d_in[17]; p.pu = (const float*)d_in[18]; p.pv = (const float*)d_in[19];
    p.final_g = (const float*)d_in[20]; p.out = (float*)d_out; p.ws = (unsigned char*)d_ws;
    p.ph_lo = 0; p.ph_hi = N_PHASES; p.bar_li = 0;
    hipLaunchKernelGGL(mega, dim3(grid), dim3(NTHR), LDS_BYTES, stream, p);
}
```

```cpp
#include <hip/hip_runtime.h>
#include <cstdio>
#include <cstdint>
__device__ __forceinline__ int ltid() { int t = threadIdx.x; asm volatile("" : "+v"(t)); return t; }
namespace pg8 {
#define PG8_LAS __attribute__((address_space(3)))
typedef unsigned short bf16_t;
typedef short bf16x8 __attribute__((ext_vector_type(8)));
typedef float f32x4 __attribute__((ext_vector_type(4)));
typedef unsigned u32x4 __attribute__((ext_vector_type(4)));
constexpr int BM = 256, BK = 64, HALF = 128, HTB = HALF * BK * 2  , STAGE_BYTES = 8 * HTB, NXCD = 8, WGM = 8;

__host__ __device__ __forceinline__ int lds_byte(int r, int c) { const int st = (r >> 4) * 2 + (c >> 5), rr = r & 15, cc = c & 31, ob = rr * 64 + cc * 2; return st * 1024 + (ob ^ (((ob >> 9) & 1) << 5)); }
__host__ __device__ __forceinline__ void stage_rc(int b, int& R, int& C) { const int st = b / 1024, sb = b % 1024, swz = sb ^ (((sb >> 9) & 1) << 5); R = (st >> 1) * 16 + swz / 64; C = (st & 1) * 32 + (swz % 64) / 2; }
__host__ __device__ __forceinline__ int perm32(int rho) { const int n = rho >> 4, i = rho & 15; return 8 * (i >> 2) + 4 * n + (i & 3); }

struct Unit { int pm, pn; };
struct Gemm { const bf16_t* A; const bf16_t* Bt; int M, N, K; };

struct StaticOrder {
    int nM, nN, nwg, G, c;
    __host__ __device__ void init(int M, int N, int G_, int c_) { nM = M / BM; nN = N / BM; nwg = nM * nN; G = G_; c = c_; }
    __host__ __device__ bool next(int i, Unit& u) const {
        const long L = (long)i * G + c; if (L >= nwg) return false;
        int wgid = (int)L; { const int q = nwg / NXCD, r = nwg % NXCD, xcd = wgid % NXCD, off = wgid / NXCD; wgid = (xcd < r ? xcd * (q + 1) : r * (q + 1) + (xcd - r) * q) + off; }
        const int nig = WGM * nN, gid = wgid / nig, fm = gid * WGM, gsz = (nM - fm) < WGM ? (nM - fm) : WGM;
        u.pm = fm + ((wgid % nig) % gsz); u.pn = (wgid % nig) / gsz; return true;
    }
    __device__ __forceinline__ void a_ready(const Unit&) const {}
    __device__ __forceinline__ void done(const Unit&) const {}
};

__device__ __forceinline__ unsigned cvt_pk_bf16(float lo, float hi) { unsigned r; asm volatile("v_cvt_pk_bf16_f32 %0, %1, %2" : "=v"(r) : "v"(lo), "v"(hi)); return r; }
typedef float f32x2 __attribute__((ext_vector_type(2)));
__device__ __forceinline__ f32x2 gelu_pk(f32x2 v) {
    const f32x2 av = __builtin_elementwise_abs(v), d = av * 0.2316418882f + 1.0f;
    f32x2 t; t.x = __builtin_amdgcn_rcpf(d.x); t.y = __builtin_amdgcn_rcpf(d.y);
    f32x2 q = t * 0.5307027145f + (-0.7265760135f); q = q * t + 0.7107068705f; q = q * t + (-0.142248368f); q = q * t + 0.127414796f; q = q * t;
    const f32x2 s = (v * v) * (-0.72134752044f);
    f32x2 e; e.x = __builtin_amdgcn_exp2f(s.x); e.y = __builtin_amdgcn_exp2f(s.y);
    const f32x2 m = v * (q * e), r = v - m;
    f32x2 o; o.x = v.x < 0.f ? m.x : r.x; o.y = v.y < 0.f ? m.y : r.y; return o;
}

template <int ACT  > struct EpiBf16 {
    static constexpr bool PERM = true, AFTER_DRAIN = false; static_assert(ACT == 0 || ACT == 1, "EpiBf16: ACT is 0 (none) or 1 (gelu_pk)");
    bf16_t* O; int ldc; const float* bias; int split_cols; size_t split_stride; float scale0;
    __device__ __forceinline__ void operator()(const f32x4 (&acc)[2][2][4][2], const Unit& u, int wr, int wc, int fr, int fq) const {
        const int row0 = u.pm * BM + wr * 64 + fr; int colt = u.pn * BM; bf16_t* base = O;
        float sc = 1.f; if (split_cols) { const int t = colt / split_cols; base += (size_t)t * split_stride; colt -= t * split_cols; if (t == 0) sc = scale0; }
        const int col0 = colt + wc * 32 + 8 * fq, bcol0 = u.pn * BM + wc * 32 + 8 * fq;
        f32x4 bv[2][2];
#pragma unroll
        for (int bj = 0; bj < 2; ++bj)
#pragma unroll
            for (int n = 0; n < 2; ++n) bv[bj][n] = bias ? *(const f32x4*)(bias + bcol0 + bj * HALF + 4 * n) : (f32x4){0.f, 0.f, 0.f, 0.f};
#pragma unroll
        for (int ai = 0; ai < 2; ++ai)
#pragma unroll
            for (int m = 0; m < 4; ++m) { bf16_t* rowp = base + (size_t)(row0 + ai * HALF + m * 16) * ldc + col0;
#pragma unroll
                for (int bj = 0; bj < 2; ++bj) { f32x4 v0 = acc[ai][bj][m][0] + bv[bj][0], v1 = acc[ai][bj][m][1] + bv[bj][1];
                    if (ACT == 1) { f32x2 a = gelu_pk((f32x2){v0[0], v0[1]}), b = gelu_pk((f32x2){v0[2], v0[3]}), c = gelu_pk((f32x2){v1[0], v1[1]}), d = gelu_pk((f32x2){v1[2], v1[3]});
                        v0 = (f32x4){a.x, a.y, b.x, b.y}; v1 = (f32x4){c.x, c.y, d.x, d.y}; }
                    v0 = v0 * sc; v1 = v1 * sc; u32x4 w; w.x = cvt_pk_bf16(v0[0], v0[1]); w.y = cvt_pk_bf16(v0[2], v0[3]); w.z = cvt_pk_bf16(v1[0], v1[1]); w.w = cvt_pk_bf16(v1[2], v1[3]);
                    *(u32x4*)(rowp + bj * HALF) = w; } }
    }
};
template <class Epi, class Sched, bool ALIGN_EPI = false, bool SP2 = false>
__device__ __forceinline__ void gemm_phase(PG8_LAS unsigned char* lds, const Gemm g, const Sched& S, const Epi& E) {
    const int tid = ltid(), wid = __builtin_amdgcn_readfirstlane(tid >> 6), lane = tid & 63, wr = wid >> 2, wc = wid & 3, fr = lane & 15, fq = lane >> 4;
    const int K = g.K, nt = K / BK;
    unsigned voffA[2], voffB[2];
#pragma unroll
    for (int i = 0; i < 2; ++i) { int R, C; stage_rc(tid * 16 + i * 8192, R, C); const int Rb = Epi::PERM ? ((R & ~31) + perm32(R & 31)) : R;
        voffA[i] = (unsigned)(R * K + C) * 2u; voffB[i] = (unsigned)(Rb * K + C) * 2u; }
    const size_t kstep = (size_t)(BK * 2);
    const size_t hstep = (size_t)HALF * K * 2;
    const size_t tstep = 2 * hstep;
    const unsigned ldsw = (unsigned)wid * 1024u;
    const int aoff = lds_byte(wr * 64 + fr, fq * 8), boff = lds_byte(wc * 32 + fr, fq * 8);
#define PG8_SA(b, h) (((b) * 2 + (h)) * HTB)
#define PG8_SB(b, h) ((4 + (b) * 2 + (h)) * HTB)
#define PG8_STAGE(bufoff, gbase, voff) do { _Pragma("unroll") for (int _i = 0; _i < 2; ++_i) \
        __builtin_amdgcn_global_load_lds((const unsigned*)((const char*)(gbase) + (voff)[_i]), (PG8_LAS unsigned*)(lds + (bufoff) + ldsw + _i * 8192), 16, 0, 0); } while (0)
#define PG8_LDA(dst, b, h) do { _Pragma("unroll") for (int m = 0; m < 4; ++m) _Pragma("unroll") for (int k = 0; k < 2; ++k) dst[m][k] = *(const PG8_LAS bf16x8*)(lds + PG8_SA(b, h) + aoff + m * 2048 + k * 1024); } while (0)
#define PG8_LDB(dst, b, h) do { _Pragma("unroll") for (int n = 0; n < 2; ++n) _Pragma("unroll") for (int k = 0; k < 2; ++k) dst[n][k] = *(const PG8_LAS bf16x8*)(lds + PG8_SB(b, h) + boff + n * 2048 + k * 1024); } while (0)
#define PG8_MMA(ai, bj, At, Bt) do { __builtin_amdgcn_s_setprio(1); _Pragma("unroll") for (int m = 0; m < 4; ++m) _Pragma("unroll") for (int n = 0; n < 2; ++n) _Pragma("unroll") for (int k = 0; k < 2; ++k) \
        acc[ai][bj][m][n] = __builtin_amdgcn_mfma_f32_16x16x32_bf16(Bt[n][k], At[m][k], acc[ai][bj][m][n], 0, 0, 0); __builtin_amdgcn_s_setprio(0); } while (0)
#define PG8_WAIT_V(n) asm volatile("s_waitcnt vmcnt(" #n ")" ::: "memory")
#define PG8_WAIT_L(n) asm volatile("s_waitcnt lgkmcnt(" #n ")" ::: "memory")
#define PG8_BAR __builtin_amdgcn_s_barrier()
#define PG8_SCHED __builtin_amdgcn_sched_barrier(0)
    Unit cur, nxt; int ui = 0;
    if (!S.next(0, cur)) return;
    f32x4 acc[2][2][4][2];
#pragma unroll
    for (int a = 0; a < 2; ++a)
#pragma unroll
        for (int b = 0; b < 2; ++b)
#pragma unroll
            for (int m = 0; m < 4; ++m)
#pragma unroll
                for (int n = 0; n < 2; ++n) acc[a][b][m][n] = (f32x4){0.f, 0.f, 0.f, 0.f};
    bf16x8 At[4][2], B0[2][2], B1[2][2];
    const char* cA = (const char*)g.A + (size_t)cur.pm * tstep; const char* cB = (const char*)g.Bt + (size_t)cur.pn * tstep;
    S.a_ready(cur);
    if constexpr (SP2) {
        PG8_STAGE(PG8_SB(0, 0), cB, voffB); PG8_STAGE(PG8_SB(0, 1), cB + hstep, voffB); PG8_STAGE(PG8_SA(0, 0), cA, voffA); PG8_STAGE(PG8_SA(0, 1), cA + hstep, voffA);
        if (wr == 1) PG8_BAR;
        PG8_WAIT_V(2); PG8_BAR;
        PG8_STAGE(PG8_SB(1, 0), cB + kstep, voffB); PG8_STAGE(PG8_SA(1, 0), cA + kstep, voffA); PG8_STAGE(PG8_SB(1, 1), cB + hstep + kstep, voffB);
        PG8_WAIT_V(6); PG8_BAR;
    } else {
        PG8_STAGE(PG8_SB(0, 0), cB, voffB); PG8_STAGE(PG8_SA(0, 0), cA, voffA); PG8_STAGE(PG8_SB(0, 1), cB + hstep, voffB); PG8_STAGE(PG8_SA(0, 1), cA + hstep, voffA);
        if (wr == 1) PG8_BAR;
        PG8_WAIT_V(4); PG8_BAR;
        PG8_STAGE(PG8_SB(1, 0), cB + kstep, voffB); PG8_STAGE(PG8_SA(1, 0), cA + kstep, voffA); PG8_STAGE(PG8_SB(1, 1), cB + hstep + kstep, voffB);
        PG8_WAIT_V(6); PG8_BAR;
    }
    for (;;) {
        const bool has_next = S.next(ui + 1, nxt);
        const char* nA = has_next ? (const char*)g.A + (size_t)nxt.pm * tstep : cA; const char* nB = has_next ? (const char*)g.Bt + (size_t)nxt.pn * tstep : cB;
        for (int t = 0; t < nt; t += 2) {
            const bool last = (t == nt - 2);
            const char* a1 = cA + (size_t)(t + 1) * kstep;
            const char* a2 = last ? nA : cA + (size_t)(t + 2) * kstep; const char* b2 = last ? nB : cB + (size_t)(t + 2) * kstep;
            const char* a3 = a2 + kstep; const char* b3 = b2 + kstep;
            if (last && has_next) S.a_ready(nxt);
            if constexpr (SP2) {
            PG8_LDB(B0, 0, 0); PG8_LDB(B1, 0, 1); PG8_SCHED; PG8_LDA(At, 0, 0); PG8_STAGE(PG8_SA(1, 1), a1 + hstep, voffA);
            PG8_WAIT_V(8); PG8_WAIT_L(0); PG8_BAR; PG8_MMA(0, 0, At, B0); PG8_MMA(0, 1, At, B1); PG8_BAR; PG8_SCHED;
            PG8_LDA(At, 0, 1); PG8_STAGE(PG8_SB(0, 0), b2, voffB); PG8_STAGE(PG8_SB(0, 1), b2 + hstep, voffB); PG8_STAGE(PG8_SA(0, 0), a2, voffA);
            PG8_WAIT_V(8); PG8_WAIT_L(0); PG8_BAR; PG8_MMA(1, 0, At, B0); PG8_MMA(1, 1, At, B1); PG8_BAR; PG8_SCHED;
            PG8_LDB(B0, 1, 0); PG8_LDB(B1, 1, 1); PG8_SCHED; PG8_LDA(At, 1, 0); PG8_STAGE(PG8_SA(0, 1), a2 + hstep, voffA);
            PG8_WAIT_V(8); PG8_WAIT_L(0); PG8_BAR; PG8_MMA(0, 0, At, B0); PG8_MMA(0, 1, At, B1); PG8_BAR; PG8_SCHED;
            PG8_LDA(At, 1, 1); PG8_STAGE(PG8_SB(1, 0), b3, voffB); PG8_STAGE(PG8_SB(1, 1), b3 + hstep, voffB); PG8_STAGE(PG8_SA(1, 0), a3, voffA);
            PG8_WAIT_V(8); PG8_WAIT_L(0); PG8_BAR; PG8_MMA(1, 0, At, B0); PG8_MMA(1, 1, At, B1); PG8_BAR; PG8_SCHED;
            } else {
            PG8_LDB(B0, 0, 0); PG8_SCHED; PG8_LDA(At, 0, 0); PG8_STAGE(PG8_SA(1, 1), a1 + hstep, voffA);
            PG8_WAIT_L(8); PG8_BAR; PG8_WAIT_L(0); PG8_MMA(0, 0, At, B0); PG8_BAR; PG8_SCHED;
            PG8_LDB(B1, 0, 1); PG8_STAGE(PG8_SB(0, 0), b2, voffB);
            PG8_BAR; PG8_WAIT_L(0); PG8_MMA(0, 1, At, B1); PG8_BAR;
            PG8_LDA(At, 0, 1); PG8_STAGE(PG8_SA(0, 0), a2, voffA);
            PG8_BAR; PG8_WAIT_L(0); PG8_MMA(1, 0, At, B0); PG8_BAR; PG8_SCHED;
            PG8_STAGE(PG8_SB(0, 1), b2 + hstep, voffB);
            PG8_WAIT_V(6); PG8_BAR; PG8_MMA(1, 1, At, B1); PG8_BAR;
            PG8_LDB(B0, 1, 0); PG8_SCHED; PG8_LDA(At, 1, 0); PG8_STAGE(PG8_SA(0, 1), a2 + hstep, voffA);
            PG8_WAIT_L(8); PG8_BAR; PG8_WAIT_L(0); PG8_MMA(0, 0, At, B0); PG8_BAR; PG8_SCHED;
            PG8_LDB(B1, 1, 1); PG8_STAGE(PG8_SB(1, 0), b3, voffB);
            PG8_BAR; PG8_WAIT_L(0); PG8_MMA(0, 1, At, B1); PG8_BAR;
            PG8_LDA(At, 1, 1); PG8_STAGE(PG8_SA(1, 0), a3, voffA);
            PG8_BAR; PG8_WAIT_L(0); PG8_MMA(1, 0, At, B0); PG8_BAR; PG8_SCHED;
            PG8_STAGE(PG8_SB(1, 1), b3 + hstep, voffB);
            PG8_WAIT_V(6); PG8_BAR; PG8_MMA(1, 1, At, B1); PG8_BAR;
            }
        }
        if constexpr (ALIGN_EPI) { if (wr == 0) PG8_BAR; }
        if constexpr (!Epi::AFTER_DRAIN) { E(acc, cur, wr, wc, fr, fq); S.done(cur); }
        if (!has_next) break;
#pragma unroll
        for (int a = 0; a < 2; ++a)
#pragma unroll
            for (int b = 0; b < 2; ++b)
#pragma unroll
                for (int m = 0; m < 4; ++m)
#pragma unroll
                    for (int n = 0; n < 2; ++n) acc[a][b][m][n] = (f32x4){0.f, 0.f, 0.f, 0.f};
        cur = nxt; cA = nA; cB = nB; ++ui;
        if constexpr (ALIGN_EPI) { if (wr == 1) PG8_BAR; }
    }
    PG8_WAIT_V(0);
    if constexpr (!ALIGN_EPI) { if (wr == 0) PG8_BAR; }
    PG8_BAR;
    if constexpr (Epi::AFTER_DRAIN) { E.fused(acc, cur, wr, wc, fr, fq, lds, wid, lane); S.done(cur); }
#undef PG8_SA
#undef PG8_SB
#undef PG8_STAGE
#undef PG8_LDA
#undef PG8_LDB
#undef PG8_MMA
#undef PG8_WAIT_V
#undef PG8_WAIT_L
#undef PG8_BAR
#undef PG8_SCHED
}
}
#define GAS __attribute__((address_space(1)))
#define LAS __attribute__((address_space(3)))
typedef unsigned short bf16;
typedef unsigned v4u __attribute__((ext_vector_type(4)));
typedef unsigned v2u __attribute__((ext_vector_type(2)));
typedef float f32x4 __attribute__((ext_vector_type(4)));
constexpr int NWAVES = 8, NTHR = 512;
constexpr int TT = 8192, DM = 2048, SEQ = 4096;
constexpr int INC = 6592, INCP = 6656;
constexpr int C_AK = 1024, C_AV = 2048, C_RW = 3072;
constexpr int RWC = 3520;
constexpr float RMS_EPS = 1e-6f;
constexpr size_t MiB = 1u << 20;
constexpr size_t WS_CTL = 0, CTL_ZERO_BYTES = 1 * MiB;
constexpr size_t WS_WIN = 1 * MiB;
constexpr size_t WS_WOUT = 27 * MiB;
constexpr size_t WS_WQ = 35 * MiB;
constexpr size_t WS_XN = 43 * MiB;
constexpr size_t WS_PROJ = 75 * MiB;
constexpr size_t WS_AR = 179 * MiB;
constexpr size_t WS_H = 211 * MiB;
constexpr size_t WS_RWA = 275 * MiB;
constexpr size_t WS_CHK = 339 * MiB;
constexpr size_t WS_KMEAN = 467 * MiB;
constexpr size_t WS_ACT = WS_H;
constexpr size_t WS_SSP = WS_WIN + 4 * MiB;
constexpr size_t WS_LORA = 468 * MiB;
constexpr size_t WS_END = 469 * MiB;
constexpr int CW_BAR = 4096, CW_MOBA_CTR = 16384, CW_SS = 32768;
constexpr int RING_BYTES = 147456, LDSCTL_OFF = RING_BYTES, MISC_OFF = LDSCTL_OFF + 320, LDS_BYTES = 163840;

struct Params {
    const float* x; const float* norm1_g; const float* w_in; const float* mu; const float* w0; const float* w2; const float* a0; const float* a2; const float* g2;
    const float* k_k; const float* k_a; const float* r_k; const float* ln_g; const float* ln_b; const float* w_out; const float* norm2_g; const float* wq;
    const float* sub_keys; const float* pu; const float* pv; const float* final_g;
    float* out; unsigned char* ws;
    int ph_lo, ph_hi, bar_li, pad;
};

typedef const __attribute__((address_space(4))) Params& KP;
__device__ __forceinline__ const __attribute__((address_space(4))) Params* params_ptr() {
    const __attribute__((address_space(4))) Params* ka = (const __attribute__((address_space(4))) Params*)__builtin_amdgcn_kernarg_segment_ptr(); asm volatile("" : "+s"(ka)); return ka; }
typedef float f32x2_t __attribute__((ext_vector_type(2))); typedef __bf16 bf16x2_t __attribute__((ext_vector_type(2)));
__device__ __forceinline__ unsigned pk2(float lo, float hi) { const f32x2_t v = {lo, hi}; const bf16x2_t b = __builtin_convertvector(v, bf16x2_t); return __builtin_bit_cast(unsigned, b); }
__device__ __forceinline__ unsigned f2bf(float f) { return pk2(f, 0.f) & 0xffffu; }
__device__ __forceinline__ float bf2f(bf16 v) { return __builtin_bit_cast(float, (unsigned)v << 16); }
__device__ __forceinline__ float bflo(unsigned u) { return __builtin_bit_cast(float, u << 16); }
__device__ __forceinline__ float bfhi(unsigned u) { return __builtin_bit_cast(float, u & 0xffff0000u); }
#define DPP_F(v, ctrl) __builtin_bit_cast(float, __builtin_amdgcn_update_dpp(0, __builtin_bit_cast(int, (v)), (ctrl), 0xf, 0xf, true))
__device__ __forceinline__ float wave_sum(float v) {
    v += DPP_F(v, 0xB1);
    v += DPP_F(v, 0x4E);
    v += DPP_F(v, 0x141);
    v += DPP_F(v, 0x140);
    const int b = __builtin_bit_cast(int, v);
    return (__builtin_bit_cast(float, __builtin_amdgcn_readlane(b, 0)) + __builtin_bit_cast(float, __builtin_amdgcn_readlane(b, 16))) +
           (__builtin_bit_cast(float, __builtin_amdgcn_readlane(b, 32)) + __builtin_bit_cast(float, __builtin_amdgcn_readlane(b, 48)));
}
__device__ __forceinline__ float wave_max(float v) {
#pragma unroll
    for (int o = 1; o < 64; o <<= 1) v = fmaxf(v, __shfl_xor(v, o));
    return v;
}
#define LDS_WAIT() asm volatile("s_waitcnt lgkmcnt(0)" ::: "memory")

__device__ __forceinline__ void p0_transpose_item(const float* W, int K, int N, bf16* WT, LAS float* scr, int item, int lane, const float* ksc = nullptr) {
    const int nblk = N / 32, kb = item / nblk, nb = item % nblk, k0 = 64 * kb, n0 = 32 * nb;
    float wv[32];
#pragma unroll
    for (int i = 0; i < 32; ++i) wv[i] = W[(size_t)(k0 + 2 * i + (lane >> 5)) * N + n0 + (lane & 31)];
#pragma unroll
    for (int i = 0; i < 32; ++i) { const int kk = 2 * i + (lane >> 5); scr[kk * 33 + (lane & 31)] = ksc ? wv[i] * ksc[k0 + kk] : wv[i]; }
    LDS_WAIT(); asm volatile("" ::: "memory");
    const int c = lane & 7;
#pragma unroll
    for (int j = 0; j < 4; ++j) { const int n = (lane >> 3) + 8 * j; const LAS float* s = scr + (8 * c) * 33 + n;
        v4u o; o.x = pk2(s[0 * 33], s[1 * 33]); o.y = pk2(s[2 * 33], s[3 * 33]); o.z = pk2(s[4 * 33], s[5 * 33]); o.w = pk2(s[6 * 33], s[7 * 33]);
        *(v4u*)(WT + (size_t)(n0 + n) * K + k0 + 8 * c) = o; }
    LDS_WAIT(); asm volatile("" ::: "memory");
}
__device__ __forceinline__ void rms_row_to_bf16(const float* xrow, const float* g, bf16* orow, int lane) {
    const f32x4* xr = (const f32x4*)xrow + lane;
    f32x4 v[8]; float s = 0.f;
#pragma unroll
    for (int j = 0; j < 8; ++j) { v[j] = xr[64 * j]; s += (v[j].x * v[j].x + v[j].y * v[j].y) + (v[j].z * v[j].z + v[j].w * v[j].w); }
    const float rs = 1.0f / sqrtf(wave_sum(s) * (1.f / DM) + RMS_EPS);
    v2u* o8 = (v2u*)orow + lane;
#pragma unroll
    for (int j = 0; j < 8; ++j) { const f32x4 gg = ((const f32x4*)g)[lane + 64 * j];
        v2u o; o.x = pk2(v[j].x * rs * gg.x, v[j].y * rs * gg.y); o.y = pk2(v[j].z * rs * gg.z, v[j].w * rs * gg.w); o8[64 * j] = o; }
}
__device__ __forceinline__ void phase_prologue(KP P, LAS unsigned char* lds, int vcu, int G) {
    const int tid = ltid(), lane = tid & 63, wave = tid >> 6;
    LAS float* scr = (LAS float*)(lds + wave * 16384);
    const int gw = vcu * NWAVES + wave, NGW = G * NWAVES;
    bf16* WIN = (bf16*)(P.ws + WS_WIN); bf16* XN = (bf16*)(P.ws + WS_XN);
    constexpr int I_IN = (DM / 64) * (INC / 32);
    for (int it = gw; it < I_IN; it += NGW) p0_transpose_item(P.w_in, DM, INC, WIN, scr, it, lane);
    for (int i = vcu * NTHR + tid; i < (INCP - INC) * DM / 8; i += G * NTHR) ((v4u*)(WIN + (size_t)INC * DM))[i] = (v4u){0u, 0u, 0u, 0u};
    for (int m = gw; m < TT; m += NGW) rms_row_to_bf16(P.x + (size_t)m * DM, P.norm1_g, XN + (size_t)m * DM, lane);
}
__device__ __forceinline__ void phase_transpose_late(KP P, LAS unsigned char* lds) {
    const int tid = ltid(), lane = tid & 63, wave = tid >> 6;
    constexpr int I_SQ = (DM / 64) * (DM / 32), NTK = 2 * I_SQ / NWAVES;
    unsigned* ctr = (unsigned*)(P.ws + WS_CTL) + CW_MOBA_CTR + 16; LAS int* slot = (LAS int*)(lds + 8 * 16384); LAS float* scr = (LAS float*)(lds + wave * 16384);
    __syncthreads();
    if (tid == 0) slot[0] = (int)__hip_atomic_fetch_add(ctr, 1u, __ATOMIC_RELAXED, __HIP_MEMORY_SCOPE_AGENT);
    __syncthreads();
    for (int it = 0;; ++it) {
        const int c = slot[it & 1]; if (c >= NTK) break;
        if (tid == 0) slot[(it & 1) ^ 1] = (int)__hip_atomic_fetch_add(ctr, 1u, __ATOMIC_RELAXED, __HIP_MEMORY_SCOPE_AGENT);
        const int r = c * NWAVES + wave;
        if (r < I_SQ) p0_transpose_item(P.w_out, DM, DM, (bf16*)(P.ws + WS_WOUT), scr, r, lane);
        else p0_transpose_item(P.wq, DM, DM, (bf16*)(P.ws + WS_WQ), scr, r - I_SQ, lane, P.norm2_g);
        __syncthreads();
    }
}

namespace pg8 {
struct EpiF32 {
    static constexpr bool PERM = false, AFTER_DRAIN = false;
    const float* base; float* out; int ldc;
    __device__ __forceinline__ void operator()(const f32x4 (&acc)[2][2][4][2], const Unit& u, int wr, int wc, int fr, int fq) const {
        const int col0 = u.pn * BM + wc * 32 + 4 * fq;
#pragma unroll
        for (int ai = 0; ai < 2; ++ai)
#pragma unroll
            for (int m = 0; m < 4; ++m) { const int r = ai * HALF + wr * 64 + m * 16 + fr; const size_t off = (size_t)(u.pm * BM + r) * ldc + col0;
#pragma unroll
                for (int bj = 0; bj < 2; ++bj)
#pragma unroll
                    for (int n = 0; n < 2; ++n) { f32x4 o = acc[ai][bj][m][n]; if (base) o = o + *(const f32x4*)(base + off + bj * HALF + n * 16);
                        *(f32x4*)(out + off + bj * HALF + n * 16) = o; } }
    }
};
struct EpiH {
    static constexpr bool PERM = false, AFTER_DRAIN = false;
    const float* base; bf16* outb; float* ss; int ldc;
    __device__ __forceinline__ void operator()(const f32x4 (&acc)[2][2][4][2], const Unit& u, int wr, int wc, int fr, int fq) const {
        const int col0 = u.pn * BM + wc * 32 + 4 * fq;
#pragma unroll
        for (int ai = 0; ai < 2; ++ai) {
            f32x4 xv[4][2][2];
#pragma unroll
            for (int m = 0; m < 4; ++m) { const size_t off = (size_t)(u.pm * BM + ai * HALF + wr * 64 + m * 16 + fr) * ldc + col0;
#pragma unroll
                for (int bj = 0; bj < 2; ++bj)
#pragma unroll
                    for (int n = 0; n < 2; ++n) xv[m][bj][n] = *(const f32x4*)(base + off + bj * HALF + n * 16); }
#pragma unroll
            for (int m = 0; m < 4; ++m) { const int r = ai * HALF + wr * 64 + m * 16 + fr; const size_t off = (size_t)(u.pm * BM + r) * ldc + col0; float sq = 0.f;
#pragma unroll
                for (int bj = 0; bj < 2; ++bj)
#pragma unroll
                    for (int n = 0; n < 2; ++n) { const f32x4 o = acc[ai][bj][m][n] + xv[m][bj][n];
                        *(v2u*)(outb + off + bj * HALF + n * 16) = (v2u){pk2(o.x, o.y), pk2(o.z, o.w)};
                        sq += (o.x * o.x + o.y * o.y) + (o.z * o.z + o.w * o.w); }
                sq += __shfl_xor(sq, 16); sq += __shfl_xor(sq, 32);
                if (fq == 0) ss[(size_t)(u.pm * BM + r) * 32 + u.pn * 4 + wc] = sq; }
        }
    }
};
struct EpiBf16Row {
    static constexpr bool PERM = true, AFTER_DRAIN = false;
    bf16_t* O; int ldc; const float* rs;
    __device__ __forceinline__ void operator()(const f32x4 (&acc)[2][2][4][2], const Unit& u, int wr, int wc, int fr, int fq) const {
        const int row0 = u.pm * BM + wr * 64 + fr, col0 = u.pn * BM + wc * 32 + 8 * fq;
        float scv[2][4];
#pragma unroll
        for (int ai = 0; ai < 2; ++ai)
#pragma unroll
            for (int m = 0; m < 4; ++m) scv[ai][m] = rs[row0 + ai * HALF + m * 16];
#pragma unroll
        for (int ai = 0; ai < 2; ++ai)
#pragma unroll
            for (int m = 0; m < 4; ++m) { const int row = row0 + ai * HALF + m * 16; const float sc = scv[ai][m]; bf16_t* rowp = O + (size_t)row * ldc + col0;
#pragma unroll
                for (int bj = 0; bj < 2; ++bj) { const f32x4 v0 = acc[ai][bj][m][0] * sc, v1 = acc[ai][bj][m][1] * sc;
                    u32x4 w; w.x = cvt_pk_bf16(v0[0], v0[1]); w.y = cvt_pk_bf16(v0[2], v0[3]); w.z = cvt_pk_bf16(v1[0], v1[1]); w.w = cvt_pk_bf16(v1[2], v1[3]);
                    *(u32x4*)(rowp + bj * HALF) = w; } }
    }
};
struct Order1 {
    StaticOrder s; bool split; int c;
    __device__ void init(int M, int N, int G_, int c_) { s.init(M, N, G_, c_); split = (G_ == 256 && M == 8192 && N == 6656); c = c_; }
    __device__ bool next(int i, Unit& u) const {
        if (!split) return s.next(i, u);
        if (c >= 208 || i >= 4) return false;
        const int x = c & 7, j = c >> 3; u.pm = 4 * x + 2 * (i >> 1) + (j & 1); u.pn = 13 * (i & 1) + (j >> 1); return true; }
    __device__ __forceinline__ void a_ready(const Unit&) const {}
    __device__ __forceinline__ void done(const Unit&) const {}
};
}

__device__ __forceinline__ void phase_rstd(KP P, int vcu, int G) {
    const float* ssp = (const float*)(P.ws + WS_SSP); float* rstd = (float*)(P.ws + WS_SSP + 2 * MiB);
    for (int row = vcu * NTHR + ltid(); row < TT; row += G * NTHR) { const f32x4* sp = (const f32x4*)(ssp + (size_t)row * 32); float a = 0.f;
#pragma unroll
        for (int j = 0; j < 8; ++j) { const f32x4 v = sp[j]; a += (v.x + v.y) + (v.z + v.w); }
        rstd[row] = 1.0f / sqrtf(a * (1.f / DM) + RMS_EPS); }
}
__device__ __forceinline__ void phase_kmean(KP P, LAS unsigned char* lds, int vcu, int G) {
    const int tid = ltid(); const bf16* proj = (const bf16*)(P.ws + WS_PROJ); float* kmean = (float*)(P.ws + WS_KMEAN);
    LAS float* red = (LAS float*)lds;
    for (int item = vcu; item < 32 * 8; item += G) {
        const int bb = item >> 3, cg = item & 7;
        const int c = tid & 127, rq = tid >> 7;
        const bf16* p = proj + (size_t)(bb * 256 + rq * 64) * INCP + C_AK + cg * 128 + c;
        float s = 0.f;
        for (int r = 0; r < 64; ++r) s += bf2f(p[(size_t)r * INCP]);
        red[rq * 128 + c] = s;
        __syncthreads();
        if (tid < 128) kmean[(size_t)bb * 1024 + cg * 128 + tid] = (red[tid] + red[128 + tid] + red[256 + tid] + red[384 + tid]) * (1.f / 256.f);
        __syncthreads();
    }
}

typedef short bf16x8 __attribute__((ext_vector_type(8)));
typedef float f32x16 __attribute__((ext_vector_type(16)));
constexpr int CP = 72;
constexpr int MATB = 64 * CP * 2;
enum { M_AT = 0, M_BT = 1, M_KT = 2, M_RT = 3, M_VT = 4, M_BBT = 5, M_KBT = 6, M_LAK = 7, M_MRB = 8, M_MRK = 9, M_LAB = 10, M_AHT = 0, M_U0T = 1 };
constexpr int L_RHS = 11 * MATB;
constexpr int L_MISC = L_RHS + 32768;
constexpr int L_TB = L_MISC + 9 * 64 * 4;
constexpr int L_A_END = L_TB + 2048;
static_assert(L_A_END <= RING_BYTES, "stage A LDS");
constexpr size_t CHK_ITEM = 6 * 8192;

__device__ __forceinline__ f32x16 mm_tile(const LAS unsigned char* A, int ra, const LAS unsigned char* B, int rb, f32x16 acc, int lane, int k0 = 0, int k1 = 4) {
    const int r = lane & 31, hi = lane >> 5;
    const LAS unsigned char* ap = A + ((ra * 32 + r) * CP + 8 * hi) * 2; const LAS unsigned char* bp = B + ((rb * 32 + r) * CP + 8 * hi) * 2;
#pragma unroll
    for (int kk = 0; kk < 4; ++kk) if (kk >= k0 && kk < k1) {
        const bf16x8 a = *(const LAS bf16x8*)(ap + kk * 32), b = *(const LAS bf16x8*)(bp + kk * 32);
        acc = __builtin_amdgcn_mfma_f32_32x32x16_bf16(a, b, acc, 0, 0, 0); }
    return acc;
}
__device__ __forceinline__ int crow32(int reg, int hi) { return (reg & 3) + 8 * (reg >> 2) + 4 * hi; }

__device__ __forceinline__ void prologue_lora(KP P, int vcu, int G) {
    bf16* w2T = (bf16*)(P.ws + WS_LORA); bf16* a2T = w2T + 1024 * 96; bf16* g2T = a2T + 1024 * 96;
    for (int e0 = vcu * NTHR + ltid(); e0 < 448 * 1024; e0 += 4 * G * NTHR) { float v[4];
#pragma unroll
        for (int u = 0; u < 4; ++u) { const int e = e0 + u * G * NTHR, i = e >> 10; v[u] = 0.f;
            if (e < 448 * 1024) v[u] = i < 96 ? P.w2[e] : (i < 192 ? P.a2[e - 96 * 1024] : P.g2[e - 192 * 1024]); }
#pragma unroll
        for (int u = 0; u < 4; ++u) { const int e = e0 + u * G * NTHR, i = e >> 10, n = e & 1023;
            if (e < 448 * 1024) { if (i < 96) w2T[n * 96 + i] = (bf16)f2bf(v[u]); else if (i < 192) a2T[n * 96 + (i - 96)] = (bf16)f2bf(v[u]); else g2T[n * 256 + (i - 192)] = (bf16)f2bf(v[u]); } }
    }
}
__device__ __forceinline__ void phase_act(KP P, int vcu, int G) {
    const bf16* proj = (const bf16*)(P.ws + WS_PROJ); unsigned* act = (unsigned*)(P.ws + WS_ACT);
    for (int e0 = vcu * NTHR + ltid(); e0 < TT * 224; e0 += 4 * G * NTHR) {
        unsigned cu[4], pu[4]; float m0[4], m1[4];
#pragma unroll
        for (int u = 0; u < 4; ++u) { const int e = e0 + u * G * NTHR; cu[u] = 0u; pu[u] = 0u; m0[u] = 0.f; m1[u] = 0.f;
            if (e < TT * 224) { const int t = e / 224, cc = 2 * (e - t * 224); const bf16* pr = proj + (size_t)t * INCP + C_RW + 3072 + cc;
                cu[u] = *(const unsigned*)pr; pu[u] = (t & (SEQ - 1)) == 0 ? 0u : *(const unsigned*)(pr - INCP); m0[u] = P.mu[3072 + cc]; m1[u] = P.mu[3072 + cc + 1]; } }
#pragma unroll
        for (int u = 0; u < 4; ++u) { const int e = e0 + u * G * NTHR;
            if (e < TT * 224) { const int t = e / 224, cc = 2 * (e - t * 224);
                float v0 = bflo(cu[u]) + (bflo(pu[u]) - bflo(cu[u])) * m0[u], v1 = bfhi(cu[u]) + (bfhi(pu[u]) - bfhi(cu[u])) * m1[u];
                if (cc < 96) { v0 = tanhf(v0); v1 = tanhf(v1); } else if (cc >= 192) { v0 = 1.f / (1.f + __expf(-v0)); v1 = 1.f / (1.f + __expf(-v1)); }
                act[e] = pk2(v0, v1); } }
    }
}
constexpr int ACTP = 456;
constexpr int L_WAG = 58368;
static_assert(L_WAG + 3 * 16384 <= L_MISC, "lora scratch fits below misc");
struct LoraFrags { bf16x8 f[16]; f32x4 w0[4], a0[4]; float mu_r, mu_k, mu_v, kkc, kac, rkc, lng, lnb; };
__device__ __forceinline__ LoraFrags lora_frags_load(KP P, int h, int wave, int lane) {
    const int c32 = lane & 31, hi = lane >> 5, nb = (wave & 3) >> 1; const int nrow = h * 64 + nb * 32 + c32;
    const bf16* w2T = (const bf16*)(P.ws + WS_LORA); const bf16* a2T = w2T + 1024 * 96; const bf16* g2T = a2T + 1024 * 96;
    const bf16* wp = w2T + (size_t)nrow * 96 + 8 * hi; const bf16* ap = a2T + (size_t)nrow * 96 + 8 * hi; const bf16* gp = g2T + (size_t)nrow * 256 + 8 * hi;
    LoraFrags W;
#pragma unroll
    for (int kk = 0; kk < 16; ++kk) { const bf16* src = wave < 4 ? (kk < 6 ? wp + 16 * kk : ap + 16 * ((kk - 6) % 6)) : gp + 16 * kk; W.f[kk] = *(const bf16x8*)src; }
#pragma unroll
    for (int g = 0; g < 4; ++g) { const int n0 = h * 64 + nb * 32 + 8 * g + 4 * hi; W.w0[g] = *(const f32x4*)(P.w0 + n0); W.a0[g] = *(const f32x4*)(P.a0 + n0); }
    const int col = h * 64 + lane;
    W.mu_r = P.mu[col]; W.mu_k = P.mu[1024 + col]; W.mu_v = P.mu[2048 + col]; W.kkc = P.k_k[col]; W.kac = P.k_a[col]; W.rkc = P.r_k[col]; W.lng = P.ln_g[col]; W.lnb = P.ln_b[col];
    return W;
}
__device__ __forceinline__ void rwkv_stage_a(KP P, LAS unsigned char* lds, int item, const LoraFrags& W) {
    const int tid = ltid(), lane = tid & 63, wave = __builtin_amdgcn_readfirstlane(tid >> 6);
    const int b = item >> 10, h = (item >> 6) & 15, c = item & 63;
    const int tok0 = b * SEQ + c * 64;
    const bf16* proj = (const bf16*)(P.ws + WS_PROJ);
    unsigned char* chk = P.ws + WS_CHK + (size_t)((item & 63) * 32 + (item >> 6)) * CHK_ITEM;
    LAS float* misc = (LAS float*)(lds + L_MISC);
    { const bf16* actg = (const bf16*)(P.ws + WS_ACT) + (size_t)tok0 * 448;
#pragma unroll
      for (int e = tid; e < 64 * 56; e += NTHR) { const int row = e / 56, ch = e - row * 56; *(LAS v4u*)(lds + (row * ACTP + ch * 8) * 2) = *(const v4u*)(actg + (size_t)row * 448 + ch * 8); } }
    __syncthreads();
    {
        const int c32 = lane & 31, hi = lane >> 5, qd = wave & 3, nb = qd >> 1, tb = qd & 1;
        const LAS unsigned char* actp = lds + ((tb * 32 + c32) * ACTP + 8 * hi) * 2;
        LAS float* wag = (LAS float*)(lds + L_WAG) + (tb * 32 + c32) * 64 + nb * 32;
        if (wave < 4) {
            f32x16 aw = {}, aa = {};
#pragma unroll
            for (int kk = 0; kk < 6; ++kk) {
                aw = __builtin_amdgcn_mfma_f32_32x32x16_bf16(W.f[kk], *(const LAS bf16x8*)(actp + (16 * kk) * 2), aw, 0, 0, 0);
                aa = __builtin_amdgcn_mfma_f32_32x32x16_bf16(W.f[6 + kk], *(const LAS bf16x8*)(actp + (96 + 16 * kk) * 2), aa, 0, 0, 0); }
#pragma unroll
            for (int g = 0; g < 4; ++g) { const int n0 = h * 64 + nb * 32 + 8 * g + 4 * hi;
                const f32x4 w0 = W.w0[g], a0 = W.a0[g]; f32x4 ow, oa;
#pragma unroll
                for (int e = 0; e < 4; ++e) { const float xx = w0[e] + aw[4 * g + e];
                    ow[e] = __expf(-0.6065306597126334f * __builtin_amdgcn_rcpf(1.f + __expf(-xx))); oa[e] = __builtin_amdgcn_rcpf(1.f + __expf(-(a0[e] + aa[4 * g + e]))); }
                *(LAS f32x4*)(wag + 8 * g + 4 * hi) = ow; *(LAS f32x4*)(wag + 4096 + 8 * g + 4 * hi) = oa; }
        } else {
            f32x16 ag = {};
#pragma unroll
            for (int kk = 0; kk < 16; ++kk) ag = __builtin_amdgcn_mfma_f32_32x32x16_bf16(W.f[kk], *(const LAS bf16x8*)(actp + (192 + 16 * kk) * 2), ag, 0, 0, 0);
#pragma unroll
            for (int g = 0; g < 4; ++g) *(LAS f32x4*)(wag + 8192 + 8 * g + 4 * hi) = (f32x4){ag[4 * g], ag[4 * g + 1], ag[4 * g + 2], ag[4 * g + 3]};
        }
    }
    __syncthreads();
    {
        const int n = lane, tg = wave, col = h * 64 + n;
        const float mu_r = W.mu_r, mu_k = W.mu_k, mu_v = W.mu_v, kkc = W.kkc, kac = W.kac, rkc = W.rkc, lng = W.lng, lnb = W.lnb;
        float rr[8], kr[8], vv[8], ww[8], aa[8], gg[8], kk[8];
        const int tfirst = tok0 + 8 * tg;
        const bf16* pp = proj + (size_t)tfirst * INCP + C_RW + col;
        float pr, pk, pvv;
        if (c == 0 && tg == 0) { pr = 0.f; pk = 0.f; pvv = 0.f; } else { pr = bf2f(pp[-(long)INCP]); pk = bf2f(pp[-(long)INCP + 1024]); pvv = bf2f(pp[-(long)INCP + 2048]); }
        const LAS float* wagr = (const LAS float*)(lds + L_WAG) + (8 * tg) * 64 + n;
#pragma unroll
        for (int q = 0; q < 8; ++q) { const float cr = bf2f(pp[(size_t)q * INCP]), ck = bf2f(pp[(size_t)q * INCP + 1024]), cv = bf2f(pp[(size_t)q * INCP + 2048]);
            rr[q] = cr + (pr - cr) * mu_r; kr[q] = ck + (pk - ck) * mu_k; vv[q] = cv + (pvv - cv) * mu_v; pr = cr; pk = ck; pvv = cv;
            ww[q] = wagr[q * 64]; aa[q] = wagr[4096 + q * 64]; gg[q] = wagr[8192 + q * 64]; }
        float lam[8]; float run = 1.f;
#pragma unroll
        for (int q = 0; q < 8; ++q) { run *= ww[q]; lam[q] = run; }
        misc[tg * 64 + n] = run;
#pragma unroll
        for (int q = 0; q < 8; ++q) { const float kkv = kr[q] * kkc; const float ss = wave_sum(kkv * kkv); kk[q] = kkv * __builtin_amdgcn_rsqf(fmaxf(ss, 1e-24f));
            kr[q] = kr[q] * (1.f + (aa[q] - 1.f) * kac); }
        __syncthreads();
        float pre = 1.f, tot = 1.f;
#pragma unroll
        for (int g = 0; g < 8; ++g) { const float sgt = misc[g * 64 + n]; if (g < tg) pre *= sgt; tot *= sgt; }
        if (tg == 0) misc[512 + n] = tot;
        unsigned vt[4], bbt[4], kbt[4];
        LAS bf16* At = (LAS bf16*)(lds + M_AT * MATB); LAS bf16* Bt = (LAS bf16*)(lds + M_BT * MATB); LAS bf16* Kt = (LAS bf16*)(lds + M_KT * MATB); LAS bf16* Rt = (LAS bf16*)(lds + M_RT * MATB);
        float hbb = 0.f, hkb = 0.f, hv = 0.f;
#pragma unroll
        for (int q = 0; q < 8; ++q) { const int t = 8 * tg + q;
            const float L = pre * lam[q], Lp = q == 0 ? pre : pre * lam[q - 1], iL = __builtin_amdgcn_rcpf(L), rel = tot * iL;
            const float bq = kk[q] * aa[q];
            ((LAS float*)(lds + L_RHS))[t * 128 + 64 + n] = -kk[q] * Lp;
            At[t * CP + n] = (bf16)f2bf(-kk[q] * Lp); Bt[t * CP + n] = (bf16)f2bf(bq * iL); Kt[t * CP + n] = (bf16)f2bf(kr[q] * iL); Rt[t * CP + n] = (bf16)f2bf(rr[q] * L);
            const float bb = bq * rel, kb = kr[q] * rel;
            if (q & 1) { vt[q >> 1] = pk2(hv, vv[q]); bbt[q >> 1] = pk2(hbb, bb); kbt[q >> 1] = pk2(hkb, kb); } else { hv = vv[q]; hbb = bb; hkb = kb; }
            const float bs = wave_sum(rr[q] * kr[q] * rkc);
            const int pl = t * 64 + ((n >> 2) & 3) * 16 + (n >> 4) * 4 + (n & 3);
            ((bf16*)(chk + 4 * 8192))[pl] = (bf16)f2bf(lng * gg[q]);
            ((bf16*)(chk + 5 * 8192))[pl] = (bf16)f2bf((lnb + bs * vv[q]) * gg[q]); }
        *(LAS v4u*)(lds + M_VT * MATB + (n * CP + 8 * tg) * 2) = (v4u){vt[0], vt[1], vt[2], vt[3]};
        *(LAS v4u*)(lds + M_BBT * MATB + (n * CP + 8 * tg) * 2) = (v4u){bbt[0], bbt[1], bbt[2], bbt[3]};
        *(LAS v4u*)(lds + M_KBT * MATB + (n * CP + 8 * tg) * 2) = (v4u){kbt[0], kbt[1], kbt[2], kbt[3]};
    }
    __syncthreads();
    const int c32 = lane & 31, hi = lane >> 5;
    {
        const int prod = wave >> 1;
#pragma unroll
        for (int qi = 0; qi < 2; ++qi) {
            const int tb = (wave & 1) ? (qi == 0 ? 1 : 0) : qi, sb = (wave & 1) ? 1 : 0; const bool zero = (tb == 0 && sb == 1);
            f32x16 acc = {};
            const int xa = (prod == 0 || prod == 2) ? M_BT : M_KT, ya = prod < 2 ? M_AT : M_RT, dm = prod == 0 ? M_LAB : (prod == 1 ? M_LAK : (prod == 2 ? M_MRB : M_MRK));
            if (!zero) acc = mm_tile(lds + xa * MATB, sb, lds + ya * MATB, tb, acc, lane);
            const int t = tb * 32 + c32; LAS unsigned char* dst = lds + dm * MATB + (t * CP + sb * 32) * 2;
#pragma unroll
            for (int g = 0; g < 4; ++g) { float o[4];
#pragma unroll
                for (int e = 0; e < 4; ++e) { const int s = sb * 32 + 8 * g + 4 * hi + e; const bool keep = prod < 2 ? (s < t) : (s <= t); o[e] = keep ? acc[4 * g + e] : 0.f; }
                *(LAS v2u*)(dst + (8 * g + 4 * hi) * 2) = (v2u){pk2(o[0], o[1]), pk2(o[2], o[3])}; }
        }
    }
    __syncthreads();
    if (wave < 4) {
        const int ib = wave >> 1, tb = wave & 1; f32x16 acc = {};
        acc = mm_tile(lds + M_VT * MATB, ib, lds + M_LAK * MATB, tb, acc, lane, 0, tb == 0 ? 2 : 4);
        const int t = tb * 32 + c32; LAS float* dst = (LAS float*)(lds + L_RHS) + t * 128 + ib * 32;
#pragma unroll
        for (int g = 0; g < 4; ++g) *(LAS f32x4*)(dst + 8 * g + 4 * hi) = (f32x4){acc[4 * g], acc[4 * g + 1], acc[4 * g + 2], acc[4 * g + 3]};
    } else if (wave == 4) {
        const int bb = lane >> 4, col = lane & 15;
        float x[16];
#pragma unroll
        for (int t = 0; t < 16; ++t) x[t] = t == col ? 1.f : 0.f;
#pragma unroll
        for (int t = 1; t < 16; ++t) { const LAS unsigned char* rp = lds + M_LAB * MATB + ((16 * bb + t) * CP + 16 * bb) * 2; const v4u ra = *(const LAS v4u*)rp, rb = *(const LAS v4u*)(rp + 16);
            float lrow[16];
#pragma unroll
            for (int q = 0; q < 4; ++q) { lrow[2 * q] = bflo(ra[q]); lrow[2 * q + 1] = bfhi(ra[q]); lrow[8 + 2 * q] = bflo(rb[q]); lrow[8 + 2 * q + 1] = bfhi(rb[q]); }
#pragma unroll
            for (int s = 0; s < t; ++s) x[t] += lrow[s] * x[s]; }
        LAS bf16* T = (LAS bf16*)(lds + L_TB) + bb * 256 + col;
#pragma unroll
        for (int t = 0; t < 16; ++t) T[t * 16] = (bf16)f2bf(x[t]);
    }
    __syncthreads();
    {
        typedef short s16x4 __attribute__((ext_vector_type(4)));
        const int l15 = lane & 15, q4 = lane >> 4;
        LAS unsigned char* xt = lds + (wave < 4 ? M_U0T : M_AHT) * MATB + ((16 * (wave & 3) + l15) * CP) * 2;
        *(LAS v4u*)(xt + q4 * 32) = (v4u){0u, 0u, 0u, 0u}; *(LAS v4u*)(xt + q4 * 32 + 16) = (v4u){0u, 0u, 0u, 0u};
        const LAS float* Xf = (const LAS float*)(lds + L_RHS) + 16 * wave + l15;
#pragma unroll
        for (int bq = 0; bq < 4; ++bq) {
            f32x4 acc;
#pragma unroll
            for (int e = 0; e < 4; ++e) acc[e] = Xf[(16 * bq + 4 * q4 + e) * 128];
#pragma unroll
            for (int kk = 0; kk < (bq + 1) / 2; ++kk) {
                const bf16x8 a = *(const LAS bf16x8*)(lds + M_LAB * MATB + ((16 * bq + l15) * CP + 32 * kk + 8 * q4) * 2);
                const bf16x8 xb = *(const LAS bf16x8*)(xt + (32 * kk + 8 * q4) * 2);
                acc = __builtin_amdgcn_mfma_f32_16x16x32_bf16(a, xb, acc, 0, 0, 0); }
            const v2u tf = *(const LAS v2u*)(lds + L_TB + (bq * 256 + l15 * 16 + 4 * q4) * 2);
            const v2u ab = (v2u){pk2(acc[0], acc[1]), pk2(acc[2], acc[3])};
            const f32x4 z = {0.f, 0.f, 0.f, 0.f};
            const f32x4 xn = __builtin_amdgcn_mfma_f32_16x16x16bf16_1k(__builtin_bit_cast(s16x4, tf), __builtin_bit_cast(s16x4, ab), z, 0, 0, 0);
            *(LAS v2u*)(xt + (16 * bq + 4 * q4) * 2) = (v2u){pk2(xn[0], xn[1]), pk2(xn[2], xn[3])};
        }
    }
    __syncthreads();
    {
        const int qd = wave & 3, yb = qd >> 1, xb = qd & 1;
        f32x16 acc1 = {}, acc2 = {};
        if (wave < 4) {
            acc1 = mm_tile(lds + M_AHT * MATB, yb, lds + M_BBT * MATB, xb, acc1, lane);
            acc2 = mm_tile(lds + M_BBT * MATB, yb, lds + M_U0T * MATB, xb, acc2, lane);
            acc2 = mm_tile(lds + M_KBT * MATB, yb, lds + M_VT * MATB, xb, acc2, lane);
            const int x = xb * 32 + c32; const float lc = misc[512 + x];
            bf16* o1 = (bf16*)(chk + 0 * 8192) + x * 64 + yb * 32; bf16* o2 = (bf16*)(chk + 1 * 8192) + x * 64 + yb * 32;
#pragma unroll
            for (int g = 0; g < 4; ++g) { float p[4];
#pragma unroll
                for (int e = 0; e < 4; ++e) { const int y = yb * 32 + 8 * g + 4 * hi + e; p[e] = acc1[4 * g + e] + (y == x ? lc : 0.f); }
                *(v2u*)(o1 + 8 * g + 4 * hi) = (v2u){pk2(p[0], p[1]), pk2(p[2], p[3])};
                *(v2u*)(o2 + 8 * g + 4 * hi) = (v2u){pk2(acc2[4 * g], acc2[4 * g + 1]), pk2(acc2[4 * g + 2], acc2[4 * g + 3])}; }
        } else {
            acc1 = mm_tile(lds + M_AHT * MATB, yb, lds + M_MRB * MATB, xb, acc1, lane);
            acc2 = mm_tile(lds + M_U0T * MATB, yb, lds + M_MRB * MATB, xb, acc2, lane);
            acc2 = mm_tile(lds + M_VT * MATB, yb, lds + M_MRK * MATB, xb, acc2, lane);
            const int x = xb * 32 + c32;
            bf16* o1 = (bf16*)(chk + 2 * 8192) + x * 64 + yb * 32; bf16* o2 = (bf16*)(chk + 3 * 8192) + x * 64;
            const LAS bf16* Rt = (const LAS bf16*)(lds + M_RT * MATB) + x * CP + yb * 32;
#pragma unroll
            for (int g = 0; g < 4; ++g) { float p[4];
#pragma unroll
                for (int e = 0; e < 4; ++e) p[e] = acc1[4 * g + e] + bf2f(Rt[8 * g + 4 * hi + e]);
                *(v2u*)(o1 + 8 * g + 4 * hi) = (v2u){pk2(p[0], p[1]), pk2(p[2], p[3])};
                *(v2u*)(o2 + ((2 * g + hi) & 3) * 16 + (2 * yb + (g >> 1)) * 4) = (v2u){pk2(acc2[4 * g], acc2[4 * g + 1]), pk2(acc2[4 * g + 2], acc2[4 * g + 3])}; }
        }
    }
    __syncthreads();
}

__device__ __forceinline__ void phase_rwkv_stage_a(KP P, LAS unsigned char* lds, int vcu, int G) {
    const int tid = ltid(), lane = tid & 63, wave = __builtin_amdgcn_readfirstlane(tid >> 6);
    int cur_bh = (vcu & 255) >> 3; LoraFrags W = lora_frags_load(P, cur_bh & 15, wave, lane);
    for (int k = vcu; k < 2048; k += G) { const int bh = (k & 255) >> 3, c = (k & 7) + 8 * (k >> 8);
        if (bh != cur_bh) { W = lora_frags_load(P, bh & 15, wave, lane); cur_bh = bh; }
        rwkv_stage_a(P, lds, bh * 64 + c, W); }
}
typedef float f32x4v __attribute__((ext_vector_type(4)));
struct YSet { bf16x8 b0, b1; v4u y0[2], g1[2], g2[2]; };
struct SSet { bf16x8 p0[1], p1[1]; v2u q[4]; };
__device__ __forceinline__ void rwkv_stage_b(KP P, LAS unsigned char* lds, int bh) {
    const int tid = ltid(), lane = tid & 63, wave = __builtin_amdgcn_readfirstlane(tid >> 6);
    const int b = bh >> 4, h = bh & 15; const int l15 = lane & 15, q4 = lane >> 4;
    bf16* AR = (bf16*)(P.ws + WS_AR);
    for (int u = tid; u < 2 * MATB / 4; u += NTHR) ((LAS unsigned*)lds)[u] = 0u;
    __syncthreads();
    const int w4 = wave & 3;
    const unsigned char* chk0 = P.ws + WS_CHK + (size_t)bh * CHK_ITEM;
    if (wave < 4) {
        const int t = 16 * w4 + l15;
        YSet ys[4];
#define YLOAD(S_, c_) do { const unsigned char* chk = chk0 + (size_t)(c_) * (32 * CHK_ITEM); const bf16* rh = (const bf16*)(chk + 2 * 8192) + t * 64 + 8 * q4; S_.b0 = *(const bf16x8*)rh; S_.b1 = *(const bf16x8*)(rh + 32); \
        const bf16* y0 = (const bf16*)(chk + 3 * 8192) + t * 64 + 16 * q4; \
        S_.y0[0] = *(const v4u*)y0; S_.y0[1] = *(const v4u*)(y0 + 8); S_.g1[0] = *(const v4u*)(y0 + 4096); S_.g1[1] = *(const v4u*)(y0 + 4096 + 8); S_.g2[0] = *(const v4u*)(y0 + 8192); S_.g2[1] = *(const v4u*)(y0 + 8192 + 8); } while (0)
#define YV(A_, it_, w_) ((A_)[(it_) >> 1][2 * ((it_) & 1) + (w_)])
#pragma unroll
        for (int u = 0; u < 4; ++u) YLOAD(ys[u], u);
        for (int c0 = 0; c0 < 64; c0 += 4) {
#pragma unroll
            for (int u = 0; u < 4; ++u) { const int c = c0 + u;
                const LAS unsigned char* Scur = lds + (c & 1) * MATB;
                f32x4v acc[4];
#pragma unroll
                for (int it = 0; it < 4; ++it) { acc[it] = (f32x4v){bflo(YV(ys[u].y0, it, 0)), bfhi(YV(ys[u].y0, it, 0)), bflo(YV(ys[u].y0, it, 1)), bfhi(YV(ys[u].y0, it, 1))};
                    const LAS unsigned char* sp = Scur + ((16 * it + l15) * CP + 8 * q4) * 2;
                    acc[it] = __builtin_amdgcn_mfma_f32_16x16x32_bf16(*(const LAS bf16x8*)sp, ys[u].b0, acc[it], 0, 0, 0);
                    acc[it] = __builtin_amdgcn_mfma_f32_16x16x32_bf16(*(const LAS bf16x8*)(sp + 64), ys[u].b1, acc[it], 0, 0, 0); }
                float s = 0.f;
#pragma unroll
                for (int it = 0; it < 4; ++it) s += (acc[it].x + acc[it].y) + (acc[it].z + acc[it].w);
                s += __shfl_xor(s, 16); s += __shfl_xor(s, 32);
                const float mean = s * (1.f / 64.f); float v = 0.f;
#pragma unroll
                for (int it = 0; it < 4; ++it) { acc[it] = acc[it] - mean; v += (acc[it].x * acc[it].x + acc[it].y * acc[it].y) + (acc[it].z * acc[it].z + acc[it].w * acc[it].w); }
                v += __shfl_xor(v, 16); v += __shfl_xor(v, 32);
                const float rstd = 1.0f / sqrtf(v * (1.f / 64.f) + 64e-5f);
                bf16* orow = AR + (size_t)(b * SEQ + c * 64 + t) * DM + 1024 + h * 64 + 4 * q4;
#pragma unroll
                for (int it = 0; it < 4; ++it) {
                    const float o0 = acc[it].x * rstd * bflo(YV(ys[u].g1, it, 0)) + bflo(YV(ys[u].g2, it, 0)), o1 = acc[it].y * rstd * bfhi(YV(ys[u].g1, it, 0)) + bfhi(YV(ys[u].g2, it, 0));
                    const float o2 = acc[it].z * rstd * bflo(YV(ys[u].g1, it, 1)) + bflo(YV(ys[u].g2, it, 1)), o3 = acc[it].w * rstd * bfhi(YV(ys[u].g1, it, 1)) + bfhi(YV(ys[u].g2, it, 1));
                    *(v2u*)(orow + 16 * it) = (v2u){pk2(o0, o1), pk2(o2, o3)}; }
                if (c + 4 < 64) YLOAD(ys[u], c + 4);
                __syncthreads();
            }
        }
#undef YLOAD
#undef YV
    } else {
        const int nrow = 16 * w4 + l15;
        SSet ss[4];
#define SLOADX(S_, c_) do { const unsigned char* chk = chk0 + (size_t)(c_) * (32 * CHK_ITEM); const bf16* pt = (const bf16*)chk + nrow * 64 + 8 * q4; S_.p0[0] = *(const bf16x8*)pt; S_.p1[0] = *(const bf16x8*)(pt + 32); \
        const bf16* q = (const bf16*)(chk + 1 * 8192) + l15 * 64 + 16 * w4 + 4 * q4; \
        _Pragma("unroll") for (int it = 0; it < 4; ++it) S_.q[it] = *(const v2u*)(q + 16 * it * 64); } while (0)
#pragma unroll
        for (int u = 0; u < 4; ++u) SLOADX(ss[u], u);
        for (int c0 = 0; c0 < 64; c0 += 4) {
#pragma unroll
            for (int u = 0; u < 4; ++u) { const int c = c0 + u;
                const LAS unsigned char* Scur = lds + (c & 1) * MATB; LAS unsigned char* Snxt = lds + ((c & 1) ^ 1) * MATB;
#pragma unroll
                for (int it = 0; it < 4; ++it) { const int i = 16 * it + l15;
                    const LAS unsigned char* sp = Scur + (i * CP + 8 * q4) * 2; const bf16x8 s0 = *(const LAS bf16x8*)sp, s1 = *(const LAS bf16x8*)(sp + 64);
                    f32x4v acc = (f32x4v){bflo(ss[u].q[it].x), bfhi(ss[u].q[it].x), bflo(ss[u].q[it].y), bfhi(ss[u].q[it].y)};
                    acc = __builtin_amdgcn_mfma_f32_16x16x32_bf16(ss[u].p0[0], s0, acc, 0, 0, 0);
                    acc = __builtin_amdgcn_mfma_f32_16x16x32_bf16(ss[u].p1[0], s1, acc, 0, 0, 0);
                    *(LAS v2u*)(Snxt + (i * CP + 16 * w4 + 4 * q4) * 2) = (v2u){pk2(acc.x, acc.y), pk2(acc.z, acc.w)}; }
                if (c + 4 < 64) SLOADX(ss[u], c + 4);
                __syncthreads();
            }
        }
#undef SLOADX
    }
}

constexpr size_t WS_UB = WS_RWA;
constexpr size_t WS_VB = WS_RWA + 32 * MiB;
constexpr float U_SCALE = 512.f, V_SCALE = 32.f;
constexpr int SLICE_BYTES = 16384 * 128;
typedef float f32x2 __attribute__((ext_vector_type(2)));
__device__ __forceinline__ void phase_convert_tables(KP P, LAS unsigned char* lds) {
    const int tid = ltid(); constexpr int N16 = 16384 * 2048 / 16, GPT = 4, CH = GPT * NTHR, NCH = 2 * N16 / CH;
    unsigned* ctr = (unsigned*)(P.ws + WS_CTL) + CW_MOBA_CTR; LAS int* slot = (LAS int*)lds;
    const int q = tid & 127;
    f32x4 gu[4];
#pragma unroll
    for (int m = 0; m < 4; ++m) gu[m] = *(const f32x4*)(P.norm2_g + 16 * q + 4 * m) * U_SCALE;
    __syncthreads();
    if (tid == 0) slot[0] = (int)__hip_atomic_fetch_add(ctr, 1u, __ATOMIC_RELAXED, __HIP_MEMORY_SCOPE_AGENT);
    __syncthreads();
    for (int it = 0;; ++it) {
        const int c = slot[it & 1]; if (c >= NCH) break;
        if (tid == 0) slot[(it & 1) ^ 1] = (int)__hip_atomic_fetch_add(ctr, 1u, __ATOMIC_RELAXED, __HIP_MEMORY_SCOPE_AGENT);
        const bool isv = c >= NCH / 2;
        const int j0 = (isv ? c - NCH / 2 : c) * CH + tid;
        const float* src = (isv ? P.pv : P.pu) + (size_t)j0 * 16;
        unsigned char* dst = P.ws + (isv ? WS_VB : WS_UB) + (size_t)(q >> 3) * SLICE_BYTES + (size_t)(j0 >> 7) * 128 + (q & 7) * 16;
        f32x4 sc[4];
#pragma unroll
        for (int m = 0; m < 4; ++m) sc[m] = isv ? (f32x4){V_SCALE, V_SCALE, V_SCALE, V_SCALE} : gu[m];
#pragma unroll
        for (int hb = 0; hb < 1; ++hb) {
            f32x4 a[4][4];
#pragma unroll
            for (int k = 0; k < 4; ++k)
#pragma unroll
                for (int m = 0; m < 4; ++m) a[k][m] = *(const f32x4*)(src + (size_t)(4 * hb + k) * (NTHR * 16) + 4 * m);
#pragma unroll
            for (int k = 0; k < 4; ++k) { v4u o;
#pragma unroll
                for (int m = 0; m < 4; ++m) { const f32x4 v = a[k][m] * sc[m]; int p = 0;
                    p = __builtin_amdgcn_cvt_pk_fp8_f32(v.x, v.y, p, false); p = __builtin_amdgcn_cvt_pk_fp8_f32(v.z, v.w, p, true); o[m] = (unsigned)p; }
                *(v4u*)(dst + (size_t)(4 * hb + k) * 512) = o; }
        }
        __syncthreads();
    }
}
__device__ __forceinline__ f32x2 dot16p(const v4u u, const f32x2* x, f32x2 acc) {
#pragma unroll
    for (int q = 0; q < 4; ++q) { const f32x2 lo = __builtin_amdgcn_cvt_pk_f32_fp8((int)u[q], false), hi = __builtin_amdgcn_cvt_pk_f32_fp8((int)u[q], true);
        acc = __builtin_elementwise_fma(lo, x[2 * q], acc); acc = __builtin_elementwise_fma(hi, x[2 * q + 1], acc); }
    return acc;
}
__device__ __forceinline__ void axpy16p(const v4u v, f32x2 s, f32x2* y) {
#pragma unroll
    for (int q = 0; q < 4; ++q) { const f32x2 lo = __builtin_amdgcn_cvt_pk_f32_fp8((int)v[q], false), hi = __builtin_amdgcn_cvt_pk_f32_fp8((int)v[q], true);
        y[2 * q] = __builtin_elementwise_fma(s, lo, y[2 * q]); y[2 * q + 1] = __builtin_elementwise_fma(s, hi, y[2 * q + 1]); }
}
__device__ __forceinline__ float xsum_g8(float v) {
    v += DPP_F(v, 0x128);
    { auto r = __builtin_amdgcn_permlane16_swap(__float_as_uint(v), __float_as_uint(v), false, false); v = __uint_as_float(r[0]) + __uint_as_float(r[1]); }
    { auto r = __builtin_amdgcn_permlane32_swap(__float_as_uint(v), __float_as_uint(v), false, false); v = __uint_as_float(r[0]) + __uint_as_float(r[1]); }
    return v;
}
__device__ __forceinline__ void phase_peer_sliced(KP P, LAS unsigned char* lds, int bx, int G) {
    const int grp = bx & 7;
    const unsigned char* UB = P.ws + WS_UB; const unsigned char* VB = P.ws + WS_VB; const bf16* HB = (const bf16*)(P.ws + WS_XN);
    const int* ridx = (const int*)(P.ws + WS_PROJ + 64 * MiB); const float* rgate = (const float*)(P.ws + WS_PROJ + 68 * MiB); const float* RSTD = (const float*)(P.ws + WS_SSP + 2 * MiB);
    for (int bt = bx; bt < TT / 32; bt += G) {
        const int tid = ltid(), lane = tid & 63, wave = __builtin_amdgcn_readfirstlane(tid >> 6), g8 = lane >> 3, p = lane & 7;
        LAS int* idxT = (LAS int*)(lds + wave * 4096); LAS float* gT = (LAS float*)(lds + wave * 4096 + 2048);
        LAS bf16* h2T = (LAS bf16*)(lds + 32768 + wave * 16384);
        const int t0 = 32 * bt + 4 * wave;
#pragma unroll
        for (int i = 0; i < 4; ++i) { const size_t o = (size_t)(t0 + i) * 128; const int wofs = (i * 8 + (lane & 7)) * 16 + (lane >> 3);
            idxT[wofs] = ridx[o + lane]; idxT[wofs + 8] = ridx[o + 64 + lane]; gT[wofs] = rgate[o + lane]; gT[wofs + 8] = rgate[o + 64 + lane]; }
        float hacc[4][2];
#pragma unroll
        for (int i = 0; i < 4; ++i) { hacc[i][0] = 0.f; hacc[i][1] = 0.f; }
        {
            v4u rA[8], rB[8]; f32x2 xA[8], xB[8];
#define PS_SG(s_) (((s_) + 2 * grp) & 15)
#define PS_ISSUE(R, tabbase, s_, i_, hb_) do { const unsigned char* tb_ = (tabbase) + (size_t)PS_SG(s_) * SLICE_BYTES;        \
            const v4u ia_ = *(const LAS v4u*)(idxT + ((i_) * 8 + g8) * 16 + 8 * (hb_)), ib_ = *(const LAS v4u*)(idxT + ((i_) * 8 + g8) * 16 + 8 * (hb_) + 4); const unsigned po_ = 16u * (unsigned)p; \
            R[0] = *(const v4u*)(tb_ + (ia_[0] * 128u + po_)); R[1] = *(const v4u*)(tb_ + (ia_[1] * 128u + po_)); R[2] = *(const v4u*)(tb_ + (ia_[2] * 128u + po_)); R[3] = *(const v4u*)(tb_ + (ia_[3] * 128u + po_)); \
            R[4] = *(const v4u*)(tb_ + (ib_[0] * 128u + po_)); R[5] = *(const v4u*)(tb_ + (ib_[1] * 128u + po_)); R[6] = *(const v4u*)(tb_ + (ib_[2] * 128u + po_)); R[7] = *(const v4u*)(tb_ + (ib_[3] * 128u + po_)); } while (0)
#define PS_LOADX(X, s_, i_) do { const bf16* xp_ = HB + (size_t)(t0 + (i_)) * DM + 128 * PS_SG(s_) + 16 * p; const v4u xa_ = *(const v4u*)xp_, xb_ = *(const v4u*)(xp_ + 8); \
            _Pragma("unroll") for (int q = 0; q < 4; ++q) { X[q] = (f32x2){bflo(xa_[q]), bfhi(xa_[q])}; X[4 + q] = (f32x2){bflo(xb_[q]), bfhi(xb_[q])}; } } while (0)
#define PS_DOTS(R, X, i_, hb_) do { _Pragma("unroll") for (int m = 0; m < 8; ++m) { const f32x2 a2_ = dot16p(R[m], X, (f32x2){0.f, 0.f}); float sd_ = a2_.x + a2_.y; \
            sd_ += DPP_F(sd_, 0xB1); sd_ += DPP_F(sd_, 0x4E); sd_ += DPP_F(sd_, 0x141); if (p == m) hacc[i_][hb_] += sd_; } asm volatile("" ::: "memory"); } while (0)
            PS_LOADX(xA, 0, 0); PS_ISSUE(rA, UB, 0, 0, 0);
            for (int s = 0; s < 16; ++s) {
                PS_ISSUE(rB, UB, s, 0, 1); PS_LOADX(xB, s, 1);  PS_DOTS(rA, xA, 0, 0);
                PS_ISSUE(rA, UB, s, 1, 0);                       PS_DOTS(rB, xA, 0, 1);
                PS_ISSUE(rB, UB, s, 1, 1); PS_LOADX(xA, s, 2);  PS_DOTS(rA, xB, 1, 0);
                PS_ISSUE(rA, UB, s, 2, 0);                       PS_DOTS(rB, xB, 1, 1);
                PS_ISSUE(rB, UB, s, 2, 1); PS_LOADX(xB, s, 3);  PS_DOTS(rA, xA, 2, 0);
                PS_ISSUE(rA, UB, s, 3, 0);                       PS_DOTS(rB, xA, 2, 1);
                PS_ISSUE(rB, UB, s, 3, 1); if (s + 1 < 16) PS_LOADX(xA, s + 1, 0);  PS_DOTS(rA, xB, 3, 0);
                if (s + 1 < 16) PS_ISSUE(rA, UB, s + 1, 0, 0);  PS_DOTS(rB, xB, 3, 1);
            }
#undef PS_LOADX
#undef PS_DOTS
        }
#pragma unroll
        for (int i = 0; i < 4; ++i) { const float rsn = RSTD[t0 + i] * (1.f / U_SCALE);
#pragma unroll
            for (int hb = 0; hb < 2; ++hb) { const float hp = hacc[i][hb] * rsn; LAS float* gp = gT + (i * 8 + g8) * 16 + 8 * hb + p;
                *gp = 0.5f * hp * (1.f + erff(hp * 0.70710678118654752f)) * (1.f / V_SCALE) * *gp; } }
        float ssq[4] = {0.f, 0.f, 0.f, 0.f};
        {
            v4u rA[8], rB[8]; f32x2 y2[8];
#define PS_AXPY(R, i_, hb_) do { const f32x4 aa_ = *(const LAS f32x4*)(gT + ((i_) * 8 + g8) * 16 + 8 * (hb_)), ab_ = *(const LAS f32x4*)(gT + ((i_) * 8 + g8) * 16 + 8 * (hb_) + 4); \
            if ((hb_) == 0) { _Pragma("unroll") for (int q = 0; q < 8; ++q) y2[q] = (f32x2){0.f, 0.f}; } \
            _Pragma("unroll") for (int m = 0; m < 8; ++m) { const float av_ = m < 4 ? aa_[m & 3] : ab_[m & 3]; axpy16p(R[m], (f32x2){av_, av_}, y2); } asm volatile("" ::: "memory"); } while (0)
#define PS_FIN(s_, i_) do { f32x2 ysel_ = {0.f, 0.f}; _Pragma("unroll") for (int q = 0; q < 8; ++q) { const float a_ = xsum_g8(y2[q].x), b_ = xsum_g8(y2[q].y); if (g8 == q) ysel_ = (f32x2){a_, b_}; } \
            const int d_ = 128 * PS_SG(s_) + 16 * p + 2 * g8; const unsigned hb_ = *(const unsigned*)(HB + (size_t)(t0 + (i_)) * DM + d_); const f32x2 hv_ = (f32x2){bflo(hb_), bfhi(hb_)} + ysel_; \
            *(LAS unsigned*)(h2T + (i_) * DM + d_) = pk2(hv_.x, hv_.y); ssq[i_] += hv_.x * hv_.x + hv_.y * hv_.y; } while (0)
            PS_ISSUE(rA, VB, 0, 0, 0);
            for (int s = 0; s < 16; ++s) {
                PS_ISSUE(rB, VB, s, 0, 1); PS_AXPY(rA, 0, 0);
                PS_ISSUE(rA, VB, s, 1, 0); PS_AXPY(rB, 0, 1); PS_FIN(s, 0);
                PS_ISSUE(rB, VB, s, 1, 1); PS_AXPY(rA, 1, 0);
                PS_ISSUE(rA, VB, s, 2, 0); PS_AXPY(rB, 1, 1); PS_FIN(s, 1);
                PS_ISSUE(rB, VB, s, 2, 1); PS_AXPY(rA, 2, 0);
                PS_ISSUE(rA, VB, s, 3, 0); PS_AXPY(rB, 2, 1); PS_FIN(s, 2);
                PS_ISSUE(rB, VB, s, 3, 1); PS_AXPY(rA, 3, 0);
                if (s + 1 < 16) PS_ISSUE(rA, VB, s + 1, 0, 0); PS_AXPY(rB, 3, 1); PS_FIN(s, 3);
            }
#undef PS_AXPY
#undef PS_FIN
#undef PS_ISSUE
#undef PS_SG
        }
        { f32x4 fg[8];
#pragma unroll
          for (int j = 0; j < 8; ++j) fg[j] = *(const f32x4*)(P.final_g + 4 * lane + 256 * j);
#pragma unroll
          for (int i = 0; i < 4; ++i) { const float rs2 = 1.0f / sqrtf(wave_sum(ssq[i]) * (1.f / DM) + RMS_EPS);
#pragma unroll
            for (int j = 0; j < 8; ++j) { const v2u hv = *(const LAS v2u*)(h2T + i * DM + 4 * lane + 256 * j);
                *(f32x4*)(P.out + (size_t)(t0 + i) * DM + 4 * lane + 256 * j) = (f32x4){bflo(hv.x) * rs2 * fg[j].x, bfhi(hv.x) * rs2 * fg[j].y, bflo(hv.y) * rs2 * fg[j].z, bfhi(hv.y) * rs2 * fg[j].w}; } } }
        asm volatile("" ::: "memory");
    }
}
namespace moba {
constexpr float SCALE = 0.08838834764831845f;
constexpr float THR = 8.f;
constexpr bool WSKIP = false;
constexpr int D = 128, NW = 8, QBLK = 32, KVBLK = 64, QB = NW * QBLK;
constexpr int SHM_V = KVBLK * D * 2, SHM_K = KVBLK * D * 2;
constexpr int ATT_LDS_BYTES = 2 * SHM_V + 2 * SHM_K + NW * 64 * 4;
constexpr int KPITCH = INCP, QPITCH = INCP, OPITCH = DM;
typedef unsigned short bf16;
typedef short bf16x8 __attribute__((ext_vector_type(8)));
typedef short s16x4 __attribute__((ext_vector_type(4)));
typedef float f32x16 __attribute__((ext_vector_type(16)));
typedef float f32x4 __attribute__((ext_vector_type(4)));
typedef unsigned u32x4 __attribute__((ext_vector_type(4)));
template <class A, class Bt> struct same_t { static constexpr bool v = false; };
template <class A> struct same_t<A, A> { static constexpr bool v = true; };
#define KSWZ(row, colB) ((row) * 256 + ((colB) ^ (((row) & 7) << 4)))
#define SBAR() __builtin_amdgcn_sched_barrier(0)
__device__ __forceinline__ int v_st(int k, int c) { const int kk = (k & ~0xC) | ((k & 4) << 1) | ((k & 8) >> 1); return ((kk >> 3) * 4 + (c >> 5)) * 512 + ((kk & 7) * 32 + (c & 31)) * 2; }
__device__ __forceinline__ int v_rd_base(int lane) { return ((lane & 3) << 3) | (((lane >> 2) & 3) << 6) | (((lane >> 4) & 1) << 5) | (((lane >> 5) & 1) << 8); }
constexpr int v_rd_off(int d0, int ks, int half) { return d0 * 512 + ks * 4096 + half * 2048; }
__device__ __forceinline__ int crow(int r, int hi) { return (r & 3) + 8 * (r >> 2) + 4 * hi; }
__device__ __forceinline__ unsigned cvtpk(float lo, float hi) {
    unsigned r; asm volatile("v_cvt_pk_bf16_f32 %0, %1, %2" : "=v"(r) : "v"(lo), "v"(hi)); return r;
}
__device__ __forceinline__ bf16x8 pack8(f32x4 a, f32x4 b) {
    u32x4 w = {cvtpk(a[0], a[1]), cvtpk(a[2], a[3]), cvtpk(b[0], b[1]), cvtpk(b[2], b[3])};
    return *reinterpret_cast<bf16x8*>(&w);
}
template <class T> __device__ __forceinline__ bf16x8 load8(const T* p) {
    if constexpr (same_t<T, float>::v) { return pack8(*(const f32x4*)p, *(const f32x4*)(p + 4)); }
    else { return *reinterpret_cast<const bf16x8*>(p); }
}
__device__ __forceinline__ void mask_tile(f32x16& p0, f32x16& p1, int dq, unsigned W) {
    const float NEG = -__builtin_inff();
#pragma unroll
    for (int r = 0; r < 16; ++r) {
        const int c = (r & 3) + 8 * (r >> 2);
        if ((unsigned)(dq - c) >= W) p0[r] = NEG;
        if ((unsigned)(dq - c - 32) >= W) p1[r] = NEG;
    }
}
__device__ __forceinline__ void partialSM(f32x16& p0, f32x16& p1, float& m_reg, float& mn, float& alpha, float base0, float base1) {
    float pm0 = p0[0]; for (int r = 1; r < 16; ++r) pm0 = fmaxf(pm0, p0[r]); float pm1 = p1[0]; for (int r = 1; r < 16; ++r) pm1 = fmaxf(pm1, p1[r]);
    float pmax = fmaxf(pm0 + base0, pm1 + base1);
    { auto rr = __builtin_amdgcn_permlane32_swap(__float_as_uint(pmax), __float_as_uint(pmax), false, false);
      pmax = fmaxf(__uint_as_float(rr[0]), __uint_as_float(rr[1])); }
    constexpr float C2 = 1.4426950408889634f * SCALE;
    if (__builtin_expect(__all((pmax - m_reg) * SCALE <= THR), 1)) { mn = m_reg; alpha = 1.f; }
    else { mn = fmaxf(m_reg, pmax); alpha = __builtin_amdgcn_exp2f((m_reg - mn) * C2); m_reg = mn; }
    const float mnL0 = (base0 - mn) * C2, mnL1 = (base1 - mn) * C2;
    for (int r = 0; r < 16; ++r) p0[r] = fmaf(p0[r], C2, mnL0); for (int r = 0; r < 16; ++r) p1[r] = fmaf(p1[r], C2, mnL1);
    for (int r = 0; r < 16; ++r) p0[r] = __builtin_amdgcn_exp2f(p0[r]);
}
__device__ __forceinline__ void finishSM(f32x16& p0, f32x16& p1, float alpha, float& l_reg, bf16x8& pa0, bf16x8& pa1, bf16x8& pa2, bf16x8& pa3) {
    for (int r = 0; r < 16; ++r) p1[r] = __builtin_amdgcn_exp2f(p1[r]);
    float ps = 0; for (int r = 0; r < 16; ++r) ps += p0[r]; for (int r = 0; r < 16; ++r) ps += p1[r];
    { auto rr = __builtin_amdgcn_permlane32_swap(__float_as_uint(ps), __float_as_uint(ps), false, false);
      ps = __uint_as_float(rr[0]) + __uint_as_float(rr[1]); }
    l_reg = l_reg * alpha + ps;
#define PK4(P, B_, OUT) do { unsigned a0 = cvtpk(P[B_+0], P[B_+1]), a1 = cvtpk(P[B_+2], P[B_+3]);                          \
        unsigned b0 = cvtpk(P[B_+4], P[B_+5]), b1 = cvtpk(P[B_+6], P[B_+7]);                                             \
        auto r0 = __builtin_amdgcn_permlane32_swap(a0, b0, false, false); auto r1 = __builtin_amdgcn_permlane32_swap(a1, b1, false, false); \
        u32x4 w = {r0[0], r1[0], r0[1], r1[1]}; OUT = *reinterpret_cast<bf16x8*>(&w); } while (0)
    PK4(p0, 0, pa0); PK4(p0, 8, pa1); PK4(p1, 0, pa2); PK4(p1, 8, pa3);
#undef PK4
}
template <int KB, bool SK>
__device__ __forceinline__ void qkt(f32x16& p0, f32x16& p1, const char* K_lds, int r32, int hi, const bf16x8* qr, bool act) {
    if (SK && !act) { const float NEG = -__builtin_inff();
#pragma unroll
        for (int r = 0; r < 16; ++r) { p0[r] = NEG; p1[r] = NEG; } return; }
    p0 = f32x16{}; p1 = f32x16{};
    const char* kb[4];
#pragma unroll
    for (int dd = 0; dd < 4; ++dd) kb[dd] = K_lds + KB * SHM_K + KSWZ(r32, (dd * 16 + hi * 8) * 2);
#pragma unroll
    for (int d0 = 0; d0 < 8; ++d0) { const char* a = kb[d0 & 3] + (d0 >> 2) * 128;
        bf16x8 b0 = *reinterpret_cast<const bf16x8*>(a);
        bf16x8 b1 = *reinterpret_cast<const bf16x8*>(a + 32 * 256);
        p0 = __builtin_amdgcn_mfma_f32_32x32x16_bf16(b0, qr[d0], p0, 0, 0, 0);
        p1 = __builtin_amdgcn_mfma_f32_32x32x16_bf16(b1, qr[d0], p1, 0, 0, 0); }
}
template <int VB, bool SK>
__device__ __forceinline__ void pv_tile(f32x16* o, int vb0, bf16x8 pa0, bf16x8 pa1, bf16x8 pa2, bf16x8 pa3, bool act) {
    if (SK && !act) return;
#define TRRD(dst, off) asm volatile("ds_read_b64_tr_b16 %0, %1 offset:%2" : "=&v"(dst) : "v"(vb0), "i"(off) : "memory")
#define PV_D0(d0) do { s16x4 l0, l1, h0, h1; constexpr int b_ = VB * SHM_V + v_rd_off(d0, 0, 0);     \
        TRRD(l0, b_); TRRD(h0, b_ + 2048); TRRD(l1, b_ + 4096); TRRD(h1, b_ + 6144); \
        asm volatile("s_waitcnt lgkmcnt(0)" ::: "memory"); SBAR();                 \
        o[d0] = __builtin_amdgcn_mfma_f32_32x32x16_bf16(pa0, (bf16x8){l0[0], l0[1], l0[2], l0[3], h0[0], h0[1], h0[2], h0[3]}, o[d0], 0, 0, 0);   \
        o[d0] = __builtin_amdgcn_mfma_f32_32x32x16_bf16(pa1, (bf16x8){l1[0], l1[1], l1[2], l1[3], h1[0], h1[1], h1[2], h1[3]}, o[d0], 0, 0, 0);   \
        SBAR(); TRRD(l0, b_ + 8192); TRRD(h0, b_ + 10240); TRRD(l1, b_ + 12288); TRRD(h1, b_ + 14336); \
        asm volatile("s_waitcnt lgkmcnt(0)" ::: "memory"); SBAR();   \
        o[d0] = __builtin_amdgcn_mfma_f32_32x32x16_bf16(pa2, (bf16x8){l0[0], l0[1], l0[2], l0[3], h0[0], h0[1], h0[2], h0[3]}, o[d0], 0, 0, 0);   \
        o[d0] = __builtin_amdgcn_mfma_f32_32x32x16_bf16(pa3, (bf16x8){l1[0], l1[1], l1[2], l1[3], h1[0], h1[1], h1[2], h1[3]}, o[d0], 0, 0, 0); } while (0)
    PV_D0(0); PV_D0(1); PV_D0(2); PV_D0(3);
#undef PV_D0
#undef TRRD
}

template <class TIn, class TOut> struct BlockRef { const TIn* Q; const TIn* K; const TIn* V; TOut* O; int P0; const float* KM; float A; int jlo, jhi; float* ST; };
template <class TIn> struct Seam {
    bf16x8 qr[8];
    bf16x8 st_v0, st_v1, st_k0, st_k1; f32x4 sf0, sf1, sf2, sf3;
    f32x4 tq[16];
};
__device__ __forceinline__ int swa_jlo(int P0, int W) { const int lowk = P0 - W + 1; return lowk > 0 ? lowk / KVBLK : 0; }
#define ROW(p, k0, rr) ((p) + (size_t)((k0) + (rr)) * KPITCH + sc)
#define VMW() asm volatile("s_waitcnt vmcnt(0)" ::: "memory")
#define VMWN(n) asm volatile("s_waitcnt vmcnt(%0)" :: "i"(n) : "memory")
#define SLOAD_H(Kp, Vp, k0) do { S.st_v0 = load8<TIn>(ROW(Vp, k0, sr)); S.st_v1 = load8<TIn>(ROW(Vp, k0, 32 + sr));              \
                         S.st_k0 = load8<TIn>(ROW(Kp, k0, sr)); S.st_k1 = load8<TIn>(ROW(Kp, k0, 32 + sr)); } while (0)
#define SWRITE_HK(bf) do { *(bf16x8*)(K_lds + (bf) * SHM_K + kws) = S.st_k0; *(bf16x8*)(K_lds + (bf) * SHM_K + kws + 32 * 256) = S.st_k1; } while (0)
#define SWRITE_HV(bf) do { *(bf16x8*)(V_lds + (bf) * SHM_V + vst0) = S.st_v0; *(bf16x8*)(V_lds + (bf) * SHM_V + vst1) = S.st_v1; } while (0)
#define SWRITE_H(bf) do { SWRITE_HV(bf); SWRITE_HK(bf); } while (0)
#define SLOAD_F(p, k0) do { S.sf0 = *(const f32x4*)ROW(p, k0, sr); S.sf1 = *(const f32x4*)(ROW(p, k0, sr) + 4);                \
                            S.sf2 = *(const f32x4*)ROW(p, k0, 32 + sr); S.sf3 = *(const f32x4*)(ROW(p, k0, 32 + sr) + 4); } while (0)
#define SWRITE_KF(bf) do { *(bf16x8*)(K_lds + (bf) * SHM_K + kws) = pack8(S.sf0, S.sf1); *(bf16x8*)(K_lds + (bf) * SHM_K + kws + 32 * 256) = pack8(S.sf2, S.sf3); } while (0)
#define SWRITE_VF(bf) do { *(bf16x8*)(V_lds + (bf) * SHM_V + vst0) = pack8(S.sf0, S.sf1); *(bf16x8*)(V_lds + (bf) * SHM_V + vst1) = pack8(S.sf2, S.sf3); } while (0)
template <class TIn, class TOut>
__device__ __forceinline__ void causal_swa_prime(const BlockRef<TIn, TOut>& cur, int W, char* lds, Seam<TIn>& S) {
    constexpr bool F32 = same_t<TIn, float>::v;
    const int tid = ltid(), wid = __builtin_amdgcn_readfirstlane(tid >> 6), lane = tid & 63, r32 = lane & 31, hi = lane >> 5;
    const int sr = tid >> 4, sc = (tid & 15) * 8, kws = KSWZ(sr, sc * 2); char* K_lds = lds + 2 * SHM_V;
    const int kb0 = cur.jlo * KVBLK;
    for (int d0 = 0; d0 < 8; ++d0) S.qr[d0] = load8<TIn>(cur.Q + (size_t)(wid * QBLK + r32) * QPITCH + d0 * 16 + hi * 8);
    if constexpr (F32) { SLOAD_F((const float*)cur.K, kb0); VMW(); SWRITE_KF(0); SBAR(); SLOAD_F((const float*)cur.V, kb0); }
    else { SLOAD_H(cur.K, cur.V, kb0); VMW(); SWRITE_HK(0); }
    __syncthreads();
}
template <class TIn, class TOut>
__device__ __forceinline__ void causal_swa_block(const BlockRef<TIn, TOut>& cur, const BlockRef<TIn, TOut>& nxt, int skv, int W, char* lds, Seam<TIn>& S) {
    constexpr bool F32 = same_t<TIn, float>::v;
    const int tid = ltid(), wid = __builtin_amdgcn_readfirstlane(tid >> 6), lane = tid & 63, r32 = lane & 31, hi = lane >> 5;
    const int j_lo = cur.jlo, j_hi = cur.jhi;
    const int NT = j_hi - j_lo;
    const int kbn = nxt.jlo * KVBLK;
    const int qlo = cur.P0 + wid * QBLK, qm = qlo + r32 - 4 * hi;
    char* V_lds = lds; char* K_lds = lds + 2 * SHM_V;
    float* ws = (float*)(lds + 2 * SHM_V + 2 * SHM_K) + wid * 64; float* li_l = ws, * al_l = ws + 32;
    float m_reg = -1e30f, l_reg = 0; f32x16 o[4] = {};
    const int sr = tid >> 4, sc = (tid & 15) * 8, vst0 = v_st(sr, sc), vst1 = v_st(32 + sr, sc), kws = KSWZ(sr, sc * 2);
    const int vb0 = (int)(uintptr_t)V_lds + v_rd_base(lane);
    const TIn* Kh = cur.K; const TIn* Vh = cur.V;
    const float alA_ = cur.A;
    unsigned selm = 0u;
    { const int qb_ = cur.P0 >> 8;
      if (qb_ > 0) {
        float* kmL = (float*)(K_lds + SHM_K);
        *(f32x4*)(kmL + 4 * tid) = *(const f32x4*)(cur.KM + (size_t)(tid >> 5) * 1024 + 4 * (tid & 31));
        __syncthreads();
        float g[16];
#pragma unroll
        for (int n = 0; n < 16; ++n) g[n] = 0.f;
#pragma unroll
        for (int d0 = 0; d0 < 8; ++d0) { float qf[8];
#pragma unroll
            for (int j = 0; j < 8; ++j) qf[j] = __uint_as_float(((unsigned)(unsigned short)S.qr[d0][j]) << 16);
#pragma unroll
            for (int n = 0; n < 16; ++n) if (n < qb_) { const f32x4 k0 = *(const f32x4*)(kmL + n * 128 + d0 * 16 + hi * 8), k1 = *(const f32x4*)(kmL + n * 128 + d0 * 16 + hi * 8 + 4);
                g[n] += qf[0] * k0[0] + qf[1] * k0[1] + qf[2] * k0[2] + qf[3] * k0[3] + qf[4] * k1[0] + qf[5] * k1[1] + qf[6] * k1[2] + qf[7] * k1[3]; }
            asm volatile("" ::: "memory"); }
#pragma unroll
        for (int n = 0; n < 16; ++n) { const float a = g[n] + __shfl_xor(g[n], 32); g[n] = n < qb_ ? a : -1e30f; }
#pragma unroll
        for (int r = 0; r < 3; ++r) { float best = -3e38f; int bi = 0;
#pragma unroll
            for (int n = 0; n < 16; ++n) if (!((selm >> n) & 1u) && g[n] > best) { best = g[n]; bi = n; }
            selm |= 1u << bi; }
        selm &= (1u << qb_) - 1u;
        __syncthreads();
      }
      li_l[r32] = __uint_as_float(selm); }
#define RESC(a) do { if (__any((a) < 1.f)) { if (hi == 0) al_l[r32] = (a); asm volatile("s_waitcnt lgkmcnt(0)" ::: "memory");              \
                     for (int d_ = 0; d_ < 4; ++d_) for (int r = 0; r < 16; ++r) o[d_][r] *= al_l[crow(r, hi)]; } } while (0)
#define KBASE(t) ((j_lo + (t)) * KVBLK)
#define ACT(t) (KBASE(t) <= qlo + QBLK - 1 && KBASE(t) + KVBLK - 1 >= qlo - W + 1)
#define MASKT(P0_, P1_, t) do { const int kb_ = KBASE(t); if ((!SK || ACT(t)) && (kb_ + KVBLK - 1 > qlo || kb_ <= qlo + QBLK - 1 - W)) mask_tile(P0_, P1_, qm - kb_, (unsigned)W); \
        _Pragma("unroll") for (int r = 0; r < 16; ++r) { const float c_ = (float)((r & 3) + 8 * (r >> 2)); P0_[r] = fmaf(alA_, c_, P0_[r]); P1_[r] = fmaf(alA_, c_, P1_[r]); } } while (0)
#define BASE0(t) ((KBASE(t) < cur.P0 && !((__float_as_uint(li_l[r32]) >> (KBASE(t) >> 8)) & 1u)) ? -__builtin_inff() : alA_ * (float)(KBASE(t) - cur.P0 + 4 * hi))
#define BASE1(t) (BASE0(t) + 32.f * alA_)
    constexpr int NQL = F32 ? 16 : 8;
    constexpr bool SK = WSKIP && !F32;
#define SEAM_K0() do { VMWN(NQL); if constexpr (F32) { SWRITE_KF(0); SBAR(); SLOAD_F((const float*)nxt.V, kbn); } else { SWRITE_HK(0); } SBAR(); } while (0)
    f32x16 pA0, pA1, pB0, pB1; float mnA, mnB, alA, alB; bf16x8 pa0, pa1, pa2, pa3;
    if constexpr (F32) { VMW(); SWRITE_VF(0); SBAR(); } else { SWRITE_HV(0); SBAR(); }
    if (NT > 1) { if constexpr (F32) SLOAD_F((const float*)Kh, KBASE(1)); else SLOAD_H(Kh, Vh, KBASE(1)); }
    SBAR(); qkt<0, SK>(pA0, pA1, K_lds, r32, hi, S.qr, ACT(0));
    if constexpr (F32) { if (NT > 1) { VMW(); SWRITE_KF(1); SBAR(); SLOAD_F((const float*)Vh, KBASE(1)); } }
    MASKT(pA0, pA1, 0); partialSM(pA0, pA1, m_reg, mnA, alA, BASE0(0), BASE1(0));
    if (NT > 1) { VMW(); if constexpr (F32) { SWRITE_VF(1); SBAR(); if (NT > 2) SLOAD_F((const float*)Kh, KBASE(2)); } else SWRITE_H(1); }
    __syncthreads();
#define HALF_STEP(PX0, PX1, mnX, alX, PY0, PY1, alY, t, KB, VB, SB) do {                                                      \
        SBAR(); qkt<KB, SK>(PX0, PX1, K_lds, r32, hi, S.qr, ACT(t));                                             \
        finishSM(PY0, PY1, alY, l_reg, pa0, pa1, pa2, pa3); SBAR();                                                           \
        if ((t) + 1 < NT) { if constexpr (F32) { VMW(); SWRITE_KF(SB); SBAR(); SLOAD_F((const float*)Vh, KBASE((t) + 1)); }  \
                            else { SLOAD_H(Kh, Vh, KBASE((t) + 1)); } SBAR(); }                                               \
        pv_tile<VB, SK>(o, vb0, pa0, pa1, pa2, pa3, ACT((t) - 1)); MASKT(PX0, PX1, (t)); partialSM(PX0, PX1, m_reg, mnX, alX, BASE0(t), BASE1(t));                                        \
        __syncthreads();                                                                                                      \
        if ((t) + 1 < NT) { VMW(); if constexpr (F32) { SWRITE_VF(SB); SBAR(); if ((t) + 2 < NT) SLOAD_F((const float*)Kh, KBASE((t) + 2)); } \
                            else { SWRITE_H(SB); } }                                                                          \
        RESC(alX); __syncthreads(); } while (0)
    for (int t = 1; t + 1 < NT; t += 2) {
        HALF_STEP(pB0, pB1, mnB, alB, pA0, pA1, alA, t, 1, 0, 0);
        HALF_STEP(pA0, pA1, mnA, alA, pB0, pB1, alB, t + 1, 0, 1, 1);
    }
    const bool even = (NT & 1) == 0;
    if (even) { SBAR(); qkt<1, SK>(pB0, pB1, K_lds, r32, hi, S.qr, ACT(NT - 1)); SBAR(); }
#define QROW(e) (nxt.Q + (size_t)(wid * QBLK + r32) * QPITCH + ((e) >> 1) * 16 + hi * 8 + ((e) & 1) * 4)
    if constexpr (F32) { SLOAD_F((const float*)nxt.K, kbn); SBAR();
#pragma unroll
        for (int e = 0; e < 8; ++e) S.tq[e] = *(const f32x4*)QROW(e); }
    else { SLOAD_H(nxt.K, nxt.V, kbn); SBAR();
#pragma unroll
        for (int d0 = 0; d0 < 8; ++d0) S.qr[d0] = load8<TIn>(nxt.Q + (size_t)(wid * QBLK + r32) * QPITCH + d0 * 16 + hi * 8); }
    SBAR();
    finishSM(pA0, pA1, alA, l_reg, pa0, pa1, pa2, pa3); SBAR();
    if constexpr (F32) {
#pragma unroll
        for (int e = 8; e < 16; ++e) S.tq[e] = *(const f32x4*)QROW(e); SBAR(); }
#undef QROW
    pv_tile<0, SK>(o, vb0, pa0, pa1, pa2, pa3, ACT(even ? NT - 2 : NT - 1));
    if (even) { MASKT(pB0, pB1, NT - 1); partialSM(pB0, pB1, m_reg, mnB, alB, BASE0(NT - 1), BASE1(NT - 1)); __syncthreads(); RESC(alB);
        finishSM(pB0, pB1, alB, l_reg, pa0, pa1, pa2, pa3); SBAR(); pv_tile<1, SK>(o, vb0, pa0, pa1, pa2, pa3, ACT(NT - 1)); }
    SBAR(); SEAM_K0();
    if (hi == 0) { li_l[r32] = l_reg; if (cur.ST) { cur.ST[(wid * QBLK + r32) * 16] = m_reg; cur.ST[(wid * QBLK + r32) * 16 + 1] = l_reg; } }
    asm volatile("s_waitcnt lgkmcnt(0)" ::: "memory");
    float rli[16];
#pragma unroll
    for (int r = 0; r < 16; ++r) { const float l_ = li_l[crow(r, hi)]; rli[r] = l_ > 0.f ? __builtin_amdgcn_rcpf(l_) : 0.f; }
    TOut* Ow = cur.O + (size_t)(wid * QBLK) * OPITCH;
#pragma unroll
    for (int r = 0; r < 16; ++r) { const int orow = crow(r, hi);
#pragma unroll
        for (int d0 = 0; d0 < 4; ++d0) { const float v = o[d0][r] * rli[r];
            if constexpr (same_t<TOut, float>::v) { Ow[(size_t)orow * OPITCH + d0 * 32 + r32] = v; }
            else { const float vn = __shfl_xor(v, 1);
                   if ((r32 & 1) == 0) *(unsigned*)(Ow + (size_t)orow * OPITCH + d0 * 32 + r32) = cvtpk(v, vn); } } }
    if constexpr (F32) {
#pragma unroll
        for (int d0 = 0; d0 < 8; ++d0) S.qr[d0] = pack8(S.tq[2 * d0], S.tq[2 * d0 + 1]); }
    __syncthreads();
#undef RESC
#undef KBASE
#undef ACT
#undef MASKT
#undef SEAM_K0
#undef HALF_STEP
}
#undef ROW
#undef VMW
#undef VMWN
#undef SLOAD_H
#undef SWRITE_HK
#undef SWRITE_HV
#undef SWRITE_H
#undef SLOAD_F
#undef SWRITE_KF
#undef SWRITE_VF

#undef BASE0
#undef BASE1
}
constexpr size_t WS_OSL = WS_XN, WS_OSU = WS_H;
constexpr size_t WS_STL = WS_WIN, WS_STU = WS_WIN + 1 * MiB;
constexpr int MOBA_SPLIT_QB = 8;
__device__ __forceinline__ void phase_moba(KP P, char* lds, int vcu, int G) {
    typedef moba::BlockRef<moba::bf16, moba::bf16> BR;
    const moba::bf16* proj = (const moba::bf16*)(P.ws + WS_PROJ); moba::bf16* AR = (moba::bf16*)(P.ws + WS_AR); const float* kmean = (const float*)(P.ws + WS_KMEAN);
    constexpr int W = 1 << 30;
    auto mkref = [&](int bh, int qb, int part) -> BR { const int b = bh >> 3, h = bh & 7; BR r; const int nt = 4 * qb + 4;
        r.Q = proj + (size_t)(b * SEQ + qb * 256) * INCP + h * 128; r.K = proj + (size_t)(b * SEQ) * INCP + C_AK + h * 128; r.V = proj + (size_t)(b * SEQ) * INCP + C_AV + h * 128;
        moba::bf16* ob = part == 0 ? AR : (moba::bf16*)(P.ws + (part == 1 ? WS_OSL : WS_OSU));
        r.O = ob + (size_t)(b * SEQ + qb * 256) * DM + h * 128; r.P0 = qb * 256; r.KM = kmean + (size_t)(b * 16) * 1024 + h * 128; r.A = exp2f(-(float)(h + 1)) * (1.f / moba::SCALE);
        r.jlo = part == 2 ? nt / 2 : 0; r.jhi = part == 1 ? nt / 2 : nt;
        r.ST = part == 0 ? nullptr : (float*)(P.ws + (part == 1 ? WS_STL : WS_STU)) + ((size_t)(b * SEQ + qb * 256) * 8 + h) * 2;
        return r; };
    moba::Seam<moba::bf16> S;
    if (G == 256) {
        const int q_ = vcu & 15, bh = vcu >> 4;
        const int qbA[16] = {-1, -1, 15, 15,  7, 14, 14, 13, 13,  6, 12, 12, 11, 11,  5, 10};
        const int ptA[16] = { 0,  0,  2,  1,  0,  2,  1,  2,  1,  0,  2,  1,  2,  1,  0,  2};
        const int qbB[16] = {-1, -1, -1, -1, -1,  0, -1,  1,  2,  3,  8,  8,  4,  9,  9, 10};
        const int ptB[16] = { 0,  0,  0,  0,  0,  0,  0,  0,  0,  0,  2,  1,  0,  2,  1,  1};
        int qa = -1, pa = 0, qb2 = -1, pb = 0;
#pragma unroll
        for (int k = 0; k < 16; ++k) if (k == q_) { qa = qbA[k]; pa = ptA[k]; qb2 = qbB[k]; pb = ptB[k]; }
        for (int it = 0; it < 2; ++it) { const int qq = it == 0 ? qa : qb2, pp = it == 0 ? pa : pb; if (qq < 0) continue;
            const BR cur = mkref(bh, qq, pp);
            moba::causal_swa_prime<moba::bf16, moba::bf16>(cur, W, lds, S);
            moba::causal_swa_block<moba::bf16, moba::bf16>(cur, cur, SEQ, W, lds, S); }
    } else {
        for (int item = vcu; item < 256; item += G) {
            const BR cur = mkref(item >> 4, item & 15, 0);
            moba::causal_swa_prime<moba::bf16, moba::bf16>(cur, W, lds, S);
            moba::causal_swa_block<moba::bf16, moba::bf16>(cur, cur, SEQ, W, lds, S); }
    }
}
__device__ __forceinline__ void moba_combine(KP P, int vcu, int G) {
    if (G != 256) return;
    const int tid = ltid(); const bf16* OL = (const bf16*)(P.ws + WS_OSL); const bf16* OU = (const bf16*)(P.ws + WS_OSU); bf16* AR = (bf16*)(P.ws + WS_AR);
    const float* STL = (const float*)(P.ws + WS_STL); const float* STU = (const float*)(P.ws + WS_STU);
    constexpr int NSPL = 16 - MOBA_SPLIT_QB; constexpr float C2 = 1.4426950408889634f * moba::SCALE;
    for (int item = vcu; item < 16 * NSPL * 2; item += G) {
        const int half = item & 1, k = item >> 1, bh = k / NSPL, qb = MOBA_SPLIT_QB + k % NSPL, b = bh >> 3, h = bh & 7;
        const int row = b * SEQ + qb * 256 + half * 128 + (tid >> 2), c0 = (tid & 3) * 32;
        const size_t so = ((size_t)row * 8 + h) * 2; const float mL = STL[so], lL = STL[so + 1], mU = STU[so], lU = STU[so + 1];
        const float m = fmaxf(mL, mU); const float wL = lL * __builtin_amdgcn_exp2f((mL - m) * C2), wU = lU * __builtin_amdgcn_exp2f((mU - m) * C2); const float inv = __builtin_amdgcn_rcpf(wL + wU);
        const float aL = wL * inv, aU = wU * inv; const size_t o = (size_t)row * DM + h * 128 + c0;
        v4u l4[4], u4[4];
#pragma unroll
        for (int j = 0; j < 4; ++j) { l4[j] = *(const v4u*)(OL + o + 8 * j); u4[j] = *(const v4u*)(OU + o + 8 * j); }
#pragma unroll
        for (int j = 0; j < 4; ++j) { v4u r4;
#pragma unroll
            for (int e = 0; e < 4; ++e) r4[e] = pk2(aL * bflo(l4[j][e]) + aU * bflo(u4[j][e]), aL * bfhi(l4[j][e]) + aU * bfhi(u4[j][e]));
            *(v4u*)(AR + o + 8 * j) = r4; }
    }
}
constexpr size_t WS_SKB = WS_KMEAN + 256 * 1024;
__device__ __forceinline__ void prologue_subkeys(KP P, int vcu, int G) {
    unsigned* dst = (unsigned*)(P.ws + WS_SKB);
    for (int i = vcu * NTHR + ltid(); i < 8 * 2 * 128 * 128 / 2; i += G * NTHR) dst[i] = pk2(P.sub_keys[2 * i], P.sub_keys[2 * i + 1]);
}
__device__ __forceinline__ unsigned f2key(float v) { const unsigned u = __float_as_uint(v); return u ^ ((u >> 31) ? 0xFFFFFFFFu : 0x80000000u); }
__device__ __forceinline__ float key2f(unsigned k) { return __uint_as_float(k ^ ((k >> 31) ? 0x80000000u : 0xFFFFFFFFu)); }
__device__ __forceinline__ unsigned umax3(unsigned a, unsigned b, unsigned c) { return max(max(a, b), c); }
__device__ __forceinline__ void peer_route_tiles(KP P, LAS unsigned char* lds, int tt0, int nitems, int h) {
    const int tid = ltid(), lane = tid & 63, wave = __builtin_amdgcn_readfirstlane(tid >> 6), l15 = lane & 15, q4 = lane >> 4;
    const bf16* PQ = (const bf16*)(P.ws + WS_PROJ); const bf16* SKB = (const bf16*)(P.ws + WS_SKB);
    int* ridx = (int*)(P.ws + WS_PROJ + 64 * MiB); float* rgate = (float*)(P.ws + WS_PROJ + 68 * MiB);
    for (int it_ = 0; it_ < nitems; ++it_) {
        LAS float* sval = (LAS float*)(lds + it_ * 16384); LAS int* sidx = (LAS int*)(lds + it_ * 16384 + 8192);
        const int tt = tt0 + it_, p = wave & 1, sub = wave >> 1, tl = sub * 16 + l15;
        const bf16* qp = PQ + ((size_t)tt * 64 + tl) * DM + h * 256 + p * 128 + 8 * q4;
        bf16x8 qb[4];
#pragma unroll
        for (int kk = 0; kk < 4; ++kk) qb[kk] = *(const bf16x8*)(qp + 32 * kk);
        const bf16* sk = SKB + ((size_t)((h * 2 + p) * 128 + l15)) * 128 + 8 * q4;
        unsigned key[32];
#pragma unroll
        for (int nt = 0; nt < 8; ++nt) { f32x4v acc = {0.f, 0.f, 0.f, 0.f};
#pragma unroll
            for (int kk = 0; kk < 4; ++kk) acc = __builtin_amdgcn_mfma_f32_16x16x32_bf16(*(const bf16x8*)(sk + nt * 16 * 128 + 32 * kk), qb[kk], acc, 0, 0, 0);
#pragma unroll
            for (int e = 0; e < 4; ++e) key[4 * nt + e] = (f2key(acc[e]) & ~127u) | (unsigned)(127 - (16 * nt + 4 * q4 + e)); }
#define CE(a_, b_) { const unsigned hi_ = max(KA[a_], KA[b_]), lo_ = min(KA[a_], KA[b_]); KA[a_] = hi_; KA[b_] = lo_; }
#define SORT16_NET CE(0,1) CE(2,3) CE(0,2) CE(1,3) CE(1,2) CE(4,5) CE(6,7) CE(4,6) CE(5,7) CE(5,6) CE(0,4) CE(2,6) CE(2,4) CE(1,5) CE(3,7) CE(3,5) CE(1,2) CE(3,4) CE(5,6) CE(8,9) CE(10,11) CE(8,10) CE(9,11) CE(9,10) CE(12,13) CE(14,15) CE(12,14) CE(13,15) CE(13,14) CE(8,12) CE(10,14) CE(10,12) CE(9,13) CE(11,15) CE(11,13) CE(9,10) CE(11,12) CE(13,14) CE(0,8) CE(4,12) CE(4,8) CE(2,10) CE(6,14) CE(6,10) CE(2,4) CE(6,8) CE(10,12) CE(1,9) CE(5,13) CE(5,9) CE(3,11) CE(7,15) CE(7,11) CE(3,5) CE(7,9) CE(11,13) CE(1,2) CE(3,4) CE(5,6) CE(7,8) CE(9,10) CE(11,12) CE(13,14)
#define BMERGE16(T_) _Pragma("unroll") for (int d_ = 8; d_ >= 1; d_ >>= 1) { _Pragma("unroll") for (int i_ = 0; i_ < 16; ++i_) if ((i_ & d_) == 0) { const unsigned hi_ = max(T_[i_], T_[i_ + d_]), lo_ = min(T_[i_], T_[i_ + d_]); T_[i_] = hi_; T_[i_ + d_] = lo_; } }
#define KA key
        SORT16_NET
#undef KA
#define KA (key + 16)
        SORT16_NET
#undef KA
        unsigned t16[16];
#pragma unroll
        for (int i = 0; i < 16; ++i) t16[i] = max(key[i], key[31 - i]);
        BMERGE16(t16)
        { const bool odd = (lane & 16) != 0; unsigned L[16];
#pragma unroll
          for (int i = 0; i < 16; ++i) L[i] = odd ? t16[15 - i] : t16[i];
#pragma unroll
          for (int i = 0; i < 16; ++i) { auto x = __builtin_amdgcn_permlane16_swap(L[i], L[i], false, false); t16[i] = max(x[0], x[1]); }
          BMERGE16(t16) }
        { const bool odd = (lane & 32) != 0; unsigned L[16];
#pragma unroll
          for (int i = 0; i < 16; ++i) L[i] = odd ? t16[15 - i] : t16[i];
#pragma unroll
          for (int i = 0; i < 16; ++i) { auto x = __builtin_amdgcn_permlane32_swap(L[i], L[i], false, false); t16[i] = max(x[0], x[1]); }
          BMERGE16(t16) }
#undef CE
#undef SORT16_NET
#undef BMERGE16
        if (q4 == 0) {
#pragma unroll
            for (int r4 = 0; r4 < 4; ++r4) {
                *(LAS f32x4*)(sval + (tl * 2 + p) * 16 + 4 * r4) = (f32x4){key2f(t16[4 * r4] & ~127u), key2f(t16[4 * r4 + 1] & ~127u), key2f(t16[4 * r4 + 2] & ~127u), key2f(t16[4 * r4 + 3] & ~127u)};
                *(LAS v4u*)(sidx + (tl * 2 + p) * 16 + 4 * r4) = (v4u){127u - (t16[4 * r4] & 127u), 127u - (t16[4 * r4 + 1] & 127u), 127u - (t16[4 * r4 + 2] & 127u), 127u - (t16[4 * r4 + 3] & 127u)}; }
        }
    }
    __syncthreads();
    {
        const int it_ = wave; const int tt = tt0 + it_;
        LAS float* sval = (LAS float*)(lds + it_ * 16384); LAS int* sidx = (LAS int*)(lds + it_ * 16384 + 8192);
        if (wave < nitems) {
            const LAS float* av = sval + (lane * 2) * 16; const LAS float* bv = av + 16; const LAS int* ai = sidx + (lane * 2) * 16; const LAS int* bi = ai + 16;
            unsigned hk[16];
            const float b0 = bv[0];
#pragma unroll
            for (int i4 = 0; i4 < 4; ++i4) { const f32x4 t4 = *(const LAS f32x4*)(av + 4 * i4);
#pragma unroll
                for (int e = 0; e < 4; ++e) hk[4 * i4 + e] = (f2key(t4[e] + b0) & ~255u) | (unsigned)(255 - (4 * i4 + e) * 16); }
            float bestv[16]; int beste[16];
#pragma unroll
            for (int r = 0; r < 16; ++r) {
                unsigned m0 = umax3(hk[0], hk[1], hk[2]), m1 = umax3(hk[3], hk[4], hk[5]), m2 = umax3(hk[6], hk[7], hk[8]), m3 = umax3(hk[9], hk[10], hk[11]);
                m0 = umax3(m0, hk[12], hk[13]); m1 = umax3(m1, hk[14], hk[15]);
                const unsigned best = max(max(m0, m1), max(m2, m3));
                const int f = 255 - (int)(best & 255u), bi_ = f >> 4, bj = f & 15;
                const float a_i = av[bi_]; bestv[r] = a_i + bv[bj]; beste[r] = ai[bi_] * 128 + bi[bj];
                const int nj = bj + 1;
                const unsigned nk = nj < 16 ? ((f2key(a_i + bv[nj & 15]) & ~255u) | (unsigned)(255 - (bi_ * 16 + nj))) : 0u;
#pragma unroll
                for (int i = 0; i < 16; ++i) hk[i] = i == bi_ ? nk : hk[i];
            }
            float se = 0.f; const float mx = bestv[0];
#pragma unroll
            for (int r = 0; r < 16; ++r) { bestv[r] = __expf(bestv[r] - mx); se += bestv[r]; }
            const float ise = 1.f / se; const size_t o = ((size_t)tt * 64 + lane) * 128 + h * 16;
#pragma unroll
            for (int r4 = 0; r4 < 4; ++r4) { *(v4u*)(ridx + o + 4 * r4) = (v4u){(unsigned)beste[4 * r4], (unsigned)beste[4 * r4 + 1], (unsigned)beste[4 * r4 + 2], (unsigned)beste[4 * r4 + 3]};
                *(f32x4*)(rgate + o + 4 * r4) = (f32x4){bestv[4 * r4] * ise, bestv[4 * r4 + 1] * ise, bestv[4 * r4 + 2] * ise, bestv[4 * r4 + 3] * ise}; }
        }
        __syncthreads();
    }
}
#define XB_TMO      128
#define XB_XCNT(j)  (256  + 64 * (j))
#define XB_XSUB(j)  (1280 + 64 * (j))
#define XB_XGEN(j)  (2304 + 64 * (j))
#define XB_TOP      3328
#define XB_TOPGEN   3392
#define XCD_BAR_WORDS 3456
#define XB_SPIN_CAP (1u << 18)

__device__ __forceinline__ unsigned xb_ld(unsigned* p)              { return __hip_atomic_load(p, __ATOMIC_RELAXED, __HIP_MEMORY_SCOPE_AGENT); }
__device__ __forceinline__ unsigned xb_add(unsigned* p, unsigned v) { return __hip_atomic_fetch_add(p, v, __ATOMIC_RELAXED, __HIP_MEMORY_SCOPE_AGENT); }
__device__ __forceinline__ unsigned xb_xcc_id() { return (unsigned)__builtin_amdgcn_s_getreg((3 << 11) | 20) & 0xFu; }
#define XB_SPIN(cond, bar) do { unsigned _sp = 0; while (cond) { __builtin_amdgcn_s_sleep(1); \
    if ((++_sp & 255u) == 0u) { if (xb_ld(&(bar)[XB_TMO])) break; if (_sp > XB_SPIN_CAP) { atomicAdd(&(bar)[XB_TMO], 1u); break; } } } } while (0)

struct XcdBarrier {
    unsigned* bar; unsigned x;
    volatile LAS unsigned* st;
};

__device__ __forceinline__ XcdBarrier xcd_barrier_post(unsigned* bar, volatile LAS unsigned* st) {
    XcdBarrier b; b.bar = bar; b.x = xb_xcc_id(); b.st = st;
    if (threadIdx.x == 0) (void)xb_add(&bar[XB_XCNT(b.x)], 1u);
    return b;
}
__device__ __forceinline__ void xcd_barrier_complete(unsigned* bar, unsigned x, unsigned& nloc, unsigned& nx) {
    const unsigned G = gridDim.x * gridDim.y * gridDim.z;
    unsigned sum, cnt, mine, sp = 0u;
    for (;;) {
        sum = 0u; cnt = 0u; mine = 0u;
#pragma unroll
        for (unsigned j = 0; j < 16; ++j) { const unsigned c = xb_ld(&bar[XB_XCNT(j)]); sum += c; cnt += (c > 0u) ? 1u : 0u; mine = (j == x) ? c : mine; }
        if (sum == G) break;
        __builtin_amdgcn_s_sleep(1);
        if ((++sp & 255u) == 0u) { if (xb_ld(&bar[XB_TMO])) break; if (sp > XB_SPIN_CAP) { atomicAdd(&bar[XB_TMO], 1u); break; } }
    }
    nloc = mine > 0u ? mine : 1u; nx = cnt > 0u ? cnt : 1u;
}

__device__ __forceinline__ void xcd_barrier(const XcdBarrier& b) {
    asm volatile("s_waitcnt vmcnt(0)" ::: "memory");
    __syncthreads();
    if (threadIdx.x == 0) {
        unsigned* bar = b.bar;
        __builtin_amdgcn_s_waitcnt(0);
        unsigned nloc = b.st[0], nx = b.st[1];
        if (nloc == 0u) { xcd_barrier_complete(bar, b.x, nloc, nx); b.st[0] = nloc; b.st[1] = nx; }
        const unsigned old = xb_add(&bar[XB_XSUB(b.x)], 1u);
        const unsigned gen = old / nloc;
        if (old + 1u == (gen + 1u) * nloc) {
            __builtin_amdgcn_fence(__ATOMIC_RELEASE, "agent");
            asm volatile("s_waitcnt vmcnt(0)" ::: "memory");
            const unsigned og = xb_add(&bar[XB_TOP], 1u);
            const unsigned tg = og / nx;
            if (og + 1u == (tg + 1u) * nx) xb_add(&bar[XB_TOPGEN], 1u);
            else XB_SPIN(xb_ld(&bar[XB_TOPGEN]) == tg, bar);
            __builtin_amdgcn_fence(__ATOMIC_ACQUIRE, "agent");
            xb_add(&bar[XB_XGEN(b.x)], 1u);
            asm volatile("s_waitcnt vmcnt(0)" ::: "memory");
        } else {
            XB_SPIN(xb_ld(&bar[XB_XGEN(b.x)]) == gen, bar);
            __builtin_amdgcn_fence(__ATOMIC_ACQUIRE, "agent");
            asm volatile("s_waitcnt vmcnt(0)" ::: "memory");
        }
    }
    __syncthreads();
}
#ifndef MK_ONE_LAUNCH
#define MK_ONE_LAUNCH 1
#endif
constexpr int N_PHASES = 11;
__global__ void __launch_bounds__(NTHR, 2) mega(Params Pkernarg) {
    extern __shared__ __attribute__((aligned(16))) unsigned char lds_raw[];
    LAS unsigned char* lds = (LAS unsigned char*)lds_raw;
    const int tid = ltid();
    const int G = gridDim.x, bx = blockIdx.x; const int vcu = (G % 8 == 0) ? (bx % 8) * (G / 8) + bx / 8 : bx;
    for (int u = tid; u < (LDS_BYTES - LDSCTL_OFF) / 4; u += NTHR) ((LAS unsigned*)(lds + LDSCTL_OFF))[u] = 0u;
    __syncthreads();
#if MK_ONE_LAUNCH
    XcdBarrier bar = xcd_barrier_post((unsigned*)(params_ptr()->ws + WS_CTL) + CW_BAR + params_ptr()->bar_li * XCD_BAR_WORDS, (volatile LAS unsigned*)(lds + MISC_OFF) + 8);
#define GRID_BAR() xcd_barrier(bar)
#else
#define GRID_BAR() do {} while (0)
#endif
#ifndef PHOFF
#define PHOFF 0
#endif
#define IN(k) (!((PHOFF >> (k)) & 1))
#define BOTH(k) (IN(k) && IN((k) + 1))
    if (IN(0)) { KP P = *params_ptr(); phase_prologue(P, lds, vcu, G); prologue_subkeys(P, vcu, G); prologue_lora(P, vcu, G); if (BOTH(0)) GRID_BAR(); }
    if (IN(1)) { KP P = *params_ptr();
        pg8::Gemm g{(const bf16*)(P.ws + WS_XN), (const bf16*)(P.ws + WS_WIN), TT, INCP, DM}; pg8::Order1 S; S.init(TT, INCP, G, bx);
        pg8::EpiBf16<0> E{(bf16*)(P.ws + WS_PROJ), INCP, nullptr, 0, 0, 1.f};
        pg8::gemm_phase<pg8::EpiBf16<0>, pg8::Order1, true, true>(lds, g, S, E);
        phase_convert_tables(P, lds); phase_transpose_late(P, lds);
        if (BOTH(1)) GRID_BAR();
    }
    if (IN(2)) { KP P = *params_ptr(); phase_act(P, vcu, G); phase_kmean(P, lds, vcu, G); if (BOTH(2)) GRID_BAR(); }
    if (IN(3)) { KP P = *params_ptr(); phase_rwkv_stage_a(P, lds, vcu, G); if (BOTH(3)) GRID_BAR(); }
    if (IN(4)) { KP P = *params_ptr(); if ((vcu & 15) < 2 && vcu < 256) rwkv_stage_b(P, lds, (vcu >> 4) * 2 + (vcu & 15)); phase_moba(P, (char*)lds_raw, vcu, G); }
    if (IN(5)) { GRID_BAR(); KP P = *params_ptr(); moba_combine(P, vcu, G); GRID_BAR(); }
    if (IN(6)) { KP P = *params_ptr();
        pg8::Gemm g{(const bf16*)(P.ws + WS_AR), (const bf16*)(P.ws + WS_WOUT), TT, DM, DM}; pg8::StaticOrder S; S.init(TT, DM, G, bx);
        pg8::EpiH E{P.x, (bf16*)(P.ws + WS_XN), (float*)(P.ws + WS_SSP), DM};
        pg8::gemm_phase<pg8::EpiH, pg8::StaticOrder, true, true>(lds, g, S, E);
        if (BOTH(6)) GRID_BAR();
    }
    if (IN(8)) { KP P = *params_ptr(); phase_rstd(P, vcu, G); GRID_BAR();
        pg8::Gemm g{(const bf16*)(P.ws + WS_XN), (const bf16*)(P.ws + WS_WQ), TT, DM, DM}; pg8::StaticOrder S; S.init(TT, DM, G, bx);
        pg8::EpiBf16Row E{(bf16*)(P.ws + WS_PROJ), DM, (const float*)(P.ws + WS_SSP + 2 * MiB)};
        pg8::gemm_phase<pg8::EpiBf16Row, pg8::StaticOrder, true, true>(lds, g, S, E);
        if (G == 256) { const int wg_ = (bx & 7) * 32 + (bx >> 3); pg8::Unit u; u.pm = (wg_ >> 6) * 8 + (wg_ & 7); u.pn = (wg_ & 63) >> 3;
            asm volatile("s_waitcnt vmcnt(0)" ::: "memory"); __syncthreads(); __builtin_amdgcn_fence(__ATOMIC_ACQUIRE, "agent"); asm volatile("s_waitcnt vmcnt(0)" ::: "memory");
            peer_route_tiles(P, lds, 4 * u.pm, 4, u.pn);
        } else if (G != 256) { GRID_BAR(); for (int item = vcu; item < 1024; item += G) peer_route_tiles(P, lds, item >> 3, 1, item & 7); }
        if (BOTH(8)) GRID_BAR();
    }
    if (IN(10)) { KP P = *params_ptr(); phase_peer_sliced(P, lds, bx, G); }
#undef IN
#undef BOTH
}

extern "C" void kernel_launch(void* const* d_in, const int* in_sizes, int n_in, void* d_out, int out_size, void* d_ws, size_t ws_size, hipStream_t stream) {
    static int grid = 0;
    if (grid == 0) {
        if (n_in != 21 || in_sizes[0] != TT * DM || out_size != TT * DM || ws_size < WS_END) {
            fprintf(stderr, "kernel_launch: unexpected shapes: n_in %d in0 %d out %d ws %zu\n", n_in, n_in > 0 ? in_sizes[0] : -1, out_size, ws_size); grid = -1; return; }
        int dev = 0, cus = 0;
        if (hipGetDevice(&dev) != hipSuccess || hipDeviceGetAttribute(&cus, hipDeviceAttributeMultiprocessorCount, dev) != hipSuccess) { grid = -1; return; }
        if (hipFuncSetAttribute((const void*)mega, hipFuncAttributeMaxDynamicSharedMemorySize, LDS_BYTES) != hipSuccess) { fprintf(stderr, "kernel_launch: hipFuncSetAttribute failed\n"); grid = -1; return; }
        int per_cu = 0;
        if (hipOccupancyMaxActiveBlocksPerMultiprocessor(&per_cu, (const void*)mega, NTHR, LDS_BYTES) != hipSuccess || per_cu < 1) fprintf(stderr, "kernel_launch: occupancy query says %d blocks per CU\n", per_cu);
        (void)hipGetLastError();
        grid = cus;
    }
    if (grid < 0) return;
    (void)hipMemsetAsync((char*)d_ws + WS_CTL, 0, CTL_ZERO_BYTES, stream);
    Params p{};
    p.x = (const float*)d_in[0]; p.norm1_g = (const float*)d_in[1]; p.w_in = (const float*)d_in[2]; p.mu = (const float*)d_in[3]; p.w0 = (const float*)d_in[4];
    p.w2 = (const float*)d_in[5]; p.a0 = (const float*)d_in[6]; p.a2 = (const float*)d_in[7]; p.g2 = (const float*)d_in[8]; p.k_k = (const float*)d_in[9];
    p.k_a = (const float*)d_in[10]; p.r_k = (const float*)d_in[11]; p.ln_g = (const float*)d_in[12]; p.ln_b = (const float*)d_in[13]; p.w_out = (const float*)d_in[14];
    p.norm2_g = (const float*)d_in[15]; p.wq = (const float*)d_in[16]; p.sub_keys = (const float*)d_in[17]; p.pu = (const float*)d_in[18]; p.pv = (const float*)d_in[19];
    p.final_g = (const float*)d_in[20]; p.out = (float*)d_out; p.ws = (unsigned char*)d_ws;
    p.ph_lo = 0; p.ph_hi = N_PHASES; p.bar_li = 0;
    hipLaunchKernelGGL(mega, dim3(grid), dim3(NTHR), LDS_BYTES, stream, p);
}
```

```cpp
#include <hip/hip_runtime.h>
#include <cstdio>
#include <cstdint>
__device__ __forceinline__ int ltid() { int t = threadIdx.x; asm volatile("" : "+v"(t)); return t; }
namespace pg8 {
#define PG8_LAS __attribute__((address_space(3)))
typedef unsigned short bf16_t;
typedef short bf16x8 __attribute__((ext_vector_type(8)));
typedef float f32x4 __attribute__((ext_vector_type(4)));
typedef unsigned u32x4 __attribute__((ext_vector_type(4)));
constexpr int BM = 256, BK = 64, HALF = 128, HTB = HALF * BK * 2  , STAGE_BYTES = 8 * HTB, NXCD = 8, WGM = 8;

__host__ __device__ __forceinline__ int lds_byte(int r, int c) { const int st = (r >> 4) * 2 + (c >> 5), rr = r & 15, cc = c & 31, ob = rr * 64 + cc * 2; return st * 1024 + (ob ^ (((ob >> 9) & 1) << 5)); }
__host__ __device__ __forceinline__ void stage_rc(int b, int& R, int& C) { const int st = b / 1024, sb = b % 1024, swz = sb ^ (((sb >> 9) & 1) << 5); R = (st >> 1) * 16 + swz / 64; C = (st & 1) * 32 + (swz % 64) / 2; }
__host__ __device__ __forceinline__ int perm32(int rho) { const int n = rho >> 4, i = rho & 15; return 8 * (i >> 2) + 4 * n + (i & 3); }

struct Unit { int pm, pn; };
struct Gemm { const bf16_t* A; const bf16_t* Bt; int M, N, K; };

struct StaticOrder {
    int nM, nN, nwg, G, c;
    __host__ __device__ void init(int M, int N, int G_, int c_) { nM = M / BM; nN = N / BM; nwg = nM * nN; G = G_; c = c_; }
    __host__ __device__ bool next(int i, Unit& u) const {
        const long L = (long)i * G + c; if (L >= nwg) return false;
        int wgid = (int)L; { const int q = nwg / NXCD, r = nwg % NXCD, xcd = wgid % NXCD, off = wgid / NXCD; wgid = (xcd < r ? xcd * (q + 1) : r * (q + 1) + (xcd - r) * q) + off; }
        const int nig = WGM * nN, gid = wgid / nig, fm = gid * WGM, gsz = (nM - fm) < WGM ? (nM - fm) : WGM;
        u.pm = fm + ((wgid % nig) % gsz); u.pn = (wgid % nig) / gsz; return true;
    }
    __device__ __forceinline__ void a_ready(const Unit&) const {}
    __device__ __forceinline__ void done(const Unit&) const {}
};

__device__ __forceinline__ unsigned cvt_pk_bf16(float lo, float hi) { unsigned r; asm volatile("v_cvt_pk_bf16_f32 %0, %1, %2" : "=v"(r) : "v"(lo), "v"(hi)); return r; }
typedef float f32x2 __attribute__((ext_vector_type(2)));
__device__ __forceinline__ f32x2 gelu_pk(f32x2 v) {
    const f32x2 av = __builtin_elementwise_abs(v), d = av * 0.2316418882f + 1.0f;
    f32x2 t; t.x = __builtin_amdgcn_rcpf(d.x); t.y = __builtin_amdgcn_rcpf(d.y);
    f32x2 q = t * 0.5307027145f + (-0.7265760135f); q = q * t + 0.7107068705f; q = q * t + (-0.142248368f); q = q * t + 0.127414796f; q = q * t;
    const f32x2 s = (v * v) * (-0.72134752044f);
    f32x2 e; e.x = __builtin_amdgcn_exp2f(s.x); e.y = __builtin_amdgcn_exp2f(s.y);
    const f32x2 m = v * (q * e), r = v - m;
    f32x2 o; o.x = v.x < 0.f ? m.x : r.x; o.y = v.y < 0.f ? m.y : r.y; return o;
}

template <int ACT  > struct EpiBf16 {
    static constexpr bool PERM = true, AFTER_DRAIN = false; static_assert(ACT == 0 || ACT == 1, "EpiBf16: ACT is 0 (none) or 1 (gelu_pk)");
    bf16_t* O; int ldc; const float* bias; int split_cols; size_t split_stride; float scale0;
    __device__ __forceinline__ void operator()(const f32x4 (&acc)[2][2][4][2], const Unit& u, int wr, int wc, int fr, int fq) const {
        const int row0 = u.pm * BM + wr * 64 + fr; int colt = u.pn * BM; bf16_t* base = O;
        float sc = 1.f; if (split_cols) { const int t = colt / split_cols; base += (size_t)t * split_stride; colt -= t * split_cols; if (t == 0) sc = scale0; }
        const int col0 = colt + wc * 32 + 8 * fq, bcol0 = u.pn * BM + wc * 32 + 8 * fq;
        f32x4 bv[2][2];
#pragma unroll
        for (int bj = 0; bj < 2; ++bj)
#pragma unroll
            for (int n = 0; n < 2; ++n) bv[bj][n] = bias ? *(const f32x4*)(bias + bcol0 + bj * HALF + 4 * n) : (f32x4){0.f, 0.f, 0.f, 0.f};
#pragma unroll
        for (int ai = 0; ai < 2; ++ai)
#pragma unroll
            for (int m = 0; m < 4; ++m) { bf16_t* rowp = base + (size_t)(row0 + ai * HALF + m * 16) * ldc + col0;
#pragma unroll
                for (int bj = 0; bj < 2; ++bj) { f32x4 v0 = acc[ai][bj][m][0] + bv[bj][0], v1 = acc[ai][bj][m][1] + bv[bj][1];
                    if (ACT == 1) { f32x2 a = gelu_pk((f32x2){v0[0], v0[1]}), b = gelu_pk((f32x2){v0[2], v0[3]}), c = gelu_pk((f32x2){v1[0], v1[1]}), d = gelu_pk((f32x2){v1[2], v1[3]});
                        v0 = (f32x4){a.x, a.y, b.x, b.y}; v1 = (f32x4){c.x, c.y, d.x, d.y}; }
                    v0 = v0 * sc; v1 = v1 * sc; u32x4 w; w.x = cvt_pk_bf16(v0[0], v0[1]); w.y = cvt_pk_bf16(v0[2], v0[3]); w.z = cvt_pk_bf16(v1[0], v1[1]); w.w = cvt_pk_bf16(v1[2], v1[3]);
                    *(u32x4*)(rowp + bj * HALF) = w; } }
    }
};
template <class Epi, class Sched, bool ALIGN_EPI = false, bool SP2 = false>
__device__ __forceinline__ void gemm_phase(PG8_LAS unsigned char* lds, const Gemm g, const Sched& S, const Epi& E) {
    const int tid = ltid(), wid = __builtin_amdgcn_readfirstlane(tid >> 6), lane = tid & 63, wr = wid >> 2, wc = wid & 3, fr = lane & 15, fq = lane >> 4;
    const int K = g.K, nt = K / BK;
    unsigned voffA[2], voffB[2];
#pragma unroll
    for (int i = 0; i < 2; ++i) { int R, C; stage_rc(tid * 16 + i * 8192, R, C); const int Rb = Epi::PERM ? ((R & ~31) + perm32(R & 31)) : R;
        voffA[i] = (unsigned)(R * K + C) * 2u; voffB[i] = (unsigned)(Rb * K + C) * 2u; }
    const size_t kstep = (size_t)(BK * 2);
    const size_t hstep = (size_t)HALF * K * 2;
    const size_t tstep = 2 * hstep;
    const unsigned ldsw = (unsigned)wid * 1024u;
    const int aoff = lds_byte(wr * 64 + fr, fq * 8), boff = lds_byte(wc * 32 + fr, fq * 8);
#define PG8_SA(b, h) (((b) * 2 + (h)) * HTB)
#define PG8_SB(b, h) ((4 + (b) * 2 + (h)) * HTB)
#define PG8_STAGE(bufoff, gbase, voff) do { _Pragma("unroll") for (int _i = 0; _i < 2; ++_i) \
        __builtin_amdgcn_global_load_lds((const unsigned*)((const char*)(gbase) + (voff)[_i]), (PG8_LAS unsigned*)(lds + (bufoff) + ldsw + _i * 8192), 16, 0, 0); } while (0)
#define PG8_LDA(dst, b, h) do { _Pragma("unroll") for (int m = 0; m < 4; ++m) _Pragma("unroll") for (int k = 0; k < 2; ++k) dst[m][k] = *(const PG8_LAS bf16x8*)(lds + PG8_SA(b, h) + aoff + m * 2048 + k * 1024); } while (0)
#define PG8_LDB(dst, b, h) do { _Pragma("unroll") for (int n = 0; n < 2; ++n) _Pragma("unroll") for (int k = 0; k < 2; ++k) dst[n][k] = *(const PG8_LAS bf16x8*)(lds + PG8_SB(b, h) + boff + n * 2048 + k * 1024); } while (0)
#define PG8_MMA(ai, bj, At, Bt) do { __builtin_amdgcn_s_setprio(1); _Pragma("unroll") for (int m = 0; m < 4; ++m) _Pragma("unroll") for (int n = 0; n < 2; ++n) _Pragma("unroll") for (int k = 0; k < 2; ++k) \
        acc[ai][bj][m][n] = __builtin_amdgcn_mfma_f32_16x16x32_bf16(Bt[n][k], At[m][k], acc[ai][bj][m][n], 0, 0, 0); __builtin_amdgcn_s_setprio(0); } while (0)
#define PG8_WAIT_V(n) asm volatile("s_waitcnt vmcnt(" #n ")" ::: "memory")
#define PG8_WAIT_L(n) asm volatile("s_waitcnt lgkmcnt(" #n ")" ::: "memory")
#define PG8_BAR __builtin_amdgcn_s_barrier()
#define PG8_SCHED __builtin_amdgcn_sched_barrier(0)
    Unit cur, nxt; int ui = 0;
    if (!S.next(0, cur)) return;
    f32x4 acc[2][2][4][2];
#pragma unroll
    for (int a = 0; a < 2; ++a)
#pragma unroll
        for (int b = 0; b < 2; ++b)
#pragma unroll
            for (int m = 0; m < 4; ++m)
#pragma unroll
                for (int n = 0; n < 2; ++n) acc[a][b][m][n] = (f32x4){0.f, 0.f, 0.f, 0.f};
    bf16x8 At[4][2], B0[2][2], B1[2][2];
    const char* cA = (const char*)g.A + (size_t)cur.pm * tstep; const char* cB = (const char*)g.Bt + (size_t)cur.pn * tstep;
    S.a_ready(cur);
    if constexpr (SP2) {
        PG8_STAGE(PG8_SB(0, 0), cB, voffB); PG8_STAGE(PG8_SB(0, 1), cB + hstep, voffB); PG8_STAGE(PG8_SA(0, 0), cA, voffA); PG8_STAGE(PG8_SA(0, 1), cA + hstep, voffA);
        if (wr == 1) PG8_BAR;
        PG8_WAIT_V(2); PG8_BAR;
        PG8_STAGE(PG8_SB(1, 0), cB + kstep, voffB); PG8_STAGE(PG8_SA(1, 0), cA + kstep, voffA); PG8_STAGE(PG8_SB(1, 1), cB + hstep + kstep, voffB);
        PG8_WAIT_V(6); PG8_BAR;
    } else {
        PG8_STAGE(PG8_SB(0, 0), cB, voffB); PG8_STAGE(PG8_SA(0, 0), cA, voffA); PG8_STAGE(PG8_SB(0, 1), cB + hstep, voffB); PG8_STAGE(PG8_SA(0, 1), cA + hstep, voffA);
        if (wr == 1) PG8_BAR;
        PG8_WAIT_V(4); PG8_BAR;
        PG8_STAGE(PG8_SB(1, 0), cB + kstep, voffB); PG8_STAGE(PG8_SA(1, 0), cA + kstep, voffA); PG8_STAGE(PG8_SB(1, 1), cB + hstep + kstep, voffB);
        PG8_WAIT_V(6); PG8_BAR;
    }
    for (;;) {
        const bool has_next = S.next(ui + 1, nxt);
        const char* nA = has_next ? (const char*)g.A + (size_t)nxt.pm * tstep : cA; const char* nB = has_next ? (const char*)g.Bt + (size_t)nxt.pn * tstep : cB;
        for (int t = 0; t < nt; t += 2) {
            const bool last = (t == nt - 2);
            const char* a1 = cA + (size_t)(t + 1) * kstep;
            const char* a2 = last ? nA : cA + (size_t)(t + 2) * kstep; const char* b2 = last ? nB : cB + (size_t)(t + 2) * kstep;
            const char* a3 = a2 + kstep; const char* b3 = b2 + kstep;
            if (last && has_next) S.a_ready(nxt);
            if constexpr (SP2) {
            PG8_LDB(B0, 0, 0); PG8_LDB(B1, 0, 1); PG8_SCHED; PG8_LDA(At, 0, 0); PG8_STAGE(PG8_SA(1, 1), a1 + hstep, voffA);
            PG8_WAIT_V(8); PG8_WAIT_L(0); PG8_BAR; PG8_MMA(0, 0, At, B0); PG8_MMA(0, 1, At, B1); PG8_BAR; PG8_SCHED;
            PG8_LDA(At, 0, 1); PG8_STAGE(PG8_SB(0, 0), b2, voffB); PG8_STAGE(PG8_SB(0, 1), b2 + hstep, voffB); PG8_STAGE(PG8_SA(0, 0), a2, voffA);
            PG8_WAIT_V(8); PG8_WAIT_L(0); PG8_BAR; PG8_MMA(1, 0, At, B0); PG8_MMA(1, 1, At, B1); PG8_BAR; PG8_SCHED;
            PG8_LDB(B0, 1, 0); PG8_LDB(B1, 1, 1); PG8_SCHED; PG8_LDA(At, 1, 0); PG8_STAGE(PG8_SA(0, 1), a2 + hstep, voffA);
            PG8_WAIT_V(8); PG8_WAIT_L(0); PG8_BAR; PG8_MMA(0, 0, At, B0); PG8_MMA(0, 1, At, B1); PG8_BAR; PG8_SCHED;
            PG8_LDA(At, 1, 1); PG8_STAGE(PG8_SB(1, 0), b3, voffB); PG8_STAGE(PG8_SB(1, 1), b3 + hstep, voffB); PG8_STAGE(PG8_SA(1, 0), a3, voffA);
            PG8_WAIT_V(8); PG8_WAIT_L(0); PG8_BAR; PG8_MMA(1, 0, At, B0); PG8_MMA(1, 1, At, B1); PG8_BAR; PG8_SCHED;
            } else {
            PG8_LDB(B0, 0, 0); PG8_SCHED; PG8_LDA(At, 0, 0); PG8_STAGE(PG8_SA(1, 1), a1 + hstep, voffA);
            PG8_WAIT_L(8); PG8_BAR; PG8_WAIT_L(0); PG8_MMA(0, 0, At, B0); PG8_BAR; PG8_SCHED;
            PG8_LDB(B1, 0, 1); PG8_STAGE(PG8_SB(0, 0), b2, voffB);
            PG8_BAR; PG8_WAIT_L(0); PG8_MMA(0, 1, At, B1); PG8_BAR;
            PG8_LDA(At, 0, 1); PG8_STAGE(PG8_SA(0, 0), a2, voffA);
            PG8_BAR; PG8_WAIT_L(0); PG8_MMA(1, 0, At, B0); PG8_BAR; PG8_SCHED;
            PG8_STAGE(PG8_SB(0, 1), b2 + hstep, voffB);
            PG8_WAIT_V(6); PG8_BAR; PG8_MMA(1, 1, At, B1); PG8_BAR;
            PG8_LDB(B0, 1, 0); PG8_SCHED; PG8_LDA(At, 1, 0); PG8_STAGE(PG8_SA(0, 1), a2 + hstep, voffA);
            PG8_WAIT_L(8); PG8_BAR; PG8_WAIT_L(0); PG8_MMA(0, 0, At, B0); PG8_BAR; PG8_SCHED;
            PG8_LDB(B1, 1, 1); PG8_STAGE(PG8_SB(1, 0), b3, voffB);
            PG8_BAR; PG8_WAIT_L(0); PG8_MMA(0, 1, At, B1); PG8_BAR;
            PG8_LDA(At, 1, 1); PG8_STAGE(PG8_SA(1, 0), a3, voffA);
            PG8_BAR; PG8_WAIT_L(0); PG8_MMA(1, 0, At, B0); PG8_BAR; PG8_SCHED;
            PG8_STAGE(PG8_SB(1, 1), b3 + hstep, voffB);
            PG8_WAIT_V(6); PG8_BAR; PG8_MMA(1, 1, At, B1); PG8_BAR;
            }
        }
        if constexpr (ALIGN_EPI) { if (wr == 0) PG8_BAR; }
        if constexpr (!Epi::AFTER_DRAIN) { E(acc, cur, wr, wc, fr, fq); S.done(cur); }
        if (!has_next) break;
#pragma unroll
        for (int a = 0; a < 2; ++a)
#pragma unroll
            for (int b = 0; b < 2; ++b)
#pragma unroll
                for (int m = 0; m < 4; ++m)
#pragma unroll
                    for (int n = 0; n < 2; ++n) acc[a][b][m][n] = (f32x4){0.f, 0.f, 0.f, 0.f};
        cur = nxt; cA = nA; cB = nB; ++ui;
        if constexpr (ALIGN_EPI) { if (wr == 1) PG8_BAR; }
    }
    PG8_WAIT_V(0);
    if constexpr (!ALIGN_EPI) { if (wr == 0) PG8_BAR; }
    PG8_BAR;
    if constexpr (Epi::AFTER_DRAIN) { E.fused(acc, cur, wr, wc, fr, fq, lds, wid, lane); S.done(cur); }
#undef PG8_SA
#undef PG8_SB
#undef PG8_STAGE
#undef PG8_LDA
#undef PG8_LDB
#undef PG8_MMA
#undef PG8_WAIT_V
#undef PG8_WAIT_L
#undef PG8_BAR
#undef PG8_SCHED
}
}
#define GAS __attribute__((address_space(1)))
#define LAS __attribute__((address_space(3)))
typedef unsigned short bf16;
typedef unsigned v4u __attribute__((ext_vector_type(4)));
typedef unsigned v2u __attribute__((ext_vector_type(2)));
typedef float f32x4 __attribute__((ext_vector_type(4)));
constexpr int NWAVES = 8, NTHR = 512;
constexpr int TT = 8192, DM = 2048, SEQ = 4096;
constexpr int INC = 6592, INCP = 6656;
constexpr int C_AK = 1024, C_AV = 2048, C_RW = 3072;
constexpr int RWC = 3520;
constexpr float RMS_EPS = 1e-6f;
constexpr size_t MiB = 1u << 20;
constexpr size_t WS_CTL = 0, CTL_ZERO_BYTES = 1 * MiB;
constexpr size_t WS_WIN = 1 * MiB;
constexpr size_t WS_WOUT = 27 * MiB;
constexpr size_t WS_WQ = 35 * MiB;
constexpr size_t WS_XN = 43 * MiB;
constexpr size_t WS_PROJ = 75 * MiB;
constexpr size_t WS_AR = 179 * MiB;
constexpr size_t WS_H = 211 * MiB;
constexpr size_t WS_RWA = 275 * MiB;
constexpr size_t WS_CHK = 339 * MiB;
constexpr size_t WS_KMEAN = 467 * MiB;
constexpr size_t WS_ACT = WS_H;
constexpr size_t WS_SSP = WS_WIN + 4 * MiB;
constexpr size_t WS_LORA = 468 * MiB;
constexpr size_t WS_END = 469 * MiB;
constexpr int CW_BAR = 4096, CW_MOBA_CTR = 16384, CW_SS = 32768;
constexpr int RING_BYTES = 147456, LDSCTL_OFF = RING_BYTES, MISC_OFF = LDSCTL_OFF + 320, LDS_BYTES = 163840;

struct Params {
    const float* x; const float* norm1_g; const float* w_in; const float* mu; const float* w0; const float* w2; const float* a0; const float* a2; const float* g2;
    const float* k_k; const float* k_a; const float* r_k; const float* ln_g; const float* ln_b; const float* w_out; const float* norm2_g; const float* wq;
    const float* sub_keys; const float* pu; const float* pv; const float* final_g;
    float* out; unsigned char* ws;
    int ph_lo, ph_hi, bar_li, pad;
};

typedef const __attribute__((address_space(4))) Params& KP;
__device__ __forceinline__ const __attribute__((address_space(4))) Params* params_ptr() {
    const __attribute__((address_space(4))) Params* ka = (const __attribute__((address_space(4))) Params*)__builtin_amdgcn_kernarg_segment_ptr(); asm volatile("" : "+s"(ka)); return ka; }
typedef float f32x2_t __attribute__((ext_vector_type(2))); typedef __bf16 bf16x2_t __attribute__((ext_vector_type(2)));
__device__ __forceinline__ unsigned pk2(float lo, float hi) { const f32x2_t v = {lo, hi}; const bf16x2_t b = __builtin_convertvector(v, bf16x2_t); return __builtin_bit_cast(unsigned, b); }
__device__ __forceinline__ unsigned f2bf(float f) { return pk2(f, 0.f) & 0xffffu; }
__device__ __forceinline__ float bf2f(bf16 v) { return __builtin_bit_cast(float, (unsigned)v << 16); }
__device__ __forceinline__ float bflo(unsigned u) { return __builtin_bit_cast(float, u << 16); }
__device__ __forceinline__ float bfhi(unsigned u) { return __builtin_bit_cast(float, u & 0xffff0000u); }
#define DPP_F(v, ctrl) __builtin_bit_cast(float, __builtin_amdgcn_update_dpp(0, __builtin_bit_cast(int, (v)), (ctrl), 0xf, 0xf, true))
__device__ __forceinline__ float wave_sum(float v) {
    v += DPP_F(v, 0xB1);
    v += DPP_F(v, 0x4E);
    v += DPP_F(v, 0x141);
    v += DPP_F(v, 0x140);
    const int b = __builtin_bit_cast(int, v);
    return (__builtin_bit_cast(float, __builtin_amdgcn_readlane(b, 0)) + __builtin_bit_cast(float, __builtin_amdgcn_readlane(b, 16))) +
           (__builtin_bit_cast(float, __builtin_amdgcn_readlane(b, 32)) + __builtin_bit_cast(float, __builtin_amdgcn_readlane(b, 48)));
}
__device__ __forceinline__ float wave_max(float v) {
#pragma unroll
    for (int o = 1; o < 64; o <<= 1) v = fmaxf(v, __shfl_xor(v, o));
    return v;
}
#define LDS_WAIT() asm volatile("s_waitcnt lgkmcnt(0)" ::: "memory")

__device__ __forceinline__ void p0_transpose_item(const float* W, int K, int N, bf16* WT, LAS float* scr, int item, int lane, const float* ksc = nullptr) {
    const int nblk = N / 32, kb = item / nblk, nb = item % nblk, k0 = 64 * kb, n0 = 32 * nb;
    float wv[32];
#pragma unroll
    for (int i = 0; i < 32; ++i) wv[i] = W[(size_t)(k0 + 2 * i + (lane >> 5)) * N + n0 + (lane & 31)];
#pragma unroll
    for (int i = 0; i < 32; ++i) { const int kk = 2 * i + (lane >> 5); scr[kk * 33 + (lane & 31)] = ksc ? wv[i] * ksc[k0 + kk] : wv[i]; }
    LDS_WAIT(); asm volatile("" ::: "memory");
    const int c = lane & 7;
#pragma unroll
    for (int j = 0; j < 4; ++j) { const int n = (lane >> 3) + 8 * j; const LAS float* s = scr + (8 * c) * 33 + n;
        v4u o; o.x = pk2(s[0 * 33], s[1 * 33]); o.y = pk2(s[2 * 33], s[3 * 33]); o.z = pk2(s[4 * 33], s[5 * 33]); o.w = pk2(s[6 * 33], s[7 * 33]);
        *(v4u*)(WT + (size_t)(n0 + n) * K + k0 + 8 * c) = o; }
    LDS_WAIT(); asm volatile("" ::: "memory");
}
__device__ __forceinline__ void rms_row_to_bf16(const float* xrow, const float* g, bf16* orow, int lane) {
    const f32x4* xr = (const f32x4*)xrow + lane;
    f32x4 v[8]; float s = 0.f;
#pragma unroll
    for (int j = 0; j < 8; ++j) { v[j] = xr[64 * j]; s += (v[j].x * v[j].x + v[j].y * v[j].y) + (v[j].z * v[j].z + v[j].w * v[j].w); }
    const float rs = 1.0f / sqrtf(wave_sum(s) * (1.f / DM) + RMS_EPS);
    v2u* o8 = (v2u*)orow + lane;
#pragma unroll
    for (int j = 0; j < 8; ++j) { const f32x4 gg = ((const f32x4*)g)[lane + 64 * j];
        v2u o; o.x = pk2(v[j].x * rs * gg.x, v[j].y * rs * gg.y); o.y = pk2(v[j].z * rs * gg.z, v[j].w * rs * gg.w); o8[64 * j] = o; }
}
__device__ __forceinline__ void phase_prologue(KP P, LAS unsigned char* lds, int vcu, int G) {
    const int tid = ltid(), lane = tid & 63, wave = tid >> 6;
    LAS float* scr = (LAS float*)(lds + wave * 16384);
    const int gw = vcu * NWAVES + wave, NGW = G * NWAVES;
    bf16* WIN = (bf16*)(P.ws + WS_WIN); bf16* XN = (bf16*)(P.ws + WS_XN);
    constexpr int I_IN = (DM / 64) * (INC / 32);
    for (int it = gw; it < I_IN; it += NGW) p0_transpose_item(P.w_in, DM, INC, WIN, scr, it, lane);
    for (int i = vcu * NTHR + tid; i < (INCP - INC) * DM / 8; i += G * NTHR) ((v4u*)(WIN + (size_t)INC * DM))[i] = (v4u){0u, 0u, 0u, 0u};
    for (int m = gw; m < TT; m += NGW) rms_row_to_bf16(P.x + (size_t)m * DM, P.norm1_g, XN + (size_t)m * DM, lane);
}
__device__ __forceinline__ void phase_transpose_late(KP P, LAS unsigned char* lds) {
    const int tid = ltid(), lane = tid & 63, wave = tid >> 6;
    constexpr int I_SQ = (DM / 64) * (DM / 32), NTK = 2 * I_SQ / NWAVES;
    unsigned* ctr = (unsigned*)(P.ws + WS_CTL) + CW_MOBA_CTR + 16; LAS int* slot = (LAS int*)(lds + 8 * 16384); LAS float* scr = (LAS float*)(lds + wave * 16384);
    __syncthreads();
    if (tid == 0) slot[0] = (int)__hip_atomic_fetch_add(ctr, 1u, __ATOMIC_RELAXED, __HIP_MEMORY_SCOPE_AGENT);
    __syncthreads();
    for (int it = 0;; ++it) {
        const int c = slot[it & 1]; if (c >= NTK) break;
        if (tid == 0) slot[(it & 1) ^ 1] = (int)__hip_atomic_fetch_add(ctr, 1u, __ATOMIC_RELAXED, __HIP_MEMORY_SCOPE_AGENT);
        const int r = c * NWAVES + wave;
        if (r < I_SQ) p0_transpose_item(P.w_out, DM, DM, (bf16*)(P.ws + WS_WOUT), scr, r, lane);
        else p0_transpose_item(P.wq, DM, DM, (bf16*)(P.ws + WS_WQ), scr, r - I_SQ, lane, P.norm2_g);
        __syncthreads();
    }
}

namespace pg8 {
struct EpiF32 {
    static constexpr bool PERM = false, AFTER_DRAIN = false;
    const float* base; float* out; int ldc;
    __device__ __forceinline__ void operator()(const f32x4 (&acc)[2][2][4][2], const Unit& u, int wr, int wc, int fr, int fq) const {
        const int col0 = u.pn * BM + wc * 32 + 4 * fq;
#pragma unroll
        for (int ai = 0; ai < 2; ++ai)
#pragma unroll
            for (int m = 0; m < 4; ++m) { const int r = ai * HALF + wr * 64 + m * 16 + fr; const size_t off = (size_t)(u.pm * BM + r) * ldc + col0;
#pragma unroll
                for (int bj = 0; bj < 2; ++bj)
#pragma unroll
                    for (int n = 0; n < 2; ++n) { f32x4 o = acc[ai][bj][m][n]; if (base) o = o + *(const f32x4*)(base + off + bj * HALF + n * 16);
                        *(f32x4*)(out + off + bj * HALF + n * 16) = o; } }
    }
};
struct EpiH {
    static constexpr bool PERM = false, AFTER_DRAIN = false;
    const float* base; bf16* outb; float* ss; int ldc;
    __device__ __forceinline__ void operator()(const f32x4 (&acc)[2][2][4][2], const Unit& u, int wr, int wc, int fr, int fq) const {
        const int col0 = u.pn * BM + wc * 32 + 4 * fq;
#pragma unroll
        for (int ai = 0; ai < 2; ++ai) {
            f32x4 xv[4][2][2];
#pragma unroll
            for (int m = 0; m < 4; ++m) { const size_t off = (size_t)(u.pm * BM + ai * HALF + wr * 64 + m * 16 + fr) * ldc + col0;
#pragma unroll
                for (int bj = 0; bj < 2; ++bj)
#pragma unroll
                    for (int n = 0; n < 2; ++n) xv[m][bj][n] = *(const f32x4*)(base + off + bj * HALF + n * 16); }
#pragma unroll
            for (int m = 0; m < 4; ++m) { const int r = ai * HALF + wr * 64 + m * 16 + fr; const size_t off = (size_t)(u.pm * BM + r) * ldc + col0; float sq = 0.f;
#pragma unroll
                for (int bj = 0; bj < 2; ++bj)
#pragma unroll
                    for (int n = 0; n < 2; ++n) { const f32x4 o = acc[ai][bj][m][n] + xv[m][bj][n];
                        *(v2u*)(outb + off + bj * HALF + n * 16) = (v2u){pk2(o.x, o.y), pk2(o.z, o.w)};
                        sq += (o.x * o.x + o.y * o.y) + (o.z * o.z + o.w * o.w); }
                sq += __shfl_xor(sq, 16); sq += __shfl_xor(sq, 32);
                if (fq == 0) ss[(size_t)(u.pm * BM + r) * 32 + u.pn * 4 + wc] = sq; }
        }
    }
};
struct EpiBf16Row {
    static constexpr bool PERM = true, AFTER_DRAIN = false;
    bf16_t* O; int ldc; const float* rs;
    __device__ __forceinline__ void operator()(const f32x4 (&acc)[2][2][4][2], const Unit& u, int wr, int wc, int fr, int fq) const {
        const int row0 = u.pm * BM + wr * 64 + fr, col0 = u.pn * BM + wc * 32 + 8 * fq;
        float scv[2][4];
#pragma unroll
        for (int ai = 0; ai < 2; ++ai)
#pragma unroll
            for (int m = 0; m < 4; ++m) scv[ai][m] = rs[row0 + ai * HALF + m * 16];
#pragma unroll
        for (int ai = 0; ai < 2; ++ai)
#pragma unroll
            for (int m = 0; m < 4; ++m) { const int row = row0 + ai * HALF + m * 16; const float sc = scv[ai][m]; bf16_t* rowp = O + (size_t)row * ldc + col0;
#pragma unroll
                for (int bj = 0; bj < 2; ++bj) { const f32x4 v0 = acc[ai][bj][m][0] * sc, v1 = acc[ai][bj][m][1] * sc;
                    u32x4 w; w.x = cvt_pk_bf16(v0[0], v0[1]); w.y = cvt_pk_bf16(v0[2], v0[3]); w.z = cvt_pk_bf16(v1[0], v1[1]); w.w = cvt_pk_bf16(v1[2], v1[3]);
                    *(u32x4*)(rowp + bj * HALF) = w; } }
    }
};
struct Order1 {
    StaticOrder s; bool split; int c;
    __device__ void init(int M, int N, int G_, int c_) { s.init(M, N, G_, c_); split = (G_ == 256 && M == 8192 && N == 6656); c = c_; }
    __device__ bool next(int i, Unit& u) const {
        if (!split) return s.next(i, u);
        if (c >= 208 || i >= 4) return false;
        const int x = c & 7, j = c >> 3; u.pm = 4 * x + 2 * (i >> 1) + (j & 1); u.pn = 13 * (i & 1) + (j >> 1); return true; }
    __device__ __forceinline__ void a_ready(const Unit&) const {}
    __device__ __forceinline__ void done(const Unit&) const {}
};
}

__device__ __forceinline__ void phase_rstd(KP P, int vcu, int G) {
    const float* ssp = (const float*)(P.ws + WS_SSP); float* rstd = (float*)(P.ws + WS_SSP + 2 * MiB);
    for (int row = vcu * NTHR + ltid(); row < TT; row += G * NTHR) { const f32x4* sp = (const f32x4*)(ssp + (size_t)row * 32); float a = 0.f;
#pragma unroll
        for (int j = 0; j < 8; ++j) { const f32x4 v = sp[j]; a += (v.x + v.y) + (v.z + v.w); }
        rstd[row] = 1.0f / sqrtf(a * (1.f / DM) + RMS_EPS); }
}
__device__ __forceinline__ void phase_kmean(KP P, LAS unsigned char* lds, int vcu, int G) {
    const int tid = ltid(); const bf16* proj = (const bf16*)(P.ws + WS_PROJ); float* kmean = (float*)(P.ws + WS_KMEAN);
    LAS float* red = (LAS float*)lds;
    for (int item = vcu; item < 32 * 8; item += G) {
        const int bb = item >> 3, cg = item & 7;
        const int c = tid & 127, rq = tid >> 7;
        const bf16* p = proj + (size_t)(bb * 256 + rq * 64) * INCP + C_AK + cg * 128 + c;
        float s = 0.f;
        for (int r = 0; r < 64; ++r) s += bf2f(p[(size_t)r * INCP]);
        red[rq * 128 + c] = s;
        __syncthreads();
        if (tid < 128) kmean[(size_t)bb * 1024 + cg * 128 + tid] = (red[tid] + red[128 + tid] + red[256 + tid] + red[384 + tid]) * (1.f / 256.f);
        __syncthreads();
    }
}

typedef short bf16x8 __attribute__((ext_vector_type(8)));
typedef float f32x16 __attribute__((ext_vector_type(16)));
constexpr int CP = 72;
constexpr int MATB = 64 * CP * 2;
enum { M_AT = 0, M_BT = 1, M_KT = 2, M_RT = 3, M_VT = 4, M_BBT = 5, M_KBT = 6, M_LAK = 7, M_MRB = 8, M_MRK = 9, M_LAB = 10, M_AHT = 0, M_U0T = 1 };
constexpr int L_RHS = 11 * MATB;
constexpr int L_MISC = L_RHS + 32768;
constexpr int L_TB = L_MISC + 9 * 64 * 4;
constexpr int L_A_END = L_TB + 2048;
static_assert(L_A_END <= RING_BYTES, "stage A LDS");
constexpr size_t CHK_ITEM = 6 * 8192;

__device__ __forceinline__ f32x16 mm_tile(const LAS unsigned char* A, int ra, const LAS unsigned char* B, int rb, f32x16 acc, int lane, int k0 = 0, int k1 = 4) {
    const int r = lane & 31, hi = lane >> 5;
    const LAS unsigned char* ap = A + ((ra * 32 + r) * CP + 8 * hi) * 2; const LAS unsigned char* bp = B + ((rb * 32 + r) * CP + 8 * hi) * 2;
#pragma unroll
    for (int kk = 0; kk < 4; ++kk) if (kk >= k0 && kk < k1) {
        const bf16x8 a = *(const LAS bf16x8*)(ap + kk * 32), b = *(const LAS bf16x8*)(bp + kk * 32);
        acc = __builtin_amdgcn_mfma_f32_32x32x16_bf16(a, b, acc, 0, 0, 0); }
    return acc;
}
__device__ __forceinline__ int crow32(int reg, int hi) { return (reg & 3) + 8 * (reg >> 2) + 4 * hi; }

__device__ __forceinline__ void prologue_lora(KP P, int vcu, int G) {
    bf16* w2T = (bf16*)(P.ws + WS_LORA); bf16* a2T = w2T + 1024 * 96; bf16* g2T = a2T + 1024 * 96;
    for (int e0 = vcu * NTHR + ltid(); e0 < 448 * 1024; e0 += 4 * G * NTHR) { float v[4];
#pragma unroll
        for (int u = 0; u < 4; ++u) { const int e = e0 + u * G * NTHR, i = e >> 10; v[u] = 0.f;
            if (e < 448 * 1024) v[u] = i < 96 ? P.w2[e] : (i < 192 ? P.a2[e - 96 * 1024] : P.g2[e - 192 * 1024]); }
#pragma unroll
        for (int u = 0; u < 4; ++u) { const int e = e0 + u * G * NTHR, i = e >> 10, n = e & 1023;
            if (e < 448 * 1024) { if (i < 96) w2T[n * 96 + i] = (bf16)f2bf(v[u]); else if (i < 192) a2T[n * 96 + (i - 96)] = (bf16)f2bf(v[u]); else g2T[n * 256 + (i - 192)] = (bf16)f2bf(v[u]); } }
    }
}
__device__ __forceinline__ void phase_act(KP P, int vcu, int G) {
    const bf16* proj = (const bf16*)(P.ws + WS_PROJ); unsigned* act = (unsigned*)(P.ws + WS_ACT);
    for (int e0 = vcu * NTHR + ltid(); e0 < TT * 224; e0 += 4 * G * NTHR) {
        unsigned cu[4], pu[4]; float m0[4], m1[4];
#pragma unroll
        for (int u = 0; u < 4; ++u) { const int e = e0 + u * G * NTHR; cu[u] = 0u; pu[u] = 0u; m0[u] = 0.f; m1[u] = 0.f;
            if (e < TT * 224) { const int t = e / 224, cc = 2 * (e - t * 224); const bf16* pr = proj + (size_t)t * INCP + C_RW + 3072 + cc;
                cu[u] = *(const unsigned*)pr; pu[u] = (t & (SEQ - 1)) == 0 ? 0u : *(const unsigned*)(pr - INCP); m0[u] = P.mu[3072 + cc]; m1[u] = P.mu[3072 + cc + 1]; } }
#pragma unroll
        for (int u = 0; u < 4; ++u) { const int e = e0 + u * G * NTHR;
            if (e < TT * 224) { const int t = e / 224, cc = 2 * (e - t * 224);
                float v0 = bflo(cu[u]) + (bflo(pu[u]) - bflo(cu[u])) * m0[u], v1 = bfhi(cu[u]) + (bfhi(pu[u]) - bfhi(cu[u])) * m1[u];
                if (cc < 96) { v0 = tanhf(v0); v1 = tanhf(v1); } else if (cc >= 192) { v0 = 1.f / (1.f + __expf(-v0)); v1 = 1.f / (1.f + __expf(-v1)); }
                act[e] = pk2(v0, v1); } }
    }
}
constexpr int ACTP = 456;
constexpr int L_WAG = 58368;
static_assert(L_WAG + 3 * 16384 <= L_MISC, "lora scratch fits below misc");
struct LoraFrags { bf16x8 f[16]; f32x4 w0[4], a0[4]; float mu_r, mu_k, mu_v, kkc, kac, rkc, lng, lnb; };
__device__ __forceinline__ LoraFrags lora_frags_load(KP P, int h, int wave, int lane) {
    const int c32 = lane & 31, hi = lane >> 5, nb = (wave & 3) >> 1; const int nrow = h * 64 + nb * 32 + c32;
    const bf16* w2T = (const bf16*)(P.ws + WS_LORA); const bf16* a2T = w2T + 1024 * 96; const bf16* g2T = a2T + 1024 * 96;
    const bf16* wp = w2T + (size_t)nrow * 96 + 8 * hi; const bf16* ap = a2T + (size_t)nrow * 96 + 8 * hi; const bf16* gp = g2T + (size_t)nrow * 256 + 8 * hi;
    LoraFrags W;
#pragma unroll
    for (int kk = 0; kk < 16; ++kk) { const bf16* src = wave < 4 ? (kk < 6 ? wp + 16 * kk : ap + 16 * ((kk - 6) % 6)) : gp + 16 * kk; W.f[kk] = *(const bf16x8*)src; }
#pragma unroll
    for (int g = 0; g < 4; ++g) { const int n0 = h * 64 + nb * 32 + 8 * g + 4 * hi; W.w0[g] = *(const f32x4*)(P.w0 + n0); W.a0[g] = *(const f32x4*)(P.a0 + n0); }
    const int col = h * 64 + lane;
    W.mu_r = P.mu[col]; W.mu_k = P.mu[1024 + col]; W.mu_v = P.mu[2048 + col]; W.kkc = P.k_k[col]; W.kac = P.k_a[col]; W.rkc = P.r_k[col]; W.lng = P.ln_g[col]; W.lnb = P.ln_b[col];
    return W;
}
__device__ __forceinline__ void rwkv_stage_a(KP P, LAS unsigned char* lds, int item, const LoraFrags& W) {
    const int tid = ltid(), lane = tid & 63, wave = __builtin_amdgcn_readfirstlane(tid >> 6);
    const int b = item >> 10, h = (item >> 6) & 15, c = item & 63;
    const int tok0 = b * SEQ + c * 64;
    const bf16* proj = (const bf16*)(P.ws + WS_PROJ);
    unsigned char* chk = P.ws + WS_CHK + (size_t)((item & 63) * 32 + (item >> 6)) * CHK_ITEM;
    LAS float* misc = (LAS float*)(lds + L_MISC);
    { const bf16* actg = (const bf16*)(P.ws + WS_ACT) + (size_t)tok0 * 448;
#pragma unroll
      for (int e = tid; e < 64 * 56; e += NTHR) { const int row = e / 56, ch = e - row * 56; *(LAS v4u*)(lds + (row * ACTP + ch * 8) * 2) = *(const v4u*)(actg + (size_t)row * 448 + ch * 8); } }
    __syncthreads();
    {
        const int c32 = lane & 31, hi = lane >> 5, qd = wave & 3, nb = qd >> 1, tb = qd & 1;
        const LAS unsigned char* actp = lds + ((tb * 32 + c32) * ACTP + 8 * hi) * 2;
        LAS float* wag = (LAS float*)(lds + L_WAG) + (tb * 32 + c32) * 64 + nb * 32;
        if (wave < 4) {
            f32x16 aw = {}, aa = {};
#pragma unroll
            for (int kk = 0; kk < 6; ++kk) {
                aw = __builtin_amdgcn_mfma_f32_32x32x16_bf16(W.f[kk], *(const LAS bf16x8*)(actp + (16 * kk) * 2), aw, 0, 0, 0);
                aa = __builtin_amdgcn_mfma_f32_32x32x16_bf16(W.f[6 + kk], *(const LAS bf16x8*)(actp + (96 + 16 * kk) * 2), aa, 0, 0, 0); }
#pragma unroll
            for (int g = 0; g < 4; ++g) { const int n0 = h * 64 + nb * 32 + 8 * g + 4 * hi;
                const f32x4 w0 = W.w0[g], a0 = W.a0[g]; f32x4 ow, oa;
#pragma unroll
                for (int e = 0; e < 4; ++e) { const float xx = w0[e] + aw[4 * g + e];
                    ow[e] = __expf(-0.6065306597126334f * __builtin_amdgcn_rcpf(1.f + __expf(-xx))); oa[e] = __builtin_amdgcn_rcpf(1.f + __expf(-(a0[e] + aa[4 * g + e]))); }
                *(LAS f32x4*)(wag + 8 * g + 4 * hi) = ow; *(LAS f32x4*)(wag + 4096 + 8 * g + 4 * hi) = oa; }
        } else {
            f32x16 ag = {};
#pragma unroll
            for (int kk = 0; kk < 16; ++kk) ag = __builtin_amdgcn_mfma_f32_32x32x16_bf16(W.f[kk], *(const LAS bf16x8*)(actp + (192 + 16 * kk) * 2), ag, 0, 0, 0);
#pragma unroll
            for (int g = 0; g < 4; ++g) *(LAS f32x4*)(wag + 8192 + 8 * g + 4 * hi) = (f32x4){ag[4 * g], ag[4 * g + 1], ag[4 * g + 2], ag[4 * g + 3]};
        }
    }
    __syncthreads();
    {
        const int n = lane, tg = wave, col = h * 64 + n;
        const float mu_r = W.mu_r, mu_k = W.mu_k, mu_v = W.mu_v, kkc = W.kkc, kac = W.kac, rkc = W.rkc, lng = W.lng, lnb = W.lnb;
        float rr[8], kr[8], vv[8], ww[8], aa[8], gg[8], kk[8];
        const int tfirst = tok0 + 8 * tg;
        const bf16* pp = proj + (size_t)tfirst * INCP + C_RW + col;
        float pr, pk, pvv;
        if (c == 0 && tg == 0) { pr = 0.f; pk = 0.f; pvv = 0.f; } else { pr = bf2f(pp[-(long)INCP]); pk = bf2f(pp[-(long)INCP + 1024]); pvv = bf2f(pp[-(long)INCP + 2048]); }
        const LAS float* wagr = (const LAS float*)(lds + L_WAG) + (8 * tg) * 64 + n;
#pragma unroll
        for (int q = 0; q < 8; ++q) { const float cr = bf2f(pp[(size_t)q * INCP]), ck = bf2f(pp[(size_t)q * INCP + 1024]), cv = bf2f(pp[(size_t)q * INCP + 2048]);
            rr[q] = cr + (pr - cr) * mu_r; kr[q] = ck + (pk - ck) * mu_k; vv[q] = cv + (pvv - cv) * mu_v; pr = cr; pk = ck; pvv = cv;
            ww[q] = wagr[q * 64]; aa[q] = wagr[4096 + q * 64]; gg[q] = wagr[8192 + q * 64]; }
        float lam[8]; float run = 1.f;
#pragma unroll
        for (int q = 0; q < 8; ++q) { run *= ww[q]; lam[q] = run; }
        misc[tg * 64 + n] = run;
#pragma unroll
        for (int q = 0; q < 8; ++q) { const float kkv = kr[q] * kkc; const float ss = wave_sum(kkv * kkv); kk[q] = kkv * __builtin_amdgcn_rsqf(fmaxf(ss, 1e-24f));
            kr[q] = kr[q] * (1.f + (aa[q] - 1.f) * kac); }
        __syncthreads();
        float pre = 1.f, tot = 1.f;
#pragma unroll
        for (int g = 0; g < 8; ++g) { const float sgt = misc[g * 64 + n]; if (g < tg) pre *= sgt; tot *= sgt; }
        if (tg == 0) misc[512 + n] = tot;
        unsigned vt[4], bbt[4], kbt[4];
        LAS bf16* At = (LAS bf16*)(lds + M_AT * MATB); LAS bf16* Bt = (LAS bf16*)(lds + M_BT * MATB); LAS bf16* Kt = (LAS bf16*)(lds + M_KT * MATB); LAS bf16* Rt = (LAS bf16*)(lds + M_RT * MATB);
        float hbb = 0.f, hkb = 0.f, hv = 0.f;
#pragma unroll
        for (int q = 0; q < 8; ++q) { const int t = 8 * tg + q;
            const float L = pre * lam[q], Lp = q == 0 ? pre : pre * lam[q - 1], iL = __builtin_amdgcn_rcpf(L), rel = tot * iL;
            const float bq = kk[q] * aa[q];
            ((LAS float*)(lds + L_RHS))[t * 128 + 64 + n] = -kk[q] * Lp;
            At[t * CP + n] = (bf16)f2bf(-kk[q] * Lp); Bt[t * CP + n] = (bf16)f2bf(bq * iL); Kt[t * CP + n] = (bf16)f2bf(kr[q] * iL); Rt[t * CP + n] = (bf16)f2bf(rr[q] * L);
            const float bb = bq * rel, kb = kr[q] * rel;
            if (q & 1) { vt[q >> 1] = pk2(hv, vv[q]); bbt[q >> 1] = pk2(hbb, bb); kbt[q >> 1] = pk2(hkb, kb); } else { hv = vv[q]; hbb = bb; hkb = kb; }
            const float bs = wave_sum(rr[q] * kr[q] * rkc);
            const int pl = (((t >> 4) * 2 + (n >> 5)) * 64 + (t & 15) * 4 + ((n >> 2) & 3)) * 8 + ((n >> 4) & 1) * 4 + (n & 3);
            ((bf16*)(chk + 4 * 8192))[pl] = (bf16)f2bf(lng * gg[q]);
            ((bf16*)(chk + 5 * 8192))[pl] = (bf16)f2bf((lnb + bs * vv[q]) * gg[q]); }
        *(LAS v4u*)(lds + M_VT * MATB + (n * CP + 8 * tg) * 2) = (v4u){vt[0], vt[1], vt[2], vt[3]};
        *(LAS v4u*)(lds + M_BBT * MATB + (n * CP + 8 * tg) * 2) = (v4u){bbt[0], bbt[1], bbt[2], bbt[3]};
        *(LAS v4u*)(lds + M_KBT * MATB + (n * CP + 8 * tg) * 2) = (v4u){kbt[0], kbt[1], kbt[2], kbt[3]};
    }
    __syncthreads();
    const int c32 = lane & 31, hi = lane >> 5;
    {
        const int prod = wave >> 1;
#pragma unroll
        for (int qi = 0; qi < 2; ++qi) {
            const int tb = (wave & 1) ? (qi == 0 ? 1 : 0) : qi, sb = (wave & 1) ? 1 : 0; const bool zero = (tb == 0 && sb == 1);
            f32x16 acc = {};
            const int xa = (prod == 0 || prod == 2) ? M_BT : M_KT, ya = prod < 2 ? M_AT : M_RT, dm = prod == 0 ? M_LAB : (prod == 1 ? M_LAK : (prod == 2 ? M_MRB : M_MRK));
            if (!zero) acc = mm_tile(lds + xa * MATB, sb, lds + ya * MATB, tb, acc, lane);
            const int t = tb * 32 + c32; LAS unsigned char* dst = lds + dm * MATB + (t * CP + sb * 32) * 2;
#pragma unroll
            for (int g = 0; g < 4; ++g) { float o[4];
#pragma unroll
                for (int e = 0; e < 4; ++e) { const int s = sb * 32 + 8 * g + 4 * hi + e; const bool keep = prod < 2 ? (s < t) : (s <= t); o[e] = keep ? acc[4 * g + e] : 0.f; }
                *(LAS v2u*)(dst + (8 * g + 4 * hi) * 2) = (v2u){pk2(o[0], o[1]), pk2(o[2], o[3])}; }
        }
    }
    __syncthreads();
    if (wave < 4) {
        const int ib = wave >> 1, tb = wave & 1; f32x16 acc = {};
        acc = mm_tile(lds + M_VT * MATB, ib, lds + M_LAK * MATB, tb, acc, lane, 0, tb == 0 ? 2 : 4);
        const int t = tb * 32 + c32; LAS float* dst = (LAS float*)(lds + L_RHS) + t * 128 + ib * 32;
#pragma unroll
        for (int g = 0; g < 4; ++g) *(LAS f32x4*)(dst + 8 * g + 4 * hi) = (f32x4){acc[4 * g], acc[4 * g + 1], acc[4 * g + 2], acc[4 * g + 3]};
    } else if (wave == 4) {
        const int bb = lane >> 4, col = lane & 15;
        float x[16];
#pragma unroll
        for (int t = 0; t < 16; ++t) x[t] = t == col ? 1.f : 0.f;
#pragma unroll
        for (int t = 1; t < 16; ++t) { const LAS unsigned char* rp = lds + M_LAB * MATB + ((16 * bb + t) * CP + 16 * bb) * 2; const v4u ra = *(const LAS v4u*)rp, rb = *(const LAS v4u*)(rp + 16);
            float lrow[16];
#pragma unroll
            for (int q = 0; q < 4; ++q) { lrow[2 * q] = bflo(ra[q]); lrow[2 * q + 1] = bfhi(ra[q]); lrow[8 + 2 * q] = bflo(rb[q]); lrow[8 + 2 * q + 1] = bfhi(rb[q]); }
#pragma unroll
            for (int s = 0; s < t; ++s) x[t] += lrow[s] * x[s]; }
        LAS bf16* T = (LAS bf16*)(lds + L_TB) + bb * 256 + col;
#pragma unroll
        for (int t = 0; t < 16; ++t) T[t * 16] = (bf16)f2bf(x[t]);
    }
    __syncthreads();
    {
        typedef short s16x4 __attribute__((ext_vector_type(4)));
        const int l15 = lane & 15, q4 = lane >> 4;
        LAS unsigned char* xt = lds + (wave < 4 ? M_U0T : M_AHT) * MATB + ((16 * (wave & 3) + l15) * CP) * 2;
        *(LAS v4u*)(xt + q4 * 32) = (v4u){0u, 0u, 0u, 0u}; *(LAS v4u*)(xt + q4 * 32 + 16) = (v4u){0u, 0u, 0u, 0u};
        const LAS float* Xf = (const LAS float*)(lds + L_RHS) + 16 * wave + l15;
#pragma unroll
        for (int bq = 0; bq < 4; ++bq) {
            f32x4 acc;
#pragma unroll
            for (int e = 0; e < 4; ++e) acc[e] = Xf[(16 * bq + 4 * q4 + e) * 128];
#pragma unroll
            for (int kk = 0; kk < (bq + 1) / 2; ++kk) {
                const bf16x8 a = *(const LAS bf16x8*)(lds + M_LAB * MATB + ((16 * bq + l15) * CP + 32 * kk + 8 * q4) * 2);
                const bf16x8 xb = *(const LAS bf16x8*)(xt + (32 * kk + 8 * q4) * 2);
                acc = __builtin_amdgcn_mfma_f32_16x16x32_bf16(a, xb, acc, 0, 0, 0); }
            const v2u tf = *(const LAS v2u*)(lds + L_TB + (bq * 256 + l15 * 16 + 4 * q4) * 2);
            const v2u ab = (v2u){pk2(acc[0], acc[1]), pk2(acc[2], acc[3])};
            const f32x4 z = {0.f, 0.f, 0.f, 0.f};
            const f32x4 xn = __builtin_amdgcn_mfma_f32_16x16x16bf16_1k(__builtin_bit_cast(s16x4, tf), __builtin_bit_cast(s16x4, ab), z, 0, 0, 0);
            *(LAS v2u*)(xt + (16 * bq + 4 * q4) * 2) = (v2u){pk2(xn[0], xn[1]), pk2(xn[2], xn[3])};
        }
    }
    __syncthreads();
    {
        const int qd = wave & 3, yb = qd >> 1, xb = qd & 1;
        f32x16 acc1 = {}, acc2 = {};
        if (wave < 4) {
            acc1 = mm_tile(lds + M_AHT * MATB, yb, lds + M_BBT * MATB, xb, acc1, lane);
            acc2 = mm_tile(lds + M_BBT * MATB, yb, lds + M_U0T * MATB, xb, acc2, lane);
            acc2 = mm_tile(lds + M_KBT * MATB, yb, lds + M_VT * MATB, xb, acc2, lane);
            const int x = xb * 32 + c32; const float lc = misc[512 + x];
            bf16* o1 = (bf16*)(chk + 0 * 8192) + (((x >> 4) * 2 + yb) * 64 + (x & 15)) * 8 + 4 * hi; bf16* o2 = (bf16*)(chk + 1 * 8192) + ((2 * yb * 4 + (x >> 4)) * 64 + (x & 15)) * 4;
#pragma unroll
            for (int g = 0; g < 4; ++g) { float p[4];
#pragma unroll
                for (int e = 0; e < 4; ++e) { const int y = yb * 32 + 8 * g + 4 * hi + e; p[e] = acc1[4 * g + e] + (y == x ? lc : 0.f); }
                *(v2u*)(o1 + 16 * g * 8) = (v2u){pk2(p[0], p[1]), pk2(p[2], p[3])};
                *(v2u*)(o2 + ((g >> 1) * 4 * 64 + 16 * ((2 * g + hi) & 3)) * 4) = (v2u){pk2(acc2[4 * g], acc2[4 * g + 1]), pk2(acc2[4 * g + 2], acc2[4 * g + 3])}; }
        } else {
            acc1 = mm_tile(lds + M_AHT * MATB, yb, lds + M_MRB * MATB, xb, acc1, lane);
            acc2 = mm_tile(lds + M_U0T * MATB, yb, lds + M_MRB * MATB, xb, acc2, lane);
            acc2 = mm_tile(lds + M_VT * MATB, yb, lds + M_MRK * MATB, xb, acc2, lane);
            const int x = xb * 32 + c32;
            bf16* o1 = (bf16*)(chk + 2 * 8192) + (((x >> 4) * 2 + yb) * 64 + (x & 15)) * 8 + 4 * hi; bf16* o2 = (bf16*)(chk + 3 * 8192) + (((x >> 4) * 2 + yb) * 64 + (x & 15)) * 8;
            const LAS bf16* Rt = (const LAS bf16*)(lds + M_RT * MATB) + x * CP + yb * 32;
#pragma unroll
            for (int g = 0; g < 4; ++g) { float p[4];
#pragma unroll
                for (int e = 0; e < 4; ++e) p[e] = acc1[4 * g + e] + bf2f(Rt[8 * g + 4 * hi + e]);
                *(v2u*)(o1 + 16 * g * 8) = (v2u){pk2(p[0], p[1]), pk2(p[2], p[3])};
                *(v2u*)(o2 + 16 * ((2 * g + hi) & 3) * 8 + (g >> 1) * 4) = (v2u){pk2(acc2[4 * g], acc2[4 * g + 1]), pk2(acc2[4 * g + 2], acc2[4 * g + 3])}; }
        }
    }
    __syncthreads();
}

__device__ __forceinline__ void phase_rwkv_stage_a(KP P, LAS unsigned char* lds, int vcu, int G) {
    const int tid = ltid(), lane = tid & 63, wave = __builtin_amdgcn_readfirstlane(tid >> 6);
    int cur_bh = (vcu & 255) >> 3; LoraFrags W = lora_frags_load(P, cur_bh & 15, wave, lane);
    for (int k = vcu; k < 2048; k += G) { const int bh = (k & 255) >> 3, c = (k & 7) + 8 * (k >> 8);
        if (bh != cur_bh) { W = lora_frags_load(P, bh & 15, wave, lane); cur_bh = bh; }
        rwkv_stage_a(P, lds, bh * 64 + c, W); }
}
typedef float f32x4v __attribute__((ext_vector_type(4)));
struct YSet { bf16x8 b0, b1; v4u y0[2], g1[2], g2[2]; };
struct SSet { bf16x8 p0[1], p1[1]; v2u q[4]; };
__device__ __forceinline__ void rwkv_stage_b(KP P, LAS unsigned char* lds, int bh) {
    const int tid = ltid(), lane = tid & 63, wave = __builtin_amdgcn_readfirstlane(tid >> 6);
    const int b = bh >> 4, h = bh & 15; const int l15 = lane & 15, q4 = lane >> 4;
    bf16* AR = (bf16*)(P.ws + WS_AR);
    for (int u = tid; u < 2 * MATB / 4; u += NTHR) ((LAS unsigned*)lds)[u] = 0u;
    __syncthreads();
    const int w4 = wave & 3;
    const unsigned char* chk0 = P.ws + WS_CHK + (size_t)bh * CHK_ITEM;
    if (wave < 4) {
        const int t = 16 * w4 + l15;
        YSet ys[4];
#define YLOAD(S_, c_) do { const unsigned char* chk = chk0 + (size_t)(c_) * (32 * CHK_ITEM); const bf16* rh = (const bf16*)(chk + 2 * 8192) + (w4 * 128 + lane) * 8; S_.b0 = *(const bf16x8*)rh; S_.b1 = *(const bf16x8*)(rh + 512); \
        const bf16* y0 = (const bf16*)(chk + 3 * 8192) + (w4 * 128 + lane) * 8; const bf16* g1 = (const bf16*)(chk + 4 * 8192) + (w4 * 128 + l15 * 4 + q4) * 8; \
        S_.y0[0] = *(const v4u*)y0; S_.y0[1] = *(const v4u*)(y0 + 512); S_.g1[0] = *(const v4u*)g1; S_.g1[1] = *(const v4u*)(g1 + 512); S_.g2[0] = *(const v4u*)(g1 + 4096); S_.g2[1] = *(const v4u*)(g1 + 4096 + 512); } while (0)
#define YV(A_, it_, w_) ((A_)[(it_) >> 1][2 * ((it_) & 1) + (w_)])
#pragma unroll
        for (int u = 0; u < 4; ++u) YLOAD(ys[u], u);
        for (int c0 = 0; c0 < 60; c0 += 4) {
#pragma unroll
                for (int u = 0; u < 4; ++u) { const int c = c0 + u;
                const LAS unsigned char* Scur = lds + (c & 1) * MATB;
                    f32x4v acc[4];
    #pragma unroll
                    for (int it = 0; it < 4; ++it) { acc[it] = (f32x4v){bflo(YV(ys[u].y0, it, 0)), bfhi(YV(ys[u].y0, it, 0)), bflo(YV(ys[u].y0, it, 1)), bfhi(YV(ys[u].y0, it, 1))};
                        const LAS unsigned char* sp = Scur + ((16 * it + l15) * CP + 8 * q4) * 2;
                        acc[it] = __builtin_amdgcn_mfma_f32_16x16x32_bf16(*(const LAS bf16x8*)sp, ys[u].b0, acc[it], 0, 0, 0);
                        acc[it] = __builtin_amdgcn_mfma_f32_16x16x32_bf16(*(const LAS bf16x8*)(sp + 64), ys[u].b1, acc[it], 0, 0, 0); }
                    float s = 0.f;
    #pragma unroll
                    for (int it = 0; it < 4; ++it) s += (acc[it].x + acc[it].y) + (acc[it].z + acc[it].w);
                    s += __shfl_xor(s, 16); s += __shfl_xor(s, 32);
                    const float mean = s * (1.f / 64.f); float v = 0.f;
    #pragma unroll
                    for (int it = 0; it < 4; ++it) { acc[it] = acc[it] - mean; v += (acc[it].x * acc[it].x + acc[it].y * acc[it].y) + (acc[it].z * acc[it].z + acc[it].w * acc[it].w); }
                    v += __shfl_xor(v, 16); v += __shfl_xor(v, 32);
                    const float rstd = 1.0f / sqrtf(v * (1.f / 64.f) + 64e-5f);
                    bf16* orow = AR + (size_t)(b * SEQ + c * 64 + t) * DM + 1024 + h * 64 + 4 * q4;
    #pragma unroll
                    for (int it = 0; it < 4; ++it) {
                        const float o0 = acc[it].x * rstd * bflo(YV(ys[u].g1, it, 0)) + bflo(YV(ys[u].g2, it, 0)), o1 = acc[it].y * rstd * bfhi(YV(ys[u].g1, it, 0)) + bfhi(YV(ys[u].g2, it, 0));
                        const float o2 = acc[it].z * rstd * bflo(YV(ys[u].g1, it, 1)) + bflo(YV(ys[u].g2, it, 1)), o3 = acc[it].w * rstd * bfhi(YV(ys[u].g1, it, 1)) + bfhi(YV(ys[u].g2, it, 1));
                        *(v2u*)(orow + 16 * it) = (v2u){pk2(o0, o1), pk2(o2, o3)}; }
                asm volatile("" ::: "memory");
                    YLOAD(ys[u], c + 4);
                    __syncthreads();
                }
        }
        { const int c0 = 60;
#pragma unroll
                for (int u = 0; u < 4; ++u) { const int c = c0 + u;
                const LAS unsigned char* Scur = lds + (c & 1) * MATB;
                    f32x4v acc[4];
    #pragma unroll
                    for (int it = 0; it < 4; ++it) { acc[it] = (f32x4v){bflo(YV(ys[u].y0, it, 0)), bfhi(YV(ys[u].y0, it, 0)), bflo(YV(ys[u].y0, it, 1)), bfhi(YV(ys[u].y0, it, 1))};
                        const LAS unsigned char* sp = Scur + ((16 * it + l15) * CP + 8 * q4) * 2;
                        acc[it] = __builtin_amdgcn_mfma_f32_16x16x32_bf16(*(const LAS bf16x8*)sp, ys[u].b0, acc[it], 0, 0, 0);
                        acc[it] = __builtin_amdgcn_mfma_f32_16x16x32_bf16(*(const LAS bf16x8*)(sp + 64), ys[u].b1, acc[it], 0, 0, 0); }
                    float s = 0.f;
    #pragma unroll
                    for (int it = 0; it < 4; ++it) s += (acc[it].x + acc[it].y) + (acc[it].z + acc[it].w);
                    s += __shfl_xor(s, 16); s += __shfl_xor(s, 32);
                    const float mean = s * (1.f / 64.f); float v = 0.f;
    #pragma unroll
                    for (int it = 0; it < 4; ++it) { acc[it] = acc[it] - mean; v += (acc[it].x * acc[it].x + acc[it].y * acc[it].y) + (acc[it].z * acc[it].z + acc[it].w * acc[it].w); }
                    v += __shfl_xor(v, 16); v += __shfl_xor(v, 32);
                    const float rstd = 1.0f / sqrtf(v * (1.f / 64.f) + 64e-5f);
                    bf16* orow = AR + (size_t)(b * SEQ + c * 64 + t) * DM + 1024 + h * 64 + 4 * q4;
    #pragma unroll
                    for (int it = 0; it < 4; ++it) {
                        const float o0 = acc[it].x * rstd * bflo(YV(ys[u].g1, it, 0)) + bflo(YV(ys[u].g2, it, 0)), o1 = acc[it].y * rstd * bfhi(YV(ys[u].g1, it, 0)) + bfhi(YV(ys[u].g2, it, 0));
                        const float o2 = acc[it].z * rstd * bflo(YV(ys[u].g1, it, 1)) + bflo(YV(ys[u].g2, it, 1)), o3 = acc[it].w * rstd * bfhi(YV(ys[u].g1, it, 1)) + bfhi(YV(ys[u].g2, it, 1));
                        *(v2u*)(orow + 16 * it) = (v2u){pk2(o0, o1), pk2(o2, o3)}; }
                __syncthreads();
                }
        }
#undef YLOAD
#undef YV
    } else {
        const int nrow = 16 * w4 + l15;
        SSet ss[4];
#define SLOADX(S_, c_) do { const unsigned char* chk = chk0 + (size_t)(c_) * (32 * CHK_ITEM); const bf16* pt = (const bf16*)chk + (w4 * 128 + lane) * 8; S_.p0[0] = *(const bf16x8*)pt; S_.p1[0] = *(const bf16x8*)(pt + 512); \
        const bf16* q = (const bf16*)(chk + 1 * 8192) + (w4 * 256 + lane) * 4; \
        _Pragma("unroll") for (int it = 0; it < 4; ++it) S_.q[it] = *(const v2u*)(q + it * 256); } while (0)
#pragma unroll
        for (int u = 0; u < 4; ++u) SLOADX(ss[u], u);
        for (int c0 = 0; c0 < 60; c0 += 4) {
#pragma unroll
                for (int u = 0; u < 4; ++u) { const int c = c0 + u;
                const LAS unsigned char* Scur = lds + (c & 1) * MATB; LAS unsigned char* Snxt = lds + ((c & 1) ^ 1) * MATB;
    #pragma unroll
                    for (int it = 0; it < 4; ++it) { const int i = 16 * it + l15;
                        const LAS unsigned char* sp = Scur + (i * CP + 8 * q4) * 2; const bf16x8 s0 = *(const LAS bf16x8*)sp, s1 = *(const LAS bf16x8*)(sp + 64);
                        f32x4v acc = (f32x4v){bflo(ss[u].q[it].x), bfhi(ss[u].q[it].x), bflo(ss[u].q[it].y), bfhi(ss[u].q[it].y)};
                        acc = __builtin_amdgcn_mfma_f32_16x16x32_bf16(ss[u].p0[0], s0, acc, 0, 0, 0);
                        acc = __builtin_amdgcn_mfma_f32_16x16x32_bf16(ss[u].p1[0], s1, acc, 0, 0, 0);
                        *(LAS v2u*)(Snxt + (i * CP + 16 * w4 + 4 * q4) * 2) = (v2u){pk2(acc.x, acc.y), pk2(acc.z, acc.w)}; }
                asm volatile("" ::: "memory");
                    SLOADX(ss[u], c + 4);
                    __syncthreads();
                }
        }
        { const int c0 = 60;
#pragma unroll
                for (int u = 0; u < 4; ++u) { const int c = c0 + u;
                const LAS unsigned char* Scur = lds + (c & 1) * MATB; LAS unsigned char* Snxt = lds + ((c & 1) ^ 1) * MATB;
    #pragma unroll
                    for (int it = 0; it < 4; ++it) { const int i = 16 * it + l15;
                        const LAS unsigned char* sp = Scur + (i * CP + 8 * q4) * 2; const bf16x8 s0 = *(const LAS bf16x8*)sp, s1 = *(const LAS bf16x8*)(sp + 64);
                        f32x4v acc = (f32x4v){bflo(ss[u].q[it].x), bfhi(ss[u].q[it].x), bflo(ss[u].q[it].y), bfhi(ss[u].q[it].y)};
                        acc = __builtin_amdgcn_mfma_f32_16x16x32_bf16(ss[u].p0[0], s0, acc, 0, 0, 0);
                        acc = __builtin_amdgcn_mfma_f32_16x16x32_bf16(ss[u].p1[0], s1, acc, 0, 0, 0);
                        *(LAS v2u*)(Snxt + (i * CP + 16 * w4 + 4 * q4) * 2) = (v2u){pk2(acc.x, acc.y), pk2(acc.z, acc.w)}; }
                __syncthreads();
                }
        }
#undef SLOADX
    }
}

constexpr size_t WS_UB = WS_RWA;
constexpr size_t WS_VB = WS_RWA + 32 * MiB;
constexpr float U_SCALE = 512.f, V_SCALE = 32.f;
constexpr int SLICE_BYTES = 16384 * 128;
typedef float f32x2 __attribute__((ext_vector_type(2)));
__device__ __forceinline__ void phase_convert_tables(KP P, LAS unsigned char* lds) {
    const int tid = ltid(); constexpr int N16 = 16384 * 2048 / 16, GPT = 4, CH = GPT * NTHR, NCH = 2 * N16 / CH;
    unsigned* ctr = (unsigned*)(P.ws + WS_CTL) + CW_MOBA_CTR; LAS int* slot = (LAS int*)lds;
    const int q = tid & 127;
    f32x4 gu[4];
#pragma unroll
    for (int m = 0; m < 4; ++m) gu[m] = *(const f32x4*)(P.norm2_g + 16 * q + 4 * m) * U_SCALE;
    __syncthreads();
    if (tid == 0) slot[0] = (int)__hip_atomic_fetch_add(ctr, 1u, __ATOMIC_RELAXED, __HIP_MEMORY_SCOPE_AGENT);
    __syncthreads();
    for (int it = 0;; ++it) {
        const int c = slot[it & 1]; if (c >= NCH) break;
        if (tid == 0) slot[(it & 1) ^ 1] = (int)__hip_atomic_fetch_add(ctr, 1u, __ATOMIC_RELAXED, __HIP_MEMORY_SCOPE_AGENT);
        const bool isv = c >= NCH / 2;
        const int j0 = (isv ? c - NCH / 2 : c) * CH + tid;
        const float* src = (isv ? P.pv : P.pu) + (size_t)j0 * 16;
        unsigned char* dst = P.ws + (isv ? WS_VB : WS_UB) + (size_t)(q >> 3) * SLICE_BYTES + (size_t)(j0 >> 7) * 128 + (q & 7) * 16;
        f32x4 sc[4];
#pragma unroll
        for (int m = 0; m < 4; ++m) sc[m] = isv ? (f32x4){V_SCALE, V_SCALE, V_SCALE, V_SCALE} : gu[m];
#pragma unroll
        for (int hb = 0; hb < 1; ++hb) {
            f32x4 a[4][4];
#pragma unroll
            for (int k = 0; k < 4; ++k)
#pragma unroll
                for (int m = 0; m < 4; ++m) a[k][m] = *(const f32x4*)(src + (size_t)(4 * hb + k) * (NTHR * 16) + 4 * m);
#pragma unroll
            for (int k = 0; k < 4; ++k) { v4u o;
#pragma unroll
                for (int m = 0; m < 4; ++m) { const f32x4 v = a[k][m] * sc[m]; int p = 0;
                    p = __builtin_amdgcn_cvt_pk_fp8_f32(v.x, v.y, p, false); p = __builtin_amdgcn_cvt_pk_fp8_f32(v.z, v.w, p, true); o[m] = (unsigned)p; }
                *(v4u*)(dst + (size_t)(4 * hb + k) * 512) = o; }
        }
        __syncthreads();
    }
}
__device__ __forceinline__ f32x2 dot16p(const v4u u, const f32x2* x, f32x2 acc) {
#pragma unroll
    for (int q = 0; q < 4; ++q) { const f32x2 lo = __builtin_amdgcn_cvt_pk_f32_fp8((int)u[q], false), hi = __builtin_amdgcn_cvt_pk_f32_fp8((int)u[q], true);
        acc = __builtin_elementwise_fma(lo, x[2 * q], acc); acc = __builtin_elementwise_fma(hi, x[2 * q + 1], acc); }
    return acc;
}
__device__ __forceinline__ void axpy16p(const v4u v, f32x2 s, f32x2* y) {
#pragma unroll
    for (int q = 0; q < 4; ++q) { const f32x2 lo = __builtin_amdgcn_cvt_pk_f32_fp8((int)v[q], false), hi = __builtin_amdgcn_cvt_pk_f32_fp8((int)v[q], true);
        y[2 * q] = __builtin_elementwise_fma(s, lo, y[2 * q]); y[2 * q + 1] = __builtin_elementwise_fma(s, hi, y[2 * q + 1]); }
}
__device__ __forceinline__ float xsum_g8(float v) {
    v += DPP_F(v, 0x128);
    { auto r = __builtin_amdgcn_permlane16_swap(__float_as_uint(v), __float_as_uint(v), false, false); v = __uint_as_float(r[0]) + __uint_as_float(r[1]); }
    { auto r = __builtin_amdgcn_permlane32_swap(__float_as_uint(v), __float_as_uint(v), false, false); v = __uint_as_float(r[0]) + __uint_as_float(r[1]); }
    return v;
}
__device__ __forceinline__ void phase_peer_sliced(KP P, LAS unsigned char* lds, int bx, int G) {
    const int grp = bx & 7;
    const unsigned char* UB = P.ws + WS_UB; const unsigned char* VB = P.ws + WS_VB; const bf16* HB = (const bf16*)(P.ws + WS_XN);
    const int* ridx = (const int*)(P.ws + WS_PROJ + 64 * MiB); const float* rgate = (const float*)(P.ws + WS_PROJ + 68 * MiB); const float* RSTD = (const float*)(P.ws + WS_SSP + 2 * MiB);
    for (int bt = bx; bt < TT / 32; bt += G) {
        const int tid = ltid(), lane = tid & 63, wave = __builtin_amdgcn_readfirstlane(tid >> 6), g8 = lane >> 3, p = lane & 7;
        LAS int* idxT = (LAS int*)(lds + wave * 4096); LAS float* gT = (LAS float*)(lds + wave * 4096 + 2048);
        LAS bf16* h2T = (LAS bf16*)(lds + 32768 + wave * 16384);
        const int t0 = 32 * bt + 4 * wave;
#pragma unroll
        for (int i = 0; i < 4; ++i) { const size_t o = (size_t)(t0 + i) * 128; const int wofs = (i * 8 + (lane & 7)) * 16 + (lane >> 3);
            idxT[wofs] = ridx[o + lane]; idxT[wofs + 8] = ridx[o + 64 + lane]; gT[wofs] = rgate[o + lane]; gT[wofs + 8] = rgate[o + 64 + lane]; }
        float hacc[4][2];
#pragma unroll
        for (int i = 0; i < 4; ++i) { hacc[i][0] = 0.f; hacc[i][1] = 0.f; }
        {
            v4u rA[8], rB[8]; f32x2 xA[8], xB[8];
#define PS_SG(s_) (((s_) + 2 * grp) & 15)
#define PS_ISSUE(R, tabbase, s_, i_, hb_) do { const unsigned char* tb_ = (tabbase) + (size_t)PS_SG(s_) * SLICE_BYTES;        \
            const v4u ia_ = *(const LAS v4u*)(idxT + ((i_) * 8 + g8) * 16 + 8 * (hb_)), ib_ = *(const LAS v4u*)(idxT + ((i_) * 8 + g8) * 16 + 8 * (hb_) + 4); const unsigned po_ = 16u * (unsigned)p; \
            R[0] = *(const v4u*)(tb_ + (ia_[0] * 128u + po_)); R[1] = *(const v4u*)(tb_ + (ia_[1] * 128u + po_)); R[2] = *(const v4u*)(tb_ + (ia_[2] * 128u + po_)); R[3] = *(const v4u*)(tb_ + (ia_[3] * 128u + po_)); \
            R[4] = *(const v4u*)(tb_ + (ib_[0] * 128u + po_)); R[5] = *(const v4u*)(tb_ + (ib_[1] * 128u + po_)); R[6] = *(const v4u*)(tb_ + (ib_[2] * 128u + po_)); R[7] = *(const v4u*)(tb_ + (ib_[3] * 128u + po_)); } while (0)
#define PS_LOADX(X, s_, i_) do { const bf16* xp_ = HB + (size_t)(t0 + (i_)) * DM + 128 * PS_SG(s_) + 16 * p; const v4u xa_ = *(const v4u*)xp_, xb_ = *(const v4u*)(xp_ + 8); \
            _Pragma("unroll") for (int q = 0; q < 4; ++q) { X[q] = (f32x2){bflo(xa_[q]), bfhi(xa_[q])}; X[4 + q] = (f32x2){bflo(xb_[q]), bfhi(xb_[q])}; } } while (0)
#define PS_DOTS(R, X, i_, hb_) do { _Pragma("unroll") for (int m = 0; m < 8; ++m) { const f32x2 a2_ = dot16p(R[m], X, (f32x2){0.f, 0.f}); float sd_ = a2_.x + a2_.y; \
            sd_ += DPP_F(sd_, 0xB1); sd_ += DPP_F(sd_, 0x4E); sd_ += DPP_F(sd_, 0x141); if (p == m) hacc[i_][hb_] += sd_; } asm volatile("" ::: "memory"); } while (0)
            PS_LOADX(xA, 0, 0); PS_ISSUE(rA, UB, 0, 0, 0);
            for (int s = 0; s < 16; ++s) {
                PS_ISSUE(rB, UB, s, 0, 1); PS_LOADX(xB, s, 1);  PS_DOTS(rA, xA, 0, 0);
                PS_ISSUE(rA, UB, s, 1, 0);                       PS_DOTS(rB, xA, 0, 1);
                PS_ISSUE(rB, UB, s, 1, 1); PS_LOADX(xA, s, 2);  PS_DOTS(rA, xB, 1, 0);
                PS_ISSUE(rA, UB, s, 2, 0);                       PS_DOTS(rB, xB, 1, 1);
                PS_ISSUE(rB, UB, s, 2, 1); PS_LOADX(xB, s, 3);  PS_DOTS(rA, xA, 2, 0);
                PS_ISSUE(rA, UB, s, 3, 0);                       PS_DOTS(rB, xA, 2, 1);
                PS_ISSUE(rB, UB, s, 3, 1); if (s + 1 < 16) PS_LOADX(xA, s + 1, 0);  PS_DOTS(rA, xB, 3, 0);
                if (s + 1 < 16) PS_ISSUE(rA, UB, s + 1, 0, 0);  PS_DOTS(rB, xB, 3, 1);
            }
#undef PS_LOADX
#undef PS_DOTS
        }
#pragma unroll
        for (int i = 0; i < 4; ++i) { const float rsn = RSTD[t0 + i] * (1.f / U_SCALE);
#pragma unroll
            for (int hb = 0; hb < 2; ++hb) { const float hp = hacc[i][hb] * rsn; LAS float* gp = gT + (i * 8 + g8) * 16 + 8 * hb + p;
                *gp = 0.5f * hp * (1.f + erff(hp * 0.70710678118654752f)) * (1.f / V_SCALE) * *gp; } }
        float ssq[4] = {0.f, 0.f, 0.f, 0.f};
        {
            v4u rA[8], rB[8]; f32x2 y2[8];
#define PS_AXPY(R, i_, hb_) do { const f32x4 aa_ = *(const LAS f32x4*)(gT + ((i_) * 8 + g8) * 16 + 8 * (hb_)), ab_ = *(const LAS f32x4*)(gT + ((i_) * 8 + g8) * 16 + 8 * (hb_) + 4); \
            if ((hb_) == 0) { _Pragma("unroll") for (int q = 0; q < 8; ++q) y2[q] = (f32x2){0.f, 0.f}; } \
            _Pragma("unroll") for (int m = 0; m < 8; ++m) { const float av_ = m < 4 ? aa_[m & 3] : ab_[m & 3]; axpy16p(R[m], (f32x2){av_, av_}, y2); } asm volatile("" ::: "memory"); } while (0)
#define PS_FIN(s_, i_) do { f32x2 ysel_ = {0.f, 0.f}; _Pragma("unroll") for (int q = 0; q < 8; ++q) { const float a_ = xsum_g8(y2[q].x), b_ = xsum_g8(y2[q].y); if (g8 == q) ysel_ = (f32x2){a_, b_}; } \
            const int d_ = 128 * PS_SG(s_) + 16 * p + 2 * g8; const unsigned hb_ = *(const unsigned*)(HB + (size_t)(t0 + (i_)) * DM + d_); const f32x2 hv_ = (f32x2){bflo(hb_), bfhi(hb_)} + ysel_; \
            *(LAS unsigned*)(h2T + (i_) * DM + d_) = pk2(hv_.x, hv_.y); ssq[i_] += hv_.x * hv_.x + hv_.y * hv_.y; } while (0)
            PS_ISSUE(rA, VB, 0, 0, 0);
            for (int s = 0; s < 16; ++s) {
                PS_ISSUE(rB, VB, s, 0, 1); PS_AXPY(rA, 0, 0);
                PS_ISSUE(rA, VB, s, 1, 0); PS_AXPY(rB, 0, 1); PS_FIN(s, 0);
                PS_ISSUE(rB, VB, s, 1, 1); PS_AXPY(rA, 1, 0);
                PS_ISSUE(rA, VB, s, 2, 0); PS_AXPY(rB, 1, 1); PS_FIN(s, 1);
                PS_ISSUE(rB, VB, s, 2, 1); PS_AXPY(rA, 2, 0);
                PS_ISSUE(rA, VB, s, 3, 0); PS_AXPY(rB, 2, 1); PS_FIN(s, 2);
                PS_ISSUE(rB, VB, s, 3, 1); PS_AXPY(rA, 3, 0);
                if (s + 1 < 16) PS_ISSUE(rA, VB, s + 1, 0, 0); PS_AXPY(rB, 3, 1); PS_FIN(s, 3);
            }
#undef PS_AXPY
#undef PS_FIN
#undef PS_ISSUE
#undef PS_SG
        }
        { f32x4 fg[8];
#pragma unroll
          for (int j = 0; j < 8; ++j) fg[j] = *(const f32x4*)(P.final_g + 4 * lane + 256 * j);
#pragma unroll
          for (int i = 0; i < 4; ++i) { const float rs2 = 1.0f / sqrtf(wave_sum(ssq[i]) * (1.f / DM) + RMS_EPS);
#pragma unroll
            for (int j = 0; j < 8; ++j) { const v2u hv = *(const LAS v2u*)(h2T + i * DM + 4 * lane + 256 * j);
                *(f32x4*)(P.out + (size_t)(t0 + i) * DM + 4 * lane + 256 * j) = (f32x4){bflo(hv.x) * rs2 * fg[j].x, bfhi(hv.x) * rs2 * fg[j].y, bflo(hv.y) * rs2 * fg[j].z, bfhi(hv.y) * rs2 * fg[j].w}; } } }
        asm volatile("" ::: "memory");
    }
}
namespace moba {
constexpr float SCALE = 0.08838834764831845f;
constexpr float THR = 8.f;
constexpr bool WSKIP = false;
constexpr int D = 128, NW = 8, QBLK = 32, KVBLK = 64, QB = NW * QBLK;
constexpr int SHM_V = KVBLK * D * 2, SHM_K = KVBLK * D * 2;
constexpr int ATT_LDS_BYTES = 2 * SHM_V + 2 * SHM_K + NW * 64 * 4;
constexpr int KPITCH = INCP, QPITCH = INCP, OPITCH = DM;
typedef unsigned short bf16;
typedef short bf16x8 __attribute__((ext_vector_type(8)));
typedef short s16x4 __attribute__((ext_vector_type(4)));
typedef float f32x16 __attribute__((ext_vector_type(16)));
typedef float f32x4 __attribute__((ext_vector_type(4)));
typedef unsigned u32x4 __attribute__((ext_vector_type(4)));
template <class A, class Bt> struct same_t { static constexpr bool v = false; };
template <class A> struct same_t<A, A> { static constexpr bool v = true; };
#define KSWZ(row, colB) ((row) * 256 + ((colB) ^ (((row) & 7) << 4)))
#define SBAR() __builtin_amdgcn_sched_barrier(0)
__device__ __forceinline__ int v_st(int k, int c) { const int kk = (k & ~0xC) | ((k & 4) << 1) | ((k & 8) >> 1); return ((kk >> 3) * 4 + (c >> 5)) * 512 + ((kk & 7) * 32 + (c & 31)) * 2; }
__device__ __forceinline__ int v_rd_base(int lane) { return ((lane & 3) << 3) | (((lane >> 2) & 3) << 6) | (((lane >> 4) & 1) << 5) | (((lane >> 5) & 1) << 8); }
constexpr int v_rd_off(int d0, int ks, int half) { return d0 * 512 + ks * 4096 + half * 2048; }
__device__ __forceinline__ int crow(int r, int hi) { return (r & 3) + 8 * (r >> 2) + 4 * hi; }
__device__ __forceinline__ unsigned cvtpk(float lo, float hi) {
    unsigned r; asm volatile("v_cvt_pk_bf16_f32 %0, %1, %2" : "=v"(r) : "v"(lo), "v"(hi)); return r;
}
__device__ __forceinline__ bf16x8 pack8(f32x4 a, f32x4 b) {
    u32x4 w = {cvtpk(a[0], a[1]), cvtpk(a[2], a[3]), cvtpk(b[0], b[1]), cvtpk(b[2], b[3])};
    return *reinterpret_cast<bf16x8*>(&w);
}
template <class T> __device__ __forceinline__ bf16x8 load8(const T* p) {
    if constexpr (same_t<T, float>::v) { return pack8(*(const f32x4*)p, *(const f32x4*)(p + 4)); }
    else { return *reinterpret_cast<const bf16x8*>(p); }
}
__device__ __forceinline__ void mask_tile(f32x16& p0, f32x16& p1, int dq, unsigned W) {
    const float NEG = -__builtin_inff();
#pragma unroll
    for (int r = 0; r < 16; ++r) {
        const int c = (r & 3) + 8 * (r >> 2);
        if ((unsigned)(dq - c) >= W) p0[r] = NEG;
        if ((unsigned)(dq - c - 32) >= W) p1[r] = NEG;
    }
}
__device__ __forceinline__ void partialSM(f32x16& p0, f32x16& p1, float& m_reg, float& mn, float& alpha, float base0, float base1) {
    float pm0 = p0[0]; for (int r = 1; r < 16; ++r) pm0 = fmaxf(pm0, p0[r]); float pm1 = p1[0]; for (int r = 1; r < 16; ++r) pm1 = fmaxf(pm1, p1[r]);
    float pmax = fmaxf(pm0 + base0, pm1 + base1);
    { auto rr = __builtin_amdgcn_permlane32_swap(__float_as_uint(pmax), __float_as_uint(pmax), false, false);
      pmax = fmaxf(__uint_as_float(rr[0]), __uint_as_float(rr[1])); }
    constexpr float C2 = 1.4426950408889634f * SCALE;
    if (__builtin_expect(__all((pmax - m_reg) * SCALE <= THR), 1)) { mn = m_reg; alpha = 1.f; }
    else { mn = fmaxf(m_reg, pmax); alpha = __builtin_amdgcn_exp2f((m_reg - mn) * C2); m_reg = mn; }
    const float mnL0 = (base0 - mn) * C2, mnL1 = (base1 - mn) * C2;
    for (int r = 0; r < 16; ++r) p0[r] = fmaf(p0[r], C2, mnL0); for (int r = 0; r < 16; ++r) p1[r] = fmaf(p1[r], C2, mnL1);
    for (int r = 0; r < 16; ++r) p0[r] = __builtin_amdgcn_exp2f(p0[r]);
}
__device__ __forceinline__ void finishSM(f32x16& p0, f32x16& p1, float alpha, float& l_reg, bf16x8& pa0, bf16x8& pa1, bf16x8& pa2, bf16x8& pa3) {
    for (int r = 0; r < 16; ++r) p1[r] = __builtin_amdgcn_exp2f(p1[r]);
    float ps = 0; for (int r = 0; r < 16; ++r) ps += p0[r]; for (int r = 0; r < 16; ++r) ps += p1[r];
    { auto rr = __builtin_amdgcn_permlane32_swap(__float_as_uint(ps), __float_as_uint(ps), false, false);
      ps = __uint_as_float(rr[0]) + __uint_as_float(rr[1]); }
    l_reg = l_reg * alpha + ps;
#define PK4(P, B_, OUT) do { unsigned a0 = cvtpk(P[B_+0], P[B_+1]), a1 = cvtpk(P[B_+2], P[B_+3]);                          \
        unsigned b0 = cvtpk(P[B_+4], P[B_+5]), b1 = cvtpk(P[B_+6], P[B_+7]);                                             \
        auto r0 = __builtin_amdgcn_permlane32_swap(a0, b0, false, false); auto r1 = __builtin_amdgcn_permlane32_swap(a1, b1, false, false); \
        u32x4 w = {r0[0], r1[0], r0[1], r1[1]}; OUT = *reinterpret_cast<bf16x8*>(&w); } while (0)
    PK4(p0, 0, pa0); PK4(p0, 8, pa1); PK4(p1, 0, pa2); PK4(p1, 8, pa3);
#undef PK4
}
template <int KB, bool SK>
__device__ __forceinline__ void qkt(f32x16& p0, f32x16& p1, const char* K_lds, int r32, int hi, const bf16x8* qr, bool act) {
    if (SK && !act) { const float NEG = -__builtin_inff();
#pragma unroll
        for (int r = 0; r < 16; ++r) { p0[r] = NEG; p1[r] = NEG; } return; }
    p0 = f32x16{}; p1 = f32x16{};
    const char* kb[4];
#pragma unroll
    for (int dd = 0; dd < 4; ++dd) kb[dd] = K_lds + KB * SHM_K + KSWZ(r32, (dd * 16 + hi * 8) * 2);
#pragma unroll
    for (int d0 = 0; d0 < 8; ++d0) { const char* a = kb[d0 & 3] + (d0 >> 2) * 128;
        bf16x8 b0 = *reinterpret_cast<const bf16x8*>(a);
        bf16x8 b1 = *reinterpret_cast<const bf16x8*>(a + 32 * 256);
        p0 = __builtin_amdgcn_mfma_f32_32x32x16_bf16(b0, qr[d0], p0, 0, 0, 0);
        p1 = __builtin_amdgcn_mfma_f32_32x32x16_bf16(b1, qr[d0], p1, 0, 0, 0); }
}
template <int VB, bool SK>
__device__ __forceinline__ void pv_tile(f32x16* o, int vb0, bf16x8 pa0, bf16x8 pa1, bf16x8 pa2, bf16x8 pa3, bool act) {
    if (SK && !act) return;
#define TRRD(dst, off) asm volatile("ds_read_b64_tr_b16 %0, %1 offset:%2" : "=&v"(dst) : "v"(vb0), "i"(off) : "memory")
#define PV_D0(d0) do { s16x4 l0, l1, h0, h1; constexpr int b_ = VB * SHM_V + v_rd_off(d0, 0, 0);     \
        TRRD(l0, b_); TRRD(h0, b_ + 2048); TRRD(l1, b_ + 4096); TRRD(h1, b_ + 6144); \
        asm volatile("s_waitcnt lgkmcnt(0)" ::: "memory"); SBAR();                 \
        o[d0] = __builtin_amdgcn_mfma_f32_32x32x16_bf16(pa0, (bf16x8){l0[0], l0[1], l0[2], l0[3], h0[0], h0[1], h0[2], h0[3]}, o[d0], 0, 0, 0);   \
        o[d0] = __builtin_amdgcn_mfma_f32_32x32x16_bf16(pa1, (bf16x8){l1[0], l1[1], l1[2], l1[3], h1[0], h1[1], h1[2], h1[3]}, o[d0], 0, 0, 0);   \
        SBAR(); TRRD(l0, b_ + 8192); TRRD(h0, b_ + 10240); TRRD(l1, b_ + 12288); TRRD(h1, b_ + 14336); \
        asm volatile("s_waitcnt lgkmcnt(0)" ::: "memory"); SBAR();   \
        o[d0] = __builtin_amdgcn_mfma_f32_32x32x16_bf16(pa2, (bf16x8){l0[0], l0[1], l0[2], l0[3], h0[0], h0[1], h0[2], h0[3]}, o[d0], 0, 0, 0);   \
        o[d0] = __builtin_amdgcn_mfma_f32_32x32x16_bf16(pa3, (bf16x8){l1[0], l1[1], l1[2], l1[3], h1[0], h1[1], h1[2], h1[3]}, o[d0], 0, 0, 0); } while (0)
    PV_D0(0); PV_D0(1); PV_D0(2); PV_D0(3);
#undef PV_D0
#undef TRRD
}

template <class TIn, class TOut> struct BlockRef { const TIn* Q; const TIn* K; const TIn* V; TOut* O; int P0; const float* KM; float A; int jlo, jhi; float* ST; };
template <class TIn> struct Seam {
    bf16x8 qr[8];
    bf16x8 st_v0, st_v1, st_k0, st_k1; f32x4 sf0, sf1, sf2, sf3;
    f32x4 tq[16];
};
__device__ __forceinline__ int swa_jlo(int P0, int W) { const int lowk = P0 - W + 1; return lowk > 0 ? lowk / KVBLK : 0; }
#define ROW(p, k0, rr) ((p) + (size_t)((k0) + (rr)) * KPITCH + sc)
#define VMW() asm volatile("s_waitcnt vmcnt(0)" ::: "memory")
#define VMWN(n) asm volatile("s_waitcnt vmcnt(%0)" :: "i"(n) : "memory")
#define SLOAD_H(Kp, Vp, k0) do { S.st_v0 = load8<TIn>(ROW(Vp, k0, sr)); S.st_v1 = load8<TIn>(ROW(Vp, k0, 32 + sr));              \
                         S.st_k0 = load8<TIn>(ROW(Kp, k0, sr)); S.st_k1 = load8<TIn>(ROW(Kp, k0, 32 + sr)); } while (0)
#define SWRITE_HK(bf) do { *(bf16x8*)(K_lds + (bf) * SHM_K + kws) = S.st_k0; *(bf16x8*)(K_lds + (bf) * SHM_K + kws + 32 * 256) = S.st_k1; } while (0)
#define SWRITE_HV(bf) do { *(bf16x8*)(V_lds + (bf) * SHM_V + vst0) = S.st_v0; *(bf16x8*)(V_lds + (bf) * SHM_V + vst1) = S.st_v1; } while (0)
#define SWRITE_H(bf) do { SWRITE_HV(bf); SWRITE_HK(bf); } while (0)
#define SLOAD_F(p, k0) do { S.sf0 = *(const f32x4*)ROW(p, k0, sr); S.sf1 = *(const f32x4*)(ROW(p, k0, sr) + 4);                \
                            S.sf2 = *(const f32x4*)ROW(p, k0, 32 + sr); S.sf3 = *(const f32x4*)(ROW(p, k0, 32 + sr) + 4); } while (0)
#define SWRITE_KF(bf) do { *(bf16x8*)(K_lds + (bf) * SHM_K + kws) = pack8(S.sf0, S.sf1); *(bf16x8*)(K_lds + (bf) * SHM_K + kws + 32 * 256) = pack8(S.sf2, S.sf3); } while (0)
#define SWRITE_VF(bf) do { *(bf16x8*)(V_lds + (bf) * SHM_V + vst0) = pack8(S.sf0, S.sf1); *(bf16x8*)(V_lds + (bf) * SHM_V + vst1) = pack8(S.sf2, S.sf3); } while (0)
template <class TIn, class TOut>
__device__ __forceinline__ void causal_swa_prime(const BlockRef<TIn, TOut>& cur, int W, char* lds, Seam<TIn>& S) {
    constexpr bool F32 = same_t<TIn, float>::v;
    const int tid = ltid(), wid = __builtin_amdgcn_readfirstlane(tid >> 6), lane = tid & 63, r32 = lane & 31, hi = lane >> 5;
    const int sr = tid >> 4, sc = (tid & 15) * 8, kws = KSWZ(sr, sc * 2); char* K_lds = lds + 2 * SHM_V;
    const int kb0 = cur.jlo * KVBLK;
    for (int d0 = 0; d0 < 8; ++d0) S.qr[d0] = load8<TIn>(cur.Q + (size_t)(wid * QBLK + r32) * QPITCH + d0 * 16 + hi * 8);
    if constexpr (F32) { SLOAD_F((const float*)cur.K, kb0); VMW(); SWRITE_KF(0); SBAR(); SLOAD_F((const float*)cur.V, kb0); }
    else { SLOAD_H(cur.K, cur.V, kb0); VMW(); SWRITE_HK(0); }
    __syncthreads();
}
template <class TIn, class TOut>
__device__ __forceinline__ void causal_swa_block(const BlockRef<TIn, TOut>& cur, const BlockRef<TIn, TOut>& nxt, int skv, int W, char* lds, Seam<TIn>& S) {
    constexpr bool F32 = same_t<TIn, float>::v;
    const int tid = ltid(), wid = __builtin_amdgcn_readfirstlane(tid >> 6), lane = tid & 63, r32 = lane & 31, hi = lane >> 5;
    const int j_lo = cur.jlo, j_hi = cur.jhi;
    const int NT = j_hi - j_lo;
    const int kbn = nxt.jlo * KVBLK;
    const int qlo = cur.P0 + wid * QBLK, qm = qlo + r32 - 4 * hi;
    char* V_lds = lds; char* K_lds = lds + 2 * SHM_V;
    float* ws = (float*)(lds + 2 * SHM_V + 2 * SHM_K) + wid * 64; float* li_l = ws, * al_l = ws + 32;
    float m_reg = -1e30f, l_reg = 0; f32x16 o[4] = {};
    const int sr = tid >> 4, sc = (tid & 15) * 8, vst0 = v_st(sr, sc), vst1 = v_st(32 + sr, sc), kws = KSWZ(sr, sc * 2);
    const int vb0 = (int)(uintptr_t)V_lds + v_rd_base(lane);
    const TIn* Kh = cur.K; const TIn* Vh = cur.V;
    const float alA_ = cur.A;
    unsigned selm = 0u;
    { const int qb_ = cur.P0 >> 8;
      if (qb_ > 0) {
        float* kmL = (float*)(K_lds + SHM_K);
        *(f32x4*)(kmL + 4 * tid) = *(const f32x4*)(cur.KM + (size_t)(tid >> 5) * 1024 + 4 * (tid & 31));
        __syncthreads();
        float g[16];
#pragma unroll
        for (int n = 0; n < 16; ++n) g[n] = 0.f;
#pragma unroll
        for (int d0 = 0; d0 < 8; ++d0) { float qf[8];
#pragma unroll
            for (int j = 0; j < 8; ++j) qf[j] = __uint_as_float(((unsigned)(unsigned short)S.qr[d0][j]) << 16);
#pragma unroll
            for (int n = 0; n < 16; ++n) if (n < qb_) { const f32x4 k0 = *(const f32x4*)(kmL + n * 128 + d0 * 16 + hi * 8), k1 = *(const f32x4*)(kmL + n * 128 + d0 * 16 + hi * 8 + 4);
                g[n] += qf[0] * k0[0] + qf[1] * k0[1] + qf[2] * k0[2] + qf[3] * k0[3] + qf[4] * k1[0] + qf[5] * k1[1] + qf[6] * k1[2] + qf[7] * k1[3]; }
            asm volatile("" ::: "memory"); }
#pragma unroll
        for (int n = 0; n < 16; ++n) { const float a = g[n] + __shfl_xor(g[n], 32); g[n] = n < qb_ ? a : -1e30f; }
#pragma unroll
        for (int r = 0; r < 3; ++r) { float best = -3e38f; int bi = 0;
#pragma unroll
            for (int n = 0; n < 16; ++n) if (!((selm >> n) & 1u) && g[n] > best) { best = g[n]; bi = n; }
            selm |= 1u << bi; }
        selm &= (1u << qb_) - 1u;
        __syncthreads();
      }
      li_l[r32] = __uint_as_float(selm); }
#define RESC(a) do { if (__any((a) < 1.f)) { if (hi == 0) al_l[r32] = (a); asm volatile("s_waitcnt lgkmcnt(0)" ::: "memory");              \
                     for (int d_ = 0; d_ < 4; ++d_) for (int r = 0; r < 16; ++r) o[d_][r] *= al_l[crow(r, hi)]; } } while (0)
#define KBASE(t) ((j_lo + (t)) * KVBLK)
#define ACT(t) (KBASE(t) <= qlo + QBLK - 1 && KBASE(t) + KVBLK - 1 >= qlo - W + 1)
#define MASKT(P0_, P1_, t) do { const int kb_ = KBASE(t); if ((!SK || ACT(t)) && (kb_ + KVBLK - 1 > qlo || kb_ <= qlo + QBLK - 1 - W)) mask_tile(P0_, P1_, qm - kb_, (unsigned)W); \
        _Pragma("unroll") for (int r = 0; r < 16; ++r) { const float c_ = (float)((r & 3) + 8 * (r >> 2)); P0_[r] = fmaf(alA_, c_, P0_[r]); P1_[r] = fmaf(alA_, c_, P1_[r]); } } while (0)
#define BASE0(t) ((KBASE(t) < cur.P0 && !((__float_as_uint(li_l[r32]) >> (KBASE(t) >> 8)) & 1u)) ? -__builtin_inff() : alA_ * (float)(KBASE(t) - cur.P0 + 4 * hi))
#define BASE1(t) (BASE0(t) + 32.f * alA_)
    constexpr int NQL = F32 ? 16 : 8;
    constexpr bool SK = WSKIP && !F32;
#define SEAM_K0() do { VMWN(NQL); if constexpr (F32) { SWRITE_KF(0); SBAR(); SLOAD_F((const float*)nxt.V, kbn); } else { SWRITE_HK(0); } SBAR(); } while (0)
    f32x16 pA0, pA1, pB0, pB1; float mnA, mnB, alA, alB; bf16x8 pa0, pa1, pa2, pa3;
    if constexpr (F32) { VMW(); SWRITE_VF(0); SBAR(); } else { SWRITE_HV(0); SBAR(); }
    if (NT > 1) { if constexpr (F32) SLOAD_F((const float*)Kh, KBASE(1)); else SLOAD_H(Kh, Vh, KBASE(1)); }
    SBAR(); qkt<0, SK>(pA0, pA1, K_lds, r32, hi, S.qr, ACT(0));
    if constexpr (F32) { if (NT > 1) { VMW(); SWRITE_KF(1); SBAR(); SLOAD_F((const float*)Vh, KBASE(1)); } }
    MASKT(pA0, pA1, 0); partialSM(pA0, pA1, m_reg, mnA, alA, BASE0(0), BASE1(0));
    if (NT > 1) { VMW(); if constexpr (F32) { SWRITE_VF(1); SBAR(); if (NT > 2) SLOAD_F((const float*)Kh, KBASE(2)); } else SWRITE_H(1); }
    __syncthreads();
#define HALF_STEP(PX0, PX1, mnX, alX, PY0, PY1, alY, t, KB, VB, SB) do {                                                      \
        SBAR(); qkt<KB, SK>(PX0, PX1, K_lds, r32, hi, S.qr, ACT(t));                                             \
        finishSM(PY0, PY1, alY, l_reg, pa0, pa1, pa2, pa3); SBAR();                                                           \
        if ((t) + 1 < NT) { if constexpr (F32) { VMW(); SWRITE_KF(SB); SBAR(); SLOAD_F((const float*)Vh, KBASE((t) + 1)); }  \
                            else { SLOAD_H(Kh, Vh, KBASE((t) + 1)); } SBAR(); }                                               \
        pv_tile<VB, SK>(o, vb0, pa0, pa1, pa2, pa3, ACT((t) - 1)); MASKT(PX0, PX1, (t)); partialSM(PX0, PX1, m_reg, mnX, alX, BASE0(t), BASE1(t));                                        \
        __syncthreads();                                                                                                      \
        if ((t) + 1 < NT) { VMW(); if constexpr (F32) { SWRITE_VF(SB); SBAR(); if ((t) + 2 < NT) SLOAD_F((const float*)Kh, KBASE((t) + 2)); } \
                            else { SWRITE_H(SB); } }                                                                          \
        RESC(alX); __syncthreads(); } while (0)
    for (int t = 1; t + 1 < NT; t += 2) {
        HALF_STEP(pB0, pB1, mnB, alB, pA0, pA1, alA, t, 1, 0, 0);
        HALF_STEP(pA0, pA1, mnA, alA, pB0, pB1, alB, t + 1, 0, 1, 1);
    }
    const bool even = (NT & 1) == 0;
    if (even) { SBAR(); qkt<1, SK>(pB0, pB1, K_lds, r32, hi, S.qr, ACT(NT - 1)); SBAR(); }
#define QROW(e) (nxt.Q + (size_t)(wid * QBLK + r32) * QPITCH + ((e) >> 1) * 16 + hi * 8 + ((e) & 1) * 4)
    if constexpr (F32) { SLOAD_F((const float*)nxt.K, kbn); SBAR();
#pragma unroll
        for (int e = 0; e < 8; ++e) S.tq[e] = *(const f32x4*)QROW(e); }
    else { SLOAD_H(nxt.K, nxt.V, kbn); SBAR();
#pragma unroll
        for (int d0 = 0; d0 < 8; ++d0) S.qr[d0] = load8<TIn>(nxt.Q + (size_t)(wid * QBLK + r32) * QPITCH + d0 * 16 + hi * 8); }
    SBAR();
    finishSM(pA0, pA1, alA, l_reg, pa0, pa1, pa2, pa3); SBAR();
    if constexpr (F32) {
#pragma unroll
        for (int e = 8; e < 16; ++e) S.tq[e] = *(const f32x4*)QROW(e); SBAR(); }
#undef QROW
    pv_tile<0, SK>(o, vb0, pa0, pa1, pa2, pa3, ACT(even ? NT - 2 : NT - 1));
    if (even) { MASKT(pB0, pB1, NT - 1); partialSM(pB0, pB1, m_reg, mnB, alB, BASE0(NT - 1), BASE1(NT - 1)); __syncthreads(); RESC(alB);
        finishSM(pB0, pB1, alB, l_reg, pa0, pa1, pa2, pa3); SBAR(); pv_tile<1, SK>(o, vb0, pa0, pa1, pa2, pa3, ACT(NT - 1)); }
    SBAR(); SEAM_K0();
    if (hi == 0) { li_l[r32] = l_reg; if (cur.ST) { cur.ST[(wid * QBLK + r32) * 16] = m_reg; cur.ST[(wid * QBLK + r32) * 16 + 1] = l_reg; } }
    asm volatile("s_waitcnt lgkmcnt(0)" ::: "memory");
    float rli[16];
#pragma unroll
    for (int r = 0; r < 16; ++r) { const float l_ = li_l[crow(r, hi)]; rli[r] = l_ > 0.f ? __builtin_amdgcn_rcpf(l_) : 0.f; }
    TOut* Ow = cur.O + (size_t)(wid * QBLK) * OPITCH;
#pragma unroll
    for (int r = 0; r < 16; ++r) { const int orow = crow(r, hi);
#pragma unroll
        for (int d0 = 0; d0 < 4; ++d0) { const float v = o[d0][r] * rli[r];
            if constexpr (same_t<TOut, float>::v) { Ow[(size_t)orow * OPITCH + d0 * 32 + r32] = v; }
            else { const float vn = __shfl_xor(v, 1);
                   if ((r32 & 1) == 0) *(unsigned*)(Ow + (size_t)orow * OPITCH + d0 * 32 + r32) = cvtpk(v, vn); } } }
    if constexpr (F32) {
#pragma unroll
        for (int d0 = 0; d0 < 8; ++d0) S.qr[d0] = pack8(S.tq[2 * d0], S.tq[2 * d0 + 1]); }
    __syncthreads();
#undef RESC
#undef KBASE
#undef ACT
#undef MASKT
#undef SEAM_K0
#undef HALF_STEP
}
#undef ROW
#undef VMW
#undef VMWN
#undef SLOAD_H
#undef SWRITE_HK
#undef SWRITE_HV
#undef SWRITE_H
#undef SLOAD_F
#undef SWRITE_KF
#undef SWRITE_VF

#undef BASE0
#undef BASE1
}
constexpr size_t WS_OSL = WS_XN, WS_OSU = WS_H;
constexpr size_t WS_STL = WS_WIN, WS_STU = WS_WIN + 1 * MiB;
constexpr int MOBA_SPLIT_QB = 9, MOBA_SPLIT_AT = 38;
__device__ __forceinline__ void phase_moba(KP P, char* lds, int vcu, int G) {
    typedef moba::BlockRef<moba::bf16, moba::bf16> BR;
    const moba::bf16* proj = (const moba::bf16*)(P.ws + WS_PROJ); moba::bf16* AR = (moba::bf16*)(P.ws + WS_AR); const float* kmean = (const float*)(P.ws + WS_KMEAN);
    constexpr int W = 1 << 30;
    auto mkref = [&](int bh, int qb, int part) -> BR { const int b = bh >> 3, h = bh & 7; BR r; const int nt = 4 * qb + 4;
        r.Q = proj + (size_t)(b * SEQ + qb * 256) * INCP + h * 128; r.K = proj + (size_t)(b * SEQ) * INCP + C_AK + h * 128; r.V = proj + (size_t)(b * SEQ) * INCP + C_AV + h * 128;
        moba::bf16* ob = part == 0 ? AR : (moba::bf16*)(P.ws + (part == 1 ? WS_OSL : WS_OSU));
        r.O = ob + (size_t)(b * SEQ + qb * 256) * DM + h * 128; r.P0 = qb * 256; r.KM = kmean + (size_t)(b * 16) * 1024 + h * 128; r.A = exp2f(-(float)(h + 1)) * (1.f / moba::SCALE);
        const int ks = qb == MOBA_SPLIT_QB ? nt - 4 : MOBA_SPLIT_AT;
        r.jlo = part == 2 ? ks : 0; r.jhi = part == 1 ? ks : nt;
        r.ST = part == 0 ? nullptr : (float*)(P.ws + (part == 1 ? WS_STL : WS_STU)) + ((size_t)(b * SEQ + qb * 256) * 8 + h) * 2;
        return r; };
    moba::Seam<moba::bf16> S;
    if (G == 256) {
        const int q_ = vcu & 15, bh = vcu >> 4;
        const int qbA[16] = { 1,  0,  7,  6,  5,  4,  3,  2, 15, 14, 13, 12, 11, 10,  9,  8};
        const int ptA[16] = { 0,  0,  0,  0,  0,  0,  0,  0,  1,  1,  1,  1,  1,  1,  1,  0};
        const int qbB[16] = {-1,  9, 10, 11, 12, 13, 14, 15, -1, -1, -1, -1, -1, -1, -1, -1};
        const int ptB[16] = { 0,  2,  2,  2,  2,  2,  2,  2,  0,  0,  0,  0,  0,  0,  0,  0};
        int qa = -1, pa = 0, qb2 = -1, pb = 0;
#pragma unroll
        for (int k = 0; k < 16; ++k) if (k == q_) { qa = qbA[k]; pa = ptA[k]; qb2 = qbB[k]; pb = ptB[k]; }
        for (int it = 0; it < 2; ++it) { const int qq = it == 0 ? qa : qb2, pp = it == 0 ? pa : pb; if (qq < 0) continue;
            const BR cur = mkref(bh, qq, pp);
            moba::causal_swa_prime<moba::bf16, moba::bf16>(cur, W, lds, S);
            moba::causal_swa_block<moba::bf16, moba::bf16>(cur, cur, SEQ, W, lds, S); }
    } else {
        for (int item = vcu; item < 256; item += G) {
            const BR cur = mkref(item >> 4, item & 15, 0);
            moba::causal_swa_prime<moba::bf16, moba::bf16>(cur, W, lds, S);
            moba::causal_swa_block<moba::bf16, moba::bf16>(cur, cur, SEQ, W, lds, S); }
    }
}
__device__ __forceinline__ void moba_combine(KP P, int vcu, int G) {
    if (G != 256) return;
    const int tid = ltid(); const bf16* OL = (const bf16*)(P.ws + WS_OSL); const bf16* OU = (const bf16*)(P.ws + WS_OSU); bf16* AR = (bf16*)(P.ws + WS_AR);
    const float* STL = (const float*)(P.ws + WS_STL); const float* STU = (const float*)(P.ws + WS_STU);
    constexpr int NSPL = 16 - MOBA_SPLIT_QB; constexpr float C2 = 1.4426950408889634f * moba::SCALE;
    for (int item = vcu; item < 16 * NSPL * 2; item += G) {
        const int half = item & 1, k = item >> 1, bh = k / NSPL, qb = MOBA_SPLIT_QB + k % NSPL, b = bh >> 3, h = bh & 7;
        const int row = b * SEQ + qb * 256 + half * 128 + (tid >> 2), c0 = (tid & 3) * 32;
        const size_t so = ((size_t)row * 8 + h) * 2; const float mL = STL[so], lL = STL[so + 1], mU = STU[so], lU = STU[so + 1];
        const float m = fmaxf(mL, mU); const float wL = lL * __builtin_amdgcn_exp2f((mL - m) * C2), wU = lU * __builtin_amdgcn_exp2f((mU - m) * C2); const float inv = __builtin_amdgcn_rcpf(wL + wU);
        const float aL = wL * inv, aU = wU * inv; const size_t o = (size_t)row * DM + h * 128 + c0;
        v4u l4[4], u4[4];
#pragma unroll
        for (int j = 0; j < 4; ++j) { l4[j] = *(const v4u*)(OL + o + 8 * j); u4[j] = *(const v4u*)(OU + o + 8 * j); }
#pragma unroll
        for (int j = 0; j < 4; ++j) { v4u r4;
#pragma unroll
            for (int e = 0; e < 4; ++e) r4[e] = pk2(aL * bflo(l4[j][e]) + aU * bflo(u4[j][e]), aL * bfhi(l4[j][e]) + aU * bfhi(u4[j][e]));
            *(v4u*)(AR + o + 8 * j) = r4; }
    }
}
constexpr size_t WS_SKB = WS_KMEAN + 256 * 1024;
__device__ __forceinline__ void prologue_subkeys(KP P, int vcu, int G) {
    unsigned* dst = (unsigned*)(P.ws + WS_SKB);
    for (int i = vcu * NTHR + ltid(); i < 8 * 2 * 128 * 128 / 2; i += G * NTHR) dst[i] = pk2(P.sub_keys[2 * i], P.sub_keys[2 * i + 1]);
}
__device__ __forceinline__ unsigned f2key(float v) { const unsigned u = __float_as_uint(v); return u ^ ((u >> 31) ? 0xFFFFFFFFu : 0x80000000u); }
__device__ __forceinline__ float key2f(unsigned k) { return __uint_as_float(k ^ ((k >> 31) ? 0x80000000u : 0xFFFFFFFFu)); }
__device__ __forceinline__ unsigned umax3(unsigned a, unsigned b, unsigned c) { return max(max(a, b), c); }
__device__ __forceinline__ void peer_route_tiles(KP P, LAS unsigned char* lds, int tt0, int nitems, int h) {
    const int tid = ltid(), lane = tid & 63, wave = __builtin_amdgcn_readfirstlane(tid >> 6), l15 = lane & 15, q4 = lane >> 4;
    const bf16* PQ = (const bf16*)(P.ws + WS_PROJ); const bf16* SKB = (const bf16*)(P.ws + WS_SKB);
    int* ridx = (int*)(P.ws + WS_PROJ + 64 * MiB); float* rgate = (float*)(P.ws + WS_PROJ + 68 * MiB);
    for (int it_ = 0; it_ < nitems; ++it_) {
        LAS float* sval = (LAS float*)(lds + it_ * 16384); LAS int* sidx = (LAS int*)(lds + it_ * 16384 + 8192);
        const int tt = tt0 + it_, p = wave & 1, sub = wave >> 1, tl = sub * 16 + l15;
        const bf16* qp = PQ + ((size_t)tt * 64 + tl) * DM + h * 256 + p * 128 + 8 * q4;
        bf16x8 qb[4];
#pragma unroll
        for (int kk = 0; kk < 4; ++kk) qb[kk] = *(const bf16x8*)(qp + 32 * kk);
        const bf16* sk = SKB + ((size_t)((h * 2 + p) * 128 + l15)) * 128 + 8 * q4;
        unsigned key[32];
#pragma unroll
        for (int nt = 0; nt < 8; ++nt) { f32x4v acc = {0.f, 0.f, 0.f, 0.f};
#pragma unroll
            for (int kk = 0; kk < 4; ++kk) acc = __builtin_amdgcn_mfma_f32_16x16x32_bf16(*(const bf16x8*)(sk + nt * 16 * 128 + 32 * kk), qb[kk], acc, 0, 0, 0);
#pragma unroll
            for (int e = 0; e < 4; ++e) key[4 * nt + e] = (f2key(acc[e]) & ~127u) | (unsigned)(127 - (16 * nt + 4 * q4 + e)); }
#define CE(a_, b_) { const unsigned hi_ = max(KA[a_], KA[b_]), lo_ = min(KA[a_], KA[b_]); KA[a_] = hi_; KA[b_] = lo_; }
#define SORT16_NET CE(0,1) CE(2,3) CE(0,2) CE(1,3) CE(1,2) CE(4,5) CE(6,7) CE(4,6) CE(5,7) CE(5,6) CE(0,4) CE(2,6) CE(2,4) CE(1,5) CE(3,7) CE(3,5) CE(1,2) CE(3,4) CE(5,6) CE(8,9) CE(10,11) CE(8,10) CE(9,11) CE(9,10) CE(12,13) CE(14,15) CE(12,14) CE(13,15) CE(13,14) CE(8,12) CE(10,14) CE(10,12) CE(9,13) CE(11,15) CE(11,13) CE(9,10) CE(11,12) CE(13,14) CE(0,8) CE(4,12) CE(4,8) CE(2,10) CE(6,14) CE(6,10) CE(2,4) CE(6,8) CE(10,12) CE(1,9) CE(5,13) CE(5,9) CE(3,11) CE(7,15) CE(7,11) CE(3,5) CE(7,9) CE(11,13) CE(1,2) CE(3,4) CE(5,6) CE(7,8) CE(9,10) CE(11,12) CE(13,14)
#define BMERGE16(T_) _Pragma("unroll") for (int d_ = 8; d_ >= 1; d_ >>= 1) { _Pragma("unroll") for (int i_ = 0; i_ < 16; ++i_) if ((i_ & d_) == 0) { const unsigned hi_ = max(T_[i_], T_[i_ + d_]), lo_ = min(T_[i_], T_[i_ + d_]); T_[i_] = hi_; T_[i_ + d_] = lo_; } }
#define KA key
        SORT16_NET
#undef KA
#define KA (key + 16)
        SORT16_NET
#undef KA
        unsigned t16[16];
#pragma unroll
        for (int i = 0; i < 16; ++i) t16[i] = max(key[i], key[31 - i]);
        BMERGE16(t16)
        { const bool odd = (lane & 16) != 0; unsigned L[16];
#pragma unroll
          for (int i = 0; i < 16; ++i) L[i] = odd ? t16[15 - i] : t16[i];
#pragma unroll
          for (int i = 0; i < 16; ++i) { auto x = __builtin_amdgcn_permlane16_swap(L[i], L[i], false, false); t16[i] = max(x[0], x[1]); }
          BMERGE16(t16) }
        { const bool odd = (lane & 32) != 0; unsigned L[16];
#pragma unroll
          for (int i = 0; i < 16; ++i) L[i] = odd ? t16[15 - i] : t16[i];
#pragma unroll
          for (int i = 0; i < 16; ++i) { auto x = __builtin_amdgcn_permlane32_swap(L[i], L[i], false, false); t16[i] = max(x[0], x[1]); }
          BMERGE16(t16) }
#undef CE
#undef SORT16_NET
#undef BMERGE16
        if (q4 == 0) {
#pragma unroll
            for (int r4 = 0; r4 < 4; ++r4) {
                *(LAS f32x4*)(sval + (tl * 2 + p) * 16 + 4 * r4) = (f32x4){key2f(t16[4 * r4] & ~127u), key2f(t16[4 * r4 + 1] & ~127u), key2f(t16[4 * r4 + 2] & ~127u), key2f(t16[4 * r4 + 3] & ~127u)};
                *(LAS v4u*)(sidx + (tl * 2 + p) * 16 + 4 * r4) = (v4u){127u - (t16[4 * r4] & 127u), 127u - (t16[4 * r4 + 1] & 127u), 127u - (t16[4 * r4 + 2] & 127u), 127u - (t16[4 * r4 + 3] & 127u)}; }
        }
    }
    __syncthreads();
    {
        const int it_ = wave; const int tt = tt0 + it_;
        LAS float* sval = (LAS float*)(lds + it_ * 16384); LAS int* sidx = (LAS int*)(lds + it_ * 16384 + 8192);
        if (wave < nitems) {
            const LAS float* av = sval + (lane * 2) * 16; const LAS float* bv = av + 16; const LAS int* ai = sidx + (lane * 2) * 16; const LAS int* bi = ai + 16;
            unsigned hk[16];
            const float b0 = bv[0];
#pragma unroll
            for (int i4 = 0; i4 < 4; ++i4) { const f32x4 t4 = *(const LAS f32x4*)(av + 4 * i4);
#pragma unroll
                for (int e = 0; e < 4; ++e) hk[4 * i4 + e] = (f2key(t4[e] + b0) & ~255u) | (unsigned)(255 - (4 * i4 + e) * 16); }
            float bestv[16]; int beste[16];
#pragma unroll
            for (int r = 0; r < 16; ++r) {
                unsigned m0 = umax3(hk[0], hk[1], hk[2]), m1 = umax3(hk[3], hk[4], hk[5]), m2 = umax3(hk[6], hk[7], hk[8]), m3 = umax3(hk[9], hk[10], hk[11]);
                m0 = umax3(m0, hk[12], hk[13]); m1 = umax3(m1, hk[14], hk[15]);
                const unsigned best = max(max(m0, m1), max(m2, m3));
                const int f = 255 - (int)(best & 255u), bi_ = f >> 4, bj = f & 15;
                const float a_i = av[bi_]; bestv[r] = a_i + bv[bj]; beste[r] = ai[bi_] * 128 + bi[bj];
                const int nj = bj + 1;
                const unsigned nk = nj < 16 ? ((f2key(a_i + bv[nj & 15]) & ~255u) | (unsigned)(255 - (bi_ * 16 + nj))) : 0u;
#pragma unroll
                for (int i = 0; i < 16; ++i) hk[i] = i == bi_ ? nk : hk[i];
            }
            float se = 0.f; const float mx = bestv[0];
#pragma unroll
            for (int r = 0; r < 16; ++r) { bestv[r] = __expf(bestv[r] - mx); se += bestv[r]; }
            const float ise = 1.f / se; const size_t o = ((size_t)tt * 64 + lane) * 128 + h * 16;
#pragma unroll
            for (int r4 = 0; r4 < 4; ++r4) { *(v4u*)(ridx + o + 4 * r4) = (v4u){(unsigned)beste[4 * r4], (unsigned)beste[4 * r4 + 1], (unsigned)beste[4 * r4 + 2], (unsigned)beste[4 * r4 + 3]};
                *(f32x4*)(rgate + o + 4 * r4) = (f32x4){bestv[4 * r4] * ise, bestv[4 * r4 + 1] * ise, bestv[4 * r4 + 2] * ise, bestv[4 * r4 + 3] * ise}; }
        }
        __syncthreads();
    }
}
#define XB_TMO      128
#define XB_XCNT(j)  (256  + 64 * (j))
#define XB_XSUB(j)  (1280 + 64 * (j))
#define XB_XGEN(j)  (2304 + 64 * (j))
#define XB_TOP      3328
#define XB_TOPGEN   3392
#define XCD_BAR_WORDS 3456
#define XB_SPIN_CAP (1u << 18)

__device__ __forceinline__ unsigned xb_ld(unsigned* p)              { return __hip_atomic_load(p, __ATOMIC_RELAXED, __HIP_MEMORY_SCOPE_AGENT); }
__device__ __forceinline__ unsigned xb_add(unsigned* p, unsigned v) { return __hip_atomic_fetch_add(p, v, __ATOMIC_RELAXED, __HIP_MEMORY_SCOPE_AGENT); }
__device__ __forceinline__ unsigned xb_xcc_id() { return (unsigned)__builtin_amdgcn_s_getreg((3 << 11) | 20) & 0xFu; }
#define XB_SPIN(cond, bar) do { unsigned _sp = 0; while (cond) { __builtin_amdgcn_s_sleep(1); \
    if ((++_sp & 255u) == 0u) { if (xb_ld(&(bar)[XB_TMO])) break; if (_sp > XB_SPIN_CAP) { atomicAdd(&(bar)[XB_TMO], 1u); break; } } } } while (0)

struct XcdBarrier {
    unsigned* bar; unsigned x;
    volatile LAS unsigned* st;
};

__device__ __forceinline__ XcdBarrier xcd_barrier_post(unsigned* bar, volatile LAS unsigned* st) {
    XcdBarrier b; b.bar = bar; b.x = xb_xcc_id(); b.st = st;
    if (threadIdx.x == 0) (void)xb_add(&bar[XB_XCNT(b.x)], 1u);
    return b;
}
__device__ __forceinline__ void xcd_barrier_complete(unsigned* bar, unsigned x, unsigned& nloc, unsigned& nx) {
    const unsigned G = gridDim.x * gridDim.y * gridDim.z;
    unsigned sum, cnt, mine, sp = 0u;
    for (;;) {
        sum = 0u; cnt = 0u; mine = 0u;
#pragma unroll
        for (unsigned j = 0; j < 16; ++j) { const unsigned c = xb_ld(&bar[XB_XCNT(j)]); sum += c; cnt += (c > 0u) ? 1u : 0u; mine = (j == x) ? c : mine; }
        if (sum == G) break;
        __builtin_amdgcn_s_sleep(1);
        if ((++sp & 255u) == 0u) { if (xb_ld(&bar[XB_TMO])) break; if (sp > XB_SPIN_CAP) { atomicAdd(&bar[XB_TMO], 1u); break; } }
    }
    nloc = mine > 0u ? mine : 1u; nx = cnt > 0u ? cnt : 1u;
}

__device__ __forceinline__ void xcd_barrier(const XcdBarrier& b) {
    asm volatile("s_waitcnt vmcnt(0)" ::: "memory");
    __syncthreads();
    if (threadIdx.x == 0) {
        unsigned* bar = b.bar;
        __builtin_amdgcn_s_waitcnt(0);
        unsigned nloc = b.st[0], nx = b.st[1];
        if (nloc == 0u) { xcd_barrier_complete(bar, b.x, nloc, nx); b.st[0] = nloc; b.st[1] = nx; }
        const unsigned old = xb_add(&bar[XB_XSUB(b.x)], 1u);
        const unsigned gen = old / nloc;
        if (old + 1u == (gen + 1u) * nloc) {
            __builtin_amdgcn_fence(__ATOMIC_RELEASE, "agent");
            asm volatile("s_waitcnt vmcnt(0)" ::: "memory");
            const unsigned og = xb_add(&bar[XB_TOP], 1u);
            const unsigned tg = og / nx;
            if (og + 1u == (tg + 1u) * nx) xb_add(&bar[XB_TOPGEN], 1u);
            else XB_SPIN(xb_ld(&bar[XB_TOPGEN]) == tg, bar);
            __builtin_amdgcn_fence(__ATOMIC_ACQUIRE, "agent");
            xb_add(&bar[XB_XGEN(b.x)], 1u);
            asm volatile("s_waitcnt vmcnt(0)" ::: "memory");
        } else {
            XB_SPIN(xb_ld(&bar[XB_XGEN(b.x)]) == gen, bar);
            __builtin_amdgcn_fence(__ATOMIC_ACQUIRE, "agent");
            asm volatile("s_waitcnt vmcnt(0)" ::: "memory");
        }
    }
    __syncthreads();
}
#ifndef MK_ONE_LAUNCH
#define MK_ONE_LAUNCH 1
#endif
constexpr int N_PHASES = 11;
__global__ void __launch_bounds__(NTHR, 2) mega(Params Pkernarg) {
    extern __shared__ __attribute__((aligned(16))) unsigned char lds_raw[];
    LAS unsigned char* lds = (LAS unsigned char*)lds_raw;
    const int tid = ltid();
    const int G = gridDim.x, bx = blockIdx.x; const int vcu = (G % 8 == 0) ? (bx % 8) * (G / 8) + bx / 8 : bx;
    for (int u = tid; u < (LDS_BYTES - LDSCTL_OFF) / 4; u += NTHR) ((LAS unsigned*)(lds + LDSCTL_OFF))[u] = 0u;
    __syncthreads();
#if MK_ONE_LAUNCH
    XcdBarrier bar = xcd_barrier_post((unsigned*)(params_ptr()->ws + WS_CTL) + CW_BAR + params_ptr()->bar_li * XCD_BAR_WORDS, (volatile LAS unsigned*)(lds + MISC_OFF) + 8);
#define GRID_BAR() xcd_barrier(bar)
#else
#define GRID_BAR() do {} while (0)
#endif
#ifndef PHOFF
#define PHOFF 0
#endif
#define IN(k) (!((PHOFF >> (k)) & 1))
#define BOTH(k) (IN(k) && IN((k) + 1))
    if (IN(0)) { KP P = *params_ptr(); phase_prologue(P, lds, vcu, G); prologue_subkeys(P, vcu, G); prologue_lora(P, vcu, G); if (BOTH(0)) GRID_BAR(); }
    if (IN(1)) { KP P = *params_ptr();
        pg8::Gemm g{(const bf16*)(P.ws + WS_XN), (const bf16*)(P.ws + WS_WIN), TT, INCP, DM}; pg8::Order1 S; S.init(TT, INCP, G, bx);
        pg8::EpiBf16<0> E{(bf16*)(P.ws + WS_PROJ), INCP, nullptr, 0, 0, 1.f};
        pg8::gemm_phase<pg8::EpiBf16<0>, pg8::Order1, true, true>(lds, g, S, E);
        phase_convert_tables(P, lds); phase_transpose_late(P, lds);
        if (BOTH(1)) GRID_BAR();
    }
    if (IN(2)) { KP P = *params_ptr(); phase_act(P, vcu, G); phase_kmean(P, lds, vcu, G); if (BOTH(2)) GRID_BAR(); }
    if (IN(3)) { KP P = *params_ptr(); phase_rwkv_stage_a(P, lds, vcu, G); if (BOTH(3)) GRID_BAR(); }
    if (IN(4)) { KP P = *params_ptr(); if ((vcu & 15) < 2 && vcu < 256) rwkv_stage_b(P, lds, (vcu >> 4) * 2 + (vcu & 15)); phase_moba(P, (char*)lds_raw, vcu, G); }
    if (IN(5)) { GRID_BAR(); KP P = *params_ptr(); moba_combine(P, vcu, G); GRID_BAR(); }
    if (IN(6)) { KP P = *params_ptr();
        pg8::Gemm g{(const bf16*)(P.ws + WS_AR), (const bf16*)(P.ws + WS_WOUT), TT, DM, DM}; pg8::StaticOrder S; S.init(TT, DM, G, bx);
        pg8::EpiH E{P.x, (bf16*)(P.ws + WS_XN), (float*)(P.ws + WS_SSP), DM};
        pg8::gemm_phase<pg8::EpiH, pg8::StaticOrder, true, true>(lds, g, S, E);
        if (BOTH(6)) GRID_BAR();
    }
    if (IN(8)) { KP P = *params_ptr(); phase_rstd(P, vcu, G); GRID_BAR();
        pg8::Gemm g{(const bf16*)(P.ws + WS_XN), (const bf16*)(P.ws + WS_WQ), TT, DM, DM}; pg8::StaticOrder S; S.init(TT, DM, G, bx);
        pg8::EpiBf16Row E{(bf16*)(P.ws + WS_PROJ), DM, (const float*)(P.ws + WS_SSP + 2 * MiB)};
        pg8::gemm_phase<pg8::EpiBf16Row, pg8::StaticOrder, true, true>(lds, g, S, E);
        if (G == 256) { const int wg_ = (bx & 7) * 32 + (bx >> 3); pg8::Unit u; u.pm = (wg_ >> 6) * 8 + (wg_ & 7); u.pn = (wg_ & 63) >> 3;
            asm volatile("s_waitcnt vmcnt(0)" ::: "memory"); __syncthreads(); __builtin_amdgcn_fence(__ATOMIC_ACQUIRE, "agent"); asm volatile("s_waitcnt vmcnt(0)" ::: "memory");
            peer_route_tiles(P, lds, 4 * u.pm, 4, u.pn);
        } else if (G != 256) { GRID_BAR(); for (int item = vcu; item < 1024; item += G) peer_route_tiles(P, lds, item >> 3, 1, item & 7); }
        if (BOTH(8)) GRID_BAR();
    }
    if (IN(10)) { KP P = *params_ptr(); phase_peer_sliced(P, lds, bx, G); }
#undef IN
#undef BOTH
}

extern "C" void kernel_launch(void* const* d_in, const int* in_sizes, int n_in, void* d_out, int out_size, void* d_ws, size_t ws_size, hipStream_t stream) {
    static int grid = 0;
    if (grid == 0) {
        if (n_in != 21 || in_sizes[0] != TT * DM || out_size != TT * DM || ws_size < WS_END) {
            fprintf(stderr, "kernel_launch: unexpected shapes: n_in %d in0 %d out %d ws %zu\n", n_in, n_in > 0 ? in_sizes[0] : -1, out_size, ws_size); grid = -1; return; }
        int dev = 0, cus = 0;
        if (hipGetDevice(&dev) != hipSuccess || hipDeviceGetAttribute(&cus, hipDeviceAttributeMultiprocessorCount, dev) != hipSuccess) { grid = -1; return; }
        if (hipFuncSetAttribute((const void*)mega, hipFuncAttributeMaxDynamicSharedMemorySize, LDS_BYTES) != hipSuccess) { fprintf(stderr, "kernel_launch: hipFuncSetAttribute failed\n"); grid = -1; return; }
        int per_cu = 0;
        if (hipOccupancyMaxActiveBlocksPerMultiprocessor(&per_cu, (const void*)mega, NTHR, LDS_BYTES) != hipSuccess || per_cu < 1) fprintf(stderr, "kernel_launch: occupancy query says %d blocks per CU\n", per_cu);
        (void)hipGetLastError();
        grid = cus;
    }
    if (grid < 0) return;
    (void)hipMemsetAsync((char*)d_ws + WS_CTL, 0, CTL_ZERO_BYTES, stream);
    Params p{};
    p.x = (const float*)d_in[0]; p.norm1_g = (const float*)d_in[1]; p.w_in = (const float*)d_in[2]; p.mu = (const float*)d_in[3]; p.w0 = (const float*)d_in[4];
    p.w2 = (const float*)d_in[5]; p.a0 = (const float*)d_in[6]; p.a2 = (const float*)d_in[7]; p.g2 = (const float*)d_in[8]; p.k_k = (const float*)d_in[9];
    p.k_a = (const float*)d_in[10]; p.r_k = (const float*)d_in[11]; p.ln_g = (const float*)d_in[12]; p.ln_b = (const float*)d_in[13]; p.w_out = (const float*)d_in[14];
    p.norm2_g = (const float*)d_in[15]; p.wq = (const float*)d_in[16]; p.sub_keys = (const float*)d_in[17]; p.pu = (const float*)d_in[18]; p.pv = (const float*)d_in[19];
    p.final_g = (const float*)d_in[20]; p.out = (float*)d_out; p.ws = (unsigned char*)d_ws;
    p.ph_lo = 0; p.ph_hi = N_PHASES; p.bar_li = 0;
    hipLaunchKernelGGL(mega, dim3(grid), dim3(NTHR), LDS_BYTES, stream, p);
}
```

```cpp
#include <hip/hip_runtime.h>
#include <cstdio>
#include <cstdint>
__device__ __forceinline__ int ltid() { int t = threadIdx.x; asm volatile("" : "+v"(t)); return t; }
namespace pg8 {
#define PG8_LAS __attribute__((address_space(3)))
typedef unsigned short bf16_t;
typedef short bf16x8 __attribute__((ext_vector_type(8)));
typedef float f32x4 __attribute__((ext_vector_type(4)));
typedef unsigned u32x4 __attribute__((ext_vector_type(4)));
constexpr int BM = 256, BK = 64, HALF = 128, HTB = HALF * BK * 2  , STAGE_BYTES = 8 * HTB, NXCD = 8, WGM = 8;

__host__ __device__ __forceinline__ int lds_byte(int r, int c) { const int st = (r >> 4) * 2 + (c >> 5), rr = r & 15, cc = c & 31, ob = rr * 64 + cc * 2; return st * 1024 + (ob ^ (((ob >> 9) & 1) << 5)); }
__host__ __device__ __forceinline__ void stage_rc(int b, int& R, int& C) { const int st = b / 1024, sb = b % 1024, swz = sb ^ (((sb >> 9) & 1) << 5); R = (st >> 1) * 16 + swz / 64; C = (st & 1) * 32 + (swz % 64) / 2; }
__host__ __device__ __forceinline__ int perm32(int rho) { const int n = rho >> 4, i = rho & 15; return 8 * (i >> 2) + 4 * n + (i & 3); }

struct Unit { int pm, pn; };
struct Gemm { const bf16_t* A; const bf16_t* Bt; int M, N, K; };

struct StaticOrder {
    int nM, nN, nwg, G, c;
    __host__ __device__ void init(int M, int N, int G_, int c_) { nM = M / BM; nN = N / BM; nwg = nM * nN; G = G_; c = c_; }
    __host__ __device__ bool next(int i, Unit& u) const {
        const long L = (long)i * G + c; if (L >= nwg) return false;
        int wgid = (int)L; { const int q = nwg / NXCD, r = nwg % NXCD, xcd = wgid % NXCD, off = wgid / NXCD; wgid = (xcd < r ? xcd * (q + 1) : r * (q + 1) + (xcd - r) * q) + off; }
        const int nig = WGM * nN, gid = wgid / nig, fm = gid * WGM, gsz = (nM - fm) < WGM ? (nM - fm) : WGM;
        u.pm = fm + ((wgid % nig) % gsz); u.pn = (wgid % nig) / gsz; return true;
    }
    __device__ __forceinline__ void a_ready(const Unit&) const {}
    __device__ __forceinline__ void done(const Unit&) const {}
};

__device__ __forceinline__ unsigned cvt_pk_bf16(float lo, float hi) { unsigned r; asm volatile("v_cvt_pk_bf16_f32 %0, %1, %2" : "=v"(r) : "v"(lo), "v"(hi)); return r; }
typedef float f32x2 __attribute__((ext_vector_type(2)));
__device__ __forceinline__ f32x2 gelu_pk(f32x2 v) {
    const f32x2 av = __builtin_elementwise_abs(v), d = av * 0.2316418882f + 1.0f;
    f32x2 t; t.x = __builtin_amdgcn_rcpf(d.x); t.y = __builtin_amdgcn_rcpf(d.y);
    f32x2 q = t * 0.5307027145f + (-0.7265760135f); q = q * t + 0.7107068705f; q = q * t + (-0.142248368f); q = q * t + 0.127414796f; q = q * t;
    const f32x2 s = (v * v) * (-0.72134752044f);
    f32x2 e; e.x = __builtin_amdgcn_exp2f(s.x); e.y = __builtin_amdgcn_exp2f(s.y);
    const f32x2 m = v * (q * e), r = v - m;
    f32x2 o; o.x = v.x < 0.f ? m.x : r.x; o.y = v.y < 0.f ? m.y : r.y; return o;
}

template <int ACT  > struct EpiBf16 {
    static constexpr bool PERM = true, AFTER_DRAIN = false; static_assert(ACT == 0 || ACT == 1, "EpiBf16: ACT is 0 (none) or 1 (gelu_pk)");
    bf16_t* O; int ldc; const float* bias; int split_cols; size_t split_stride; float scale0;
    __device__ __forceinline__ void operator()(const f32x4 (&acc)[2][2][4][2], const Unit& u, int wr, int wc, int fr, int fq) const {
        const int row0 = u.pm * BM + wr * 64 + fr; int colt = u.pn * BM; bf16_t* base = O;
        float sc = 1.f; if (split_cols) { const int t = colt / split_cols; base += (size_t)t * split_stride; colt -= t * split_cols; if (t == 0) sc = scale0; }
        const int col0 = colt + wc * 32 + 8 * fq, bcol0 = u.pn * BM + wc * 32 + 8 * fq;
        f32x4 bv[2][2];
#pragma unroll
        for (int bj = 0; bj < 2; ++bj)
#pragma unroll
            for (int n = 0; n < 2; ++n) bv[bj][n] = bias ? *(const f32x4*)(bias + bcol0 + bj * HALF + 4 * n) : (f32x4){0.f, 0.f, 0.f, 0.f};
#pragma unroll
        for (int ai = 0; ai < 2; ++ai)
#pragma unroll
            for (int m = 0; m < 4; ++m) { bf16_t* rowp = base + (size_t)(row0 + ai * HALF + m * 16) * ldc + col0;
#pragma unroll
                for (int bj = 0; bj < 2; ++bj) { f32x4 v0 = acc[ai][bj][m][0] + bv[bj][0], v1 = acc[ai][bj][m][1] + bv[bj][1];
                    if (ACT == 1) { f32x2 a = gelu_pk((f32x2){v0[0], v0[1]}), b = gelu_pk((f32x2){v0[2], v0[3]}), c = gelu_pk((f32x2){v1[0], v1[1]}), d = gelu_pk((f32x2){v1[2], v1[3]});
                        v0 = (f32x4){a.x, a.y, b.x, b.y}; v1 = (f32x4){c.x, c.y, d.x, d.y}; }
                    v0 = v0 * sc; v1 = v1 * sc; u32x4 w; w.x = cvt_pk_bf16(v0[0], v0[1]); w.y = cvt_pk_bf16(v0[2], v0[3]); w.z = cvt_pk_bf16(v1[0], v1[1]); w.w = cvt_pk_bf16(v1[2], v1[3]);
                    *(u32x4*)(rowp + bj * HALF) = w; } }
    }
};
template <class Epi, class Sched, bool ALIGN_EPI = false, bool SP2 = false>
__device__ __forceinline__ void gemm_phase(PG8_LAS unsigned char* lds, const Gemm g, const Sched& S, const Epi& E) {
    const int tid = ltid(), wid = __builtin_amdgcn_readfirstlane(tid >> 6), lane = tid & 63, wr = wid >> 2, wc = wid & 3, fr = lane & 15, fq = lane >> 4;
    const int K = g.K, nt = K / BK;
    unsigned voffA[2], voffB[2];
#pragma unroll
    for (int i = 0; i < 2; ++i) { int R, C; stage_rc(tid * 16 + i * 8192, R, C); const int Rb = Epi::PERM ? ((R & ~31) + perm32(R & 31)) : R;
        voffA[i] = (unsigned)(R * K + C) * 2u; voffB[i] = (unsigned)(Rb * K + C) * 2u; }
    const size_t kstep = (size_t)(BK * 2);
    const size_t hstep = (size_t)HALF * K * 2;
    const size_t tstep = 2 * hstep;
    const unsigned ldsw = (unsigned)wid * 1024u;
    const int aoff = lds_byte(wr * 64 + fr, fq * 8), boff = lds_byte(wc * 32 + fr, fq * 8);
#define PG8_SA(b, h) (((b) * 2 + (h)) * HTB)
#define PG8_SB(b, h) ((4 + (b) * 2 + (h)) * HTB)
#define PG8_STAGE(bufoff, gbase, voff) do { _Pragma("unroll") for (int _i = 0; _i < 2; ++_i) \
        __builtin_amdgcn_global_load_lds((const unsigned*)((const char*)(gbase) + (voff)[_i]), (PG8_LAS unsigned*)(lds + (bufoff) + ldsw + _i * 8192), 16, 0, 0); } while (0)
#define PG8_LDA(dst, b, h) do { _Pragma("unroll") for (int m = 0; m < 4; ++m) _Pragma("unroll") for (int k = 0; k < 2; ++k) dst[m][k] = *(const PG8_LAS bf16x8*)(lds + PG8_SA(b, h) + aoff + m * 2048 + k * 1024); } while (0)
#define PG8_LDB(dst, b, h) do { _Pragma("unroll") for (int n = 0; n < 2; ++n) _Pragma("unroll") for (int k = 0; k < 2; ++k) dst[n][k] = *(const PG8_LAS bf16x8*)(lds + PG8_SB(b, h) + boff + n * 2048 + k * 1024); } while (0)
#define PG8_MMA(ai, bj, At, Bt) do { __builtin_amdgcn_s_setprio(1); _Pragma("unroll") for (int m = 0; m < 4; ++m) _Pragma("unroll") for (int n = 0; n < 2; ++n) _Pragma("unroll") for (int k = 0; k < 2; ++k) \
        acc[ai][bj][m][n] = __builtin_amdgcn_mfma_f32_16x16x32_bf16(Bt[n][k], At[m][k], acc[ai][bj][m][n], 0, 0, 0); __builtin_amdgcn_s_setprio(0); } while (0)
#define PG8_WAIT_V(n) asm volatile("s_waitcnt vmcnt(" #n ")" ::: "memory")
#define PG8_WAIT_L(n) asm volatile("s_waitcnt lgkmcnt(" #n ")" ::: "memory")
#define PG8_BAR __builtin_amdgcn_s_barrier()
#define PG8_SCHED __builtin_amdgcn_sched_barrier(0)
    Unit cur, nxt; int ui = 0;
    if (!S.next(0, cur)) return;
    f32x4 acc[2][2][4][2];
#pragma unroll
    for (int a = 0; a < 2; ++a)
#pragma unroll
        for (int b = 0; b < 2; ++b)
#pragma unroll
            for (int m = 0; m < 4; ++m)
#pragma unroll
                for (int n = 0; n < 2; ++n) acc[a][b][m][n] = (f32x4){0.f, 0.f, 0.f, 0.f};
    bf16x8 At[4][2], B0[2][2], B1[2][2];
    const char* cA = (const char*)g.A + (size_t)cur.pm * tstep; const char* cB = (const char*)g.Bt + (size_t)cur.pn * tstep;
    S.a_ready(cur);
    if constexpr (SP2) {
        PG8_STAGE(PG8_SB(0, 0), cB, voffB); PG8_STAGE(PG8_SB(0, 1), cB + hstep, voffB); PG8_STAGE(PG8_SA(0, 0), cA, voffA); PG8_STAGE(PG8_SA(0, 1), cA + hstep, voffA);
        if (wr == 1) PG8_BAR;
        PG8_WAIT_V(2); PG8_BAR;
        PG8_STAGE(PG8_SB(1, 0), cB + kstep, voffB); PG8_STAGE(PG8_SA(1, 0), cA + kstep, voffA); PG8_STAGE(PG8_SB(1, 1), cB + hstep + kstep, voffB);
        PG8_WAIT_V(6); PG8_BAR;
    } else {
        PG8_STAGE(PG8_SB(0, 0), cB, voffB); PG8_STAGE(PG8_SA(0, 0), cA, voffA); PG8_STAGE(PG8_SB(0, 1), cB + hstep, voffB); PG8_STAGE(PG8_SA(0, 1), cA + hstep, voffA);
        if (wr == 1) PG8_BAR;
        PG8_WAIT_V(4); PG8_BAR;
        PG8_STAGE(PG8_SB(1, 0), cB + kstep, voffB); PG8_STAGE(PG8_SA(1, 0), cA + kstep, voffA); PG8_STAGE(PG8_SB(1, 1), cB + hstep + kstep, voffB);
        PG8_WAIT_V(6); PG8_BAR;
    }
    for (;;) {
        const bool has_next = S.next(ui + 1, nxt);
        const char* nA = has_next ? (const char*)g.A + (size_t)nxt.pm * tstep : cA; const char* nB = has_next ? (const char*)g.Bt + (size_t)nxt.pn * tstep : cB;
        for (int t = 0; t < nt; t += 2) {
            const bool last = (t == nt - 2);
            const char* a1 = cA + (size_t)(t + 1) * kstep;
            const char* a2 = last ? nA : cA + (size_t)(t + 2) * kstep; const char* b2 = last ? nB : cB + (size_t)(t + 2) * kstep;
            const char* a3 = a2 + kstep; const char* b3 = b2 + kstep;
            if (last && has_next) S.a_ready(nxt);
            if constexpr (SP2) {
            PG8_LDB(B0, 0, 0); PG8_LDB(B1, 0, 1); PG8_SCHED; PG8_LDA(At, 0, 0); PG8_STAGE(PG8_SA(1, 1), a1 + hstep, voffA);
            PG8_WAIT_V(8); PG8_WAIT_L(0); PG8_BAR; PG8_MMA(0, 0, At, B0); PG8_MMA(0, 1, At, B1); PG8_BAR; PG8_SCHED;
            PG8_LDA(At, 0, 1); PG8_STAGE(PG8_SB(0, 0), b2, voffB); PG8_STAGE(PG8_SB(0, 1), b2 + hstep, voffB); PG8_STAGE(PG8_SA(0, 0), a2, voffA);
            PG8_WAIT_V(8); PG8_WAIT_L(0); PG8_BAR; PG8_MMA(1, 0, At, B0); PG8_MMA(1, 1, At, B1); PG8_BAR; PG8_SCHED;
            PG8_LDB(B0, 1, 0); PG8_LDB(B1, 1, 1); PG8_SCHED; PG8_LDA(At, 1, 0); PG8_STAGE(PG8_SA(0, 1), a2 + hstep, voffA);
            PG8_WAIT_V(8); PG8_WAIT_L(0); PG8_BAR; PG8_MMA(0, 0, At, B0); PG8_MMA(0, 1, At, B1); PG8_BAR; PG8_SCHED;
            PG8_LDA(At, 1, 1); PG8_STAGE(PG8_SB(1, 0), b3, voffB); PG8_STAGE(PG8_SB(1, 1), b3 + hstep, voffB); PG8_STAGE(PG8_SA(1, 0), a3, voffA);
            PG8_WAIT_V(8); PG8_WAIT_L(0); PG8_BAR; PG8_MMA(1, 0, At, B0); PG8_MMA(1, 1, At, B1); PG8_BAR; PG8_SCHED;
            } else {
            PG8_LDB(B0, 0, 0); PG8_SCHED; PG8_LDA(At, 0, 0); PG8_STAGE(PG8_SA(1, 1), a1 + hstep, voffA);
            PG8_WAIT_L(8); PG8_BAR; PG8_WAIT_L(0); PG8_MMA(0, 0, At, B0); PG8_BAR; PG8_SCHED;
            PG8_LDB(B1, 0, 1); PG8_STAGE(PG8_SB(0, 0), b2, voffB);
            PG8_BAR; PG8_WAIT_L(0); PG8_MMA(0, 1, At, B1); PG8_BAR;
            PG8_LDA(At, 0, 1); PG8_STAGE(PG8_SA(0, 0), a2, voffA);
            PG8_BAR; PG8_WAIT_L(0); PG8_MMA(1, 0, At, B0); PG8_BAR; PG8_SCHED;
            PG8_STAGE(PG8_SB(0, 1), b2 + hstep, voffB);
            PG8_WAIT_V(6); PG8_BAR; PG8_MMA(1, 1, At, B1); PG8_BAR;
            PG8_LDB(B0, 1, 0); PG8_SCHED; PG8_LDA(At, 1, 0); PG8_STAGE(PG8_SA(0, 1), a2 + hstep, voffA);
            PG8_WAIT_L(8); PG8_BAR; PG8_WAIT_L(0); PG8_MMA(0, 0, At, B0); PG8_BAR; PG8_SCHED;
            PG8_LDB(B1, 1, 1); PG8_STAGE(PG8_SB(1, 0), b3, voffB);
            PG8_BAR; PG8_WAIT_L(0); PG8_MMA(0, 1, At, B1); PG8_BAR;
            PG8_LDA(At, 1, 1); PG8_STAGE(PG8_SA(1, 0), a3, voffA);
            PG8_BAR; PG8_WAIT_L(0); PG8_MMA(1, 0, At, B0); PG8_BAR; PG8_SCHED;
            PG8_STAGE(PG8_SB(1, 1), b3 + hstep, voffB);
            PG8_WAIT_V(6); PG8_BAR; PG8_MMA(1, 1, At, B1); PG8_BAR;
            }
        }
        if constexpr (ALIGN_EPI) { if (wr == 0) PG8_BAR; }
        if constexpr (!Epi::AFTER_DRAIN) { E(acc, cur, wr, wc, fr, fq); S.done(cur); }
        if (!has_next) break;
#pragma unroll
        for (int a = 0; a < 2; ++a)
#pragma unroll
            for (int b = 0; b < 2; ++b)
#pragma unroll
                for (int m = 0; m < 4; ++m)
#pragma unroll
                    for (int n = 0; n < 2; ++n) acc[a][b][m][n] = (f32x4){0.f, 0.f, 0.f, 0.f};
        cur = nxt; cA = nA; cB = nB; ++ui;
        if constexpr (ALIGN_EPI) { if (wr == 1) PG8_BAR; }
    }
    PG8_WAIT_V(0);
    if constexpr (!ALIGN_EPI) { if (wr == 0) PG8_BAR; }
    PG8_BAR;
    if constexpr (Epi::AFTER_DRAIN) { E.fused(acc, cur, wr, wc, fr, fq, lds, wid, lane); S.done(cur); }
#undef PG8_SA
#undef PG8_SB
#undef PG8_STAGE
#undef PG8_LDA
#undef PG8_LDB
#undef PG8_MMA
#undef PG8_WAIT_V
#undef PG8_WAIT_L
#undef PG8_BAR
#undef PG8_SCHED
}
}
#define GAS __attribute__((address_space(1)))
#define LAS __attribute__((address_space(3)))
typedef unsigned short bf16;
typedef unsigned v4u __attribute__((ext_vector_type(4)));
typedef unsigned v2u __attribute__((ext_vector_type(2)));
typedef float f32x4 __attribute__((ext_vector_type(4)));
constexpr int NWAVES = 8, NTHR = 512;
constexpr int TT = 8192, DM = 2048, SEQ = 4096;
constexpr int INC = 6592, INCP = 6656;
constexpr int C_AK = 1024, C_AV = 2048, C_RW = 3072;
constexpr int RWC = 3520;
constexpr float RMS_EPS = 1e-6f;
constexpr size_t MiB = 1u << 20;
constexpr size_t WS_CTL = 0, CTL_ZERO_BYTES = 1 * MiB;
constexpr size_t WS_WIN = 1 * MiB;
constexpr size_t WS_WOUT = 27 * MiB;
constexpr size_t WS_WQ = 35 * MiB;
constexpr size_t WS_XN = 43 * MiB;
constexpr size_t WS_PROJ = 75 * MiB;
constexpr size_t WS_AR = 179 * MiB;
constexpr size_t WS_H = 211 * MiB;
constexpr size_t WS_RWA = 275 * MiB;
constexpr size_t WS_CHK = 339 * MiB;
constexpr size_t WS_KMEAN = 467 * MiB;
constexpr size_t WS_ACT = WS_H;
constexpr size_t WS_SSP = WS_WIN + 4 * MiB;
constexpr size_t WS_LORA = 468 * MiB;
constexpr size_t WS_END = 469 * MiB;
constexpr int CW_BAR = 4096, CW_MOBA_CTR = 16384, CW_SS = 32768;
constexpr int RING_BYTES = 147456, LDSCTL_OFF = RING_BYTES, MISC_OFF = LDSCTL_OFF + 320, LDS_BYTES = 163840;

struct Params {
    const float* x; const float* norm1_g; const float* w_in; const float* mu; const float* w0; const float* w2; const float* a0; const float* a2; const float* g2;
    const float* k_k; const float* k_a; const float* r_k; const float* ln_g; const float* ln_b; const float* w_out; const float* norm2_g; const float* wq;
    const float* sub_keys; const float* pu; const float* pv; const float* final_g;
    float* out; unsigned char* ws;
    int ph_lo, ph_hi, bar_li, pad;
};

typedef const __attribute__((address_space(4))) Params& KP;
__device__ __forceinline__ const __attribute__((address_space(4))) Params* params_ptr() {
    const __attribute__((address_space(4))) Params* ka = (const __attribute__((address_space(4))) Params*)__builtin_amdgcn_kernarg_segment_ptr(); asm volatile("" : "+s"(ka)); return ka; }
typedef float f32x2_t __attribute__((ext_vector_type(2))); typedef __bf16 bf16x2_t __attribute__((ext_vector_type(2)));
__device__ __forceinline__ unsigned pk2(float lo, float hi) { const f32x2_t v = {lo, hi}; const bf16x2_t b = __builtin_convertvector(v, bf16x2_t); return __builtin_bit_cast(unsigned, b); }
__device__ __forceinline__ unsigned f2bf(float f) { return pk2(f, 0.f) & 0xffffu; }
__device__ __forceinline__ float bf2f(bf16 v) { return __builtin_bit_cast(float, (unsigned)v << 16); }
__device__ __forceinline__ float bflo(unsigned u) { return __builtin_bit_cast(float, u << 16); }
__device__ __forceinline__ float bfhi(unsigned u) { return __builtin_bit_cast(float, u & 0xffff0000u); }
#define DPP_F(v, ctrl) __builtin_bit_cast(float, __builtin_amdgcn_update_dpp(0, __builtin_bit_cast(int, (v)), (ctrl), 0xf, 0xf, true))
__device__ __forceinline__ float wave_sum(float v) {
    v += DPP_F(v, 0xB1);
    v += DPP_F(v, 0x4E);
    v += DPP_F(v, 0x141);
    v += DPP_F(v, 0x140);
    const int b = __builtin_bit_cast(int, v);
    return (__builtin_bit_cast(float, __builtin_amdgcn_readlane(b, 0)) + __builtin_bit_cast(float, __builtin_amdgcn_readlane(b, 16))) +
           (__builtin_bit_cast(float, __builtin_amdgcn_readlane(b, 32)) + __builtin_bit_cast(float, __builtin_amdgcn_readlane(b, 48)));
}
__device__ __forceinline__ float wave_max(float v) {
#pragma unroll
    for (int o = 1; o < 64; o <<= 1) v = fmaxf(v, __shfl_xor(v, o));
    return v;
}
#define LDS_WAIT() asm volatile("s_waitcnt lgkmcnt(0)" ::: "memory")

__device__ __forceinline__ void p0_transpose_item(const float* W, int K, int N, bf16* WT, LAS float* scr, int item, int lane, const float* ksc = nullptr) {
    const int nblk = N / 32, kb = item / nblk, nb = item % nblk, k0 = 64 * kb, n0 = 32 * nb;
    float wv[32];
#pragma unroll
    for (int i = 0; i < 32; ++i) wv[i] = W[(size_t)(k0 + 2 * i + (lane >> 5)) * N + n0 + (lane & 31)];
#pragma unroll
    for (int i = 0; i < 32; ++i) { const int kk = 2 * i + (lane >> 5); scr[kk * 33 + (lane & 31)] = ksc ? wv[i] * ksc[k0 + kk] : wv[i]; }
    LDS_WAIT(); asm volatile("" ::: "memory");
    const int c = lane & 7;
#pragma unroll
    for (int j = 0; j < 4; ++j) { const int n = (lane >> 3) + 8 * j; const LAS float* s = scr + (8 * c) * 33 + n;
        v4u o; o.x = pk2(s[0 * 33], s[1 * 33]); o.y = pk2(s[2 * 33], s[3 * 33]); o.z = pk2(s[4 * 33], s[5 * 33]); o.w = pk2(s[6 * 33], s[7 * 33]);
        *(v4u*)(WT + (size_t)(n0 + n) * K + k0 + 8 * c) = o; }
    LDS_WAIT(); asm volatile("" ::: "memory");
}
__device__ __forceinline__ void rms_row_to_bf16(const float* xrow, const float* g, bf16* orow, int lane) {
    const f32x4* xr = (const f32x4*)xrow + lane;
    f32x4 v[8]; float s = 0.f;
#pragma unroll
    for (int j = 0; j < 8; ++j) { v[j] = xr[64 * j]; s += (v[j].x * v[j].x + v[j].y * v[j].y) + (v[j].z * v[j].z + v[j].w * v[j].w); }
    const float rs = 1.0f / sqrtf(wave_sum(s) * (1.f / DM) + RMS_EPS);
    v2u* o8 = (v2u*)orow + lane;
#pragma unroll
    for (int j = 0; j < 8; ++j) { const f32x4 gg = ((const f32x4*)g)[lane + 64 * j];
        v2u o; o.x = pk2(v[j].x * rs * gg.x, v[j].y * rs * gg.y); o.y = pk2(v[j].z * rs * gg.z, v[j].w * rs * gg.w); o8[64 * j] = o; }
}
__device__ __forceinline__ void phase_prologue(KP P, LAS unsigned char* lds, int vcu, int G) {
    const int tid = ltid(), lane = tid & 63, wave = tid >> 6;
    LAS float* scr = (LAS float*)(lds + wave * 16384);
    const int gw = vcu * NWAVES + wave, NGW = G * NWAVES;
    bf16* WIN = (bf16*)(P.ws + WS_WIN); bf16* XN = (bf16*)(P.ws + WS_XN);
    constexpr int I_IN = (DM / 64) * (INC / 32);
    for (int it = gw; it < I_IN; it += NGW) p0_transpose_item(P.w_in, DM, INC, WIN, scr, it, lane);
    for (int i = vcu * NTHR + tid; i < (INCP - INC) * DM / 8; i += G * NTHR) ((v4u*)(WIN + (size_t)INC * DM))[i] = (v4u){0u, 0u, 0u, 0u};
    for (int m = gw; m < TT; m += NGW) rms_row_to_bf16(P.x + (size_t)m * DM, P.norm1_g, XN + (size_t)m * DM, lane);
}
__device__ __forceinline__ void phase_transpose_late(KP P, LAS unsigned char* lds) {
    const int tid = ltid(), lane = tid & 63, wave = tid >> 6;
    constexpr int I_SQ = (DM / 64) * (DM / 32), NTK = 2 * I_SQ / NWAVES;
    unsigned* ctr = (unsigned*)(P.ws + WS_CTL) + CW_MOBA_CTR + 16; LAS int* slot = (LAS int*)(lds + 8 * 16384); LAS float* scr = (LAS float*)(lds + wave * 16384);
    __syncthreads();
    if (tid == 0) slot[0] = (int)__hip_atomic_fetch_add(ctr, 1u, __ATOMIC_RELAXED, __HIP_MEMORY_SCOPE_AGENT);
    __syncthreads();
    for (int it = 0;; ++it) {
        const int c = slot[it & 1]; if (c >= NTK) break;
        if (tid == 0) slot[(it & 1) ^ 1] = (int)__hip_atomic_fetch_add(ctr, 1u, __ATOMIC_RELAXED, __HIP_MEMORY_SCOPE_AGENT);
        const int r = c * NWAVES + wave;
        if (r < I_SQ) p0_transpose_item(P.w_out, DM, DM, (bf16*)(P.ws + WS_WOUT), scr, r, lane);
        else p0_transpose_item(P.wq, DM, DM, (bf16*)(P.ws + WS_WQ), scr, r - I_SQ, lane, P.norm2_g);
        __syncthreads();
    }
}

namespace pg8 {
struct EpiF32 {
    static constexpr bool PERM = false, AFTER_DRAIN = false;
    const float* base; float* out; int ldc;
    __device__ __forceinline__ void operator()(const f32x4 (&acc)[2][2][4][2], const Unit& u, int wr, int wc, int fr, int fq) const {
        const int col0 = u.pn * BM + wc * 32 + 4 * fq;
#pragma unroll
        for (int ai = 0; ai < 2; ++ai)
#pragma unroll
            for (int m = 0; m < 4; ++m) { const int r = ai * HALF + wr * 64 + m * 16 + fr; const size_t off = (size_t)(u.pm * BM + r) * ldc + col0;
#pragma unroll
                for (int bj = 0; bj < 2; ++bj)
#pragma unroll
                    for (int n = 0; n < 2; ++n) { f32x4 o = acc[ai][bj][m][n]; if (base) o = o + *(const f32x4*)(base + off + bj * HALF + n * 16);
                        *(f32x4*)(out + off + bj * HALF + n * 16) = o; } }
    }
};
struct EpiH {
    static constexpr bool PERM = false, AFTER_DRAIN = false;
    const float* base; bf16* outb; float* ss; int ldc;
    __device__ __forceinline__ void operator()(const f32x4 (&acc)[2][2][4][2], const Unit& u, int wr, int wc, int fr, int fq) const {
        const int col0 = u.pn * BM + wc * 32 + 4 * fq;
#pragma unroll
        for (int ai = 0; ai < 2; ++ai) {
            f32x4 xv[4][2][2];
#pragma unroll
            for (int m = 0; m < 4; ++m) { const size_t off = (size_t)(u.pm * BM + ai * HALF + wr * 64 + m * 16 + fr) * ldc + col0;
#pragma unroll
                for (int bj = 0; bj < 2; ++bj)
#pragma unroll
                    for (int n = 0; n < 2; ++n) xv[m][bj][n] = *(const f32x4*)(base + off + bj * HALF + n * 16); }
#pragma unroll
            for (int m = 0; m < 4; ++m) { const int r = ai * HALF + wr * 64 + m * 16 + fr; const size_t off = (size_t)(u.pm * BM + r) * ldc + col0; float sq = 0.f;
#pragma unroll
                for (int bj = 0; bj < 2; ++bj)
#pragma unroll
                    for (int n = 0; n < 2; ++n) { const f32x4 o = acc[ai][bj][m][n] + xv[m][bj][n];
                        *(v2u*)(outb + off + bj * HALF + n * 16) = (v2u){pk2(o.x, o.y), pk2(o.z, o.w)};
                        sq += (o.x * o.x + o.y * o.y) + (o.z * o.z + o.w * o.w); }
                sq += __shfl_xor(sq, 16); sq += __shfl_xor(sq, 32);
                if (fq == 0) ss[(size_t)(u.pm * BM + r) * 32 + u.pn * 4 + wc] = sq; }
        }
    }
};
struct EpiBf16Row {
    static constexpr bool PERM = true, AFTER_DRAIN = false;
    bf16_t* O; int ldc; const float* rs;
    __device__ __forceinline__ void operator()(const f32x4 (&acc)[2][2][4][2], const Unit& u, int wr, int wc, int fr, int fq) const {
        const int row0 = u.pm * BM + wr * 64 + fr, col0 = u.pn * BM + wc * 32 + 8 * fq;
        float scv[2][4];
#pragma unroll
        for (int ai = 0; ai < 2; ++ai)
#pragma unroll
            for (int m = 0; m < 4; ++m) scv[ai][m] = rs[row0 + ai * HALF + m * 16];
#pragma unroll
        for (int ai = 0; ai < 2; ++ai)
#pragma unroll
            for (int m = 0; m < 4; ++m) { const int row = row0 + ai * HALF + m * 16; const float sc = scv[ai][m]; bf16_t* rowp = O + (size_t)row * ldc + col0;
#pragma unroll
                for (int bj = 0; bj < 2; ++bj) { const f32x4 v0 = acc[ai][bj][m][0] * sc, v1 = acc[ai][bj][m][1] * sc;
                    u32x4 w; w.x = cvt_pk_bf16(v0[0], v0[1]); w.y = cvt_pk_bf16(v0[2], v0[3]); w.z = cvt_pk_bf16(v1[0], v1[1]); w.w = cvt_pk_bf16(v1[2], v1[3]);
                    *(u32x4*)(rowp + bj * HALF) = w; } }
    }
};
struct Order1 {
    StaticOrder s; bool split; int c;
    __device__ void init(int M, int N, int G_, int c_) { s.init(M, N, G_, c_); split = (G_ == 256 && M == 8192 && N == 6656); c = c_; }
    __device__ bool next(int i, Unit& u) const {
        if (!split) return s.next(i, u);
        if (c >= 208 || i >= 4) return false;
        const int x = c & 7, j = c >> 3; u.pm = 4 * x + 2 * (i >> 1) + (j & 1); u.pn = 13 * (i & 1) + (j >> 1); return true; }
    __device__ __forceinline__ void a_ready(const Unit&) const {}
    __device__ __forceinline__ void done(const Unit&) const {}
};
}

__device__ __forceinline__ void phase_rstd(KP P, int vcu, int G) {
    const float* ssp = (const float*)(P.ws + WS_SSP); float* rstd = (float*)(P.ws + WS_SSP + 2 * MiB);
    for (int row = vcu * NTHR + ltid(); row < TT; row += G * NTHR) { const f32x4* sp = (const f32x4*)(ssp + (size_t)row * 32); float a = 0.f;
#pragma unroll
        for (int j = 0; j < 8; ++j) { const f32x4 v = sp[j]; a += (v.x + v.y) + (v.z + v.w); }
        rstd[row] = 1.0f / sqrtf(a * (1.f / DM) + RMS_EPS); }
}
__device__ __forceinline__ void phase_kmean(KP P, LAS unsigned char* lds, int vcu, int G) {
    const int tid = ltid(); const bf16* proj = (const bf16*)(P.ws + WS_PROJ); float* kmean = (float*)(P.ws + WS_KMEAN);
    LAS float* red = (LAS float*)lds;
    for (int item = vcu; item < 32 * 8; item += G) {
        const int bb = item >> 3, cg = item & 7;
        const int c = tid & 127, rq = tid >> 7;
        const bf16* p = proj + (size_t)(bb * 256 + rq * 64) * INCP + C_AK + cg * 128 + c;
        float s = 0.f;
        for (int r = 0; r < 64; ++r) s += bf2f(p[(size_t)r * INCP]);
        red[rq * 128 + c] = s;
        __syncthreads();
        if (tid < 128) kmean[(size_t)bb * 1024 + cg * 128 + tid] = (red[tid] + red[128 + tid] + red[256 + tid] + red[384 + tid]) * (1.f / 256.f);
        __syncthreads();
    }
}

typedef short bf16x8 __attribute__((ext_vector_type(8)));
typedef float f32x16 __attribute__((ext_vector_type(16)));
constexpr int CP = 72;
constexpr int MATB = 64 * CP * 2;
enum { M_AT = 0, M_BT = 1, M_KT = 2, M_RT = 3, M_VT = 4, M_BBT = 5, M_KBT = 6, M_LAK = 7, M_MRB = 8, M_MRK = 9, M_LAB = 10, M_AHT = 0, M_U0T = 1 };
constexpr int L_RHS = 11 * MATB;
constexpr int L_MISC = L_RHS + 32768;
constexpr int L_TB = L_MISC + 9 * 64 * 4;
constexpr int L_A_END = L_TB + 2048;
static_assert(L_A_END <= RING_BYTES, "stage A LDS");
constexpr size_t CHK_ITEM = 6 * 8192;

__device__ __forceinline__ f32x16 mm_tile(const LAS unsigned char* A, int ra, const LAS unsigned char* B, int rb, f32x16 acc, int lane, int k0 = 0, int k1 = 4) {
    const int r = lane & 31, hi = lane >> 5;
    const LAS unsigned char* ap = A + ((ra * 32 + r) * CP + 8 * hi) * 2; const LAS unsigned char* bp = B + ((rb * 32 + r) * CP + 8 * hi) * 2;
#pragma unroll
    for (int kk = 0; kk < 4; ++kk) if (kk >= k0 && kk < k1) {
        const bf16x8 a = *(const LAS bf16x8*)(ap + kk * 32), b = *(const LAS bf16x8*)(bp + kk * 32);
        acc = __builtin_amdgcn_mfma_f32_32x32x16_bf16(a, b, acc, 0, 0, 0); }
    return acc;
}
__device__ __forceinline__ int crow32(int reg, int hi) { return (reg & 3) + 8 * (reg >> 2) + 4 * hi; }

__device__ __forceinline__ void prologue_lora(KP P, int vcu, int G) {
    bf16* w2T = (bf16*)(P.ws + WS_LORA); bf16* a2T = w2T + 1024 * 96; bf16* g2T = a2T + 1024 * 96;
    for (int e0 = vcu * NTHR + ltid(); e0 < 448 * 1024; e0 += 4 * G * NTHR) { float v[4];
#pragma unroll
        for (int u = 0; u < 4; ++u) { const int e = e0 + u * G * NTHR, i = e >> 10; v[u] = 0.f;
            if (e < 448 * 1024) v[u] = i < 96 ? P.w2[e] : (i < 192 ? P.a2[e - 96 * 1024] : P.g2[e - 192 * 1024]); }
#pragma unroll
        for (int u = 0; u < 4; ++u) { const int e = e0 + u * G * NTHR, i = e >> 10, n = e & 1023;
            if (e < 448 * 1024) { if (i < 96) w2T[n * 96 + i] = (bf16)f2bf(v[u]); else if (i < 192) a2T[n * 96 + (i - 96)] = (bf16)f2bf(v[u]); else g2T[n * 256 + (i - 192)] = (bf16)f2bf(v[u]); } }
    }
}
__device__ __forceinline__ void phase_act(KP P, int vcu, int G) {
    const bf16* proj = (const bf16*)(P.ws + WS_PROJ); unsigned* act = (unsigned*)(P.ws + WS_ACT);
    for (int e0 = vcu * NTHR + ltid(); e0 < TT * 224; e0 += 4 * G * NTHR) {
        unsigned cu[4], pu[4]; float m0[4], m1[4];
#pragma unroll
        for (int u = 0; u < 4; ++u) { const int e = e0 + u * G * NTHR; cu[u] = 0u; pu[u] = 0u; m0[u] = 0.f; m1[u] = 0.f;
            if (e < TT * 224) { const int t = e / 224, cc = 2 * (e - t * 224); const bf16* pr = proj + (size_t)t * INCP + C_RW + 3072 + cc;
                cu[u] = *(const unsigned*)pr; pu[u] = (t & (SEQ - 1)) == 0 ? 0u : *(const unsigned*)(pr - INCP); m0[u] = P.mu[3072 + cc]; m1[u] = P.mu[3072 + cc + 1]; } }
#pragma unroll
        for (int u = 0; u < 4; ++u) { const int e = e0 + u * G * NTHR;
            if (e < TT * 224) { const int t = e / 224, cc = 2 * (e - t * 224);
                float v0 = bflo(cu[u]) + (bflo(pu[u]) - bflo(cu[u])) * m0[u], v1 = bfhi(cu[u]) + (bfhi(pu[u]) - bfhi(cu[u])) * m1[u];
                if (cc < 96) { v0 = tanhf(v0); v1 = tanhf(v1); } else if (cc >= 192) { v0 = 1.f / (1.f + __expf(-v0)); v1 = 1.f / (1.f + __expf(-v1)); }
                act[e] = pk2(v0, v1); } }
    }
}
constexpr int ACTP = 456;
constexpr int L_WAG = 58368;
static_assert(L_WAG + 3 * 16384 <= L_MISC, "lora scratch fits below misc");
struct LoraFrags { bf16x8 f[16]; f32x4 w0[4], a0[4]; float mu_r, mu_k, mu_v, kkc, kac, rkc, lng, lnb; };
__device__ __forceinline__ LoraFrags lora_frags_load(KP P, int h, int wave, int lane) {
    const int c32 = lane & 31, hi = lane >> 5, nb = (wave & 3) >> 1; const int nrow = h * 64 + nb * 32 + c32;
    const bf16* w2T = (const bf16*)(P.ws + WS_LORA); const bf16* a2T = w2T + 1024 * 96; const bf16* g2T = a2T + 1024 * 96;
    const bf16* wp = w2T + (size_t)nrow * 96 + 8 * hi; const bf16* ap = a2T + (size_t)nrow * 96 + 8 * hi; const bf16* gp = g2T + (size_t)nrow * 256 + 8 * hi;
    LoraFrags W;
#pragma unroll
    for (int kk = 0; kk < 16; ++kk) { const bf16* src = wave < 4 ? (kk < 6 ? wp + 16 * kk : ap + 16 * ((kk - 6) % 6)) : gp + 16 * kk; W.f[kk] = *(const bf16x8*)src; }
#pragma unroll
    for (int g = 0; g < 4; ++g) { const int n0 = h * 64 + nb * 32 + 8 * g + 4 * hi; W.w0[g] = *(const f32x4*)(P.w0 + n0); W.a0[g] = *(const f32x4*)(P.a0 + n0); }
    const int col = h * 64 + lane;
    W.mu_r = P.mu[col]; W.mu_k = P.mu[1024 + col]; W.mu_v = P.mu[2048 + col]; W.kkc = P.k_k[col]; W.kac = P.k_a[col]; W.rkc = P.r_k[col]; W.lng = P.ln_g[col]; W.lnb = P.ln_b[col];
    return W;
}
__device__ __forceinline__ void rwkv_stage_a(KP P, LAS unsigned char* lds, int item, const LoraFrags& W) {
    const int tid = ltid(), lane = tid & 63, wave = __builtin_amdgcn_readfirstlane(tid >> 6);
    const int b = item >> 10, h = (item >> 6) & 15, c = item & 63;
    const int tok0 = b * SEQ + c * 64;
    const bf16* proj = (const bf16*)(P.ws + WS_PROJ);
    unsigned char* chk = P.ws + WS_CHK + (size_t)((item & 63) * 32 + (item >> 6)) * CHK_ITEM;
    LAS float* misc = (LAS float*)(lds + L_MISC);
    { const bf16* actg = (const bf16*)(P.ws + WS_ACT) + (size_t)tok0 * 448;
#pragma unroll
      for (int e = tid; e < 64 * 56; e += NTHR) { const int row = e / 56, ch = e - row * 56; *(LAS v4u*)(lds + (row * ACTP + ch * 8) * 2) = *(const v4u*)(actg + (size_t)row * 448 + ch * 8); } }
    __syncthreads();
    {
        const int c32 = lane & 31, hi = lane >> 5, qd = wave & 3, nb = qd >> 1, tb = qd & 1;
        const LAS unsigned char* actp = lds + ((tb * 32 + c32) * ACTP + 8 * hi) * 2;
        LAS float* wag = (LAS float*)(lds + L_WAG) + (tb * 32 + c32) * 64 + nb * 32;
        if (wave < 4) {
            f32x16 aw = {}, aa = {};
#pragma unroll
            for (int kk = 0; kk < 6; ++kk) {
                aw = __builtin_amdgcn_mfma_f32_32x32x16_bf16(W.f[kk], *(const LAS bf16x8*)(actp + (16 * kk) * 2), aw, 0, 0, 0);
                aa = __builtin_amdgcn_mfma_f32_32x32x16_bf16(W.f[6 + kk], *(const LAS bf16x8*)(actp + (96 + 16 * kk) * 2), aa, 0, 0, 0); }
#pragma unroll
            for (int g = 0; g < 4; ++g) { const int n0 = h * 64 + nb * 32 + 8 * g + 4 * hi;
                const f32x4 w0 = W.w0[g], a0 = W.a0[g]; f32x4 ow, oa;
#pragma unroll
                for (int e = 0; e < 4; ++e) { const float xx = w0[e] + aw[4 * g + e];
                    ow[e] = __expf(-0.6065306597126334f * __builtin_amdgcn_rcpf(1.f + __expf(-xx))); oa[e] = __builtin_amdgcn_rcpf(1.f + __expf(-(a0[e] + aa[4 * g + e]))); }
                *(LAS f32x4*)(wag + 8 * g + 4 * hi) = ow; *(LAS f32x4*)(wag + 4096 + 8 * g + 4 * hi) = oa; }
        } else {
            f32x16 ag = {};
#pragma unroll
            for (int kk = 0; kk < 16; ++kk) ag = __builtin_amdgcn_mfma_f32_32x32x16_bf16(W.f[kk], *(const LAS bf16x8*)(actp + (192 + 16 * kk) * 2), ag, 0, 0, 0);
#pragma unroll
            for (int g = 0; g < 4; ++g) *(LAS f32x4*)(wag + 8192 + 8 * g + 4 * hi) = (f32x4){ag[4 * g], ag[4 * g + 1], ag[4 * g + 2], ag[4 * g + 3]};
        }
    }
    __syncthreads();
    {
        const int n = lane, tg = wave, col = h * 64 + n;
        const float mu_r = W.mu_r, mu_k = W.mu_k, mu_v = W.mu_v, kkc = W.kkc, kac = W.kac, rkc = W.rkc, lng = W.lng, lnb = W.lnb;
        float rr[8], kr[8], vv[8], ww[8], aa[8], gg[8], kk[8];
        const int tfirst = tok0 + 8 * tg;
        const bf16* pp = proj + (size_t)tfirst * INCP + C_RW + col;
        float pr, pk, pvv;
        if (c == 0 && tg == 0) { pr = 0.f; pk = 0.f; pvv = 0.f; } else { pr = bf2f(pp[-(long)INCP]); pk = bf2f(pp[-(long)INCP + 1024]); pvv = bf2f(pp[-(long)INCP + 2048]); }
        const LAS float* wagr = (const LAS float*)(lds + L_WAG) + (8 * tg) * 64 + n;
#pragma unroll
        for (int q = 0; q < 8; ++q) { const float cr = bf2f(pp[(size_t)q * INCP]), ck = bf2f(pp[(size_t)q * INCP + 1024]), cv = bf2f(pp[(size_t)q * INCP + 2048]);
            rr[q] = cr + (pr - cr) * mu_r; kr[q] = ck + (pk - ck) * mu_k; vv[q] = cv + (pvv - cv) * mu_v; pr = cr; pk = ck; pvv = cv;
            ww[q] = wagr[q * 64]; aa[q] = wagr[4096 + q * 64]; gg[q] = wagr[8192 + q * 64]; }
        float lam[8]; float run = 1.f;
#pragma unroll
        for (int q = 0; q < 8; ++q) { run *= ww[q]; lam[q] = run; }
        misc[tg * 64 + n] = run;
#pragma unroll
        for (int q = 0; q < 8; ++q) { const float kkv = kr[q] * kkc; const float ss = wave_sum(kkv * kkv); kk[q] = kkv * __builtin_amdgcn_rsqf(fmaxf(ss, 1e-24f));
            kr[q] = kr[q] * (1.f + (aa[q] - 1.f) * kac); }
        __syncthreads();
        float pre = 1.f, tot = 1.f;
#pragma unroll
        for (int g = 0; g < 8; ++g) { const float sgt = misc[g * 64 + n]; if (g < tg) pre *= sgt; tot *= sgt; }
        if (tg == 0) misc[512 + n] = tot;
        unsigned vt[4], bbt[4], kbt[4];
        LAS bf16* At = (LAS bf16*)(lds + M_AT * MATB); LAS bf16* Bt = (LAS bf16*)(lds + M_BT * MATB); LAS bf16* Kt = (LAS bf16*)(lds + M_KT * MATB); LAS bf16* Rt = (LAS bf16*)(lds + M_RT * MATB);
        float hbb = 0.f, hkb = 0.f, hv = 0.f;
#pragma unroll
        for (int q = 0; q < 8; ++q) { const int t = 8 * tg + q;
            const float L = pre * lam[q], Lp = q == 0 ? pre : pre * lam[q - 1], iL = __builtin_amdgcn_rcpf(L), rel = tot * iL;
            const float bq = kk[q] * aa[q];
            ((LAS float*)(lds + L_RHS))[t * 128 + 64 + n] = -kk[q] * Lp;
            At[t * CP + n] = (bf16)f2bf(-kk[q] * Lp); Bt[t * CP + n] = (bf16)f2bf(bq * iL); Kt[t * CP + n] = (bf16)f2bf(kr[q] * iL); Rt[t * CP + n] = (bf16)f2bf(rr[q] * L);
            const float bb = bq * rel, kb = kr[q] * rel;
            if (q & 1) { vt[q >> 1] = pk2(hv, vv[q]); bbt[q >> 1] = pk2(hbb, bb); kbt[q >> 1] = pk2(hkb, kb); } else { hv = vv[q]; hbb = bb; hkb = kb; }
            const float bs = wave_sum(rr[q] * kr[q] * rkc);
            const int pl = (((t >> 4) * 2 + (n >> 5)) * 64 + (t & 15) * 4 + ((n >> 2) & 3)) * 8 + ((n >> 4) & 1) * 4 + (n & 3);
            ((bf16*)(chk + 4 * 8192))[pl] = (bf16)f2bf(lng * gg[q]);
            ((bf16*)(chk + 5 * 8192))[pl] = (bf16)f2bf((lnb + bs * vv[q]) * gg[q]); }
        *(LAS v4u*)(lds + M_VT * MATB + (n * CP + 8 * tg) * 2) = (v4u){vt[0], vt[1], vt[2], vt[3]};
        *(LAS v4u*)(lds + M_BBT * MATB + (n * CP + 8 * tg) * 2) = (v4u){bbt[0], bbt[1], bbt[2], bbt[3]};
        *(LAS v4u*)(lds + M_KBT * MATB + (n * CP + 8 * tg) * 2) = (v4u){kbt[0], kbt[1], kbt[2], kbt[3]};
    }
    __syncthreads();
    const int c32 = lane & 31, hi = lane >> 5;
    {
        const int prod = wave >> 1;
#pragma unroll
        for (int qi = 0; qi < 2; ++qi) {
            const int tb = (wave & 1) ? (qi == 0 ? 1 : 0) : qi, sb = (wave & 1) ? 1 : 0; const bool zero = (tb == 0 && sb == 1);
            f32x16 acc = {};
            const int xa = (prod == 0 || prod == 2) ? M_BT : M_KT, ya = prod < 2 ? M_AT : M_RT, dm = prod == 0 ? M_LAB : (prod == 1 ? M_LAK : (prod == 2 ? M_MRB : M_MRK));
            if (!zero) acc = mm_tile(lds + xa * MATB, sb, lds + ya * MATB, tb, acc, lane);
            const int t = tb * 32 + c32; LAS unsigned char* dst = lds + dm * MATB + (t * CP + sb * 32) * 2;
#pragma unroll
            for (int g = 0; g < 4; ++g) { float o[4];
#pragma unroll
                for (int e = 0; e < 4; ++e) { const int s = sb * 32 + 8 * g + 4 * hi + e; const bool keep = prod < 2 ? (s < t) : (s <= t); o[e] = keep ? acc[4 * g + e] : 0.f; }
                *(LAS v2u*)(dst + (8 * g + 4 * hi) * 2) = (v2u){pk2(o[0], o[1]), pk2(o[2], o[3])}; }
        }
    }
    __syncthreads();
    if (wave < 4) {
        const int ib = wave >> 1, tb = wave & 1; f32x16 acc = {};
        acc = mm_tile(lds + M_VT * MATB, ib, lds + M_LAK * MATB, tb, acc, lane, 0, tb == 0 ? 2 : 4);
        const int t = tb * 32 + c32; LAS float* dst = (LAS float*)(lds + L_RHS) + t * 128 + ib * 32;
#pragma unroll
        for (int g = 0; g < 4; ++g) *(LAS f32x4*)(dst + 8 * g + 4 * hi) = (f32x4){acc[4 * g], acc[4 * g + 1], acc[4 * g + 2], acc[4 * g + 3]};
    } else if (wave == 4) {
        const int bb = lane >> 4, col = lane & 15;
        float x[16];
#pragma unroll
        for (int t = 0; t < 16; ++t) x[t] = t == col ? 1.f : 0.f;
#pragma unroll
        for (int t = 1; t < 16; ++t) { const LAS unsigned char* rp = lds + M_LAB * MATB + ((16 * bb + t) * CP + 16 * bb) * 2; const v4u ra = *(const LAS v4u*)rp, rb = *(const LAS v4u*)(rp + 16);
            float lrow[16];
#pragma unroll
            for (int q = 0; q < 4; ++q) { lrow[2 * q] = bflo(ra[q]); lrow[2 * q + 1] = bfhi(ra[q]); lrow[8 + 2 * q] = bflo(rb[q]); lrow[8 + 2 * q + 1] = bfhi(rb[q]); }
#pragma unroll
            for (int s = 0; s < t; ++s) x[t] += lrow[s] * x[s]; }
        LAS bf16* T = (LAS bf16*)(lds + L_TB) + bb * 256 + col;
#pragma unroll
        for (int t = 0; t < 16; ++t) T[t * 16] = (bf16)f2bf(x[t]);
    }
    __syncthreads();
    {
        typedef short s16x4 __attribute__((ext_vector_type(4)));
        const int l15 = lane & 15, q4 = lane >> 4;
        LAS unsigned char* xt = lds + (wave < 4 ? M_U0T : M_AHT) * MATB + ((16 * (wave & 3) + l15) * CP) * 2;
        *(LAS v4u*)(xt + q4 * 32) = (v4u){0u, 0u, 0u, 0u}; *(LAS v4u*)(xt + q4 * 32 + 16) = (v4u){0u, 0u, 0u, 0u};
        const LAS float* Xf = (const LAS float*)(lds + L_RHS) + 16 * wave + l15;
#pragma unroll
        for (int bq = 0; bq < 4; ++bq) {
            f32x4 acc;
#pragma unroll
            for (int e = 0; e < 4; ++e) acc[e] = Xf[(16 * bq + 4 * q4 + e) * 128];
#pragma unroll
            for (int kk = 0; kk < (bq + 1) / 2; ++kk) {
                const bf16x8 a = *(const LAS bf16x8*)(lds + M_LAB * MATB + ((16 * bq + l15) * CP + 32 * kk + 8 * q4) * 2);
                const bf16x8 xb = *(const LAS bf16x8*)(xt + (32 * kk + 8 * q4) * 2);
                acc = __builtin_amdgcn_mfma_f32_16x16x32_bf16(a, xb, acc, 0, 0, 0); }
            const v2u tf = *(const LAS v2u*)(lds + L_TB + (bq * 256 + l15 * 16 + 4 * q4) * 2);
            const v2u ab = (v2u){pk2(acc[0], acc[1]), pk2(acc[2], acc[3])};
            const f32x4 z = {0.f, 0.f, 0.f, 0.f};
            const f32x4 xn = __builtin_amdgcn_mfma_f32_16x16x16bf16_1k(__builtin_bit_cast(s16x4, tf), __builtin_bit_cast(s16x4, ab), z, 0, 0, 0);
            *(LAS v2u*)(xt + (16 * bq + 4 * q4) * 2) = (v2u){pk2(xn[0], xn[1]), pk2(xn[2], xn[3])};
        }
    }
    __syncthreads();
    {
        const int qd = wave & 3, yb = qd >> 1, xb = qd & 1;
        f32x16 acc1 = {}, acc2 = {};
        if (wave < 4) {
            acc1 = mm_tile(lds + M_AHT * MATB, yb, lds + M_BBT * MATB, xb, acc1, lane);
            acc2 = mm_tile(lds + M_BBT * MATB, yb, lds + M_U0T * MATB, xb, acc2, lane);
            acc2 = mm_tile(lds + M_KBT * MATB, yb, lds + M_VT * MATB, xb, acc2, lane);
            const int x = xb * 32 + c32; const float lc = misc[512 + x];
            bf16* o1 = (bf16*)(chk + 0 * 8192) + (((x >> 4) * 2 + yb) * 64 + (x & 15)) * 8 + 4 * hi; bf16* o2 = (bf16*)(chk + 1 * 8192) + ((2 * yb * 4 + (x >> 4)) * 64 + (x & 15)) * 4;
#pragma unroll
            for (int g = 0; g < 4; ++g) { float p[4];
#pragma unroll
                for (int e = 0; e < 4; ++e) { const int y = yb * 32 + 8 * g + 4 * hi + e; p[e] = acc1[4 * g + e] + (y == x ? lc : 0.f); }
                *(v2u*)(o1 + 16 * g * 8) = (v2u){pk2(p[0], p[1]), pk2(p[2], p[3])};
                *(v2u*)(o2 + ((g >> 1) * 4 * 64 + 16 * ((2 * g + hi) & 3)) * 4) = (v2u){pk2(acc2[4 * g], acc2[4 * g + 1]), pk2(acc2[4 * g + 2], acc2[4 * g + 3])}; }
        } else {
            acc1 = mm_tile(lds + M_AHT * MATB, yb, lds + M_MRB * MATB, xb, acc1, lane);
            acc2 = mm_tile(lds + M_U0T * MATB, yb, lds + M_MRB * MATB, xb, acc2, lane);
            acc2 = mm_tile(lds + M_VT * MATB, yb, lds + M_MRK * MATB, xb, acc2, lane);
            const int x = xb * 32 + c32;
            bf16* o1 = (bf16*)(chk + 2 * 8192) + (((x >> 4) * 2 + yb) * 64 + (x & 15)) * 8 + 4 * hi; bf16* o2 = (bf16*)(chk + 3 * 8192) + (((x >> 4) * 2 + yb) * 64 + (x & 15)) * 8;
            const LAS bf16* Rt = (const LAS bf16*)(lds + M_RT * MATB) + x * CP + yb * 32;
#pragma unroll
            for (int g = 0; g < 4; ++g) { float p[4];
#pragma unroll
                for (int e = 0; e < 4; ++e) p[e] = acc1[4 * g + e] + bf2f(Rt[8 * g + 4 * hi + e]);
                *(v2u*)(o1 + 16 * g * 8) = (v2u){pk2(p[0], p[1]), pk2(p[2], p[3])};
                *(v2u*)(o2 + 16 * ((2 * g + hi) & 3) * 8 + (g >> 1) * 4) = (v2u){pk2(acc2[4 * g], acc2[4 * g + 1]), pk2(acc2[4 * g + 2], acc2[4 * g + 3])}; }
        }
    }
    __syncthreads();
}

__device__ __forceinline__ void phase_rwkv_stage_a(KP P, LAS unsigned char* lds, int vcu, int G) {
    const int tid = ltid(), lane = tid & 63, wave = __builtin_amdgcn_readfirstlane(tid >> 6);
    int cur_bh = (vcu & 255) >> 3; LoraFrags W = lora_frags_load(P, cur_bh & 15, wave, lane);
    for (int k = vcu; k < 2048; k += G) { const int bh = (k & 255) >> 3, c = (k & 7) + 8 * (k >> 8);
        if (bh != cur_bh) { W = lora_frags_load(P, bh & 15, wave, lane); cur_bh = bh; }
        rwkv_stage_a(P, lds, bh * 64 + c, W); }
}
typedef float f32x4v __attribute__((ext_vector_type(4)));
struct YSet { bf16x8 b0, b1; v4u y0[2], g1[2], g2[2]; };
struct SSet { bf16x8 p0[1], p1[1]; v2u q[4]; };
__device__ __forceinline__ void rwkv_stage_b(KP P, LAS unsigned char* lds, int bh) {
    const int tid = ltid(), lane = tid & 63, wave = __builtin_amdgcn_readfirstlane(tid >> 6);
    const int b = bh >> 4, h = bh & 15; const int l15 = lane & 15, q4 = lane >> 4;
    bf16* AR = (bf16*)(P.ws + WS_AR);
    for (int u = tid; u < 2 * MATB / 4; u += NTHR) ((LAS unsigned*)lds)[u] = 0u;
    __syncthreads();
    const int w4 = wave & 3;
    const unsigned char* chk0 = P.ws + WS_CHK + (size_t)bh * CHK_ITEM;
    if (wave < 4) {
        const int t = 16 * w4 + l15;
        YSet ys[4];
#define YLOAD(S_, c_) do { const unsigned char* chk = chk0 + (size_t)(c_) * (32 * CHK_ITEM); const bf16* rh = (const bf16*)(chk + 2 * 8192) + (w4 * 128 + lane) * 8; S_.b0 = *(const bf16x8*)rh; S_.b1 = *(const bf16x8*)(rh + 512); \
        const bf16* y0 = (const bf16*)(chk + 3 * 8192) + (w4 * 128 + lane) * 8; const bf16* g1 = (const bf16*)(chk + 4 * 8192) + (w4 * 128 + l15 * 4 + q4) * 8; \
        S_.y0[0] = *(const v4u*)y0; S_.y0[1] = *(const v4u*)(y0 + 512); S_.g1[0] = *(const v4u*)g1; S_.g1[1] = *(const v4u*)(g1 + 512); S_.g2[0] = *(const v4u*)(g1 + 4096); S_.g2[1] = *(const v4u*)(g1 + 4096 + 512); } while (0)
#define YV(A_, it_, w_) ((A_)[(it_) >> 1][2 * ((it_) & 1) + (w_)])
#pragma unroll
        for (int u = 0; u < 4; ++u) YLOAD(ys[u], u);
        for (int c0 = 0; c0 < 60; c0 += 4) {
#pragma unroll
                for (int u = 0; u < 4; ++u) { const int c = c0 + u;
                const LAS unsigned char* Scur = lds + (c & 1) * MATB;
                    f32x4v acc[4];
    #pragma unroll
                    for (int it = 0; it < 4; ++it) { acc[it] = (f32x4v){bflo(YV(ys[u].y0, it, 0)), bfhi(YV(ys[u].y0, it, 0)), bflo(YV(ys[u].y0, it, 1)), bfhi(YV(ys[u].y0, it, 1))};
                        const LAS unsigned char* sp = Scur + ((16 * it + l15) * CP + 8 * q4) * 2;
                        acc[it] = __builtin_amdgcn_mfma_f32_16x16x32_bf16(*(const LAS bf16x8*)sp, ys[u].b0, acc[it], 0, 0, 0);
                        acc[it] = __builtin_amdgcn_mfma_f32_16x16x32_bf16(*(const LAS bf16x8*)(sp + 64), ys[u].b1, acc[it], 0, 0, 0); }
                    float s = 0.f;
    #pragma unroll
                    for (int it = 0; it < 4; ++it) s += (acc[it].x + acc[it].y) + (acc[it].z + acc[it].w);
                    s += __shfl_xor(s, 16); s += __shfl_xor(s, 32);
                    const float mean = s * (1.f / 64.f); float v = 0.f;
    #pragma unroll
                    for (int it = 0; it < 4; ++it) { acc[it] = acc[it] - mean; v += (acc[it].x * acc[it].x + acc[it].y * acc[it].y) + (acc[it].z * acc[it].z + acc[it].w * acc[it].w); }
                    v += __shfl_xor(v, 16); v += __shfl_xor(v, 32);
                    const float rstd = 1.0f / sqrtf(v * (1.f / 64.f) + 64e-5f);
                    bf16* orow = AR + (size_t)(b * SEQ + c * 64 + t) * DM + 1024 + h * 64 + 4 * q4;
    #pragma unroll
                    for (int it = 0; it < 4; ++it) {
                        const float o0 = acc[it].x * rstd * bflo(YV(ys[u].g1, it, 0)) + bflo(YV(ys[u].g2, it, 0)), o1 = acc[it].y * rstd * bfhi(YV(ys[u].g1, it, 0)) + bfhi(YV(ys[u].g2, it, 0));
                        const float o2 = acc[it].z * rstd * bflo(YV(ys[u].g1, it, 1)) + bflo(YV(ys[u].g2, it, 1)), o3 = acc[it].w * rstd * bfhi(YV(ys[u].g1, it, 1)) + bfhi(YV(ys[u].g2, it, 1));
                        *(v2u*)(orow + 16 * it) = (v2u){pk2(o0, o1), pk2(o2, o3)}; }
                asm volatile("" ::: "memory");
                    YLOAD(ys[u], c + 4);
                    __syncthreads();
                }
        }
        { const int c0 = 60;
#pragma unroll
                for (int u = 0; u < 4; ++u) { const int c = c0 + u;
                const LAS unsigned char* Scur = lds + (c & 1) * MATB;
                    f32x4v acc[4];
    #pragma unroll
                    for (int it = 0; it < 4; ++it) { acc[it] = (f32x4v){bflo(YV(ys[u].y0, it, 0)), bfhi(YV(ys[u].y0, it, 0)), bflo(YV(ys[u].y0, it, 1)), bfhi(YV(ys[u].y0, it, 1))};
                        const LAS unsigned char* sp = Scur + ((16 * it + l15) * CP + 8 * q4) * 2;
                        acc[it] = __builtin_amdgcn_mfma_f32_16x16x32_bf16(*(const LAS bf16x8*)sp, ys[u].b0, acc[it], 0, 0, 0);
                        acc[it] = __builtin_amdgcn_mfma_f32_16x16x32_bf16(*(const LAS bf16x8*)(sp + 64), ys[u].b1, acc[it], 0, 0, 0); }
                    float s = 0.f;
    #pragma unroll
                    for (int it = 0; it < 4; ++it) s += (acc[it].x + acc[it].y) + (acc[it].z + acc[it].w);
                    s += __shfl_xor(s, 16); s += __shfl_xor(s, 32);
                    const float mean = s * (1.f / 64.f); float v = 0.f;
    #pragma unroll
                    for (int it = 0; it < 4; ++it) { acc[it] = acc[it] - mean; v += (acc[it].x * acc[it].x + acc[it].y * acc[it].y) + (acc[it].z * acc[it].z + acc[it].w * acc[it].w); }
                    v += __shfl_xor(v, 16); v += __shfl_xor(v, 32);
                    const float rstd = 1.0f / sqrtf(v * (1.f / 64.f) + 64e-5f);
                    bf16* orow = AR + (size_t)(b * SEQ + c * 64 + t) * DM + 1024 + h * 64 + 4 * q4;
    #pragma unroll
                    for (int it = 0; it < 4; ++it) {
                        const float o0 = acc[it].x * rstd * bflo(YV(ys[u].g1, it, 0)) + bflo(YV(ys[u].g2, it, 0)), o1 = acc[it].y * rstd * bfhi(YV(ys[u].g1, it, 0)) + bfhi(YV(ys[u].g2, it, 0));
                        const float o2 = acc[it].z * rstd * bflo(YV(ys[u].g1, it, 1)) + bflo(YV(ys[u].g2, it, 1)), o3 = acc[it].w * rstd * bfhi(YV(ys[u].g1, it, 1)) + bfhi(YV(ys[u].g2, it, 1));
                        *(v2u*)(orow + 16 * it) = (v2u){pk2(o0, o1), pk2(o2, o3)}; }
                __syncthreads();
                }
        }
#undef YLOAD
#undef YV
    } else {
        const int nrow = 16 * w4 + l15;
        SSet ss[4];
#define SLOADX(S_, c_) do { const unsigned char* chk = chk0 + (size_t)(c_) * (32 * CHK_ITEM); const bf16* pt = (const bf16*)chk + (w4 * 128 + lane) * 8; S_.p0[0] = *(const bf16x8*)pt; S_.p1[0] = *(const bf16x8*)(pt + 512); \
        const bf16* q = (const bf16*)(chk + 1 * 8192) + (w4 * 256 + lane) * 4; \
        _Pragma("unroll") for (int it = 0; it < 4; ++it) S_.q[it] = *(const v2u*)(q + it * 256); } while (0)
#pragma unroll
        for (int u = 0; u < 4; ++u) SLOADX(ss[u], u);
        for (int c0 = 0; c0 < 60; c0 += 4) {
#pragma unroll
                for (int u = 0; u < 4; ++u) { const int c = c0 + u;
                const LAS unsigned char* Scur = lds + (c & 1) * MATB; LAS unsigned char* Snxt = lds + ((c & 1) ^ 1) * MATB;
    #pragma unroll
                    for (int it = 0; it < 4; ++it) { const int i = 16 * it + l15;
                        const LAS unsigned char* sp = Scur + (i * CP + 8 * q4) * 2; const bf16x8 s0 = *(const LAS bf16x8*)sp, s1 = *(const LAS bf16x8*)(sp + 64);
                        f32x4v acc = (f32x4v){bflo(ss[u].q[it].x), bfhi(ss[u].q[it].x), bflo(ss[u].q[it].y), bfhi(ss[u].q[it].y)};
                        acc = __builtin_amdgcn_mfma_f32_16x16x32_bf16(ss[u].p0[0], s0, acc, 0, 0, 0);
                        acc = __builtin_amdgcn_mfma_f32_16x16x32_bf16(ss[u].p1[0], s1, acc, 0, 0, 0);
                        *(LAS v2u*)(Snxt + (i * CP + 16 * w4 + 4 * q4) * 2) = (v2u){pk2(acc.x, acc.y), pk2(acc.z, acc.w)}; }
                asm volatile("" ::: "memory");
                    SLOADX(ss[u], c + 4);
                    __syncthreads();
                }
        }
        { const int c0 = 60;
#pragma unroll
                for (int u = 0; u < 4; ++u) { const int c = c0 + u;
                const LAS unsigned char* Scur = lds + (c & 1) * MATB; LAS unsigned char* Snxt = lds + ((c & 1) ^ 1) * MATB;
    #pragma unroll
                    for (int it = 0; it < 4; ++it) { const int i = 16 * it + l15;
                        const LAS unsigned char* sp = Scur + (i * CP + 8 * q4) * 2; const bf16x8 s0 = *(const LAS bf16x8*)sp, s1 = *(const LAS bf16x8*)(sp + 64);
                        f32x4v acc = (f32x4v){bflo(ss[u].q[it].x), bfhi(ss[u].q[it].x), bflo(ss[u].q[it].y), bfhi(ss[u].q[it].y)};
                        acc = __builtin_amdgcn_mfma_f32_16x16x32_bf16(ss[u].p0[0], s0, acc, 0, 0, 0);
                        acc = __builtin_amdgcn_mfma_f32_16x16x32_bf16(ss[u].p1[0], s1, acc, 0, 0, 0);
                        *(LAS v2u*)(Snxt + (i * CP + 16 * w4 + 4 * q4) * 2) = (v2u){pk2(acc.x, acc.y), pk2(acc.z, acc.w)}; }
                __syncthreads();
                }
        }
#undef SLOADX
    }
}

constexpr size_t WS_UB = WS_RWA;
constexpr size_t WS_VB = WS_RWA + 32 * MiB;
constexpr float U_SCALE = 512.f, V_SCALE = 32.f;
constexpr int SLICE_BYTES = 16384 * 128;
typedef float f32x2 __attribute__((ext_vector_type(2)));
__device__ __forceinline__ void phase_convert_tables(KP P, LAS unsigned char* lds) {
    const int tid = ltid(); constexpr int N16 = 16384 * 2048 / 16, GPT = 4, CH = GPT * NTHR, NCH = 2 * N16 / CH;
    unsigned* ctr = (unsigned*)(P.ws + WS_CTL) + CW_MOBA_CTR; LAS int* slot = (LAS int*)lds;
    const int q = tid & 127;
    f32x4 gu[4];
#pragma unroll
    for (int m = 0; m < 4; ++m) gu[m] = *(const f32x4*)(P.norm2_g + 16 * q + 4 * m) * U_SCALE;
    __syncthreads();
    if (tid == 0) slot[0] = (int)__hip_atomic_fetch_add(ctr, 1u, __ATOMIC_RELAXED, __HIP_MEMORY_SCOPE_AGENT);
    __syncthreads();
    for (int it = 0;; ++it) {
        const int c = slot[it & 1]; if (c >= NCH) break;
        if (tid == 0) slot[(it & 1) ^ 1] = (int)__hip_atomic_fetch_add(ctr, 1u, __ATOMIC_RELAXED, __HIP_MEMORY_SCOPE_AGENT);
        const bool isv = c >= NCH / 2;
        const int j0 = (isv ? c - NCH / 2 : c) * CH + tid;
        const float* src = (isv ? P.pv : P.pu) + (size_t)j0 * 16;
        unsigned char* dst = P.ws + (isv ? WS_VB : WS_UB) + (size_t)(q >> 3) * SLICE_BYTES + (size_t)(j0 >> 7) * 128 + (q & 7) * 16;
        f32x4 sc[4];
#pragma unroll
        for (int m = 0; m < 4; ++m) sc[m] = isv ? (f32x4){V_SCALE, V_SCALE, V_SCALE, V_SCALE} : gu[m];
#pragma unroll
        for (int hb = 0; hb < 1; ++hb) {
            f32x4 a[4][4];
#pragma unroll
            for (int k = 0; k < 4; ++k)
#pragma unroll
                for (int m = 0; m < 4; ++m) a[k][m] = *(const f32x4*)(src + (size_t)(4 * hb + k) * (NTHR * 16) + 4 * m);
#pragma unroll
            for (int k = 0; k < 4; ++k) { v4u o;
#pragma unroll
                for (int m = 0; m < 4; ++m) { const f32x4 v = a[k][m] * sc[m]; int p = 0;
                    p = __builtin_amdgcn_cvt_pk_fp8_f32(v.x, v.y, p, false); p = __builtin_amdgcn_cvt_pk_fp8_f32(v.z, v.w, p, true); o[m] = (unsigned)p; }
                *(v4u*)(dst + (size_t)(4 * hb + k) * 512) = o; }
        }
        __syncthreads();
    }
}
__device__ __forceinline__ f32x2 dot16p(const v4u u, const f32x2* x, f32x2 acc) {
#pragma unroll
    for (int q = 0; q < 4; ++q) { const f32x2 lo = __builtin_amdgcn_cvt_pk_f32_fp8((int)u[q], false), hi = __builtin_amdgcn_cvt_pk_f32_fp8((int)u[q], true);
        acc = __builtin_elementwise_fma(lo, x[2 * q], acc); acc = __builtin_elementwise_fma(hi, x[2 * q + 1], acc); }
    return acc;
}
__device__ __forceinline__ void axpy16p(const v4u v, f32x2 s, f32x2* y) {
#pragma unroll
    for (int q = 0; q < 4; ++q) { const f32x2 lo = __builtin_amdgcn_cvt_pk_f32_fp8((int)v[q], false), hi = __builtin_amdgcn_cvt_pk_f32_fp8((int)v[q], true);
        y[2 * q] = __builtin_elementwise_fma(s, lo, y[2 * q]); y[2 * q + 1] = __builtin_elementwise_fma(s, hi, y[2 * q + 1]); }
}
__device__ __forceinline__ float xsum_g8(float v) {
    v += DPP_F(v, 0x128);
    { auto r = __builtin_amdgcn_permlane16_swap(__float_as_uint(v), __float_as_uint(v), false, false); v = __uint_as_float(r[0]) + __uint_as_float(r[1]); }
    { auto r = __builtin_amdgcn_permlane32_swap(__float_as_uint(v), __float_as_uint(v), false, false); v = __uint_as_float(r[0]) + __uint_as_float(r[1]); }
    return v;
}
__device__ __forceinline__ void phase_peer_sliced(KP P, LAS unsigned char* lds, int bx, int G) {
    const int grp = bx & 7;
    const unsigned char* UB = P.ws + WS_UB; const unsigned char* VB = P.ws + WS_VB; const bf16* HB = (const bf16*)(P.ws + WS_XN);
    const int* ridx = (const int*)(P.ws + WS_PROJ + 64 * MiB); const float* rgate = (const float*)(P.ws + WS_PROJ + 68 * MiB); const float* RSTD = (const float*)(P.ws + WS_SSP + 2 * MiB);
    for (int bt = bx; bt < TT / 32; bt += G) {
        const int tid = ltid(), lane = tid & 63, wave = __builtin_amdgcn_readfirstlane(tid >> 6), g8 = lane >> 3, p = lane & 7;
        LAS int* idxT = (LAS int*)(lds + wave * 4096); LAS float* gT = (LAS float*)(lds + wave * 4096 + 2048);
        LAS bf16* h2T = (LAS bf16*)(lds + 32768 + wave * 16384);
        const int t0 = 32 * bt + 4 * wave;
#pragma unroll
        for (int i = 0; i < 4; ++i) { const size_t o = (size_t)(t0 + i) * 128; const int wofs = (i * 8 + (lane & 7)) * 16 + (lane >> 3);
            idxT[wofs] = ridx[o + lane]; idxT[wofs + 8] = ridx[o + 64 + lane]; gT[wofs] = rgate[o + lane]; gT[wofs + 8] = rgate[o + 64 + lane]; }
        float hacc[4][2];
#pragma unroll
        for (int i = 0; i < 4; ++i) { hacc[i][0] = 0.f; hacc[i][1] = 0.f; }
        {
            v4u rA[8], rB[8]; f32x2 xA[8], xB[8];
#define PS_SG(s_) (((s_) + 2 * grp) & 15)
#define PS_ISSUE(R, tabbase, s_, i_, hb_) do { const unsigned char* tb_ = (tabbase) + (size_t)PS_SG(s_) * SLICE_BYTES;        \
            const v4u ia_ = *(const LAS v4u*)(idxT + ((i_) * 8 + g8) * 16 + 8 * (hb_)), ib_ = *(const LAS v4u*)(idxT + ((i_) * 8 + g8) * 16 + 8 * (hb_) + 4); const unsigned po_ = 16u * (unsigned)p; \
            R[0] = *(const v4u*)(tb_ + (ia_[0] * 128u + po_)); R[1] = *(const v4u*)(tb_ + (ia_[1] * 128u + po_)); R[2] = *(const v4u*)(tb_ + (ia_[2] * 128u + po_)); R[3] = *(const v4u*)(tb_ + (ia_[3] * 128u + po_)); \
            R[4] = *(const v4u*)(tb_ + (ib_[0] * 128u + po_)); R[5] = *(const v4u*)(tb_ + (ib_[1] * 128u + po_)); R[6] = *(const v4u*)(tb_ + (ib_[2] * 128u + po_)); R[7] = *(const v4u*)(tb_ + (ib_[3] * 128u + po_)); } while (0)
#define PS_LOADX(X, s_, i_) do { const bf16* xp_ = HB + (size_t)(t0 + (i_)) * DM + 128 * PS_SG(s_) + 16 * p; const v4u xa_ = *(const v4u*)xp_, xb_ = *(const v4u*)(xp_ + 8); \
            _Pragma("unroll") for (int q = 0; q < 4; ++q) { X[q] = (f32x2){bflo(xa_[q]), bfhi(xa_[q])}; X[4 + q] = (f32x2){bflo(xb_[q]), bfhi(xb_[q])}; } } while (0)
#define PS_DOTS(R, X, i_, hb_) do { _Pragma("unroll") for (int m = 0; m < 8; ++m) { const f32x2 a2_ = dot16p(R[m], X, (f32x2){0.f, 0.f}); float sd_ = a2_.x + a2_.y; \
            sd_ += DPP_F(sd_, 0xB1); sd_ += DPP_F(sd_, 0x4E); sd_ += DPP_F(sd_, 0x141); if (p == m) hacc[i_][hb_] += sd_; } asm volatile("" ::: "memory"); } while (0)
            PS_LOADX(xA, 0, 0); PS_ISSUE(rA, UB, 0, 0, 0);
            for (int s = 0; s < 16; ++s) {
                PS_ISSUE(rB, UB, s, 0, 1); PS_LOADX(xB, s, 1);  PS_DOTS(rA, xA, 0, 0);
                PS_ISSUE(rA, UB, s, 1, 0);                       PS_DOTS(rB, xA, 0, 1);
                PS_ISSUE(rB, UB, s, 1, 1); PS_LOADX(xA, s, 2);  PS_DOTS(rA, xB, 1, 0);
                PS_ISSUE(rA, UB, s, 2, 0);                       PS_DOTS(rB, xB, 1, 1);
                PS_ISSUE(rB, UB, s, 2, 1); PS_LOADX(xB, s, 3);  PS_DOTS(rA, xA, 2, 0);
                PS_ISSUE(rA, UB, s, 3, 0);                       PS_DOTS(rB, xA, 2, 1);
                PS_ISSUE(rB, UB, s, 3, 1); if (s + 1 < 16) PS_LOADX(xA, s + 1, 0);  PS_DOTS(rA, xB, 3, 0);
                if (s + 1 < 16) PS_ISSUE(rA, UB, s + 1, 0, 0);  PS_DOTS(rB, xB, 3, 1);
            }
#undef PS_LOADX
#undef PS_DOTS
        }
#pragma unroll
        for (int i = 0; i < 4; ++i) { const float rsn = RSTD[t0 + i] * (1.f / U_SCALE);
#pragma unroll
            for (int hb = 0; hb < 2; ++hb) { const float hp = hacc[i][hb] * rsn; LAS float* gp = gT + (i * 8 + g8) * 16 + 8 * hb + p;
                *gp = 0.5f * hp * (1.f + erff(hp * 0.70710678118654752f)) * (1.f / V_SCALE) * *gp; } }
        float ssq[4] = {0.f, 0.f, 0.f, 0.f};
        {
            v4u rA[8], rB[8]; f32x2 y2[8];
#define PS_AXPY(R, i_, hb_) do { const f32x4 aa_ = *(const LAS f32x4*)(gT + ((i_) * 8 + g8) * 16 + 8 * (hb_)), ab_ = *(const LAS f32x4*)(gT + ((i_) * 8 + g8) * 16 + 8 * (hb_) + 4); \
            if ((hb_) == 0) { _Pragma("unroll") for (int q = 0; q < 8; ++q) y2[q] = (f32x2){0.f, 0.f}; } \
            _Pragma("unroll") for (int m = 0; m < 8; ++m) { const float av_ = m < 4 ? aa_[m & 3] : ab_[m & 3]; axpy16p(R[m], (f32x2){av_, av_}, y2); } asm volatile("" ::: "memory"); } while (0)
#define PS_FIN(s_, i_) do { f32x2 ysel_ = {0.f, 0.f}; _Pragma("unroll") for (int q = 0; q < 8; ++q) { const float a_ = xsum_g8(y2[q].x), b_ = xsum_g8(y2[q].y); if (g8 == q) ysel_ = (f32x2){a_, b_}; } \
            const int d_ = 128 * PS_SG(s_) + 16 * p + 2 * g8; const unsigned hb_ = *(const unsigned*)(HB + (size_t)(t0 + (i_)) * DM + d_); const f32x2 hv_ = (f32x2){bflo(hb_), bfhi(hb_)} + ysel_; \
            *(LAS unsigned*)(h2T + (i_) * DM + d_) = pk2(hv_.x, hv_.y); ssq[i_] += hv_.x * hv_.x + hv_.y * hv_.y; } while (0)
            PS_ISSUE(rA, VB, 0, 0, 0);
            for (int s = 0; s < 16; ++s) {
                PS_ISSUE(rB, VB, s, 0, 1); PS_AXPY(rA, 0, 0);
                PS_ISSUE(rA, VB, s, 1, 0); PS_AXPY(rB, 0, 1); PS_FIN(s, 0);
                PS_ISSUE(rB, VB, s, 1, 1); PS_AXPY(rA, 1, 0);
                PS_ISSUE(rA, VB, s, 2, 0); PS_AXPY(rB, 1, 1); PS_FIN(s, 1);
                PS_ISSUE(rB, VB, s, 2, 1); PS_AXPY(rA, 2, 0);
                PS_ISSUE(rA, VB, s, 3, 0); PS_AXPY(rB, 2, 1); PS_FIN(s, 2);
                PS_ISSUE(rB, VB, s, 3, 1); PS_AXPY(rA, 3, 0);
                if (s + 1 < 16) PS_ISSUE(rA, VB, s + 1, 0, 0); PS_AXPY(rB, 3, 1); PS_FIN(s, 3);
            }
#undef PS_AXPY
#undef PS_FIN
#undef PS_ISSUE
#undef PS_SG
        }
        { f32x4 fg[8];
#pragma unroll
          for (int j = 0; j < 8; ++j) fg[j] = *(const f32x4*)(P.final_g + 4 * lane + 256 * j);
#pragma unroll
          for (int i = 0; i < 4; ++i) { const float rs2 = 1.0f / sqrtf(wave_sum(ssq[i]) * (1.f / DM) + RMS_EPS);
#pragma unroll
            for (int j = 0; j < 8; ++j) { const v2u hv = *(const LAS v2u*)(h2T + i * DM + 4 * lane + 256 * j);
                *(f32x4*)(P.out + (size_t)(t0 + i) * DM + 4 * lane + 256 * j) = (f32x4){bflo(hv.x) * rs2 * fg[j].x, bfhi(hv.x) * rs2 * fg[j].y, bflo(hv.y) * rs2 * fg[j].z, bfhi(hv.y) * rs2 * fg[j].w}; } } }
        asm volatile("" ::: "memory");
    }
}
namespace moba {
constexpr float SCALE = 0.08838834764831845f;
constexpr float THR = 8.f;
constexpr bool WSKIP = false;
constexpr int D = 128, NW = 8, QBLK = 32, KVBLK = 64, QB = NW * QBLK;
constexpr int SHM_V = KVBLK * D * 2, SHM_K = KVBLK * D * 2;
constexpr int ATT_LDS_BYTES = 2 * SHM_V + 2 * SHM_K + NW * 64 * 4;
constexpr int KPITCH = INCP, QPITCH = INCP, OPITCH = DM;
typedef unsigned short bf16;
typedef short bf16x8 __attribute__((ext_vector_type(8)));
typedef short s16x4 __attribute__((ext_vector_type(4)));
typedef float f32x16 __attribute__((ext_vector_type(16)));
typedef float f32x4 __attribute__((ext_vector_type(4)));
typedef unsigned u32x4 __attribute__((ext_vector_type(4)));
template <class A, class Bt> struct same_t { static constexpr bool v = false; };
template <class A> struct same_t<A, A> { static constexpr bool v = true; };
#define KSWZ(row, colB) ((row) * 256 + ((colB) ^ (((row) & 7) << 4)))
#define SBAR() __builtin_amdgcn_sched_barrier(0)
__device__ __forceinline__ int v_st(int k, int c) { const int kk = (k & ~0xC) | ((k & 4) << 1) | ((k & 8) >> 1); return ((kk >> 3) * 4 + (c >> 5)) * 512 + ((kk & 7) * 32 + (c & 31)) * 2; }
__device__ __forceinline__ int v_rd_base(int lane) { return ((lane & 3) << 3) | (((lane >> 2) & 3) << 6) | (((lane >> 4) & 1) << 5) | (((lane >> 5) & 1) << 8); }
constexpr int v_rd_off(int d0, int ks, int half) { return d0 * 512 + ks * 4096 + half * 2048; }
__device__ __forceinline__ int crow(int r, int hi) { return (r & 3) + 8 * (r >> 2) + 4 * hi; }
__device__ __forceinline__ unsigned cvtpk(float lo, float hi) {
    unsigned r; asm volatile("v_cvt_pk_bf16_f32 %0, %1, %2" : "=v"(r) : "v"(lo), "v"(hi)); return r;
}
__device__ __forceinline__ bf16x8 pack8(f32x4 a, f32x4 b) {
    u32x4 w = {cvtpk(a[0], a[1]), cvtpk(a[2], a[3]), cvtpk(b[0], b[1]), cvtpk(b[2], b[3])};
    return *reinterpret_cast<bf16x8*>(&w);
}
template <class T> __device__ __forceinline__ bf16x8 load8(const T* p) {
    if constexpr (same_t<T, float>::v) { return pack8(*(const f32x4*)p, *(const f32x4*)(p + 4)); }
    else { return *reinterpret_cast<const bf16x8*>(p); }
}
__device__ __forceinline__ void mask_tile(f32x16& p0, f32x16& p1, int dq, unsigned W) {
    const float NEG = -__builtin_inff();
#pragma unroll
    for (int r = 0; r < 16; ++r) {
        const int c = (r & 3) + 8 * (r >> 2);
        if ((unsigned)(dq - c) >= W) p0[r] = NEG;
        if ((unsigned)(dq - c - 32) >= W) p1[r] = NEG;
    }
}
__device__ __forceinline__ void partialSM(f32x16& p0, f32x16& p1, float& m_reg, float& mn, float& alpha, float base0, float base1) {
    float pm0 = p0[0]; for (int r = 1; r < 16; ++r) pm0 = fmaxf(pm0, p0[r]); float pm1 = p1[0]; for (int r = 1; r < 16; ++r) pm1 = fmaxf(pm1, p1[r]);
    float pmax = fmaxf(pm0 + base0, pm1 + base1);
    { auto rr = __builtin_amdgcn_permlane32_swap(__float_as_uint(pmax), __float_as_uint(pmax), false, false);
      pmax = fmaxf(__uint_as_float(rr[0]), __uint_as_float(rr[1])); }
    constexpr float C2 = 1.4426950408889634f * SCALE;
    if (__builtin_expect(__all((pmax - m_reg) * SCALE <= THR), 1)) { mn = m_reg; alpha = 1.f; }
    else { mn = fmaxf(m_reg, pmax); alpha = __builtin_amdgcn_exp2f((m_reg - mn) * C2); m_reg = mn; }
    const float mnL0 = (base0 - mn) * C2, mnL1 = (base1 - mn) * C2;
    for (int r = 0; r < 16; ++r) p0[r] = fmaf(p0[r], C2, mnL0); for (int r = 0; r < 16; ++r) p1[r] = fmaf(p1[r], C2, mnL1);
    for (int r = 0; r < 16; ++r) p0[r] = __builtin_amdgcn_exp2f(p0[r]);
}
__device__ __forceinline__ void finishSM(f32x16& p0, f32x16& p1, float alpha, float& l_reg, bf16x8& pa0, bf16x8& pa1, bf16x8& pa2, bf16x8& pa3) {
    for (int r = 0; r < 16; ++r) p1[r] = __builtin_amdgcn_exp2f(p1[r]);
    float ps = 0; for (int r = 0; r < 16; ++r) ps += p0[r]; for (int r = 0; r < 16; ++r) ps += p1[r];
    { auto rr = __builtin_amdgcn_permlane32_swap(__float_as_uint(ps), __float_as_uint(ps), false, false);
      ps = __uint_as_float(rr[0]) + __uint_as_float(rr[1]); }
    l_reg = l_reg * alpha + ps;
#define PK4(P, B_, OUT) do { unsigned a0 = cvtpk(P[B_+0], P[B_+1]), a1 = cvtpk(P[B_+2], P[B_+3]);                          \
        unsigned b0 = cvtpk(P[B_+4], P[B_+5]), b1 = cvtpk(P[B_+6], P[B_+7]);                                             \
        auto r0 = __builtin_amdgcn_permlane32_swap(a0, b0, false, false); auto r1 = __builtin_amdgcn_permlane32_swap(a1, b1, false, false); \
        u32x4 w = {r0[0], r1[0], r0[1], r1[1]}; OUT = *reinterpret_cast<bf16x8*>(&w); } while (0)
    PK4(p0, 0, pa0); PK4(p0, 8, pa1); PK4(p1, 0, pa2); PK4(p1, 8, pa3);
#undef PK4
}
template <int KB, bool SK>
__device__ __forceinline__ void qkt(f32x16& p0, f32x16& p1, const char* K_lds, int r32, int hi, const bf16x8* qr, bool act) {
    if (SK && !act) { const float NEG = -__builtin_inff();
#pragma unroll
        for (int r = 0; r < 16; ++r) { p0[r] = NEG; p1[r] = NEG; } return; }
    p0 = f32x16{}; p1 = f32x16{};
    const char* kb[4];
#pragma unroll
    for (int dd = 0; dd < 4; ++dd) kb[dd] = K_lds + KB * SHM_K + KSWZ(r32, (dd * 16 + hi * 8) * 2);
#pragma unroll
    for (int d0 = 0; d0 < 8; ++d0) { const char* a = kb[d0 & 3] + (d0 >> 2) * 128;
        bf16x8 b0 = *reinterpret_cast<const bf16x8*>(a);
        bf16x8 b1 = *reinterpret_cast<const bf16x8*>(a + 32 * 256);
        p0 = __builtin_amdgcn_mfma_f32_32x32x16_bf16(b0, qr[d0], p0, 0, 0, 0);
        p1 = __builtin_amdgcn_mfma_f32_32x32x16_bf16(b1, qr[d0], p1, 0, 0, 0); }
}
template <int VB, bool SK>
__device__ __forceinline__ void pv_tile(f32x16* o, int vb0, bf16x8 pa0, bf16x8 pa1, bf16x8 pa2, bf16x8 pa3, bool act) {
    if (SK && !act) return;
#define TRRD(dst, off) asm volatile("ds_read_b64_tr_b16 %0, %1 offset:%2" : "=&v"(dst) : "v"(vb0), "i"(off) : "memory")
#define PV_D0(d0) do { s16x4 l0, l1, h0, h1; constexpr int b_ = VB * SHM_V + v_rd_off(d0, 0, 0);     \
        TRRD(l0, b_); TRRD(h0, b_ + 2048); TRRD(l1, b_ + 4096); TRRD(h1, b_ + 6144); \
        asm volatile("s_waitcnt lgkmcnt(0)" ::: "memory"); SBAR();                 \
        o[d0] = __builtin_amdgcn_mfma_f32_32x32x16_bf16(pa0, (bf16x8){l0[0], l0[1], l0[2], l0[3], h0[0], h0[1], h0[2], h0[3]}, o[d0], 0, 0, 0);   \
        o[d0] = __builtin_amdgcn_mfma_f32_32x32x16_bf16(pa1, (bf16x8){l1[0], l1[1], l1[2], l1[3], h1[0], h1[1], h1[2], h1[3]}, o[d0], 0, 0, 0);   \
        SBAR(); TRRD(l0, b_ + 8192); TRRD(h0, b_ + 10240); TRRD(l1, b_ + 12288); TRRD(h1, b_ + 14336); \
        asm volatile("s_waitcnt lgkmcnt(0)" ::: "memory"); SBAR();   \
        o[d0] = __builtin_amdgcn_mfma_f32_32x32x16_bf16(pa2, (bf16x8){l0[0], l0[1], l0[2], l0[3], h0[0], h0[1], h0[2], h0[3]}, o[d0], 0, 0, 0);   \
        o[d0] = __builtin_amdgcn_mfma_f32_32x32x16_bf16(pa3, (bf16x8){l1[0], l1[1], l1[2], l1[3], h1[0], h1[1], h1[2], h1[3]}, o[d0], 0, 0, 0); } while (0)
    PV_D0(0); PV_D0(1); PV_D0(2); PV_D0(3);
#undef PV_D0
#undef TRRD
}

template <class TIn, class TOut> struct BlockRef { const TIn* Q; const TIn* K; const TIn* V; TOut* O; int P0; const float* KM; float A; int jlo, jhi; float* ST; };
template <class TIn> struct Seam {
    bf16x8 qr[8];
    bf16x8 st_v0, st_v1, st_k0, st_k1; f32x4 sf0, sf1, sf2, sf3;
    f32x4 tq[16];
};
__device__ __forceinline__ int swa_jlo(int P0, int W) { const int lowk = P0 - W + 1; return lowk > 0 ? lowk / KVBLK : 0; }
#define ROW(p, k0, rr) ((p) + (size_t)((k0) + (rr)) * KPITCH + sc)
#define VMW() asm volatile("s_waitcnt vmcnt(0)" ::: "memory")
#define VMWN(n) asm volatile("s_waitcnt vmcnt(%0)" :: "i"(n) : "memory")
#define SLOAD_H(Kp, Vp, k0) do { S.st_v0 = load8<TIn>(ROW(Vp, k0, sr)); S.st_v1 = load8<TIn>(ROW(Vp, k0, 32 + sr));              \
                         S.st_k0 = load8<TIn>(ROW(Kp, k0, sr)); S.st_k1 = load8<TIn>(ROW(Kp, k0, 32 + sr)); } while (0)
#define SWRITE_HK(bf) do { *(bf16x8*)(K_lds + (bf) * SHM_K + kws) = S.st_k0; *(bf16x8*)(K_lds + (bf) * SHM_K + kws + 32 * 256) = S.st_k1; } while (0)
#define SWRITE_HV(bf) do { *(bf16x8*)(V_lds + (bf) * SHM_V + vst0) = S.st_v0; *(bf16x8*)(V_lds + (bf) * SHM_V + vst1) = S.st_v1; } while (0)
#define SWRITE_H(bf) do { SWRITE_HV(bf); SWRITE_HK(bf); } while (0)
#define SLOAD_F(p, k0) do { S.sf0 = *(const f32x4*)ROW(p, k0, sr); S.sf1 = *(const f32x4*)(ROW(p, k0, sr) + 4);                \
                            S.sf2 = *(const f32x4*)ROW(p, k0, 32 + sr); S.sf3 = *(const f32x4*)(ROW(p, k0, 32 + sr) + 4); } while (0)
#define SWRITE_KF(bf) do { *(bf16x8*)(K_lds + (bf) * SHM_K + kws) = pack8(S.sf0, S.sf1); *(bf16x8*)(K_lds + (bf) * SHM_K + kws + 32 * 256) = pack8(S.sf2, S.sf3); } while (0)
#define SWRITE_VF(bf) do { *(bf16x8*)(V_lds + (bf) * SHM_V + vst0) = pack8(S.sf0, S.sf1); *(bf16x8*)(V_lds + (bf) * SHM_V + vst1) = pack8(S.sf2, S.sf3); } while (0)
template <class TIn, class TOut>
__device__ __forceinline__ void causal_swa_prime(const BlockRef<TIn, TOut>& cur, int W, char* lds, Seam<TIn>& S) {
    constexpr bool F32 = same_t<TIn, float>::v;
    const int tid = ltid(), wid = __builtin_amdgcn_readfirstlane(tid >> 6), lane = tid & 63, r32 = lane & 31, hi = lane >> 5;
    const int sr = tid >> 4, sc = (tid & 15) * 8, kws = KSWZ(sr, sc * 2); char* K_lds = lds + 2 * SHM_V;
    const int kb0 = cur.jlo * KVBLK;
    for (int d0 = 0; d0 < 8; ++d0) S.qr[d0] = load8<TIn>(cur.Q + (size_t)(wid * QBLK + r32) * QPITCH + d0 * 16 + hi * 8);
    if constexpr (F32) { SLOAD_F((const float*)cur.K, kb0); VMW(); SWRITE_KF(0); SBAR(); SLOAD_F((const float*)cur.V, kb0); }
    else { SLOAD_H(cur.K, cur.V, kb0); VMW(); SWRITE_HK(0); }
    __syncthreads();
}
template <class TIn, class TOut>
__device__ __forceinline__ void causal_swa_block(const BlockRef<TIn, TOut>& cur, const BlockRef<TIn, TOut>& nxt, int skv, int W, char* lds, Seam<TIn>& S) {
    constexpr bool F32 = same_t<TIn, float>::v;
    const int tid = ltid(), wid = __builtin_amdgcn_readfirstlane(tid >> 6), lane = tid & 63, r32 = lane & 31, hi = lane >> 5;
    const int j_lo = cur.jlo, j_hi = cur.jhi;
    const int NT = j_hi - j_lo;
    const int kbn = nxt.jlo * KVBLK;
    const int qlo = cur.P0 + wid * QBLK, qm = qlo + r32 - 4 * hi;
    char* V_lds = lds; char* K_lds = lds + 2 * SHM_V;
    float* ws = (float*)(lds + 2 * SHM_V + 2 * SHM_K) + wid * 64; float* li_l = ws, * al_l = ws + 32;
    float m_reg = -1e30f, l_reg = 0; f32x16 o[4] = {};
    const int sr = tid >> 4, sc = (tid & 15) * 8, vst0 = v_st(sr, sc), vst1 = v_st(32 + sr, sc), kws = KSWZ(sr, sc * 2);
    const int vb0 = (int)(uintptr_t)V_lds + v_rd_base(lane);
    const TIn* Kh = cur.K; const TIn* Vh = cur.V;
    const float alA_ = cur.A;
    unsigned selm = 0u;
    { const int qb_ = cur.P0 >> 8;
      if (qb_ > 0) {
        float* kmL = (float*)(K_lds + SHM_K);
        *(f32x4*)(kmL + 4 * tid) = *(const f32x4*)(cur.KM + (size_t)(tid >> 5) * 1024 + 4 * (tid & 31));
        __syncthreads();
        float g[16];
#pragma unroll
        for (int n = 0; n < 16; ++n) g[n] = 0.f;
#pragma unroll
        for (int d0 = 0; d0 < 8; ++d0) { float qf[8];
#pragma unroll
            for (int j = 0; j < 8; ++j) qf[j] = __uint_as_float(((unsigned)(unsigned short)S.qr[d0][j]) << 16);
#pragma unroll
            for (int n = 0; n < 16; ++n) if (n < qb_) { const f32x4 k0 = *(const f32x4*)(kmL + n * 128 + d0 * 16 + hi * 8), k1 = *(const f32x4*)(kmL + n * 128 + d0 * 16 + hi * 8 + 4);
                g[n] += qf[0] * k0[0] + qf[1] * k0[1] + qf[2] * k0[2] + qf[3] * k0[3] + qf[4] * k1[0] + qf[5] * k1[1] + qf[6] * k1[2] + qf[7] * k1[3]; }
            asm volatile("" ::: "memory"); }
#pragma unroll
        for (int n = 0; n < 16; ++n) { const float a = g[n] + __shfl_xor(g[n], 32); g[n] = n < qb_ ? a : -1e30f; }
#pragma unroll
        for (int r = 0; r < 3; ++r) { float best = -3e38f; int bi = 0;
#pragma unroll
            for (int n = 0; n < 16; ++n) if (!((selm >> n) & 1u) && g[n] > best) { best = g[n]; bi = n; }
            selm |= 1u << bi; }
        selm &= (1u << qb_) - 1u;
        __syncthreads();
      }
      li_l[r32] = __uint_as_float(selm); }
#define RESC(a) do { if (__any((a) < 1.f)) { if (hi == 0) al_l[r32] = (a); asm volatile("s_waitcnt lgkmcnt(0)" ::: "memory");              \
                     for (int d_ = 0; d_ < 4; ++d_) for (int r = 0; r < 16; ++r) o[d_][r] *= al_l[crow(r, hi)]; } } while (0)
#define KBASE(t) ((j_lo + (t)) * KVBLK)
#define ACT(t) (KBASE(t) <= qlo + QBLK - 1 && KBASE(t) + KVBLK - 1 >= qlo - W + 1)
#define MASKT(P0_, P1_, t) do { const int kb_ = KBASE(t); if ((!SK || ACT(t)) && (kb_ + KVBLK - 1 > qlo || kb_ <= qlo + QBLK - 1 - W)) mask_tile(P0_, P1_, qm - kb_, (unsigned)W); \
        _Pragma("unroll") for (int r = 0; r < 16; ++r) { const float c_ = (float)((r & 3) + 8 * (r >> 2)); P0_[r] = fmaf(alA_, c_, P0_[r]); P1_[r] = fmaf(alA_, c_, P1_[r]); } } while (0)
#define BASE0(t) ((KBASE(t) < cur.P0 && !((__float_as_uint(li_l[r32]) >> (KBASE(t) >> 8)) & 1u)) ? -__builtin_inff() : alA_ * (float)(KBASE(t) - cur.P0 + 4 * hi))
#define BASE1(t) (BASE0(t) + 32.f * alA_)
    constexpr int NQL = F32 ? 16 : 8;
    constexpr bool SK = WSKIP && !F32;
#define SEAM_K0() do { VMWN(NQL); if constexpr (F32) { SWRITE_KF(0); SBAR(); SLOAD_F((const float*)nxt.V, kbn); } else { SWRITE_HK(0); } SBAR(); } while (0)
    f32x16 pA0, pA1, pB0, pB1; float mnA, mnB, alA, alB; bf16x8 pa0, pa1, pa2, pa3;
    if constexpr (F32) { VMW(); SWRITE_VF(0); SBAR(); } else { SWRITE_HV(0); SBAR(); }
    if (NT > 1) { if constexpr (F32) SLOAD_F((const float*)Kh, KBASE(1)); else SLOAD_H(Kh, Vh, KBASE(1)); }
    SBAR(); qkt<0, SK>(pA0, pA1, K_lds, r32, hi, S.qr, ACT(0));
    if constexpr (F32) { if (NT > 1) { VMW(); SWRITE_KF(1); SBAR(); SLOAD_F((const float*)Vh, KBASE(1)); } }
    MASKT(pA0, pA1, 0); partialSM(pA0, pA1, m_reg, mnA, alA, BASE0(0), BASE1(0));
    if (NT > 1) { VMW(); if constexpr (F32) { SWRITE_VF(1); SBAR(); if (NT > 2) SLOAD_F((const float*)Kh, KBASE(2)); } else SWRITE_H(1); }
    __syncthreads();
#define HALF_STEP(PX0, PX1, mnX, alX, PY0, PY1, alY, t, KB, VB, SB) do {                                                      \
        SBAR(); qkt<KB, SK>(PX0, PX1, K_lds, r32, hi, S.qr, ACT(t));                                             \
        finishSM(PY0, PY1, alY, l_reg, pa0, pa1, pa2, pa3); SBAR();                                                           \
        if ((t) + 1 < NT) { if constexpr (F32) { VMW(); SWRITE_KF(SB); SBAR(); SLOAD_F((const float*)Vh, KBASE((t) + 1)); }  \
                            else { SLOAD_H(Kh, Vh, KBASE((t) + 1)); } SBAR(); }                                               \
        pv_tile<VB, SK>(o, vb0, pa0, pa1, pa2, pa3, ACT((t) - 1)); MASKT(PX0, PX1, (t)); partialSM(PX0, PX1, m_reg, mnX, alX, BASE0(t), BASE1(t));                                        \
        __syncthreads();                                                                                                      \
        if ((t) + 1 < NT) { VMW(); if constexpr (F32) { SWRITE_VF(SB); SBAR(); if ((t) + 2 < NT) SLOAD_F((const float*)Kh, KBASE((t) + 2)); } \
                            else { SWRITE_H(SB); } }                                                                          \
        RESC(alX); __syncthreads(); } while (0)
    for (int t = 1; t + 1 < NT; t += 2) {
        HALF_STEP(pB0, pB1, mnB, alB, pA0, pA1, alA, t, 1, 0, 0);
        HALF_STEP(pA0, pA1, mnA, alA, pB0, pB1, alB, t + 1, 0, 1, 1);
    }
    const bool even = (NT & 1) == 0;
    if (even) { SBAR(); qkt<1, SK>(pB0, pB1, K_lds, r32, hi, S.qr, ACT(NT - 1)); SBAR(); }
#define QROW(e) (nxt.Q + (size_t)(wid * QBLK + r32) * QPITCH + ((e) >> 1) * 16 + hi * 8 + ((e) & 1) * 4)
    if constexpr (F32) { SLOAD_F((const float*)nxt.K, kbn); SBAR();
#pragma unroll
        for (int e = 0; e < 8; ++e) S.tq[e] = *(const f32x4*)QROW(e); }
    else { SLOAD_H(nxt.K, nxt.V, kbn); SBAR();
#pragma unroll
        for (int d0 = 0; d0 < 8; ++d0) S.qr[d0] = load8<TIn>(nxt.Q + (size_t)(wid * QBLK + r32) * QPITCH + d0 * 16 + hi * 8); }
    SBAR();
    finishSM(pA0, pA1, alA, l_reg, pa0, pa1, pa2, pa3); SBAR();
    if constexpr (F32) {
#pragma unroll
        for (int e = 8; e < 16; ++e) S.tq[e] = *(const f32x4*)QROW(e); SBAR(); }
#undef QROW
    pv_tile<0, SK>(o, vb0, pa0, pa1, pa2, pa3, ACT(even ? NT - 2 : NT - 1));
    if (even) { MASKT(pB0, pB1, NT - 1); partialSM(pB0, pB1, m_reg, mnB, alB, BASE0(NT - 1), BASE1(NT - 1)); __syncthreads(); RESC(alB);
        finishSM(pB0, pB1, alB, l_reg, pa0, pa1, pa2, pa3); SBAR(); pv_tile<1, SK>(o, vb0, pa0, pa1, pa2, pa3, ACT(NT - 1)); }
    SBAR(); SEAM_K0();
    if (hi == 0) { li_l[r32] = l_reg; if (cur.ST) { cur.ST[(wid * QBLK + r32) * 16] = m_reg; cur.ST[(wid * QBLK + r32) * 16 + 1] = l_reg; } }
    asm volatile("s_waitcnt lgkmcnt(0)" ::: "memory");
    float rli[16];
#pragma unroll
    for (int r = 0; r < 16; ++r) { const float l_ = li_l[crow(r, hi)]; rli[r] = l_ > 0.f ? __builtin_amdgcn_rcpf(l_) : 0.f; }
    TOut* Ow = cur.O + (size_t)(wid * QBLK) * OPITCH;
#pragma unroll
    for (int r = 0; r < 16; ++r) { const int orow = crow(r, hi);
#pragma unroll
        for (int d0 = 0; d0 < 4; ++d0) { const float v = o[d0][r] * rli[r];
            if constexpr (same_t<TOut, float>::v) { Ow[(size_t)orow * OPITCH + d0 * 32 + r32] = v; }
            else { const float vn = __shfl_xor(v, 1);
                   if ((r32 & 1) == 0) *(unsigned*)(Ow + (size_t)orow * OPITCH + d0 * 32 + r32) = cvtpk(v, vn); } } }
    if constexpr (F32) {
#pragma unroll
        for (int d0 = 0; d0 < 8; ++d0) S.qr[d0] = pack8(S.tq[2 * d0], S.tq[2 * d0 + 1]); }
    __syncthreads();
#undef RESC
#undef KBASE
#undef ACT
#undef MASKT
#undef SEAM_K0
#undef HALF_STEP
}
#undef ROW
#undef VMW
#undef VMWN
#undef SLOAD_H
#undef SWRITE_HK
#undef SWRITE_HV
#undef SWRITE_H
#undef SLOAD_F
#undef SWRITE_KF
#undef SWRITE_VF

#undef BASE0
#undef BASE1
}
constexpr size_t WS_OSL = WS_XN, WS_OSU = WS_H;
constexpr size_t WS_STL = WS_WIN, WS_STU = WS_WIN + 1 * MiB;
constexpr int MOBA_SPLIT_QB = 9, MOBA_SPLIT_AT = 38;
__device__ __forceinline__ void phase_moba(KP P, char* lds, int vcu, int G) {
    typedef moba::BlockRef<moba::bf16, moba::bf16> BR;
    const moba::bf16* proj = (const moba::bf16*)(P.ws + WS_PROJ); moba::bf16* AR = (moba::bf16*)(P.ws + WS_AR); const float* kmean = (const float*)(P.ws + WS_KMEAN);
    constexpr int W = 1 << 30;
    auto mkref = [&](int bh, int qb, int part) -> BR { const int b = bh >> 3, h = bh & 7; BR r; const int nt = 4 * qb + 4;
        r.Q = proj + (size_t)(b * SEQ + qb * 256) * INCP + h * 128; r.K = proj + (size_t)(b * SEQ) * INCP + C_AK + h * 128; r.V = proj + (size_t)(b * SEQ) * INCP + C_AV + h * 128;
        moba::bf16* ob = part == 0 ? AR : (moba::bf16*)(P.ws + (part == 1 ? WS_OSL : WS_OSU));
        r.O = ob + (size_t)(b * SEQ + qb * 256) * DM + h * 128; r.P0 = qb * 256; r.KM = kmean + (size_t)(b * 16) * 1024 + h * 128; r.A = exp2f(-(float)(h + 1)) * (1.f / moba::SCALE);
        const int ks = qb == MOBA_SPLIT_QB ? nt - 4 : MOBA_SPLIT_AT;
        r.jlo = part == 2 ? ks : 0; r.jhi = part == 1 ? ks : nt;
        r.ST = part == 0 ? nullptr : (float*)(P.ws + (part == 1 ? WS_STL : WS_STU)) + ((size_t)(b * SEQ + qb * 256) * 8 + h) * 2;
        return r; };
    moba::Seam<moba::bf16> S;
    if (G == 256) {
        const int q_ = vcu & 15, bh = vcu >> 4;
        const int qbA[16] = { 1,  0,  7,  6,  5,  4,  3,  2, 15, 14, 13, 12, 11, 10,  9,  8};
        const int ptA[16] = { 0,  0,  0,  0,  0,  0,  0,  0,  1,  1,  1,  1,  1,  1,  1,  0};
        const int qbB[16] = {-1,  9, 10, 11, 12, 13, 14, 15, -1, -1, -1, -1, -1, -1, -1, -1};
        const int ptB[16] = { 0,  2,  2,  2,  2,  2,  2,  2,  0,  0,  0,  0,  0,  0,  0,  0};
        int qa = -1, pa = 0, qb2 = -1, pb = 0;
#pragma unroll
        for (int k = 0; k < 16; ++k) if (k == q_) { qa = qbA[k]; pa = ptA[k]; qb2 = qbB[k]; pb = ptB[k]; }
        for (int it = 0; it < 2; ++it) { const int qq = it == 0 ? qa : qb2, pp = it == 0 ? pa : pb; if (qq < 0) continue;
            const BR cur = mkref(bh, qq, pp);
            moba::causal_swa_prime<moba::bf16, moba::bf16>(cur, W, lds, S);
            moba::causal_swa_block<moba::bf16, moba::bf16>(cur, cur, SEQ, W, lds, S); }
    } else {
        for (int item = vcu; item < 256; item += G) {
            const BR cur = mkref(item >> 4, item & 15, 0);
            moba::causal_swa_prime<moba::bf16, moba::bf16>(cur, W, lds, S);
            moba::causal_swa_block<moba::bf16, moba::bf16>(cur, cur, SEQ, W, lds, S); }
    }
}
__device__ __forceinline__ void moba_combine(KP P, int vcu, int G) {
    if (G != 256) return;
    const int tid = ltid(); const bf16* OL = (const bf16*)(P.ws + WS_OSL); const bf16* OU = (const bf16*)(P.ws + WS_OSU); bf16* AR = (bf16*)(P.ws + WS_AR);
    const float* STL = (const float*)(P.ws + WS_STL); const float* STU = (const float*)(P.ws + WS_STU);
    constexpr int NSPL = 16 - MOBA_SPLIT_QB; constexpr float C2 = 1.4426950408889634f * moba::SCALE;
    for (int item = vcu; item < 16 * NSPL * 2; item += G) {
        const int half = item & 1, k = item >> 1, bh = k / NSPL, qb = MOBA_SPLIT_QB + k % NSPL, b = bh >> 3, h = bh & 7;
        const int row = b * SEQ + qb * 256 + half * 128 + (tid >> 2), c0 = (tid & 3) * 32;
        const size_t so = ((size_t)row * 8 + h) * 2; const float mL = STL[so], lL = STL[so + 1], mU = STU[so], lU = STU[so + 1];
        const float m = fmaxf(mL, mU); const float wL = lL * __builtin_amdgcn_exp2f((mL - m) * C2), wU = lU * __builtin_amdgcn_exp2f((mU - m) * C2); const float inv = __builtin_amdgcn_rcpf(wL + wU);
        const float aL = wL * inv, aU = wU * inv; const size_t o = (size_t)row * DM + h * 128 + c0;
        v4u l4[4], u4[4];
#pragma unroll
        for (int j = 0; j < 4; ++j) { l4[j] = *(const v4u*)(OL + o + 8 * j); u4[j] = *(const v4u*)(OU + o + 8 * j); }
#pragma unroll
        for (int j = 0; j < 4; ++j) { v4u r4;
#pragma unroll
            for (int e = 0; e < 4; ++e) r4[e] = pk2(aL * bflo(l4[j][e]) + aU * bflo(u4[j][e]), aL * bfhi(l4[j][e]) + aU * bfhi(u4[j][e]));
            *(v4u*)(AR + o + 8 * j) = r4; }
    }
}
constexpr size_t WS_SKB = WS_KMEAN + 256 * 1024;
__device__ __forceinline__ void prologue_subkeys(KP P, int vcu, int G) {
    unsigned* dst = (unsigned*)(P.ws + WS_SKB);
    for (int i = vcu * NTHR + ltid(); i < 8 * 2 * 128 * 128 / 2; i += G * NTHR) dst[i] = pk2(P.sub_keys[2 * i], P.sub_keys[2 * i + 1]);
}
__device__ __forceinline__ unsigned f2key(float v) { const unsigned u = __float_as_uint(v); return u ^ ((u >> 31) ? 0xFFFFFFFFu : 0x80000000u); }
__device__ __forceinline__ float key2f(unsigned k) { return __uint_as_float(k ^ ((k >> 31) ? 0x80000000u : 0xFFFFFFFFu)); }
__device__ __forceinline__ unsigned umax3(unsigned a, unsigned b, unsigned c) { return max(max(a, b), c); }
__device__ __forceinline__ void peer_route_tiles(KP P, LAS unsigned char* lds, int tt0, int nitems, int h) {
    const int tid = ltid(), lane = tid & 63, wave = __builtin_amdgcn_readfirstlane(tid >> 6), l15 = lane & 15, q4 = lane >> 4;
    const bf16* PQ = (const bf16*)(P.ws + WS_PROJ); const bf16* SKB = (const bf16*)(P.ws + WS_SKB);
    int* ridx = (int*)(P.ws + WS_PROJ + 64 * MiB); float* rgate = (float*)(P.ws + WS_PROJ + 68 * MiB);
    for (int it_ = 0; it_ < nitems; ++it_) {
        LAS float* sval = (LAS float*)(lds + it_ * 16384); LAS int* sidx = (LAS int*)(lds + it_ * 16384 + 8192);
        const int tt = tt0 + it_, p = wave & 1, sub = wave >> 1, tl = sub * 16 + l15;
        const bf16* qp = PQ + ((size_t)tt * 64 + tl) * DM + h * 256 + p * 128 + 8 * q4;
        bf16x8 qb[4];
#pragma unroll
        for (int kk = 0; kk < 4; ++kk) qb[kk] = *(const bf16x8*)(qp + 32 * kk);
        const bf16* sk = SKB + ((size_t)((h * 2 + p) * 128 + l15)) * 128 + 8 * q4;
        unsigned key[32];
#pragma unroll
        for (int nt = 0; nt < 8; ++nt) { f32x4v acc = {0.f, 0.f, 0.f, 0.f};
#pragma unroll
            for (int kk = 0; kk < 4; ++kk) acc = __builtin_amdgcn_mfma_f32_16x16x32_bf16(*(const bf16x8*)(sk + nt * 16 * 128 + 32 * kk), qb[kk], acc, 0, 0, 0);
#pragma unroll
            for (int e = 0; e < 4; ++e) key[4 * nt + e] = (f2key(acc[e]) & ~127u) | (unsigned)(127 - (16 * nt + 4 * q4 + e)); }
#define CE(a_, b_) { const unsigned hi_ = max(KA[a_], KA[b_]), lo_ = min(KA[a_], KA[b_]); KA[a_] = hi_; KA[b_] = lo_; }
#define SORT16_NET CE(0,1) CE(2,3) CE(0,2) CE(1,3) CE(1,2) CE(4,5) CE(6,7) CE(4,6) CE(5,7) CE(5,6) CE(0,4) CE(2,6) CE(2,4) CE(1,5) CE(3,7) CE(3,5) CE(1,2) CE(3,4) CE(5,6) CE(8,9) CE(10,11) CE(8,10) CE(9,11) CE(9,10) CE(12,13) CE(14,15) CE(12,14) CE(13,15) CE(13,14) CE(8,12) CE(10,14) CE(10,12) CE(9,13) CE(11,15) CE(11,13) CE(9,10) CE(11,12) CE(13,14) CE(0,8) CE(4,12) CE(4,8) CE(2,10) CE(6,14) CE(6,10) CE(2,4) CE(6,8) CE(10,12) CE(1,9) CE(5,13) CE(5,9) CE(3,11) CE(7,15) CE(7,11) CE(3,5) CE(7,9) CE(11,13) CE(1,2) CE(3,4) CE(5,6) CE(7,8) CE(9,10) CE(11,12) CE(13,14)
#define BMERGE16(T_) _Pragma("unroll") for (int d_ = 8; d_ >= 1; d_ >>= 1) { _Pragma("unroll") for (int i_ = 0; i_ < 16; ++i_) if ((i_ & d_) == 0) { const unsigned hi_ = max(T_[i_], T_[i_ + d_]), lo_ = min(T_[i_], T_[i_ + d_]); T_[i_] = hi_; T_[i_ + d_] = lo_; } }
#define KA key
        SORT16_NET
#undef KA
#define KA (key + 16)
        SORT16_NET
#undef KA
        unsigned t16[16];
#pragma unroll
        for (int i = 0; i < 16; ++i) t16[i] = max(key[i], key[31 - i]);
        BMERGE16(t16)
        { const bool odd = (lane & 16) != 0; unsigned L[16];
#pragma unroll
          for (int i = 0; i < 16; ++i) L[i] = odd ? t16[15 - i] : t16[i];
#pragma unroll
          for (int i = 0; i < 16; ++i) { auto x = __builtin_amdgcn_permlane16_swap(L[i], L[i], false, false); t16[i] = max(x[0], x[1]); }
          BMERGE16(t16) }
        { const bool odd = (lane & 32) != 0; unsigned L[16];
#pragma unroll
          for (int i = 0; i < 16; ++i) L[i] = odd ? t16[15 - i] : t16[i];
#pragma unroll
          for (int i = 0; i < 16; ++i) { auto x = __builtin_amdgcn_permlane32_swap(L[i], L[i], false, false); t16[i] = max(x[0], x[1]); }
          BMERGE16(t16) }
#undef CE
#undef SORT16_NET
#undef BMERGE16
        if (q4 == 0) {
#pragma unroll
            for (int r4 = 0; r4 < 4; ++r4) {
                *(LAS f32x4*)(sval + (tl * 2 + p) * 16 + 4 * r4) = (f32x4){key2f(t16[4 * r4] & ~127u), key2f(t16[4 * r4 + 1] & ~127u), key2f(t16[4 * r4 + 2] & ~127u), key2f(t16[4 * r4 + 3] & ~127u)};
                *(LAS v4u*)(sidx + (tl * 2 + p) * 16 + 4 * r4) = (v4u){127u - (t16[4 * r4] & 127u), 127u - (t16[4 * r4 + 1] & 127u), 127u - (t16[4 * r4 + 2] & 127u), 127u - (t16[4 * r4 + 3] & 127u)}; }
        }
    }
    __syncthreads();
    {
        const int it_ = wave; const int tt = tt0 + it_;
        LAS float* sval = (LAS float*)(lds + it_ * 16384); LAS int* sidx = (LAS int*)(lds + it_ * 16384 + 8192);
        if (wave < nitems) {
            const LAS float* av = sval + (lane * 2) * 16; const LAS float* bv = av + 16; const LAS int* ai = sidx + (lane * 2) * 16; const LAS int* bi = ai + 16;
            unsigned hk[16];
            const float b0 = bv[0];
#pragma unroll
            for (int i4 = 0; i4 < 4; ++i4) { const f32x4 t4 = *(const LAS f32x4*)(av + 4 * i4);
#pragma unroll
                for (int e = 0; e < 4; ++e) hk[4 * i4 + e] = (f2key(t4[e] + b0) & ~255u) | (unsigned)(255 - (4 * i4 + e) * 16); }
            float bestv[16]; int beste[16];
#pragma unroll
            for (int r = 0; r < 16; ++r) {
                unsigned m0 = umax3(hk[0], hk[1], hk[2]), m1 = umax3(hk[3], hk[4], hk[5]), m2 = umax3(hk[6], hk[7], hk[8]), m3 = umax3(hk[9], hk[10], hk[11]);
                m0 = umax3(m0, hk[12], hk[13]); m1 = umax3(m1, hk[14], hk[15]);
                const unsigned best = max(max(m0, m1), max(m2, m3));
                const int f = 255 - (int)(best & 255u), bi_ = f >> 4, bj = f & 15;
                const float a_i = av[bi_]; bestv[r] = a_i + bv[bj]; beste[r] = ai[bi_] * 128 + bi[bj];
                const int nj = bj + 1;
                const unsigned nk = nj < 16 ? ((f2key(a_i + bv[nj & 15]) & ~255u) | (unsigned)(255 - (bi_ * 16 + nj))) : 0u;
#pragma unroll
                for (int i = 0; i < 16; ++i) hk[i] = i == bi_ ? nk : hk[i];
            }
            float rsd; { const f32x4* sp = (const f32x4*)((const float*)(P.ws + WS_SSP) + ((size_t)tt * 64 + lane) * 32); float a = 0.f;
#pragma unroll
                for (int j = 0; j < 8; ++j) { const f32x4 v = sp[j]; a += (v.x + v.y) + (v.z + v.w); }
                rsd = 1.0f / sqrtf(a * (1.f / DM) + RMS_EPS); ((float*)(P.ws + WS_SSP + 2 * MiB))[(size_t)tt * 64 + lane] = rsd; }
            float se = 0.f; const float mx = bestv[0];
#pragma unroll
            for (int r = 0; r < 16; ++r) { bestv[r] = __expf((bestv[r] - mx) * rsd); se += bestv[r]; }
            const float ise = 1.f / se; const size_t o = ((size_t)tt * 64 + lane) * 128 + h * 16;
#pragma unroll
            for (int r4 = 0; r4 < 4; ++r4) { *(v4u*)(ridx + o + 4 * r4) = (v4u){(unsigned)beste[4 * r4], (unsigned)beste[4 * r4 + 1], (unsigned)beste[4 * r4 + 2], (unsigned)beste[4 * r4 + 3]};
                *(f32x4*)(rgate + o + 4 * r4) = (f32x4){bestv[4 * r4] * ise, bestv[4 * r4 + 1] * ise, bestv[4 * r4 + 2] * ise, bestv[4 * r4 + 3] * ise}; }
        }
        __syncthreads();
    }
}
#define XB_TMO      128
#define XB_XCNT(j)  (256  + 64 * (j))
#define XB_XSUB(j)  (1280 + 64 * (j))
#define XB_XGEN(j)  (2304 + 64 * (j))
#define XB_TOP      3328
#define XB_TOPGEN   3392
#define XCD_BAR_WORDS 3456
#define XB_SPIN_CAP (1u << 18)

__device__ __forceinline__ unsigned xb_ld(unsigned* p)              { return __hip_atomic_load(p, __ATOMIC_RELAXED, __HIP_MEMORY_SCOPE_AGENT); }
__device__ __forceinline__ unsigned xb_add(unsigned* p, unsigned v) { return __hip_atomic_fetch_add(p, v, __ATOMIC_RELAXED, __HIP_MEMORY_SCOPE_AGENT); }
__device__ __forceinline__ unsigned xb_xcc_id() { return (unsigned)__builtin_amdgcn_s_getreg((3 << 11) | 20) & 0xFu; }
#define XB_SPIN(cond, bar) do { unsigned _sp = 0; while (cond) { __builtin_amdgcn_s_sleep(1); \
    if ((++_sp & 255u) == 0u) { if (xb_ld(&(bar)[XB_TMO])) break; if (_sp > XB_SPIN_CAP) { atomicAdd(&(bar)[XB_TMO], 1u); break; } } } } while (0)

struct XcdBarrier {
    unsigned* bar; unsigned x;
    volatile LAS unsigned* st;
};

__device__ __forceinline__ XcdBarrier xcd_barrier_post(unsigned* bar, volatile LAS unsigned* st) {
    XcdBarrier b; b.bar = bar; b.x = xb_xcc_id(); b.st = st;
    if (threadIdx.x == 0) (void)xb_add(&bar[XB_XCNT(b.x)], 1u);
    return b;
}
__device__ __forceinline__ void xcd_barrier_complete(unsigned* bar, unsigned x, unsigned& nloc, unsigned& nx) {
    const unsigned G = gridDim.x * gridDim.y * gridDim.z;
    unsigned sum, cnt, mine, sp = 0u;
    for (;;) {
        sum = 0u; cnt = 0u; mine = 0u;
#pragma unroll
        for (unsigned j = 0; j < 16; ++j) { const unsigned c = xb_ld(&bar[XB_XCNT(j)]); sum += c; cnt += (c > 0u) ? 1u : 0u; mine = (j == x) ? c : mine; }
        if (sum == G) break;
        __builtin_amdgcn_s_sleep(1);
        if ((++sp & 255u) == 0u) { if (xb_ld(&bar[XB_TMO])) break; if (sp > XB_SPIN_CAP) { atomicAdd(&bar[XB_TMO], 1u); break; } }
    }
    nloc = mine > 0u ? mine : 1u; nx = cnt > 0u ? cnt : 1u;
}

__device__ __forceinline__ void xcd_barrier(const XcdBarrier& b) {
    asm volatile("s_waitcnt vmcnt(0)" ::: "memory");
    __syncthreads();
    if (threadIdx.x == 0) {
        unsigned* bar = b.bar;
        __builtin_amdgcn_s_waitcnt(0);
        unsigned nloc = b.st[0], nx = b.st[1];
        if (nloc == 0u) { xcd_barrier_complete(bar, b.x, nloc, nx); b.st[0] = nloc; b.st[1] = nx; }
        const unsigned old = xb_add(&bar[XB_XSUB(b.x)], 1u);
        const unsigned gen = old / nloc;
        if (old + 1u == (gen + 1u) * nloc) {
            __builtin_amdgcn_fence(__ATOMIC_RELEASE, "agent");
            asm volatile("s_waitcnt vmcnt(0)" ::: "memory");
            const unsigned og = xb_add(&bar[XB_TOP], 1u);
            const unsigned tg = og / nx;
            if (og + 1u == (tg + 1u) * nx) xb_add(&bar[XB_TOPGEN], 1u);
            else XB_SPIN(xb_ld(&bar[XB_TOPGEN]) == tg, bar);
            __builtin_amdgcn_fence(__ATOMIC_ACQUIRE, "agent");
            xb_add(&bar[XB_XGEN(b.x)], 1u);
            asm volatile("s_waitcnt vmcnt(0)" ::: "memory");
        } else {
            XB_SPIN(xb_ld(&bar[XB_XGEN(b.x)]) == gen, bar);
            __builtin_amdgcn_fence(__ATOMIC_ACQUIRE, "agent");
            asm volatile("s_waitcnt vmcnt(0)" ::: "memory");
        }
    }
    __syncthreads();
}
#ifndef MK_ONE_LAUNCH
#define MK_ONE_LAUNCH 1
#endif
constexpr int N_PHASES = 11;
__global__ void __launch_bounds__(NTHR, 2) mega(Params Pkernarg) {
    extern __shared__ __attribute__((aligned(16))) unsigned char lds_raw[];
    LAS unsigned char* lds = (LAS unsigned char*)lds_raw;
    const int tid = ltid();
    const int G = gridDim.x, bx = blockIdx.x; const int vcu = (G % 8 == 0) ? (bx % 8) * (G / 8) + bx / 8 : bx;
    for (int u = tid; u < (LDS_BYTES - LDSCTL_OFF) / 4; u += NTHR) ((LAS unsigned*)(lds + LDSCTL_OFF))[u] = 0u;
    __syncthreads();
#if MK_ONE_LAUNCH
    XcdBarrier bar = xcd_barrier_post((unsigned*)(params_ptr()->ws + WS_CTL) + CW_BAR + params_ptr()->bar_li * XCD_BAR_WORDS, (volatile LAS unsigned*)(lds + MISC_OFF) + 8);
#define GRID_BAR() xcd_barrier(bar)
#else
#define GRID_BAR() do {} while (0)
#endif
#ifndef PHOFF
#define PHOFF 0
#endif
#define IN(k) (!((PHOFF >> (k)) & 1))
#define BOTH(k) (IN(k) && IN((k) + 1))
    if (IN(0)) { KP P = *params_ptr(); phase_prologue(P, lds, vcu, G); prologue_subkeys(P, vcu, G); prologue_lora(P, vcu, G); if (BOTH(0)) GRID_BAR(); }
    if (IN(1)) { KP P = *params_ptr();
        pg8::Gemm g{(const bf16*)(P.ws + WS_XN), (const bf16*)(P.ws + WS_WIN), TT, INCP, DM}; pg8::Order1 S; S.init(TT, INCP, G, bx);
        pg8::EpiBf16<0> E{(bf16*)(P.ws + WS_PROJ), INCP, nullptr, 0, 0, 1.f};
        pg8::gemm_phase<pg8::EpiBf16<0>, pg8::Order1, true, true>(lds, g, S, E);
        phase_convert_tables(P, lds); phase_transpose_late(P, lds);
        if (BOTH(1)) GRID_BAR();
    }
    if (IN(2)) { KP P = *params_ptr(); phase_act(P, vcu, G); phase_kmean(P, lds, vcu, G); if (BOTH(2)) GRID_BAR(); }
    if (IN(3)) { KP P = *params_ptr(); phase_rwkv_stage_a(P, lds, vcu, G); if (BOTH(3)) GRID_BAR(); }
    if (IN(4)) { KP P = *params_ptr(); if ((vcu & 15) < 2 && vcu < 256) rwkv_stage_b(P, lds, (vcu >> 4) * 2 + (vcu & 15)); phase_moba(P, (char*)lds_raw, vcu, G); }
    if (IN(5)) { GRID_BAR(); KP P = *params_ptr(); moba_combine(P, vcu, G); GRID_BAR(); }
    if (IN(6)) { KP P = *params_ptr();
        pg8::Gemm g{(const bf16*)(P.ws + WS_AR), (const bf16*)(P.ws + WS_WOUT), TT, DM, DM}; pg8::StaticOrder S; S.init(TT, DM, G, bx);
        pg8::EpiH E{P.x, (bf16*)(P.ws + WS_XN), (float*)(P.ws + WS_SSP), DM};
        pg8::gemm_phase<pg8::EpiH, pg8::StaticOrder, true, true>(lds, g, S, E);
        if (BOTH(6)) GRID_BAR();
    }
    if (IN(8)) { KP P = *params_ptr();
        pg8::Gemm g{(const bf16*)(P.ws + WS_XN), (const bf16*)(P.ws + WS_WQ), TT, DM, DM}; pg8::StaticOrder S; S.init(TT, DM, G, bx);
        pg8::EpiBf16<0> E{(bf16*)(P.ws + WS_PROJ), DM, nullptr, 0, 0, 1.f};
        pg8::gemm_phase<pg8::EpiBf16<0>, pg8::StaticOrder, true, true>(lds, g, S, E);
        if (G == 256) { const int wg_ = (bx & 7) * 32 + (bx >> 3); pg8::Unit u; u.pm = (wg_ >> 6) * 8 + (wg_ & 7); u.pn = (wg_ & 63) >> 3;
            asm volatile("s_waitcnt vmcnt(0)" ::: "memory"); __syncthreads(); __builtin_amdgcn_fence(__ATOMIC_ACQUIRE, "agent"); asm volatile("s_waitcnt vmcnt(0)" ::: "memory");
            peer_route_tiles(P, lds, 4 * u.pm, 4, u.pn);
        } else if (G != 256) { GRID_BAR(); for (int item = vcu; item < 1024; item += G) peer_route_tiles(P, lds, item >> 3, 1, item & 7); }
        if (BOTH(8)) GRID_BAR();
    }
    if (IN(10)) { KP P = *params_ptr(); phase_peer_sliced(P, lds, bx, G); }
#undef IN
#undef BOTH
}

extern "C" void kernel_launch(void* const* d_in, const int* in_sizes, int n_in, void* d_out, int out_size, void* d_ws, size_t ws_size, hipStream_t stream) {
    static int grid = 0;
    if (grid == 0) {
        if (n_in != 21 || in_sizes[0] != TT * DM || out_size != TT * DM || ws_size < WS_END) {
            fprintf(stderr, "kernel_launch: unexpected shapes: n_in %d in0 %d out %d ws %zu\n", n_in, n_in > 0 ? in_sizes[0] : -1, out_size, ws_size); grid = -1; return; }
        int dev = 0, cus = 0;
        if (hipGetDevice(&dev) != hipSuccess || hipDeviceGetAttribute(&cus, hipDeviceAttributeMultiprocessorCount, dev) != hipSuccess) { grid = -1; return; }
        if (hipFuncSetAttribute((const void*)mega, hipFuncAttributeMaxDynamicSharedMemorySize, LDS_BYTES) != hipSuccess) { fprintf(stderr, "kernel_launch: hipFuncSetAttribute failed\n"); grid = -1; return; }
        int per_cu = 0;
        if (hipOccupancyMaxActiveBlocksPerMultiprocessor(&per_cu, (const void*)mega, NTHR, LDS_BYTES) != hipSuccess || per_cu < 1) fprintf(stderr, "kernel_launch: occupancy query says %d blocks per CU\n", per_cu);
        (void)hipGetLastError();
        grid = cus;
    }
    if (grid < 0) return;
    (void)hipMemsetAsync((char*)d_ws + WS_CTL, 0, CTL_ZERO_BYTES, stream);
    Params p{};
    p.x = (const float*)d_in[0]; p.norm1_g = (const float*)d_in[1]; p.w_in = (const float*)d_in[2]; p.mu = (const float*)d_in[3]; p.w0 = (const float*)d_in[4];
    p.w2 = (const float*)d_in[5]; p.a0 = (const float*)d_in[6]; p.a2 = (const float*)d_in[7]; p.g2 = (const float*)d_in[8]; p.k_k = (const float*)d_in[9];
    p.k_a = (const float*)d_in[10]; p.r_k = (const float*)d_in[11]; p.ln_g = (const float*)d_in[12]; p.ln_b = (const float*)d_in[13]; p.w_out = (const float*)d_in[14];
    p.norm2_g = (const float*)d_in[15]; p.wq = (const float*)d_in[16]; p.sub_keys = (const float*)d_in[17]; p.pu = (const float*)d_in[18]; p.pv = (const float*)d_in[19];
    p.final_g = (const float*)d_in[20]; p.out = (float*)d_out; p.ws = (unsigned char*)d_ws;
    p.ph_lo = 0; p.ph_hi = N_PHASES; p.bar_li = 0;
    hipLaunchKernelGGL(mega, dim3(grid), dim3(NTHR), LDS_BYTES, stream, p);
}
```

```cpp
#include <hip/hip_runtime.h>
#include <cstdio>
#include <cstdint>
__device__ __forceinline__ int ltid() { int t = threadIdx.x; asm volatile("" : "+v"(t)); return t; }
namespace pg8 {
#define PG8_LAS __attribute__((address_space(3)))
typedef unsigned short bf16_t;
typedef short bf16x8 __attribute__((ext_vector_type(8)));
typedef float f32x4 __attribute__((ext_vector_type(4)));
typedef unsigned u32x4 __attribute__((ext_vector_type(4)));
constexpr int BM = 256, BK = 64, HALF = 128, HTB = HALF * BK * 2  , STAGE_BYTES = 8 * HTB, NXCD = 8, WGM = 8;

__host__ __device__ __forceinline__ int lds_byte(int r, int c) { const int st = (r >> 4) * 2 + (c >> 5), rr = r & 15, cc = c & 31, ob = rr * 64 + cc * 2; return st * 1024 + (ob ^ (((ob >> 9) & 1) << 5)); }
__host__ __device__ __forceinline__ void stage_rc(int b, int& R, int& C) { const int st = b / 1024, sb = b % 1024, swz = sb ^ (((sb >> 9) & 1) << 5); R = (st >> 1) * 16 + swz / 64; C = (st & 1) * 32 + (swz % 64) / 2; }
__host__ __device__ __forceinline__ int perm32(int rho) { const int n = rho >> 4, i = rho & 15; return 8 * (i >> 2) + 4 * n + (i & 3); }

struct Unit { int pm, pn; };
struct Gemm { const bf16_t* A; const bf16_t* Bt; int M, N, K; };

struct StaticOrder {
    int nM, nN, nwg, G, c;
    __host__ __device__ void init(int M, int N, int G_, int c_) { nM = M / BM; nN = N / BM; nwg = nM * nN; G = G_; c = c_; }
    __host__ __device__ bool next(int i, Unit& u) const {
        const long L = (long)i * G + c; if (L >= nwg) return false;
        int wgid = (int)L; { const int q = nwg / NXCD, r = nwg % NXCD, xcd = wgid % NXCD, off = wgid / NXCD; wgid = (xcd < r ? xcd * (q + 1) : r * (q + 1) + (xcd - r) * q) + off; }
        const int nig = WGM * nN, gid = wgid / nig, fm = gid * WGM, gsz = (nM - fm) < WGM ? (nM - fm) : WGM;
        u.pm = fm + ((wgid % nig) % gsz); u.pn = (wgid % nig) / gsz; return true;
    }
    __device__ __forceinline__ void a_ready(const Unit&) const {}
    __device__ __forceinline__ void done(const Unit&) const {}
};

__device__ __forceinline__ unsigned cvt_pk_bf16(float lo, float hi) { unsigned r; asm volatile("v_cvt_pk_bf16_f32 %0, %1, %2" : "=v"(r) : "v"(lo), "v"(hi)); return r; }
typedef float f32x2 __attribute__((ext_vector_type(2)));
__device__ __forceinline__ f32x2 gelu_pk(f32x2 v) {
    const f32x2 av = __builtin_elementwise_abs(v), d = av * 0.2316418882f + 1.0f;
    f32x2 t; t.x = __builtin_amdgcn_rcpf(d.x); t.y = __builtin_amdgcn_rcpf(d.y);
    f32x2 q = t * 0.5307027145f + (-0.7265760135f); q = q * t + 0.7107068705f; q = q * t + (-0.142248368f); q = q * t + 0.127414796f; q = q * t;
    const f32x2 s = (v * v) * (-0.72134752044f);
    f32x2 e; e.x = __builtin_amdgcn_exp2f(s.x); e.y = __builtin_amdgcn_exp2f(s.y);
    const f32x2 m = v * (q * e), r = v - m;
    f32x2 o; o.x = v.x < 0.f ? m.x : r.x; o.y = v.y < 0.f ? m.y : r.y; return o;
}

template <int ACT  > struct EpiBf16 {
    static constexpr bool PERM = true, AFTER_DRAIN = false; static_assert(ACT == 0 || ACT == 1, "EpiBf16: ACT is 0 (none) or 1 (gelu_pk)");
    bf16_t* O; int ldc; const float* bias; int split_cols; size_t split_stride; float scale0;
    __device__ __forceinline__ void operator()(const f32x4 (&acc)[2][2][4][2], const Unit& u, int wr, int wc, int fr, int fq) const {
        const int row0 = u.pm * BM + wr * 64 + fr; int colt = u.pn * BM; bf16_t* base = O;
        float sc = 1.f; if (split_cols) { const int t = colt / split_cols; base += (size_t)t * split_stride; colt -= t * split_cols; if (t == 0) sc = scale0; }
        const int col0 = colt + wc * 32 + 8 * fq, bcol0 = u.pn * BM + wc * 32 + 8 * fq;
        f32x4 bv[2][2];
#pragma unroll
        for (int bj = 0; bj < 2; ++bj)
#pragma unroll
            for (int n = 0; n < 2; ++n) bv[bj][n] = bias ? *(const f32x4*)(bias + bcol0 + bj * HALF + 4 * n) : (f32x4){0.f, 0.f, 0.f, 0.f};
#pragma unroll
        for (int ai = 0; ai < 2; ++ai)
#pragma unroll
            for (int m = 0; m < 4; ++m) { bf16_t* rowp = base + (size_t)(row0 + ai * HALF + m * 16) * ldc + col0;
#pragma unroll
                for (int bj = 0; bj < 2; ++bj) { f32x4 v0 = acc[ai][bj][m][0] + bv[bj][0], v1 = acc[ai][bj][m][1] + bv[bj][1];
                    if (ACT == 1) { f32x2 a = gelu_pk((f32x2){v0[0], v0[1]}), b = gelu_pk((f32x2){v0[2], v0[3]}), c = gelu_pk((f32x2){v1[0], v1[1]}), d = gelu_pk((f32x2){v1[2], v1[3]});
                        v0 = (f32x4){a.x, a.y, b.x, b.y}; v1 = (f32x4){c.x, c.y, d.x, d.y}; }
                    v0 = v0 * sc; v1 = v1 * sc; u32x4 w; w.x = cvt_pk_bf16(v0[0], v0[1]); w.y = cvt_pk_bf16(v0[2], v0[3]); w.z = cvt_pk_bf16(v1[0], v1[1]); w.w = cvt_pk_bf16(v1[2], v1[3]);
                    *(u32x4*)(rowp + bj * HALF) = w; } }
    }
};
template <class Epi, class Sched, bool ALIGN_EPI = false, bool SP2 = false>
__device__ __forceinline__ void gemm_phase(PG8_LAS unsigned char* lds, const Gemm g, const Sched& S, const Epi& E) {
    const int tid = ltid(), wid = __builtin_amdgcn_readfirstlane(tid >> 6), lane = tid & 63, wr = wid >> 2, wc = wid & 3, fr = lane & 15, fq = lane >> 4;
    const int K = g.K, nt = K / BK;
    unsigned voffA[2], voffB[2];
#pragma unroll
    for (int i = 0; i < 2; ++i) { int R, C; stage_rc(tid * 16 + i * 8192, R, C); const int Rb = Epi::PERM ? ((R & ~31) + perm32(R & 31)) : R;
        voffA[i] = (unsigned)(R * K + C) * 2u; voffB[i] = (unsigned)(Rb * K + C) * 2u; }
    const size_t kstep = (size_t)(BK * 2);
    const size_t hstep = (size_t)HALF * K * 2;
    const size_t tstep = 2 * hstep;
    const unsigned ldsw = (unsigned)wid * 1024u;
    const int aoff = lds_byte(wr * 64 + fr, fq * 8), boff = lds_byte(wc * 32 + fr, fq * 8);
#define PG8_SA(b, h) (((b) * 2 + (h)) * HTB)
#define PG8_SB(b, h) ((4 + (b) * 2 + (h)) * HTB)
#define PG8_STAGE(bufoff, gbase, voff) do { _Pragma("unroll") for (int _i = 0; _i < 2; ++_i) \
        __builtin_amdgcn_global_load_lds((const unsigned*)((const char*)(gbase) + (voff)[_i]), (PG8_LAS unsigned*)(lds + (bufoff) + ldsw + _i * 8192), 16, 0, 0); } while (0)
#define PG8_LDA(dst, b, h) do { _Pragma("unroll") for (int m = 0; m < 4; ++m) _Pragma("unroll") for (int k = 0; k < 2; ++k) dst[m][k] = *(const PG8_LAS bf16x8*)(lds + PG8_SA(b, h) + aoff + m * 2048 + k * 1024); } while (0)
#define PG8_LDB(dst, b, h) do { _Pragma("unroll") for (int n = 0; n < 2; ++n) _Pragma("unroll") for (int k = 0; k < 2; ++k) dst[n][k] = *(const PG8_LAS bf16x8*)(lds + PG8_SB(b, h) + boff + n * 2048 + k * 1024); } while (0)
#define PG8_MMA(ai, bj, At, Bt) do { __builtin_amdgcn_s_setprio(1); _Pragma("unroll") for (int m = 0; m < 4; ++m) _Pragma("unroll") for (int n = 0; n < 2; ++n) _Pragma("unroll") for (int k = 0; k < 2; ++k) \
        acc[ai][bj][m][n] = __builtin_amdgcn_mfma_f32_16x16x32_bf16(Bt[n][k], At[m][k], acc[ai][bj][m][n], 0, 0, 0); __builtin_amdgcn_s_setprio(0); } while (0)
#define PG8_WAIT_V(n) asm volatile("s_waitcnt vmcnt(" #n ")" ::: "memory")
#define PG8_WAIT_L(n) asm volatile("s_waitcnt lgkmcnt(" #n ")" ::: "memory")
#define PG8_BAR __builtin_amdgcn_s_barrier()
#define PG8_SCHED __builtin_amdgcn_sched_barrier(0)
    Unit cur, nxt; int ui = 0;
    if (!S.next(0, cur)) return;
    f32x4 acc[2][2][4][2];
#pragma unroll
    for (int a = 0; a < 2; ++a)
#pragma unroll
        for (int b = 0; b < 2; ++b)
#pragma unroll
            for (int m = 0; m < 4; ++m)
#pragma unroll
                for (int n = 0; n < 2; ++n) acc[a][b][m][n] = (f32x4){0.f, 0.f, 0.f, 0.f};
    bf16x8 At[4][2], B0[2][2], B1[2][2];
    const char* cA = (const char*)g.A + (size_t)cur.pm * tstep; const char* cB = (const char*)g.Bt + (size_t)cur.pn * tstep;
    S.a_ready(cur);
    if constexpr (SP2) {
        PG8_STAGE(PG8_SB(0, 0), cB, voffB); PG8_STAGE(PG8_SB(0, 1), cB + hstep, voffB); PG8_STAGE(PG8_SA(0, 0), cA, voffA); PG8_STAGE(PG8_SA(0, 1), cA + hstep, voffA);
        if (wr == 1) PG8_BAR;
        PG8_WAIT_V(2); PG8_BAR;
        PG8_STAGE(PG8_SB(1, 0), cB + kstep, voffB); PG8_STAGE(PG8_SA(1, 0), cA + kstep, voffA); PG8_STAGE(PG8_SB(1, 1), cB + hstep + kstep, voffB);
        PG8_WAIT_V(6); PG8_BAR;
    } else {
        PG8_STAGE(PG8_SB(0, 0), cB, voffB); PG8_STAGE(PG8_SA(0, 0), cA, voffA); PG8_STAGE(PG8_SB(0, 1), cB + hstep, voffB); PG8_STAGE(PG8_SA(0, 1), cA + hstep, voffA);
        if (wr == 1) PG8_BAR;
        PG8_WAIT_V(4); PG8_BAR;
        PG8_STAGE(PG8_SB(1, 0), cB + kstep, voffB); PG8_STAGE(PG8_SA(1, 0), cA + kstep, voffA); PG8_STAGE(PG8_SB(1, 1), cB + hstep + kstep, voffB);
        PG8_WAIT_V(6); PG8_BAR;
    }
    for (;;) {
        const bool has_next = S.next(ui + 1, nxt);
        const char* nA = has_next ? (const char*)g.A + (size_t)nxt.pm * tstep : cA; const char* nB = has_next ? (const char*)g.Bt + (size_t)nxt.pn * tstep : cB;
        for (int t = 0; t < nt; t += 2) {
            const bool last = (t == nt - 2);
            const char* a1 = cA + (size_t)(t + 1) * kstep;
            const char* a2 = last ? nA : cA + (size_t)(t + 2) * kstep; const char* b2 = last ? nB : cB + (size_t)(t + 2) * kstep;
            const char* a3 = a2 + kstep; const char* b3 = b2 + kstep;
            if (last && has_next) S.a_ready(nxt);
            if constexpr (SP2) {
            PG8_LDB(B0, 0, 0); PG8_LDB(B1, 0, 1); PG8_SCHED; PG8_LDA(At, 0, 0); PG8_STAGE(PG8_SA(1, 1), a1 + hstep, voffA);
            PG8_WAIT_V(8); PG8_WAIT_L(0); PG8_BAR; PG8_MMA(0, 0, At, B0); PG8_MMA(0, 1, At, B1); PG8_BAR; PG8_SCHED;
            PG8_LDA(At, 0, 1); PG8_STAGE(PG8_SB(0, 0), b2, voffB); PG8_STAGE(PG8_SB(0, 1), b2 + hstep, voffB); PG8_STAGE(PG8_SA(0, 0), a2, voffA);
            PG8_WAIT_V(8); PG8_WAIT_L(0); PG8_BAR; PG8_MMA(1, 0, At, B0); PG8_MMA(1, 1, At, B1); PG8_BAR; PG8_SCHED;
            PG8_LDB(B0, 1, 0); PG8_LDB(B1, 1, 1); PG8_SCHED; PG8_LDA(At, 1, 0); PG8_STAGE(PG8_SA(0, 1), a2 + hstep, voffA);
            PG8_WAIT_V(8); PG8_WAIT_L(0); PG8_BAR; PG8_MMA(0, 0, At, B0); PG8_MMA(0, 1, At, B1); PG8_BAR; PG8_SCHED;
            PG8_LDA(At, 1, 1); PG8_STAGE(PG8_SB(1, 0), b3, voffB); PG8_STAGE(PG8_SB(1, 1), b3 + hstep, voffB); PG8_STAGE(PG8_SA(1, 0), a3, voffA);
            PG8_WAIT_V(8); PG8_WAIT_L(0); PG8_BAR; PG8_MMA(1, 0, At, B0); PG8_MMA(1, 1, At, B1); PG8_BAR; PG8_SCHED;
            } else {
            PG8_LDB(B0, 0, 0); PG8_SCHED; PG8_LDA(At, 0, 0); PG8_STAGE(PG8_SA(1, 1), a1 + hstep, voffA);
            PG8_WAIT_L(8); PG8_BAR; PG8_WAIT_L(0); PG8_MMA(0, 0, At, B0); PG8_BAR; PG8_SCHED;
            PG8_LDB(B1, 0, 1); PG8_STAGE(PG8_SB(0, 0), b2, voffB);
            PG8_BAR; PG8_WAIT_L(0); PG8_MMA(0, 1, At, B1); PG8_BAR;
            PG8_LDA(At, 0, 1); PG8_STAGE(PG8_SA(0, 0), a2, voffA);
            PG8_BAR; PG8_WAIT_L(0); PG8_MMA(1, 0, At, B0); PG8_BAR; PG8_SCHED;
            PG8_STAGE(PG8_SB(0, 1), b2 + hstep, voffB);
            PG8_WAIT_V(6); PG8_BAR; PG8_MMA(1, 1, At, B1); PG8_BAR;
            PG8_LDB(B0, 1, 0); PG8_SCHED; PG8_LDA(At, 1, 0); PG8_STAGE(PG8_SA(0, 1), a2 + hstep, voffA);
            PG8_WAIT_L(8); PG8_BAR; PG8_WAIT_L(0); PG8_MMA(0, 0, At, B0); PG8_BAR; PG8_SCHED;
            PG8_LDB(B1, 1, 1); PG8_STAGE(PG8_SB(1, 0), b3, voffB);
            PG8_BAR; PG8_WAIT_L(0); PG8_MMA(0, 1, At, B1); PG8_BAR;
            PG8_LDA(At, 1, 1); PG8_STAGE(PG8_SA(1, 0), a3, voffA);
            PG8_BAR; PG8_WAIT_L(0); PG8_MMA(1, 0, At, B0); PG8_BAR; PG8_SCHED;
            PG8_STAGE(PG8_SB(1, 1), b3 + hstep, voffB);
            PG8_WAIT_V(6); PG8_BAR; PG8_MMA(1, 1, At, B1); PG8_BAR;
            }
        }
        if constexpr (ALIGN_EPI) { if (wr == 0) PG8_BAR; }
        if constexpr (!Epi::AFTER_DRAIN) { E(acc, cur, wr, wc, fr, fq); S.done(cur); }
        if (!has_next) break;
#pragma unroll
        for (int a = 0; a < 2; ++a)
#pragma unroll
            for (int b = 0; b < 2; ++b)
#pragma unroll
                for (int m = 0; m < 4; ++m)
#pragma unroll
                    for (int n = 0; n < 2; ++n) acc[a][b][m][n] = (f32x4){0.f, 0.f, 0.f, 0.f};
        cur = nxt; cA = nA; cB = nB; ++ui;
        if constexpr (ALIGN_EPI) { if (wr == 1) PG8_BAR; }
    }
    PG8_WAIT_V(0);
    if constexpr (!ALIGN_EPI) { if (wr == 0) PG8_BAR; }
    PG8_BAR;
    if constexpr (Epi::AFTER_DRAIN) { E.fused(acc, cur, wr, wc, fr, fq, lds, wid, lane); S.done(cur); }
#undef PG8_SA
#undef PG8_SB
#undef PG8_STAGE
#undef PG8_LDA
#undef PG8_LDB
#undef PG8_MMA
#undef PG8_WAIT_V
#undef PG8_WAIT_L
#undef PG8_BAR
#undef PG8_SCHED
}
}
#define GAS __attribute__((address_space(1)))
#define LAS __attribute__((address_space(3)))
typedef unsigned short bf16;
typedef unsigned v4u __attribute__((ext_vector_type(4)));
typedef unsigned v2u __attribute__((ext_vector_type(2)));
typedef float f32x4 __attribute__((ext_vector_type(4)));
constexpr int NWAVES = 8, NTHR = 512;
constexpr int TT = 8192, DM = 2048, SEQ = 4096;
constexpr int INC = 6592, INCP = 6656;
constexpr int C_AK = 1024, C_AV = 2048, C_RW = 3072;
constexpr int RWC = 3520;
constexpr float RMS_EPS = 1e-6f;
constexpr size_t MiB = 1u << 20;
constexpr size_t WS_CTL = 0, CTL_ZERO_BYTES = 1 * MiB;
constexpr size_t WS_WIN = 1 * MiB;
constexpr size_t WS_WOUT = 27 * MiB;
constexpr size_t WS_WQ = 35 * MiB;
constexpr size_t WS_XN = 43 * MiB;
constexpr size_t WS_PROJ = 75 * MiB;
constexpr size_t WS_AR = 179 * MiB;
constexpr size_t WS_H = 211 * MiB;
constexpr size_t WS_RWA = 275 * MiB;
constexpr size_t WS_CHK = 339 * MiB;
constexpr size_t WS_KMEAN = 467 * MiB;
constexpr size_t WS_ACT = WS_H;
constexpr size_t WS_SSP = WS_WIN + 4 * MiB;
constexpr size_t WS_LORA = 468 * MiB;
constexpr size_t WS_END = 469 * MiB;
constexpr int CW_BAR = 4096, CW_MOBA_CTR = 16384, CW_SS = 32768;
constexpr int RING_BYTES = 147456, LDSCTL_OFF = RING_BYTES, MISC_OFF = LDSCTL_OFF + 320, LDS_BYTES = 163840;

struct Params {
    const float* x; const float* norm1_g; const float* w_in; const float* mu; const float* w0; const float* w2; const float* a0; const float* a2; const float* g2;
    const float* k_k; const float* k_a; const float* r_k; const float* ln_g; const float* ln_b; const float* w_out; const float* norm2_g; const float* wq;
    const float* sub_keys; const float* pu; const float* pv; const float* final_g;
    float* out; unsigned char* ws;
    int ph_lo, ph_hi, bar_li, pad;
};

typedef const __attribute__((address_space(4))) Params& KP;
__device__ __forceinline__ const __attribute__((address_space(4))) Params* params_ptr() {
    const __attribute__((address_space(4))) Params* ka = (const __attribute__((address_space(4))) Params*)__builtin_amdgcn_kernarg_segment_ptr(); asm volatile("" : "+s"(ka)); return ka; }
typedef float f32x2_t __attribute__((ext_vector_type(2))); typedef __bf16 bf16x2_t __attribute__((ext_vector_type(2)));
__device__ __forceinline__ unsigned pk2(float lo, float hi) { const f32x2_t v = {lo, hi}; const bf16x2_t b = __builtin_convertvector(v, bf16x2_t); return __builtin_bit_cast(unsigned, b); }
__device__ __forceinline__ unsigned f2bf(float f) { return pk2(f, 0.f) & 0xffffu; }
__device__ __forceinline__ float bf2f(bf16 v) { return __builtin_bit_cast(float, (unsigned)v << 16); }
__device__ __forceinline__ float bflo(unsigned u) { return __builtin_bit_cast(float, u << 16); }
__device__ __forceinline__ float bfhi(unsigned u) { return __builtin_bit_cast(float, u & 0xffff0000u); }
#define DPP_F(v, ctrl) __builtin_bit_cast(float, __builtin_amdgcn_update_dpp(0, __builtin_bit_cast(int, (v)), (ctrl), 0xf, 0xf, true))
__device__ __forceinline__ float wave_sum(float v) {
    v += DPP_F(v, 0xB1);
    v += DPP_F(v, 0x4E);
    v += DPP_F(v, 0x141);
    v += DPP_F(v, 0x140);
    const int b = __builtin_bit_cast(int, v);
    return (__builtin_bit_cast(float, __builtin_amdgcn_readlane(b, 0)) + __builtin_bit_cast(float, __builtin_amdgcn_readlane(b, 16))) +
           (__builtin_bit_cast(float, __builtin_amdgcn_readlane(b, 32)) + __builtin_bit_cast(float, __builtin_amdgcn_readlane(b, 48)));
}
__device__ __forceinline__ float wave_max(float v) {
#pragma unroll
    for (int o = 1; o < 64; o <<= 1) v = fmaxf(v, __shfl_xor(v, o));
    return v;
}
#define LDS_WAIT() asm volatile("s_waitcnt lgkmcnt(0)" ::: "memory")

__device__ __forceinline__ void p0_transpose_item(const float* W, int K, int N, bf16* WT, LAS float* scr, int item, int lane, const float* ksc = nullptr) {
    const int nblk = N / 32, kb = item / nblk, nb = item % nblk, k0 = 64 * kb, n0 = 32 * nb;
    float wv[32];
#pragma unroll
    for (int i = 0; i < 32; ++i) wv[i] = W[(size_t)(k0 + 2 * i + (lane >> 5)) * N + n0 + (lane & 31)];
#pragma unroll
    for (int i = 0; i < 32; ++i) { const int kk = 2 * i + (lane >> 5); scr[kk * 33 + (lane & 31)] = ksc ? wv[i] * ksc[k0 + kk] : wv[i]; }
    LDS_WAIT(); asm volatile("" ::: "memory");
    const int c = lane & 7;
#pragma unroll
    for (int j = 0; j < 4; ++j) { const int n = (lane >> 3) + 8 * j; const LAS float* s = scr + (8 * c) * 33 + n;
        v4u o; o.x = pk2(s[0 * 33], s[1 * 33]); o.y = pk2(s[2 * 33], s[3 * 33]); o.z = pk2(s[4 * 33], s[5 * 33]); o.w = pk2(s[6 * 33], s[7 * 33]);
        *(v4u*)(WT + (size_t)(n0 + n) * K + k0 + 8 * c) = o; }
    LDS_WAIT(); asm volatile("" ::: "memory");
}
__device__ __forceinline__ void rms_row_to_bf16(const float* xrow, const float* g, bf16* orow, int lane) {
    const f32x4* xr = (const f32x4*)xrow + lane;
    f32x4 v[8]; float s = 0.f;
#pragma unroll
    for (int j = 0; j < 8; ++j) { v[j] = xr[64 * j]; s += (v[j].x * v[j].x + v[j].y * v[j].y) + (v[j].z * v[j].z + v[j].w * v[j].w); }
    const float rs = 1.0f / sqrtf(wave_sum(s) * (1.f / DM) + RMS_EPS);
    v2u* o8 = (v2u*)orow + lane;
#pragma unroll
    for (int j = 0; j < 8; ++j) { const f32x4 gg = ((const f32x4*)g)[lane + 64 * j];
        v2u o; o.x = pk2(v[j].x * rs * gg.x, v[j].y * rs * gg.y); o.y = pk2(v[j].z * rs * gg.z, v[j].w * rs * gg.w); o8[64 * j] = o; }
}
__device__ __forceinline__ void phase_prologue(KP P, LAS unsigned char* lds, int vcu, int G) {
    const int tid = ltid(), lane = tid & 63, wave = tid >> 6;
    LAS float* scr = (LAS float*)(lds + wave * 16384);
    const int gw = vcu * NWAVES + wave, NGW = G * NWAVES;
    bf16* WIN = (bf16*)(P.ws + WS_WIN); bf16* XN = (bf16*)(P.ws + WS_XN);
    constexpr int I_IN = (DM / 64) * (INC / 32);
    for (int it = gw; it < I_IN; it += NGW) p0_transpose_item(P.w_in, DM, INC, WIN, scr, it, lane);
    for (int i = vcu * NTHR + tid; i < (INCP - INC) * DM / 8; i += G * NTHR) ((v4u*)(WIN + (size_t)INC * DM))[i] = (v4u){0u, 0u, 0u, 0u};
    for (int m = gw; m < TT; m += NGW) rms_row_to_bf16(P.x + (size_t)m * DM, P.norm1_g, XN + (size_t)m * DM, lane);
}
__device__ __forceinline__ void phase_transpose_late(KP P, LAS unsigned char* lds) {
    const int tid = ltid(), lane = tid & 63, wave = tid >> 6;
    constexpr int I_SQ = (DM / 64) * (DM / 32), NTK = 2 * I_SQ / NWAVES;
    unsigned* ctr = (unsigned*)(P.ws + WS_CTL) + CW_MOBA_CTR + 16; LAS int* slot = (LAS int*)(lds + 8 * 16384); LAS float* scr = (LAS float*)(lds + wave * 16384);
    __syncthreads();
    if (tid == 0) slot[0] = (int)__hip_atomic_fetch_add(ctr, 1u, __ATOMIC_RELAXED, __HIP_MEMORY_SCOPE_AGENT);
    __syncthreads();
    for (int it = 0;; ++it) {
        const int c = slot[it & 1]; if (c >= NTK) break;
        if (tid == 0) slot[(it & 1) ^ 1] = (int)__hip_atomic_fetch_add(ctr, 1u, __ATOMIC_RELAXED, __HIP_MEMORY_SCOPE_AGENT);
        const int r = c * NWAVES + wave;
        if (r < I_SQ) p0_transpose_item(P.w_out, DM, DM, (bf16*)(P.ws + WS_WOUT), scr, r, lane);
        else p0_transpose_item(P.wq, DM, DM, (bf16*)(P.ws + WS_WQ), scr, r - I_SQ, lane, P.norm2_g);
        __syncthreads();
    }
}

namespace pg8 {
struct EpiF32 {
    static constexpr bool PERM = false, AFTER_DRAIN = false;
    const float* base; float* out; int ldc;
    __device__ __forceinline__ void operator()(const f32x4 (&acc)[2][2][4][2], const Unit& u, int wr, int wc, int fr, int fq) const {
        const int col0 = u.pn * BM + wc * 32 + 4 * fq;
#pragma unroll
        for (int ai = 0; ai < 2; ++ai)
#pragma unroll
            for (int m = 0; m < 4; ++m) { const int r = ai * HALF + wr * 64 + m * 16 + fr; const size_t off = (size_t)(u.pm * BM + r) * ldc + col0;
#pragma unroll
                for (int bj = 0; bj < 2; ++bj)
#pragma unroll
                    for (int n = 0; n < 2; ++n) { f32x4 o = acc[ai][bj][m][n]; if (base) o = o + *(const f32x4*)(base + off + bj * HALF + n * 16);
                        *(f32x4*)(out + off + bj * HALF + n * 16) = o; } }
    }
};
struct EpiH {
    static constexpr bool PERM = false, AFTER_DRAIN = false;
    const float* base; bf16* outb; float* ss; int ldc;
    __device__ __forceinline__ void operator()(const f32x4 (&acc)[2][2][4][2], const Unit& u, int wr, int wc, int fr, int fq) const {
        const int col0 = u.pn * BM + wc * 32 + 4 * fq;
#pragma unroll
        for (int ai = 0; ai < 2; ++ai) {
            f32x4 xv[4][2][2];
#pragma unroll
            for (int m = 0; m < 4; ++m) { const size_t off = (size_t)(u.pm * BM + ai * HALF + wr * 64 + m * 16 + fr) * ldc + col0;
#pragma unroll
                for (int bj = 0; bj < 2; ++bj)
#pragma unroll
                    for (int n = 0; n < 2; ++n) xv[m][bj][n] = *(const f32x4*)(base + off + bj * HALF + n * 16); }
#pragma unroll
            for (int m = 0; m < 4; ++m) { const int r = ai * HALF + wr * 64 + m * 16 + fr; const size_t off = (size_t)(u.pm * BM + r) * ldc + col0; float sq = 0.f;
#pragma unroll
                for (int bj = 0; bj < 2; ++bj)
#pragma unroll
                    for (int n = 0; n < 2; ++n) { const f32x4 o = acc[ai][bj][m][n] + xv[m][bj][n];
                        *(v2u*)(outb + off + bj * HALF + n * 16) = (v2u){pk2(o.x, o.y), pk2(o.z, o.w)};
                        sq += (o.x * o.x + o.y * o.y) + (o.z * o.z + o.w * o.w); }
                sq += __shfl_xor(sq, 16); sq += __shfl_xor(sq, 32);
                if (fq == 0) ss[(size_t)(u.pm * BM + r) * 32 + u.pn * 4 + wc] = sq; }
        }
    }
};
struct EpiBf16Row {
    static constexpr bool PERM = true, AFTER_DRAIN = false;
    bf16_t* O; int ldc; const float* rs;
    __device__ __forceinline__ void operator()(const f32x4 (&acc)[2][2][4][2], const Unit& u, int wr, int wc, int fr, int fq) const {
        const int row0 = u.pm * BM + wr * 64 + fr, col0 = u.pn * BM + wc * 32 + 8 * fq;
        float scv[2][4];
#pragma unroll
        for (int ai = 0; ai < 2; ++ai)
#pragma unroll
            for (int m = 0; m < 4; ++m) scv[ai][m] = rs[row0 + ai * HALF + m * 16];
#pragma unroll
        for (int ai = 0; ai < 2; ++ai)
#pragma unroll
            for (int m = 0; m < 4; ++m) { const int row = row0 + ai * HALF + m * 16; const float sc = scv[ai][m]; bf16_t* rowp = O + (size_t)row * ldc + col0;
#pragma unroll
                for (int bj = 0; bj < 2; ++bj) { const f32x4 v0 = acc[ai][bj][m][0] * sc, v1 = acc[ai][bj][m][1] * sc;
                    u32x4 w; w.x = cvt_pk_bf16(v0[0], v0[1]); w.y = cvt_pk_bf16(v0[2], v0[3]); w.z = cvt_pk_bf16(v1[0], v1[1]); w.w = cvt_pk_bf16(v1[2], v1[3]);
                    *(u32x4*)(rowp + bj * HALF) = w; } }
    }
};
struct Order1 {
    StaticOrder s; bool split; int c;
    __device__ void init(int M, int N, int G_, int c_) { s.init(M, N, G_, c_); split = (G_ == 256 && M == 8192 && N == 6656); c = c_; }
    __device__ bool next(int i, Unit& u) const {
        if (!split) return s.next(i, u);
        if (c >= 208 || i >= 4) return false;
        const int x = c & 7, j = c >> 3; u.pm = 4 * x + 2 * (i >> 1) + (j & 1); u.pn = 13 * (i & 1) + (j >> 1); return true; }
    __device__ __forceinline__ void a_ready(const Unit&) const {}
    __device__ __forceinline__ void done(const Unit&) const {}
};
}

__device__ __forceinline__ void phase_rstd(KP P, int vcu, int G) {
    const float* ssp = (const float*)(P.ws + WS_SSP); float* rstd = (float*)(P.ws + WS_SSP + 2 * MiB);
    for (int row = vcu * NTHR + ltid(); row < TT; row += G * NTHR) { const f32x4* sp = (const f32x4*)(ssp + (size_t)row * 32); float a = 0.f;
#pragma unroll
        for (int j = 0; j < 8; ++j) { const f32x4 v = sp[j]; a += (v.x + v.y) + (v.z + v.w); }
        rstd[row] = 1.0f / sqrtf(a * (1.f / DM) + RMS_EPS); }
}
__device__ __forceinline__ void phase_kmean(KP P, LAS unsigned char* lds, int vcu, int G) {
    const int tid = ltid(); const bf16* proj = (const bf16*)(P.ws + WS_PROJ); float* kmean = (float*)(P.ws + WS_KMEAN);
    LAS float* red = (LAS float*)lds;
    for (int item = vcu; item < 32 * 8; item += G) {
        const int bb = item >> 3, cg = item & 7;
        const int c = tid & 127, rq = tid >> 7;
        const bf16* p = proj + (size_t)(bb * 256 + rq * 64) * INCP + C_AK + cg * 128 + c;
        float s = 0.f;
        for (int r = 0; r < 64; ++r) s += bf2f(p[(size_t)r * INCP]);
        red[rq * 128 + c] = s;
        __syncthreads();
        if (tid < 128) kmean[(size_t)bb * 1024 + cg * 128 + tid] = (red[tid] + red[128 + tid] + red[256 + tid] + red[384 + tid]) * (1.f / 256.f);
        __syncthreads();
    }
}

typedef short bf16x8 __attribute__((ext_vector_type(8)));
typedef float f32x16 __attribute__((ext_vector_type(16)));
constexpr int CP = 72;
constexpr int MATB = 64 * CP * 2;
enum { M_AT = 0, M_BT = 1, M_KT = 2, M_RT = 3, M_VT = 4, M_BBT = 5, M_KBT = 6, M_LAK = 7, M_MRB = 8, M_MRK = 9, M_LAB = 10, M_AHT = 0, M_U0T = 1 };
constexpr int L_RHS = 11 * MATB;
constexpr int L_MISC = L_RHS + 32768;
constexpr int L_TB = L_MISC + 9 * 64 * 4;
constexpr int L_A_END = L_TB + 2048;
static_assert(L_A_END <= RING_BYTES, "stage A LDS");
constexpr size_t CHK_ITEM = 6 * 8192;

__device__ __forceinline__ f32x16 mm_tile(const LAS unsigned char* A, int ra, const LAS unsigned char* B, int rb, f32x16 acc, int lane, int k0 = 0, int k1 = 4) {
    const int r = lane & 31, hi = lane >> 5;
    const LAS unsigned char* ap = A + ((ra * 32 + r) * CP + 8 * hi) * 2; const LAS unsigned char* bp = B + ((rb * 32 + r) * CP + 8 * hi) * 2;
#pragma unroll
    for (int kk = 0; kk < 4; ++kk) if (kk >= k0 && kk < k1) {
        const bf16x8 a = *(const LAS bf16x8*)(ap + kk * 32), b = *(const LAS bf16x8*)(bp + kk * 32);
        acc = __builtin_amdgcn_mfma_f32_32x32x16_bf16(a, b, acc, 0, 0, 0); }
    return acc;
}
__device__ __forceinline__ int crow32(int reg, int hi) { return (reg & 3) + 8 * (reg >> 2) + 4 * hi; }

__device__ __forceinline__ void prologue_lora(KP P, int vcu, int G) {
    bf16* w2T = (bf16*)(P.ws + WS_LORA); bf16* a2T = w2T + 1024 * 96; bf16* g2T = a2T + 1024 * 96;
    for (int e0 = vcu * NTHR + ltid(); e0 < 448 * 1024; e0 += 4 * G * NTHR) { float v[4];
#pragma unroll
        for (int u = 0; u < 4; ++u) { const int e = e0 + u * G * NTHR, i = e >> 10; v[u] = 0.f;
            if (e < 448 * 1024) v[u] = i < 96 ? P.w2[e] : (i < 192 ? P.a2[e - 96 * 1024] : P.g2[e - 192 * 1024]); }
#pragma unroll
        for (int u = 0; u < 4; ++u) { const int e = e0 + u * G * NTHR, i = e >> 10, n = e & 1023;
            if (e < 448 * 1024) { if (i < 96) w2T[n * 96 + i] = (bf16)f2bf(v[u]); else if (i < 192) a2T[n * 96 + (i - 96)] = (bf16)f2bf(v[u]); else g2T[n * 256 + (i - 192)] = (bf16)f2bf(v[u]); } }
    }
}
__device__ __forceinline__ void phase_act(KP P, int vcu, int G) {
    const bf16* proj = (const bf16*)(P.ws + WS_PROJ); unsigned* act = (unsigned*)(P.ws + WS_ACT);
    for (int e0 = vcu * NTHR + ltid(); e0 < TT * 224; e0 += 4 * G * NTHR) {
        unsigned cu[4], pu[4]; float m0[4], m1[4];
#pragma unroll
        for (int u = 0; u < 4; ++u) { const int e = e0 + u * G * NTHR; cu[u] = 0u; pu[u] = 0u; m0[u] = 0.f; m1[u] = 0.f;
            if (e < TT * 224) { const int t = e / 224, cc = 2 * (e - t * 224); const bf16* pr = proj + (size_t)t * INCP + C_RW + 3072 + cc;
                cu[u] = *(const unsigned*)pr; pu[u] = (t & (SEQ - 1)) == 0 ? 0u : *(const unsigned*)(pr - INCP); m0[u] = P.mu[3072 + cc]; m1[u] = P.mu[3072 + cc + 1]; } }
#pragma unroll
        for (int u = 0; u < 4; ++u) { const int e = e0 + u * G * NTHR;
            if (e < TT * 224) { const int t = e / 224, cc = 2 * (e - t * 224);
                float v0 = bflo(cu[u]) + (bflo(pu[u]) - bflo(cu[u])) * m0[u], v1 = bfhi(cu[u]) + (bfhi(pu[u]) - bfhi(cu[u])) * m1[u];
                if (cc < 96) { v0 = tanhf(v0); v1 = tanhf(v1); } else if (cc >= 192) { v0 = 1.f / (1.f + __expf(-v0)); v1 = 1.f / (1.f + __expf(-v1)); }
                act[e] = pk2(v0, v1); } }
    }
}
constexpr int ACTP = 456;
constexpr int L_WAG = 58368;
static_assert(L_WAG + 3 * 16384 <= L_MISC, "lora scratch fits below misc");
struct LoraFrags { bf16x8 f[16]; f32x4 w0[4], a0[4]; float mu_r, mu_k, mu_v, kkc, kac, rkc, lng, lnb; };
__device__ __forceinline__ LoraFrags lora_frags_load(KP P, int h, int wave, int lane) {
    const int c32 = lane & 31, hi = lane >> 5, nb = (wave & 3) >> 1; const int nrow = h * 64 + nb * 32 + c32;
    const bf16* w2T = (const bf16*)(P.ws + WS_LORA); const bf16* a2T = w2T + 1024 * 96; const bf16* g2T = a2T + 1024 * 96;
    const bf16* wp = w2T + (size_t)nrow * 96 + 8 * hi; const bf16* ap = a2T + (size_t)nrow * 96 + 8 * hi; const bf16* gp = g2T + (size_t)nrow * 256 + 8 * hi;
    LoraFrags W;
#pragma unroll
    for (int kk = 0; kk < 16; ++kk) { const bf16* src = wave < 4 ? (kk < 6 ? wp + 16 * kk : ap + 16 * ((kk - 6) % 6)) : gp + 16 * kk; W.f[kk] = *(const bf16x8*)src; }
#pragma unroll
    for (int g = 0; g < 4; ++g) { const int n0 = h * 64 + nb * 32 + 8 * g + 4 * hi; W.w0[g] = *(const f32x4*)(P.w0 + n0); W.a0[g] = *(const f32x4*)(P.a0 + n0); }
    const int col = h * 64 + lane;
    W.mu_r = P.mu[col]; W.mu_k = P.mu[1024 + col]; W.mu_v = P.mu[2048 + col]; W.kkc = P.k_k[col]; W.kac = P.k_a[col]; W.rkc = P.r_k[col]; W.lng = P.ln_g[col]; W.lnb = P.ln_b[col];
    return W;
}
__device__ __forceinline__ void rwkv_stage_a(KP P, LAS unsigned char* lds, int item, const LoraFrags& W) {
    const int tid = ltid(), lane = tid & 63, wave = __builtin_amdgcn_readfirstlane(tid >> 6);
    const int b = item >> 10, h = (item >> 6) & 15, c = item & 63;
    const int tok0 = b * SEQ + c * 64;
    const bf16* proj = (const bf16*)(P.ws + WS_PROJ);
    unsigned char* chk = P.ws + WS_CHK + (size_t)((item & 63) * 32 + (item >> 6)) * CHK_ITEM;
    LAS float* misc = (LAS float*)(lds + L_MISC);
    { const bf16* actg = (const bf16*)(P.ws + WS_ACT) + (size_t)tok0 * 448;
#pragma unroll
      for (int e = tid; e < 64 * 56; e += NTHR) { const int row = e / 56, ch = e - row * 56; *(LAS v4u*)(lds + (row * ACTP + ch * 8) * 2) = *(const v4u*)(actg + (size_t)row * 448 + ch * 8); } }
    __syncthreads();
    {
        const int c32 = lane & 31, hi = lane >> 5, qd = wave & 3, nb = qd >> 1, tb = qd & 1;
        const LAS unsigned char* actp = lds + ((tb * 32 + c32) * ACTP + 8 * hi) * 2;
        LAS float* wag = (LAS float*)(lds + L_WAG) + (tb * 32 + c32) * 64 + nb * 32;
        if (wave < 4) {
            f32x16 aw = {}, aa = {};
#pragma unroll
            for (int kk = 0; kk < 6; ++kk) {
                aw = __builtin_amdgcn_mfma_f32_32x32x16_bf16(W.f[kk], *(const LAS bf16x8*)(actp + (16 * kk) * 2), aw, 0, 0, 0);
                aa = __builtin_amdgcn_mfma_f32_32x32x16_bf16(W.f[6 + kk], *(const LAS bf16x8*)(actp + (96 + 16 * kk) * 2), aa, 0, 0, 0); }
#pragma unroll
            for (int g = 0; g < 4; ++g) { const int n0 = h * 64 + nb * 32 + 8 * g + 4 * hi;
                const f32x4 w0 = W.w0[g], a0 = W.a0[g]; f32x4 ow, oa;
#pragma unroll
                for (int e = 0; e < 4; ++e) { const float xx = w0[e] + aw[4 * g + e];
                    ow[e] = __expf(-0.6065306597126334f * __builtin_amdgcn_rcpf(1.f + __expf(-xx))); oa[e] = __builtin_amdgcn_rcpf(1.f + __expf(-(a0[e] + aa[4 * g + e]))); }
                *(LAS f32x4*)(wag + 8 * g + 4 * hi) = ow; *(LAS f32x4*)(wag + 4096 + 8 * g + 4 * hi) = oa; }
        } else {
            f32x16 ag = {};
#pragma unroll
            for (int kk = 0; kk < 16; ++kk) ag = __builtin_amdgcn_mfma_f32_32x32x16_bf16(W.f[kk], *(const LAS bf16x8*)(actp + (192 + 16 * kk) * 2), ag, 0, 0, 0);
#pragma unroll
            for (int g = 0; g < 4; ++g) *(LAS f32x4*)(wag + 8192 + 8 * g + 4 * hi) = (f32x4){ag[4 * g], ag[4 * g + 1], ag[4 * g + 2], ag[4 * g + 3]};
        }
    }
    __syncthreads();
    {
        const int n = lane, tg = wave, col = h * 64 + n;
        const float mu_r = W.mu_r, mu_k = W.mu_k, mu_v = W.mu_v, kkc = W.kkc, kac = W.kac, rkc = W.rkc, lng = W.lng, lnb = W.lnb;
        float rr[8], kr[8], vv[8], ww[8], aa[8], gg[8], kk[8];
        const int tfirst = tok0 + 8 * tg;
        const bf16* pp = proj + (size_t)tfirst * INCP + C_RW + col;
        float pr, pk, pvv;
        if (c == 0 && tg == 0) { pr = 0.f; pk = 0.f; pvv = 0.f; } else { pr = bf2f(pp[-(long)INCP]); pk = bf2f(pp[-(long)INCP + 1024]); pvv = bf2f(pp[-(long)INCP + 2048]); }
        const LAS float* wagr = (const LAS float*)(lds + L_WAG) + (8 * tg) * 64 + n;
#pragma unroll
        for (int q = 0; q < 8; ++q) { const float cr = bf2f(pp[(size_t)q * INCP]), ck = bf2f(pp[(size_t)q * INCP + 1024]), cv = bf2f(pp[(size_t)q * INCP + 2048]);
            rr[q] = cr + (pr - cr) * mu_r; kr[q] = ck + (pk - ck) * mu_k; vv[q] = cv + (pvv - cv) * mu_v; pr = cr; pk = ck; pvv = cv;
            ww[q] = wagr[q * 64]; aa[q] = wagr[4096 + q * 64]; gg[q] = wagr[8192 + q * 64]; }
        float lam[8]; float run = 1.f;
#pragma unroll
        for (int q = 0; q < 8; ++q) { run *= ww[q]; lam[q] = run; }
        misc[tg * 64 + n] = run;
#pragma unroll
        for (int q = 0; q < 8; ++q) { const float kkv = kr[q] * kkc; const float ss = wave_sum(kkv * kkv); kk[q] = kkv * __builtin_amdgcn_rsqf(fmaxf(ss, 1e-24f));
            kr[q] = kr[q] * (1.f + (aa[q] - 1.f) * kac); }
        __syncthreads();
        float pre = 1.f, tot = 1.f;
#pragma unroll
        for (int g = 0; g < 8; ++g) { const float sgt = misc[g * 64 + n]; if (g < tg) pre *= sgt; tot *= sgt; }
        if (tg == 0) misc[512 + n] = tot;
        unsigned vt[4], bbt[4], kbt[4];
        LAS bf16* At = (LAS bf16*)(lds + M_AT * MATB); LAS bf16* Bt = (LAS bf16*)(lds + M_BT * MATB); LAS bf16* Kt = (LAS bf16*)(lds + M_KT * MATB); LAS bf16* Rt = (LAS bf16*)(lds + M_RT * MATB);
        float hbb = 0.f, hkb = 0.f, hv = 0.f;
#pragma unroll
        for (int q = 0; q < 8; ++q) { const int t = 8 * tg + q;
            const float L = pre * lam[q], Lp = q == 0 ? pre : pre * lam[q - 1], iL = __builtin_amdgcn_rcpf(L), rel = tot * iL;
            const float bq = kk[q] * aa[q];
            ((LAS float*)(lds + L_RHS))[t * 128 + 64 + n] = -kk[q] * Lp;
            At[t * CP + n] = (bf16)f2bf(-kk[q] * Lp); Bt[t * CP + n] = (bf16)f2bf(bq * iL); Kt[t * CP + n] = (bf16)f2bf(kr[q] * iL); Rt[t * CP + n] = (bf16)f2bf(rr[q] * L);
            const float bb = bq * rel, kb = kr[q] * rel;
            if (q & 1) { vt[q >> 1] = pk2(hv, vv[q]); bbt[q >> 1] = pk2(hbb, bb); kbt[q >> 1] = pk2(hkb, kb); } else { hv = vv[q]; hbb = bb; hkb = kb; }
            const float bs = wave_sum(rr[q] * kr[q] * rkc);
            const int pl = (((t >> 4) * 2 + (n >> 5)) * 64 + (t & 15) * 4 + ((n >> 2) & 3)) * 8 + ((n >> 4) & 1) * 4 + (n & 3);
            ((bf16*)(chk + 4 * 8192))[pl] = (bf16)f2bf(lng * gg[q]);
            ((bf16*)(chk + 5 * 8192))[pl] = (bf16)f2bf((lnb + bs * vv[q]) * gg[q]); }
        *(LAS v4u*)(lds + M_VT * MATB + (n * CP + 8 * tg) * 2) = (v4u){vt[0], vt[1], vt[2], vt[3]};
        *(LAS v4u*)(lds + M_BBT * MATB + (n * CP + 8 * tg) * 2) = (v4u){bbt[0], bbt[1], bbt[2], bbt[3]};
        *(LAS v4u*)(lds + M_KBT * MATB + (n * CP + 8 * tg) * 2) = (v4u){kbt[0], kbt[1], kbt[2], kbt[3]};
    }
    __syncthreads();
    const int c32 = lane & 31, hi = lane >> 5;
    {
        const int prod = wave >> 1;
#pragma unroll
        for (int qi = 0; qi < 2; ++qi) {
            const int tb = (wave & 1) ? (qi == 0 ? 1 : 0) : qi, sb = (wave & 1) ? 1 : 0; const bool zero = (tb == 0 && sb == 1);
            f32x16 acc = {};
            const int xa = (prod == 0 || prod == 2) ? M_BT : M_KT, ya = prod < 2 ? M_AT : M_RT, dm = prod == 0 ? M_LAB : (prod == 1 ? M_LAK : (prod == 2 ? M_MRB : M_MRK));
            if (!zero) acc = mm_tile(lds + xa * MATB, sb, lds + ya * MATB, tb, acc, lane);
            const int t = tb * 32 + c32; LAS unsigned char* dst = lds + dm * MATB + (t * CP + sb * 32) * 2;
#pragma unroll
            for (int g = 0; g < 4; ++g) { float o[4];
#pragma unroll
                for (int e = 0; e < 4; ++e) { const int s = sb * 32 + 8 * g + 4 * hi + e; const bool keep = prod < 2 ? (s < t) : (s <= t); o[e] = keep ? acc[4 * g + e] : 0.f; }
                *(LAS v2u*)(dst + (8 * g + 4 * hi) * 2) = (v2u){pk2(o[0], o[1]), pk2(o[2], o[3])}; }
        }
    }
    __syncthreads();
    if (wave < 4) {
        const int ib = wave >> 1, tb = wave & 1; f32x16 acc = {};
        acc = mm_tile(lds + M_VT * MATB, ib, lds + M_LAK * MATB, tb, acc, lane, 0, tb == 0 ? 2 : 4);
        const int t = tb * 32 + c32; LAS float* dst = (LAS float*)(lds + L_RHS) + t * 128 + ib * 32;
#pragma unroll
        for (int g = 0; g < 4; ++g) *(LAS f32x4*)(dst + 8 * g + 4 * hi) = (f32x4){acc[4 * g], acc[4 * g + 1], acc[4 * g + 2], acc[4 * g + 3]};
    } else if (wave == 4) {
        const int bb = lane >> 4, col = lane & 15;
        float x[16];
#pragma unroll
        for (int t = 0; t < 16; ++t) x[t] = t == col ? 1.f : 0.f;
#pragma unroll
        for (int t = 1; t < 16; ++t) { const LAS unsigned char* rp = lds + M_LAB * MATB + ((16 * bb + t) * CP + 16 * bb) * 2; const v4u ra = *(const LAS v4u*)rp, rb = *(const LAS v4u*)(rp + 16);
            float lrow[16];
#pragma unroll
            for (int q = 0; q < 4; ++q) { lrow[2 * q] = bflo(ra[q]); lrow[2 * q + 1] = bfhi(ra[q]); lrow[8 + 2 * q] = bflo(rb[q]); lrow[8 + 2 * q + 1] = bfhi(rb[q]); }
#pragma unroll
            for (int s = 0; s < t; ++s) x[t] += lrow[s] * x[s]; }
        LAS bf16* T = (LAS bf16*)(lds + L_TB) + bb * 256 + col;
#pragma unroll
        for (int t = 0; t < 16; ++t) T[t * 16] = (bf16)f2bf(x[t]);
    }
    __syncthreads();
    {
        typedef short s16x4 __attribute__((ext_vector_type(4)));
        const int l15 = lane & 15, q4 = lane >> 4;
        LAS unsigned char* xt = lds + (wave < 4 ? M_U0T : M_AHT) * MATB + ((16 * (wave & 3) + l15) * CP) * 2;
        *(LAS v4u*)(xt + q4 * 32) = (v4u){0u, 0u, 0u, 0u}; *(LAS v4u*)(xt + q4 * 32 + 16) = (v4u){0u, 0u, 0u, 0u};
        const LAS float* Xf = (const LAS float*)(lds + L_RHS) + 16 * wave + l15;
#pragma unroll
        for (int bq = 0; bq < 4; ++bq) {
            f32x4 acc;
#pragma unroll
            for (int e = 0; e < 4; ++e) acc[e] = Xf[(16 * bq + 4 * q4 + e) * 128];
#pragma unroll
            for (int kk = 0; kk < (bq + 1) / 2; ++kk) {
                const bf16x8 a = *(const LAS bf16x8*)(lds + M_LAB * MATB + ((16 * bq + l15) * CP + 32 * kk + 8 * q4) * 2);
                const bf16x8 xb = *(const LAS bf16x8*)(xt + (32 * kk + 8 * q4) * 2);
                acc = __builtin_amdgcn_mfma_f32_16x16x32_bf16(a, xb, acc, 0, 0, 0); }
            const v2u tf = *(const LAS v2u*)(lds + L_TB + (bq * 256 + l15 * 16 + 4 * q4) * 2);
            const v2u ab = (v2u){pk2(acc[0], acc[1]), pk2(acc[2], acc[3])};
            const f32x4 z = {0.f, 0.f, 0.f, 0.f};
            const f32x4 xn = __builtin_amdgcn_mfma_f32_16x16x16bf16_1k(__builtin_bit_cast(s16x4, tf), __builtin_bit_cast(s16x4, ab), z, 0, 0, 0);
            *(LAS v2u*)(xt + (16 * bq + 4 * q4) * 2) = (v2u){pk2(xn[0], xn[1]), pk2(xn[2], xn[3])};
        }
    }
    __syncthreads();
    {
        const int qd = wave & 3, yb = qd >> 1, xb = qd & 1;
        f32x16 acc1 = {}, acc2 = {};
        if (wave < 4) {
            acc1 = mm_tile(lds + M_AHT * MATB, yb, lds + M_BBT * MATB, xb, acc1, lane);
            acc2 = mm_tile(lds + M_BBT * MATB, yb, lds + M_U0T * MATB, xb, acc2, lane);
            acc2 = mm_tile(lds + M_KBT * MATB, yb, lds + M_VT * MATB, xb, acc2, lane);
            const int x = xb * 32 + c32; const float lc = misc[512 + x];
            bf16* o1 = (bf16*)(chk + 0 * 8192) + (((x >> 4) * 2 + yb) * 64 + (x & 15)) * 8 + 4 * hi; bf16* o2 = (bf16*)(chk + 1 * 8192) + ((2 * yb * 4 + (x >> 4)) * 64 + (x & 15)) * 4;
#pragma unroll
            for (int g = 0; g < 4; ++g) { float p[4];
#pragma unroll
                for (int e = 0; e < 4; ++e) { const int y = yb * 32 + 8 * g + 4 * hi + e; p[e] = acc1[4 * g + e] + (y == x ? lc : 0.f); }
                *(v2u*)(o1 + 16 * g * 8) = (v2u){pk2(p[0], p[1]), pk2(p[2], p[3])};
                *(v2u*)(o2 + ((g >> 1) * 4 * 64 + 16 * ((2 * g + hi) & 3)) * 4) = (v2u){pk2(acc2[4 * g], acc2[4 * g + 1]), pk2(acc2[4 * g + 2], acc2[4 * g + 3])}; }
        } else {
            acc1 = mm_tile(lds + M_AHT * MATB, yb, lds + M_MRB * MATB, xb, acc1, lane);
            acc2 = mm_tile(lds + M_U0T * MATB, yb, lds + M_MRB * MATB, xb, acc2, lane);
            acc2 = mm_tile(lds + M_VT * MATB, yb, lds + M_MRK * MATB, xb, acc2, lane);
            const int x = xb * 32 + c32;
            bf16* o1 = (bf16*)(chk + 2 * 8192) + (((x >> 4) * 2 + yb) * 64 + (x & 15)) * 8 + 4 * hi; bf16* o2 = (bf16*)(chk + 3 * 8192) + (((x >> 4) * 2 + yb) * 64 + (x & 15)) * 8;
            const LAS bf16* Rt = (const LAS bf16*)(lds + M_RT * MATB) + x * CP + yb * 32;
#pragma unroll
            for (int g = 0; g < 4; ++g) { float p[4];
#pragma unroll
                for (int e = 0; e < 4; ++e) p[e] = acc1[4 * g + e] + bf2f(Rt[8 * g + 4 * hi + e]);
                *(v2u*)(o1 + 16 * g * 8) = (v2u){pk2(p[0], p[1]), pk2(p[2], p[3])};
                *(v2u*)(o2 + 16 * ((2 * g + hi) & 3) * 8 + (g >> 1) * 4) = (v2u){pk2(acc2[4 * g], acc2[4 * g + 1]), pk2(acc2[4 * g + 2], acc2[4 * g + 3])}; }
        }
    }
    __syncthreads();
}

__device__ __forceinline__ void phase_rwkv_stage_a(KP P, LAS unsigned char* lds, int vcu, int G) {
    const int tid = ltid(), lane = tid & 63, wave = __builtin_amdgcn_readfirstlane(tid >> 6);
    int cur_bh = (vcu & 255) >> 3; LoraFrags W = lora_frags_load(P, cur_bh & 15, wave, lane);
    for (int k = vcu; k < 2048; k += G) { const int bh = (k & 255) >> 3, c = (k & 7) + 8 * (k >> 8);
        if (bh != cur_bh) { W = lora_frags_load(P, bh & 15, wave, lane); cur_bh = bh; }
        rwkv_stage_a(P, lds, bh * 64 + c, W); }
}
typedef float f32x4v __attribute__((ext_vector_type(4)));
struct YSet { bf16x8 b0, b1; v4u y0[2], g1[2], g2[2]; };
struct SSet { bf16x8 p0[1], p1[1]; v2u q[4]; };
__device__ __forceinline__ void rwkv_stage_b(KP P, LAS unsigned char* lds, int bh) {
    const int tid = ltid(), lane = tid & 63, wave = __builtin_amdgcn_readfirstlane(tid >> 6);
    const int b = bh >> 4, h = bh & 15; const int l15 = lane & 15, q4 = lane >> 4;
    bf16* AR = (bf16*)(P.ws + WS_AR);
    for (int u = tid; u < 2 * MATB / 4; u += NTHR) ((LAS unsigned*)lds)[u] = 0u;
    __syncthreads();
    const int w4 = wave & 3;
    const unsigned char* chk0 = P.ws + WS_CHK + (size_t)bh * CHK_ITEM;
    if (wave < 4) {
        const int t = 16 * w4 + l15;
        YSet ys[4];
#define YLOAD(S_, c_) do { const unsigned char* chk = chk0 + (size_t)(c_) * (32 * CHK_ITEM); const bf16* rh = (const bf16*)(chk + 2 * 8192) + (w4 * 128 + lane) * 8; S_.b0 = *(const bf16x8*)rh; S_.b1 = *(const bf16x8*)(rh + 512); \
        const bf16* y0 = (const bf16*)(chk + 3 * 8192) + (w4 * 128 + lane) * 8; const bf16* g1 = (const bf16*)(chk + 4 * 8192) + (w4 * 128 + l15 * 4 + q4) * 8; \
        S_.y0[0] = *(const v4u*)y0; S_.y0[1] = *(const v4u*)(y0 + 512); S_.g1[0] = *(const v4u*)g1; S_.g1[1] = *(const v4u*)(g1 + 512); S_.g2[0] = *(const v4u*)(g1 + 4096); S_.g2[1] = *(const v4u*)(g1 + 4096 + 512); } while (0)
#define YV(A_, it_, w_) ((A_)[(it_) >> 1][2 * ((it_) & 1) + (w_)])
#pragma unroll
        for (int u = 0; u < 4; ++u) YLOAD(ys[u], u);
        for (int c0 = 0; c0 < 60; c0 += 4) {
#pragma unroll
                for (int u = 0; u < 4; ++u) { const int c = c0 + u;
                const LAS unsigned char* Scur = lds + (c & 1) * MATB;
                    f32x4v acc[4];
    #pragma unroll
                    for (int it = 0; it < 4; ++it) { acc[it] = (f32x4v){bflo(YV(ys[u].y0, it, 0)), bfhi(YV(ys[u].y0, it, 0)), bflo(YV(ys[u].y0, it, 1)), bfhi(YV(ys[u].y0, it, 1))};
                        const LAS unsigned char* sp = Scur + ((16 * it + l15) * CP + 8 * q4) * 2;
                        acc[it] = __builtin_amdgcn_mfma_f32_16x16x32_bf16(*(const LAS bf16x8*)sp, ys[u].b0, acc[it], 0, 0, 0);
                        acc[it] = __builtin_amdgcn_mfma_f32_16x16x32_bf16(*(const LAS bf16x8*)(sp + 64), ys[u].b1, acc[it], 0, 0, 0); }
                    float s = 0.f;
    #pragma unroll
                    for (int it = 0; it < 4; ++it) s += (acc[it].x + acc[it].y) + (acc[it].z + acc[it].w);
                    s += __shfl_xor(s, 16); s += __shfl_xor(s, 32);
                    const float mean = s * (1.f / 64.f); float v = 0.f;
    #pragma unroll
                    for (int it = 0; it < 4; ++it) { acc[it] = acc[it] - mean; v += (acc[it].x * acc[it].x + acc[it].y * acc[it].y) + (acc[it].z * acc[it].z + acc[it].w * acc[it].w); }
                    v += __shfl_xor(v, 16); v += __shfl_xor(v, 32);
                    const float rstd = 1.0f / sqrtf(v * (1.f / 64.f) + 64e-5f);
                    bf16* orow = AR + (size_t)(b * SEQ + c * 64 + t) * DM + 1024 + h * 64 + 4 * q4;
    #pragma unroll
                    for (int it = 0; it < 4; ++it) {
                        const float o0 = acc[it].x * rstd * bflo(YV(ys[u].g1, it, 0)) + bflo(YV(ys[u].g2, it, 0)), o1 = acc[it].y * rstd * bfhi(YV(ys[u].g1, it, 0)) + bfhi(YV(ys[u].g2, it, 0));
                        const float o2 = acc[it].z * rstd * bflo(YV(ys[u].g1, it, 1)) + bflo(YV(ys[u].g2, it, 1)), o3 = acc[it].w * rstd * bfhi(YV(ys[u].g1, it, 1)) + bfhi(YV(ys[u].g2, it, 1));
                        *(v2u*)(orow + 16 * it) = (v2u){pk2(o0, o1), pk2(o2, o3)}; }
                asm volatile("" ::: "memory");
                    YLOAD(ys[u], c + 4);
                    __syncthreads();
                }
        }
        { const int c0 = 60;
#pragma unroll
                for (int u = 0; u < 4; ++u) { const int c = c0 + u;
                const LAS unsigned char* Scur = lds + (c & 1) * MATB;
                    f32x4v acc[4];
    #pragma unroll
                    for (int it = 0; it < 4; ++it) { acc[it] = (f32x4v){bflo(YV(ys[u].y0, it, 0)), bfhi(YV(ys[u].y0, it, 0)), bflo(YV(ys[u].y0, it, 1)), bfhi(YV(ys[u].y0, it, 1))};
                        const LAS unsigned char* sp = Scur + ((16 * it + l15) * CP + 8 * q4) * 2;
                        acc[it] = __builtin_amdgcn_mfma_f32_16x16x32_bf16(*(const LAS bf16x8*)sp, ys[u].b0, acc[it], 0, 0, 0);
                        acc[it] = __builtin_amdgcn_mfma_f32_16x16x32_bf16(*(const LAS bf16x8*)(sp + 64), ys[u].b1, acc[it], 0, 0, 0); }
                    float s = 0.f;
    #pragma unroll
                    for (int it = 0; it < 4; ++it) s += (acc[it].x + acc[it].y) + (acc[it].z + acc[it].w);
                    s += __shfl_xor(s, 16); s += __shfl_xor(s, 32);
                    const float mean = s * (1.f / 64.f); float v = 0.f;
    #pragma unroll
                    for (int it = 0; it < 4; ++it) { acc[it] = acc[it] - mean; v += (acc[it].x * acc[it].x + acc[it].y * acc[it].y) + (acc[it].z * acc[it].z + acc[it].w * acc[it].w); }
                    v += __shfl_xor(v, 16); v += __shfl_xor(v, 32);
                    const float rstd = 1.0f / sqrtf(v * (1.f / 64.f) + 64e-5f);
                    bf16* orow = AR + (size_t)(b * SEQ + c * 64 + t) * DM + 1024 + h * 64 + 4 * q4;
    #pragma unroll
                    for (int it = 0; it < 4; ++it) {
                        const float o0 = acc[it].x * rstd * bflo(YV(ys[u].g1, it, 0)) + bflo(YV(ys[u].g2, it, 0)), o1 = acc[it].y * rstd * bfhi(YV(ys[u].g1, it, 0)) + bfhi(YV(ys[u].g2, it, 0));
                        const float o2 = acc[it].z * rstd * bflo(YV(ys[u].g1, it, 1)) + bflo(YV(ys[u].g2, it, 1)), o3 = acc[it].w * rstd * bfhi(YV(ys[u].g1, it, 1)) + bfhi(YV(ys[u].g2, it, 1));
                        *(v2u*)(orow + 16 * it) = (v2u){pk2(o0, o1), pk2(o2, o3)}; }
                __syncthreads();
                }
        }
#undef YLOAD
#undef YV
    } else {
        const int nrow = 16 * w4 + l15;
        SSet ss[4];
#define SLOADX(S_, c_) do { const unsigned char* chk = chk0 + (size_t)(c_) * (32 * CHK_ITEM); const bf16* pt = (const bf16*)chk + (w4 * 128 + lane) * 8; S_.p0[0] = *(const bf16x8*)pt; S_.p1[0] = *(const bf16x8*)(pt + 512); \
        const bf16* q = (const bf16*)(chk + 1 * 8192) + (w4 * 256 + lane) * 4; \
        _Pragma("unroll") for (int it = 0; it < 4; ++it) S_.q[it] = *(const v2u*)(q + it * 256); } while (0)
#pragma unroll
        for (int u = 0; u < 4; ++u) SLOADX(ss[u], u);
        for (int c0 = 0; c0 < 60; c0 += 4) {
#pragma unroll
                for (int u = 0; u < 4; ++u) { const int c = c0 + u;
                const LAS unsigned char* Scur = lds + (c & 1) * MATB; LAS unsigned char* Snxt = lds + ((c & 1) ^ 1) * MATB;
    #pragma unroll
                    for (int it = 0; it < 4; ++it) { const int i = 16 * it + l15;
                        const LAS unsigned char* sp = Scur + (i * CP + 8 * q4) * 2; const bf16x8 s0 = *(const LAS bf16x8*)sp, s1 = *(const LAS bf16x8*)(sp + 64);
                        f32x4v acc = (f32x4v){bflo(ss[u].q[it].x), bfhi(ss[u].q[it].x), bflo(ss[u].q[it].y), bfhi(ss[u].q[it].y)};
                        acc = __builtin_amdgcn_mfma_f32_16x16x32_bf16(ss[u].p0[0], s0, acc, 0, 0, 0);
                        acc = __builtin_amdgcn_mfma_f32_16x16x32_bf16(ss[u].p1[0], s1, acc, 0, 0, 0);
                        *(LAS v2u*)(Snxt + (i * CP + 16 * w4 + 4 * q4) * 2) = (v2u){pk2(acc.x, acc.y), pk2(acc.z, acc.w)}; }
                asm volatile("" ::: "memory");
                    SLOADX(ss[u], c + 4);
                    __syncthreads();
                }
        }
        { const int c0 = 60;
#pragma unroll
                for (int u = 0; u < 4; ++u) { const int c = c0 + u;
                const LAS unsigned char* Scur = lds + (c & 1) * MATB; LAS unsigned char* Snxt = lds + ((c & 1) ^ 1) * MATB;
    #pragma unroll
                    for (int it = 0; it < 4; ++it) { const int i = 16 * it + l15;
                        const LAS unsigned char* sp = Scur + (i * CP + 8 * q4) * 2; const bf16x8 s0 = *(const LAS bf16x8*)sp, s1 = *(const LAS bf16x8*)(sp + 64);
                        f32x4v acc = (f32x4v){bflo(ss[u].q[it].x), bfhi(ss[u].q[it].x), bflo(ss[u].q[it].y), bfhi(ss[u].q[it].y)};
                        acc = __builtin_amdgcn_mfma_f32_16x16x32_bf16(ss[u].p0[0], s0, acc, 0, 0, 0);
                        acc = __builtin_amdgcn_mfma_f32_16x16x32_bf16(ss[u].p1[0], s1, acc, 0, 0, 0);
                        *(LAS v2u*)(Snxt + (i * CP + 16 * w4 + 4 * q4) * 2) = (v2u){pk2(acc.x, acc.y), pk2(acc.z, acc.w)}; }
                __syncthreads();
                }
        }
#undef SLOADX
    }
}

constexpr size_t WS_UB = WS_RWA;
constexpr size_t WS_VB = WS_RWA + 32 * MiB;
constexpr float U_SCALE = 512.f, V_SCALE = 32.f;
constexpr int SLICE_BYTES = 16384 * 128;
typedef float f32x2 __attribute__((ext_vector_type(2)));
__device__ __forceinline__ void phase_convert_tables(KP P, LAS unsigned char* lds) {
    const int tid = ltid(); constexpr int N16 = 16384 * 2048 / 16, GPT = 8, CH = GPT * NTHR, NCH = 2 * N16 / CH;
    unsigned* ctr = (unsigned*)(P.ws + WS_CTL) + CW_MOBA_CTR; LAS int* slot = (LAS int*)lds;
    const int q = tid & 127;
    f32x4 gu[4];
#pragma unroll
    for (int m = 0; m < 4; ++m) gu[m] = *(const f32x4*)(P.norm2_g + 16 * q + 4 * m) * U_SCALE;
    __syncthreads();
    if (tid == 0) slot[0] = (int)__hip_atomic_fetch_add(ctr, 1u, __ATOMIC_RELAXED, __HIP_MEMORY_SCOPE_AGENT);
    __syncthreads();
    for (int it = 0;; ++it) {
        const int c = slot[it & 1]; if (c >= NCH) break;
        if (tid == 0) slot[(it & 1) ^ 1] = (int)__hip_atomic_fetch_add(ctr, 1u, __ATOMIC_RELAXED, __HIP_MEMORY_SCOPE_AGENT);
        const bool isv = c >= NCH / 2;
        const int j0 = (isv ? c - NCH / 2 : c) * CH + tid;
        const float* src = (isv ? P.pv : P.pu) + (size_t)j0 * 16;
        unsigned char* dst = P.ws + (isv ? WS_VB : WS_UB) + (size_t)(q >> 3) * SLICE_BYTES + (size_t)(j0 >> 7) * 128 + (q & 7) * 16;
        f32x4 sc[4];
#pragma unroll
        for (int m = 0; m < 4; ++m) sc[m] = isv ? (f32x4){V_SCALE, V_SCALE, V_SCALE, V_SCALE} : gu[m];
#pragma unroll
        for (int hb = 0; hb < 1; ++hb) {
            f32x4 a[8][4];
#pragma unroll
            for (int k = 0; k < 8; ++k)
#pragma unroll
                for (int m = 0; m < 4; ++m) a[k][m] = *(const f32x4*)(src + (size_t)k * (NTHR * 16) + 4 * m);
#pragma unroll
            for (int k = 0; k < 8; ++k) { v4u o;
#pragma unroll
                for (int m = 0; m < 4; ++m) { const f32x4 v = a[k][m] * sc[m]; int p = 0;
                    p = __builtin_amdgcn_cvt_pk_fp8_f32(v.x, v.y, p, false); p = __builtin_amdgcn_cvt_pk_fp8_f32(v.z, v.w, p, true); o[m] = (unsigned)p; }
                *(v4u*)(dst + (size_t)k * 512) = o; }
        }
        __syncthreads();
    }
}
__device__ __forceinline__ f32x2 dot16p(const v4u u, const f32x2* x, f32x2 acc) {
#pragma unroll
    for (int q = 0; q < 4; ++q) { const f32x2 lo = __builtin_amdgcn_cvt_pk_f32_fp8((int)u[q], false), hi = __builtin_amdgcn_cvt_pk_f32_fp8((int)u[q], true);
        acc = __builtin_elementwise_fma(lo, x[2 * q], acc); acc = __builtin_elementwise_fma(hi, x[2 * q + 1], acc); }
    return acc;
}
__device__ __forceinline__ void axpy16p(const v4u v, f32x2 s, f32x2* y) {
#pragma unroll
    for (int q = 0; q < 4; ++q) { const f32x2 lo = __builtin_amdgcn_cvt_pk_f32_fp8((int)v[q], false), hi = __builtin_amdgcn_cvt_pk_f32_fp8((int)v[q], true);
        y[2 * q] = __builtin_elementwise_fma(s, lo, y[2 * q]); y[2 * q + 1] = __builtin_elementwise_fma(s, hi, y[2 * q + 1]); }
}
__device__ __forceinline__ float xsum_g8(float v) {
    v += DPP_F(v, 0x128);
    { auto r = __builtin_amdgcn_permlane16_swap(__float_as_uint(v), __float_as_uint(v), false, false); v = __uint_as_float(r[0]) + __uint_as_float(r[1]); }
    { auto r = __builtin_amdgcn_permlane32_swap(__float_as_uint(v), __float_as_uint(v), false, false); v = __uint_as_float(r[0]) + __uint_as_float(r[1]); }
    return v;
}
__device__ __forceinline__ void phase_peer_sliced(KP P, LAS unsigned char* lds, int bx, int G) {
    const int grp = bx & 7;
    const unsigned char* UB = P.ws + WS_UB; const unsigned char* VB = P.ws + WS_VB; const bf16* HB = (const bf16*)(P.ws + WS_XN);
    const int* ridx = (const int*)(P.ws + WS_PROJ + 64 * MiB); const float* rgate = (const float*)(P.ws + WS_PROJ + 68 * MiB); const float* RSTD = (const float*)(P.ws + WS_SSP + 2 * MiB);
    for (int bt = bx; bt < TT / 32; bt += G) {
        const int tid = ltid(), lane = tid & 63, wave = __builtin_amdgcn_readfirstlane(tid >> 6), g8 = lane >> 3, p = lane & 7;
        LAS int* idxT = (LAS int*)(lds + wave * 4096); LAS float* gT = (LAS float*)(lds + wave * 4096 + 2048);
        LAS bf16* h2T = (LAS bf16*)(lds + 32768 + wave * 16384);
        const int t0 = 32 * bt + 4 * wave;
#pragma unroll
        for (int i = 0; i < 4; ++i) { const size_t o = (size_t)(t0 + i) * 128; const int wofs = (i * 8 + (lane & 7)) * 16 + (lane >> 3);
            idxT[wofs] = ridx[o + lane]; idxT[wofs + 8] = ridx[o + 64 + lane]; gT[wofs] = rgate[o + lane]; gT[wofs + 8] = rgate[o + 64 + lane]; }
        float hacc[4][2];
#pragma unroll
        for (int i = 0; i < 4; ++i) { hacc[i][0] = 0.f; hacc[i][1] = 0.f; }
        {
            v4u rA[8], rB[8]; f32x2 xA[8], xB[8];
#define PS_SG(s_) (((s_) + 2 * grp) & 15)
#define PS_ISSUE(R, tabbase, s_, i_, hb_) do { const unsigned char* tb_ = (tabbase) + (size_t)PS_SG(s_) * SLICE_BYTES;        \
            const v4u ia_ = *(const LAS v4u*)(idxT + ((i_) * 8 + g8) * 16 + 8 * (hb_)), ib_ = *(const LAS v4u*)(idxT + ((i_) * 8 + g8) * 16 + 8 * (hb_) + 4); const unsigned po_ = 16u * (unsigned)p; \
            R[0] = *(const v4u*)(tb_ + (ia_[0] * 128u + po_)); R[1] = *(const v4u*)(tb_ + (ia_[1] * 128u + po_)); R[2] = *(const v4u*)(tb_ + (ia_[2] * 128u + po_)); R[3] = *(const v4u*)(tb_ + (ia_[3] * 128u + po_)); \
            R[4] = *(const v4u*)(tb_ + (ib_[0] * 128u + po_)); R[5] = *(const v4u*)(tb_ + (ib_[1] * 128u + po_)); R[6] = *(const v4u*)(tb_ + (ib_[2] * 128u + po_)); R[7] = *(const v4u*)(tb_ + (ib_[3] * 128u + po_)); } while (0)
#define PS_LOADX(X, s_, i_) do { const bf16* xp_ = HB + (size_t)(t0 + (i_)) * DM + 128 * PS_SG(s_) + 16 * p; const v4u xa_ = *(const v4u*)xp_, xb_ = *(const v4u*)(xp_ + 8); \
            _Pragma("unroll") for (int q = 0; q < 4; ++q) { X[q] = (f32x2){bflo(xa_[q]), bfhi(xa_[q])}; X[4 + q] = (f32x2){bflo(xb_[q]), bfhi(xb_[q])}; } } while (0)
#define PS_DOTS(R, X, i_, hb_) do { _Pragma("unroll") for (int m = 0; m < 8; ++m) { const f32x2 a2_ = dot16p(R[m], X, (f32x2){0.f, 0.f}); float sd_ = a2_.x + a2_.y; \
            sd_ += DPP_F(sd_, 0xB1); sd_ += DPP_F(sd_, 0x4E); sd_ += DPP_F(sd_, 0x141); if (p == m) hacc[i_][hb_] += sd_; } asm volatile("" ::: "memory"); } while (0)
            PS_LOADX(xA, 0, 0); PS_ISSUE(rA, UB, 0, 0, 0);
            for (int s = 0; s < 16; ++s) {
                PS_ISSUE(rB, UB, s, 0, 1); PS_LOADX(xB, s, 1);  PS_DOTS(rA, xA, 0, 0);
                PS_ISSUE(rA, UB, s, 1, 0);                       PS_DOTS(rB, xA, 0, 1);
                PS_ISSUE(rB, UB, s, 1, 1); PS_LOADX(xA, s, 2);  PS_DOTS(rA, xB, 1, 0);
                PS_ISSUE(rA, UB, s, 2, 0);                       PS_DOTS(rB, xB, 1, 1);
                PS_ISSUE(rB, UB, s, 2, 1); PS_LOADX(xB, s, 3);  PS_DOTS(rA, xA, 2, 0);
                PS_ISSUE(rA, UB, s, 3, 0);                       PS_DOTS(rB, xA, 2, 1);
                PS_ISSUE(rB, UB, s, 3, 1); if (s + 1 < 16) PS_LOADX(xA, s + 1, 0);  PS_DOTS(rA, xB, 3, 0);
                if (s + 1 < 16) PS_ISSUE(rA, UB, s + 1, 0, 0);  PS_DOTS(rB, xB, 3, 1);
            }
#undef PS_LOADX
#undef PS_DOTS
        }
#pragma unroll
        for (int i = 0; i < 4; ++i) { const float rsn = RSTD[t0 + i] * (1.f / U_SCALE);
#pragma unroll
            for (int hb = 0; hb < 2; ++hb) { const float hp = hacc[i][hb] * rsn; LAS float* gp = gT + (i * 8 + g8) * 16 + 8 * hb + p;
                *gp = 0.5f * hp * (1.f + erff(hp * 0.70710678118654752f)) * (1.f / V_SCALE) * *gp; } }
        float ssq[4] = {0.f, 0.f, 0.f, 0.f};
        {
            v4u rA[8], rB[8]; f32x2 y2[8];
#define PS_AXPY(R, i_, hb_) do { const f32x4 aa_ = *(const LAS f32x4*)(gT + ((i_) * 8 + g8) * 16 + 8 * (hb_)), ab_ = *(const LAS f32x4*)(gT + ((i_) * 8 + g8) * 16 + 8 * (hb_) + 4); \
            if ((hb_) == 0) { _Pragma("unroll") for (int q = 0; q < 8; ++q) y2[q] = (f32x2){0.f, 0.f}; } \
            _Pragma("unroll") for (int m = 0; m < 8; ++m) { const float av_ = m < 4 ? aa_[m & 3] : ab_[m & 3]; axpy16p(R[m], (f32x2){av_, av_}, y2); } asm volatile("" ::: "memory"); } while (0)
#define PS_FIN(s_, i_) do { f32x2 ysel_ = {0.f, 0.f}; _Pragma("unroll") for (int q = 0; q < 8; ++q) { const float a_ = xsum_g8(y2[q].x), b_ = xsum_g8(y2[q].y); if (g8 == q) ysel_ = (f32x2){a_, b_}; } \
            const int d_ = 128 * PS_SG(s_) + 16 * p + 2 * g8; const unsigned hb_ = *(const unsigned*)(HB + (size_t)(t0 + (i_)) * DM + d_); const f32x2 hv_ = (f32x2){bflo(hb_), bfhi(hb_)} + ysel_; \
            *(LAS unsigned*)(h2T + (i_) * DM + d_) = pk2(hv_.x, hv_.y); ssq[i_] += hv_.x * hv_.x + hv_.y * hv_.y; } while (0)
            PS_ISSUE(rA, VB, 0, 0, 0);
            for (int s = 0; s < 16; ++s) {
                PS_ISSUE(rB, VB, s, 0, 1); PS_AXPY(rA, 0, 0);
                PS_ISSUE(rA, VB, s, 1, 0); PS_AXPY(rB, 0, 1); PS_FIN(s, 0);
                PS_ISSUE(rB, VB, s, 1, 1); PS_AXPY(rA, 1, 0);
                PS_ISSUE(rA, VB, s, 2, 0); PS_AXPY(rB, 1, 1); PS_FIN(s, 1);
                PS_ISSUE(rB, VB, s, 2, 1); PS_AXPY(rA, 2, 0);
                PS_ISSUE(rA, VB, s, 3, 0); PS_AXPY(rB, 2, 1); PS_FIN(s, 2);
                PS_ISSUE(rB, VB, s, 3, 1); PS_AXPY(rA, 3, 0);
                if (s + 1 < 16) PS_ISSUE(rA, VB, s + 1, 0, 0); PS_AXPY(rB, 3, 1); PS_FIN(s, 3);
            }
#undef PS_AXPY
#undef PS_FIN
#undef PS_ISSUE
#undef PS_SG
        }
        { f32x4 fg[8];
#pragma unroll
          for (int j = 0; j < 8; ++j) fg[j] = *(const f32x4*)(P.final_g + 4 * lane + 256 * j);
#pragma unroll
          for (int i = 0; i < 4; ++i) { const float rs2 = 1.0f / sqrtf(wave_sum(ssq[i]) * (1.f / DM) + RMS_EPS);
#pragma unroll
            for (int j = 0; j < 8; ++j) { const v2u hv = *(const LAS v2u*)(h2T + i * DM + 4 * lane + 256 * j);
                *(f32x4*)(P.out + (size_t)(t0 + i) * DM + 4 * lane + 256 * j) = (f32x4){bflo(hv.x) * rs2 * fg[j].x, bfhi(hv.x) * rs2 * fg[j].y, bflo(hv.y) * rs2 * fg[j].z, bfhi(hv.y) * rs2 * fg[j].w}; } } }
        asm volatile("" ::: "memory");
    }
}
namespace moba {
constexpr float SCALE = 0.08838834764831845f;
constexpr float THR = 8.f;
constexpr bool WSKIP = false;
constexpr int D = 128, NW = 8, QBLK = 32, KVBLK = 64, QB = NW * QBLK;
constexpr int SHM_V = KVBLK * D * 2, SHM_K = KVBLK * D * 2;
constexpr int ATT_LDS_BYTES = 2 * SHM_V + 2 * SHM_K + NW * 64 * 4;
constexpr int KPITCH = INCP, QPITCH = INCP, OPITCH = DM;
typedef unsigned short bf16;
typedef short bf16x8 __attribute__((ext_vector_type(8)));
typedef short s16x4 __attribute__((ext_vector_type(4)));
typedef float f32x16 __attribute__((ext_vector_type(16)));
typedef float f32x4 __attribute__((ext_vector_type(4)));
typedef unsigned u32x4 __attribute__((ext_vector_type(4)));
template <class A, class Bt> struct same_t { static constexpr bool v = false; };
template <class A> struct same_t<A, A> { static constexpr bool v = true; };
#define KSWZ(row, colB) ((row) * 256 + ((colB) ^ (((row) & 7) << 4)))
#define SBAR() __builtin_amdgcn_sched_barrier(0)
__device__ __forceinline__ int v_st(int k, int c) { const int kk = (k & ~0xC) | ((k & 4) << 1) | ((k & 8) >> 1); return ((kk >> 3) * 4 + (c >> 5)) * 512 + ((kk & 7) * 32 + (c & 31)) * 2; }
__device__ __forceinline__ int v_rd_base(int lane) { return ((lane & 3) << 3) | (((lane >> 2) & 3) << 6) | (((lane >> 4) & 1) << 5) | (((lane >> 5) & 1) << 8); }
constexpr int v_rd_off(int d0, int ks, int half) { return d0 * 512 + ks * 4096 + half * 2048; }
__device__ __forceinline__ int crow(int r, int hi) { return (r & 3) + 8 * (r >> 2) + 4 * hi; }
__device__ __forceinline__ unsigned cvtpk(float lo, float hi) {
    unsigned r; asm volatile("v_cvt_pk_bf16_f32 %0, %1, %2" : "=v"(r) : "v"(lo), "v"(hi)); return r;
}
__device__ __forceinline__ bf16x8 pack8(f32x4 a, f32x4 b) {
    u32x4 w = {cvtpk(a[0], a[1]), cvtpk(a[2], a[3]), cvtpk(b[0], b[1]), cvtpk(b[2], b[3])};
    return *reinterpret_cast<bf16x8*>(&w);
}
template <class T> __device__ __forceinline__ bf16x8 load8(const T* p) {
    if constexpr (same_t<T, float>::v) { return pack8(*(const f32x4*)p, *(const f32x4*)(p + 4)); }
    else { return *reinterpret_cast<const bf16x8*>(p); }
}
__device__ __forceinline__ void mask_tile(f32x16& p0, f32x16& p1, int dq, unsigned W) {
    const float NEG = -__builtin_inff();
#pragma unroll
    for (int r = 0; r < 16; ++r) {
        const int c = (r & 3) + 8 * (r >> 2);
        if ((unsigned)(dq - c) >= W) p0[r] = NEG;
        if ((unsigned)(dq - c - 32) >= W) p1[r] = NEG;
    }
}
__device__ __forceinline__ void partialSM(f32x16& p0, f32x16& p1, float& m_reg, float& mn, float& alpha, float base0, float base1) {
    float pm0 = p0[0]; for (int r = 1; r < 16; ++r) pm0 = fmaxf(pm0, p0[r]); float pm1 = p1[0]; for (int r = 1; r < 16; ++r) pm1 = fmaxf(pm1, p1[r]);
    float pmax = fmaxf(pm0 + base0, pm1 + base1);
    { auto rr = __builtin_amdgcn_permlane32_swap(__float_as_uint(pmax), __float_as_uint(pmax), false, false);
      pmax = fmaxf(__uint_as_float(rr[0]), __uint_as_float(rr[1])); }
    constexpr float C2 = 1.4426950408889634f * SCALE;
    if (__builtin_expect(__all((pmax - m_reg) * SCALE <= THR), 1)) { mn = m_reg; alpha = 1.f; }
    else { mn = fmaxf(m_reg, pmax); alpha = __builtin_amdgcn_exp2f((m_reg - mn) * C2); m_reg = mn; }
    const float mnL0 = (base0 - mn) * C2, mnL1 = (base1 - mn) * C2;
    for (int r = 0; r < 16; ++r) p0[r] = fmaf(p0[r], C2, mnL0); for (int r = 0; r < 16; ++r) p1[r] = fmaf(p1[r], C2, mnL1);
    for (int r = 0; r < 16; ++r) p0[r] = __builtin_amdgcn_exp2f(p0[r]);
}
__device__ __forceinline__ void finishSM(f32x16& p0, f32x16& p1, float alpha, float& l_reg, bf16x8& pa0, bf16x8& pa1, bf16x8& pa2, bf16x8& pa3) {
    for (int r = 0; r < 16; ++r) p1[r] = __builtin_amdgcn_exp2f(p1[r]);
    float ps = 0; for (int r = 0; r < 16; ++r) ps += p0[r]; for (int r = 0; r < 16; ++r) ps += p1[r];
    { auto rr = __builtin_amdgcn_permlane32_swap(__float_as_uint(ps), __float_as_uint(ps), false, false);
      ps = __uint_as_float(rr[0]) + __uint_as_float(rr[1]); }
    l_reg = l_reg * alpha + ps;
#define PK4(P, B_, OUT) do { unsigned a0 = cvtpk(P[B_+0], P[B_+1]), a1 = cvtpk(P[B_+2], P[B_+3]);                          \
        unsigned b0 = cvtpk(P[B_+4], P[B_+5]), b1 = cvtpk(P[B_+6], P[B_+7]);                                             \
        auto r0 = __builtin_amdgcn_permlane32_swap(a0, b0, false, false); auto r1 = __builtin_amdgcn_permlane32_swap(a1, b1, false, false); \
        u32x4 w = {r0[0], r1[0], r0[1], r1[1]}; OUT = *reinterpret_cast<bf16x8*>(&w); } while (0)
    PK4(p0, 0, pa0); PK4(p0, 8, pa1); PK4(p1, 0, pa2); PK4(p1, 8, pa3);
#undef PK4
}
template <int KB, bool SK>
__device__ __forceinline__ void qkt(f32x16& p0, f32x16& p1, const char* K_lds, int r32, int hi, const bf16x8* qr, bool act) {
    if (SK && !act) { const float NEG = -__builtin_inff();
#pragma unroll
        for (int r = 0; r < 16; ++r) { p0[r] = NEG; p1[r] = NEG; } return; }
    p0 = f32x16{}; p1 = f32x16{};
    const char* kb[4];
#pragma unroll
    for (int dd = 0; dd < 4; ++dd) kb[dd] = K_lds + KB * SHM_K + KSWZ(r32, (dd * 16 + hi * 8) * 2);
#pragma unroll
    for (int d0 = 0; d0 < 8; ++d0) { const char* a = kb[d0 & 3] + (d0 >> 2) * 128;
        bf16x8 b0 = *reinterpret_cast<const bf16x8*>(a);
        bf16x8 b1 = *reinterpret_cast<const bf16x8*>(a + 32 * 256);
        p0 = __builtin_amdgcn_mfma_f32_32x32x16_bf16(b0, qr[d0], p0, 0, 0, 0);
        p1 = __builtin_amdgcn_mfma_f32_32x32x16_bf16(b1, qr[d0], p1, 0, 0, 0); }
}
template <int VB, bool SK>
__device__ __forceinline__ void pv_tile(f32x16* o, int vb0, bf16x8 pa0, bf16x8 pa1, bf16x8 pa2, bf16x8 pa3, bool act) {
    if (SK && !act) return;
#define TRRD(dst, off) asm volatile("ds_read_b64_tr_b16 %0, %1 offset:%2" : "=&v"(dst) : "v"(vb0), "i"(off) : "memory")
#define PV_D0(d0) do { s16x4 l0, l1, h0, h1; constexpr int b_ = VB * SHM_V + v_rd_off(d0, 0, 0);     \
        TRRD(l0, b_); TRRD(h0, b_ + 2048); TRRD(l1, b_ + 4096); TRRD(h1, b_ + 6144); \
        asm volatile("s_waitcnt lgkmcnt(0)" ::: "memory"); SBAR();                 \
        o[d0] = __builtin_amdgcn_mfma_f32_32x32x16_bf16(pa0, (bf16x8){l0[0], l0[1], l0[2], l0[3], h0[0], h0[1], h0[2], h0[3]}, o[d0], 0, 0, 0);   \
        o[d0] = __builtin_amdgcn_mfma_f32_32x32x16_bf16(pa1, (bf16x8){l1[0], l1[1], l1[2], l1[3], h1[0], h1[1], h1[2], h1[3]}, o[d0], 0, 0, 0);   \
        SBAR(); TRRD(l0, b_ + 8192); TRRD(h0, b_ + 10240); TRRD(l1, b_ + 12288); TRRD(h1, b_ + 14336); \
        asm volatile("s_waitcnt lgkmcnt(0)" ::: "memory"); SBAR();   \
        o[d0] = __builtin_amdgcn_mfma_f32_32x32x16_bf16(pa2, (bf16x8){l0[0], l0[1], l0[2], l0[3], h0[0], h0[1], h0[2], h0[3]}, o[d0], 0, 0, 0);   \
        o[d0] = __builtin_amdgcn_mfma_f32_32x32x16_bf16(pa3, (bf16x8){l1[0], l1[1], l1[2], l1[3], h1[0], h1[1], h1[2], h1[3]}, o[d0], 0, 0, 0); } while (0)
    PV_D0(0); PV_D0(1); PV_D0(2); PV_D0(3);
#undef PV_D0
#undef TRRD
}

template <class TIn, class TOut> struct BlockRef { const TIn* Q; const TIn* K; const TIn* V; TOut* O; int P0; const float* KM; float A; int jlo, jhi; float* ST; };
template <class TIn> struct Seam {
    bf16x8 qr[8];
    bf16x8 st_v0, st_v1, st_k0, st_k1; f32x4 sf0, sf1, sf2, sf3;
    f32x4 tq[16];
};
__device__ __forceinline__ int swa_jlo(int P0, int W) { const int lowk = P0 - W + 1; return lowk > 0 ? lowk / KVBLK : 0; }
#define ROW(p, k0, rr) ((p) + (size_t)((k0) + (rr)) * KPITCH + sc)
#define VMW() asm volatile("s_waitcnt vmcnt(0)" ::: "memory")
#define VMWN(n) asm volatile("s_waitcnt vmcnt(%0)" :: "i"(n) : "memory")
#define SLOAD_H(Kp, Vp, k0) do { S.st_v0 = load8<TIn>(ROW(Vp, k0, sr)); S.st_v1 = load8<TIn>(ROW(Vp, k0, 32 + sr));              \
                         S.st_k0 = load8<TIn>(ROW(Kp, k0, sr)); S.st_k1 = load8<TIn>(ROW(Kp, k0, 32 + sr)); } while (0)
#define SWRITE_HK(bf) do { *(bf16x8*)(K_lds + (bf) * SHM_K + kws) = S.st_k0; *(bf16x8*)(K_lds + (bf) * SHM_K + kws + 32 * 256) = S.st_k1; } while (0)
#define SWRITE_HV(bf) do { *(bf16x8*)(V_lds + (bf) * SHM_V + vst0) = S.st_v0; *(bf16x8*)(V_lds + (bf) * SHM_V + vst1) = S.st_v1; } while (0)
#define SWRITE_H(bf) do { SWRITE_HV(bf); SWRITE_HK(bf); } while (0)
#define SLOAD_F(p, k0) do { S.sf0 = *(const f32x4*)ROW(p, k0, sr); S.sf1 = *(const f32x4*)(ROW(p, k0, sr) + 4);                \
                            S.sf2 = *(const f32x4*)ROW(p, k0, 32 + sr); S.sf3 = *(const f32x4*)(ROW(p, k0, 32 + sr) + 4); } while (0)
#define SWRITE_KF(bf) do { *(bf16x8*)(K_lds + (bf) * SHM_K + kws) = pack8(S.sf0, S.sf1); *(bf16x8*)(K_lds + (bf) * SHM_K + kws + 32 * 256) = pack8(S.sf2, S.sf3); } while (0)
#define SWRITE_VF(bf) do { *(bf16x8*)(V_lds + (bf) * SHM_V + vst0) = pack8(S.sf0, S.sf1); *(bf16x8*)(V_lds + (bf) * SHM_V + vst1) = pack8(S.sf2, S.sf3); } while (0)
template <class TIn, class TOut>
__device__ __forceinline__ void causal_swa_prime(const BlockRef<TIn, TOut>& cur, int W, char* lds, Seam<TIn>& S) {
    constexpr bool F32 = same_t<TIn, float>::v;
    const int tid = ltid(), wid = __builtin_amdgcn_readfirstlane(tid >> 6), lane = tid & 63, r32 = lane & 31, hi = lane >> 5;
    const int sr = tid >> 4, sc = (tid & 15) * 8, kws = KSWZ(sr, sc * 2); char* K_lds = lds + 2 * SHM_V;
    const int kb0 = cur.jlo * KVBLK;
    for (int d0 = 0; d0 < 8; ++d0) S.qr[d0] = load8<TIn>(cur.Q + (size_t)(wid * QBLK + r32) * QPITCH + d0 * 16 + hi * 8);
    if constexpr (F32) { SLOAD_F((const float*)cur.K, kb0); VMW(); SWRITE_KF(0); SBAR(); SLOAD_F((const float*)cur.V, kb0); }
    else { SLOAD_H(cur.K, cur.V, kb0); VMW(); SWRITE_HK(0); }
    __syncthreads();
}
template <class TIn, class TOut>
__device__ __forceinline__ void causal_swa_block(const BlockRef<TIn, TOut>& cur, const BlockRef<TIn, TOut>& nxt, int skv, int W, char* lds, Seam<TIn>& S) {
    constexpr bool F32 = same_t<TIn, float>::v;
    const int tid = ltid(), wid = __builtin_amdgcn_readfirstlane(tid >> 6), lane = tid & 63, r32 = lane & 31, hi = lane >> 5;
    const int j_lo = cur.jlo, j_hi = cur.jhi;
    const int NT = j_hi - j_lo;
    const int kbn = nxt.jlo * KVBLK;
    const int qlo = cur.P0 + wid * QBLK, qm = qlo + r32 - 4 * hi;
    char* V_lds = lds; char* K_lds = lds + 2 * SHM_V;
    float* ws = (float*)(lds + 2 * SHM_V + 2 * SHM_K) + wid * 64; float* li_l = ws, * al_l = ws + 32;
    float m_reg = -1e30f, l_reg = 0; f32x16 o[4] = {};
    const int sr = tid >> 4, sc = (tid & 15) * 8, vst0 = v_st(sr, sc), vst1 = v_st(32 + sr, sc), kws = KSWZ(sr, sc * 2);
    const int vb0 = (int)(uintptr_t)V_lds + v_rd_base(lane);
    const TIn* Kh = cur.K; const TIn* Vh = cur.V;
    const float alA_ = cur.A;
    unsigned selm = 0u;
    { const int qb_ = cur.P0 >> 8;
      if (qb_ > 0) {
        float* kmL = (float*)(K_lds + SHM_K);
        *(f32x4*)(kmL + 4 * tid) = *(const f32x4*)(cur.KM + (size_t)(tid >> 5) * 1024 + 4 * (tid & 31));
        __syncthreads();
        float g[16];
#pragma unroll
        for (int n = 0; n < 16; ++n) g[n] = 0.f;
#pragma unroll
        for (int d0 = 0; d0 < 8; ++d0) { float qf[8];
#pragma unroll
            for (int j = 0; j < 8; ++j) qf[j] = __uint_as_float(((unsigned)(unsigned short)S.qr[d0][j]) << 16);
#pragma unroll
            for (int n = 0; n < 16; ++n) if (n < qb_) { const f32x4 k0 = *(const f32x4*)(kmL + n * 128 + d0 * 16 + hi * 8), k1 = *(const f32x4*)(kmL + n * 128 + d0 * 16 + hi * 8 + 4);
                g[n] += qf[0] * k0[0] + qf[1] * k0[1] + qf[2] * k0[2] + qf[3] * k0[3] + qf[4] * k1[0] + qf[5] * k1[1] + qf[6] * k1[2] + qf[7] * k1[3]; }
            asm volatile("" ::: "memory"); }
#pragma unroll
        for (int n = 0; n < 16; ++n) { const float a = g[n] + __shfl_xor(g[n], 32); g[n] = n < qb_ ? a : -1e30f; }
#pragma unroll
        for (int r = 0; r < 3; ++r) { float best = -3e38f; int bi = 0;
#pragma unroll
            for (int n = 0; n < 16; ++n) if (!((selm >> n) & 1u) && g[n] > best) { best = g[n]; bi = n; }
            selm |= 1u << bi; }
        selm &= (1u << qb_) - 1u;
        __syncthreads();
      }
      li_l[r32] = __uint_as_float(selm); }
#define RESC(a) do { if (__any((a) < 1.f)) { if (hi == 0) al_l[r32] = (a); asm volatile("s_waitcnt lgkmcnt(0)" ::: "memory");              \
                     for (int d_ = 0; d_ < 4; ++d_) for (int r = 0; r < 16; ++r) o[d_][r] *= al_l[crow(r, hi)]; } } while (0)
#define KBASE(t) ((j_lo + (t)) * KVBLK)
#define ACT(t) (KBASE(t) <= qlo + QBLK - 1 && KBASE(t) + KVBLK - 1 >= qlo - W + 1)
#define MASKT(P0_, P1_, t) do { const int kb_ = KBASE(t); if ((!SK || ACT(t)) && (kb_ + KVBLK - 1 > qlo || kb_ <= qlo + QBLK - 1 - W)) mask_tile(P0_, P1_, qm - kb_, (unsigned)W); \
        _Pragma("unroll") for (int r = 0; r < 16; ++r) { const float c_ = (float)((r & 3) + 8 * (r >> 2)); P0_[r] = fmaf(alA_, c_, P0_[r]); P1_[r] = fmaf(alA_, c_, P1_[r]); } } while (0)
#define BASE0(t) ((KBASE(t) < cur.P0 && !((__float_as_uint(li_l[r32]) >> (KBASE(t) >> 8)) & 1u)) ? -__builtin_inff() : alA_ * (float)(KBASE(t) - cur.P0 + 4 * hi))
#define BASE1(t) (BASE0(t) + 32.f * alA_)
    constexpr int NQL = F32 ? 16 : 8;
    constexpr bool SK = WSKIP && !F32;
#define SEAM_K0() do { VMWN(NQL); if constexpr (F32) { SWRITE_KF(0); SBAR(); SLOAD_F((const float*)nxt.V, kbn); } else { SWRITE_HK(0); } SBAR(); } while (0)
    f32x16 pA0, pA1, pB0, pB1; float mnA, mnB, alA, alB; bf16x8 pa0, pa1, pa2, pa3;
    if constexpr (F32) { VMW(); SWRITE_VF(0); SBAR(); } else { SWRITE_HV(0); SBAR(); }
    if (NT > 1) { if constexpr (F32) SLOAD_F((const float*)Kh, KBASE(1)); else SLOAD_H(Kh, Vh, KBASE(1)); }
    SBAR(); qkt<0, SK>(pA0, pA1, K_lds, r32, hi, S.qr, ACT(0));
    if constexpr (F32) { if (NT > 1) { VMW(); SWRITE_KF(1); SBAR(); SLOAD_F((const float*)Vh, KBASE(1)); } }
    MASKT(pA0, pA1, 0); partialSM(pA0, pA1, m_reg, mnA, alA, BASE0(0), BASE1(0));
    if (NT > 1) { VMW(); if constexpr (F32) { SWRITE_VF(1); SBAR(); if (NT > 2) SLOAD_F((const float*)Kh, KBASE(2)); } else SWRITE_H(1); }
    __syncthreads();
#define HALF_STEP(PX0, PX1, mnX, alX, PY0, PY1, alY, t, KB, VB, SB) do {                                                      \
        SBAR(); qkt<KB, SK>(PX0, PX1, K_lds, r32, hi, S.qr, ACT(t));                                             \
        finishSM(PY0, PY1, alY, l_reg, pa0, pa1, pa2, pa3); SBAR();                                                           \
        if ((t) + 1 < NT) { if constexpr (F32) { VMW(); SWRITE_KF(SB); SBAR(); SLOAD_F((const float*)Vh, KBASE((t) + 1)); }  \
                            else { SLOAD_H(Kh, Vh, KBASE((t) + 1)); } SBAR(); }                                               \
        pv_tile<VB, SK>(o, vb0, pa0, pa1, pa2, pa3, ACT((t) - 1)); MASKT(PX0, PX1, (t)); partialSM(PX0, PX1, m_reg, mnX, alX, BASE0(t), BASE1(t));                                        \
        __syncthreads();                                                                                                      \
        if ((t) + 1 < NT) { VMW(); if constexpr (F32) { SWRITE_VF(SB); SBAR(); if ((t) + 2 < NT) SLOAD_F((const float*)Kh, KBASE((t) + 2)); } \
                            else { SWRITE_H(SB); } }                                                                          \
        RESC(alX); __syncthreads(); } while (0)
    for (int t = 1; t + 1 < NT; t += 2) {
        HALF_STEP(pB0, pB1, mnB, alB, pA0, pA1, alA, t, 1, 0, 0);
        HALF_STEP(pA0, pA1, mnA, alA, pB0, pB1, alB, t + 1, 0, 1, 1);
    }
    const bool even = (NT & 1) == 0;
    if (even) { SBAR(); qkt<1, SK>(pB0, pB1, K_lds, r32, hi, S.qr, ACT(NT - 1)); SBAR(); }
#define QROW(e) (nxt.Q + (size_t)(wid * QBLK + r32) * QPITCH + ((e) >> 1) * 16 + hi * 8 + ((e) & 1) * 4)
    if constexpr (F32) { SLOAD_F((const float*)nxt.K, kbn); SBAR();
#pragma unroll
        for (int e = 0; e < 8; ++e) S.tq[e] = *(const f32x4*)QROW(e); }
    else { SLOAD_H(nxt.K, nxt.V, kbn); SBAR();
#pragma unroll
        for (int d0 = 0; d0 < 8; ++d0) S.qr[d0] = load8<TIn>(nxt.Q + (size_t)(wid * QBLK + r32) * QPITCH + d0 * 16 + hi * 8); }
    SBAR();
    finishSM(pA0, pA1, alA, l_reg, pa0, pa1, pa2, pa3); SBAR();
    if constexpr (F32) {
#pragma unroll
        for (int e = 8; e < 16; ++e) S.tq[e] = *(const f32x4*)QROW(e); SBAR(); }
#undef QROW
    pv_tile<0, SK>(o, vb0, pa0, pa1, pa2, pa3, ACT(even ? NT - 2 : NT - 1));
    if (even) { MASKT(pB0, pB1, NT - 1); partialSM(pB0, pB1, m_reg, mnB, alB, BASE0(NT - 1), BASE1(NT - 1)); __syncthreads(); RESC(alB);
        finishSM(pB0, pB1, alB, l_reg, pa0, pa1, pa2, pa3); SBAR(); pv_tile<1, SK>(o, vb0, pa0, pa1, pa2, pa3, ACT(NT - 1)); }
    SBAR(); SEAM_K0();
    if (hi == 0) { li_l[r32] = l_reg; if (cur.ST) { cur.ST[(wid * QBLK + r32) * 16] = m_reg; cur.ST[(wid * QBLK + r32) * 16 + 1] = l_reg; } }
    asm volatile("s_waitcnt lgkmcnt(0)" ::: "memory");
    float rli[16];
#pragma unroll
    for (int r = 0; r < 16; ++r) { const float l_ = li_l[crow(r, hi)]; rli[r] = l_ > 0.f ? __builtin_amdgcn_rcpf(l_) : 0.f; }
    TOut* Ow = cur.O + (size_t)(wid * QBLK) * OPITCH;
#pragma unroll
    for (int r = 0; r < 16; ++r) { const int orow = crow(r, hi);
#pragma unroll
        for (int d0 = 0; d0 < 4; ++d0) { const float v = o[d0][r] * rli[r];
            if constexpr (same_t<TOut, float>::v) { Ow[(size_t)orow * OPITCH + d0 * 32 + r32] = v; }
            else { const float vn = __shfl_xor(v, 1);
                   if ((r32 & 1) == 0) *(unsigned*)(Ow + (size_t)orow * OPITCH + d0 * 32 + r32) = cvtpk(v, vn); } } }
    if constexpr (F32) {
#pragma unroll
        for (int d0 = 0; d0 < 8; ++d0) S.qr[d0] = pack8(S.tq[2 * d0], S.tq[2 * d0 + 1]); }
    __syncthreads();
#undef RESC
#undef KBASE
#undef ACT
#undef MASKT
#undef SEAM_K0
#undef HALF_STEP
}
#undef ROW
#undef VMW
#undef VMWN
#undef SLOAD_H
#undef SWRITE_HK
#undef SWRITE_HV
#undef SWRITE_H
#undef SLOAD_F
#undef SWRITE_KF
#undef SWRITE_VF

#undef BASE0
#undef BASE1
}
constexpr size_t WS_OSL = WS_XN, WS_OSU = WS_H;
constexpr size_t WS_STL = WS_WIN, WS_STU = WS_WIN + 1 * MiB;
constexpr int MOBA_SPLIT_QB = 9, MOBA_SPLIT_AT = 38;
__device__ __forceinline__ void phase_moba(KP P, char* lds, int vcu, int G) {
    typedef moba::BlockRef<moba::bf16, moba::bf16> BR;
    const moba::bf16* proj = (const moba::bf16*)(P.ws + WS_PROJ); moba::bf16* AR = (moba::bf16*)(P.ws + WS_AR); const float* kmean = (const float*)(P.ws + WS_KMEAN);
    constexpr int W = 1 << 30;
    auto mkref = [&](int bh, int qb, int part) -> BR { const int b = bh >> 3, h = bh & 7; BR r; const int nt = 4 * qb + 4;
        r.Q = proj + (size_t)(b * SEQ + qb * 256) * INCP + h * 128; r.K = proj + (size_t)(b * SEQ) * INCP + C_AK + h * 128; r.V = proj + (size_t)(b * SEQ) * INCP + C_AV + h * 128;
        moba::bf16* ob = part == 0 ? AR : (moba::bf16*)(P.ws + (part == 1 ? WS_OSL : WS_OSU));
        r.O = ob + (size_t)(b * SEQ + qb * 256) * DM + h * 128; r.P0 = qb * 256; r.KM = kmean + (size_t)(b * 16) * 1024 + h * 128; r.A = exp2f(-(float)(h + 1)) * (1.f / moba::SCALE);
        const int ks = qb == MOBA_SPLIT_QB ? nt - 4 : MOBA_SPLIT_AT;
        r.jlo = part == 2 ? ks : 0; r.jhi = part == 1 ? ks : nt;
        r.ST = part == 0 ? nullptr : (float*)(P.ws + (part == 1 ? WS_STL : WS_STU)) + ((size_t)(b * SEQ + qb * 256) * 8 + h) * 2;
        return r; };
    moba::Seam<moba::bf16> S;
    if (G == 256) {
        const int q_ = vcu & 15, bh = vcu >> 4;
        const int qbA[16] = { 1,  0,  7,  6,  5,  4,  3,  2, 15, 14, 13, 12, 11, 10,  9,  8};
        const int ptA[16] = { 0,  0,  0,  0,  0,  0,  0,  0,  1,  1,  1,  1,  1,  1,  1,  0};
        const int qbB[16] = {-1,  9, 10, 11, 12, 13, 14, 15, -1, -1, -1, -1, -1, -1, -1, -1};
        const int ptB[16] = { 0,  2,  2,  2,  2,  2,  2,  2,  0,  0,  0,  0,  0,  0,  0,  0};
        int qa = -1, pa = 0, qb2 = -1, pb = 0;
#pragma unroll
        for (int k = 0; k < 16; ++k) if (k == q_) { qa = qbA[k]; pa = ptA[k]; qb2 = qbB[k]; pb = ptB[k]; }
        for (int it = 0; it < 2; ++it) { const int qq = it == 0 ? qa : qb2, pp = it == 0 ? pa : pb; if (qq < 0) continue;
            const BR cur = mkref(bh, qq, pp);
            moba::causal_swa_prime<moba::bf16, moba::bf16>(cur, W, lds, S);
            moba::causal_swa_block<moba::bf16, moba::bf16>(cur, cur, SEQ, W, lds, S); }
    } else {
        for (int item = vcu; item < 256; item += G) {
            const BR cur = mkref(item >> 4, item & 15, 0);
            moba::causal_swa_prime<moba::bf16, moba::bf16>(cur, W, lds, S);
            moba::causal_swa_block<moba::bf16, moba::bf16>(cur, cur, SEQ, W, lds, S); }
    }
}
__device__ __forceinline__ void moba_combine(KP P, int vcu, int G) {
    if (G != 256) return;
    const int tid = ltid(); const bf16* OL = (const bf16*)(P.ws + WS_OSL); const bf16* OU = (const bf16*)(P.ws + WS_OSU); bf16* AR = (bf16*)(P.ws + WS_AR);
    const float* STL = (const float*)(P.ws + WS_STL); const float* STU = (const float*)(P.ws + WS_STU);
    constexpr int NSPL = 16 - MOBA_SPLIT_QB; constexpr float C2 = 1.4426950408889634f * moba::SCALE;
    for (int item = vcu; item < 16 * NSPL * 2; item += G) {
        const int half = item & 1, k = item >> 1, bh = k / NSPL, qb = MOBA_SPLIT_QB + k % NSPL, b = bh >> 3, h = bh & 7;
        const int row = b * SEQ + qb * 256 + half * 128 + (tid >> 2), c0 = (tid & 3) * 32;
        const size_t so = ((size_t)row * 8 + h) * 2; const float mL = STL[so], lL = STL[so + 1], mU = STU[so], lU = STU[so + 1];
        const float m = fmaxf(mL, mU); const float wL = lL * __builtin_amdgcn_exp2f((mL - m) * C2), wU = lU * __builtin_amdgcn_exp2f((mU - m) * C2); const float inv = __builtin_amdgcn_rcpf(wL + wU);
        const float aL = wL * inv, aU = wU * inv; const size_t o = (size_t)row * DM + h * 128 + c0;
        v4u l4[4], u4[4];
#pragma unroll
        for (int j = 0; j < 4; ++j) { l4[j] = *(const v4u*)(OL + o + 8 * j); u4[j] = *(const v4u*)(OU + o + 8 * j); }
#pragma unroll
        for (int j = 0; j < 4; ++j) { v4u r4;
#pragma unroll
            for (int e = 0; e < 4; ++e) r4[e] = pk2(aL * bflo(l4[j][e]) + aU * bflo(u4[j][e]), aL * bfhi(l4[j][e]) + aU * bfhi(u4[j][e]));
            *(v4u*)(AR + o + 8 * j) = r4; }
    }
}
constexpr size_t WS_SKB = WS_KMEAN + 256 * 1024;
__device__ __forceinline__ void prologue_subkeys(KP P, int vcu, int G) {
    unsigned* dst = (unsigned*)(P.ws + WS_SKB);
    for (int i = vcu * NTHR + ltid(); i < 8 * 2 * 128 * 128 / 2; i += G * NTHR) dst[i] = pk2(P.sub_keys[2 * i], P.sub_keys[2 * i + 1]);
}
__device__ __forceinline__ unsigned f2key(float v) { const unsigned u = __float_as_uint(v); return u ^ ((u >> 31) ? 0xFFFFFFFFu : 0x80000000u); }
__device__ __forceinline__ float key2f(unsigned k) { return __uint_as_float(k ^ ((k >> 31) ? 0x80000000u : 0xFFFFFFFFu)); }
__device__ __forceinline__ unsigned umax3(unsigned a, unsigned b, unsigned c) { return max(max(a, b), c); }
__device__ __forceinline__ void peer_route_tiles(KP P, LAS unsigned char* lds, int tt0, int nitems, int h) {
    const int tid = ltid(), lane = tid & 63, wave = __builtin_amdgcn_readfirstlane(tid >> 6), l15 = lane & 15, q4 = lane >> 4;
    const bf16* PQ = (const bf16*)(P.ws + WS_PROJ); const bf16* SKB = (const bf16*)(P.ws + WS_SKB);
    int* ridx = (int*)(P.ws + WS_PROJ + 64 * MiB); float* rgate = (float*)(P.ws + WS_PROJ + 68 * MiB);
    for (int it_ = 0; it_ < nitems; ++it_) {
        LAS float* sval = (LAS float*)(lds + it_ * 16384); LAS int* sidx = (LAS int*)(lds + it_ * 16384 + 8192);
        const int tt = tt0 + it_, p = wave & 1, sub = wave >> 1, tl = sub * 16 + l15;
        const bf16* qp = PQ + ((size_t)tt * 64 + tl) * DM + h * 256 + p * 128 + 8 * q4;
        bf16x8 qb[4];
#pragma unroll
        for (int kk = 0; kk < 4; ++kk) qb[kk] = *(const bf16x8*)(qp + 32 * kk);
        const bf16* sk = SKB + ((size_t)((h * 2 + p) * 128 + l15)) * 128 + 8 * q4;
        unsigned key[32];
#pragma unroll
        for (int nt = 0; nt < 8; ++nt) { f32x4v acc = {0.f, 0.f, 0.f, 0.f};
#pragma unroll
            for (int kk = 0; kk < 4; ++kk) acc = __builtin_amdgcn_mfma_f32_16x16x32_bf16(*(const bf16x8*)(sk + nt * 16 * 128 + 32 * kk), qb[kk], acc, 0, 0, 0);
#pragma unroll
            for (int e = 0; e < 4; ++e) key[4 * nt + e] = (f2key(acc[e]) & ~127u) | (unsigned)(127 - (16 * nt + 4 * q4 + e)); }
#define CE(a_, b_) { const unsigned hi_ = max(KA[a_], KA[b_]), lo_ = min(KA[a_], KA[b_]); KA[a_] = hi_; KA[b_] = lo_; }
#define SORT16_NET CE(0,1) CE(2,3) CE(0,2) CE(1,3) CE(1,2) CE(4,5) CE(6,7) CE(4,6) CE(5,7) CE(5,6) CE(0,4) CE(2,6) CE(2,4) CE(1,5) CE(3,7) CE(3,5) CE(1,2) CE(3,4) CE(5,6) CE(8,9) CE(10,11) CE(8,10) CE(9,11) CE(9,10) CE(12,13) CE(14,15) CE(12,14) CE(13,15) CE(13,14) CE(8,12) CE(10,14) CE(10,12) CE(9,13) CE(11,15) CE(11,13) CE(9,10) CE(11,12) CE(13,14) CE(0,8) CE(4,12) CE(4,8) CE(2,10) CE(6,14) CE(6,10) CE(2,4) CE(6,8) CE(10,12) CE(1,9) CE(5,13) CE(5,9) CE(3,11) CE(7,15) CE(7,11) CE(3,5) CE(7,9) CE(11,13) CE(1,2) CE(3,4) CE(5,6) CE(7,8) CE(9,10) CE(11,12) CE(13,14)
#define BMERGE16(T_) _Pragma("unroll") for (int d_ = 8; d_ >= 1; d_ >>= 1) { _Pragma("unroll") for (int i_ = 0; i_ < 16; ++i_) if ((i_ & d_) == 0) { const unsigned hi_ = max(T_[i_], T_[i_ + d_]), lo_ = min(T_[i_], T_[i_ + d_]); T_[i_] = hi_; T_[i_ + d_] = lo_; } }
#define KA key
        SORT16_NET
#undef KA
#define KA (key + 16)
        SORT16_NET
#undef KA
        unsigned t16[16];
#pragma unroll
        for (int i = 0; i < 16; ++i) t16[i] = max(key[i], key[31 - i]);
        BMERGE16(t16)
        { const bool odd = (lane & 16) != 0; unsigned L[16];
#pragma unroll
          for (int i = 0; i < 16; ++i) L[i] = odd ? t16[15 - i] : t16[i];
#pragma unroll
          for (int i = 0; i < 16; ++i) { auto x = __builtin_amdgcn_permlane16_swap(L[i], L[i], false, false); t16[i] = max(x[0], x[1]); }
          BMERGE16(t16) }
        { const bool odd = (lane & 32) != 0; unsigned L[16];
#pragma unroll
          for (int i = 0; i < 16; ++i) L[i] = odd ? t16[15 - i] : t16[i];
#pragma unroll
          for (int i = 0; i < 16; ++i) { auto x = __builtin_amdgcn_permlane32_swap(L[i], L[i], false, false); t16[i] = max(x[0], x[1]); }
          BMERGE16(t16) }
#undef CE
#undef SORT16_NET
#undef BMERGE16
        if (q4 == 0) {
#pragma unroll
            for (int r4 = 0; r4 < 4; ++r4) {
                *(LAS f32x4*)(sval + (tl * 2 + p) * 16 + 4 * r4) = (f32x4){key2f(t16[4 * r4] & ~127u), key2f(t16[4 * r4 + 1] & ~127u), key2f(t16[4 * r4 + 2] & ~127u), key2f(t16[4 * r4 + 3] & ~127u)};
                *(LAS v4u*)(sidx + (tl * 2 + p) * 16 + 4 * r4) = (v4u){127u - (t16[4 * r4] & 127u), 127u - (t16[4 * r4 + 1] & 127u), 127u - (t16[4 * r4 + 2] & 127u), 127u - (t16[4 * r4 + 3] & 127u)}; }
        }
    }
    __syncthreads();
    {
        const int it_ = wave; const int tt = tt0 + it_;
        LAS float* sval = (LAS float*)(lds + it_ * 16384); LAS int* sidx = (LAS int*)(lds + it_ * 16384 + 8192);
        if (wave < nitems) {
            const LAS float* av = sval + (lane * 2) * 16; const LAS float* bv = av + 16; const LAS int* ai = sidx + (lane * 2) * 16; const LAS int* bi = ai + 16;
            unsigned hk[16];
            const float b0 = bv[0];
#pragma unroll
            for (int i4 = 0; i4 < 4; ++i4) { const f32x4 t4 = *(const LAS f32x4*)(av + 4 * i4);
#pragma unroll
                for (int e = 0; e < 4; ++e) hk[4 * i4 + e] = (f2key(t4[e] + b0) & ~255u) | (unsigned)(255 - (4 * i4 + e) * 16); }
            float bestv[16]; int beste[16];
#pragma unroll
            for (int r = 0; r < 16; ++r) {
                unsigned m0 = umax3(hk[0], hk[1], hk[2]), m1 = umax3(hk[3], hk[4], hk[5]), m2 = umax3(hk[6], hk[7], hk[8]), m3 = umax3(hk[9], hk[10], hk[11]);
                m0 = umax3(m0, hk[12], hk[13]); m1 = umax3(m1, hk[14], hk[15]);
                const unsigned best = max(max(m0, m1), max(m2, m3));
                const int f = 255 - (int)(best & 255u), bi_ = f >> 4, bj = f & 15;
                const float a_i = av[bi_]; bestv[r] = a_i + bv[bj]; beste[r] = ai[bi_] * 128 + bi[bj];
                const int nj = bj + 1;
                const unsigned nk = nj < 16 ? ((f2key(a_i + bv[nj & 15]) & ~255u) | (unsigned)(255 - (bi_ * 16 + nj))) : 0u;
#pragma unroll
                for (int i = 0; i < 16; ++i) hk[i] = i == bi_ ? nk : hk[i];
            }
            float rsd; { const f32x4* sp = (const f32x4*)((const float*)(P.ws + WS_SSP) + ((size_t)tt * 64 + lane) * 32); float a = 0.f;
#pragma unroll
                for (int j = 0; j < 8; ++j) { const f32x4 v = sp[j]; a += (v.x + v.y) + (v.z + v.w); }
                rsd = 1.0f / sqrtf(a * (1.f / DM) + RMS_EPS); ((float*)(P.ws + WS_SSP + 2 * MiB))[(size_t)tt * 64 + lane] = rsd; }
            float se = 0.f; const float mx = bestv[0];
#pragma unroll
            for (int r = 0; r < 16; ++r) { bestv[r] = __expf((bestv[r] - mx) * rsd); se += bestv[r]; }
            const float ise = 1.f / se; const size_t o = ((size_t)tt * 64 + lane) * 128 + h * 16;
#pragma unroll
            for (int r4 = 0; r4 < 4; ++r4) { *(v4u*)(ridx + o + 4 * r4) = (v4u){(unsigned)beste[4 * r4], (unsigned)beste[4 * r4 + 1], (unsigned)beste[4 * r4 + 2], (unsigned)beste[4 * r4 + 3]};
                *(f32x4*)(rgate + o + 4 * r4) = (f32x4){bestv[4 * r4] * ise, bestv[4 * r4 + 1] * ise, bestv[4 * r4 + 2] * ise, bestv[4 * r4 + 3] * ise}; }
        }
        __syncthreads();
    }
}
#define XB_TMO      128
#define XB_XCNT(j)  (256  + 64 * (j))
#define XB_XSUB(j)  (1280 + 64 * (j))
#define XB_XGEN(j)  (2304 + 64 * (j))
#define XB_TOP      3328
#define XB_TOPGEN   3392
#define XCD_BAR_WORDS 3456
#define XB_SPIN_CAP (1u << 18)

__device__ __forceinline__ unsigned xb_ld(unsigned* p)              { return __hip_atomic_load(p, __ATOMIC_RELAXED, __HIP_MEMORY_SCOPE_AGENT); }
__device__ __forceinline__ unsigned xb_add(unsigned* p, unsigned v) { return __hip_atomic_fetch_add(p, v, __ATOMIC_RELAXED, __HIP_MEMORY_SCOPE_AGENT); }
__device__ __forceinline__ unsigned xb_xcc_id() { return (unsigned)__builtin_amdgcn_s_getreg((3 << 11) | 20) & 0xFu; }
#define XB_SPIN(cond, bar) do { unsigned _sp = 0; while (cond) { __builtin_amdgcn_s_sleep(1); \
    if ((++_sp & 255u) == 0u) { if (xb_ld(&(bar)[XB_TMO])) break; if (_sp > XB_SPIN_CAP) { atomicAdd(&(bar)[XB_TMO], 1u); break; } } } } while (0)

struct XcdBarrier {
    unsigned* bar; unsigned x;
    volatile LAS unsigned* st;
};

__device__ __forceinline__ XcdBarrier xcd_barrier_post(unsigned* bar, volatile LAS unsigned* st) {
    XcdBarrier b; b.bar = bar; b.x = xb_xcc_id(); b.st = st;
    if (threadIdx.x == 0) (void)xb_add(&bar[XB_XCNT(b.x)], 1u);
    return b;
}
__device__ __forceinline__ void xcd_barrier_complete(unsigned* bar, unsigned x, unsigned& nloc, unsigned& nx) {
    const unsigned G = gridDim.x * gridDim.y * gridDim.z;
    unsigned sum, cnt, mine, sp = 0u;
    for (;;) {
        sum = 0u; cnt = 0u; mine = 0u;
#pragma unroll
        for (unsigned j = 0; j < 16; ++j) { const unsigned c = xb_ld(&bar[XB_XCNT(j)]); sum += c; cnt += (c > 0u) ? 1u : 0u; mine = (j == x) ? c : mine; }
        if (sum == G) break;
        __builtin_amdgcn_s_sleep(1);
        if ((++sp & 255u) == 0u) { if (xb_ld(&bar[XB_TMO])) break; if (sp > XB_SPIN_CAP) { atomicAdd(&bar[XB_TMO], 1u); break; } }
    }
    nloc = mine > 0u ? mine : 1u; nx = cnt > 0u ? cnt : 1u;
}

__device__ __forceinline__ void xcd_barrier(const XcdBarrier& b) {
    asm volatile("s_waitcnt vmcnt(0)" ::: "memory");
    __syncthreads();
    if (threadIdx.x == 0) {
        unsigned* bar = b.bar;
        __builtin_amdgcn_s_waitcnt(0);
        unsigned nloc = b.st[0], nx = b.st[1];
        if (nloc == 0u) { xcd_barrier_complete(bar, b.x, nloc, nx); b.st[0] = nloc; b.st[1] = nx; }
        const unsigned old = xb_add(&bar[XB_XSUB(b.x)], 1u);
        const unsigned gen = old / nloc;
        if (old + 1u == (gen + 1u) * nloc) {
            __builtin_amdgcn_fence(__ATOMIC_RELEASE, "agent");
            asm volatile("s_waitcnt vmcnt(0)" ::: "memory");
            const unsigned og = xb_add(&bar[XB_TOP], 1u);
            const unsigned tg = og / nx;
            if (og + 1u == (tg + 1u) * nx) xb_add(&bar[XB_TOPGEN], 1u);
            else XB_SPIN(xb_ld(&bar[XB_TOPGEN]) == tg, bar);
            __builtin_amdgcn_fence(__ATOMIC_ACQUIRE, "agent");
            xb_add(&bar[XB_XGEN(b.x)], 1u);
            asm volatile("s_waitcnt vmcnt(0)" ::: "memory");
        } else {
            XB_SPIN(xb_ld(&bar[XB_XGEN(b.x)]) == gen, bar);
            __builtin_amdgcn_fence(__ATOMIC_ACQUIRE, "agent");
            asm volatile("s_waitcnt vmcnt(0)" ::: "memory");
        }
    }
    __syncthreads();
}
#ifndef MK_ONE_LAUNCH
#define MK_ONE_LAUNCH 1
#endif
constexpr int N_PHASES = 11;
__global__ void __launch_bounds__(NTHR, 2) mega(Params Pkernarg) {
    extern __shared__ __attribute__((aligned(16))) unsigned char lds_raw[];
    LAS unsigned char* lds = (LAS unsigned char*)lds_raw;
    const int tid = ltid();
    const int G = gridDim.x, bx = blockIdx.x; const int vcu = (G % 8 == 0) ? (bx % 8) * (G / 8) + bx / 8 : bx;
    for (int u = tid; u < (LDS_BYTES - LDSCTL_OFF) / 4; u += NTHR) ((LAS unsigned*)(lds + LDSCTL_OFF))[u] = 0u;
    __syncthreads();
#if MK_ONE_LAUNCH
    XcdBarrier bar = xcd_barrier_post((unsigned*)(params_ptr()->ws + WS_CTL) + CW_BAR + params_ptr()->bar_li * XCD_BAR_WORDS, (volatile LAS unsigned*)(lds + MISC_OFF) + 8);
#define GRID_BAR() xcd_barrier(bar)
#else
#define GRID_BAR() do {} while (0)
#endif
#ifndef PHOFF
#define PHOFF 0
#endif
#define IN(k) (!((PHOFF >> (k)) & 1))
#define BOTH(k) (IN(k) && IN((k) + 1))
    if (IN(0)) { KP P = *params_ptr(); phase_prologue(P, lds, vcu, G); prologue_subkeys(P, vcu, G); prologue_lora(P, vcu, G); if (BOTH(0)) GRID_BAR(); }
    if (IN(1)) { KP P = *params_ptr();
        pg8::Gemm g{(const bf16*)(P.ws + WS_XN), (const bf16*)(P.ws + WS_WIN), TT, INCP, DM}; pg8::Order1 S; S.init(TT, INCP, G, bx);
        pg8::EpiBf16<0> E{(bf16*)(P.ws + WS_PROJ), INCP, nullptr, 0, 0, 1.f};
        pg8::gemm_phase<pg8::EpiBf16<0>, pg8::Order1, true, true>(lds, g, S, E);
        phase_convert_tables(P, lds); phase_transpose_late(P, lds);
        if (BOTH(1)) GRID_BAR();
    }
    if (IN(2)) { KP P = *params_ptr(); phase_act(P, vcu, G); phase_kmean(P, lds, vcu, G); if (BOTH(2)) GRID_BAR(); }
    if (IN(3)) { KP P = *params_ptr(); phase_rwkv_stage_a(P, lds, vcu, G); if (BOTH(3)) GRID_BAR(); }
    if (IN(4)) { KP P = *params_ptr(); if ((vcu & 15) < 2 && vcu < 256) rwkv_stage_b(P, lds, (vcu >> 4) * 2 + (vcu & 15)); phase_moba(P, (char*)lds_raw, vcu, G); }
    if (IN(5)) { GRID_BAR(); KP P = *params_ptr(); moba_combine(P, vcu, G); GRID_BAR(); }
    if (IN(6)) { KP P = *params_ptr();
        pg8::Gemm g{(const bf16*)(P.ws + WS_AR), (const bf16*)(P.ws + WS_WOUT), TT, DM, DM}; pg8::StaticOrder S; S.init(TT, DM, G, bx);
        pg8::EpiH E{P.x, (bf16*)(P.ws + WS_XN), (float*)(P.ws + WS_SSP), DM};
        pg8::gemm_phase<pg8::EpiH, pg8::StaticOrder, true, true>(lds, g, S, E);
        if (BOTH(6)) GRID_BAR();
    }
    if (IN(8)) { KP P = *params_ptr();
        pg8::Gemm g{(const bf16*)(P.ws + WS_XN), (const bf16*)(P.ws + WS_WQ), TT, DM, DM}; pg8::StaticOrder S; S.init(TT, DM, G, bx);
        pg8::EpiBf16<0> E{(bf16*)(P.ws + WS_PROJ), DM, nullptr, 0, 0, 1.f};
        pg8::gemm_phase<pg8::EpiBf16<0>, pg8::StaticOrder, true, true>(lds, g, S, E);
        if (G == 256) { const int wg_ = (bx & 7) * 32 + (bx >> 3); pg8::Unit u; u.pm = (wg_ >> 6) * 8 + (wg_ & 7); u.pn = (wg_ & 63) >> 3;
            asm volatile("s_waitcnt vmcnt(0)" ::: "memory"); __syncthreads(); __builtin_amdgcn_fence(__ATOMIC_ACQUIRE, "agent"); asm volatile("s_waitcnt vmcnt(0)" ::: "memory");
            peer_route_tiles(P, lds, 4 * u.pm, 4, u.pn);
        } else if (G != 256) { GRID_BAR(); for (int item = vcu; item < 1024; item += G) peer_route_tiles(P, lds, item >> 3, 1, item & 7); }
        if (BOTH(8)) GRID_BAR();
    }
    if (IN(10)) { KP P = *params_ptr(); phase_peer_sliced(P, lds, bx, G); }
#undef IN
#undef BOTH
}

extern "C" void kernel_launch(void* const* d_in, const int* in_sizes, int n_in, void* d_out, int out_size, void* d_ws, size_t ws_size, hipStream_t stream) {
    static int grid = 0;
    if (grid == 0) {
        if (n_in != 21 || in_sizes[0] != TT * DM || out_size != TT * DM || ws_size < WS_END) {
            fprintf(stderr, "kernel_launch: unexpected shapes: n_in %d in0 %d out %d ws %zu\n", n_in, n_in > 0 ? in_sizes[0] : -1, out_size, ws_size); grid = -1; return; }
        int dev = 0, cus = 0;
        if (hipGetDevice(&dev) != hipSuccess || hipDeviceGetAttribute(&cus, hipDeviceAttributeMultiprocessorCount, dev) != hipSuccess) { grid = -1; return; }
        if (hipFuncSetAttribute((const void*)mega, hipFuncAttributeMaxDynamicSharedMemorySize, LDS_BYTES) != hipSuccess) { fprintf(stderr, "kernel_launch: hipFuncSetAttribute failed\n"); grid = -1; return; }
        int per_cu = 0;
        if (hipOccupancyMaxActiveBlocksPerMultiprocessor(&per_cu, (const void*)mega, NTHR, LDS_BYTES) != hipSuccess || per_cu < 1) fprintf(stderr, "kernel_launch: occupancy query says %d blocks per CU\n", per_cu);
        (void)hipGetLastError();
        grid = cus;
    }
    if (grid < 0) return;
    (void)hipMemsetAsync((char*)d_ws + WS_CTL, 0, CTL_ZERO_BYTES, stream);
    Params p{};
    p.x = (const float*)d_in[0]; p.norm1_g = (const float*)d_in[1]; p.w_in = (const float*)d_in[2]; p.mu = (const float*)d_in[3]; p.w0 = (const float*)d_in[4];
    p.w2 = (const float*)d_in[5]; p.a0 = (const float*)d_in[6]; p.a2 = (const float*)d_in[7]; p.g2 = (const float*)d_in[8]; p.k_k = (const float*)d_in[9];
    p.k_a = (const float*)d_in[10]; p.r_k = (const float*)d_in[11]; p.ln_g = (const float*)d_in[12]; p.ln_b = (const float*)d_in[13]; p.w_out = (const float*)d_in[14];
    p.norm2_g = (const float*)d_in[15]; p.wq = (const float*)d_in[16]; p.sub_keys = (const float*)d_in[17]; p.pu = (const float*)d_in[18]; p.pv = (const float*)d_in[19];
    p.final_g = (const float*)d_in[20]; p.out = (float*)d_out; p.ws = (unsigned char*)d_ws;
    p.ph_lo = 0; p.ph_hi = N_PHASES; p.bar_li = 0;
    hipLaunchKernelGGL(mega, dim3(grid), dim3(NTHR), LDS_BYTES, stream, p);
}
```

```cpp
#include <hip/hip_runtime.h>
#include <cstdio>
#include <cstdint>

__device__ __forceinline__ int ltid() { int t = threadIdx.x; asm volatile("" : "+v"(t)); return t; }
namespace pg8 {
#define PG8_LAS __attribute__((address_space(3)))
typedef unsigned short bf16_t;
typedef short bf16x8 __attribute__((ext_vector_type(8)));
typedef float f32x4 __attribute__((ext_vector_type(4)));
typedef unsigned u32x4 __attribute__((ext_vector_type(4)));
constexpr int BM = 256, BK = 64, HALF = 128, HTB = HALF * BK * 2  , STAGE_BYTES = 8 * HTB, NXCD = 8, WGM = 8;

__host__ __device__ __forceinline__ int lds_byte(int r, int c) { const int st = (r >> 4) * 2 + (c >> 5), rr = r & 15, cc = c & 31, ob = rr * 64 + cc * 2; return st * 1024 + (ob ^ (((ob >> 9) & 1) << 5)); }
__host__ __device__ __forceinline__ void stage_rc(int b, int& R, int& C) { const int st = b / 1024, sb = b % 1024, swz = sb ^ (((sb >> 9) & 1) << 5); R = (st >> 1) * 16 + swz / 64; C = (st & 1) * 32 + (swz % 64) / 2; }
__host__ __device__ __forceinline__ int perm32(int rho) { const int n = rho >> 4, i = rho & 15; return 8 * (i >> 2) + 4 * n + (i & 3); }

struct Unit { int pm, pn; };
struct Gemm { const bf16_t* A; const bf16_t* Bt; int M, N, K; };

struct StaticOrder {
    int nM, nN, nwg, G, c;
    __host__ __device__ void init(int M, int N, int G_, int c_) { nM = M / BM; nN = N / BM; nwg = nM * nN; G = G_; c = c_; }
    __host__ __device__ bool next(int i, Unit& u) const {
        const long L = (long)i * G + c; if (L >= nwg) return false;
        int wgid = (int)L; { const int q = nwg / NXCD, r = nwg % NXCD, xcd = wgid % NXCD, off = wgid / NXCD; wgid = (xcd < r ? xcd * (q + 1) : r * (q + 1) + (xcd - r) * q) + off; }
        const int nig = WGM * nN, gid = wgid / nig, fm = gid * WGM, gsz = (nM - fm) < WGM ? (nM - fm) : WGM;
        u.pm = fm + ((wgid % nig) % gsz); u.pn = (wgid % nig) / gsz; return true;
    }
    __device__ __forceinline__ void a_ready(const Unit&) const {}
    __device__ __forceinline__ void done(const Unit&) const {}
};

__device__ __forceinline__ unsigned cvt_pk_bf16(float lo, float hi) { unsigned r; asm volatile("v_cvt_pk_bf16_f32 %0, %1, %2" : "=v"(r) : "v"(lo), "v"(hi)); return r; }
typedef float f32x2 __attribute__((ext_vector_type(2)));
__device__ __forceinline__ f32x2 gelu_pk(f32x2 v) {
    const f32x2 av = __builtin_elementwise_abs(v), d = av * 0.2316418882f + 1.0f;
    f32x2 t; t.x = __builtin_amdgcn_rcpf(d.x); t.y = __builtin_amdgcn_rcpf(d.y);
    f32x2 q = t * 0.5307027145f + (-0.7265760135f); q = q * t + 0.7107068705f; q = q * t + (-0.142248368f); q = q * t + 0.127414796f; q = q * t;
    const f32x2 s = (v * v) * (-0.72134752044f);
    f32x2 e; e.x = __builtin_amdgcn_exp2f(s.x); e.y = __builtin_amdgcn_exp2f(s.y);
    const f32x2 m = v * (q * e), r = v - m;
    f32x2 o; o.x = v.x < 0.f ? m.x : r.x; o.y = v.y < 0.f ? m.y : r.y; return o;
}

template <int ACT  > struct EpiBf16 {
    static constexpr bool PERM = true, AFTER_DRAIN = false; static_assert(ACT == 0 || ACT == 1, "EpiBf16: ACT is 0 (none) or 1 (gelu_pk)");
    bf16_t* O; int ldc; const float* bias; int split_cols; size_t split_stride; float scale0;
    __device__ __forceinline__ void operator()(const f32x4 (&acc)[2][2][4][2], const Unit& u, int wr, int wc, int fr, int fq) const {
        const int row0 = u.pm * BM + wr * 64 + fr; int colt = u.pn * BM; bf16_t* base = O;
        float sc = 1.f; if (split_cols) { const int t = colt / split_cols; base += (size_t)t * split_stride; colt -= t * split_cols; if (t == 0) sc = scale0; }
        const int col0 = colt + wc * 32 + 8 * fq, bcol0 = u.pn * BM + wc * 32 + 8 * fq;
        f32x4 bv[2][2];
#pragma unroll
        for (int bj = 0; bj < 2; ++bj)
#pragma unroll
            for (int n = 0; n < 2; ++n) bv[bj][n] = bias ? *(const f32x4*)(bias + bcol0 + bj * HALF + 4 * n) : (f32x4){0.f, 0.f, 0.f, 0.f};
#pragma unroll
        for (int ai = 0; ai < 2; ++ai)
#pragma unroll
            for (int m = 0; m < 4; ++m) { bf16_t* rowp = base + (size_t)(row0 + ai * HALF + m * 16) * ldc + col0;
#pragma unroll
                for (int bj = 0; bj < 2; ++bj) { f32x4 v0 = acc[ai][bj][m][0] + bv[bj][0], v1 = acc[ai][bj][m][1] + bv[bj][1];
                    if (ACT == 1) { f32x2 a = gelu_pk((f32x2){v0[0], v0[1]}), b = gelu_pk((f32x2){v0[2], v0[3]}), c = gelu_pk((f32x2){v1[0], v1[1]}), d = gelu_pk((f32x2){v1[2], v1[3]});
                        v0 = (f32x4){a.x, a.y, b.x, b.y}; v1 = (f32x4){c.x, c.y, d.x, d.y}; }
                    v0 = v0 * sc; v1 = v1 * sc; u32x4 w; w.x = cvt_pk_bf16(v0[0], v0[1]); w.y = cvt_pk_bf16(v0[2], v0[3]); w.z = cvt_pk_bf16(v1[0], v1[1]); w.w = cvt_pk_bf16(v1[2], v1[3]);
                    *(u32x4*)(rowp + bj * HALF) = w; } }
    }
};
template <class Epi, class Sched, bool ALIGN_EPI = false, bool SP2 = false>
__device__ __forceinline__ void gemm_phase(PG8_LAS unsigned char* lds, const Gemm g, const Sched& S, const Epi& E) {
    const int tid = ltid(), wid = __builtin_amdgcn_readfirstlane(tid >> 6), lane = tid & 63, wr = wid >> 2, wc = wid & 3, fr = lane & 15, fq = lane >> 4;
    const int K = g.K, nt = K / BK;
    unsigned voffA[2], voffB[2];
#pragma unroll
    for (int i = 0; i < 2; ++i) { int R, C; stage_rc(tid * 16 + i * 8192, R, C); const int Rb = Epi::PERM ? ((R & ~31) + perm32(R & 31)) : R;
        voffA[i] = (unsigned)(R * K + C) * 2u; voffB[i] = (unsigned)(Rb * K + C) * 2u; }
    const size_t kstep = (size_t)(BK * 2);
    const size_t hstep = (size_t)HALF * K * 2;
    const size_t tstep = 2 * hstep;
    const unsigned ldsw = (unsigned)wid * 1024u;
    const int aoff = lds_byte(wr * 64 + fr, fq * 8), boff = lds_byte(wc * 32 + fr, fq * 8);
#define PG8_SA(b, h) (((b) * 2 + (h)) * HTB)
#define PG8_SB(b, h) ((4 + (b) * 2 + (h)) * HTB)
#define PG8_STAGE(bufoff, gbase, voff) do { _Pragma("unroll") for (int _i = 0; _i < 2; ++_i) \
        __builtin_amdgcn_global_load_lds((const unsigned*)((const char*)(gbase) + (voff)[_i]), (PG8_LAS unsigned*)(lds + (bufoff) + ldsw + _i * 8192), 16, 0, 0); } while (0)
#define PG8_LDA(dst, b, h) do { _Pragma("unroll") for (int m = 0; m < 4; ++m) _Pragma("unroll") for (int k = 0; k < 2; ++k) dst[m][k] = *(const PG8_LAS bf16x8*)(lds + PG8_SA(b, h) + aoff + m * 2048 + k * 1024); } while (0)
#define PG8_LDB(dst, b, h) do { _Pragma("unroll") for (int n = 0; n < 2; ++n) _Pragma("unroll") for (int k = 0; k < 2; ++k) dst[n][k] = *(const PG8_LAS bf16x8*)(lds + PG8_SB(b, h) + boff + n * 2048 + k * 1024); } while (0)
#define PG8_MMA(ai, bj, At, Bt) do { __builtin_amdgcn_s_setprio(1); _Pragma("unroll") for (int m = 0; m < 4; ++m) _Pragma("unroll") for (int n = 0; n < 2; ++n) _Pragma("unroll") for (int k = 0; k < 2; ++k) \
        acc[ai][bj][m][n] = __builtin_amdgcn_mfma_f32_16x16x32_bf16(Bt[n][k], At[m][k], acc[ai][bj][m][n], 0, 0, 0); __builtin_amdgcn_s_setprio(0); } while (0)
#define PG8_WAIT_V(n) asm volatile("s_waitcnt vmcnt(" #n ")" ::: "memory")
#define PG8_WAIT_L(n) asm volatile("s_waitcnt lgkmcnt(" #n ")" ::: "memory")
#define PG8_BAR __builtin_amdgcn_s_barrier()
#define PG8_SCHED __builtin_amdgcn_sched_barrier(0)
    Unit cur, nxt; int ui = 0;
    if (!S.next(0, cur)) return;
    f32x4 acc[2][2][4][2];
#pragma unroll
    for (int a = 0; a < 2; ++a)
#pragma unroll
        for (int b = 0; b < 2; ++b)
#pragma unroll
            for (int m = 0; m < 4; ++m)
#pragma unroll
                for (int n = 0; n < 2; ++n) acc[a][b][m][n] = (f32x4){0.f, 0.f, 0.f, 0.f};
    bf16x8 At[4][2], B0[2][2], B1[2][2];
    const char* cA = (const char*)g.A + (size_t)cur.pm * tstep; const char* cB = (const char*)g.Bt + (size_t)cur.pn * tstep;
    S.a_ready(cur);
    if constexpr (SP2) {
        PG8_STAGE(PG8_SB(0, 0), cB, voffB); PG8_STAGE(PG8_SB(0, 1), cB + hstep, voffB); PG8_STAGE(PG8_SA(0, 0), cA, voffA); PG8_STAGE(PG8_SA(0, 1), cA + hstep, voffA);
        if (wr == 1) PG8_BAR;
        PG8_WAIT_V(2); PG8_BAR;
        PG8_STAGE(PG8_SB(1, 0), cB + kstep, voffB); PG8_STAGE(PG8_SA(1, 0), cA + kstep, voffA); PG8_STAGE(PG8_SB(1, 1), cB + hstep + kstep, voffB);
        PG8_WAIT_V(6); PG8_BAR;
    } else {
        PG8_STAGE(PG8_SB(0, 0), cB, voffB); PG8_STAGE(PG8_SA(0, 0), cA, voffA); PG8_STAGE(PG8_SB(0, 1), cB + hstep, voffB); PG8_STAGE(PG8_SA(0, 1), cA + hstep, voffA);
        if (wr == 1) PG8_BAR;
        PG8_WAIT_V(4); PG8_BAR;
        PG8_STAGE(PG8_SB(1, 0), cB + kstep, voffB); PG8_STAGE(PG8_SA(1, 0), cA + kstep, voffA); PG8_STAGE(PG8_SB(1, 1), cB + hstep + kstep, voffB);
        PG8_WAIT_V(6); PG8_BAR;
    }
    for (;;) {
        const bool has_next = S.next(ui + 1, nxt);
        const char* nA = has_next ? (const char*)g.A + (size_t)nxt.pm * tstep : cA; const char* nB = has_next ? (const char*)g.Bt + (size_t)nxt.pn * tstep : cB;
        for (int t = 0; t < nt; t += 2) {
            const bool last = (t == nt - 2);
            const char* a1 = cA + (size_t)(t + 1) * kstep;
            const char* a2 = last ? nA : cA + (size_t)(t + 2) * kstep; const char* b2 = last ? nB : cB + (size_t)(t + 2) * kstep;
            const char* a3 = a2 + kstep; const char* b3 = b2 + kstep;
            if (last && has_next) S.a_ready(nxt);
            if constexpr (SP2) {
            PG8_LDB(B0, 0, 0); PG8_LDB(B1, 0, 1); PG8_SCHED; PG8_LDA(At, 0, 0); PG8_STAGE(PG8_SA(1, 1), a1 + hstep, voffA);
            PG8_WAIT_V(8); PG8_WAIT_L(0); PG8_BAR; PG8_MMA(0, 0, At, B0); PG8_MMA(0, 1, At, B1); PG8_BAR; PG8_SCHED;
            PG8_LDA(At, 0, 1); PG8_STAGE(PG8_SB(0, 0), b2, voffB); PG8_STAGE(PG8_SB(0, 1), b2 + hstep, voffB); PG8_STAGE(PG8_SA(0, 0), a2, voffA);
            PG8_WAIT_V(8); PG8_WAIT_L(0); PG8_BAR; PG8_MMA(1, 0, At, B0); PG8_MMA(1, 1, At, B1); PG8_BAR; PG8_SCHED;
            PG8_LDB(B0, 1, 0); PG8_LDB(B1, 1, 1); PG8_SCHED; PG8_LDA(At, 1, 0); PG8_STAGE(PG8_SA(0, 1), a2 + hstep, voffA);
            PG8_WAIT_V(8); PG8_WAIT_L(0); PG8_BAR; PG8_MMA(0, 0, At, B0); PG8_MMA(0, 1, At, B1); PG8_BAR; PG8_SCHED;
            PG8_LDA(At, 1, 1); PG8_STAGE(PG8_SB(1, 0), b3, voffB); PG8_STAGE(PG8_SB(1, 1), b3 + hstep, voffB); PG8_STAGE(PG8_SA(1, 0), a3, voffA);
            PG8_WAIT_V(8); PG8_WAIT_L(0); PG8_BAR; PG8_MMA(1, 0, At, B0); PG8_MMA(1, 1, At, B1); PG8_BAR; PG8_SCHED;
            } else {
            PG8_LDB(B0, 0, 0); PG8_SCHED; PG8_LDA(At, 0, 0); PG8_STAGE(PG8_SA(1, 1), a1 + hstep, voffA);
            PG8_WAIT_L(8); PG8_BAR; PG8_WAIT_L(0); PG8_MMA(0, 0, At, B0); PG8_BAR; PG8_SCHED;
            PG8_LDB(B1, 0, 1); PG8_STAGE(PG8_SB(0, 0), b2, voffB);
            PG8_BAR; PG8_WAIT_L(0); PG8_MMA(0, 1, At, B1); PG8_BAR;
            PG8_LDA(At, 0, 1); PG8_STAGE(PG8_SA(0, 0), a2, voffA);
            PG8_BAR; PG8_WAIT_L(0); PG8_MMA(1, 0, At, B0); PG8_BAR; PG8_SCHED;
            PG8_STAGE(PG8_SB(0, 1), b2 + hstep, voffB);
            PG8_WAIT_V(6); PG8_BAR; PG8_MMA(1, 1, At, B1); PG8_BAR;
            PG8_LDB(B0, 1, 0); PG8_SCHED; PG8_LDA(At, 1, 0); PG8_STAGE(PG8_SA(0, 1), a2 + hstep, voffA);
            PG8_WAIT_L(8); PG8_BAR; PG8_WAIT_L(0); PG8_MMA(0, 0, At, B0); PG8_BAR; PG8_SCHED;
            PG8_LDB(B1, 1, 1); PG8_STAGE(PG8_SB(1, 0), b3, voffB);
            PG8_BAR; PG8_WAIT_L(0); PG8_MMA(0, 1, At, B1); PG8_BAR;
            PG8_LDA(At, 1, 1); PG8_STAGE(PG8_SA(1, 0), a3, voffA);
            PG8_BAR; PG8_WAIT_L(0); PG8_MMA(1, 0, At, B0); PG8_BAR; PG8_SCHED;
            PG8_STAGE(PG8_SB(1, 1), b3 + hstep, voffB);
            PG8_WAIT_V(6); PG8_BAR; PG8_MMA(1, 1, At, B1); PG8_BAR;
            }
        }
        if constexpr (ALIGN_EPI) { if (wr == 0) PG8_BAR; }
        if constexpr (!Epi::AFTER_DRAIN) { E(acc, cur, wr, wc, fr, fq); S.done(cur); }
        if (!has_next) break;
#pragma unroll
        for (int a = 0; a < 2; ++a)
#pragma unroll
            for (int b = 0; b < 2; ++b)
#pragma unroll
                for (int m = 0; m < 4; ++m)
#pragma unroll
                    for (int n = 0; n < 2; ++n) acc[a][b][m][n] = (f32x4){0.f, 0.f, 0.f, 0.f};
        cur = nxt; cA = nA; cB = nB; ++ui;
        if constexpr (ALIGN_EPI) { if (wr == 1) PG8_BAR; }
    }
    PG8_WAIT_V(0);
    if constexpr (!ALIGN_EPI) { if (wr == 0) PG8_BAR; }
    PG8_BAR;
    if constexpr (Epi::AFTER_DRAIN) { E.fused(acc, cur, wr, wc, fr, fq, lds, wid, lane); S.done(cur); }
#undef PG8_SA
#undef PG8_SB
#undef PG8_STAGE
#undef PG8_LDA
#undef PG8_LDB
#undef PG8_MMA
#undef PG8_WAIT_V
#undef PG8_WAIT_L
#undef PG8_BAR
#undef PG8_SCHED
}
}
#define GAS __attribute__((address_space(1)))
#define LAS __attribute__((address_space(3)))
typedef unsigned short bf16;
typedef unsigned v4u __attribute__((ext_vector_type(4)));
typedef unsigned v2u __attribute__((ext_vector_type(2)));
typedef float f32x4 __attribute__((ext_vector_type(4)));
constexpr int NWAVES = 8, NTHR = 512;
constexpr int TT = 8192, DM = 2048, SEQ = 4096;
constexpr int INC = 6592, INCP = 6656;
constexpr int C_AK = 1024, C_AV = 2048, C_RW = 3072;
constexpr int RWC = 3520;
constexpr float RMS_EPS = 1e-6f;
constexpr size_t MiB = 1u << 20;
constexpr size_t WS_CTL = 0, CTL_ZERO_BYTES = 1 * MiB;
constexpr size_t WS_WIN = 1 * MiB;
constexpr size_t WS_WOUT = 27 * MiB;
constexpr size_t WS_WQ = 35 * MiB;
constexpr size_t WS_XN = 43 * MiB;
constexpr size_t WS_PROJ = 75 * MiB;
constexpr size_t WS_AR = 179 * MiB;
constexpr size_t WS_H = 211 * MiB;
constexpr size_t WS_RWA = 275 * MiB;
constexpr size_t WS_CHK = 339 * MiB;
constexpr size_t WS_KMEAN = 467 * MiB;
constexpr size_t WS_ACT = WS_H;
constexpr size_t WS_SSP = WS_WIN + 4 * MiB;
constexpr size_t WS_LORA = 468 * MiB;
constexpr size_t WS_END = 469 * MiB;
constexpr int CW_BAR = 4096, CW_MOBA_CTR = 16384, CW_SS = 32768;
constexpr int RING_BYTES = 147456, LDSCTL_OFF = RING_BYTES, MISC_OFF = LDSCTL_OFF + 320, LDS_BYTES = 163840;

struct Params {
    const float* x; const float* norm1_g; const float* w_in; const float* mu; const float* w0; const float* w2; const float* a0; const float* a2; const float* g2;
    const float* k_k; const float* k_a; const float* r_k; const float* ln_g; const float* ln_b; const float* w_out; const float* norm2_g; const float* wq;
    const float* sub_keys; const float* pu; const float* pv; const float* final_g;
    float* out; unsigned char* ws;
    int ph_lo, ph_hi, bar_li, pad;
};

typedef const __attribute__((address_space(4))) Params& KP;
__device__ __forceinline__ const __attribute__((address_space(4))) Params* params_ptr() {
    const __attribute__((address_space(4))) Params* ka = (const __attribute__((address_space(4))) Params*)__builtin_amdgcn_kernarg_segment_ptr(); asm volatile("" : "+s"(ka)); return ka; }
typedef float f32x2_t __attribute__((ext_vector_type(2))); typedef __bf16 bf16x2_t __attribute__((ext_vector_type(2)));
__device__ __forceinline__ unsigned pk2(float lo, float hi) { const f32x2_t v = {lo, hi}; const bf16x2_t b = __builtin_convertvector(v, bf16x2_t); return __builtin_bit_cast(unsigned, b); }
__device__ __forceinline__ unsigned f2bf(float f) { return pk2(f, 0.f) & 0xffffu; }
__device__ __forceinline__ float bf2f(bf16 v) { return __builtin_bit_cast(float, (unsigned)v << 16); }
__device__ __forceinline__ float bflo(unsigned u) { return __builtin_bit_cast(float, u << 16); }
__device__ __forceinline__ float bfhi(unsigned u) { return __builtin_bit_cast(float, u & 0xffff0000u); }
#define DPP_F(v, ctrl) __builtin_bit_cast(float, __builtin_amdgcn_update_dpp(0, __builtin_bit_cast(int, (v)), (ctrl), 0xf, 0xf, true))
__device__ __forceinline__ float wave_sum(float v) {
    v += DPP_F(v, 0xB1);
    v += DPP_F(v, 0x4E);
    v += DPP_F(v, 0x141);
    v += DPP_F(v, 0x140);
    const int b = __builtin_bit_cast(int, v);
    return (__builtin_bit_cast(float, __builtin_amdgcn_readlane(b, 0)) + __builtin_bit_cast(float, __builtin_amdgcn_readlane(b, 16))) +
           (__builtin_bit_cast(float, __builtin_amdgcn_readlane(b, 32)) + __builtin_bit_cast(float, __builtin_amdgcn_readlane(b, 48)));
}
__device__ __forceinline__ float wave_max(float v) {
#pragma unroll
    for (int o = 1; o < 64; o <<= 1) v = fmaxf(v, __shfl_xor(v, o));
    return v;
}
#define LDS_WAIT() asm volatile("s_waitcnt lgkmcnt(0)" ::: "memory")

__device__ __forceinline__ void p0_transpose_item(const float* W, int K, int N, bf16* WT, LAS float* scr, int item, int lane, const float* ksc = nullptr) {
    const int nblk = N / 32, kb = item / nblk, nb = item % nblk, k0 = 64 * kb, n0 = 32 * nb;
    float wv[32];
#pragma unroll
    for (int i = 0; i < 32; ++i) wv[i] = W[(size_t)(k0 + 2 * i + (lane >> 5)) * N + n0 + (lane & 31)];
#pragma unroll
    for (int i = 0; i < 32; ++i) { const int kk = 2 * i + (lane >> 5); scr[kk * 33 + (lane & 31)] = ksc ? wv[i] * ksc[k0 + kk] : wv[i]; }
    LDS_WAIT(); asm volatile("" ::: "memory");
    const int c = lane & 7;
#pragma unroll
    for (int j = 0; j < 4; ++j) { const int n = (lane >> 3) + 8 * j; const LAS float* s = scr + (8 * c) * 33 + n;
        v4u o; o.x = pk2(s[0 * 33], s[1 * 33]); o.y = pk2(s[2 * 33], s[3 * 33]); o.z = pk2(s[4 * 33], s[5 * 33]); o.w = pk2(s[6 * 33], s[7 * 33]);
        *(v4u*)(WT + (size_t)(n0 + n) * K + k0 + 8 * c) = o; }
    LDS_WAIT(); asm volatile("" ::: "memory");
}
__device__ __forceinline__ void rms_row_to_bf16(const float* xrow, const float* g, bf16* orow, int lane) {
    const f32x4* xr = (const f32x4*)xrow + lane;
    f32x4 v[8]; float s = 0.f;
#pragma unroll
    for (int j = 0; j < 8; ++j) { v[j] = xr[64 * j]; s += (v[j].x * v[j].x + v[j].y * v[j].y) + (v[j].z * v[j].z + v[j].w * v[j].w); }
    const float rs = 1.0f / sqrtf(wave_sum(s) * (1.f / DM) + RMS_EPS);
    v2u* o8 = (v2u*)orow + lane;
#pragma unroll
    for (int j = 0; j < 8; ++j) { const f32x4 gg = ((const f32x4*)g)[lane + 64 * j];
        v2u o; o.x = pk2(v[j].x * rs * gg.x, v[j].y * rs * gg.y); o.y = pk2(v[j].z * rs * gg.z, v[j].w * rs * gg.w); o8[64 * j] = o; }
}
__device__ __forceinline__ void phase_prologue(KP P, LAS unsigned char* lds, int vcu, int G) {
    const int tid = ltid(), lane = tid & 63, wave = tid >> 6;
    LAS float* scr = (LAS float*)(lds + wave * 16384);
    const int gw = vcu * NWAVES + wave, NGW = G * NWAVES;
    bf16* WIN = (bf16*)(P.ws + WS_WIN); bf16* XN = (bf16*)(P.ws + WS_XN);
    constexpr int I_IN = (DM / 64) * (INC / 32);
    for (int it = gw; it < I_IN; it += NGW) p0_transpose_item(P.w_in, DM, INC, WIN, scr, it, lane);
    for (int i = vcu * NTHR + tid; i < (INCP - INC) * DM / 8; i += G * NTHR) ((v4u*)(WIN + (size_t)INC * DM))[i] = (v4u){0u, 0u, 0u, 0u};
    for (int m = gw; m < TT; m += NGW) rms_row_to_bf16(P.x + (size_t)m * DM, P.norm1_g, XN + (size_t)m * DM, lane);
}
__device__ __forceinline__ void phase_transpose_late(KP P, LAS unsigned char* lds) {
    const int tid = ltid(), lane = tid & 63, wave = tid >> 6;
    constexpr int I_SQ = (DM / 64) * (DM / 32), NTK = 2 * I_SQ / NWAVES;
    unsigned* ctr = (unsigned*)(P.ws + WS_CTL) + CW_MOBA_CTR + 16; LAS int* slot = (LAS int*)(lds + 8 * 16384); LAS float* scr = (LAS float*)(lds + wave * 16384);
    __syncthreads();
    if (tid == 0) slot[0] = (int)__hip_atomic_fetch_add(ctr, 1u, __ATOMIC_RELAXED, __HIP_MEMORY_SCOPE_AGENT);
    __syncthreads();
    for (int it = 0;; ++it) {
        const int c = slot[it & 1]; if (c >= NTK) break;
        if (tid == 0) slot[(it & 1) ^ 1] = (int)__hip_atomic_fetch_add(ctr, 1u, __ATOMIC_RELAXED, __HIP_MEMORY_SCOPE_AGENT);
        const int r = c * NWAVES + wave;
        if (r < I_SQ) p0_transpose_item(P.w_out, DM, DM, (bf16*)(P.ws + WS_WOUT), scr, r, lane);
        else p0_transpose_item(P.wq, DM, DM, (bf16*)(P.ws + WS_WQ), scr, r - I_SQ, lane, P.norm2_g);
        __syncthreads();
    }
}

namespace pg8 {
struct EpiF32 {
    static constexpr bool PERM = false, AFTER_DRAIN = false;
    const float* base; float* out; int ldc;
    __device__ __forceinline__ void operator()(const f32x4 (&acc)[2][2][4][2], const Unit& u, int wr, int wc, int fr, int fq) const {
        const int col0 = u.pn * BM + wc * 32 + 4 * fq;
#pragma unroll
        for (int ai = 0; ai < 2; ++ai)
#pragma unroll
            for (int m = 0; m < 4; ++m) { const int r = ai * HALF + wr * 64 + m * 16 + fr; const size_t off = (size_t)(u.pm * BM + r) * ldc + col0;
#pragma unroll
                for (int bj = 0; bj < 2; ++bj)
#pragma unroll
                    for (int n = 0; n < 2; ++n) { f32x4 o = acc[ai][bj][m][n]; if (base) o = o + *(const f32x4*)(base + off + bj * HALF + n * 16);
                        *(f32x4*)(out + off + bj * HALF + n * 16) = o; } }
    }
};
struct EpiH {
    static constexpr bool PERM = false, AFTER_DRAIN = false;
    const float* base; bf16* outb; float* ss; int ldc;
    __device__ __forceinline__ void operator()(const f32x4 (&acc)[2][2][4][2], const Unit& u, int wr, int wc, int fr, int fq) const {
        const int col0 = u.pn * BM + wc * 32 + 4 * fq;
#pragma unroll
        for (int ai = 0; ai < 2; ++ai) {
            f32x4 xv[4][2][2];
#pragma unroll
            for (int m = 0; m < 4; ++m) { const size_t off = (size_t)(u.pm * BM + ai * HALF + wr * 64 + m * 16 + fr) * ldc + col0;
#pragma unroll
                for (int bj = 0; bj < 2; ++bj)
#pragma unroll
                    for (int n = 0; n < 2; ++n) xv[m][bj][n] = *(const f32x4*)(base + off + bj * HALF + n * 16); }
#pragma unroll
            for (int m = 0; m < 4; ++m) { const int r = ai * HALF + wr * 64 + m * 16 + fr; const size_t off = (size_t)(u.pm * BM + r) * ldc + col0; float sq = 0.f;
#pragma unroll
                for (int bj = 0; bj < 2; ++bj)
#pragma unroll
                    for (int n = 0; n < 2; ++n) { const f32x4 o = acc[ai][bj][m][n] + xv[m][bj][n];
                        *(v2u*)(outb + off + bj * HALF + n * 16) = (v2u){pk2(o.x, o.y), pk2(o.z, o.w)};
                        sq += (o.x * o.x + o.y * o.y) + (o.z * o.z + o.w * o.w); }
                sq += __shfl_xor(sq, 16); sq += __shfl_xor(sq, 32);
                if (fq == 0) ss[(size_t)(u.pm * BM + r) * 32 + u.pn * 4 + wc] = sq; }
        }
    }
};
struct Order1 {
    StaticOrder s; bool split; int c;
    __device__ void init(int M, int N, int G_, int c_) { s.init(M, N, G_, c_); split = (G_ == 256 && M == 8192 && N == 6656); c = c_; }
    __device__ bool next(int i, Unit& u) const {
        if (!split) return s.next(i, u);
        if (c >= 208 || i >= 4) return false;
        const int x = c & 7, j = c >> 3; u.pm = 4 * x + 2 * (i >> 1) + (j & 1); u.pn = 13 * (i & 1) + (j >> 1); return true; }
    __device__ __forceinline__ void a_ready(const Unit&) const {}
    __device__ __forceinline__ void done(const Unit&) const {}
};
}

__device__ __forceinline__ void phase_kmean(KP P, LAS unsigned char* lds, int vcu, int G) {
    const int tid = ltid(); const bf16* proj = (const bf16*)(P.ws + WS_PROJ); float* kmean = (float*)(P.ws + WS_KMEAN);
    LAS float* red = (LAS float*)lds;
    for (int item = vcu; item < 32 * 8; item += G) {
        const int bb = item >> 3, cg = item & 7;
        const int c = tid & 127, rq = tid >> 7;
        const bf16* p = proj + (size_t)(bb * 256 + rq * 64) * INCP + C_AK + cg * 128 + c;
        float s = 0.f;
        for (int r = 0; r < 64; ++r) s += bf2f(p[(size_t)r * INCP]);
        red[rq * 128 + c] = s;
        __syncthreads();
        if (tid < 128) kmean[(size_t)bb * 1024 + cg * 128 + tid] = (red[tid] + red[128 + tid] + red[256 + tid] + red[384 + tid]) * (1.f / 256.f);
        __syncthreads();
    }
}

typedef short bf16x8 __attribute__((ext_vector_type(8)));
typedef float f32x16 __attribute__((ext_vector_type(16)));
constexpr int CP = 72;
constexpr int MATB = 64 * CP * 2;
enum { M_AT = 0, M_BT = 1, M_KT = 2, M_RT = 3, M_VT = 4, M_BBT = 5, M_KBT = 6, M_LAK = 7, M_MRB = 8, M_MRK = 9, M_LAB = 10, M_AHT = 0, M_U0T = 1 };
constexpr int L_RHS = 11 * MATB;
constexpr int L_MISC = L_RHS + 32768;
constexpr int L_TB = L_MISC + 9 * 64 * 4;
constexpr int L_A_END = L_TB + 2048;
static_assert(L_A_END <= RING_BYTES, "stage A LDS");
constexpr size_t CHK_ITEM = 6 * 8192;

__device__ __forceinline__ f32x16 mm_tile(const LAS unsigned char* A, int ra, const LAS unsigned char* B, int rb, f32x16 acc, int lane, int k0 = 0, int k1 = 4) {
    const int r = lane & 31, hi = lane >> 5;
    const LAS unsigned char* ap = A + ((ra * 32 + r) * CP + 8 * hi) * 2; const LAS unsigned char* bp = B + ((rb * 32 + r) * CP + 8 * hi) * 2;
#pragma unroll
    for (int kk = 0; kk < 4; ++kk) if (kk >= k0 && kk < k1) {
        const bf16x8 a = *(const LAS bf16x8*)(ap + kk * 32), b = *(const LAS bf16x8*)(bp + kk * 32);
        acc = __builtin_amdgcn_mfma_f32_32x32x16_bf16(a, b, acc, 0, 0, 0); }
    return acc;
}
__device__ __forceinline__ int crow32(int reg, int hi) { return (reg & 3) + 8 * (reg >> 2) + 4 * hi; }

__device__ __forceinline__ void prologue_lora(KP P, int vcu, int G) {
    bf16* w2T = (bf16*)(P.ws + WS_LORA); bf16* a2T = w2T + 1024 * 96; bf16* g2T = a2T + 1024 * 96;
    for (int e0 = vcu * NTHR + ltid(); e0 < 448 * 1024; e0 += 4 * G * NTHR) { float v[4];
#pragma unroll
        for (int u = 0; u < 4; ++u) { const int e = e0 + u * G * NTHR, i = e >> 10; v[u] = 0.f;
            if (e < 448 * 1024) v[u] = i < 96 ? P.w2[e] : (i < 192 ? P.a2[e - 96 * 1024] : P.g2[e - 192 * 1024]); }
#pragma unroll
        for (int u = 0; u < 4; ++u) { const int e = e0 + u * G * NTHR, i = e >> 10, n = e & 1023;
            if (e < 448 * 1024) { if (i < 96) w2T[n * 96 + i] = (bf16)f2bf(v[u]); else if (i < 192) a2T[n * 96 + (i - 96)] = (bf16)f2bf(v[u]); else g2T[n * 256 + (i - 192)] = (bf16)f2bf(v[u]); } }
    }
}
__device__ __forceinline__ void phase_act(KP P, int vcu, int G) {
    const bf16* proj = (const bf16*)(P.ws + WS_PROJ); unsigned* act = (unsigned*)(P.ws + WS_ACT);
    for (int e0 = vcu * NTHR + ltid(); e0 < TT * 224; e0 += 4 * G * NTHR) {
        unsigned cu[4], pu[4]; float m0[4], m1[4];
#pragma unroll
        for (int u = 0; u < 4; ++u) { const int e = e0 + u * G * NTHR; cu[u] = 0u; pu[u] = 0u; m0[u] = 0.f; m1[u] = 0.f;
            if (e < TT * 224) { const int t = e / 224, cc = 2 * (e - t * 224); const bf16* pr = proj + (size_t)t * INCP + C_RW + 3072 + cc;
                cu[u] = *(const unsigned*)pr; pu[u] = (t & (SEQ - 1)) == 0 ? 0u : *(const unsigned*)(pr - INCP); m0[u] = P.mu[3072 + cc]; m1[u] = P.mu[3072 + cc + 1]; } }
#pragma unroll
        for (int u = 0; u < 4; ++u) { const int e = e0 + u * G * NTHR;
            if (e < TT * 224) { const int t = e / 224, cc = 2 * (e - t * 224);
                float v0 = bflo(cu[u]) + (bflo(pu[u]) - bflo(cu[u])) * m0[u], v1 = bfhi(cu[u]) + (bfhi(pu[u]) - bfhi(cu[u])) * m1[u];
                if (cc < 96) { v0 = tanhf(v0); v1 = tanhf(v1); } else if (cc >= 192) { v0 = 1.f / (1.f + __expf(-v0)); v1 = 1.f / (1.f + __expf(-v1)); }
                act[e] = pk2(v0, v1); } }
    }
}
constexpr int ACTP = 456;
constexpr int L_WAG = 58368;
static_assert(L_WAG + 3 * 16384 <= L_MISC, "lora scratch fits below misc");
struct LoraFrags { bf16x8 f[16]; f32x4 w0[4], a0[4]; float mu_r, mu_k, mu_v, kkc, kac, rkc, lng, lnb; };
__device__ __forceinline__ LoraFrags lora_frags_load(KP P, int h, int wave, int lane) {
    const int c32 = lane & 31, hi = lane >> 5, nb = (wave & 3) >> 1; const int nrow = h * 64 + nb * 32 + c32;
    const bf16* w2T = (const bf16*)(P.ws + WS_LORA); const bf16* a2T = w2T + 1024 * 96; const bf16* g2T = a2T + 1024 * 96;
    const bf16* wp = w2T + (size_t)nrow * 96 + 8 * hi; const bf16* ap = a2T + (size_t)nrow * 96 + 8 * hi; const bf16* gp = g2T + (size_t)nrow * 256 + 8 * hi;
    LoraFrags W;
#pragma unroll
    for (int kk = 0; kk < 16; ++kk) { const bf16* src = wave < 4 ? (kk < 6 ? wp + 16 * kk : ap + 16 * ((kk - 6) % 6)) : gp + 16 * kk; W.f[kk] = *(const bf16x8*)src; }
#pragma unroll
    for (int g = 0; g < 4; ++g) { const int n0 = h * 64 + nb * 32 + 8 * g + 4 * hi; W.w0[g] = *(const f32x4*)(P.w0 + n0); W.a0[g] = *(const f32x4*)(P.a0 + n0); }
    const int col = h * 64 + lane;
    W.mu_r = P.mu[col]; W.mu_k = P.mu[1024 + col]; W.mu_v = P.mu[2048 + col]; W.kkc = P.k_k[col]; W.kac = P.k_a[col]; W.rkc = P.r_k[col]; W.lng = P.ln_g[col]; W.lnb = P.ln_b[col];
    return W;
}
__device__ __forceinline__ void rwkv_stage_a(KP P, LAS unsigned char* lds, int item, const LoraFrags& W) {
    const int tid = ltid(), lane = tid & 63, wave = __builtin_amdgcn_readfirstlane(tid >> 6);
    const int b = item >> 10, h = (item >> 6) & 15, c = item & 63;
    const int tok0 = b * SEQ + c * 64;
    const bf16* proj = (const bf16*)(P.ws + WS_PROJ);
    unsigned char* chk = P.ws + WS_CHK + (size_t)((item & 63) * 32 + (item >> 6)) * CHK_ITEM;
    LAS float* misc = (LAS float*)(lds + L_MISC);
    { const bf16* actg = (const bf16*)(P.ws + WS_ACT) + (size_t)tok0 * 448;
#pragma unroll
      for (int e = tid; e < 64 * 56; e += NTHR) { const int row = e / 56, ch = e - row * 56; *(LAS v4u*)(lds + (row * ACTP + ch * 8) * 2) = *(const v4u*)(actg + (size_t)row * 448 + ch * 8); } }
    __syncthreads();
    {
        const int c32 = lane & 31, hi = lane >> 5, qd = wave & 3, nb = qd >> 1, tb = qd & 1;
        const LAS unsigned char* actp = lds + ((tb * 32 + c32) * ACTP + 8 * hi) * 2;
        LAS float* wag = (LAS float*)(lds + L_WAG) + (tb * 32 + c32) * 64 + nb * 32;
        if (wave < 4) {
            f32x16 aw = {}, aa = {};
#pragma unroll
            for (int kk = 0; kk < 6; ++kk) {
                aw = __builtin_amdgcn_mfma_f32_32x32x16_bf16(W.f[kk], *(const LAS bf16x8*)(actp + (16 * kk) * 2), aw, 0, 0, 0);
                aa = __builtin_amdgcn_mfma_f32_32x32x16_bf16(W.f[6 + kk], *(const LAS bf16x8*)(actp + (96 + 16 * kk) * 2), aa, 0, 0, 0); }
#pragma unroll
            for (int g = 0; g < 4; ++g) { const int n0 = h * 64 + nb * 32 + 8 * g + 4 * hi;
                const f32x4 w0 = W.w0[g], a0 = W.a0[g]; f32x4 ow, oa;
#pragma unroll
                for (int e = 0; e < 4; ++e) { const float xx = w0[e] + aw[4 * g + e];
                    ow[e] = __expf(-0.6065306597126334f * __builtin_amdgcn_rcpf(1.f + __expf(-xx))); oa[e] = __builtin_amdgcn_rcpf(1.f + __expf(-(a0[e] + aa[4 * g + e]))); }
                *(LAS f32x4*)(wag + 8 * g + 4 * hi) = ow; *(LAS f32x4*)(wag + 4096 + 8 * g + 4 * hi) = oa; }
        } else {
            f32x16 ag = {};
#pragma unroll
            for (int kk = 0; kk < 16; ++kk) ag = __builtin_amdgcn_mfma_f32_32x32x16_bf16(W.f[kk], *(const LAS bf16x8*)(actp + (192 + 16 * kk) * 2), ag, 0, 0, 0);
#pragma unroll
            for (int g = 0; g < 4; ++g) *(LAS f32x4*)(wag + 8192 + 8 * g + 4 * hi) = (f32x4){ag[4 * g], ag[4 * g + 1], ag[4 * g + 2], ag[4 * g + 3]};
        }
    }
    __syncthreads();
    {
        const int n = lane, tg = wave, col = h * 64 + n;
        const float mu_r = W.mu_r, mu_k = W.mu_k, mu_v = W.mu_v, kkc = W.kkc, kac = W.kac, rkc = W.rkc, lng = W.lng, lnb = W.lnb;
        float rr[8], kr[8], vv[8], ww[8], aa[8], gg[8], kk[8];
        const int tfirst = tok0 + 8 * tg;
        const bf16* pp = proj + (size_t)tfirst * INCP + C_RW + col;
        float pr, pk, pvv;
        if (c == 0 && tg == 0) { pr = 0.f; pk = 0.f; pvv = 0.f; } else { pr = bf2f(pp[-(long)INCP]); pk = bf2f(pp[-(long)INCP + 1024]); pvv = bf2f(pp[-(long)INCP + 2048]); }
        const LAS float* wagr = (const LAS float*)(lds + L_WAG) + (8 * tg) * 64 + n;
#pragma unroll
        for (int q = 0; q < 8; ++q) { const float cr = bf2f(pp[(size_t)q * INCP]), ck = bf2f(pp[(size_t)q * INCP + 1024]), cv = bf2f(pp[(size_t)q * INCP + 2048]);
            rr[q] = cr + (pr - cr) * mu_r; kr[q] = ck + (pk - ck) * mu_k; vv[q] = cv + (pvv - cv) * mu_v; pr = cr; pk = ck; pvv = cv;
            ww[q] = wagr[q * 64]; aa[q] = wagr[4096 + q * 64]; gg[q] = wagr[8192 + q * 64]; }
        float lam[8]; float run = 1.f;
#pragma unroll
        for (int q = 0; q < 8; ++q) { run *= ww[q]; lam[q] = run; }
        misc[tg * 64 + n] = run;
#pragma unroll
        for (int q = 0; q < 8; ++q) { const float kkv = kr[q] * kkc; const float ss = wave_sum(kkv * kkv); kk[q] = kkv * __builtin_amdgcn_rsqf(fmaxf(ss, 1e-24f));
            kr[q] = kr[q] * (1.f + (aa[q] - 1.f) * kac); }
        __syncthreads();
        float pre = 1.f, tot = 1.f;
#pragma unroll
        for (int g = 0; g < 8; ++g) { const float sgt = misc[g * 64 + n]; if (g < tg) pre *= sgt; tot *= sgt; }
        if (tg == 0) misc[512 + n] = tot;
        unsigned vt[4], bbt[4], kbt[4];
        LAS bf16* At = (LAS bf16*)(lds + M_AT * MATB); LAS bf16* Bt = (LAS bf16*)(lds + M_BT * MATB); LAS bf16* Kt = (LAS bf16*)(lds + M_KT * MATB); LAS bf16* Rt = (LAS bf16*)(lds + M_RT * MATB);
        float hbb = 0.f, hkb = 0.f, hv = 0.f;
#pragma unroll
        for (int q = 0; q < 8; ++q) { const int t = 8 * tg + q;
            const float L = pre * lam[q], Lp = q == 0 ? pre : pre * lam[q - 1], iL = __builtin_amdgcn_rcpf(L), rel = tot * iL;
            const float bq = kk[q] * aa[q];
            ((LAS float*)(lds + L_RHS))[t * 128 + 64 + n] = -kk[q] * Lp;
            At[t * CP + n] = (bf16)f2bf(-kk[q] * Lp); Bt[t * CP + n] = (bf16)f2bf(bq * iL); Kt[t * CP + n] = (bf16)f2bf(kr[q] * iL); Rt[t * CP + n] = (bf16)f2bf(rr[q] * L);
            const float bb = bq * rel, kb = kr[q] * rel;
            if (q & 1) { vt[q >> 1] = pk2(hv, vv[q]); bbt[q >> 1] = pk2(hbb, bb); kbt[q >> 1] = pk2(hkb, kb); } else { hv = vv[q]; hbb = bb; hkb = kb; }
            const float bs = wave_sum(rr[q] * kr[q] * rkc);
            const int pl = (((t >> 4) * 2 + (n >> 5)) * 64 + (t & 15) * 4 + ((n >> 2) & 3)) * 8 + ((n >> 4) & 1) * 4 + (n & 3);
            ((bf16*)(chk + 4 * 8192))[pl] = (bf16)f2bf(lng * gg[q]);
            ((bf16*)(chk + 5 * 8192))[pl] = (bf16)f2bf((lnb + bs * vv[q]) * gg[q]); }
        *(LAS v4u*)(lds + M_VT * MATB + (n * CP + 8 * tg) * 2) = (v4u){vt[0], vt[1], vt[2], vt[3]};
        *(LAS v4u*)(lds + M_BBT * MATB + (n * CP + 8 * tg) * 2) = (v4u){bbt[0], bbt[1], bbt[2], bbt[3]};
        *(LAS v4u*)(lds + M_KBT * MATB + (n * CP + 8 * tg) * 2) = (v4u){kbt[0], kbt[1], kbt[2], kbt[3]};
    }
    __syncthreads();
    const int c32 = lane & 31, hi = lane >> 5;
    {
        const int prod = wave >> 1;
#pragma unroll
        for (int qi = 0; qi < 2; ++qi) {
            const int tb = (wave & 1) ? (qi == 0 ? 1 : 0) : qi, sb = (wave & 1) ? 1 : 0; const bool zero = (tb == 0 && sb == 1);
            f32x16 acc = {};
            const int xa = (prod == 0 || prod == 2) ? M_BT : M_KT, ya = prod < 2 ? M_AT : M_RT, dm = prod == 0 ? M_LAB : (prod == 1 ? M_LAK : (prod == 2 ? M_MRB : M_MRK));
            if (!zero) acc = mm_tile(lds + xa * MATB, sb, lds + ya * MATB, tb, acc, lane);
            const int t = tb * 32 + c32; LAS unsigned char* dst = lds + dm * MATB + (t * CP + sb * 32) * 2;
#pragma unroll
            for (int g = 0; g < 4; ++g) { float o[4];
#pragma unroll
                for (int e = 0; e < 4; ++e) { const int s = sb * 32 + 8 * g + 4 * hi + e; const bool keep = prod < 2 ? (s < t) : (s <= t); o[e] = keep ? acc[4 * g + e] : 0.f; }
                *(LAS v2u*)(dst + (8 * g + 4 * hi) * 2) = (v2u){pk2(o[0], o[1]), pk2(o[2], o[3])}; }
        }
    }
    __syncthreads();
    if (wave < 4) {
        const int ib = wave >> 1, tb = wave & 1; f32x16 acc = {};
        acc = mm_tile(lds + M_VT * MATB, ib, lds + M_LAK * MATB, tb, acc, lane, 0, tb == 0 ? 2 : 4);
        const int t = tb * 32 + c32; LAS float* dst = (LAS float*)(lds + L_RHS) + t * 128 + ib * 32;
#pragma unroll
        for (int g = 0; g < 4; ++g) *(LAS f32x4*)(dst + 8 * g + 4 * hi) = (f32x4){acc[4 * g], acc[4 * g + 1], acc[4 * g + 2], acc[4 * g + 3]};
    } else if (wave == 4) {
        const int bb = lane >> 4, col = lane & 15;
        float x[16];
#pragma unroll
        for (int t = 0; t < 16; ++t) x[t] = t == col ? 1.f : 0.f;
#pragma unroll
        for (int t = 1; t < 16; ++t) { const LAS unsigned char* rp = lds + M_LAB * MATB + ((16 * bb + t) * CP + 16 * bb) * 2; const v4u ra = *(const LAS v4u*)rp, rb = *(const LAS v4u*)(rp + 16);
            float lrow[16];
#pragma unroll
            for (int q = 0; q < 4; ++q) { lrow[2 * q] = bflo(ra[q]); lrow[2 * q + 1] = bfhi(ra[q]); lrow[8 + 2 * q] = bflo(rb[q]); lrow[8 + 2 * q + 1] = bfhi(rb[q]); }
#pragma unroll
            for (int s = 0; s < t; ++s) x[t] += lrow[s] * x[s]; }
        LAS bf16* T = (LAS bf16*)(lds + L_TB) + bb * 256 + col;
#pragma unroll
        for (int t = 0; t < 16; ++t) T[t * 16] = (bf16)f2bf(x[t]);
    }
    __syncthreads();
    {
        typedef short s16x4 __attribute__((ext_vector_type(4)));
        const int l15 = lane & 15, q4 = lane >> 4;
        LAS unsigned char* xt = lds + (wave < 4 ? M_U0T : M_AHT) * MATB + ((16 * (wave & 3) + l15) * CP) * 2;
        *(LAS v4u*)(xt + q4 * 32) = (v4u){0u, 0u, 0u, 0u}; *(LAS v4u*)(xt + q4 * 32 + 16) = (v4u){0u, 0u, 0u, 0u};
        const LAS float* Xf = (const LAS float*)(lds + L_RHS) + 16 * wave + l15;
#pragma unroll
        for (int bq = 0; bq < 4; ++bq) {
            f32x4 acc;
#pragma unroll
            for (int e = 0; e < 4; ++e) acc[e] = Xf[(16 * bq + 4 * q4 + e) * 128];
#pragma unroll
            for (int kk = 0; kk < (bq + 1) / 2; ++kk) {
                const bf16x8 a = *(const LAS bf16x8*)(lds + M_LAB * MATB + ((16 * bq + l15) * CP + 32 * kk + 8 * q4) * 2);
                const bf16x8 xb = *(const LAS bf16x8*)(xt + (32 * kk + 8 * q4) * 2);
                acc = __builtin_amdgcn_mfma_f32_16x16x32_bf16(a, xb, acc, 0, 0, 0); }
            const v2u tf = *(const LAS v2u*)(lds + L_TB + (bq * 256 + l15 * 16 + 4 * q4) * 2);
            const v2u ab = (v2u){pk2(acc[0], acc[1]), pk2(acc[2], acc[3])};
            const f32x4 z = {0.f, 0.f, 0.f, 0.f};
            const f32x4 xn = __builtin_amdgcn_mfma_f32_16x16x16bf16_1k(__builtin_bit_cast(s16x4, tf), __builtin_bit_cast(s16x4, ab), z, 0, 0, 0);
            *(LAS v2u*)(xt + (16 * bq + 4 * q4) * 2) = (v2u){pk2(xn[0], xn[1]), pk2(xn[2], xn[3])};
        }
    }
    __syncthreads();
    {
        const int qd = wave & 3, yb = qd >> 1, xb = qd & 1;
        f32x16 acc1 = {}, acc2 = {};
        if (wave < 4) {
            acc1 = mm_tile(lds + M_AHT * MATB, yb, lds + M_BBT * MATB, xb, acc1, lane);
            acc2 = mm_tile(lds + M_BBT * MATB, yb, lds + M_U0T * MATB, xb, acc2, lane);
            acc2 = mm_tile(lds + M_KBT * MATB, yb, lds + M_VT * MATB, xb, acc2, lane);
            const int x = xb * 32 + c32; const float lc = misc[512 + x];
            bf16* o1 = (bf16*)(chk + 0 * 8192) + (((x >> 4) * 2 + yb) * 64 + (x & 15)) * 8 + 4 * hi; bf16* o2 = (bf16*)(chk + 1 * 8192) + ((2 * yb * 4 + (x >> 4)) * 64 + (x & 15)) * 4;
#pragma unroll
            for (int g = 0; g < 4; ++g) { float p[4];
#pragma unroll
                for (int e = 0; e < 4; ++e) { const int y = yb * 32 + 8 * g + 4 * hi + e; p[e] = acc1[4 * g + e] + (y == x ? lc : 0.f); }
                *(v2u*)(o1 + 16 * g * 8) = (v2u){pk2(p[0], p[1]), pk2(p[2], p[3])};
                *(v2u*)(o2 + ((g >> 1) * 4 * 64 + 16 * ((2 * g + hi) & 3)) * 4) = (v2u){pk2(acc2[4 * g], acc2[4 * g + 1]), pk2(acc2[4 * g + 2], acc2[4 * g + 3])}; }
        } else {
            acc1 = mm_tile(lds + M_AHT * MATB, yb, lds + M_MRB * MATB, xb, acc1, lane);
            acc2 = mm_tile(lds + M_U0T * MATB, yb, lds + M_MRB * MATB, xb, acc2, lane);
            acc2 = mm_tile(lds + M_VT * MATB, yb, lds + M_MRK * MATB, xb, acc2, lane);
            const int x = xb * 32 + c32;
            bf16* o1 = (bf16*)(chk + 2 * 8192) + (((x >> 4) * 2 + yb) * 64 + (x & 15)) * 8 + 4 * hi; bf16* o2 = (bf16*)(chk + 3 * 8192) + (((x >> 4) * 2 + yb) * 64 + (x & 15)) * 8;
            const LAS bf16* Rt = (const LAS bf16*)(lds + M_RT * MATB) + x * CP + yb * 32;
#pragma unroll
            for (int g = 0; g < 4; ++g) { float p[4];
#pragma unroll
                for (int e = 0; e < 4; ++e) p[e] = acc1[4 * g + e] + bf2f(Rt[8 * g + 4 * hi + e]);
                *(v2u*)(o1 + 16 * g * 8) = (v2u){pk2(p[0], p[1]), pk2(p[2], p[3])};
                *(v2u*)(o2 + 16 * ((2 * g + hi) & 3) * 8 + (g >> 1) * 4) = (v2u){pk2(acc2[4 * g], acc2[4 * g + 1]), pk2(acc2[4 * g + 2], acc2[4 * g + 3])}; }
        }
    }
    __syncthreads();
}

__device__ __forceinline__ void phase_rwkv_stage_a(KP P, LAS unsigned char* lds, int vcu, int G) {
    const int tid = ltid(), lane = tid & 63, wave = __builtin_amdgcn_readfirstlane(tid >> 6);
    int cur_bh = (vcu & 255) >> 3; LoraFrags W = lora_frags_load(P, cur_bh & 15, wave, lane);
    for (int k = vcu; k < 2048; k += G) { const int bh = (k & 255) >> 3, c = (k & 7) + 8 * (k >> 8);
        if (bh != cur_bh) { W = lora_frags_load(P, bh & 15, wave, lane); cur_bh = bh; }
        rwkv_stage_a(P, lds, bh * 64 + c, W); }
}
typedef float f32x4v __attribute__((ext_vector_type(4)));
struct YSet { bf16x8 b0, b1; v4u y0[2], g1[2], g2[2]; };
struct SSet { bf16x8 p0[1], p1[1]; v2u q[4]; };
__device__ __forceinline__ void rwkv_stage_b(KP P, LAS unsigned char* lds, int bh) {
    const int tid = ltid(), lane = tid & 63, wave = __builtin_amdgcn_readfirstlane(tid >> 6);
    const int b = bh >> 4, h = bh & 15; const int l15 = lane & 15, q4 = lane >> 4;
    bf16* AR = (bf16*)(P.ws + WS_AR);
    for (int u = tid; u < 2 * MATB / 4; u += NTHR) ((LAS unsigned*)lds)[u] = 0u;
    __syncthreads();
    const int w4 = wave & 3;
    const unsigned char* chk0 = P.ws + WS_CHK + (size_t)bh * CHK_ITEM;
    if (wave < 4) {
        const int t = 16 * w4 + l15;
        YSet ys[4];
#define YLOAD(S_, c_) do { const unsigned char* chk = chk0 + (size_t)(c_) * (32 * CHK_ITEM); const bf16* rh = (const bf16*)(chk + 2 * 8192) + (w4 * 128 + lane) * 8; S_.b0 = *(const bf16x8*)rh; S_.b1 = *(const bf16x8*)(rh + 512); \
        const bf16* y0 = (const bf16*)(chk + 3 * 8192) + (w4 * 128 + lane) * 8; const bf16* g1 = (const bf16*)(chk + 4 * 8192) + (w4 * 128 + l15 * 4 + q4) * 8; \
        S_.y0[0] = *(const v4u*)y0; S_.y0[1] = *(const v4u*)(y0 + 512); S_.g1[0] = *(const v4u*)g1; S_.g1[1] = *(const v4u*)(g1 + 512); S_.g2[0] = *(const v4u*)(g1 + 4096); S_.g2[1] = *(const v4u*)(g1 + 4096 + 512); } while (0)
#define YV(A_, it_, w_) ((A_)[(it_) >> 1][2 * ((it_) & 1) + (w_)])
#pragma unroll
        for (int u = 0; u < 4; ++u) YLOAD(ys[u], u);
        for (int c0 = 0; c0 < 60; c0 += 4) {
#pragma unroll
                for (int u = 0; u < 4; ++u) { const int c = c0 + u;
                const LAS unsigned char* Scur = lds + (c & 1) * MATB;
                    f32x4v acc[4];
    #pragma unroll
                    for (int it = 0; it < 4; ++it) { acc[it] = (f32x4v){bflo(YV(ys[u].y0, it, 0)), bfhi(YV(ys[u].y0, it, 0)), bflo(YV(ys[u].y0, it, 1)), bfhi(YV(ys[u].y0, it, 1))};
                        const LAS unsigned char* sp = Scur + ((16 * it + l15) * CP + 8 * q4) * 2;
                        acc[it] = __builtin_amdgcn_mfma_f32_16x16x32_bf16(*(const LAS bf16x8*)sp, ys[u].b0, acc[it], 0, 0, 0);
                        acc[it] = __builtin_amdgcn_mfma_f32_16x16x32_bf16(*(const LAS bf16x8*)(sp + 64), ys[u].b1, acc[it], 0, 0, 0); }
                    float s = 0.f;
    #pragma unroll
                    for (int it = 0; it < 4; ++it) s += (acc[it].x + acc[it].y) + (acc[it].z + acc[it].w);
                    s += __shfl_xor(s, 16); s += __shfl_xor(s, 32);
                    const float mean = s * (1.f / 64.f); float v = 0.f;
    #pragma unroll
                    for (int it = 0; it < 4; ++it) { acc[it] = acc[it] - mean; v += (acc[it].x * acc[it].x + acc[it].y * acc[it].y) + (acc[it].z * acc[it].z + acc[it].w * acc[it].w); }
                    v += __shfl_xor(v, 16); v += __shfl_xor(v, 32);
                    const float rstd = 1.0f / sqrtf(v * (1.f / 64.f) + 64e-5f);
                    bf16* orow = AR + (size_t)(b * SEQ + c * 64 + t) * DM + 1024 + h * 64 + 4 * q4;
    #pragma unroll
                    for (int it = 0; it < 4; ++it) {
                        const float o0 = acc[it].x * rstd * bflo(YV(ys[u].g1, it, 0)) + bflo(YV(ys[u].g2, it, 0)), o1 = acc[it].y * rstd * bfhi(YV(ys[u].g1, it, 0)) + bfhi(YV(ys[u].g2, it, 0));
                        const float o2 = acc[it].z * rstd * bflo(YV(ys[u].g1, it, 1)) + bflo(YV(ys[u].g2, it, 1)), o3 = acc[it].w * rstd * bfhi(YV(ys[u].g1, it, 1)) + bfhi(YV(ys[u].g2, it, 1));
                        *(v2u*)(orow + 16 * it) = (v2u){pk2(o0, o1), pk2(o2, o3)}; }
                asm volatile("" ::: "memory");
                    YLOAD(ys[u], c + 4);
                    __syncthreads();
                }
        }
        { const int c0 = 60;
#pragma unroll
                for (int u = 0; u < 4; ++u) { const int c = c0 + u;
                const LAS unsigned char* Scur = lds + (c & 1) * MATB;
                    f32x4v acc[4];
    #pragma unroll
                    for (int it = 0; it < 4; ++it) { acc[it] = (f32x4v){bflo(YV(ys[u].y0, it, 0)), bfhi(YV(ys[u].y0, it, 0)), bflo(YV(ys[u].y0, it, 1)), bfhi(YV(ys[u].y0, it, 1))};
                        const LAS unsigned char* sp = Scur + ((16 * it + l15) * CP + 8 * q4) * 2;
                        acc[it] = __builtin_amdgcn_mfma_f32_16x16x32_bf16(*(const LAS bf16x8*)sp, ys[u].b0, acc[it], 0, 0, 0);
                        acc[it] = __builtin_amdgcn_mfma_f32_16x16x32_bf16(*(const LAS bf16x8*)(sp + 64), ys[u].b1, acc[it], 0, 0, 0); }
                    float s = 0.f;
    #pragma unroll
                    for (int it = 0; it < 4; ++it) s += (acc[it].x + acc[it].y) + (acc[it].z + acc[it].w);
                    s += __shfl_xor(s, 16); s += __shfl_xor(s, 32);
                    const float mean = s * (1.f / 64.f); float v = 0.f;
    #pragma unroll
                    for (int it = 0; it < 4; ++it) { acc[it] = acc[it] - mean; v += (acc[it].x * acc[it].x + acc[it].y * acc[it].y) + (acc[it].z * acc[it].z + acc[it].w * acc[it].w); }
                    v += __shfl_xor(v, 16); v += __shfl_xor(v, 32);
                    const float rstd = 1.0f / sqrtf(v * (1.f / 64.f) + 64e-5f);
                    bf16* orow = AR + (size_t)(b * SEQ + c * 64 + t) * DM + 1024 + h * 64 + 4 * q4;
    #pragma unroll
                    for (int it = 0; it < 4; ++it) {
                        const float o0 = acc[it].x * rstd * bflo(YV(ys[u].g1, it, 0)) + bflo(YV(ys[u].g2, it, 0)), o1 = acc[it].y * rstd * bfhi(YV(ys[u].g1, it, 0)) + bfhi(YV(ys[u].g2, it, 0));
                        const float o2 = acc[it].z * rstd * bflo(YV(ys[u].g1, it, 1)) + bflo(YV(ys[u].g2, it, 1)), o3 = acc[it].w * rstd * bfhi(YV(ys[u].g1, it, 1)) + bfhi(YV(ys[u].g2, it, 1));
                        *(v2u*)(orow + 16 * it) = (v2u){pk2(o0, o1), pk2(o2, o3)}; }
                __syncthreads();
                }
        }
#undef YLOAD
#undef YV
    } else {
        const int nrow = 16 * w4 + l15;
        SSet ss[4];
#define SLOADX(S_, c_) do { const unsigned char* chk = chk0 + (size_t)(c_) * (32 * CHK_ITEM); const bf16* pt = (const bf16*)chk + (w4 * 128 + lane) * 8; S_.p0[0] = *(const bf16x8*)pt; S_.p1[0] = *(const bf16x8*)(pt + 512); \
        const bf16* q = (const bf16*)(chk + 1 * 8192) + (w4 * 256 + lane) * 4; \
        _Pragma("unroll") for (int it = 0; it < 4; ++it) S_.q[it] = *(const v2u*)(q + it * 256); } while (0)
#pragma unroll
        for (int u = 0; u < 4; ++u) SLOADX(ss[u], u);
        for (int c0 = 0; c0 < 60; c0 += 4) {
#pragma unroll
                for (int u = 0; u < 4; ++u) { const int c = c0 + u;
                const LAS unsigned char* Scur = lds + (c & 1) * MATB; LAS unsigned char* Snxt = lds + ((c & 1) ^ 1) * MATB;
    #pragma unroll
                    for (int it = 0; it < 4; ++it) { const int i = 16 * it + l15;
                        const LAS unsigned char* sp = Scur + (i * CP + 8 * q4) * 2; const bf16x8 s0 = *(const LAS bf16x8*)sp, s1 = *(const LAS bf16x8*)(sp + 64);
                        f32x4v acc = (f32x4v){bflo(ss[u].q[it].x), bfhi(ss[u].q[it].x), bflo(ss[u].q[it].y), bfhi(ss[u].q[it].y)};
                        acc = __builtin_amdgcn_mfma_f32_16x16x32_bf16(ss[u].p0[0], s0, acc, 0, 0, 0);
                        acc = __builtin_amdgcn_mfma_f32_16x16x32_bf16(ss[u].p1[0], s1, acc, 0, 0, 0);
                        *(LAS v2u*)(Snxt + (i * CP + 16 * w4 + 4 * q4) * 2) = (v2u){pk2(acc.x, acc.y), pk2(acc.z, acc.w)}; }
                asm volatile("" ::: "memory");
                    SLOADX(ss[u], c + 4);
                    __syncthreads();
                }
        }
        { const int c0 = 60;
#pragma unroll
                for (int u = 0; u < 4; ++u) { const int c = c0 + u;
                const LAS unsigned char* Scur = lds + (c & 1) * MATB; LAS unsigned char* Snxt = lds + ((c & 1) ^ 1) * MATB;
    #pragma unroll
                    for (int it = 0; it < 4; ++it) { const int i = 16 * it + l15;
                        const LAS unsigned char* sp = Scur + (i * CP + 8 * q4) * 2; const bf16x8 s0 = *(const LAS bf16x8*)sp, s1 = *(const LAS bf16x8*)(sp + 64);
                        f32x4v acc = (f32x4v){bflo(ss[u].q[it].x), bfhi(ss[u].q[it].x), bflo(ss[u].q[it].y), bfhi(ss[u].q[it].y)};
                        acc = __builtin_amdgcn_mfma_f32_16x16x32_bf16(ss[u].p0[0], s0, acc, 0, 0, 0);
                        acc = __builtin_amdgcn_mfma_f32_16x16x32_bf16(ss[u].p1[0], s1, acc, 0, 0, 0);
                        *(LAS v2u*)(Snxt + (i * CP + 16 * w4 + 4 * q4) * 2) = (v2u){pk2(acc.x, acc.y), pk2(acc.z, acc.w)}; }
                __syncthreads();
                }
        }
#undef SLOADX
    }
}

constexpr size_t WS_UB = WS_RWA;
constexpr size_t WS_VB = WS_RWA + 32 * MiB;
constexpr float U_SCALE = 512.f, V_SCALE = 32.f;
constexpr int SLICE_BYTES = 16384 * 128;
typedef float f32x2 __attribute__((ext_vector_type(2)));
__device__ __forceinline__ void phase_convert_tables(KP P, LAS unsigned char* lds) {
    const int tid = ltid(); constexpr int N16 = 16384 * 2048 / 16, GPT = 8, CH = GPT * NTHR, NCH = 2 * N16 / CH;
    unsigned* ctr = (unsigned*)(P.ws + WS_CTL) + CW_MOBA_CTR; LAS int* slot = (LAS int*)lds;
    const int q = tid & 127;
    f32x4 gu[4];
#pragma unroll
    for (int m = 0; m < 4; ++m) gu[m] = *(const f32x4*)(P.norm2_g + 16 * q + 4 * m) * U_SCALE;
    __syncthreads();
    if (tid == 0) slot[0] = (int)__hip_atomic_fetch_add(ctr, 1u, __ATOMIC_RELAXED, __HIP_MEMORY_SCOPE_AGENT);
    __syncthreads();
    for (int it = 0;; ++it) {
        const int c = slot[it & 1]; if (c >= NCH) break;
        if (tid == 0) slot[(it & 1) ^ 1] = (int)__hip_atomic_fetch_add(ctr, 1u, __ATOMIC_RELAXED, __HIP_MEMORY_SCOPE_AGENT);
        const bool isv = c >= NCH / 2;
        const int j0 = (isv ? c - NCH / 2 : c) * CH + tid;
        const float* src = (isv ? P.pv : P.pu) + (size_t)j0 * 16;
        unsigned char* dst = P.ws + (isv ? WS_VB : WS_UB) + (size_t)(q >> 3) * SLICE_BYTES + (size_t)(j0 >> 7) * 128 + (q & 7) * 16;
        f32x4 sc[4];
#pragma unroll
        for (int m = 0; m < 4; ++m) sc[m] = isv ? (f32x4){V_SCALE, V_SCALE, V_SCALE, V_SCALE} : gu[m];
#pragma unroll
        for (int hb = 0; hb < 1; ++hb) {
            f32x4 a[8][4];
#pragma unroll
            for (int k = 0; k < 8; ++k)
#pragma unroll
                for (int m = 0; m < 4; ++m) a[k][m] = *(const f32x4*)(src + (size_t)k * (NTHR * 16) + 4 * m);
#pragma unroll
            for (int k = 0; k < 8; ++k) { v4u o;
#pragma unroll
                for (int m = 0; m < 4; ++m) { const f32x4 v = a[k][m] * sc[m]; int p = 0;
                    p = __builtin_amdgcn_cvt_pk_fp8_f32(v.x, v.y, p, false); p = __builtin_amdgcn_cvt_pk_fp8_f32(v.z, v.w, p, true); o[m] = (unsigned)p; }
                *(v4u*)(dst + (size_t)k * 512) = o; }
        }
        __syncthreads();
    }
}
__device__ __forceinline__ f32x2 dot16p(const v4u u, const f32x2* x, f32x2 acc) {
#pragma unroll
    for (int q = 0; q < 4; ++q) { const f32x2 lo = __builtin_amdgcn_cvt_pk_f32_fp8((int)u[q], false), hi = __builtin_amdgcn_cvt_pk_f32_fp8((int)u[q], true);
        acc = __builtin_elementwise_fma(lo, x[2 * q], acc); acc = __builtin_elementwise_fma(hi, x[2 * q + 1], acc); }
    return acc;
}
__device__ __forceinline__ void axpy16p(const v4u v, f32x2 s, f32x2* y) {
#pragma unroll
    for (int q = 0; q < 4; ++q) { const f32x2 lo = __builtin_amdgcn_cvt_pk_f32_fp8((int)v[q], false), hi = __builtin_amdgcn_cvt_pk_f32_fp8((int)v[q], true);
        y[2 * q] = __builtin_elementwise_fma(s, lo, y[2 * q]); y[2 * q + 1] = __builtin_elementwise_fma(s, hi, y[2 * q + 1]); }
}
__device__ __forceinline__ float xsum_g8(float v) {
    v += DPP_F(v, 0x128);
    { auto r = __builtin_amdgcn_permlane16_swap(__float_as_uint(v), __float_as_uint(v), false, false); v = __uint_as_float(r[0]) + __uint_as_float(r[1]); }
    { auto r = __builtin_amdgcn_permlane32_swap(__float_as_uint(v), __float_as_uint(v), false, false); v = __uint_as_float(r[0]) + __uint_as_float(r[1]); }
    return v;
}
__device__ __forceinline__ void phase_peer_sliced(KP P, LAS unsigned char* lds, int bx, int G) {
    const int grp = bx & 7;
    const unsigned char* UB = P.ws + WS_UB; const unsigned char* VB = P.ws + WS_VB; const bf16* HB = (const bf16*)(P.ws + WS_XN);
    const int* ridx = (const int*)(P.ws + WS_PROJ + 64 * MiB); const float* rgate = (const float*)(P.ws + WS_PROJ + 68 * MiB); const float* RSTD = (const float*)(P.ws + WS_SSP + 2 * MiB);
    for (int bt = bx; bt < TT / 32; bt += G) {
        const int tid = ltid(), lane = tid & 63, wave = __builtin_amdgcn_readfirstlane(tid >> 6), g8 = lane >> 3, p = lane & 7;
        LAS int* idxT = (LAS int*)(lds + wave * 4096); LAS float* gT = (LAS float*)(lds + wave * 4096 + 2048);
        LAS bf16* h2T = (LAS bf16*)(lds + 32768 + wave * 16384);
        const int t0 = 32 * bt + 4 * wave;
#pragma unroll
        for (int i = 0; i < 4; ++i) { const size_t o = (size_t)(t0 + i) * 128; const int wofs = (i * 8 + (lane & 7)) * 16 + (lane >> 3);
            idxT[wofs] = ridx[o + lane]; idxT[wofs + 8] = ridx[o + 64 + lane]; gT[wofs] = rgate[o + lane]; gT[wofs + 8] = rgate[o + 64 + lane]; }
        float hacc[4][2];
#pragma unroll
        for (int i = 0; i < 4; ++i) { hacc[i][0] = 0.f; hacc[i][1] = 0.f; }
        {
            v4u rA[8], rB[8]; f32x2 xA[8], xB[8];
#define PS_SG(s_) (((s_) + 2 * grp) & 15)
#define PS_ISSUE(R, tabbase, s_, i_, hb_) do { const unsigned char* tb_ = (tabbase) + (size_t)PS_SG(s_) * SLICE_BYTES;        \
            const v4u ia_ = *(const LAS v4u*)(idxT + ((i_) * 8 + g8) * 16 + 8 * (hb_)), ib_ = *(const LAS v4u*)(idxT + ((i_) * 8 + g8) * 16 + 8 * (hb_) + 4); const unsigned po_ = 16u * (unsigned)p; \
            R[0] = *(const v4u*)(tb_ + (ia_[0] * 128u + po_)); R[1] = *(const v4u*)(tb_ + (ia_[1] * 128u + po_)); R[2] = *(const v4u*)(tb_ + (ia_[2] * 128u + po_)); R[3] = *(const v4u*)(tb_ + (ia_[3] * 128u + po_)); \
            R[4] = *(const v4u*)(tb_ + (ib_[0] * 128u + po_)); R[5] = *(const v4u*)(tb_ + (ib_[1] * 128u + po_)); R[6] = *(const v4u*)(tb_ + (ib_[2] * 128u + po_)); R[7] = *(const v4u*)(tb_ + (ib_[3] * 128u + po_)); } while (0)
#define PS_LOADX(X, s_, i_) do { const bf16* xp_ = HB + (size_t)(t0 + (i_)) * DM + 128 * PS_SG(s_) + 16 * p; const v4u xa_ = *(const v4u*)xp_, xb_ = *(const v4u*)(xp_ + 8); \
            _Pragma("unroll") for (int q = 0; q < 4; ++q) { X[q] = (f32x2){bflo(xa_[q]), bfhi(xa_[q])}; X[4 + q] = (f32x2){bflo(xb_[q]), bfhi(xb_[q])}; } } while (0)
#define PS_DOTS(R, X, i_, hb_) do { _Pragma("unroll") for (int m = 0; m < 8; ++m) { const f32x2 a2_ = dot16p(R[m], X, (f32x2){0.f, 0.f}); float sd_ = a2_.x + a2_.y; \
            sd_ += DPP_F(sd_, 0xB1); sd_ += DPP_F(sd_, 0x4E); sd_ += DPP_F(sd_, 0x141); if (p == m) hacc[i_][hb_] += sd_; } asm volatile("" ::: "memory"); } while (0)
            PS_LOADX(xA, 0, 0); PS_ISSUE(rA, UB, 0, 0, 0);
            for (int s = 0; s < 16; ++s) {
                PS_ISSUE(rB, UB, s, 0, 1); PS_LOADX(xB, s, 1);  PS_DOTS(rA, xA, 0, 0);
                PS_ISSUE(rA, UB, s, 1, 0);                       PS_DOTS(rB, xA, 0, 1);
                PS_ISSUE(rB, UB, s, 1, 1); PS_LOADX(xA, s, 2);  PS_DOTS(rA, xB, 1, 0);
                PS_ISSUE(rA, UB, s, 2, 0);                       PS_DOTS(rB, xB, 1, 1);
                PS_ISSUE(rB, UB, s, 2, 1); PS_LOADX(xB, s, 3);  PS_DOTS(rA, xA, 2, 0);
                PS_ISSUE(rA, UB, s, 3, 0);                       PS_DOTS(rB, xA, 2, 1);
                PS_ISSUE(rB, UB, s, 3, 1); if (s + 1 < 16) PS_LOADX(xA, s + 1, 0);  PS_DOTS(rA, xB, 3, 0);
                if (s + 1 < 16) PS_ISSUE(rA, UB, s + 1, 0, 0);  PS_DOTS(rB, xB, 3, 1);
            }
#undef PS_LOADX
#undef PS_DOTS
        }
#pragma unroll
        for (int i = 0; i < 4; ++i) { const float rsn = RSTD[t0 + i] * (1.f / U_SCALE);
#pragma unroll
            for (int hb = 0; hb < 2; ++hb) { const float hp = hacc[i][hb] * rsn; LAS float* gp = gT + (i * 8 + g8) * 16 + 8 * hb + p;
                *gp = 0.5f * hp * (1.f + erff(hp * 0.70710678118654752f)) * (1.f / V_SCALE) * *gp; } }
        float ssq[4] = {0.f, 0.f, 0.f, 0.f};
        {
            v4u rA[8], rB[8]; f32x2 y2[8];
#define PS_AXPY(R, i_, hb_) do { const f32x4 aa_ = *(const LAS f32x4*)(gT + ((i_) * 8 + g8) * 16 + 8 * (hb_)), ab_ = *(const LAS f32x4*)(gT + ((i_) * 8 + g8) * 16 + 8 * (hb_) + 4); \
            if ((hb_) == 0) { _Pragma("unroll") for (int q = 0; q < 8; ++q) y2[q] = (f32x2){0.f, 0.f}; } \
            _Pragma("unroll") for (int m = 0; m < 8; ++m) { const float av_ = m < 4 ? aa_[m & 3] : ab_[m & 3]; axpy16p(R[m], (f32x2){av_, av_}, y2); } asm volatile("" ::: "memory"); } while (0)
#define PS_FIN(s_, i_) do { f32x2 ysel_ = {0.f, 0.f}; _Pragma("unroll") for (int q = 0; q < 8; ++q) { const float a_ = xsum_g8(y2[q].x), b_ = xsum_g8(y2[q].y); if (g8 == q) ysel_ = (f32x2){a_, b_}; } \
            const int d_ = 128 * PS_SG(s_) + 16 * p + 2 * g8; const unsigned hb_ = *(const unsigned*)(HB + (size_t)(t0 + (i_)) * DM + d_); const f32x2 hv_ = (f32x2){bflo(hb_), bfhi(hb_)} + ysel_; \
            *(LAS unsigned*)(h2T + (i_) * DM + d_) = pk2(hv_.x, hv_.y); ssq[i_] += hv_.x * hv_.x + hv_.y * hv_.y; } while (0)
            PS_ISSUE(rA, VB, 0, 0, 0);
            for (int s = 0; s < 16; ++s) {
                PS_ISSUE(rB, VB, s, 0, 1); PS_AXPY(rA, 0, 0);
                PS_ISSUE(rA, VB, s, 1, 0); PS_AXPY(rB, 0, 1); PS_FIN(s, 0);
                PS_ISSUE(rB, VB, s, 1, 1); PS_AXPY(rA, 1, 0);
                PS_ISSUE(rA, VB, s, 2, 0); PS_AXPY(rB, 1, 1); PS_FIN(s, 1);
                PS_ISSUE(rB, VB, s, 2, 1); PS_AXPY(rA, 2, 0);
                PS_ISSUE(rA, VB, s, 3, 0); PS_AXPY(rB, 2, 1); PS_FIN(s, 2);
                PS_ISSUE(rB, VB, s, 3, 1); PS_AXPY(rA, 3, 0);
                if (s + 1 < 16) PS_ISSUE(rA, VB, s + 1, 0, 0); PS_AXPY(rB, 3, 1); PS_FIN(s, 3);
            }
#undef PS_AXPY
#undef PS_FIN
#undef PS_ISSUE
#undef PS_SG
        }
        { f32x4 fg[8];
#pragma unroll
          for (int j = 0; j < 8; ++j) fg[j] = *(const f32x4*)(P.final_g + 4 * lane + 256 * j);
#pragma unroll
          for (int i = 0; i < 4; ++i) { const float rs2 = 1.0f / sqrtf(wave_sum(ssq[i]) * (1.f / DM) + RMS_EPS);
#pragma unroll
            for (int j = 0; j < 8; ++j) { const v2u hv = *(const LAS v2u*)(h2T + i * DM + 4 * lane + 256 * j);
                *(f32x4*)(P.out + (size_t)(t0 + i) * DM + 4 * lane + 256 * j) = (f32x4){bflo(hv.x) * rs2 * fg[j].x, bfhi(hv.x) * rs2 * fg[j].y, bflo(hv.y) * rs2 * fg[j].z, bfhi(hv.y) * rs2 * fg[j].w}; } } }
        asm volatile("" ::: "memory");
    }
}
namespace moba {
constexpr float SCALE = 0.08838834764831845f;
constexpr float THR = 8.f;
constexpr bool WSKIP = false;
constexpr int D = 128, NW = 8, QBLK = 32, KVBLK = 64, QB = NW * QBLK;
constexpr int SHM_V = KVBLK * D * 2, SHM_K = KVBLK * D * 2;
constexpr int ATT_LDS_BYTES = 2 * SHM_V + 2 * SHM_K + NW * 64 * 4;
constexpr int KPITCH = INCP, QPITCH = INCP, OPITCH = DM;
typedef unsigned short bf16;
typedef short bf16x8 __attribute__((ext_vector_type(8)));
typedef short s16x4 __attribute__((ext_vector_type(4)));
typedef float f32x16 __attribute__((ext_vector_type(16)));
typedef float f32x4 __attribute__((ext_vector_type(4)));
typedef unsigned u32x4 __attribute__((ext_vector_type(4)));
template <class A, class Bt> struct same_t { static constexpr bool v = false; };
template <class A> struct same_t<A, A> { static constexpr bool v = true; };
#define KSWZ(row, colB) ((row) * 256 + ((colB) ^ (((row) & 7) << 4)))
#define SBAR() __builtin_amdgcn_sched_barrier(0)
__device__ __forceinline__ int v_st(int k, int c) { const int kk = (k & ~0xC) | ((k & 4) << 1) | ((k & 8) >> 1); return ((kk >> 3) * 4 + (c >> 5)) * 512 + ((kk & 7) * 32 + (c & 31)) * 2; }
__device__ __forceinline__ int v_rd_base(int lane) { return ((lane & 3) << 3) | (((lane >> 2) & 3) << 6) | (((lane >> 4) & 1) << 5) | (((lane >> 5) & 1) << 8); }
constexpr int v_rd_off(int d0, int ks, int half) { return d0 * 512 + ks * 4096 + half * 2048; }
__device__ __forceinline__ int crow(int r, int hi) { return (r & 3) + 8 * (r >> 2) + 4 * hi; }
__device__ __forceinline__ unsigned cvtpk(float lo, float hi) {
    unsigned r; asm volatile("v_cvt_pk_bf16_f32 %0, %1, %2" : "=v"(r) : "v"(lo), "v"(hi)); return r;
}
__device__ __forceinline__ bf16x8 pack8(f32x4 a, f32x4 b) {
    u32x4 w = {cvtpk(a[0], a[1]), cvtpk(a[2], a[3]), cvtpk(b[0], b[1]), cvtpk(b[2], b[3])};
    return *reinterpret_cast<bf16x8*>(&w);
}
template <class T> __device__ __forceinline__ bf16x8 load8(const T* p) {
    if constexpr (same_t<T, float>::v) { return pack8(*(const f32x4*)p, *(const f32x4*)(p + 4)); }
    else { return *reinterpret_cast<const bf16x8*>(p); }
}
__device__ __forceinline__ void mask_tile(f32x16& p0, f32x16& p1, int dq, unsigned W) {
    const float NEG = -__builtin_inff();
#pragma unroll
    for (int r = 0; r < 16; ++r) {
        const int c = (r & 3) + 8 * (r >> 2);
        if ((unsigned)(dq - c) >= W) p0[r] = NEG;
        if ((unsigned)(dq - c - 32) >= W) p1[r] = NEG;
    }
}
__device__ __forceinline__ void partialSM(f32x16& p0, f32x16& p1, float& m_reg, float& mn, float& alpha, float base0, float base1) {
    float pm0 = p0[0]; for (int r = 1; r < 16; ++r) pm0 = fmaxf(pm0, p0[r]); float pm1 = p1[0]; for (int r = 1; r < 16; ++r) pm1 = fmaxf(pm1, p1[r]);
    float pmax = fmaxf(pm0 + base0, pm1 + base1);
    { auto rr = __builtin_amdgcn_permlane32_swap(__float_as_uint(pmax), __float_as_uint(pmax), false, false);
      pmax = fmaxf(__uint_as_float(rr[0]), __uint_as_float(rr[1])); }
    constexpr float C2 = 1.4426950408889634f * SCALE;
    if (__builtin_expect(__all((pmax - m_reg) * SCALE <= THR), 1)) { mn = m_reg; alpha = 1.f; }
    else { mn = fmaxf(m_reg, pmax); alpha = __builtin_amdgcn_exp2f((m_reg - mn) * C2); m_reg = mn; }
    const float mnL0 = (base0 - mn) * C2, mnL1 = (base1 - mn) * C2;
    for (int r = 0; r < 16; ++r) p0[r] = fmaf(p0[r], C2, mnL0); for (int r = 0; r < 16; ++r) p1[r] = fmaf(p1[r], C2, mnL1);
    for (int r = 0; r < 16; ++r) p0[r] = __builtin_amdgcn_exp2f(p0[r]);
}
__device__ __forceinline__ void finishSM(f32x16& p0, f32x16& p1, float alpha, float& l_reg, bf16x8& pa0, bf16x8& pa1, bf16x8& pa2, bf16x8& pa3) {
    for (int r = 0; r < 16; ++r) p1[r] = __builtin_amdgcn_exp2f(p1[r]);
    float ps = 0; for (int r = 0; r < 16; ++r) ps += p0[r]; for (int r = 0; r < 16; ++r) ps += p1[r];
    { auto rr = __builtin_amdgcn_permlane32_swap(__float_as_uint(ps), __float_as_uint(ps), false, false);
      ps = __uint_as_float(rr[0]) + __uint_as_float(rr[1]); }
    l_reg = l_reg * alpha + ps;
#define PK4(P, B_, OUT) do { unsigned a0 = cvtpk(P[B_+0], P[B_+1]), a1 = cvtpk(P[B_+2], P[B_+3]);                          \
        unsigned b0 = cvtpk(P[B_+4], P[B_+5]), b1 = cvtpk(P[B_+6], P[B_+7]);                                             \
        auto r0 = __builtin_amdgcn_permlane32_swap(a0, b0, false, false); auto r1 = __builtin_amdgcn_permlane32_swap(a1, b1, false, false); \
        u32x4 w = {r0[0], r1[0], r0[1], r1[1]}; OUT = *reinterpret_cast<bf16x8*>(&w); } while (0)
    PK4(p0, 0, pa0); PK4(p0, 8, pa1); PK4(p1, 0, pa2); PK4(p1, 8, pa3);
#undef PK4
}
template <int KB, bool SK>
__device__ __forceinline__ void qkt(f32x16& p0, f32x16& p1, const char* K_lds, int r32, int hi, const bf16x8* qr, bool act) {
    if (SK && !act) { const float NEG = -__builtin_inff();
#pragma unroll
        for (int r = 0; r < 16; ++r) { p0[r] = NEG; p1[r] = NEG; } return; }
    p0 = f32x16{}; p1 = f32x16{};
    const char* kb[4];
#pragma unroll
    for (int dd = 0; dd < 4; ++dd) kb[dd] = K_lds + KB * SHM_K + KSWZ(r32, (dd * 16 + hi * 8) * 2);
#pragma unroll
    for (int d0 = 0; d0 < 8; ++d0) { const char* a = kb[d0 & 3] + (d0 >> 2) * 128;
        bf16x8 b0 = *reinterpret_cast<const bf16x8*>(a);
        bf16x8 b1 = *reinterpret_cast<const bf16x8*>(a + 32 * 256);
        p0 = __builtin_amdgcn_mfma_f32_32x32x16_bf16(b0, qr[d0], p0, 0, 0, 0);
        p1 = __builtin_amdgcn_mfma_f32_32x32x16_bf16(b1, qr[d0], p1, 0, 0, 0); }
}
template <int VB, bool SK>
__device__ __forceinline__ void pv_tile(f32x16* o, int vb0, bf16x8 pa0, bf16x8 pa1, bf16x8 pa2, bf16x8 pa3, bool act) {
    if (SK && !act) return;
#define TRRD(dst, off) asm volatile("ds_read_b64_tr_b16 %0, %1 offset:%2" : "=&v"(dst) : "v"(vb0), "i"(off) : "memory")
#define PV_D0(d0) do { s16x4 l0, l1, h0, h1; constexpr int b_ = VB * SHM_V + v_rd_off(d0, 0, 0);     \
        TRRD(l0, b_); TRRD(h0, b_ + 2048); TRRD(l1, b_ + 4096); TRRD(h1, b_ + 6144); \
        asm volatile("s_waitcnt lgkmcnt(0)" ::: "memory"); SBAR();                 \
        o[d0] = __builtin_amdgcn_mfma_f32_32x32x16_bf16(pa0, (bf16x8){l0[0], l0[1], l0[2], l0[3], h0[0], h0[1], h0[2], h0[3]}, o[d0], 0, 0, 0);   \
        o[d0] = __builtin_amdgcn_mfma_f32_32x32x16_bf16(pa1, (bf16x8){l1[0], l1[1], l1[2], l1[3], h1[0], h1[1], h1[2], h1[3]}, o[d0], 0, 0, 0);   \
        SBAR(); TRRD(l0, b_ + 8192); TRRD(h0, b_ + 10240); TRRD(l1, b_ + 12288); TRRD(h1, b_ + 14336); \
        asm volatile("s_waitcnt lgkmcnt(0)" ::: "memory"); SBAR();   \
        o[d0] = __builtin_amdgcn_mfma_f32_32x32x16_bf16(pa2, (bf16x8){l0[0], l0[1], l0[2], l0[3], h0[0], h0[1], h0[2], h0[3]}, o[d0], 0, 0, 0);   \
        o[d0] = __builtin_amdgcn_mfma_f32_32x32x16_bf16(pa3, (bf16x8){l1[0], l1[1], l1[2], l1[3], h1[0], h1[1], h1[2], h1[3]}, o[d0], 0, 0, 0); } while (0)
    PV_D0(0); PV_D0(1); PV_D0(2); PV_D0(3);
#undef PV_D0
#undef TRRD
}

template <class TIn, class TOut> struct BlockRef { const TIn* Q; const TIn* K; const TIn* V; TOut* O; int P0; const float* KM; float A; int jlo, jhi; float* ST; };
template <class TIn> struct Seam {
    bf16x8 qr[8];
    bf16x8 st_v0, st_v1, st_k0, st_k1; f32x4 sf0, sf1, sf2, sf3;
    f32x4 tq[16];
};
__device__ __forceinline__ int swa_jlo(int P0, int W) { const int lowk = P0 - W + 1; return lowk > 0 ? lowk / KVBLK : 0; }
#define ROW(p, k0, rr) ((p) + (size_t)((k0) + (rr)) * KPITCH + sc)
#define VMW() asm volatile("s_waitcnt vmcnt(0)" ::: "memory")
#define VMWN(n) asm volatile("s_waitcnt vmcnt(%0)" :: "i"(n) : "memory")
#define SLOAD_H(Kp, Vp, k0) do { S.st_v0 = load8<TIn>(ROW(Vp, k0, sr)); S.st_v1 = load8<TIn>(ROW(Vp, k0, 32 + sr));              \
                         S.st_k0 = load8<TIn>(ROW(Kp, k0, sr)); S.st_k1 = load8<TIn>(ROW(Kp, k0, 32 + sr)); } while (0)
#define SWRITE_HK(bf) do { *(bf16x8*)(K_lds + (bf) * SHM_K + kws) = S.st_k0; *(bf16x8*)(K_lds + (bf) * SHM_K + kws + 32 * 256) = S.st_k1; } while (0)
#define SWRITE_HV(bf) do { *(bf16x8*)(V_lds + (bf) * SHM_V + vst0) = S.st_v0; *(bf16x8*)(V_lds + (bf) * SHM_V + vst1) = S.st_v1; } while (0)
#define SWRITE_H(bf) do { SWRITE_HV(bf); SWRITE_HK(bf); } while (0)
#define SLOAD_F(p, k0) do { S.sf0 = *(const f32x4*)ROW(p, k0, sr); S.sf1 = *(const f32x4*)(ROW(p, k0, sr) + 4);                \
                            S.sf2 = *(const f32x4*)ROW(p, k0, 32 + sr); S.sf3 = *(const f32x4*)(ROW(p, k0, 32 + sr) + 4); } while (0)
#define SWRITE_KF(bf) do { *(bf16x8*)(K_lds + (bf) * SHM_K + kws) = pack8(S.sf0, S.sf1); *(bf16x8*)(K_lds + (bf) * SHM_K + kws + 32 * 256) = pack8(S.sf2, S.sf3); } while (0)
#define SWRITE_VF(bf) do { *(bf16x8*)(V_lds + (bf) * SHM_V + vst0) = pack8(S.sf0, S.sf1); *(bf16x8*)(V_lds + (bf) * SHM_V + vst1) = pack8(S.sf2, S.sf3); } while (0)
template <class TIn, class TOut>
__device__ __forceinline__ void causal_swa_prime(const BlockRef<TIn, TOut>& cur, int W, char* lds, Seam<TIn>& S) {
    constexpr bool F32 = same_t<TIn, float>::v;
    const int tid = ltid(), wid = __builtin_amdgcn_readfirstlane(tid >> 6), lane = tid & 63, r32 = lane & 31, hi = lane >> 5;
    const int sr = tid >> 4, sc = (tid & 15) * 8, kws = KSWZ(sr, sc * 2); char* K_lds = lds + 2 * SHM_V;
    const int kb0 = cur.jlo * KVBLK;
    for (int d0 = 0; d0 < 8; ++d0) S.qr[d0] = load8<TIn>(cur.Q + (size_t)(wid * QBLK + r32) * QPITCH + d0 * 16 + hi * 8);
    if constexpr (F32) { SLOAD_F((const float*)cur.K, kb0); VMW(); SWRITE_KF(0); SBAR(); SLOAD_F((const float*)cur.V, kb0); }
    else { SLOAD_H(cur.K, cur.V, kb0); VMW(); SWRITE_HK(0); }
    __syncthreads();
}
template <class TIn, class TOut>
__device__ __forceinline__ void causal_swa_block(const BlockRef<TIn, TOut>& cur, const BlockRef<TIn, TOut>& nxt, int skv, int W, char* lds, Seam<TIn>& S) {
    constexpr bool F32 = same_t<TIn, float>::v;
    const int tid = ltid(), wid = __builtin_amdgcn_readfirstlane(tid >> 6), lane = tid & 63, r32 = lane & 31, hi = lane >> 5;
    const int j_lo = cur.jlo, j_hi = cur.jhi;
    const int NT = j_hi - j_lo;
    const int kbn = nxt.jlo * KVBLK;
    const int qlo = cur.P0 + wid * QBLK, qm = qlo + r32 - 4 * hi;
    char* V_lds = lds; char* K_lds = lds + 2 * SHM_V;
    float* ws = (float*)(lds + 2 * SHM_V + 2 * SHM_K) + wid * 64; float* li_l = ws, * al_l = ws + 32;
    float m_reg = -1e30f, l_reg = 0; f32x16 o[4] = {};
    const int sr = tid >> 4, sc = (tid & 15) * 8, vst0 = v_st(sr, sc), vst1 = v_st(32 + sr, sc), kws = KSWZ(sr, sc * 2);
    const int vb0 = (int)(uintptr_t)V_lds + v_rd_base(lane);
    const TIn* Kh = cur.K; const TIn* Vh = cur.V;
    const float alA_ = cur.A;
    unsigned selm = 0u;
    { const int qb_ = cur.P0 >> 8;
      if (qb_ > 0) {
        float* kmL = (float*)(K_lds + SHM_K);
        *(f32x4*)(kmL + 4 * tid) = *(const f32x4*)(cur.KM + (size_t)(tid >> 5) * 1024 + 4 * (tid & 31));
        __syncthreads();
        float g[16];
#pragma unroll
        for (int n = 0; n < 16; ++n) g[n] = 0.f;
#pragma unroll
        for (int d0 = 0; d0 < 8; ++d0) { float qf[8];
#pragma unroll
            for (int j = 0; j < 8; ++j) qf[j] = __uint_as_float(((unsigned)(unsigned short)S.qr[d0][j]) << 16);
#pragma unroll
            for (int n = 0; n < 16; ++n) if (n < qb_) { const f32x4 k0 = *(const f32x4*)(kmL + n * 128 + d0 * 16 + hi * 8), k1 = *(const f32x4*)(kmL + n * 128 + d0 * 16 + hi * 8 + 4);
                g[n] += qf[0] * k0[0] + qf[1] * k0[1] + qf[2] * k0[2] + qf[3] * k0[3] + qf[4] * k1[0] + qf[5] * k1[1] + qf[6] * k1[2] + qf[7] * k1[3]; }
            asm volatile("" ::: "memory"); }
#pragma unroll
        for (int n = 0; n < 16; ++n) { const float a = g[n] + __shfl_xor(g[n], 32); g[n] = n < qb_ ? a : -1e30f; }
#pragma unroll
        for (int r = 0; r < 3; ++r) { float best = -3e38f; int bi = 0;
#pragma unroll
            for (int n = 0; n < 16; ++n) if (!((selm >> n) & 1u) && g[n] > best) { best = g[n]; bi = n; }
            selm |= 1u << bi; }
        selm &= (1u << qb_) - 1u;
        __syncthreads();
      }
      li_l[r32] = __uint_as_float(selm); }
#define RESC(a) do { if (__any((a) < 1.f)) { if (hi == 0) al_l[r32] = (a); asm volatile("s_waitcnt lgkmcnt(0)" ::: "memory");              \
                     for (int d_ = 0; d_ < 4; ++d_) for (int r = 0; r < 16; ++r) o[d_][r] *= al_l[crow(r, hi)]; } } while (0)
#define KBASE(t) ((j_lo + (t)) * KVBLK)
#define ACT(t) (KBASE(t) <= qlo + QBLK - 1 && KBASE(t) + KVBLK - 1 >= qlo - W + 1)
#define MASKT(P0_, P1_, t) do { const int kb_ = KBASE(t); if ((!SK || ACT(t)) && (kb_ + KVBLK - 1 > qlo || kb_ <= qlo + QBLK - 1 - W)) mask_tile(P0_, P1_, qm - kb_, (unsigned)W); \
        _Pragma("unroll") for (int r = 0; r < 16; ++r) { const float c_ = (float)((r & 3) + 8 * (r >> 2)); P0_[r] = fmaf(alA_, c_, P0_[r]); P1_[r] = fmaf(alA_, c_, P1_[r]); } } while (0)
#define BASE0(t) ((KBASE(t) < cur.P0 && !((__float_as_uint(li_l[r32]) >> (KBASE(t) >> 8)) & 1u)) ? -__builtin_inff() : alA_ * (float)(KBASE(t) - cur.P0 + 4 * hi))
#define BASE1(t) (BASE0(t) + 32.f * alA_)
    constexpr int NQL = F32 ? 16 : 8;
    constexpr bool SK = WSKIP && !F32;
#define SEAM_K0() do { VMWN(NQL); if constexpr (F32) { SWRITE_KF(0); SBAR(); SLOAD_F((const float*)nxt.V, kbn); } else { SWRITE_HK(0); } SBAR(); } while (0)
    f32x16 pA0, pA1, pB0, pB1; float mnA, mnB, alA, alB; bf16x8 pa0, pa1, pa2, pa3;
    if constexpr (F32) { VMW(); SWRITE_VF(0); SBAR(); } else { SWRITE_HV(0); SBAR(); }
    if (NT > 1) { if constexpr (F32) SLOAD_F((const float*)Kh, KBASE(1)); else SLOAD_H(Kh, Vh, KBASE(1)); }
    SBAR(); qkt<0, SK>(pA0, pA1, K_lds, r32, hi, S.qr, ACT(0));
    if constexpr (F32) { if (NT > 1) { VMW(); SWRITE_KF(1); SBAR(); SLOAD_F((const float*)Vh, KBASE(1)); } }
    MASKT(pA0, pA1, 0); partialSM(pA0, pA1, m_reg, mnA, alA, BASE0(0), BASE1(0));
    if (NT > 1) { VMW(); if constexpr (F32) { SWRITE_VF(1); SBAR(); if (NT > 2) SLOAD_F((const float*)Kh, KBASE(2)); } else SWRITE_H(1); }
    __syncthreads();
#define HALF_STEP(PX0, PX1, mnX, alX, PY0, PY1, alY, t, KB, VB, SB) do {                                                      \
        SBAR(); qkt<KB, SK>(PX0, PX1, K_lds, r32, hi, S.qr, ACT(t));                                             \
        finishSM(PY0, PY1, alY, l_reg, pa0, pa1, pa2, pa3); SBAR();                                                           \
        if ((t) + 1 < NT) { if constexpr (F32) { VMW(); SWRITE_KF(SB); SBAR(); SLOAD_F((const float*)Vh, KBASE((t) + 1)); }  \
                            else { SLOAD_H(Kh, Vh, KBASE((t) + 1)); } SBAR(); }                                               \
        pv_tile<VB, SK>(o, vb0, pa0, pa1, pa2, pa3, ACT((t) - 1)); MASKT(PX0, PX1, (t)); partialSM(PX0, PX1, m_reg, mnX, alX, BASE0(t), BASE1(t));                                        \
        __syncthreads();                                                                                                      \
        if ((t) + 1 < NT) { VMW(); if constexpr (F32) { SWRITE_VF(SB); SBAR(); if ((t) + 2 < NT) SLOAD_F((const float*)Kh, KBASE((t) + 2)); } \
                            else { SWRITE_H(SB); } }                                                                          \
        RESC(alX); __syncthreads(); } while (0)
    for (int t = 1; t + 1 < NT; t += 2) {
        HALF_STEP(pB0, pB1, mnB, alB, pA0, pA1, alA, t, 1, 0, 0);
        HALF_STEP(pA0, pA1, mnA, alA, pB0, pB1, alB, t + 1, 0, 1, 1);
    }
    const bool even = (NT & 1) == 0;
    if (even) { SBAR(); qkt<1, SK>(pB0, pB1, K_lds, r32, hi, S.qr, ACT(NT - 1)); SBAR(); }
#define QROW(e) (nxt.Q + (size_t)(wid * QBLK + r32) * QPITCH + ((e) >> 1) * 16 + hi * 8 + ((e) & 1) * 4)
    if constexpr (F32) { SLOAD_F((const float*)nxt.K, kbn); SBAR();
#pragma unroll
        for (int e = 0; e < 8; ++e) S.tq[e] = *(const f32x4*)QROW(e); }
    else { SLOAD_H(nxt.K, nxt.V, kbn); SBAR();
#pragma unroll
        for (int d0 = 0; d0 < 8; ++d0) S.qr[d0] = load8<TIn>(nxt.Q + (size_t)(wid * QBLK + r32) * QPITCH + d0 * 16 + hi * 8); }
    SBAR();
    finishSM(pA0, pA1, alA, l_reg, pa0, pa1, pa2, pa3); SBAR();
    if constexpr (F32) {
#pragma unroll
        for (int e = 8; e < 16; ++e) S.tq[e] = *(const f32x4*)QROW(e); SBAR(); }
#undef QROW
    pv_tile<0, SK>(o, vb0, pa0, pa1, pa2, pa3, ACT(even ? NT - 2 : NT - 1));
    if (even) { MASKT(pB0, pB1, NT - 1); partialSM(pB0, pB1, m_reg, mnB, alB, BASE0(NT - 1), BASE1(NT - 1)); __syncthreads(); RESC(alB);
        finishSM(pB0, pB1, alB, l_reg, pa0, pa1, pa2, pa3); SBAR(); pv_tile<1, SK>(o, vb0, pa0, pa1, pa2, pa3, ACT(NT - 1)); }
    SBAR(); SEAM_K0();
    if (hi == 0) { li_l[r32] = l_reg; if (cur.ST) { cur.ST[(wid * QBLK + r32) * 16] = m_reg; cur.ST[(wid * QBLK + r32) * 16 + 1] = l_reg; } }
    asm volatile("s_waitcnt lgkmcnt(0)" ::: "memory");
    float rli[16];
#pragma unroll
    for (int r = 0; r < 16; ++r) { const float l_ = li_l[crow(r, hi)]; rli[r] = l_ > 0.f ? __builtin_amdgcn_rcpf(l_) : 0.f; }
    TOut* Ow = cur.O + (size_t)(wid * QBLK) * OPITCH;
#pragma unroll
    for (int r = 0; r < 16; ++r) { const int orow = crow(r, hi);
#pragma unroll
        for (int d0 = 0; d0 < 4; ++d0) { const float v = o[d0][r] * rli[r];
            if constexpr (same_t<TOut, float>::v) { Ow[(size_t)orow * OPITCH + d0 * 32 + r32] = v; }
            else { const float vn = __shfl_xor(v, 1);
                   if ((r32 & 1) == 0) *(unsigned*)(Ow + (size_t)orow * OPITCH + d0 * 32 + r32) = cvtpk(v, vn); } } }
    if constexpr (F32) {
#pragma unroll
        for (int d0 = 0; d0 < 8; ++d0) S.qr[d0] = pack8(S.tq[2 * d0], S.tq[2 * d0 + 1]); }
    __syncthreads();
#undef RESC
#undef KBASE
#undef ACT
#undef MASKT
#undef SEAM_K0
#undef HALF_STEP
}
#undef ROW
#undef VMW
#undef VMWN
#undef SLOAD_H
#undef SWRITE_HK
#undef SWRITE_HV
#undef SWRITE_H
#undef SLOAD_F
#undef SWRITE_KF
#undef SWRITE_VF

#undef BASE0
#undef BASE1
}
constexpr size_t WS_OSL = WS_XN, WS_OSU = WS_H;
constexpr size_t WS_STL = WS_WIN, WS_STU = WS_WIN + 1 * MiB;
constexpr int MOBA_SPLIT_QB = 9, MOBA_SPLIT_AT = 38;
__device__ __forceinline__ void phase_moba(KP P, char* lds, int vcu, int G) {
    typedef moba::BlockRef<moba::bf16, moba::bf16> BR;
    const moba::bf16* proj = (const moba::bf16*)(P.ws + WS_PROJ); moba::bf16* AR = (moba::bf16*)(P.ws + WS_AR); const float* kmean = (const float*)(P.ws + WS_KMEAN);
    constexpr int W = 1 << 30;
    auto mkref = [&](int bh, int qb, int part) -> BR { const int b = bh >> 3, h = bh & 7; BR r; const int nt = 4 * qb + 4;
        r.Q = proj + (size_t)(b * SEQ + qb * 256) * INCP + h * 128; r.K = proj + (size_t)(b * SEQ) * INCP + C_AK + h * 128; r.V = proj + (size_t)(b * SEQ) * INCP + C_AV + h * 128;
        moba::bf16* ob = part == 0 ? AR : (moba::bf16*)(P.ws + (part == 1 ? WS_OSL : WS_OSU));
        r.O = ob + (size_t)(b * SEQ + qb * 256) * DM + h * 128; r.P0 = qb * 256; r.KM = kmean + (size_t)(b * 16) * 1024 + h * 128; r.A = exp2f(-(float)(h + 1)) * (1.f / moba::SCALE);
        const int ks = qb == MOBA_SPLIT_QB ? nt - 4 : MOBA_SPLIT_AT;
        r.jlo = part == 2 ? ks : 0; r.jhi = part == 1 ? ks : nt;
        r.ST = part == 0 ? nullptr : (float*)(P.ws + (part == 1 ? WS_STL : WS_STU)) + ((size_t)(b * SEQ + qb * 256) * 8 + h) * 2;
        return r; };
    moba::Seam<moba::bf16> S;
    if (G == 256) {
        const int q_ = vcu & 15, bh = vcu >> 4;
        const int qbA[16] = { 1,  0,  7,  6,  5,  4,  3,  2, 15, 14, 13, 12, 11, 10,  9,  8};
        const int ptA[16] = { 0,  0,  0,  0,  0,  0,  0,  0,  1,  1,  1,  1,  1,  1,  1,  0};
        const int qbB[16] = {-1,  9, 10, 11, 12, 13, 14, 15, -1, -1, -1, -1, -1, -1, -1, -1};
        const int ptB[16] = { 0,  2,  2,  2,  2,  2,  2,  2,  0,  0,  0,  0,  0,  0,  0,  0};
        int qa = -1, pa = 0, qb2 = -1, pb = 0;
#pragma unroll
        for (int k = 0; k < 16; ++k) if (k == q_) { qa = qbA[k]; pa = ptA[k]; qb2 = qbB[k]; pb = ptB[k]; }
        for (int it = 0; it < 2; ++it) { const int qq = it == 0 ? qa : qb2, pp = it == 0 ? pa : pb; if (qq < 0) continue;
            const BR cur = mkref(bh, qq, pp);
            moba::causal_swa_prime<moba::bf16, moba::bf16>(cur, W, lds, S);
            moba::causal_swa_block<moba::bf16, moba::bf16>(cur, cur, SEQ, W, lds, S); }
    } else {
        for (int item = vcu; item < 256; item += G) {
            const BR cur = mkref(item >> 4, item & 15, 0);
            moba::causal_swa_prime<moba::bf16, moba::bf16>(cur, W, lds, S);
            moba::causal_swa_block<moba::bf16, moba::bf16>(cur, cur, SEQ, W, lds, S); }
    }
}
__device__ __forceinline__ void moba_combine(KP P, int vcu, int G) {
    if (G != 256) return;
    const int tid = ltid(); const bf16* OL = (const bf16*)(P.ws + WS_OSL); const bf16* OU = (const bf16*)(P.ws + WS_OSU); bf16* AR = (bf16*)(P.ws + WS_AR);
    const float* STL = (const float*)(P.ws + WS_STL); const float* STU = (const float*)(P.ws + WS_STU);
    constexpr int NSPL = 16 - MOBA_SPLIT_QB; constexpr float C2 = 1.4426950408889634f * moba::SCALE;
    for (int item = vcu; item < 16 * NSPL * 2; item += G) {
        const int half = item & 1, k = item >> 1, bh = k / NSPL, qb = MOBA_SPLIT_QB + k % NSPL, b = bh >> 3, h = bh & 7;
        const int row = b * SEQ + qb * 256 + half * 128 + (tid >> 2), c0 = (tid & 3) * 32;
        const size_t so = ((size_t)row * 8 + h) * 2; const float mL = STL[so], lL = STL[so + 1], mU = STU[so], lU = STU[so + 1];
        const float m = fmaxf(mL, mU); const float wL = lL * __builtin_amdgcn_exp2f((mL - m) * C2), wU = lU * __builtin_amdgcn_exp2f((mU - m) * C2); const float inv = __builtin_amdgcn_rcpf(wL + wU);
        const float aL = wL * inv, aU = wU * inv; const size_t o = (size_t)row * DM + h * 128 + c0;
        v4u l4[4], u4[4];
#pragma unroll
        for (int j = 0; j < 4; ++j) { l4[j] = *(const v4u*)(OL + o + 8 * j); u4[j] = *(const v4u*)(OU + o + 8 * j); }
#pragma unroll
        for (int j = 0; j < 4; ++j) { v4u r4;
#pragma unroll
            for (int e = 0; e < 4; ++e) r4[e] = pk2(aL * bflo(l4[j][e]) + aU * bflo(u4[j][e]), aL * bfhi(l4[j][e]) + aU * bfhi(u4[j][e]));
            *(v4u*)(AR + o + 8 * j) = r4; }
    }
}
constexpr size_t WS_SKB = WS_KMEAN + 256 * 1024;
__device__ __forceinline__ void prologue_subkeys(KP P, int vcu, int G) {
    unsigned* dst = (unsigned*)(P.ws + WS_SKB);
    for (int i = vcu * NTHR + ltid(); i < 8 * 2 * 128 * 128 / 2; i += G * NTHR) dst[i] = pk2(P.sub_keys[2 * i], P.sub_keys[2 * i + 1]);
}
__device__ __forceinline__ unsigned f2key(float v) { const unsigned u = __float_as_uint(v); return u ^ ((u >> 31) ? 0xFFFFFFFFu : 0x80000000u); }
__device__ __forceinline__ float key2f(unsigned k) { return __uint_as_float(k ^ ((k >> 31) ? 0x80000000u : 0xFFFFFFFFu)); }
__device__ __forceinline__ unsigned umax3(unsigned a, unsigned b, unsigned c) { return max(max(a, b), c); }
__device__ __forceinline__ void peer_route_tiles(KP P, LAS unsigned char* lds, int tt0, int nitems, int h) {
    const int tid = ltid(), lane = tid & 63, wave = __builtin_amdgcn_readfirstlane(tid >> 6), l15 = lane & 15, q4 = lane >> 4;
    const bf16* PQ = (const bf16*)(P.ws + WS_PROJ); const bf16* SKB = (const bf16*)(P.ws + WS_SKB);
    int* ridx = (int*)(P.ws + WS_PROJ + 64 * MiB); float* rgate = (float*)(P.ws + WS_PROJ + 68 * MiB);
    for (int it_ = 0; it_ < nitems; ++it_) {
        LAS float* sval = (LAS float*)(lds + it_ * 16384); LAS int* sidx = (LAS int*)(lds + it_ * 16384 + 8192);
        const int tt = tt0 + it_, p = wave & 1, sub = wave >> 1, tl = sub * 16 + l15;
        const bf16* qp = PQ + ((size_t)tt * 64 + tl) * DM + h * 256 + p * 128 + 8 * q4;
        bf16x8 qb[4];
#pragma unroll
        for (int kk = 0; kk < 4; ++kk) qb[kk] = *(const bf16x8*)(qp + 32 * kk);
        const bf16* sk = SKB + ((size_t)((h * 2 + p) * 128 + l15)) * 128 + 8 * q4;
        unsigned key[32];
#pragma unroll
        for (int nt = 0; nt < 8; ++nt) { f32x4v acc = {0.f, 0.f, 0.f, 0.f};
#pragma unroll
            for (int kk = 0; kk < 4; ++kk) acc = __builtin_amdgcn_mfma_f32_16x16x32_bf16(*(const bf16x8*)(sk + nt * 16 * 128 + 32 * kk), qb[kk], acc, 0, 0, 0);
#pragma unroll
            for (int e = 0; e < 4; ++e) key[4 * nt + e] = (f2key(acc[e]) & ~127u) | (unsigned)(127 - (16 * nt + 4 * q4 + e)); }
#define CE(a_, b_) { const unsigned hi_ = max(KA[a_], KA[b_]), lo_ = min(KA[a_], KA[b_]); KA[a_] = hi_; KA[b_] = lo_; }
#define SORT16_NET CE(0,1) CE(2,3) CE(0,2) CE(1,3) CE(1,2) CE(4,5) CE(6,7) CE(4,6) CE(5,7) CE(5,6) CE(0,4) CE(2,6) CE(2,4) CE(1,5) CE(3,7) CE(3,5) CE(1,2) CE(3,4) CE(5,6) CE(8,9) CE(10,11) CE(8,10) CE(9,11) CE(9,10) CE(12,13) CE(14,15) CE(12,14) CE(13,15) CE(13,14) CE(8,12) CE(10,14) CE(10,12) CE(9,13) CE(11,15) CE(11,13) CE(9,10) CE(11,12) CE(13,14) CE(0,8) CE(4,12) CE(4,8) CE(2,10) CE(6,14) CE(6,10) CE(2,4) CE(6,8) CE(10,12) CE(1,9) CE(5,13) CE(5,9) CE(3,11) CE(7,15) CE(7,11) CE(3,5) CE(7,9) CE(11,13) CE(1,2) CE(3,4) CE(5,6) CE(7,8) CE(9,10) CE(11,12) CE(13,14)
#define BMERGE16(T_) _Pragma("unroll") for (int d_ = 8; d_ >= 1; d_ >>= 1) { _Pragma("unroll") for (int i_ = 0; i_ < 16; ++i_) if ((i_ & d_) == 0) { const unsigned hi_ = max(T_[i_], T_[i_ + d_]), lo_ = min(T_[i_], T_[i_ + d_]); T_[i_] = hi_; T_[i_ + d_] = lo_; } }
#define KA key
        SORT16_NET
#undef KA
#define KA (key + 16)
        SORT16_NET
#undef KA
        unsigned t16[16];
#pragma unroll
        for (int i = 0; i < 16; ++i) t16[i] = max(key[i], key[31 - i]);
        BMERGE16(t16)
        { const bool odd = (lane & 16) != 0; unsigned L[16];
#pragma unroll
          for (int i = 0; i < 16; ++i) L[i] = odd ? t16[15 - i] : t16[i];
#pragma unroll
          for (int i = 0; i < 16; ++i) { auto x = __builtin_amdgcn_permlane16_swap(L[i], L[i], false, false); t16[i] = max(x[0], x[1]); }
          BMERGE16(t16) }
        { const bool odd = (lane & 32) != 0; unsigned L[16];
#pragma unroll
          for (int i = 0; i < 16; ++i) L[i] = odd ? t16[15 - i] : t16[i];
#pragma unroll
          for (int i = 0; i < 16; ++i) { auto x = __builtin_amdgcn_permlane32_swap(L[i], L[i], false, false); t16[i] = max(x[0], x[1]); }
          BMERGE16(t16) }
#undef CE
#undef SORT16_NET
#undef BMERGE16
        if (q4 == 0) {
#pragma unroll
            for (int r4 = 0; r4 < 4; ++r4) {
                *(LAS f32x4*)(sval + (tl * 2 + p) * 16 + 4 * r4) = (f32x4){key2f(t16[4 * r4] & ~127u), key2f(t16[4 * r4 + 1] & ~127u), key2f(t16[4 * r4 + 2] & ~127u), key2f(t16[4 * r4 + 3] & ~127u)};
                *(LAS v4u*)(sidx + (tl * 2 + p) * 16 + 4 * r4) = (v4u){127u - (t16[4 * r4] & 127u), 127u - (t16[4 * r4 + 1] & 127u), 127u - (t16[4 * r4 + 2] & 127u), 127u - (t16[4 * r4 + 3] & 127u)}; }
        }
    }
    __syncthreads();
    {
        const int it_ = wave; const int tt = tt0 + it_;
        LAS float* sval = (LAS float*)(lds + it_ * 16384); LAS int* sidx = (LAS int*)(lds + it_ * 16384 + 8192);
        if (wave < nitems) {
            const LAS float* av = sval + (lane * 2) * 16; const LAS float* bv = av + 16; const LAS int* ai = sidx + (lane * 2) * 16; const LAS int* bi = ai + 16;
            unsigned hk[16];
            const float b0 = bv[0];
#pragma unroll
            for (int i4 = 0; i4 < 4; ++i4) { const f32x4 t4 = *(const LAS f32x4*)(av + 4 * i4);
#pragma unroll
                for (int e = 0; e < 4; ++e) hk[4 * i4 + e] = (f2key(t4[e] + b0) & ~255u) | (unsigned)(255 - (4 * i4 + e) * 16); }
            float bestv[16]; int beste[16];
#pragma unroll
            for (int r = 0; r < 16; ++r) {
                unsigned m0 = umax3(hk[0], hk[1], hk[2]), m1 = umax3(hk[3], hk[4], hk[5]), m2 = umax3(hk[6], hk[7], hk[8]), m3 = umax3(hk[9], hk[10], hk[11]);
                m0 = umax3(m0, hk[12], hk[13]); m1 = umax3(m1, hk[14], hk[15]);
                const unsigned best = max(max(m0, m1), max(m2, m3));
                const int f = 255 - (int)(best & 255u), bi_ = f >> 4, bj = f & 15;
                const float a_i = av[bi_]; bestv[r] = a_i + bv[bj]; beste[r] = ai[bi_] * 128 + bi[bj];
                const int nj = bj + 1;
                const unsigned nk = nj < 16 ? ((f2key(a_i + bv[nj & 15]) & ~255u) | (unsigned)(255 - (bi_ * 16 + nj))) : 0u;
#pragma unroll
                for (int i = 0; i < 16; ++i) hk[i] = i == bi_ ? nk : hk[i];
            }
            float rsd; { const f32x4* sp = (const f32x4*)((const float*)(P.ws + WS_SSP) + ((size_t)tt * 64 + lane) * 32); float a = 0.f;
#pragma unroll
                for (int j = 0; j < 8; ++j) { const f32x4 v = sp[j]; a += (v.x + v.y) + (v.z + v.w); }
                rsd = 1.0f / sqrtf(a * (1.f / DM) + RMS_EPS); ((float*)(P.ws + WS_SSP + 2 * MiB))[(size_t)tt * 64 + lane] = rsd; }
            float se = 0.f; const float mx = bestv[0];
#pragma unroll
            for (int r = 0; r < 16; ++r) { bestv[r] = __expf((bestv[r] - mx) * rsd); se += bestv[r]; }
            const float ise = 1.f / se; const size_t o = ((size_t)tt * 64 + lane) * 128 + h * 16;
#pragma unroll
            for (int r4 = 0; r4 < 4; ++r4) { *(v4u*)(ridx + o + 4 * r4) = (v4u){(unsigned)beste[4 * r4], (unsigned)beste[4 * r4 + 1], (unsigned)beste[4 * r4 + 2], (unsigned)beste[4 * r4 + 3]};
                *(f32x4*)(rgate + o + 4 * r4) = (f32x4){bestv[4 * r4] * ise, bestv[4 * r4 + 1] * ise, bestv[4 * r4 + 2] * ise, bestv[4 * r4 + 3] * ise}; }
        }
        __syncthreads();
    }
}
#define XB_TMO      128
#define XB_XCNT(j)  (256  + 64 * (j))
#define XB_XSUB(j)  (1280 + 64 * (j))
#define XB_XGEN(j)  (2304 + 64 * (j))
#define XB_TOP      3328
#define XB_TOPGEN   3392
#define XCD_BAR_WORDS 3456
#define XB_SPIN_CAP (1u << 18)

__device__ __forceinline__ unsigned xb_ld(unsigned* p)              { return __hip_atomic_load(p, __ATOMIC_RELAXED, __HIP_MEMORY_SCOPE_AGENT); }
__device__ __forceinline__ unsigned xb_add(unsigned* p, unsigned v) { return __hip_atomic_fetch_add(p, v, __ATOMIC_RELAXED, __HIP_MEMORY_SCOPE_AGENT); }
__device__ __forceinline__ unsigned xb_xcc_id() { return (unsigned)__builtin_amdgcn_s_getreg((3 << 11) | 20) & 0xFu; }
#define XB_SPIN(cond, bar) do { unsigned _sp = 0; while (cond) { __builtin_amdgcn_s_sleep(1); \
    if ((++_sp & 255u) == 0u) { if (xb_ld(&(bar)[XB_TMO])) break; if (_sp > XB_SPIN_CAP) { atomicAdd(&(bar)[XB_TMO], 1u); break; } } } } while (0)

struct XcdBarrier {
    unsigned* bar; unsigned x;
    volatile LAS unsigned* st;
};

__device__ __forceinline__ XcdBarrier xcd_barrier_post(unsigned* bar, volatile LAS unsigned* st) {
    XcdBarrier b; b.bar = bar; b.x = xb_xcc_id(); b.st = st;
    if (threadIdx.x == 0) (void)xb_add(&bar[XB_XCNT(b.x)], 1u);
    return b;
}
__device__ __forceinline__ void xcd_barrier_complete(unsigned* bar, unsigned x, unsigned& nloc, unsigned& nx) {
    const unsigned G = gridDim.x * gridDim.y * gridDim.z;
    unsigned sum, cnt, mine, sp = 0u;
    for (;;) {
        sum = 0u; cnt = 0u; mine = 0u;
#pragma unroll
        for (unsigned j = 0; j < 16; ++j) { const unsigned c = xb_ld(&bar[XB_XCNT(j)]); sum += c; cnt += (c > 0u) ? 1u : 0u; mine = (j == x) ? c : mine; }
        if (sum == G) break;
        __builtin_amdgcn_s_sleep(1);
        if ((++sp & 255u) == 0u) { if (xb_ld(&bar[XB_TMO])) break; if (sp > XB_SPIN_CAP) { atomicAdd(&bar[XB_TMO], 1u); break; } }
    }
    nloc = mine > 0u ? mine : 1u; nx = cnt > 0u ? cnt : 1u;
}

__device__ __forceinline__ void xcd_barrier(const XcdBarrier& b) {
    asm volatile("s_waitcnt vmcnt(0)" ::: "memory");
    __syncthreads();
    if (threadIdx.x == 0) {
        unsigned* bar = b.bar;
        __builtin_amdgcn_s_waitcnt(0);
        unsigned nloc = b.st[0], nx = b.st[1];
        if (nloc == 0u) { xcd_barrier_complete(bar, b.x, nloc, nx); b.st[0] = nloc; b.st[1] = nx; }
        const unsigned old = xb_add(&bar[XB_XSUB(b.x)], 1u);
        const unsigned gen = old / nloc;
        if (old + 1u == (gen + 1u) * nloc) {
            __builtin_amdgcn_fence(__ATOMIC_RELEASE, "agent");
            asm volatile("s_waitcnt vmcnt(0)" ::: "memory");
            const unsigned og = xb_add(&bar[XB_TOP], 1u);
            const unsigned tg = og / nx;
            if (og + 1u == (tg + 1u) * nx) xb_add(&bar[XB_TOPGEN], 1u);
            else XB_SPIN(xb_ld(&bar[XB_TOPGEN]) == tg, bar);
            __builtin_amdgcn_fence(__ATOMIC_ACQUIRE, "agent");
            xb_add(&bar[XB_XGEN(b.x)], 1u);
            asm volatile("s_waitcnt vmcnt(0)" ::: "memory");
        } else {
            XB_SPIN(xb_ld(&bar[XB_XGEN(b.x)]) == gen, bar);
            __builtin_amdgcn_fence(__ATOMIC_ACQUIRE, "agent");
            asm volatile("s_waitcnt vmcnt(0)" ::: "memory");
        }
    }
    __syncthreads();
}
#ifndef MK_ONE_LAUNCH
#define MK_ONE_LAUNCH 1
#endif
constexpr int N_PHASES = 11;
__global__ void __launch_bounds__(NTHR, 2) mega(Params Pkernarg) {
    extern __shared__ __attribute__((aligned(16))) unsigned char lds_raw[];
    LAS unsigned char* lds = (LAS unsigned char*)lds_raw;
    const int tid = ltid();
    const int G = gridDim.x, bx = blockIdx.x; const int vcu = (G % 8 == 0) ? (bx % 8) * (G / 8) + bx / 8 : bx;
    for (int u = tid; u < (LDS_BYTES - LDSCTL_OFF) / 4; u += NTHR) ((LAS unsigned*)(lds + LDSCTL_OFF))[u] = 0u;
    __syncthreads();
#if MK_ONE_LAUNCH
    XcdBarrier bar = xcd_barrier_post((unsigned*)(params_ptr()->ws + WS_CTL) + CW_BAR + params_ptr()->bar_li * XCD_BAR_WORDS, (volatile LAS unsigned*)(lds + MISC_OFF) + 8);
#define GRID_BAR() xcd_barrier(bar)
#else
#define GRID_BAR() do {} while (0)
#endif
#ifndef PHOFF
#define PHOFF 0
#endif
#define IN(k) (!((PHOFF >> (k)) & 1))
#define BOTH(k) (IN(k) && IN((k) + 1))
    if (IN(0)) { KP P = *params_ptr(); phase_prologue(P, lds, vcu, G); prologue_subkeys(P, vcu, G); prologue_lora(P, vcu, G); if (BOTH(0)) GRID_BAR(); }
    if (IN(1)) { KP P = *params_ptr();
        pg8::Gemm g{(const bf16*)(P.ws + WS_XN), (const bf16*)(P.ws + WS_WIN), TT, INCP, DM}; pg8::Order1 S; S.init(TT, INCP, G, bx);
        pg8::EpiBf16<0> E{(bf16*)(P.ws + WS_PROJ), INCP, nullptr, 0, 0, 1.f};
        pg8::gemm_phase<pg8::EpiBf16<0>, pg8::Order1, true, true>(lds, g, S, E);
        phase_convert_tables(P, lds); phase_transpose_late(P, lds);
        if (BOTH(1)) GRID_BAR();
    }
    if (IN(2)) { KP P = *params_ptr(); phase_act(P, vcu, G); phase_kmean(P, lds, vcu, G); if (BOTH(2)) GRID_BAR(); }
    if (IN(3)) { KP P = *params_ptr(); phase_rwkv_stage_a(P, lds, vcu, G); if (BOTH(3)) GRID_BAR(); }
    if (IN(4)) { KP P = *params_ptr(); if ((vcu & 15) < 2 && vcu < 256) rwkv_stage_b(P, lds, (vcu >> 4) * 2 + (vcu & 15)); phase_moba(P, (char*)lds_raw, vcu, G); }
    if (IN(5)) { GRID_BAR(); KP P = *params_ptr(); moba_combine(P, vcu, G); GRID_BAR(); }
    if (IN(6)) { KP P = *params_ptr();
        pg8::Gemm g{(const bf16*)(P.ws + WS_AR), (const bf16*)(P.ws + WS_WOUT), TT, DM, DM}; pg8::StaticOrder S; S.init(TT, DM, G, bx);
        pg8::EpiH E{P.x, (bf16*)(P.ws + WS_XN), (float*)(P.ws + WS_SSP), DM};
        pg8::gemm_phase<pg8::EpiH, pg8::StaticOrder, true, true>(lds, g, S, E);
        if (BOTH(6)) GRID_BAR();
    }
    if (IN(8)) { KP P = *params_ptr();
        pg8::Gemm g{(const bf16*)(P.ws + WS_XN), (const bf16*)(P.ws + WS_WQ), TT, DM, DM}; pg8::StaticOrder S; S.init(TT, DM, G, bx);
        pg8::EpiBf16<0> E{(bf16*)(P.ws + WS_PROJ), DM, nullptr, 0, 0, 1.f};
        pg8::gemm_phase<pg8::EpiBf16<0>, pg8::StaticOrder, true, true>(lds, g, S, E);
        if (G == 256) { const int wg_ = (bx & 7) * 32 + (bx >> 3); pg8::Unit u; u.pm = (wg_ >> 6) * 8 + (wg_ & 7); u.pn = (wg_ & 63) >> 3;
            asm volatile("s_waitcnt vmcnt(0)" ::: "memory"); __syncthreads(); __builtin_amdgcn_fence(__ATOMIC_ACQUIRE, "agent"); asm volatile("s_waitcnt vmcnt(0)" ::: "memory");
            peer_route_tiles(P, lds, 4 * u.pm, 4, u.pn);
        } else if (G != 256) { GRID_BAR(); for (int item = vcu; item < 1024; item += G) peer_route_tiles(P, lds, item >> 3, 1, item & 7); }
        if (BOTH(8)) GRID_BAR();
    }
    if (IN(10)) { KP P = *params_ptr(); phase_peer_sliced(P, lds, bx, G); }
#undef IN
#undef BOTH
}

extern "C" void kernel_launch(void* const* d_in, const int* in_sizes, int n_in, void* d_out, int out_size, void* d_ws, size_t ws_size, hipStream_t stream) {
    static int grid = 0;
    if (grid == 0) {
        if (n_in != 21 || in_sizes[0] != TT * DM || out_size != TT * DM || ws_size < WS_END) {
            fprintf(stderr, "kernel_launch: unexpected shapes: n_in %d in0 %d out %d ws %zu\n", n_in, n_in > 0 ? in_sizes[0] : -1, out_size, ws_size); grid = -1; return; }
        int dev = 0, cus = 0;
        if (hipGetDevice(&dev) != hipSuccess || hipDeviceGetAttribute(&cus, hipDeviceAttributeMultiprocessorCount, dev) != hipSuccess) { grid = -1; return; }
        if (hipFuncSetAttribute((const void*)mega, hipFuncAttributeMaxDynamicSharedMemorySize, LDS_BYTES) != hipSuccess) { fprintf(stderr, "kernel_launch: hipFuncSetAttribute failed\n"); grid = -1; return; }
        int per_cu = 0;
        if (hipOccupancyMaxActiveBlocksPerMultiprocessor(&per_cu, (const void*)mega, NTHR, LDS_BYTES) != hipSuccess || per_cu < 1) fprintf(stderr, "kernel_launch: occupancy query says %d blocks per CU\n", per_cu);
        (void)hipGetLastError();
        grid = cus;
    }
    if (grid < 0) return;
    (void)hipMemsetAsync((char*)d_ws + WS_CTL, 0, CTL_ZERO_BYTES, stream);
    Params p{};
    p.x = (const float*)d_in[0]; p.norm1_g = (const float*)d_in[1]; p.w_in = (const float*)d_in[2]; p.mu = (const float*)d_in[3]; p.w0 = (const float*)d_in[4];
    p.w2 = (const float*)d_in[5]; p.a0 = (const float*)d_in[6]; p.a2 = (const float*)d_in[7]; p.g2 = (const float*)d_in[8]; p.k_k = (const float*)d_in[9];
    p.k_a = (const float*)d_in[10]; p.r_k = (const float*)d_in[11]; p.ln_g = (const float*)d_in[12]; p.ln_b = (const float*)d_in[13]; p.w_out = (const float*)d_in[14];
    p.norm2_g = (const float*)d_in[15]; p.wq = (const float*)d_in[16]; p.sub_keys = (const float*)d_in[17]; p.pu = (const float*)d_in[18]; p.pv = (const float*)d_in[19];
    p.final_g = (const float*)d_in[20]; p.out = (float*)d_out; p.ws = (unsigned char*)d_ws;
    p.ph_lo = 0; p.ph_hi = N_PHASES; p.bar_li = 0;
    hipLaunchKernelGGL(mega, dim3(grid), dim3(NTHR), LDS_BYTES, stream, p);
}
```

```cpp
#include <hip/hip_runtime.h>
#include <cstdio>
#include <cstdint>

__device__ __forceinline__ int ltid() { int t = threadIdx.x; asm volatile("" : "+v"(t)); return t; }
namespace pg8 {
#define PG8_LAS __attribute__((address_space(3)))
typedef unsigned short bf16_t;
typedef short bf16x8 __attribute__((ext_vector_type(8)));
typedef float f32x4 __attribute__((ext_vector_type(4)));
typedef unsigned u32x4 __attribute__((ext_vector_type(4)));
constexpr int BM = 256, BK = 64, HALF = 128, HTB = HALF * BK * 2  , STAGE_BYTES = 8 * HTB, NXCD = 8, WGM = 8;

__host__ __device__ __forceinline__ int lds_byte(int r, int c) { const int st = (r >> 4) * 2 + (c >> 5), rr = r & 15, cc = c & 31, ob = rr * 64 + cc * 2; return st * 1024 + (ob ^ (((ob >> 9) & 1) << 5)); }
__host__ __device__ __forceinline__ void stage_rc(int b, int& R, int& C) { const int st = b / 1024, sb = b % 1024, swz = sb ^ (((sb >> 9) & 1) << 5); R = (st >> 1) * 16 + swz / 64; C = (st & 1) * 32 + (swz % 64) / 2; }
__host__ __device__ __forceinline__ int perm32(int rho) { const int n = rho >> 4, i = rho & 15; return 8 * (i >> 2) + 4 * n + (i & 3); }

struct Unit { int pm, pn; };
struct Gemm { const bf16_t* A; const bf16_t* Bt; int M, N, K; };

struct StaticOrder {
    int nM, nN, nwg, G, c;
    __host__ __device__ void init(int M, int N, int G_, int c_) { nM = M / BM; nN = N / BM; nwg = nM * nN; G = G_; c = c_; }
    __host__ __device__ bool next(int i, Unit& u) const {
        const long L = (long)i * G + c; if (L >= nwg) return false;
        int wgid = (int)L; { const int q = nwg / NXCD, r = nwg % NXCD, xcd = wgid % NXCD, off = wgid / NXCD; wgid = (xcd < r ? xcd * (q + 1) : r * (q + 1) + (xcd - r) * q) + off; }
        const int nig = WGM * nN, gid = wgid / nig, fm = gid * WGM, gsz = (nM - fm) < WGM ? (nM - fm) : WGM;
        u.pm = fm + ((wgid % nig) % gsz); u.pn = (wgid % nig) / gsz; return true;
    }
    __device__ __forceinline__ void a_ready(const Unit&) const {}
    __device__ __forceinline__ void done(const Unit&) const {}
};

__device__ __forceinline__ unsigned cvt_pk_bf16(float lo, float hi) { unsigned r; asm volatile("v_cvt_pk_bf16_f32 %0, %1, %2" : "=v"(r) : "v"(lo), "v"(hi)); return r; }
typedef float f32x2 __attribute__((ext_vector_type(2)));
__device__ __forceinline__ f32x2 gelu_pk(f32x2 v) {
    const f32x2 av = __builtin_elementwise_abs(v), d = av * 0.2316418882f + 1.0f;
    f32x2 t; t.x = __builtin_amdgcn_rcpf(d.x); t.y = __builtin_amdgcn_rcpf(d.y);
    f32x2 q = t * 0.5307027145f + (-0.7265760135f); q = q * t + 0.7107068705f; q = q * t + (-0.142248368f); q = q * t + 0.127414796f; q = q * t;
    const f32x2 s = (v * v) * (-0.72134752044f);
    f32x2 e; e.x = __builtin_amdgcn_exp2f(s.x); e.y = __builtin_amdgcn_exp2f(s.y);
    const f32x2 m = v * (q * e), r = v - m;
    f32x2 o; o.x = v.x < 0.f ? m.x : r.x; o.y = v.y < 0.f ? m.y : r.y; return o;
}

template <int ACT  > struct EpiBf16 {
    static constexpr bool PERM = true, AFTER_DRAIN = false; static_assert(ACT == 0 || ACT == 1, "EpiBf16: ACT is 0 (none) or 1 (gelu_pk)");
    bf16_t* O; int ldc; const float* bias; int split_cols; size_t split_stride; float scale0;
    __device__ __forceinline__ void operator()(const f32x4 (&acc)[2][2][4][2], const Unit& u, int wr, int wc, int fr, int fq) const {
        const int row0 = u.pm * BM + wr * 64 + fr; int colt = u.pn * BM; bf16_t* base = O;
        float sc = 1.f; if (split_cols) { const int t = colt / split_cols; base += (size_t)t * split_stride; colt -= t * split_cols; if (t == 0) sc = scale0; }
        const int col0 = colt + wc * 32 + 8 * fq, bcol0 = u.pn * BM + wc * 32 + 8 * fq;
        f32x4 bv[2][2];
#pragma unroll
        for (int bj = 0; bj < 2; ++bj)
#pragma unroll
            for (int n = 0; n < 2; ++n) bv[bj][n] = bias ? *(const f32x4*)(bias + bcol0 + bj * HALF + 4 * n) : (f32x4){0.f, 0.f, 0.f, 0.f};
#pragma unroll
        for (int ai = 0; ai < 2; ++ai)
#pragma unroll
            for (int m = 0; m < 4; ++m) { bf16_t* rowp = base + (size_t)(row0 + ai * HALF + m * 16) * ldc + col0;
#pragma unroll
                for (int bj = 0; bj < 2; ++bj) { f32x4 v0 = acc[ai][bj][m][0] + bv[bj][0], v1 = acc[ai][bj][m][1] + bv[bj][1];
                    if (ACT == 1) { f32x2 a = gelu_pk((f32x2){v0[0], v0[1]}), b = gelu_pk((f32x2){v0[2], v0[3]}), c = gelu_pk((f32x2){v1[0], v1[1]}), d = gelu_pk((f32x2){v1[2], v1[3]});
                        v0 = (f32x4){a.x, a.y, b.x, b.y}; v1 = (f32x4){c.x, c.y, d.x, d.y}; }
                    v0 = v0 * sc; v1 = v1 * sc; u32x4 w; w.x = cvt_pk_bf16(v0[0], v0[1]); w.y = cvt_pk_bf16(v0[2], v0[3]); w.z = cvt_pk_bf16(v1[0], v1[1]); w.w = cvt_pk_bf16(v1[2], v1[3]);
                    *(u32x4*)(rowp + bj * HALF) = w; } }
    }
};
template <class Epi, class Sched, bool ALIGN_EPI = false, bool SP2 = false>
__device__ __forceinline__ void gemm_phase(PG8_LAS unsigned char* lds, const Gemm g, const Sched& S, const Epi& E) {
    const int tid = ltid(), wid = __builtin_amdgcn_readfirstlane(tid >> 6), lane = tid & 63, wr = wid >> 2, wc = wid & 3, fr = lane & 15, fq = lane >> 4;
    const int K = g.K, nt = K / BK;
    unsigned voffA[2], voffB[2];
#pragma unroll
    for (int i = 0; i < 2; ++i) { int R, C; stage_rc(tid * 16 + i * 8192, R, C); const int Rb = Epi::PERM ? ((R & ~31) + perm32(R & 31)) : R;
        voffA[i] = (unsigned)(R * K + C) * 2u; voffB[i] = (unsigned)(Rb * K + C) * 2u; }
    const size_t kstep = (size_t)(BK * 2);
    const size_t hstep = (size_t)HALF * K * 2;
    const size_t tstep = 2 * hstep;
    const unsigned ldsw = (unsigned)wid * 1024u;
    const int aoff = lds_byte(wr * 64 + fr, fq * 8), boff = lds_byte(wc * 32 + fr, fq * 8);
#define PG8_SA(b, h) (((b) * 2 + (h)) * HTB)
#define PG8_SB(b, h) ((4 + (b) * 2 + (h)) * HTB)
#define PG8_STAGE(bufoff, gbase, voff) do { _Pragma("unroll") for (int _i = 0; _i < 2; ++_i) \
        __builtin_amdgcn_global_load_lds((const unsigned*)((const char*)(gbase) + (voff)[_i]), (PG8_LAS unsigned*)(lds + (bufoff) + ldsw + _i * 8192), 16, 0, 0); } while (0)
#define PG8_LDA(dst, b, h) do { _Pragma("unroll") for (int m = 0; m < 4; ++m) _Pragma("unroll") for (int k = 0; k < 2; ++k) dst[m][k] = *(const PG8_LAS bf16x8*)(lds + PG8_SA(b, h) + aoff + m * 2048 + k * 1024); } while (0)
#define PG8_LDB(dst, b, h) do { _Pragma("unroll") for (int n = 0; n < 2; ++n) _Pragma("unroll") for (int k = 0; k < 2; ++k) dst[n][k] = *(const PG8_LAS bf16x8*)(lds + PG8_SB(b, h) + boff + n * 2048 + k * 1024); } while (0)
#define PG8_MMA(ai, bj, At, Bt) do { __builtin_amdgcn_s_setprio(1); _Pragma("unroll") for (int m = 0; m < 4; ++m) _Pragma("unroll") for (int n = 0; n < 2; ++n) _Pragma("unroll") for (int k = 0; k < 2; ++k) \
        acc[ai][bj][m][n] = __builtin_amdgcn_mfma_f32_16x16x32_bf16(Bt[n][k], At[m][k], acc[ai][bj][m][n], 0, 0, 0); __builtin_amdgcn_s_setprio(0); } while (0)
#define PG8_WAIT_V(n) asm volatile("s_waitcnt vmcnt(" #n ")" ::: "memory")
#define PG8_WAIT_L(n) asm volatile("s_waitcnt lgkmcnt(" #n ")" ::: "memory")
#define PG8_BAR __builtin_amdgcn_s_barrier()
#define PG8_SCHED __builtin_amdgcn_sched_barrier(0)
    Unit cur, nxt; int ui = 0;
    if (!S.next(0, cur)) return;
    f32x4 acc[2][2][4][2];
#pragma unroll
    for (int a = 0; a < 2; ++a)
#pragma unroll
        for (int b = 0; b < 2; ++b)
#pragma unroll
            for (int m = 0; m < 4; ++m)
#pragma unroll
                for (int n = 0; n < 2; ++n) acc[a][b][m][n] = (f32x4){0.f, 0.f, 0.f, 0.f};
    bf16x8 At[4][2], B0[2][2], B1[2][2];
    const char* cA = (const char*)g.A + (size_t)cur.pm * tstep; const char* cB = (const char*)g.Bt + (size_t)cur.pn * tstep;
    S.a_ready(cur);
    if constexpr (SP2) {
        PG8_STAGE(PG8_SB(0, 0), cB, voffB); PG8_STAGE(PG8_SB(0, 1), cB + hstep, voffB); PG8_STAGE(PG8_SA(0, 0), cA, voffA); PG8_STAGE(PG8_SA(0, 1), cA + hstep, voffA);
        if (wr == 1) PG8_BAR;
        PG8_WAIT_V(2); PG8_BAR;
        PG8_STAGE(PG8_SB(1, 0), cB + kstep, voffB); PG8_STAGE(PG8_SA(1, 0), cA + kstep, voffA); PG8_STAGE(PG8_SB(1, 1), cB + hstep + kstep, voffB);
        PG8_WAIT_V(6); PG8_BAR;
    } else {
        PG8_STAGE(PG8_SB(0, 0), cB, voffB); PG8_STAGE(PG8_SA(0, 0), cA, voffA); PG8_STAGE(PG8_SB(0, 1), cB + hstep, voffB); PG8_STAGE(PG8_SA(0, 1), cA + hstep, voffA);
        if (wr == 1) PG8_BAR;
        PG8_WAIT_V(4); PG8_BAR;
        PG8_STAGE(PG8_SB(1, 0), cB + kstep, voffB); PG8_STAGE(PG8_SA(1, 0), cA + kstep, voffA); PG8_STAGE(PG8_SB(1, 1), cB + hstep + kstep, voffB);
        PG8_WAIT_V(6); PG8_BAR;
    }
    for (;;) {
        const bool has_next = S.next(ui + 1, nxt);
        const char* nA = has_next ? (const char*)g.A + (size_t)nxt.pm * tstep : cA; const char* nB = has_next ? (const char*)g.Bt + (size_t)nxt.pn * tstep : cB;
        for (int t = 0; t < nt; t += 2) {
            const bool last = (t == nt - 2);
            const char* a1 = cA + (size_t)(t + 1) * kstep;
            const char* a2 = last ? nA : cA + (size_t)(t + 2) * kstep; const char* b2 = last ? nB : cB + (size_t)(t + 2) * kstep;
            const char* a3 = a2 + kstep; const char* b3 = b2 + kstep;
            if (last && has_next) S.a_ready(nxt);
            if constexpr (SP2) {
            PG8_LDB(B0, 0, 0); PG8_LDB(B1, 0, 1); PG8_SCHED; PG8_LDA(At, 0, 0); PG8_STAGE(PG8_SA(1, 1), a1 + hstep, voffA);
            PG8_WAIT_V(8); PG8_WAIT_L(0); PG8_BAR; PG8_MMA(0, 0, At, B0); PG8_MMA(0, 1, At, B1); PG8_BAR; PG8_SCHED;
            PG8_LDA(At, 0, 1); PG8_STAGE(PG8_SB(0, 0), b2, voffB); PG8_STAGE(PG8_SB(0, 1), b2 + hstep, voffB); PG8_STAGE(PG8_SA(0, 0), a2, voffA);
            PG8_WAIT_V(8); PG8_WAIT_L(0); PG8_BAR; PG8_MMA(1, 0, At, B0); PG8_MMA(1, 1, At, B1); PG8_BAR; PG8_SCHED;
            PG8_LDB(B0, 1, 0); PG8_LDB(B1, 1, 1); PG8_SCHED; PG8_LDA(At, 1, 0); PG8_STAGE(PG8_SA(0, 1), a2 + hstep, voffA);
            PG8_WAIT_V(8); PG8_WAIT_L(0); PG8_BAR; PG8_MMA(0, 0, At, B0); PG8_MMA(0, 1, At, B1); PG8_BAR; PG8_SCHED;
            PG8_LDA(At, 1, 1); PG8_STAGE(PG8_SB(1, 0), b3, voffB); PG8_STAGE(PG8_SB(1, 1), b3 + hstep, voffB); PG8_STAGE(PG8_SA(1, 0), a3, voffA);
            PG8_WAIT_V(8); PG8_WAIT_L(0); PG8_BAR; PG8_MMA(1, 0, At, B0); PG8_MMA(1, 1, At, B1); PG8_BAR; PG8_SCHED;
            } else {
            PG8_LDB(B0, 0, 0); PG8_SCHED; PG8_LDA(At, 0, 0); PG8_STAGE(PG8_SA(1, 1), a1 + hstep, voffA);
            PG8_WAIT_L(8); PG8_BAR; PG8_WAIT_L(0); PG8_MMA(0, 0, At, B0); PG8_BAR; PG8_SCHED;
            PG8_LDB(B1, 0, 1); PG8_STAGE(PG8_SB(0, 0), b2, voffB);
            PG8_BAR; PG8_WAIT_L(0); PG8_MMA(0, 1, At, B1); PG8_BAR;
            PG8_LDA(At, 0, 1); PG8_STAGE(PG8_SA(0, 0), a2, voffA);
            PG8_BAR; PG8_WAIT_L(0); PG8_MMA(1, 0, At, B0); PG8_BAR; PG8_SCHED;
            PG8_STAGE(PG8_SB(0, 1), b2 + hstep, voffB);
            PG8_WAIT_V(6); PG8_BAR; PG8_MMA(1, 1, At, B1); PG8_BAR;
            PG8_LDB(B0, 1, 0); PG8_SCHED; PG8_LDA(At, 1, 0); PG8_STAGE(PG8_SA(0, 1), a2 + hstep, voffA);
            PG8_WAIT_L(8); PG8_BAR; PG8_WAIT_L(0); PG8_MMA(0, 0, At, B0); PG8_BAR; PG8_SCHED;
            PG8_LDB(B1, 1, 1); PG8_STAGE(PG8_SB(1, 0), b3, voffB);
            PG8_BAR; PG8_WAIT_L(0); PG8_MMA(0, 1, At, B1); PG8_BAR;
            PG8_LDA(At, 1, 1); PG8_STAGE(PG8_SA(1, 0), a3, voffA);
            PG8_BAR; PG8_WAIT_L(0); PG8_MMA(1, 0, At, B0); PG8_BAR; PG8_SCHED;
            PG8_STAGE(PG8_SB(1, 1), b3 + hstep, voffB);
            PG8_WAIT_V(6); PG8_BAR; PG8_MMA(1, 1, At, B1); PG8_BAR;
            }
        }
        if constexpr (ALIGN_EPI) { if (wr == 0) PG8_BAR; }
        if constexpr (!Epi::AFTER_DRAIN) { E(acc, cur, wr, wc, fr, fq); S.done(cur); }
        if (!has_next) break;
#pragma unroll
        for (int a = 0; a < 2; ++a)
#pragma unroll
            for (int b = 0; b < 2; ++b)
#pragma unroll
                for (int m = 0; m < 4; ++m)
#pragma unroll
                    for (int n = 0; n < 2; ++n) acc[a][b][m][n] = (f32x4){0.f, 0.f, 0.f, 0.f};
        cur = nxt; cA = nA; cB = nB; ++ui;
        if constexpr (ALIGN_EPI) { if (wr == 1) PG8_BAR; }
    }
    PG8_WAIT_V(0);
    if constexpr (!ALIGN_EPI) { if (wr == 0) PG8_BAR; }
    PG8_BAR;
    if constexpr (Epi::AFTER_DRAIN) { E.fused(acc, cur, wr, wc, fr, fq, lds, wid, lane); S.done(cur); }
#undef PG8_SA
#undef PG8_SB
#undef PG8_STAGE
#undef PG8_LDA
#undef PG8_LDB
#undef PG8_MMA
#undef PG8_WAIT_V
#undef PG8_WAIT_L
#undef PG8_BAR
#undef PG8_SCHED
}
}
#define GAS __attribute__((address_space(1)))
#define LAS __attribute__((address_space(3)))
typedef unsigned short bf16;
typedef unsigned v4u __attribute__((ext_vector_type(4)));
typedef unsigned v2u __attribute__((ext_vector_type(2)));
typedef float f32x4 __attribute__((ext_vector_type(4)));
constexpr int NWAVES = 8, NTHR = 512;
constexpr int TT = 8192, DM = 2048, SEQ = 4096;
constexpr int INC = 6592, INCP = 6656;
constexpr int C_AK = 1024, C_AV = 2048, C_RW = 3072;
constexpr int RWC = 3520;
constexpr float RMS_EPS = 1e-6f;
constexpr size_t MiB = 1u << 20;
constexpr size_t WS_CTL = 0, CTL_ZERO_BYTES = 1 * MiB;
constexpr size_t WS_WIN = 1 * MiB;
constexpr size_t WS_WOUT = 27 * MiB;
constexpr size_t WS_WQ = 35 * MiB;
constexpr size_t WS_XN = 43 * MiB;
constexpr size_t WS_PROJ = 75 * MiB;
constexpr size_t WS_AR = 179 * MiB;
constexpr size_t WS_H = 211 * MiB;
constexpr size_t WS_RWA = 275 * MiB;
constexpr size_t WS_CHK = 339 * MiB;
constexpr size_t WS_KMEAN = 467 * MiB;
constexpr size_t WS_ACT = WS_H;
constexpr size_t WS_SSP = WS_WIN + 4 * MiB;
constexpr size_t WS_LORA = 468 * MiB;
constexpr size_t WS_END = 469 * MiB;
constexpr int CW_BAR = 4096, CW_MOBA_CTR = 16384, CW_SS = 32768;
constexpr int RING_BYTES = 147456, LDSCTL_OFF = RING_BYTES, MISC_OFF = LDSCTL_OFF + 320, LDS_BYTES = 163840;

struct Params {
    const float* x; const float* norm1_g; const float* w_in; const float* mu; const float* w0; const float* w2; const float* a0; const float* a2; const float* g2;
    const float* k_k; const float* k_a; const float* r_k; const float* ln_g; const float* ln_b; const float* w_out; const float* norm2_g; const float* wq;
    const float* sub_keys; const float* pu; const float* pv; const float* final_g;
    float* out; unsigned char* ws;
    int ph_lo, ph_hi, bar_li, pad;
};

typedef const __attribute__((address_space(4))) Params& KP;
__device__ __forceinline__ const __attribute__((address_space(4))) Params* params_ptr() {
    const __attribute__((address_space(4))) Params* ka = (const __attribute__((address_space(4))) Params*)__builtin_amdgcn_kernarg_segment_ptr(); asm volatile("" : "+s"(ka)); return ka; }
typedef float f32x2_t __attribute__((ext_vector_type(2))); typedef __bf16 bf16x2_t __attribute__((ext_vector_type(2)));
__device__ __forceinline__ unsigned pk2(float lo, float hi) { const f32x2_t v = {lo, hi}; const bf16x2_t b = __builtin_convertvector(v, bf16x2_t); return __builtin_bit_cast(unsigned, b); }
__device__ __forceinline__ unsigned f2bf(float f) { return pk2(f, 0.f) & 0xffffu; }
__device__ __forceinline__ float bf2f(bf16 v) { return __builtin_bit_cast(float, (unsigned)v << 16); }
__device__ __forceinline__ float bflo(unsigned u) { return __builtin_bit_cast(float, u << 16); }
__device__ __forceinline__ float bfhi(unsigned u) { return __builtin_bit_cast(float, u & 0xffff0000u); }
#define DPP_F(v, ctrl) __builtin_bit_cast(float, __builtin_amdgcn_update_dpp(0, __builtin_bit_cast(int, (v)), (ctrl), 0xf, 0xf, true))
__device__ __forceinline__ float wave_sum(float v) {
    v += DPP_F(v, 0xB1);
    v += DPP_F(v, 0x4E);
    v += DPP_F(v, 0x141);
    v += DPP_F(v, 0x140);
    const int b = __builtin_bit_cast(int, v);
    return (__builtin_bit_cast(float, __builtin_amdgcn_readlane(b, 0)) + __builtin_bit_cast(float, __builtin_amdgcn_readlane(b, 16))) +
           (__builtin_bit_cast(float, __builtin_amdgcn_readlane(b, 32)) + __builtin_bit_cast(float, __builtin_amdgcn_readlane(b, 48)));
}
__device__ __forceinline__ float wave_max(float v) {
#pragma unroll
    for (int o = 1; o < 64; o <<= 1) v = fmaxf(v, __shfl_xor(v, o));
    return v;
}
#define LDS_WAIT() asm volatile("s_waitcnt lgkmcnt(0)" ::: "memory")

__device__ __forceinline__ void p0_transpose_item(const float* W, int K, int N, bf16* WT, LAS float* scr, int item, int lane, const float* ksc = nullptr) {
    const int nblk = N / 32, kb = item / nblk, nb = item % nblk, k0 = 64 * kb, n0 = 32 * nb;
    float wv[32];
#pragma unroll
    for (int i = 0; i < 32; ++i) wv[i] = __builtin_nontemporal_load(W + (size_t)(k0 + 2 * i + (lane >> 5)) * N + n0 + (lane & 31));
#pragma unroll
    for (int i = 0; i < 32; ++i) { const int kk = 2 * i + (lane >> 5); scr[kk * 33 + (lane & 31)] = ksc ? wv[i] * ksc[k0 + kk] : wv[i]; }
    LDS_WAIT(); asm volatile("" ::: "memory");
    const int c = lane & 7;
#pragma unroll
    for (int j = 0; j < 4; ++j) { const int n = (lane >> 3) + 8 * j; const LAS float* s = scr + (8 * c) * 33 + n;
        v4u o; o.x = pk2(s[0 * 33], s[1 * 33]); o.y = pk2(s[2 * 33], s[3 * 33]); o.z = pk2(s[4 * 33], s[5 * 33]); o.w = pk2(s[6 * 33], s[7 * 33]);
        *(v4u*)(WT + (size_t)(n0 + n) * K + k0 + 8 * c) = o; }
    LDS_WAIT(); asm volatile("" ::: "memory");
}
__device__ __forceinline__ void rms_row_to_bf16(const float* xrow, const float* g, bf16* orow, int lane) {
    const f32x4* xr = (const f32x4*)xrow + lane;
    f32x4 v[8]; float s = 0.f;
#pragma unroll
    for (int j = 0; j < 8; ++j) { v[j] = __builtin_nontemporal_load(xr + 64 * j); s += (v[j].x * v[j].x + v[j].y * v[j].y) + (v[j].z * v[j].z + v[j].w * v[j].w); }
    const float rs = 1.0f / sqrtf(wave_sum(s) * (1.f / DM) + RMS_EPS);
    v2u* o8 = (v2u*)orow + lane;
#pragma unroll
    for (int j = 0; j < 8; ++j) { const f32x4 gg = ((const f32x4*)g)[lane + 64 * j];
        v2u o; o.x = pk2(v[j].x * rs * gg.x, v[j].y * rs * gg.y); o.y = pk2(v[j].z * rs * gg.z, v[j].w * rs * gg.w); o8[64 * j] = o; }
}
__device__ __forceinline__ void phase_prologue(KP P, LAS unsigned char* lds, int vcu, int G) {
    const int tid = ltid(), lane = tid & 63, wave = tid >> 6;
    LAS float* scr = (LAS float*)(lds + wave * 16384);
    const int gw = vcu * NWAVES + wave, NGW = G * NWAVES;
    bf16* WIN = (bf16*)(P.ws + WS_WIN); bf16* XN = (bf16*)(P.ws + WS_XN);
    constexpr int I_IN = (DM / 64) * (INC / 32);
    for (int it = gw; it < I_IN; it += NGW) p0_transpose_item(P.w_in, DM, INC, WIN, scr, it, lane);
    for (int i = vcu * NTHR + tid; i < (INCP - INC) * DM / 8; i += G * NTHR) ((v4u*)(WIN + (size_t)INC * DM))[i] = (v4u){0u, 0u, 0u, 0u};
    for (int m = gw; m < TT; m += NGW) rms_row_to_bf16(P.x + (size_t)m * DM, P.norm1_g, XN + (size_t)m * DM, lane);
}
__device__ __forceinline__ void phase_transpose_late(KP P, LAS unsigned char* lds) {
    const int tid = ltid(), lane = tid & 63, wave = tid >> 6;
    constexpr int I_SQ = (DM / 64) * (DM / 32), NTK = 2 * I_SQ / NWAVES;
    unsigned* ctr = (unsigned*)(P.ws + WS_CTL) + CW_MOBA_CTR + 16; LAS int* slot = (LAS int*)(lds + 8 * 16384); LAS float* scr = (LAS float*)(lds + wave * 16384);
    __syncthreads();
    if (tid == 0) slot[0] = (int)__hip_atomic_fetch_add(ctr, 1u, __ATOMIC_RELAXED, __HIP_MEMORY_SCOPE_AGENT);
    __syncthreads();
    for (int it = 0;; ++it) {
        const int c = slot[it & 1]; if (c >= NTK) break;
        if (tid == 0) slot[(it & 1) ^ 1] = (int)__hip_atomic_fetch_add(ctr, 1u, __ATOMIC_RELAXED, __HIP_MEMORY_SCOPE_AGENT);
        const int r = c * NWAVES + wave;
        if (r < I_SQ) p0_transpose_item(P.w_out, DM, DM, (bf16*)(P.ws + WS_WOUT), scr, r, lane);
        else p0_transpose_item(P.wq, DM, DM, (bf16*)(P.ws + WS_WQ), scr, r - I_SQ, lane, P.norm2_g);
        __syncthreads();
    }
}

namespace pg8 {
struct EpiF32 {
    static constexpr bool PERM = false, AFTER_DRAIN = false;
    const float* base; float* out; int ldc;
    __device__ __forceinline__ void operator()(const f32x4 (&acc)[2][2][4][2], const Unit& u, int wr, int wc, int fr, int fq) const {
        const int col0 = u.pn * BM + wc * 32 + 4 * fq;
#pragma unroll
        for (int ai = 0; ai < 2; ++ai)
#pragma unroll
            for (int m = 0; m < 4; ++m) { const int r = ai * HALF + wr * 64 + m * 16 + fr; const size_t off = (size_t)(u.pm * BM + r) * ldc + col0;
#pragma unroll
                for (int bj = 0; bj < 2; ++bj)
#pragma unroll
                    for (int n = 0; n < 2; ++n) { f32x4 o = acc[ai][bj][m][n]; if (base) o = o + *(const f32x4*)(base + off + bj * HALF + n * 16);
                        *(f32x4*)(out + off + bj * HALF + n * 16) = o; } }
    }
};
struct EpiH {
    static constexpr bool PERM = true, AFTER_DRAIN = false;
    const float* base; bf16* outb; float* ss; int ldc;
    __device__ __forceinline__ void operator()(const f32x4 (&acc)[2][2][4][2], const Unit& u, int wr, int wc, int fr, int fq) const {
        const int col0 = u.pn * BM + wc * 32 + 8 * fq;
#pragma unroll
        for (int ai = 0; ai < 2; ++ai) {
            f32x4 xv[4][2][2];
#pragma unroll
            for (int m = 0; m < 4; ++m) { const size_t off = (size_t)(u.pm * BM + ai * HALF + wr * 64 + m * 16 + fr) * ldc + col0;
#pragma unroll
                for (int bj = 0; bj < 2; ++bj)
#pragma unroll
                    for (int n = 0; n < 2; ++n) xv[m][bj][n] = *(const f32x4*)(base + off + bj * HALF + 4 * n); }
#pragma unroll
            for (int m = 0; m < 4; ++m) { const int r = ai * HALF + wr * 64 + m * 16 + fr; const size_t off = (size_t)(u.pm * BM + r) * ldc + col0; float sq = 0.f;
#pragma unroll
                for (int bj = 0; bj < 2; ++bj) { const f32x4 o0 = acc[ai][bj][m][0] + xv[m][bj][0], o1 = acc[ai][bj][m][1] + xv[m][bj][1];
                    *(u32x4*)(outb + off + bj * HALF) = (u32x4){pk2(o0.x, o0.y), pk2(o0.z, o0.w), pk2(o1.x, o1.y), pk2(o1.z, o1.w)};
                    sq += ((o0.x * o0.x + o0.y * o0.y) + (o0.z * o0.z + o0.w * o0.w)) + ((o1.x * o1.x + o1.y * o1.y) + (o1.z * o1.z + o1.w * o1.w)); }
                sq += __shfl_xor(sq, 16); sq += __shfl_xor(sq, 32);
                if (fq == 0) ss[(size_t)(u.pm * BM + r) * 32 + u.pn * 4 + wc] = sq; }
        }
    }
};
struct Order1 {
    StaticOrder s; bool split; int c;
    __device__ void init(int M, int N, int G_, int c_) { s.init(M, N, G_, c_); split = (G_ == 256 && M == 8192 && N == 6656); c = c_; }
    __device__ bool next(int i, Unit& u) const {
        if (!split) return s.next(i, u);
        if (c >= 208 || i >= 4) return false;
        const int x = c & 7, j = c >> 3; u.pm = 4 * x + 2 * (i >> 1) + (j & 1); u.pn = 13 * (i & 1) + (j >> 1); return true; }
    __device__ __forceinline__ void a_ready(const Unit&) const {}
    __device__ __forceinline__ void done(const Unit&) const {}
};
}

__device__ __forceinline__ void phase_kmean(KP P, LAS unsigned char* lds, int vcu, int G) {
    const int tid = ltid(); const bf16* proj = (const bf16*)(P.ws + WS_PROJ); float* kmean = (float*)(P.ws + WS_KMEAN);
    LAS float* red = (LAS float*)lds;
    for (int item = vcu; item < 32 * 8; item += G) {
        const int bb = item >> 3, cg = item & 7;
        const int c = tid & 127, rq = tid >> 7;
        const bf16* p = proj + (size_t)(bb * 256 + rq * 64) * INCP + C_AK + cg * 128 + c;
        float s = 0.f;
        for (int r = 0; r < 64; ++r) s += bf2f(p[(size_t)r * INCP]);
        red[rq * 128 + c] = s;
        __syncthreads();
        if (tid < 128) kmean[(size_t)bb * 1024 + cg * 128 + tid] = (red[tid] + red[128 + tid] + red[256 + tid] + red[384 + tid]) * (1.f / 256.f);
        __syncthreads();
    }
}

typedef short bf16x8 __attribute__((ext_vector_type(8)));
typedef float f32x16 __attribute__((ext_vector_type(16)));
constexpr int CP = 72;
constexpr int MATB = 64 * CP * 2;
enum { M_AT = 0, M_BT = 1, M_KT = 2, M_RT = 3, M_VT = 4, M_BBT = 5, M_KBT = 6, M_LAK = 7, M_MRB = 8, M_MRK = 9, M_LAB = 10, M_AHT = 0, M_U0T = 1 };
constexpr int L_RHS = 11 * MATB;
constexpr int L_MISC = L_RHS + 32768;
constexpr int L_TB = L_MISC + 9 * 64 * 4;
constexpr int L_A_END = L_TB + 2048;
static_assert(L_A_END <= RING_BYTES, "stage A LDS");
constexpr size_t CHK_ITEM = 6 * 8192;

__device__ __forceinline__ f32x16 mm_tile(const LAS unsigned char* A, int ra, const LAS unsigned char* B, int rb, f32x16 acc, int lane, int k0 = 0, int k1 = 4) {
    const int r = lane & 31, hi = lane >> 5;
    const LAS unsigned char* ap = A + ((ra * 32 + r) * CP + 8 * hi) * 2; const LAS unsigned char* bp = B + ((rb * 32 + r) * CP + 8 * hi) * 2;
#pragma unroll
    for (int kk = 0; kk < 4; ++kk) if (kk >= k0 && kk < k1) {
        const bf16x8 a = *(const LAS bf16x8*)(ap + kk * 32), b = *(const LAS bf16x8*)(bp + kk * 32);
        acc = __builtin_amdgcn_mfma_f32_32x32x16_bf16(a, b, acc, 0, 0, 0); }
    return acc;
}
__device__ __forceinline__ int crow32(int reg, int hi) { return (reg & 3) + 8 * (reg >> 2) + 4 * hi; }

__device__ __forceinline__ void prologue_lora(KP P, int vcu, int G) {
    bf16* w2T = (bf16*)(P.ws + WS_LORA); bf16* a2T = w2T + 1024 * 96; bf16* g2T = a2T + 1024 * 96;
    for (int e0 = vcu * NTHR + ltid(); e0 < 448 * 1024; e0 += 4 * G * NTHR) { float v[4];
#pragma unroll
        for (int u = 0; u < 4; ++u) { const int e = e0 + u * G * NTHR, i = e >> 10; v[u] = 0.f;
            if (e < 448 * 1024) v[u] = i < 96 ? P.w2[e] : (i < 192 ? P.a2[e - 96 * 1024] : P.g2[e - 192 * 1024]); }
#pragma unroll
        for (int u = 0; u < 4; ++u) { const int e = e0 + u * G * NTHR, i = e >> 10, n = e & 1023;
            if (e < 448 * 1024) { if (i < 96) w2T[n * 96 + i] = (bf16)f2bf(v[u]); else if (i < 192) a2T[n * 96 + (i - 96)] = (bf16)f2bf(v[u]); else g2T[n * 256 + (i - 192)] = (bf16)f2bf(v[u]); } }
    }
}
__device__ __forceinline__ void phase_act(KP P, int vcu, int G) {
    const bf16* proj = (const bf16*)(P.ws + WS_PROJ); unsigned* act = (unsigned*)(P.ws + WS_ACT);
    for (int e0 = vcu * NTHR + ltid(); e0 < TT * 224; e0 += 14 * G * NTHR) {
        unsigned cu[14], pu[14]; float m0[14], m1[14];
#pragma unroll
        for (int u = 0; u < 14; ++u) { const int e = e0 + u * G * NTHR; cu[u] = 0u; pu[u] = 0u; m0[u] = 0.f; m1[u] = 0.f;
            if (e < TT * 224) { const int t = e / 224, cc = 2 * (e - t * 224); const bf16* pr = proj + (size_t)t * INCP + C_RW + 3072 + cc;
                cu[u] = *(const unsigned*)pr; pu[u] = (t & (SEQ - 1)) == 0 ? 0u : *(const unsigned*)(pr - INCP); m0[u] = P.mu[3072 + cc]; m1[u] = P.mu[3072 + cc + 1]; } }
#pragma unroll
        for (int u = 0; u < 14; ++u) { const int e = e0 + u * G * NTHR;
            if (e < TT * 224) { const int t = e / 224, cc = 2 * (e - t * 224);
                float v0 = bflo(cu[u]) + (bflo(pu[u]) - bflo(cu[u])) * m0[u], v1 = bfhi(cu[u]) + (bfhi(pu[u]) - bfhi(cu[u])) * m1[u];
                const bool th = cc < 96, sg = cc >= 192; const float ab = th ? 2.f : 1.f, cc_ = th ? -1.f : 0.f;
                const float s0 = ab * __builtin_amdgcn_rcpf(1.f + __expf(-ab * v0)) + cc_, s1 = ab * __builtin_amdgcn_rcpf(1.f + __expf(-ab * v1)) + cc_;
                if (th || sg) { v0 = s0; v1 = s1; }
                act[e] = pk2(v0, v1); } }
    }
}
constexpr int ACTP = 456;
constexpr int L_WAG = 58368;
static_assert(L_WAG + 3 * 16384 <= L_MISC, "lora scratch fits below misc");
struct LoraFrags { bf16x8 f[16]; f32x4 w0[4], a0[4]; float mu_r, mu_k, mu_v, kkc, kac, rkc, lng, lnb; };
__device__ __forceinline__ LoraFrags lora_frags_load(KP P, int h, int wave, int lane) {
    const int c32 = lane & 31, hi = lane >> 5, nb = (wave & 3) >> 1; const int nrow = h * 64 + nb * 32 + c32;
    const bf16* w2T = (const bf16*)(P.ws + WS_LORA); const bf16* a2T = w2T + 1024 * 96; const bf16* g2T = a2T + 1024 * 96;
    const bf16* wp = w2T + (size_t)nrow * 96 + 8 * hi; const bf16* ap = a2T + (size_t)nrow * 96 + 8 * hi; const bf16* gp = g2T + (size_t)nrow * 256 + 8 * hi;
    LoraFrags W;
#pragma unroll
    for (int kk = 0; kk < 16; ++kk) { const bf16* src = wave < 4 ? (kk < 6 ? wp + 16 * kk : ap + 16 * ((kk - 6) % 6)) : gp + 16 * kk; W.f[kk] = *(const bf16x8*)src; }
#pragma unroll
    for (int g = 0; g < 4; ++g) { const int n0 = h * 64 + nb * 32 + 8 * g + 4 * hi; W.w0[g] = *(const f32x4*)(P.w0 + n0); W.a0[g] = *(const f32x4*)(P.a0 + n0); }
    const int col = h * 64 + lane;
    W.mu_r = P.mu[col]; W.mu_k = P.mu[1024 + col]; W.mu_v = P.mu[2048 + col]; W.kkc = P.k_k[col]; W.kac = P.k_a[col]; W.rkc = P.r_k[col]; W.lng = P.ln_g[col]; W.lnb = P.ln_b[col];
    return W;
}
struct ActPre { v4u v[7]; };
__device__ __forceinline__ void act_prefetch(KP P, int item, ActPre& A) {
    const int tid = ltid(); const int tok0 = (item >> 10) * SEQ + (item & 63) * 64; const bf16* actg = (const bf16*)(P.ws + WS_ACT) + (size_t)tok0 * 448;
#pragma unroll
    for (int j = 0; j < 7; ++j) { const int e = tid + j * NTHR, row = e / 56, ch = e - row * 56; A.v[j] = *(const v4u*)(actg + (size_t)row * 448 + ch * 8); }
}
__device__ __forceinline__ void rwkv_stage_a(KP P, LAS unsigned char* lds, int item, const LoraFrags& W, ActPre& APRE, int next_item) {
    const int tid = ltid(), lane = tid & 63, wave = __builtin_amdgcn_readfirstlane(tid >> 6);
    const int b = item >> 10, h = (item >> 6) & 15, c = item & 63;
    const int tok0 = b * SEQ + c * 64;
    const bf16* proj = (const bf16*)(P.ws + WS_PROJ);
    unsigned char* chk = P.ws + WS_CHK + (size_t)((item & 63) * 32 + (item >> 6)) * CHK_ITEM;
    LAS float* misc = (LAS float*)(lds + L_MISC);
    {
#pragma unroll
      for (int j = 0; j < 7; ++j) { const int e = tid + j * NTHR, row = e / 56, ch = e - row * 56; *(LAS v4u*)(lds + (row * ACTP + ch * 8) * 2) = APRE.v[j]; } }
    __syncthreads();
    bf16 qr_[9], qk_[9], qv_[9];
    { const bf16* pp = proj + (size_t)(tok0 + 8 * wave) * INCP + C_RW + h * 64 + lane;
      if (c == 0 && wave == 0) { qr_[0] = (bf16)0; qk_[0] = (bf16)0; qv_[0] = (bf16)0; } else { qr_[0] = pp[-(long)INCP]; qk_[0] = pp[-(long)INCP + 1024]; qv_[0] = pp[-(long)INCP + 2048]; }
#pragma unroll
      for (int q = 0; q < 8; ++q) { qr_[q + 1] = __builtin_nontemporal_load(pp + (size_t)q * INCP); qk_[q + 1] = __builtin_nontemporal_load(pp + (size_t)q * INCP + 1024); qv_[q + 1] = __builtin_nontemporal_load(pp + (size_t)q * INCP + 2048); } }
    {
        const int c32 = lane & 31, hi = lane >> 5, qd = wave & 3, nb = qd >> 1, tb = qd & 1;
        const LAS unsigned char* actp = lds + ((tb * 32 + c32) * ACTP + 8 * hi) * 2;
        LAS float* wag = (LAS float*)(lds + L_WAG) + (tb * 32 + c32) * 64 + nb * 32;
        if (wave < 4) {
            f32x16 aw = {}, aa = {};
#pragma unroll
            for (int kk = 0; kk < 6; ++kk) {
                aw = __builtin_amdgcn_mfma_f32_32x32x16_bf16(W.f[kk], *(const LAS bf16x8*)(actp + (16 * kk) * 2), aw, 0, 0, 0);
                aa = __builtin_amdgcn_mfma_f32_32x32x16_bf16(W.f[6 + kk], *(const LAS bf16x8*)(actp + (96 + 16 * kk) * 2), aa, 0, 0, 0); }
#pragma unroll
            for (int g = 0; g < 4; ++g) { const int n0 = h * 64 + nb * 32 + 8 * g + 4 * hi;
                const f32x4 w0 = W.w0[g], a0 = W.a0[g]; f32x4 ow, oa;
#pragma unroll
                for (int e = 0; e < 4; ++e) { const float xx = w0[e] + aw[4 * g + e];
                    ow[e] = __expf(-0.6065306597126334f * __builtin_amdgcn_rcpf(1.f + __expf(-xx))); oa[e] = __builtin_amdgcn_rcpf(1.f + __expf(-(a0[e] + aa[4 * g + e]))); }
                *(LAS f32x4*)(wag + 8 * g + 4 * hi) = ow; *(LAS f32x4*)(wag + 4096 + 8 * g + 4 * hi) = oa; }
        } else {
            bf16x8 bop[16];
#pragma unroll
            for (int kk = 0; kk < 16; ++kk) bop[kk] = *(const LAS bf16x8*)(actp + (192 + 16 * kk) * 2);
            f32x16 ag = {}, ag1 = {};
#pragma unroll
            for (int kk = 0; kk < 8; ++kk) { ag = __builtin_amdgcn_mfma_f32_32x32x16_bf16(W.f[2 * kk], bop[2 * kk], ag, 0, 0, 0); ag1 = __builtin_amdgcn_mfma_f32_32x32x16_bf16(W.f[2 * kk + 1], bop[2 * kk + 1], ag1, 0, 0, 0); }
            ag = ag + ag1;
#pragma unroll
            for (int g = 0; g < 4; ++g) *(LAS f32x4*)(wag + 8192 + 8 * g + 4 * hi) = (f32x4){ag[4 * g], ag[4 * g + 1], ag[4 * g + 2], ag[4 * g + 3]};
        }
    }
    __syncthreads();
    {
        const int n = lane, tg = wave, col = h * 64 + n;
        const float mu_r = W.mu_r, mu_k = W.mu_k, mu_v = W.mu_v, kkc = W.kkc, kac = W.kac, rkc = W.rkc, lng = W.lng, lnb = W.lnb;
        float rr[8], kr[8], vv[8], ww[8], aa[8], gg[8], kk[8];
        float pr = bf2f(qr_[0]), pk = bf2f(qk_[0]), pvv = bf2f(qv_[0]);
        const LAS float* wagr = (const LAS float*)(lds + L_WAG) + (8 * tg) * 64 + n;
#pragma unroll
        for (int q = 0; q < 8; ++q) { const float cr = bf2f(qr_[q + 1]), ck = bf2f(qk_[q + 1]), cv = bf2f(qv_[q + 1]);
            rr[q] = cr + (pr - cr) * mu_r; kr[q] = ck + (pk - ck) * mu_k; vv[q] = cv + (pvv - cv) * mu_v; pr = cr; pk = ck; pvv = cv;
            ww[q] = wagr[q * 64]; aa[q] = wagr[4096 + q * 64]; gg[q] = wagr[8192 + q * 64]; }
        float lam[8]; float run = 1.f;
#pragma unroll
        for (int q = 0; q < 8; ++q) { run *= ww[q]; lam[q] = run; }
        misc[tg * 64 + n] = run;
#pragma unroll
        for (int q = 0; q < 8; ++q) { const float kkv = kr[q] * kkc; const float ss = wave_sum(kkv * kkv); kk[q] = kkv * __builtin_amdgcn_rsqf(fmaxf(ss, 1e-24f));
            kr[q] = kr[q] * (1.f + (aa[q] - 1.f) * kac); }
        __syncthreads();
        float pre = 1.f, tot = 1.f;
#pragma unroll
        for (int g = 0; g < 8; ++g) { const float sgt = misc[g * 64 + n]; if (g < tg) pre *= sgt; tot *= sgt; }
        if (tg == 0) misc[512 + n] = tot;
        unsigned vt[4], bbt[4], kbt[4];
        LAS bf16* At = (LAS bf16*)(lds + M_AT * MATB); LAS bf16* Bt = (LAS bf16*)(lds + M_BT * MATB); LAS bf16* Kt = (LAS bf16*)(lds + M_KT * MATB); LAS bf16* Rt = (LAS bf16*)(lds + M_RT * MATB);
        float hbb = 0.f, hkb = 0.f, hv = 0.f;
#pragma unroll
        for (int q = 0; q < 8; ++q) { const int t = 8 * tg + q;
            const float L = pre * lam[q], Lp = q == 0 ? pre : pre * lam[q - 1], iL = __builtin_amdgcn_rcpf(L), rel = tot * iL;
            const float bq = kk[q] * aa[q];
            ((LAS float*)(lds + L_RHS))[t * 128 + 64 + n] = -kk[q] * Lp;
            At[t * CP + n] = (bf16)f2bf(-kk[q] * Lp); Bt[t * CP + n] = (bf16)f2bf(bq * iL); Kt[t * CP + n] = (bf16)f2bf(kr[q] * iL); Rt[t * CP + n] = (bf16)f2bf(rr[q] * L);
            const float bb = bq * rel, kb = kr[q] * rel;
            if (q & 1) { vt[q >> 1] = pk2(hv, vv[q]); bbt[q >> 1] = pk2(hbb, bb); kbt[q >> 1] = pk2(hkb, kb); } else { hv = vv[q]; hbb = bb; hkb = kb; }
            const float bs = wave_sum(rr[q] * kr[q] * rkc);
            const int pl = (((t >> 4) * 2 + (n >> 5)) * 64 + (t & 15) * 4 + ((n >> 2) & 3)) * 8 + ((n >> 4) & 1) * 4 + (n & 3);
            ((bf16*)(chk + 4 * 8192))[pl] = (bf16)f2bf(lng * gg[q]);
            ((bf16*)(chk + 5 * 8192))[pl] = (bf16)f2bf((lnb + bs * vv[q]) * gg[q]); }
        *(LAS v4u*)(lds + M_VT * MATB + (n * CP + 8 * tg) * 2) = (v4u){vt[0], vt[1], vt[2], vt[3]};
        *(LAS v4u*)(lds + M_BBT * MATB + (n * CP + 8 * tg) * 2) = (v4u){bbt[0], bbt[1], bbt[2], bbt[3]};
        *(LAS v4u*)(lds + M_KBT * MATB + (n * CP + 8 * tg) * 2) = (v4u){kbt[0], kbt[1], kbt[2], kbt[3]};
    }
    if (next_item >= 0) act_prefetch(P, next_item, APRE);
    __syncthreads();
    const int c32 = lane & 31, hi = lane >> 5;
    {
        const int prod = wave >> 1;
        const int xa = (prod == 0 || prod == 2) ? M_BT : M_KT, ya = prod < 2 ? M_AT : M_RT, dm = prod == 0 ? M_LAB : (prod == 1 ? M_LAK : (prod == 2 ? M_MRB : M_MRK));
        f32x16 accq[2] = {};
#pragma unroll
        for (int qi = 0; qi < 2; ++qi) { const int tb = (wave & 1) ? (qi == 0 ? 1 : 0) : qi, sb = (wave & 1) ? 1 : 0; const bool zero = (tb == 0 && sb == 1);
            if (!zero) accq[qi] = mm_tile(lds + xa * MATB, sb, lds + ya * MATB, tb, accq[qi], lane); }
#pragma unroll
        for (int qi = 0; qi < 2; ++qi) {
            const int tb = (wave & 1) ? (qi == 0 ? 1 : 0) : qi, sb = (wave & 1) ? 1 : 0;
            const int t = tb * 32 + c32; LAS unsigned char* dst = lds + dm * MATB + (t * CP + sb * 32) * 2;
#pragma unroll
            for (int g = 0; g < 4; ++g) { float o[4];
#pragma unroll
                for (int e = 0; e < 4; ++e) { const int s = sb * 32 + 8 * g + 4 * hi + e; const bool keep = prod < 2 ? (s < t) : (s <= t); o[e] = keep ? accq[qi][4 * g + e] : 0.f; }
                *(LAS v2u*)(dst + (8 * g + 4 * hi) * 2) = (v2u){pk2(o[0], o[1]), pk2(o[2], o[3])}; }
        }
    }
    __syncthreads();
    if (wave < 4) {
        const int ib = wave >> 1, tb = wave & 1; f32x16 acc = {};
        acc = mm_tile(lds + M_VT * MATB, ib, lds + M_LAK * MATB, tb, acc, lane, 0, tb == 0 ? 2 : 4);
        const int t = tb * 32 + c32; LAS float* dst = (LAS float*)(lds + L_RHS) + t * 128 + ib * 32;
#pragma unroll
        for (int g = 0; g < 4; ++g) *(LAS f32x4*)(dst + 8 * g + 4 * hi) = (f32x4){acc[4 * g], acc[4 * g + 1], acc[4 * g + 2], acc[4 * g + 3]};
    } else if (wave == 4) {
        const int bb = lane >> 4, col = lane & 15;
        float x[16];
#pragma unroll
        for (int t = 0; t < 16; ++t) x[t] = t == col ? 1.f : 0.f;
#pragma unroll
        for (int t = 1; t < 16; ++t) { const LAS unsigned char* rp = lds + M_LAB * MATB + ((16 * bb + t) * CP + 16 * bb) * 2; const v4u ra = *(const LAS v4u*)rp, rb = *(const LAS v4u*)(rp + 16);
            float lrow[16];
#pragma unroll
            for (int q = 0; q < 4; ++q) { lrow[2 * q] = bflo(ra[q]); lrow[2 * q + 1] = bfhi(ra[q]); lrow[8 + 2 * q] = bflo(rb[q]); lrow[8 + 2 * q + 1] = bfhi(rb[q]); }
#pragma unroll
            for (int s = 0; s < t; ++s) x[t] += lrow[s] * x[s]; }
        LAS bf16* T = (LAS bf16*)(lds + L_TB) + bb * 256 + col;
#pragma unroll
        for (int t = 0; t < 16; ++t) T[t * 16] = (bf16)f2bf(x[t]);
    }
    __syncthreads();
    {
        typedef short s16x4 __attribute__((ext_vector_type(4)));
        const int l15 = lane & 15, q4 = lane >> 4;
        LAS unsigned char* xt = lds + (wave < 4 ? M_U0T : M_AHT) * MATB + ((16 * (wave & 3) + l15) * CP) * 2;
        *(LAS v4u*)(xt + q4 * 32) = (v4u){0u, 0u, 0u, 0u}; *(LAS v4u*)(xt + q4 * 32 + 16) = (v4u){0u, 0u, 0u, 0u};
        const LAS float* Xf = (const LAS float*)(lds + L_RHS) + 16 * wave + l15;
#pragma unroll
        for (int bq = 0; bq < 4; ++bq) {
            f32x4 acc;
#pragma unroll
            for (int e = 0; e < 4; ++e) acc[e] = Xf[(16 * bq + 4 * q4 + e) * 128];
#pragma unroll
            for (int kk = 0; kk < (bq + 1) / 2; ++kk) {
                const bf16x8 a = *(const LAS bf16x8*)(lds + M_LAB * MATB + ((16 * bq + l15) * CP + 32 * kk + 8 * q4) * 2);
                const bf16x8 xb = *(const LAS bf16x8*)(xt + (32 * kk + 8 * q4) * 2);
                acc = __builtin_amdgcn_mfma_f32_16x16x32_bf16(a, xb, acc, 0, 0, 0); }
            const v2u tf = *(const LAS v2u*)(lds + L_TB + (bq * 256 + l15 * 16 + 4 * q4) * 2);
            const v2u ab = (v2u){pk2(acc[0], acc[1]), pk2(acc[2], acc[3])};
            const f32x4 z = {0.f, 0.f, 0.f, 0.f};
            const f32x4 xn = __builtin_amdgcn_mfma_f32_16x16x16bf16_1k(__builtin_bit_cast(s16x4, tf), __builtin_bit_cast(s16x4, ab), z, 0, 0, 0);
            *(LAS v2u*)(xt + (16 * bq + 4 * q4) * 2) = (v2u){pk2(xn[0], xn[1]), pk2(xn[2], xn[3])};
        }
    }
    __syncthreads();
    {
        const int qd = wave & 3, yb = qd >> 1, xb = qd & 1;
        f32x16 acc1 = {}, acc2 = {};
        if (wave < 4) {
            acc1 = mm_tile(lds + M_AHT * MATB, yb, lds + M_BBT * MATB, xb, acc1, lane);
            { f32x16 acc3 = {}; acc2 = mm_tile(lds + M_BBT * MATB, yb, lds + M_U0T * MATB, xb, acc2, lane);
              acc3 = mm_tile(lds + M_KBT * MATB, yb, lds + M_VT * MATB, xb, acc3, lane); acc2 = acc2 + acc3; }
            const int x = xb * 32 + c32; const float lc = misc[512 + x];
            bf16* o1 = (bf16*)(chk + 0 * 8192) + (((x >> 4) * 2 + yb) * 64 + (x & 15)) * 8 + 4 * hi; bf16* o2 = (bf16*)(chk + 1 * 8192) + ((2 * yb * 4 + (x >> 4)) * 64 + (x & 15)) * 4;
#pragma unroll
            for (int g = 0; g < 4; ++g) { float p[4];
#pragma unroll
                for (int e = 0; e < 4; ++e) { const int y = yb * 32 + 8 * g + 4 * hi + e; p[e] = acc1[4 * g + e] + (y == x ? lc : 0.f); }
                *(v2u*)(o1 + 16 * g * 8) = (v2u){pk2(p[0], p[1]), pk2(p[2], p[3])};
                *(v2u*)(o2 + ((g >> 1) * 4 * 64 + 16 * ((2 * g + hi) & 3)) * 4) = (v2u){pk2(acc2[4 * g], acc2[4 * g + 1]), pk2(acc2[4 * g + 2], acc2[4 * g + 3])}; }
        } else {
            acc1 = mm_tile(lds + M_AHT * MATB, yb, lds + M_MRB * MATB, xb, acc1, lane);
            { f32x16 acc3 = {}; acc2 = mm_tile(lds + M_U0T * MATB, yb, lds + M_MRB * MATB, xb, acc2, lane);
              acc3 = mm_tile(lds + M_VT * MATB, yb, lds + M_MRK * MATB, xb, acc3, lane); acc2 = acc2 + acc3; }
            const int x = xb * 32 + c32;
            bf16* o1 = (bf16*)(chk + 2 * 8192) + (((x >> 4) * 2 + yb) * 64 + (x & 15)) * 8 + 4 * hi; bf16* o2 = (bf16*)(chk + 3 * 8192) + (((x >> 4) * 2 + yb) * 64 + (x & 15)) * 8;
            const LAS bf16* Rt = (const LAS bf16*)(lds + M_RT * MATB) + x * CP + yb * 32;
#pragma unroll
            for (int g = 0; g < 4; ++g) { float p[4];
#pragma unroll
                for (int e = 0; e < 4; ++e) p[e] = acc1[4 * g + e] + bf2f(Rt[8 * g + 4 * hi + e]);
                *(v2u*)(o1 + 16 * g * 8) = (v2u){pk2(p[0], p[1]), pk2(p[2], p[3])};
                *(v2u*)(o2 + 16 * ((2 * g + hi) & 3) * 8 + (g >> 1) * 4) = (v2u){pk2(acc2[4 * g], acc2[4 * g + 1]), pk2(acc2[4 * g + 2], acc2[4 * g + 3])}; }
        }
    }
    __syncthreads();
}

__device__ __forceinline__ void phase_rwkv_stage_a(KP P, LAS unsigned char* lds, int vcu, int G) {
    const int tid = ltid(), lane = tid & 63, wave = __builtin_amdgcn_readfirstlane(tid >> 6);
    int cur_bh = (vcu & 255) >> 3; LoraFrags W = lora_frags_load(P, cur_bh & 15, wave, lane);
    ActPre APRE;
    if (vcu < 2048) act_prefetch(P, ((vcu & 255) >> 3) * 64 + (vcu & 7) + 8 * (vcu >> 8), APRE);
    for (int k = vcu; k < 2048; k += G) { const int bh = (k & 255) >> 3, c = (k & 7) + 8 * (k >> 8);
        if (bh != cur_bh) { W = lora_frags_load(P, bh & 15, wave, lane); cur_bh = bh; }
        const int kn = k + G; const int nxt = kn < 2048 ? ((kn & 255) >> 3) * 64 + (kn & 7) + 8 * (kn >> 8) : -1;
        rwkv_stage_a(P, lds, bh * 64 + c, W, APRE, nxt); }
}
typedef float f32x4v __attribute__((ext_vector_type(4)));
struct YSet { bf16x8 b0, b1; v4u y0[2], g1[2], g2[2]; };
struct SSet { bf16x8 p0[1], p1[1]; v2u q[4]; };
__device__ __forceinline__ void rwkv_stage_b(KP P, LAS unsigned char* lds, int bh) {
    const int tid = ltid(), lane = tid & 63, wave = __builtin_amdgcn_readfirstlane(tid >> 6);
    const int b = bh >> 4, h = bh & 15; const int l15 = lane & 15, q4 = lane >> 4;
    bf16* AR = (bf16*)(P.ws + WS_AR);
    for (int u = tid; u < 2 * MATB / 4; u += NTHR) ((LAS unsigned*)lds)[u] = 0u;
    __syncthreads();
    const int w4 = wave & 3;
    const unsigned char* chk0 = P.ws + WS_CHK + (size_t)bh * CHK_ITEM;
    if (wave < 4) {
        const int t = 16 * w4 + l15;
        YSet ys[4];
#define YLOAD(S_, c_) do { const unsigned char* chk = chk0 + (size_t)(c_) * (32 * CHK_ITEM); const bf16* rh = (const bf16*)(chk + 2 * 8192) + (w4 * 128 + lane) * 8; S_.b0 = __builtin_nontemporal_load((const bf16x8*)rh); S_.b1 = __builtin_nontemporal_load((const bf16x8*)(rh + 512)); \
        const bf16* y0 = (const bf16*)(chk + 3 * 8192) + (w4 * 128 + lane) * 8; const bf16* g1 = (const bf16*)(chk + 4 * 8192) + (w4 * 128 + l15 * 4 + q4) * 8; \
        S_.y0[0] = __builtin_nontemporal_load((const v4u*)y0); S_.y0[1] = __builtin_nontemporal_load((const v4u*)(y0 + 512)); S_.g1[0] = __builtin_nontemporal_load((const v4u*)g1); S_.g1[1] = __builtin_nontemporal_load((const v4u*)(g1 + 512)); S_.g2[0] = __builtin_nontemporal_load((const v4u*)(g1 + 4096)); S_.g2[1] = __builtin_nontemporal_load((const v4u*)(g1 + 4096 + 512)); } while (0)
#define YV(A_, it_, w_) ((A_)[(it_) >> 1][2 * ((it_) & 1) + (w_)])
#pragma unroll
        for (int u = 0; u < 4; ++u) YLOAD(ys[u], u);
        for (int c0 = 0; c0 < 60; c0 += 4) {
#pragma unroll
                for (int u = 0; u < 4; ++u) { const int c = c0 + u;
                const LAS unsigned char* Scur = lds + (c & 1) * MATB;
                    f32x4v acc[4];
    #pragma unroll
                    for (int it = 0; it < 4; ++it) { acc[it] = (f32x4v){bflo(YV(ys[u].y0, it, 0)), bfhi(YV(ys[u].y0, it, 0)), bflo(YV(ys[u].y0, it, 1)), bfhi(YV(ys[u].y0, it, 1))};
                        const LAS unsigned char* sp = Scur + ((16 * it + l15) * CP + 8 * q4) * 2;
                        acc[it] = __builtin_amdgcn_mfma_f32_16x16x32_bf16(*(const LAS bf16x8*)sp, ys[u].b0, acc[it], 0, 0, 0);
                        acc[it] = __builtin_amdgcn_mfma_f32_16x16x32_bf16(*(const LAS bf16x8*)(sp + 64), ys[u].b1, acc[it], 0, 0, 0); }
                    float s = 0.f;
    #pragma unroll
                    for (int it = 0; it < 4; ++it) s += (acc[it].x + acc[it].y) + (acc[it].z + acc[it].w);
                    s += __shfl_xor(s, 16); s += __shfl_xor(s, 32);
                    const float mean = s * (1.f / 64.f); float v = 0.f;
    #pragma unroll
                    for (int it = 0; it < 4; ++it) { acc[it] = acc[it] - mean; v += (acc[it].x * acc[it].x + acc[it].y * acc[it].y) + (acc[it].z * acc[it].z + acc[it].w * acc[it].w); }
                    v += __shfl_xor(v, 16); v += __shfl_xor(v, 32);
                    const float rstd = 1.0f / sqrtf(v * (1.f / 64.f) + 64e-5f);
                    bf16* orow = AR + (size_t)(b * SEQ + c * 64 + t) * DM + 1024 + h * 64 + 4 * q4;
    #pragma unroll
                    for (int it = 0; it < 4; ++it) {
                        const float o0 = acc[it].x * rstd * bflo(YV(ys[u].g1, it, 0)) + bflo(YV(ys[u].g2, it, 0)), o1 = acc[it].y * rstd * bfhi(YV(ys[u].g1, it, 0)) + bfhi(YV(ys[u].g2, it, 0));
                        const float o2 = acc[it].z * rstd * bflo(YV(ys[u].g1, it, 1)) + bflo(YV(ys[u].g2, it, 1)), o3 = acc[it].w * rstd * bfhi(YV(ys[u].g1, it, 1)) + bfhi(YV(ys[u].g2, it, 1));
                        *(v2u*)(orow + 16 * it) = (v2u){pk2(o0, o1), pk2(o2, o3)}; }
                asm volatile("" ::: "memory");
                    YLOAD(ys[u], c + 4);
                    __syncthreads();
                }
        }
        { const int c0 = 60;
#pragma unroll
                for (int u = 0; u < 4; ++u) { const int c = c0 + u;
                const LAS unsigned char* Scur = lds + (c & 1) * MATB;
                    f32x4v acc[4];
    #pragma unroll
                    for (int it = 0; it < 4; ++it) { acc[it] = (f32x4v){bflo(YV(ys[u].y0, it, 0)), bfhi(YV(ys[u].y0, it, 0)), bflo(YV(ys[u].y0, it, 1)), bfhi(YV(ys[u].y0, it, 1))};
                        const LAS unsigned char* sp = Scur + ((16 * it + l15) * CP + 8 * q4) * 2;
                        acc[it] = __builtin_amdgcn_mfma_f32_16x16x32_bf16(*(const LAS bf16x8*)sp, ys[u].b0, acc[it], 0, 0, 0);
                        acc[it] = __builtin_amdgcn_mfma_f32_16x16x32_bf16(*(const LAS bf16x8*)(sp + 64), ys[u].b1, acc[it], 0, 0, 0); }
                    float s = 0.f;
    #pragma unroll
                    for (int it = 0; it < 4; ++it) s += (acc[it].x + acc[it].y) + (acc[it].z + acc[it].w);
                    s += __shfl_xor(s, 16); s += __shfl_xor(s, 32);
                    const float mean = s * (1.f / 64.f); float v = 0.f;
    #pragma unroll
                    for (int it = 0; it < 4; ++it) { acc[it] = acc[it] - mean; v += (acc[it].x * acc[it].x + acc[it].y * acc[it].y) + (acc[it].z * acc[it].z + acc[it].w * acc[it].w); }
                    v += __shfl_xor(v, 16); v += __shfl_xor(v, 32);
                    const float rstd = 1.0f / sqrtf(v * (1.f / 64.f) + 64e-5f);
                    bf16* orow = AR + (size_t)(b * SEQ + c * 64 + t) * DM + 1024 + h * 64 + 4 * q4;
    #pragma unroll
                    for (int it = 0; it < 4; ++it) {
                        const float o0 = acc[it].x * rstd * bflo(YV(ys[u].g1, it, 0)) + bflo(YV(ys[u].g2, it, 0)), o1 = acc[it].y * rstd * bfhi(YV(ys[u].g1, it, 0)) + bfhi(YV(ys[u].g2, it, 0));
                        const float o2 = acc[it].z * rstd * bflo(YV(ys[u].g1, it, 1)) + bflo(YV(ys[u].g2, it, 1)), o3 = acc[it].w * rstd * bfhi(YV(ys[u].g1, it, 1)) + bfhi(YV(ys[u].g2, it, 1));
                        *(v2u*)(orow + 16 * it) = (v2u){pk2(o0, o1), pk2(o2, o3)}; }
                __syncthreads();
                }
        }
#undef YLOAD
#undef YV
    } else {
        const int nrow = 16 * w4 + l15;
        SSet ss[4];
#define SLOADX(S_, c_) do { const unsigned char* chk = chk0 + (size_t)(c_) * (32 * CHK_ITEM); const bf16* pt = (const bf16*)chk + (w4 * 128 + lane) * 8; S_.p0[0] = __builtin_nontemporal_load((const bf16x8*)pt); S_.p1[0] = __builtin_nontemporal_load((const bf16x8*)(pt + 512)); \
        const bf16* q = (const bf16*)(chk + 1 * 8192) + (w4 * 256 + lane) * 4; \
        _Pragma("unroll") for (int it = 0; it < 4; ++it) S_.q[it] = __builtin_nontemporal_load((const v2u*)(q + it * 256)); } while (0)
#pragma unroll
        for (int u = 0; u < 4; ++u) SLOADX(ss[u], u);
        for (int c0 = 0; c0 < 60; c0 += 4) {
#pragma unroll
                for (int u = 0; u < 4; ++u) { const int c = c0 + u;
                const LAS unsigned char* Scur = lds + (c & 1) * MATB; LAS unsigned char* Snxt = lds + ((c & 1) ^ 1) * MATB;
    #pragma unroll
                    for (int it = 0; it < 4; ++it) { const int i = 16 * it + l15;
                        const LAS unsigned char* sp = Scur + (i * CP + 8 * q4) * 2; const bf16x8 s0 = *(const LAS bf16x8*)sp, s1 = *(const LAS bf16x8*)(sp + 64);
                        f32x4v acc = (f32x4v){bflo(ss[u].q[it].x), bfhi(ss[u].q[it].x), bflo(ss[u].q[it].y), bfhi(ss[u].q[it].y)};
                        acc = __builtin_amdgcn_mfma_f32_16x16x32_bf16(ss[u].p0[0], s0, acc, 0, 0, 0);
                        acc = __builtin_amdgcn_mfma_f32_16x16x32_bf16(ss[u].p1[0], s1, acc, 0, 0, 0);
                        *(LAS v2u*)(Snxt + (i * CP + 16 * w4 + 4 * q4) * 2) = (v2u){pk2(acc.x, acc.y), pk2(acc.z, acc.w)}; }
                asm volatile("" ::: "memory");
                    SLOADX(ss[u], c + 4);
                    __syncthreads();
                }
        }
        { const int c0 = 60;
#pragma unroll
                for (int u = 0; u < 4; ++u) { const int c = c0 + u;
                const LAS unsigned char* Scur = lds + (c & 1) * MATB; LAS unsigned char* Snxt = lds + ((c & 1) ^ 1) * MATB;
    #pragma unroll
                    for (int it = 0; it < 4; ++it) { const int i = 16 * it + l15;
                        const LAS unsigned char* sp = Scur + (i * CP + 8 * q4) * 2; const bf16x8 s0 = *(const LAS bf16x8*)sp, s1 = *(const LAS bf16x8*)(sp + 64);
                        f32x4v acc = (f32x4v){bflo(ss[u].q[it].x), bfhi(ss[u].q[it].x), bflo(ss[u].q[it].y), bfhi(ss[u].q[it].y)};
                        acc = __builtin_amdgcn_mfma_f32_16x16x32_bf16(ss[u].p0[0], s0, acc, 0, 0, 0);
                        acc = __builtin_amdgcn_mfma_f32_16x16x32_bf16(ss[u].p1[0], s1, acc, 0, 0, 0);
                        *(LAS v2u*)(Snxt + (i * CP + 16 * w4 + 4 * q4) * 2) = (v2u){pk2(acc.x, acc.y), pk2(acc.z, acc.w)}; }
                __syncthreads();
                }
        }
#undef SLOADX
    }
}

constexpr size_t WS_UB = WS_RWA;
constexpr size_t WS_VB = WS_RWA + 32 * MiB;
constexpr float U_SCALE = 512.f, V_SCALE = 32.f;
constexpr int SLICE_BYTES = 16384 * 128;
typedef float f32x2 __attribute__((ext_vector_type(2)));
__device__ __forceinline__ void phase_convert_tables(KP P, LAS unsigned char* lds) {
    const int tid = ltid(); constexpr int ROWS = 32, NCH = 2 * 16384 / ROWS;
    unsigned* ctr = (unsigned*)(P.ws + WS_CTL) + CW_MOBA_CTR; LAS int* slot = (LAS int*)lds;
    const f32x4 gu = *(const f32x4*)(P.norm2_g + 4 * tid) * U_SCALE;
    __syncthreads();
    if (tid == 0) slot[0] = (int)__hip_atomic_fetch_add(ctr, 1u, __ATOMIC_RELAXED, __HIP_MEMORY_SCOPE_AGENT);
    __syncthreads();
    for (int it = 0;; ++it) {
        const int c = slot[it & 1]; if (c >= NCH) break;
        if (tid == 0) slot[(it & 1) ^ 1] = (int)__hip_atomic_fetch_add(ctr, 1u, __ATOMIC_RELAXED, __HIP_MEMORY_SCOPE_AGENT);
        const bool isv = c >= NCH / 2;
        const int e0 = (isv ? c - NCH / 2 : c) * ROWS;
        const float* src = (isv ? P.pv : P.pu) + (size_t)e0 * DM + 4 * tid;
        unsigned char* dst = P.ws + (isv ? WS_VB : WS_UB) + (size_t)(tid >> 5) * SLICE_BYTES + (size_t)e0 * 128 + ((tid >> 2) & 7) * 16 + 4 * (tid & 3);
        const f32x4 sc = isv ? (f32x4){V_SCALE, V_SCALE, V_SCALE, V_SCALE} : gu;
        f32x4 a[ROWS];
#pragma unroll
        for (int r = 0; r < ROWS; ++r) a[r] = __builtin_nontemporal_load((const f32x4*)(src + (size_t)r * DM));
#pragma unroll
        for (int r = 0; r < ROWS; ++r) { const f32x4 v = a[r] * sc; int p = 0;
            p = __builtin_amdgcn_cvt_pk_fp8_f32(v.x, v.y, p, false); p = __builtin_amdgcn_cvt_pk_fp8_f32(v.z, v.w, p, true); __builtin_nontemporal_store((unsigned)p, (unsigned*)(dst + r * 128)); }
        __syncthreads();
    }
}
__device__ __forceinline__ void axpy16p_init(const v4u v, f32x2 s, f32x2* y) {
#pragma unroll
    for (int q = 0; q < 4; ++q) { const f32x2 lo = __builtin_amdgcn_cvt_pk_f32_fp8((int)v[q], false), hi = __builtin_amdgcn_cvt_pk_f32_fp8((int)v[q], true);
        y[2 * q] = s * lo; y[2 * q + 1] = s * hi; }
}
__device__ __forceinline__ f32x2 dot16p(const v4u u, const f32x2* x, f32x2 acc) {
#pragma unroll
    for (int q = 0; q < 4; ++q) { const f32x2 lo = __builtin_amdgcn_cvt_pk_f32_fp8((int)u[q], false), hi = __builtin_amdgcn_cvt_pk_f32_fp8((int)u[q], true);
        acc = __builtin_elementwise_fma(lo, x[2 * q], acc); acc = __builtin_elementwise_fma(hi, x[2 * q + 1], acc); }
    return acc;
}
__device__ __forceinline__ void axpy16p(const v4u v, f32x2 s, f32x2* y) {
#pragma unroll
    for (int q = 0; q < 4; ++q) { const f32x2 lo = __builtin_amdgcn_cvt_pk_f32_fp8((int)v[q], false), hi = __builtin_amdgcn_cvt_pk_f32_fp8((int)v[q], true);
        y[2 * q] = __builtin_elementwise_fma(s, lo, y[2 * q]); y[2 * q + 1] = __builtin_elementwise_fma(s, hi, y[2 * q + 1]); }
}
__device__ __forceinline__ float xsum_g8(float v) {
    v += DPP_F(v, 0x128);
    { auto r = __builtin_amdgcn_permlane16_swap(__float_as_uint(v), __float_as_uint(v), false, false); v = __uint_as_float(r[0]) + __uint_as_float(r[1]); }
    { auto r = __builtin_amdgcn_permlane32_swap(__float_as_uint(v), __float_as_uint(v), false, false); v = __uint_as_float(r[0]) + __uint_as_float(r[1]); }
    return v;
}
__device__ __forceinline__ void phase_peer_sliced(KP P, LAS unsigned char* lds, int bx, int G) {
    const int grp = bx & 7;
    const unsigned char* UB = P.ws + WS_UB; const unsigned char* VB = P.ws + WS_VB; const bf16* HB = (const bf16*)(P.ws + WS_XN);
    const int* ridx = (const int*)(P.ws + WS_PROJ + 64 * MiB); const float* rgate = (const float*)(P.ws + WS_PROJ + 68 * MiB); const float* RSTD = (const float*)(P.ws + WS_SSP + 2 * MiB);
    for (int bt = bx; bt < TT / 32; bt += G) {
        const int tid = ltid(), lane = tid & 63, wave = __builtin_amdgcn_readfirstlane(tid >> 6), g8 = lane >> 3, p = lane & 7;
        LAS int* idxT = (LAS int*)(lds + wave * 4096); LAS float* gT = (LAS float*)(lds + wave * 4096 + 2048);
        LAS bf16* h2T = (LAS bf16*)(lds + 32768 + wave * 16384);
        const int t0 = 32 * bt + 4 * wave;
#pragma unroll
        for (int i = 0; i < 4; ++i) { const size_t o = (size_t)(t0 + i) * 128; const int wofs = (i * 8 + (lane & 7)) * 16 + (lane >> 3);
            idxT[wofs] = ridx[o + lane]; idxT[wofs + 8] = ridx[o + 64 + lane]; gT[wofs] = rgate[o + lane]; gT[wofs + 8] = rgate[o + 64 + lane]; }
        float hacc[4][2];
#pragma unroll
        for (int i = 0; i < 4; ++i) { hacc[i][0] = 0.f; hacc[i][1] = 0.f; }
        {
            v4u rA[8], rB[8]; f32x2 xA[8], xB[8];
#define PS_SG(s_) (((s_) + 2 * grp) & 15)
#define PS_ISSUE(R, tabbase, s_, i_, hb_) do { const unsigned char* tb_ = (tabbase) + (size_t)PS_SG(s_) * SLICE_BYTES;        \
            const v4u ia_ = *(const LAS v4u*)(idxT + ((i_) * 8 + g8) * 16 + 8 * (hb_)), ib_ = *(const LAS v4u*)(idxT + ((i_) * 8 + g8) * 16 + 8 * (hb_) + 4); const unsigned po_ = 16u * (unsigned)p; \
            R[0] = *(const v4u*)(tb_ + (ia_[0] * 128u + po_)); R[1] = *(const v4u*)(tb_ + (ia_[1] * 128u + po_)); R[2] = *(const v4u*)(tb_ + (ia_[2] * 128u + po_)); R[3] = *(const v4u*)(tb_ + (ia_[3] * 128u + po_)); \
            R[4] = *(const v4u*)(tb_ + (ib_[0] * 128u + po_)); R[5] = *(const v4u*)(tb_ + (ib_[1] * 128u + po_)); R[6] = *(const v4u*)(tb_ + (ib_[2] * 128u + po_)); R[7] = *(const v4u*)(tb_ + (ib_[3] * 128u + po_)); } while (0)
#define PS_LOADX(X, s_, i_) do { const bf16* xp_ = HB + (size_t)(t0 + (i_)) * DM + 128 * PS_SG(s_) + 16 * p; const v4u xa_ = *(const v4u*)xp_, xb_ = *(const v4u*)(xp_ + 8); \
            _Pragma("unroll") for (int q = 0; q < 4; ++q) { X[q] = (f32x2){bflo(xa_[q]), bfhi(xa_[q])}; X[4 + q] = (f32x2){bflo(xb_[q]), bfhi(xb_[q])}; } } while (0)
  \
#define PS_DOTS(R, X, i_, hb_) do { float sd_[8]; _Pragma("unroll") for (int m = 0; m < 8; ++m) { const f32x2 a2_ = dot16p(R[m], X, (f32x2){0.f, 0.f}); sd_[m] = a2_.x + a2_.y; } \
            { const bool c2_ = (p & 4) != 0, c0_ = (p & 1) != 0, c1_ = (p & 2) != 0; float w4_[4], w2_[2]; \
              _Pragma("unroll") for (int k = 0; k < 4; ++k) { const float kp_ = c2_ ? sd_[k + 4] : sd_[k], sn_ = c2_ ? sd_[k] : sd_[k + 4]; w4_[k] = kp_ + DPP_F(sn_, 0x141); }        \
              _Pragma("unroll") for (int k = 0; k < 2; ++k) { const float kp_ = c0_ ? w4_[2 * k + 1] : w4_[2 * k], sn_ = c0_ ? w4_[2 * k] : w4_[2 * k + 1]; w2_[k] = kp_ + DPP_F(sn_, 0xB1); }     \
              const float kp_ = c1_ ? w2_[1] : w2_[0], sn_ = c1_ ? w2_[0] : w2_[1]; hacc[i_][hb_] += kp_ + DPP_F(sn_, 0x4E); }                                                              \
            asm volatile("" ::: "memory"); } while (0)
            PS_LOADX(xA, 0, 0); PS_ISSUE(rA, UB, 0, 0, 0);
            for (int s = 0; s < 16; ++s) {
                PS_ISSUE(rB, UB, s, 0, 1); PS_LOADX(xB, s, 1);  PS_DOTS(rA, xA, 0, 0);
                PS_ISSUE(rA, UB, s, 1, 0);                       PS_DOTS(rB, xA, 0, 1);
                PS_ISSUE(rB, UB, s, 1, 1); PS_LOADX(xA, s, 2);  PS_DOTS(rA, xB, 1, 0);
                PS_ISSUE(rA, UB, s, 2, 0);                       PS_DOTS(rB, xB, 1, 1);
                PS_ISSUE(rB, UB, s, 2, 1); PS_LOADX(xB, s, 3);  PS_DOTS(rA, xA, 2, 0);
                PS_ISSUE(rA, UB, s, 3, 0);                       PS_DOTS(rB, xA, 2, 1);
                PS_ISSUE(rB, UB, s, 3, 1); if (s + 1 < 16) PS_LOADX(xA, s + 1, 0);  PS_DOTS(rA, xB, 3, 0);
                if (s + 1 < 16) PS_ISSUE(rA, UB, s + 1, 0, 0);  PS_DOTS(rB, xB, 3, 1);
            }
#undef PS_LOADX
#undef PS_DOTS
        }
#pragma unroll
        for (int i = 0; i < 4; ++i) { const float rsn = RSTD[t0 + i] * (1.f / U_SCALE);
#pragma unroll
            for (int hb = 0; hb < 2; ++hb) { const float hp = hacc[i][hb] * rsn; LAS float* gp = gT + (i * 8 + g8) * 16 + 8 * hb + p;
                *gp = 0.5f * hp * (1.f + erff(hp * 0.70710678118654752f)) * (1.f / V_SCALE) * *gp; } }
        float ssq[4] = {0.f, 0.f, 0.f, 0.f};
        {
            v4u rA[8], rB[8]; f32x2 y2[8];
#define PS_AXPY(R, i_, hb_) do { const f32x4 aa_ = *(const LAS f32x4*)(gT + ((i_) * 8 + g8) * 16 + 8 * (hb_)), ab_ = *(const LAS f32x4*)(gT + ((i_) * 8 + g8) * 16 + 8 * (hb_) + 4); \
            _Pragma("unroll") for (int m = 0; m < 8; ++m) { const float av_ = m < 4 ? aa_[m & 3] : ab_[m & 3]; if ((hb_) == 0 && m == 0) axpy16p_init(R[m], (f32x2){av_, av_}, y2); else axpy16p(R[m], (f32x2){av_, av_}, y2); } asm volatile("" ::: "memory"); } while (0)
  \
#define PS_FIN(s_, i_) do { f32x2 ysel_; { const bool b3_ = (lane & 8) != 0; float wx_[4], wy_[4]; \
            _Pragma("unroll") for (int k = 0; k < 4; ++k) { const float kx_ = b3_ ? y2[2 * k + 1].x : y2[2 * k].x, sx_ = b3_ ? y2[2 * k].x : y2[2 * k + 1].x, ky_ = b3_ ? y2[2 * k + 1].y : y2[2 * k].y, sy_ = b3_ ? y2[2 * k].y : y2[2 * k + 1].y; \
                wx_[k] = kx_ + DPP_F(sx_, 0x128); wy_[k] = ky_ + DPP_F(sy_, 0x128); } \
            float vx_[2], vy_[2]; \
            _Pragma("unroll") for (int k = 0; k < 2; ++k) { auto rx_ = __builtin_amdgcn_permlane16_swap(__float_as_uint(wx_[2 * k]), __float_as_uint(wx_[2 * k + 1]), false, false); vx_[k] = __uint_as_float(rx_[0]) + __uint_as_float(rx_[1]); \
                auto ry_ = __builtin_amdgcn_permlane16_swap(__float_as_uint(wy_[2 * k]), __float_as_uint(wy_[2 * k + 1]), false, false); vy_[k] = __uint_as_float(ry_[0]) + __uint_as_float(ry_[1]); } \
            auto rx_ = __builtin_amdgcn_permlane32_swap(__float_as_uint(vx_[0]), __float_as_uint(vx_[1]), false, false); auto ry_ = __builtin_amdgcn_permlane32_swap(__float_as_uint(vy_[0]), __float_as_uint(vy_[1]), false, false); \
            ysel_ = (f32x2){__uint_as_float(rx_[0]) + __uint_as_float(rx_[1]), __uint_as_float(ry_[0]) + __uint_as_float(ry_[1])}; } \
            const int d_ = 128 * PS_SG(s_) + 16 * p + 2 * g8; const unsigned hb_ = hbv_; const f32x2 hv_ = (f32x2){bflo(hb_), bfhi(hb_)} + ysel_; \
            *(LAS unsigned*)(h2T + (i_) * DM + d_) = pk2(hv_.x, hv_.y); ssq[i_] += hv_.x * hv_.x + hv_.y * hv_.y; } while (0)
            unsigned hbv_;
#define PS_HB(s_, i_) do { hbv_ = *(const unsigned*)(HB + (size_t)(t0 + (i_)) * DM + 128 * PS_SG(s_) + 16 * p + 2 * g8); } while (0)
            PS_ISSUE(rA, VB, 0, 0, 0);
            for (int s = 0; s < 16; ++s) {
                PS_HB(s, 0); PS_ISSUE(rB, VB, s, 0, 1); PS_AXPY(rA, 0, 0);
                PS_ISSUE(rA, VB, s, 1, 0); PS_AXPY(rB, 0, 1); PS_FIN(s, 0);
                PS_HB(s, 1); PS_ISSUE(rB, VB, s, 1, 1); PS_AXPY(rA, 1, 0);
                PS_ISSUE(rA, VB, s, 2, 0); PS_AXPY(rB, 1, 1); PS_FIN(s, 1);
                PS_HB(s, 2); PS_ISSUE(rB, VB, s, 2, 1); PS_AXPY(rA, 2, 0);
                PS_ISSUE(rA, VB, s, 3, 0); PS_AXPY(rB, 2, 1); PS_FIN(s, 2);
                PS_HB(s, 3); PS_ISSUE(rB, VB, s, 3, 1); PS_AXPY(rA, 3, 0);
                if (s + 1 < 16) PS_ISSUE(rA, VB, s + 1, 0, 0); PS_AXPY(rB, 3, 1); PS_FIN(s, 3);
            }
#undef PS_AXPY
#undef PS_HB
#undef PS_FIN
#undef PS_ISSUE
#undef PS_SG
        }
        { f32x4 fg[8];
#pragma unroll
          for (int j = 0; j < 8; ++j) fg[j] = *(const f32x4*)(P.final_g + 4 * lane + 256 * j);
#pragma unroll
          for (int i = 0; i < 4; ++i) { const float rs2 = 1.0f / sqrtf(wave_sum(ssq[i]) * (1.f / DM) + RMS_EPS);
#pragma unroll
            for (int j = 0; j < 8; ++j) { const v2u hv = *(const LAS v2u*)(h2T + i * DM + 4 * lane + 256 * j);
                __builtin_nontemporal_store((f32x4){bflo(hv.x) * rs2 * fg[j].x, bfhi(hv.x) * rs2 * fg[j].y, bflo(hv.y) * rs2 * fg[j].z, bfhi(hv.y) * rs2 * fg[j].w}, (f32x4*)(P.out + (size_t)(t0 + i) * DM + 4 * lane + 256 * j)); } } }
        asm volatile("" ::: "memory");
    }
}
namespace moba {
constexpr float SCALE = 0.08838834764831845f;
constexpr float THR = 8.f;
constexpr bool WSKIP = false;
constexpr int D = 128, NW = 8, QBLK = 32, KVBLK = 64, QB = NW * QBLK;
constexpr int SHM_V = KVBLK * D * 2, SHM_K = KVBLK * D * 2;
constexpr int ATT_LDS_BYTES = 2 * SHM_V + 2 * SHM_K + NW * 64 * 4;
constexpr int KPITCH = INCP, QPITCH = INCP, OPITCH = DM;
typedef unsigned short bf16;
typedef short bf16x8 __attribute__((ext_vector_type(8)));
typedef short s16x4 __attribute__((ext_vector_type(4)));
typedef float f32x16 __attribute__((ext_vector_type(16)));
typedef float f32x4 __attribute__((ext_vector_type(4)));
typedef unsigned u32x4 __attribute__((ext_vector_type(4)));
template <class A, class Bt> struct same_t { static constexpr bool v = false; };
template <class A> struct same_t<A, A> { static constexpr bool v = true; };
#define KSWZ(row, colB) ((row) * 256 + ((colB) ^ (((row) & 7) << 4)))
#define SBAR() __builtin_amdgcn_sched_barrier(0)
__device__ __forceinline__ int v_st(int k, int c) { const int kk = (k & ~0xC) | ((k & 4) << 1) | ((k & 8) >> 1); return ((kk >> 3) * 4 + (c >> 5)) * 512 + ((kk & 7) * 32 + (c & 31)) * 2; }
__device__ __forceinline__ int v_rd_base(int lane) { return ((lane & 3) << 3) | (((lane >> 2) & 3) << 6) | (((lane >> 4) & 1) << 5) | (((lane >> 5) & 1) << 8); }
constexpr int v_rd_off(int d0, int ks, int half) { return d0 * 512 + ks * 4096 + half * 2048; }
__device__ __forceinline__ int crow(int r, int hi) { return (r & 3) + 8 * (r >> 2) + 4 * hi; }
__device__ __forceinline__ unsigned cvtpk(float lo, float hi) {
    unsigned r; asm volatile("v_cvt_pk_bf16_f32 %0, %1, %2" : "=v"(r) : "v"(lo), "v"(hi)); return r;
}
__device__ __forceinline__ bf16x8 pack8(f32x4 a, f32x4 b) {
    u32x4 w = {cvtpk(a[0], a[1]), cvtpk(a[2], a[3]), cvtpk(b[0], b[1]), cvtpk(b[2], b[3])};
    return *reinterpret_cast<bf16x8*>(&w);
}
template <class T> __device__ __forceinline__ bf16x8 load8(const T* p) {
    if constexpr (same_t<T, float>::v) { return pack8(*(const f32x4*)p, *(const f32x4*)(p + 4)); }
    else { return *reinterpret_cast<const bf16x8*>(p); }
}
__device__ __forceinline__ void mask_tile(f32x16& p0, f32x16& p1, int dq, unsigned W) {
    const float NEG = -__builtin_inff();
#pragma unroll
    for (int r = 0; r < 16; ++r) {
        const int c = (r & 3) + 8 * (r >> 2);
        if ((unsigned)(dq - c) >= W) p0[r] = NEG;
        if ((unsigned)(dq - c - 32) >= W) p1[r] = NEG;
    }
}
__device__ __forceinline__ void partialSM(f32x16& p0, f32x16& p1, float& m_reg, float& mn, float& alpha, float base0, float base1) {
    float pm0 = p0[0]; for (int r = 1; r < 16; ++r) pm0 = fmaxf(pm0, p0[r]); float pm1 = p1[0]; for (int r = 1; r < 16; ++r) pm1 = fmaxf(pm1, p1[r]);
    float pmax = fmaxf(pm0 + base0, pm1 + base1);
    { auto rr = __builtin_amdgcn_permlane32_swap(__float_as_uint(pmax), __float_as_uint(pmax), false, false);
      pmax = fmaxf(__uint_as_float(rr[0]), __uint_as_float(rr[1])); }
    constexpr float C2 = 1.4426950408889634f * SCALE;
    if (__builtin_expect(__all((pmax - m_reg) * SCALE <= THR), 1)) { mn = m_reg; alpha = 1.f; }
    else { mn = fmaxf(m_reg, pmax); alpha = __builtin_amdgcn_exp2f((m_reg - mn) * C2); m_reg = mn; }
    const float mnL0 = (base0 - mn) * C2, mnL1 = (base1 - mn) * C2;
    for (int r = 0; r < 16; ++r) p0[r] = fmaf(p0[r], C2, mnL0); for (int r = 0; r < 16; ++r) p1[r] = fmaf(p1[r], C2, mnL1);
    for (int r = 0; r < 16; ++r) p0[r] = __builtin_amdgcn_exp2f(p0[r]);
}
__device__ __forceinline__ void finishSM(f32x16& p0, f32x16& p1, float alpha, float& l_reg, bf16x8& pa0, bf16x8& pa1, bf16x8& pa2, bf16x8& pa3) {
    for (int r = 0; r < 16; ++r) p1[r] = __builtin_amdgcn_exp2f(p1[r]);
    float ps = 0; for (int r = 0; r < 16; ++r) ps += p0[r]; for (int r = 0; r < 16; ++r) ps += p1[r];
    { auto rr = __builtin_amdgcn_permlane32_swap(__float_as_uint(ps), __float_as_uint(ps), false, false);
      ps = __uint_as_float(rr[0]) + __uint_as_float(rr[1]); }
    l_reg = l_reg * alpha + ps;
#define PK4(P, B_, OUT) do { unsigned a0 = cvtpk(P[B_+0], P[B_+1]), a1 = cvtpk(P[B_+2], P[B_+3]);                          \
        unsigned b0 = cvtpk(P[B_+4], P[B_+5]), b1 = cvtpk(P[B_+6], P[B_+7]);                                             \
        auto r0 = __builtin_amdgcn_permlane32_swap(a0, b0, false, false); auto r1 = __builtin_amdgcn_permlane32_swap(a1, b1, false, false); \
        u32x4 w = {r0[0], r1[0], r0[1], r1[1]}; OUT = *reinterpret_cast<bf16x8*>(&w); } while (0)
    PK4(p0, 0, pa0); PK4(p0, 8, pa1); PK4(p1, 0, pa2); PK4(p1, 8, pa3);
#undef PK4
}
template <int KB, bool SK>
__device__ __forceinline__ void qkt(f32x16& p0, f32x16& p1, const char* K_lds, int r32, int hi, const bf16x8* qr, bool act) {
    if (SK && !act) { const float NEG = -__builtin_inff();
#pragma unroll
        for (int r = 0; r < 16; ++r) { p0[r] = NEG; p1[r] = NEG; } return; }
    p0 = f32x16{}; p1 = f32x16{};
    const char* kb[4];
#pragma unroll
    for (int dd = 0; dd < 4; ++dd) kb[dd] = K_lds + KB * SHM_K + KSWZ(r32, (dd * 16 + hi * 8) * 2);
#pragma unroll
    for (int d0 = 0; d0 < 8; ++d0) { const char* a = kb[d0 & 3] + (d0 >> 2) * 128;
        bf16x8 b0 = *reinterpret_cast<const bf16x8*>(a);
        bf16x8 b1 = *reinterpret_cast<const bf16x8*>(a + 32 * 256);
        p0 = __builtin_amdgcn_mfma_f32_32x32x16_bf16(b0, qr[d0], p0, 0, 0, 0);
        p1 = __builtin_amdgcn_mfma_f32_32x32x16_bf16(b1, qr[d0], p1, 0, 0, 0); }
}
template <int VB, bool SK>
__device__ __forceinline__ void pv_tile(f32x16* o, int vb0, bf16x8 pa0, bf16x8 pa1, bf16x8 pa2, bf16x8 pa3, bool act) {
    if (SK && !act) return;
#define TRRD(dst, off) asm volatile("ds_read_b64_tr_b16 %0, %1 offset:%2" : "=&v"(dst) : "v"(vb0), "i"(off) : "memory")
#define PV_D0(d0) do { s16x4 l0, l1, h0, h1; constexpr int b_ = VB * SHM_V + v_rd_off(d0, 0, 0);     \
        TRRD(l0, b_); TRRD(h0, b_ + 2048); TRRD(l1, b_ + 4096); TRRD(h1, b_ + 6144); \
        asm volatile("s_waitcnt lgkmcnt(0)" ::: "memory"); SBAR();                 \
        o[d0] = __builtin_amdgcn_mfma_f32_32x32x16_bf16(pa0, (bf16x8){l0[0], l0[1], l0[2], l0[3], h0[0], h0[1], h0[2], h0[3]}, o[d0], 0, 0, 0);   \
        o[d0] = __builtin_amdgcn_mfma_f32_32x32x16_bf16(pa1, (bf16x8){l1[0], l1[1], l1[2], l1[3], h1[0], h1[1], h1[2], h1[3]}, o[d0], 0, 0, 0);   \
        SBAR(); TRRD(l0, b_ + 8192); TRRD(h0, b_ + 10240); TRRD(l1, b_ + 12288); TRRD(h1, b_ + 14336); \
        asm volatile("s_waitcnt lgkmcnt(0)" ::: "memory"); SBAR();   \
        o[d0] = __builtin_amdgcn_mfma_f32_32x32x16_bf16(pa2, (bf16x8){l0[0], l0[1], l0[2], l0[3], h0[0], h0[1], h0[2], h0[3]}, o[d0], 0, 0, 0);   \
        o[d0] = __builtin_amdgcn_mfma_f32_32x32x16_bf16(pa3, (bf16x8){l1[0], l1[1], l1[2], l1[3], h1[0], h1[1], h1[2], h1[3]}, o[d0], 0, 0, 0); } while (0)
    PV_D0(0); PV_D0(1); PV_D0(2); PV_D0(3);
#undef PV_D0
#undef TRRD
}

template <class TIn, class TOut> struct BlockRef { const TIn* Q; const TIn* K; const TIn* V; TOut* O; int P0; const float* KM; float A; int jlo, jhi; float* ST; };
template <class TIn> struct Seam {
    bf16x8 qr[8];
    bf16x8 st_v0, st_v1, st_k0, st_k1; f32x4 sf0, sf1, sf2, sf3;
    f32x4 tq[16];
};
__device__ __forceinline__ int swa_jlo(int P0, int W) { const int lowk = P0 - W + 1; return lowk > 0 ? lowk / KVBLK : 0; }
#define ROW(p, k0, rr) ((p) + (size_t)((k0) + (rr)) * KPITCH + sc)
#define VMW() asm volatile("s_waitcnt vmcnt(0)" ::: "memory")
#define VMWN(n) asm volatile("s_waitcnt vmcnt(%0)" :: "i"(n) : "memory")
#define SLOAD_H(Kp, Vp, k0) do { S.st_v0 = load8<TIn>(ROW(Vp, k0, sr)); S.st_v1 = load8<TIn>(ROW(Vp, k0, 32 + sr));              \
                         S.st_k0 = load8<TIn>(ROW(Kp, k0, sr)); S.st_k1 = load8<TIn>(ROW(Kp, k0, 32 + sr)); } while (0)
#define SWRITE_HK(bf) do { *(bf16x8*)(K_lds + (bf) * SHM_K + kws) = S.st_k0; *(bf16x8*)(K_lds + (bf) * SHM_K + kws + 32 * 256) = S.st_k1; } while (0)
#define SWRITE_HV(bf) do { *(bf16x8*)(V_lds + (bf) * SHM_V + vst0) = S.st_v0; *(bf16x8*)(V_lds + (bf) * SHM_V + vst1) = S.st_v1; } while (0)
#define SWRITE_H(bf) do { SWRITE_HV(bf); SWRITE_HK(bf); } while (0)
#define SLOAD_F(p, k0) do { S.sf0 = *(const f32x4*)ROW(p, k0, sr); S.sf1 = *(const f32x4*)(ROW(p, k0, sr) + 4);                \
                            S.sf2 = *(const f32x4*)ROW(p, k0, 32 + sr); S.sf3 = *(const f32x4*)(ROW(p, k0, 32 + sr) + 4); } while (0)
#define SWRITE_KF(bf) do { *(bf16x8*)(K_lds + (bf) * SHM_K + kws) = pack8(S.sf0, S.sf1); *(bf16x8*)(K_lds + (bf) * SHM_K + kws + 32 * 256) = pack8(S.sf2, S.sf3); } while (0)
#define SWRITE_VF(bf) do { *(bf16x8*)(V_lds + (bf) * SHM_V + vst0) = pack8(S.sf0, S.sf1); *(bf16x8*)(V_lds + (bf) * SHM_V + vst1) = pack8(S.sf2, S.sf3); } while (0)
template <class TIn, class TOut>
__device__ __forceinline__ void causal_swa_prime(const BlockRef<TIn, TOut>& cur, int W, char* lds, Seam<TIn>& S) {
    constexpr bool F32 = same_t<TIn, float>::v;
    const int tid = ltid(), wid = __builtin_amdgcn_readfirstlane(tid >> 6), lane = tid & 63, r32 = lane & 31, hi = lane >> 5;
    const int sr = tid >> 4, sc = (tid & 15) * 8, kws = KSWZ(sr, sc * 2); char* K_lds = lds + 2 * SHM_V;
    const int kb0 = cur.jlo * KVBLK;
    for (int d0 = 0; d0 < 8; ++d0) S.qr[d0] = load8<TIn>(cur.Q + (size_t)(wid * QBLK + r32) * QPITCH + d0 * 16 + hi * 8);
    if constexpr (F32) { SLOAD_F((const float*)cur.K, kb0); VMW(); SWRITE_KF(0); SBAR(); SLOAD_F((const float*)cur.V, kb0); }
    else { SLOAD_H(cur.K, cur.V, kb0); VMW(); SWRITE_HK(0); }
    __syncthreads();
}
template <class TIn, class TOut>
__device__ __forceinline__ void causal_swa_block(const BlockRef<TIn, TOut>& cur, const BlockRef<TIn, TOut>& nxt, int skv, int W, char* lds, Seam<TIn>& S) {
    constexpr bool F32 = same_t<TIn, float>::v;
    const int tid = ltid(), wid = __builtin_amdgcn_readfirstlane(tid >> 6), lane = tid & 63, r32 = lane & 31, hi = lane >> 5;
    const int j_lo = cur.jlo, j_hi = cur.jhi;
    const int NT = j_hi - j_lo;
    const int kbn = nxt.jlo * KVBLK;
    const int qlo = cur.P0 + wid * QBLK, qm = qlo + r32 - 4 * hi;
    char* V_lds = lds; char* K_lds = lds + 2 * SHM_V;
    float* ws = (float*)(lds + 2 * SHM_V + 2 * SHM_K) + wid * 64; float* li_l = ws, * al_l = ws + 32;
    float m_reg = -1e30f, l_reg = 0; f32x16 o[4] = {};
    const int sr = tid >> 4, sc = (tid & 15) * 8, vst0 = v_st(sr, sc), vst1 = v_st(32 + sr, sc), kws = KSWZ(sr, sc * 2);
    const int vb0 = (int)(uintptr_t)V_lds + v_rd_base(lane);
    const TIn* Kh = cur.K; const TIn* Vh = cur.V;
    const float alA_ = cur.A;
    unsigned selm = 0u;
    { const int qb_ = cur.P0 >> 8;
      if (qb_ > 0) {
        float* kmL = (float*)(K_lds + SHM_K);
        *(f32x4*)(kmL + 4 * tid) = *(const f32x4*)(cur.KM + (size_t)(tid >> 5) * 1024 + 4 * (tid & 31));
        __syncthreads();
        f32x16 ga = {};
#pragma unroll
        for (int d0 = 0; d0 < 8; ++d0) { const f32x4 k0 = *(const f32x4*)(kmL + r32 * 128 + d0 * 16 + hi * 8), k1 = *(const f32x4*)(kmL + r32 * 128 + d0 * 16 + hi * 8 + 4);
            const bf16x8 ah = pack8(k0, k1); f32x4 e0, e1;
#pragma unroll
            for (int j = 0; j < 4; ++j) { e0[j] = k0[j] - __uint_as_float(((unsigned)(unsigned short)ah[j]) << 16); e1[j] = k1[j] - __uint_as_float(((unsigned)(unsigned short)ah[4 + j]) << 16); }
            const bf16x8 al = pack8(e0, e1);
            ga = __builtin_amdgcn_mfma_f32_32x32x16_bf16(ah, S.qr[d0], ga, 0, 0, 0); ga = __builtin_amdgcn_mfma_f32_32x32x16_bf16(al, S.qr[d0], ga, 0, 0, 0); }
        float g[16];
#pragma unroll
        for (int j = 0; j < 8; ++j) { auto sw = __builtin_amdgcn_permlane32_swap(__float_as_uint(ga[j]), __float_as_uint(ga[j]), false, false);
            const int nb = (j & 3) + 8 * (j >> 2); g[nb] = __uint_as_float(sw[0]); g[nb + 4] = __uint_as_float(sw[1]); }
#pragma unroll
        for (int n = 0; n < 16; ++n) g[n] = n < qb_ ? g[n] : -1e30f;
#pragma unroll
        for (int r = 0; r < 3; ++r) { float best = -3e38f; int bi = 0;
#pragma unroll
            for (int n = 0; n < 16; ++n) if (!((selm >> n) & 1u) && g[n] > best) { best = g[n]; bi = n; }
            selm |= 1u << bi; }
        selm &= (1u << qb_) - 1u;
        __syncthreads();
      }
      li_l[r32] = __uint_as_float(selm); }
#define RESC(a) do { if (__any((a) < 1.f)) { if (hi == 0) al_l[r32] = (a); asm volatile("s_waitcnt lgkmcnt(0)" ::: "memory");              \
                     for (int d_ = 0; d_ < 4; ++d_) for (int r = 0; r < 16; ++r) o[d_][r] *= al_l[crow(r, hi)]; } } while (0)
#define KBASE(t) ((j_lo + (t)) * KVBLK)
#define ACT(t) (KBASE(t) <= qlo + QBLK - 1 && KBASE(t) + KVBLK - 1 >= qlo - W + 1)
#define MASKT(P0_, P1_, t) do { const int kb_ = KBASE(t); if ((!SK || ACT(t)) && (kb_ + KVBLK - 1 > qlo || kb_ <= qlo + QBLK - 1 - W)) mask_tile(P0_, P1_, qm - kb_, (unsigned)W); \
        _Pragma("unroll") for (int r = 0; r < 16; ++r) { const float c_ = (float)((r & 3) + 8 * (r >> 2)); P0_[r] = fmaf(alA_, c_, P0_[r]); P1_[r] = fmaf(alA_, c_, P1_[r]); } } while (0)
#define BASE0(t) ((KBASE(t) < cur.P0 && !((__float_as_uint(li_l[r32]) >> (KBASE(t) >> 8)) & 1u)) ? -__builtin_inff() : alA_ * (float)(KBASE(t) - cur.P0 + 4 * hi))
#define BASE1(t) (BASE0(t) + 32.f * alA_)
    constexpr int NQL = F32 ? 16 : 8;
    constexpr bool SK = WSKIP && !F32;
#define SEAM_K0() do { VMWN(NQL); if constexpr (F32) { SWRITE_KF(0); SBAR(); SLOAD_F((const float*)nxt.V, kbn); } else { SWRITE_HK(0); } SBAR(); } while (0)
    f32x16 pA0, pA1, pB0, pB1; float mnA, mnB, alA, alB; bf16x8 pa0, pa1, pa2, pa3;
    if constexpr (F32) { VMW(); SWRITE_VF(0); SBAR(); } else { SWRITE_HV(0); SBAR(); }
    if (NT > 1) { if constexpr (F32) SLOAD_F((const float*)Kh, KBASE(1)); else SLOAD_H(Kh, Vh, KBASE(1)); }
    SBAR(); qkt<0, SK>(pA0, pA1, K_lds, r32, hi, S.qr, ACT(0));
    if constexpr (F32) { if (NT > 1) { VMW(); SWRITE_KF(1); SBAR(); SLOAD_F((const float*)Vh, KBASE(1)); } }
    MASKT(pA0, pA1, 0); partialSM(pA0, pA1, m_reg, mnA, alA, BASE0(0), BASE1(0));
    if (NT > 1) { VMW(); if constexpr (F32) { SWRITE_VF(1); SBAR(); if (NT > 2) SLOAD_F((const float*)Kh, KBASE(2)); } else SWRITE_H(1); }
    __syncthreads();
#define HALF_STEP(PX0, PX1, mnX, alX, PY0, PY1, alY, t, KB, VB, SB) do {                                                      \
        SBAR(); qkt<KB, SK>(PX0, PX1, K_lds, r32, hi, S.qr, ACT(t));                                             \
        finishSM(PY0, PY1, alY, l_reg, pa0, pa1, pa2, pa3); SBAR();                                                           \
        if ((t) + 1 < NT) { if constexpr (F32) { VMW(); SWRITE_KF(SB); SBAR(); SLOAD_F((const float*)Vh, KBASE((t) + 1)); }  \
                            else { SLOAD_H(Kh, Vh, KBASE((t) + 1)); } SBAR(); }                                               \
        pv_tile<VB, SK>(o, vb0, pa0, pa1, pa2, pa3, ACT((t) - 1)); MASKT(PX0, PX1, (t)); partialSM(PX0, PX1, m_reg, mnX, alX, BASE0(t), BASE1(t));                                        \
        __syncthreads();                                                                                                      \
        if ((t) + 1 < NT) { VMW(); if constexpr (F32) { SWRITE_VF(SB); SBAR(); if ((t) + 2 < NT) SLOAD_F((const float*)Kh, KBASE((t) + 2)); } \
                            else { SWRITE_H(SB); } }                                                                          \
        RESC(alX); __syncthreads(); } while (0)
    for (int t = 1; t + 1 < NT; t += 2) {
        HALF_STEP(pB0, pB1, mnB, alB, pA0, pA1, alA, t, 1, 0, 0);
        HALF_STEP(pA0, pA1, mnA, alA, pB0, pB1, alB, t + 1, 0, 1, 1);
    }
    const bool even = (NT & 1) == 0;
    if (even) { SBAR(); qkt<1, SK>(pB0, pB1, K_lds, r32, hi, S.qr, ACT(NT - 1)); SBAR(); }
#define QROW(e) (nxt.Q + (size_t)(wid * QBLK + r32) * QPITCH + ((e) >> 1) * 16 + hi * 8 + ((e) & 1) * 4)
    if constexpr (F32) { SLOAD_F((const float*)nxt.K, kbn); SBAR();
#pragma unroll
        for (int e = 0; e < 8; ++e) S.tq[e] = *(const f32x4*)QROW(e); }
    else { SLOAD_H(nxt.K, nxt.V, kbn); SBAR();
#pragma unroll
        for (int d0 = 0; d0 < 8; ++d0) S.qr[d0] = load8<TIn>(nxt.Q + (size_t)(wid * QBLK + r32) * QPITCH + d0 * 16 + hi * 8); }
    SBAR();
    finishSM(pA0, pA1, alA, l_reg, pa0, pa1, pa2, pa3); SBAR();
    if constexpr (F32) {
#pragma unroll
        for (int e = 8; e < 16; ++e) S.tq[e] = *(const f32x4*)QROW(e); SBAR(); }
#undef QROW
    pv_tile<0, SK>(o, vb0, pa0, pa1, pa2, pa3, ACT(even ? NT - 2 : NT - 1));
    if (even) { MASKT(pB0, pB1, NT - 1); partialSM(pB0, pB1, m_reg, mnB, alB, BASE0(NT - 1), BASE1(NT - 1)); __syncthreads(); RESC(alB);
        finishSM(pB0, pB1, alB, l_reg, pa0, pa1, pa2, pa3); SBAR(); pv_tile<1, SK>(o, vb0, pa0, pa1, pa2, pa3, ACT(NT - 1)); }
    SBAR(); SEAM_K0();
    if (hi == 0) { li_l[r32] = l_reg; if (cur.ST) { cur.ST[(wid * QBLK + r32) * 16] = m_reg; cur.ST[(wid * QBLK + r32) * 16 + 1] = l_reg; } }
    asm volatile("s_waitcnt lgkmcnt(0)" ::: "memory");
    float rli[16];
#pragma unroll
    for (int r = 0; r < 16; ++r) { const float l_ = li_l[crow(r, hi)]; rli[r] = l_ > 0.f ? __builtin_amdgcn_rcpf(l_) : 0.f; }
    TOut* Ow = cur.O + (size_t)(wid * QBLK) * OPITCH;
#pragma unroll
    for (int r = 0; r < 16; ++r) { const int orow = crow(r, hi);
#pragma unroll
        for (int d0 = 0; d0 < 4; ++d0) { const float v = o[d0][r] * rli[r];
            if constexpr (same_t<TOut, float>::v) { Ow[(size_t)orow * OPITCH + d0 * 32 + r32] = v; }
            else { const float vn = __shfl_xor(v, 1);
                   if ((r32 & 1) == 0) *(unsigned*)(Ow + (size_t)orow * OPITCH + d0 * 32 + r32) = cvtpk(v, vn); } } }
    if constexpr (F32) {
#pragma unroll
        for (int d0 = 0; d0 < 8; ++d0) S.qr[d0] = pack8(S.tq[2 * d0], S.tq[2 * d0 + 1]); }
    __syncthreads();
#undef RESC
#undef KBASE
#undef ACT
#undef MASKT
#undef SEAM_K0
#undef HALF_STEP
}
#undef ROW
#undef VMW
#undef VMWN
#undef SLOAD_H
#undef SWRITE_HK
#undef SWRITE_HV
#undef SWRITE_H
#undef SLOAD_F
#undef SWRITE_KF
#undef SWRITE_VF

#undef BASE0
#undef BASE1
}
constexpr size_t WS_OSL = WS_XN, WS_OSU = WS_H;
constexpr size_t WS_STL = WS_WIN, WS_STU = WS_WIN + 1 * MiB;
constexpr int MOBA_SPLIT_QB = 9, MOBA_SPLIT_AT = 38;
__device__ __forceinline__ void phase_moba(KP P, char* lds, int vcu, int G) {
    typedef moba::BlockRef<moba::bf16, moba::bf16> BR;
    const moba::bf16* proj = (const moba::bf16*)(P.ws + WS_PROJ); moba::bf16* AR = (moba::bf16*)(P.ws + WS_AR); const float* kmean = (const float*)(P.ws + WS_KMEAN);
    constexpr int W = 1 << 30;
    auto mkref = [&](int bh, int qb, int part) -> BR { const int b = bh >> 3, h = bh & 7; BR r; const int nt = 4 * qb + 4;
        r.Q = proj + (size_t)(b * SEQ + qb * 256) * INCP + h * 128; r.K = proj + (size_t)(b * SEQ) * INCP + C_AK + h * 128; r.V = proj + (size_t)(b * SEQ) * INCP + C_AV + h * 128;
        moba::bf16* ob = part == 0 ? AR : (moba::bf16*)(P.ws + (part == 1 ? WS_OSL : WS_OSU));
        r.O = ob + (size_t)(b * SEQ + qb * 256) * DM + h * 128; r.P0 = qb * 256; r.KM = kmean + (size_t)(b * 16) * 1024 + h * 128; r.A = exp2f(-(float)(h + 1)) * (1.f / moba::SCALE);
        const int ks = qb == MOBA_SPLIT_QB ? nt - 4 : MOBA_SPLIT_AT;
        r.jlo = part == 2 ? ks : 0; r.jhi = part == 1 ? ks : nt;
        r.ST = part == 0 ? nullptr : (float*)(P.ws + (part == 1 ? WS_STL : WS_STU)) + ((size_t)(b * SEQ + qb * 256) * 8 + h) * 2;
        return r; };
    moba::Seam<moba::bf16> S;
    if (G == 256) {
        const int q_ = vcu & 15, bh = vcu >> 4;
        const int qbA[16] = { 1,  0,  7,  6,  5,  4,  3,  2, 15, 14, 13, 12, 11, 10,  9,  8};
        const int ptA[16] = { 0,  0,  0,  0,  0,  0,  0,  0,  1,  1,  1,  1,  1,  1,  1,  0};
        const int qbB[16] = {-1,  9, 10, 11, 12, 13, 14, 15, -1, -1, -1, -1, -1, -1, -1, -1};
        const int ptB[16] = { 0,  2,  2,  2,  2,  2,  2,  2,  0,  0,  0,  0,  0,  0,  0,  0};
        int qa = -1, pa = 0, qb2 = -1, pb = 0;
#pragma unroll
        for (int k = 0; k < 16; ++k) if (k == q_) { qa = qbA[k]; pa = ptA[k]; qb2 = qbB[k]; pb = ptB[k]; }
        for (int it = 0; it < 2; ++it) { const int qq = it == 0 ? qa : qb2, pp = it == 0 ? pa : pb; if (qq < 0) continue;
            const BR cur = mkref(bh, qq, pp);
            moba::causal_swa_prime<moba::bf16, moba::bf16>(cur, W, lds, S);
            moba::causal_swa_block<moba::bf16, moba::bf16>(cur, cur, SEQ, W, lds, S); }
    } else {
        for (int item = vcu; item < 256; item += G) {
            const BR cur = mkref(item >> 4, item & 15, 0);
            moba::causal_swa_prime<moba::bf16, moba::bf16>(cur, W, lds, S);
            moba::causal_swa_block<moba::bf16, moba::bf16>(cur, cur, SEQ, W, lds, S); }
    }
}
__device__ __forceinline__ void moba_combine(KP P, int vcu, int G) {
    if (G != 256) return;
    const int tid = ltid(); const bf16* OL = (const bf16*)(P.ws + WS_OSL); const bf16* OU = (const bf16*)(P.ws + WS_OSU); bf16* AR = (bf16*)(P.ws + WS_AR);
    const float* STL = (const float*)(P.ws + WS_STL); const float* STU = (const float*)(P.ws + WS_STU);
    constexpr int NSPL = 16 - MOBA_SPLIT_QB; constexpr float C2 = 1.4426950408889634f * moba::SCALE;
    for (int item = vcu; item < 16 * NSPL * 2; item += G) {
        const int half = item & 1, k = item >> 1, bh = k / NSPL, qb = MOBA_SPLIT_QB + k % NSPL, b = bh >> 3, h = bh & 7;
        const int row = b * SEQ + qb * 256 + half * 128 + (tid >> 2), c0 = (tid & 3) * 32;
        const size_t so = ((size_t)row * 8 + h) * 2; const float mL = STL[so], lL = STL[so + 1], mU = STU[so], lU = STU[so + 1];
        const float m = fmaxf(mL, mU); const float wL = lL * __builtin_amdgcn_exp2f((mL - m) * C2), wU = lU * __builtin_amdgcn_exp2f((mU - m) * C2); const float inv = __builtin_amdgcn_rcpf(wL + wU);
        const float aL = wL * inv, aU = wU * inv; const size_t o = (size_t)row * DM + h * 128 + c0;
        v4u l4[4], u4[4];
#pragma unroll
        for (int j = 0; j < 4; ++j) { l4[j] = *(const v4u*)(OL + o + 8 * j); u4[j] = *(const v4u*)(OU + o + 8 * j); }
#pragma unroll
        for (int j = 0; j < 4; ++j) { v4u r4;
#pragma unroll
            for (int e = 0; e < 4; ++e) r4[e] = pk2(aL * bflo(l4[j][e]) + aU * bflo(u4[j][e]), aL * bfhi(l4[j][e]) + aU * bfhi(u4[j][e]));
            *(v4u*)(AR + o + 8 * j) = r4; }
    }
}
constexpr size_t WS_SKB = WS_KMEAN + 256 * 1024;
__device__ __forceinline__ void prologue_subkeys(KP P, int vcu, int G) {
    unsigned* dst = (unsigned*)(P.ws + WS_SKB);
    for (int i = vcu * NTHR + ltid(); i < 8 * 2 * 128 * 128 / 2; i += G * NTHR) dst[i] = pk2(P.sub_keys[2 * i], P.sub_keys[2 * i + 1]);
}
__device__ __forceinline__ unsigned f2key(float v) { const unsigned u = __float_as_uint(v); return u ^ ((u >> 31) ? 0xFFFFFFFFu : 0x80000000u); }
__device__ __forceinline__ float key2f(unsigned k) { return __uint_as_float(k ^ ((k >> 31) ? 0x80000000u : 0xFFFFFFFFu)); }
__device__ __forceinline__ unsigned umax3(unsigned a, unsigned b, unsigned c) { return max(max(a, b), c); }
__device__ __forceinline__ void peer_route_tiles(KP P, LAS unsigned char* lds, int tt0, int nitems, int h) {
    const int tid = ltid(), lane = tid & 63, wave = __builtin_amdgcn_readfirstlane(tid >> 6), l15 = lane & 15, q4 = lane >> 4;
    const bf16* PQ = (const bf16*)(P.ws + WS_PROJ); const bf16* SKB = (const bf16*)(P.ws + WS_SKB);
    int* ridx = (int*)(P.ws + WS_PROJ + 64 * MiB); float* rgate = (float*)(P.ws + WS_PROJ + 68 * MiB);
    LAS unsigned char* skl = lds + 65536;
    { const bf16* src = SKB + (size_t)(h * 2) * 128 * 128;
#pragma unroll
      for (int j = 0; j < 8; ++j) { const int e = tid + j * NTHR, row = e >> 4, pc = e & 15; *(LAS v4u*)(skl + row * 272 + pc * 16) = *(const v4u*)(src + (size_t)row * 128 + pc * 8); } }
    __syncthreads();
    for (int it_ = 0; it_ < nitems; ++it_) {
        LAS float* sval = (LAS float*)(lds + it_ * 16384); LAS int* sidx = (LAS int*)(lds + it_ * 16384 + 8192);
        const int tt = tt0 + it_, p = wave & 1, sub = wave >> 1, tl = sub * 16 + l15;
        const bf16* qp = PQ + ((size_t)tt * 64 + tl) * DM + h * 256 + p * 128 + 8 * q4;
        bf16x8 qb[4];
#pragma unroll
        for (int kk = 0; kk < 4; ++kk) qb[kk] = *(const bf16x8*)(qp + 32 * kk);
        const LAS unsigned char* sk = skl + (p * 128 + l15) * 272 + 16 * q4;
        unsigned key[32];
#pragma unroll
        for (int nt = 0; nt < 8; ++nt) { f32x4v acc = {0.f, 0.f, 0.f, 0.f};
#pragma unroll
            for (int kk = 0; kk < 4; ++kk) acc = __builtin_amdgcn_mfma_f32_16x16x32_bf16(*(const LAS bf16x8*)(sk + nt * 16 * 272 + 64 * kk), qb[kk], acc, 0, 0, 0);
#pragma unroll
            for (int e = 0; e < 4; ++e) key[4 * nt + e] = (f2key(acc[e]) & ~127u) | (unsigned)(127 - (16 * nt + 4 * q4 + e)); }
#define CE(a_, b_) { const unsigned hi_ = max(KA[a_], KA[b_]), lo_ = min(KA[a_], KA[b_]); KA[a_] = hi_; KA[b_] = lo_; }
#define SORT16_NET CE(0,1) CE(2,3) CE(0,2) CE(1,3) CE(1,2) CE(4,5) CE(6,7) CE(4,6) CE(5,7) CE(5,6) CE(0,4) CE(2,6) CE(2,4) CE(1,5) CE(3,7) CE(3,5) CE(1,2) CE(3,4) CE(5,6) CE(8,9) CE(10,11) CE(8,10) CE(9,11) CE(9,10) CE(12,13) CE(14,15) CE(12,14) CE(13,15) CE(13,14) CE(8,12) CE(10,14) CE(10,12) CE(9,13) CE(11,15) CE(11,13) CE(9,10) CE(11,12) CE(13,14) CE(0,8) CE(4,12) CE(4,8) CE(2,10) CE(6,14) CE(6,10) CE(2,4) CE(6,8) CE(10,12) CE(1,9) CE(5,13) CE(5,9) CE(3,11) CE(7,15) CE(7,11) CE(3,5) CE(7,9) CE(11,13) CE(1,2) CE(3,4) CE(5,6) CE(7,8) CE(9,10) CE(11,12) CE(13,14)
#define BMERGE16(T_) _Pragma("unroll") for (int d_ = 8; d_ >= 1; d_ >>= 1) { _Pragma("unroll") for (int i_ = 0; i_ < 16; ++i_) if ((i_ & d_) == 0) { const unsigned hi_ = max(T_[i_], T_[i_ + d_]), lo_ = min(T_[i_], T_[i_ + d_]); T_[i_] = hi_; T_[i_ + d_] = lo_; } }
#define KA key
        SORT16_NET
#undef KA
#define KA (key + 16)
        SORT16_NET
#undef KA
        unsigned t16[16];
#pragma unroll
        for (int i = 0; i < 16; ++i) t16[i] = max(key[i], key[31 - i]);
        BMERGE16(t16)
        { const bool odd = (lane & 16) != 0; unsigned L[16];
#pragma unroll
          for (int i = 0; i < 16; ++i) L[i] = odd ? t16[15 - i] : t16[i];
#pragma unroll
          for (int i = 0; i < 16; ++i) { auto x = __builtin_amdgcn_permlane16_swap(L[i], L[i], false, false); t16[i] = max(x[0], x[1]); }
          BMERGE16(t16) }
        { const bool odd = (lane & 32) != 0; unsigned L[16];
#pragma unroll
          for (int i = 0; i < 16; ++i) L[i] = odd ? t16[15 - i] : t16[i];
#pragma unroll
          for (int i = 0; i < 16; ++i) { auto x = __builtin_amdgcn_permlane32_swap(L[i], L[i], false, false); t16[i] = max(x[0], x[1]); }
          BMERGE16(t16) }
#undef CE
#undef SORT16_NET
#undef BMERGE16
        if (q4 == 0) {
#pragma unroll
            for (int r4 = 0; r4 < 4; ++r4) {
                *(LAS f32x4*)(sval + (tl * 2 + p) * 16 + 4 * r4) = (f32x4){key2f(t16[4 * r4] & ~127u), key2f(t16[4 * r4 + 1] & ~127u), key2f(t16[4 * r4 + 2] & ~127u), key2f(t16[4 * r4 + 3] & ~127u)};
                *(LAS v4u*)(sidx + (tl * 2 + p) * 16 + 4 * r4) = (v4u){127u - (t16[4 * r4] & 127u), 127u - (t16[4 * r4 + 1] & 127u), 127u - (t16[4 * r4 + 2] & 127u), 127u - (t16[4 * r4 + 3] & 127u)}; }
        }
    }
    __syncthreads();
    {
        const int it_ = wave; const int tt = tt0 + it_;
        LAS float* sval = (LAS float*)(lds + it_ * 16384); LAS int* sidx = (LAS int*)(lds + it_ * 16384 + 8192);
        if (wave < nitems) {
            const LAS float* av = sval + (lane * 2) * 16; const LAS float* bv = av + 16; const LAS int* ai = sidx + (lane * 2) * 16; const LAS int* bi = ai + 16;
            unsigned hk[16];
            const float b0 = bv[0];
#pragma unroll
            for (int i4 = 0; i4 < 4; ++i4) { const f32x4 t4 = *(const LAS f32x4*)(av + 4 * i4);
#pragma unroll
                for (int e = 0; e < 4; ++e) hk[4 * i4 + e] = (f2key(t4[e] + b0) & ~255u) | (unsigned)(255 - (4 * i4 + e) * 16); }
            float bestv[16]; int beste[16];
#pragma unroll
            for (int r = 0; r < 16; ++r) {
                unsigned m0 = umax3(hk[0], hk[1], hk[2]), m1 = umax3(hk[3], hk[4], hk[5]), m2 = umax3(hk[6], hk[7], hk[8]), m3 = umax3(hk[9], hk[10], hk[11]);
                m0 = umax3(m0, hk[12], hk[13]); m1 = umax3(m1, hk[14], hk[15]);
                const unsigned best = max(max(m0, m1), max(m2, m3));
                const int f = 255 - (int)(best & 255u), bi_ = f >> 4, bj = f & 15;
                const float a_i = av[bi_]; bestv[r] = a_i + bv[bj]; beste[r] = ai[bi_] * 128 + bi[bj];
                const int nj = bj + 1;
                const unsigned nk = nj < 16 ? ((f2key(a_i + bv[nj & 15]) & ~255u) | (unsigned)(255 - (bi_ * 16 + nj))) : 0u;
#pragma unroll
                for (int i = 0; i < 16; ++i) hk[i] = i == bi_ ? nk : hk[i];
            }
            float rsd; { const f32x4* sp = (const f32x4*)((const float*)(P.ws + WS_SSP) + ((size_t)tt * 64 + lane) * 32); float a = 0.f;
#pragma unroll
                for (int j = 0; j < 8; ++j) { const f32x4 v = sp[j]; a += (v.x + v.y) + (v.z + v.w); }
                rsd = 1.0f / sqrtf(a * (1.f / DM) + RMS_EPS); ((float*)(P.ws + WS_SSP + 2 * MiB))[(size_t)tt * 64 + lane] = rsd; }
            float se = 0.f; const float mx = bestv[0];
#pragma unroll
            for (int r = 0; r < 16; ++r) { bestv[r] = __expf((bestv[r] - mx) * rsd); se += bestv[r]; }
            const float ise = 1.f / se; const size_t o = ((size_t)tt * 64 + lane) * 128 + h * 16;
#pragma unroll
            for (int r4 = 0; r4 < 4; ++r4) { *(v4u*)(ridx + o + 4 * r4) = (v4u){(unsigned)beste[4 * r4], (unsigned)beste[4 * r4 + 1], (unsigned)beste[4 * r4 + 2], (unsigned)beste[4 * r4 + 3]};
                *(f32x4*)(rgate + o + 4 * r4) = (f32x4){bestv[4 * r4] * ise, bestv[4 * r4 + 1] * ise, bestv[4 * r4 + 2] * ise, bestv[4 * r4 + 3] * ise}; }
        }
        __syncthreads();
    }
}
#define XB_TMO      128
#define XB_XCNT(j)  (256  + 64 * (j))
#define XB_XSUB(j)  (1280 + 64 * (j))
#define XB_XGEN(j)  (2304 + 64 * (j))
#define XB_TOP      3328
#define XB_TOPGEN   3392
#define XCD_BAR_WORDS 3456
#define XB_SPIN_CAP (1u << 18)

__device__ __forceinline__ unsigned xb_ld(unsigned* p)              { return __hip_atomic_load(p, __ATOMIC_RELAXED, __HIP_MEMORY_SCOPE_AGENT); }
__device__ __forceinline__ unsigned xb_add(unsigned* p, unsigned v) { return __hip_atomic_fetch_add(p, v, __ATOMIC_RELAXED, __HIP_MEMORY_SCOPE_AGENT); }
__device__ __forceinline__ unsigned xb_xcc_id() { return (unsigned)__builtin_amdgcn_s_getreg((3 << 11) | 20) & 0xFu; }
#define XB_SPIN(cond, bar) do { unsigned _sp = 0; while (cond) { __builtin_amdgcn_s_sleep(1); \
    if ((++_sp & 255u) == 0u) { if (xb_ld(&(bar)[XB_TMO])) break; if (_sp > XB_SPIN_CAP) { atomicAdd(&(bar)[XB_TMO], 1u); break; } } } } while (0)

struct XcdBarrier {
    unsigned* bar; unsigned x;
    volatile LAS unsigned* st;
};

__device__ __forceinline__ XcdBarrier xcd_barrier_post(unsigned* bar, volatile LAS unsigned* st) {
    XcdBarrier b; b.bar = bar; b.x = xb_xcc_id(); b.st = st;
    if (threadIdx.x == 0) (void)xb_add(&bar[XB_XCNT(b.x)], 1u);
    return b;
}
__device__ __forceinline__ void xcd_barrier_complete(unsigned* bar, unsigned x, unsigned& nloc, unsigned& nx) {
    const unsigned G = gridDim.x * gridDim.y * gridDim.z;
    unsigned sum, cnt, mine, sp = 0u;
    for (;;) {
        sum = 0u; cnt = 0u; mine = 0u;
#pragma unroll
        for (unsigned j = 0; j < 16; ++j) { const unsigned c = xb_ld(&bar[XB_XCNT(j)]); sum += c; cnt += (c > 0u) ? 1u : 0u; mine = (j == x) ? c : mine; }
        if (sum == G) break;
        __builtin_amdgcn_s_sleep(1);
        if ((++sp & 255u) == 0u) { if (xb_ld(&bar[XB_TMO])) break; if (sp > XB_SPIN_CAP) { atomicAdd(&bar[XB_TMO], 1u); break; } }
    }
    nloc = mine > 0u ? mine : 1u; nx = cnt > 0u ? cnt : 1u;
}

__device__ __forceinline__ void xcd_barrier(const XcdBarrier& b) {
    asm volatile("s_waitcnt vmcnt(0)" ::: "memory");
    __syncthreads();
    if (threadIdx.x == 0) {
        unsigned* bar = b.bar;
        __builtin_amdgcn_s_waitcnt(0);
        unsigned nloc = b.st[0], nx = b.st[1];
        if (nloc == 0u) { xcd_barrier_complete(bar, b.x, nloc, nx); b.st[0] = nloc; b.st[1] = nx; }
        const unsigned old = xb_add(&bar[XB_XSUB(b.x)], 1u);
        const unsigned gen = old / nloc;
        if (old + 1u == (gen + 1u) * nloc) {
            __builtin_amdgcn_fence(__ATOMIC_RELEASE, "agent");
            asm volatile("s_waitcnt vmcnt(0)" ::: "memory");
            const unsigned og = xb_add(&bar[XB_TOP], 1u);
            const unsigned tg = og / nx;
            if (og + 1u == (tg + 1u) * nx) xb_add(&bar[XB_TOPGEN], 1u);
            else XB_SPIN(xb_ld(&bar[XB_TOPGEN]) == tg, bar);
            __builtin_amdgcn_fence(__ATOMIC_ACQUIRE, "agent");
            xb_add(&bar[XB_XGEN(b.x)], 1u);
            asm volatile("s_waitcnt vmcnt(0)" ::: "memory");
        } else {
            XB_SPIN(xb_ld(&bar[XB_XGEN(b.x)]) == gen, bar);
            __builtin_amdgcn_fence(__ATOMIC_ACQUIRE, "agent");
            asm volatile("s_waitcnt vmcnt(0)" ::: "memory");
        }
    }
    __syncthreads();
}
#ifndef MK_ONE_LAUNCH
#define MK_ONE_LAUNCH 1
#endif
constexpr int N_PHASES = 11;
__global__ void __launch_bounds__(NTHR, 2) mega(Params Pkernarg) {
    extern __shared__ __attribute__((aligned(16))) unsigned char lds_raw[];
    LAS unsigned char* lds = (LAS unsigned char*)lds_raw;
    const int tid = ltid();
    const int G = gridDim.x, bx = blockIdx.x; const int vcu = (G % 8 == 0) ? (bx % 8) * (G / 8) + bx / 8 : bx;
    for (int u = tid; u < (LDS_BYTES - LDSCTL_OFF) / 4; u += NTHR) ((LAS unsigned*)(lds + LDSCTL_OFF))[u] = 0u;
    __syncthreads();
#if MK_ONE_LAUNCH
    XcdBarrier bar = xcd_barrier_post((unsigned*)(params_ptr()->ws + WS_CTL) + CW_BAR + params_ptr()->bar_li * XCD_BAR_WORDS, (volatile LAS unsigned*)(lds + MISC_OFF) + 8);
#define GRID_BAR() xcd_barrier(bar)
#else
#define GRID_BAR() do {} while (0)
#endif
#ifndef PHOFF
#define PHOFF 0
#endif
#define IN(k) (!((PHOFF >> (k)) & 1))
#define BOTH(k) (IN(k) && IN((k) + 1))
    if (IN(0)) { KP P = *params_ptr(); phase_prologue(P, lds, vcu, G); prologue_subkeys(P, vcu, G); prologue_lora(P, vcu, G); if (BOTH(0)) GRID_BAR(); }
    if (IN(1)) { KP P = *params_ptr();
        pg8::Gemm g{(const bf16*)(P.ws + WS_XN), (const bf16*)(P.ws + WS_WIN), TT, INCP, DM}; pg8::Order1 S; S.init(TT, INCP, G, bx);
        pg8::EpiBf16<0> E{(bf16*)(P.ws + WS_PROJ), INCP, nullptr, 0, 0, 1.f};
        pg8::gemm_phase<pg8::EpiBf16<0>, pg8::Order1, true, true>(lds, g, S, E);
        phase_convert_tables(P, lds); phase_transpose_late(P, lds);
        if (BOTH(1)) GRID_BAR();
    }
    if (IN(2)) { KP P = *params_ptr(); phase_act(P, vcu, G); phase_kmean(P, lds, vcu, G); if (BOTH(2)) GRID_BAR(); }
    if (IN(3)) { KP P = *params_ptr(); phase_rwkv_stage_a(P, lds, vcu, G); if (BOTH(3)) GRID_BAR(); }
    if (IN(4)) { KP P = *params_ptr(); if ((vcu & 15) < 2 && vcu < 256) rwkv_stage_b(P, lds, (vcu >> 4) * 2 + (vcu & 15)); phase_moba(P, (char*)lds_raw, vcu, G); }
    if (IN(5)) { GRID_BAR(); KP P = *params_ptr(); moba_combine(P, vcu, G); GRID_BAR(); }
    if (IN(6)) { KP P = *params_ptr();
        pg8::Gemm g{(const bf16*)(P.ws + WS_AR), (const bf16*)(P.ws + WS_WOUT), TT, DM, DM}; pg8::StaticOrder S; S.init(TT, DM, G, bx);
        pg8::EpiH E{P.x, (bf16*)(P.ws + WS_XN), (float*)(P.ws + WS_SSP), DM};
        pg8::gemm_phase<pg8::EpiH, pg8::StaticOrder, true, true>(lds, g, S, E);
        if (BOTH(6)) GRID_BAR();
    }
    if (IN(8)) { KP P = *params_ptr();
        pg8::Gemm g{(const bf16*)(P.ws + WS_XN), (const bf16*)(P.ws + WS_WQ), TT, DM, DM}; pg8::StaticOrder S; S.init(TT, DM, G, bx);
        pg8::EpiBf16<0> E{(bf16*)(P.ws + WS_PROJ), DM, nullptr, 0, 0, 1.f};
        pg8::gemm_phase<pg8::EpiBf16<0>, pg8::StaticOrder, true, true>(lds, g, S, E);
        if (G == 256) { const int wg_ = (bx & 7) * 32 + (bx >> 3); pg8::Unit u; u.pm = (wg_ >> 6) * 8 + (wg_ & 7); u.pn = (wg_ & 63) >> 3;
            asm volatile("s_waitcnt vmcnt(0)" ::: "memory"); __syncthreads(); __builtin_amdgcn_fence(__ATOMIC_ACQUIRE, "agent"); asm volatile("s_waitcnt vmcnt(0)" ::: "memory");
            peer_route_tiles(P, lds, 4 * u.pm, 4, u.pn);
        } else if (G != 256) { GRID_BAR(); for (int item = vcu; item < 1024; item += G) peer_route_tiles(P, lds, item >> 3, 1, item & 7); }
        if (BOTH(8)) GRID_BAR();
    }
    if (IN(10)) { KP P = *params_ptr(); phase_peer_sliced(P, lds, bx, G); }
#undef IN
#undef BOTH
}

extern "C" void kernel_launch(void* const* d_in, const int* in_sizes, int n_in, void* d_out, int out_size, void* d_ws, size_t ws_size, hipStream_t stream) {
    static int grid = 0;
    if (grid == 0) {
        if (n_in != 21 || in_sizes[0] != TT * DM || out_size != TT * DM || ws_size < WS_END) {
            fprintf(stderr, "kernel_launch: unexpected shapes: n_in %d in0 %d out %d ws %zu\n", n_in, n_in > 0 ? in_sizes[0] : -1, out_size, ws_size); grid = -1; return; }
        int dev = 0, cus = 0;
        if (hipGetDevice(&dev) != hipSuccess || hipDeviceGetAttribute(&cus, hipDeviceAttributeMultiprocessorCount, dev) != hipSuccess) { grid = -1; return; }
        if (hipFuncSetAttribute((const void*)mega, hipFuncAttributeMaxDynamicSharedMemorySize, LDS_BYTES) != hipSuccess) { fprintf(stderr, "kernel_launch: hipFuncSetAttribute failed\n"); grid = -1; return; }
        int per_cu = 0;
        if (hipOccupancyMaxActiveBlocksPerMultiprocessor(&per_cu, (const void*)mega, NTHR, LDS_BYTES) != hipSuccess || per_cu < 1) fprintf(stderr, "kernel_launch: occupancy query says %d blocks per CU\n", per_cu);
        (void)hipGetLastError();
        grid = cus;
    }
    if (grid < 0) return;
    (void)hipMemsetAsync((char*)d_ws + WS_CTL, 0, CTL_ZERO_BYTES, stream);
    Params p{};
    p.x = (const float*)d_in[0]; p.norm1_g = (const float*)d_in[1]; p.w_in = (const float*)d_in[2]; p.mu = (const float*)d_in[3]; p.w0 = (const float*)d_in[4];
    p.w2 = (const float*)d_in[5]; p.a0 = (const float*)d_in[6]; p.a2 = (const float*)d_in[7]; p.g2 = (const float*)d_in[8]; p.k_k = (const float*)d_in[9];
    p.k_a = (const float*)d_in[10]; p.r_k = (const float*)d_in[11]; p.ln_g = (const float*)d_in[12]; p.ln_b = (const float*)d_in[13]; p.w_out = (const float*)d_in[14];
    p.norm2_g = (const float*)d_in[15]; p.wq = (const float*)d_in[16]; p.sub_keys = (const float*)d_in[17]; p.pu = (const float*)d_in[18]; p.pv = (const float*)d_in[19];
    p.final_g = (const float*)d_in[20]; p.out = (float*)d_out; p.ws = (unsigned char*)d_ws;
    p.ph_lo = 0; p.ph_hi = N_PHASES; p.bar_li = 0;
    hipLaunchKernelGGL(mega, dim3(grid), dim3(NTHR), LDS_BYTES, stream, p);
}
```
